# Optimizing an MI355X kernel written in HIP

```python
import math
import jax, jax.numpy as jnp
from jax import lax
import numpy as np

D_MODEL = 1024
BATCH = 1
SEQ = 16384
DEPTH = 1

N_HEADS = 8
N_KV_GROUPS = 2
GROUP_SIZE = N_HEADS // N_KV_GROUPS
HEAD_DIM = 64
NSA_WIDTH = N_HEADS * HEAD_DIM
KV_WIDTH = N_KV_GROUPS * HEAD_DIM
CMP_STRIDE = 16
CMP_BLOCK = 2 * CMP_STRIDE
CMP_HIDDEN = 256
SEL_BLOCK = 64
SEL_PER_CMP = SEL_BLOCK // CMP_STRIDE
N_SELECT = 16
WINDOW = 512
Q_BLOCK = 128
LRU_WIDTH = 512
LRU_BLOCKS = 8
LRU_BLOCK_DIM = LRU_WIDTH // LRU_BLOCKS
CONV_WIDTH = 4
LRU_C = 8.0
N_BUCKETS = 32
MAX_DISTANCE = 128
N_BRANCHES = 2
EPS = 1e-6
NEG = -1e30
FORCE_SCORE = 1e9
IN_SIZES = (NSA_WIDTH, 6 * KV_WIDTH, NSA_WIDTH, 3 * N_HEADS, LRU_WIDTH, LRU_WIDTH, N_BRANCHES * D_MODEL)
D_IN = NSA_WIDTH + 6 * KV_WIDTH + NSA_WIDTH + 3 * N_HEADS + LRU_WIDTH + LRU_WIDTH + N_BRANCHES * D_MODEL

kernel_name = "hybrid_nsa_rglru_gated_block"


def rms_norm(x, g):
    xf = x.astype(jnp.float32)
    y = xf * lax.rsqrt(jnp.mean(xf * xf, axis=-1, keepdims=True) + EPS)
    return (y * g.astype(jnp.float32)).astype(x.dtype)


def t5_bucket(dist):
    n = jnp.maximum(dist, 0)
    max_exact = N_BUCKETS // 2
    nf = jnp.maximum(n, 1).astype(jnp.float32)
    large = max_exact + (jnp.log(nf / max_exact) / math.log(MAX_DISTANCE / max_exact)
                         * (N_BUCKETS - max_exact)).astype(jnp.int32)
    large = jnp.minimum(large, N_BUCKETS - 1)
    return jnp.where(n < max_exact, n, large)


def masked_softmax(s, mask):
    s = jnp.where(mask, s.astype(jnp.float32), NEG)
    return jax.nn.softmax(s, axis=-1) * mask


def compress_blocks(kv, pe, w1, b1, w2):
    B, S, G, dh = kv.shape
    ch = kv.reshape(B, S // CMP_STRIDE, CMP_STRIDE, G, dh)
    blocks = jnp.concatenate([ch[:, :-1], ch[:, 1:]], axis=2)
    blocks = blocks + pe[None, None, :, None, :]
    nc = blocks.shape[1]
    flat = blocks.transpose(0, 1, 3, 2, 4).reshape(B, nc, G, CMP_BLOCK * dh)
    return jax.nn.silu(flat @ w1 + b1) @ w2


def setup_inputs(seed: int = 0) -> dict:
    key = jax.random.key(seed)
    ks = jax.random.split(key, 24)
    nrm = lambda k, shape, s: jax.random.normal(k, shape, jnp.float32) * s
    u = jax.random.uniform(ks[17], (LRU_WIDTH,), jnp.float32, 0.9, 0.999)
    sig = u ** (1.0 / LRU_C)
    lru_lambda = jnp.log(sig) - jnp.log1p(-sig)
    return {
        "x": nrm(ks[0], (BATCH, SEQ, D_MODEL), 1.0),
        "norm_gain": 1.0 + nrm(ks[1], (D_MODEL,), 0.1),
        "w_in": nrm(ks[2], (D_MODEL, D_IN), D_MODEL ** -0.5),
        "q_norm_gain": 1.0 + nrm(ks[3], (HEAD_DIM,), 0.1),
        "k_norm_gain": 1.0 + nrm(ks[4], (3, HEAD_DIM), 0.1),
        "cmp_pe": nrm(ks[5], (2, CMP_BLOCK, HEAD_DIM), 0.5),
        "cmp_w1": nrm(ks[6], (2, CMP_BLOCK * HEAD_DIM, CMP_HIDDEN), (CMP_BLOCK * HEAD_DIM) ** -0.5),
        "cmp_b1": nrm(ks[7], (2, CMP_HIDDEN), 0.02),
        "cmp_w2": nrm(ks[8], (2, CMP_HIDDEN, HEAD_DIM), CMP_HIDDEN ** -0.5),
        "rel_bias": nrm(ks[9], (N_BUCKETS, N_HEADS), 0.5),
        "conv_w": nrm(ks[10], (CONV_WIDTH, LRU_WIDTH), CONV_WIDTH ** -0.5),
        "conv_b": nrm(ks[11], (LRU_WIDTH,), 0.02),
        "lru_wa": nrm(ks[12], (LRU_BLOCKS, LRU_BLOCK_DIM, LRU_BLOCK_DIM), LRU_BLOCK_DIM ** -0.5),
        "lru_ba": nrm(ks[13], (LRU_WIDTH,), 0.02),
        "lru_wx": nrm(ks[14], (LRU_BLOCKS, LRU_BLOCK_DIM, LRU_BLOCK_DIM), LRU_BLOCK_DIM ** -0.5),
        "lru_bx": nrm(ks[15], (LRU_WIDTH,), 0.02),
        "lru_lambda": lru_lambda,
        "w_proj_a": nrm(ks[18], (NSA_WIDTH, D_MODEL), NSA_WIDTH ** -0.5),
        "w_proj_b": nrm(ks[19], (LRU_WIDTH, D_MODEL), LRU_WIDTH ** -0.5),
        "w_out": nrm(ks[20], (D_MODEL, D_MODEL), D_MODEL ** -0.5),
    }


def nsa_mixer(q, k_cmp, v_cmp, k_slc, v_slc, k_win, v_win, br_gate, q_norm_gain, k_norm_gain,
              cmp_pe, cmp_w1, cmp_b1, cmp_w2, rel_bias):
    B, S, _ = q.shape
    G, R, dh = N_KV_GROUPS, GROUP_SIZE, HEAD_DIM
    nsb = S // SEL_BLOCK
    n_sel = min(N_SELECT, nsb)
    scale = dh ** -0.5

    q = (rms_norm(q.reshape(B, S, G, R, dh), q_norm_gain) * scale).transpose(0, 2, 3, 1, 4)
    kc = rms_norm(compress_blocks(k_cmp, cmp_pe[0], cmp_w1[0], cmp_b1[0], cmp_w2[0]), k_norm_gain[0])
    vc = compress_blocks(v_cmp, cmp_pe[1], cmp_w1[1], cmp_b1[1], cmp_w2[1])
    kc = kc.transpose(0, 2, 1, 3)
    vc = vc.transpose(0, 2, 1, 3)
    nc = kc.shape[2]
    k_blocks = rms_norm(k_slc, k_norm_gain[1]).transpose(0, 2, 1, 3).reshape(B, G, nsb, SEL_BLOCK, dh)
    v_blocks = v_slc.transpose(0, 2, 1, 3).reshape(B, G, nsb, SEL_BLOCK, dh)
    pad_w = ((0, 0), (0, 0), (WINDOW, 0), (0, 0))
    k_wp = jnp.pad(rms_norm(k_win, k_norm_gain[2]).transpose(0, 2, 1, 3), pad_w)
    v_wp = jnp.pad(v_win.transpose(0, 2, 1, 3), pad_w)

    bias_gr = rel_bias.reshape(N_BUCKETS, G, R)
    def shared_bias(dist):
        return rel_bias[t5_bucket(dist)].transpose(2, 0, 1).reshape(G, R, *dist.shape)
    def group_bias(dist):
        b = jax.vmap(lambda tab, bk: tab[bk], in_axes=(1, 1), out_axes=1)(bias_gr, t5_bucket(dist))
        return jnp.moveaxis(b, -1, 2)

    c_end = jnp.arange(nc, dtype=jnp.int32) * CMP_STRIDE + CMP_BLOCK - 1
    blk = jnp.arange(nsb, dtype=jnp.int32)
    bi = jnp.arange(B)[:, None, None, None]
    gi = jnp.arange(G)[None, :, None, None]
    right_pad = SEL_PER_CMP * nsb + SEL_PER_CMP - 1 - nc

    def block_fn(q0):
        qc = lax.dynamic_slice_in_dim(q, q0, Q_BLOCK, axis=3)
        t = q0 + jnp.arange(Q_BLOCK, dtype=jnp.int32)
        dist = t[:, None] - c_end[None, :]
        s = jnp.einsum('bgrqd,bgcd->bgrqc', qc, kc) + shared_bias(dist)
        p_cmp = masked_softmax(s, dist >= 0)
        o_cmp = jnp.einsum('bgrqc,bgcd->bgrqd', p_cmp.astype(vc.dtype), vc)
        imp = jnp.pad(p_cmp.sum(axis=2), ((0, 0), (0, 0), (0, 0), (1, right_pad)))
        imp_blk = (imp[..., :SEL_PER_CMP * nsb].reshape(B, G, Q_BLOCK, nsb, SEL_PER_CMP).sum(-1)
                   + imp[..., SEL_PER_CMP:SEL_PER_CMP * nsb + SEL_PER_CMP:SEL_PER_CMP])
        cur = (t // SEL_BLOCK)[:, None]
        valid = blk[None, :] <= cur
        force = (blk[None, :] == 0) | (blk[None, :] == cur) | (blk[None, :] == cur - 1)
        score = jnp.where(valid, jnp.where(force, FORCE_SCORE, imp_blk), -1.0)
        _, idx = lax.top_k(score, n_sel)
        kb = k_blocks[bi, gi, idx].reshape(B, G, Q_BLOCK, n_sel * SEL_BLOCK, dh)
        vb = v_blocks[bi, gi, idx].reshape(B, G, Q_BLOCK, n_sel * SEL_BLOCK, dh)
        pos = (idx[..., None] * SEL_BLOCK + jnp.arange(SEL_BLOCK, dtype=jnp.int32)).reshape(B, G, Q_BLOCK, -1)
        dist = t[None, None, :, None] - pos
        s = jnp.einsum('bgrqd,bgqkd->bgrqk', qc, kb) + group_bias(dist)
        p = masked_softmax(s, (dist >= 0)[:, :, None])
        o_slc = jnp.einsum('bgrqk,bgqkd->bgrqd', p.astype(vb.dtype), vb)
        kw = lax.dynamic_slice_in_dim(k_wp, q0, WINDOW + Q_BLOCK, axis=2)
        vw = lax.dynamic_slice_in_dim(v_wp, q0, WINDOW + Q_BLOCK, axis=2)
        pos = q0 - WINDOW + jnp.arange(WINDOW + Q_BLOCK, dtype=jnp.int32)
        dist = t[:, None] - pos[None, :]
        mask = (dist >= 0) & (dist < WINDOW) & (pos[None, :] >= 0)
        s = jnp.einsum('bgrqd,bgkd->bgrqk', qc, kw) + shared_bias(dist)
        p = masked_softmax(s, mask)
        o_win = jnp.einsum('bgrqk,bgkd->bgrqd', p.astype(vw.dtype), vw)
        return o_cmp, o_slc, o_win

    starts = jnp.arange(0, S, Q_BLOCK, dtype=jnp.int32)
    outs = lax.map(block_fn, starts)
    o = jnp.stack([ob.transpose(1, 0, 4, 2, 3, 5).reshape(B, S, N_HEADS, dh) for ob in outs], axis=2)
    g = jax.nn.sigmoid(br_gate.reshape(B, S, 3, N_HEADS, 1))
    return (g * o).sum(axis=2).reshape(B, S, NSA_WIDTH)


def rglru_mixer(u, conv_w, conv_b, lru_wa, lru_ba, lru_wx, lru_bx, lru_lambda):
    B, S, W = u.shape
    up = jnp.pad(u, ((0, 0), (CONV_WIDTH - 1, 0), (0, 0)))
    uc = conv_b + sum(up[:, k:k + S] * conv_w[k] for k in range(CONV_WIDTH))
    ub = uc.reshape(B, S, LRU_BLOCKS, LRU_BLOCK_DIM)
    r = jax.nn.sigmoid(jnp.einsum('bsnd,nde->bsne', ub, lru_wa).reshape(B, S, W) + lru_ba)
    i = jax.nn.sigmoid(jnp.einsum('bsnd,nde->bsne', ub, lru_wx).reshape(B, S, W) + lru_bx)
    log_a = (-LRU_C * r.astype(jnp.float32)) * jax.nn.softplus(-lru_lambda.astype(jnp.float32))
    a = jnp.exp(log_a)
    b = jnp.sqrt(-jnp.expm1(2.0 * log_a)) * (i * uc).astype(jnp.float32)
    def comb(left, right):
        a1, b1 = left
        a2, b2 = right
        return a1 * a2, a2 * b1 + b2
    _, h = lax.associative_scan(comb, (a, b), axis=1)
    return h.astype(u.dtype)


def reference(x, norm_gain, w_in, q_norm_gain, k_norm_gain, cmp_pe, cmp_w1, cmp_b1, cmp_w2, rel_bias,
              conv_w, conv_b, lru_wa, lru_ba, lru_wx, lru_bx, lru_lambda, w_proj_a, w_proj_b, w_out):
    B, S, _ = x.shape
    split_idx = np.cumsum(IN_SIZES)[:-1].tolist()
    for _layer in range(DEPTH):
        h = rms_norm(x, norm_gain)
        proj = h @ w_in
        q, kv_all, g_nsa, br_gate, u_lru, g_lru, merge_g = jnp.split(proj, split_idx, axis=-1)
        kv_all = kv_all.reshape(B, S, 6, N_KV_GROUPS, HEAD_DIM)
        y_a = nsa_mixer(q, kv_all[:, :, 0], kv_all[:, :, 1], kv_all[:, :, 2], kv_all[:, :, 3],
                        kv_all[:, :, 4], kv_all[:, :, 5], br_gate, q_norm_gain, k_norm_gain,
                        cmp_pe, cmp_w1, cmp_b1, cmp_w2, rel_bias)
        y_a = (y_a * jax.nn.silu(g_nsa)) @ w_proj_a
        y_b = rglru_mixer(u_lru, conv_w, conv_b, lru_wa, lru_ba, lru_wx, lru_bx, lru_lambda)
        y_b = (y_b * jax.nn.silu(g_lru)) @ w_proj_b
        gate_a, gate_b = jnp.split(merge_g, N_BRANCHES, axis=-1)
        m = jax.nn.sigmoid(gate_a) * y_a + jax.nn.sigmoid(gate_b) * y_b
        x = x + m @ w_out
    return x
```

```cpp
#include <hip/hip_runtime.h>
#include <cstdio>
#include <cstdint>

#ifndef MK_N_LAUNCHES
#define MK_N_LAUNCHES 1
#endif

#define GAS __attribute__((address_space(1)))
#define LAS __attribute__((address_space(3)))
typedef unsigned short bf16;
typedef short bf16x8 __attribute__((ext_vector_type(8)));
typedef short s16x4 __attribute__((ext_vector_type(4)));
typedef float f32x4 __attribute__((ext_vector_type(4)));
typedef float f32x16 __attribute__((ext_vector_type(16)));
typedef unsigned u32x4 __attribute__((ext_vector_type(4)));
typedef unsigned u32x2 __attribute__((ext_vector_type(2)));
typedef GAS unsigned gu32;

constexpr int SEQ = 16384, DM = 1024;
constexpr int NPROJ = 5120;
constexpr float LOG2E = 1.4426950408889634f;
constexpr float RMS_EPS = 1e-6f;

__device__ __forceinline__ unsigned f2bf(float f) { unsigned u = __builtin_bit_cast(unsigned, f); return (u + 0x7fffu + ((u >> 16) & 1u)) >> 16; }
__device__ __forceinline__ unsigned pk2(float lo, float hi) { return f2bf(lo) | (f2bf(hi) << 16); }
__device__ __forceinline__ float bf2f(unsigned h) { return __builtin_bit_cast(float, h << 16); }
__device__ __forceinline__ float bflo(unsigned w) { return __builtin_bit_cast(float, w << 16); }
__device__ __forceinline__ float bfhi(unsigned w) { return __builtin_bit_cast(float, w & 0xffff0000u); }
typedef float f32x2_t __attribute__((ext_vector_type(2))); typedef __bf16 bf16x2_t __attribute__((ext_vector_type(2)));
__device__ __forceinline__ unsigned cvtpk(float lo, float hi) { f32x2_t v = {lo, hi}; bf16x2_t b = __builtin_convertvector(v, bf16x2_t); return __builtin_bit_cast(unsigned, b); }
__device__ __forceinline__ float fsigmoid(float v) { return __builtin_amdgcn_rcpf(1.0f + __builtin_amdgcn_exp2f(-v * LOG2E)); }
template <int CTRL> __device__ __forceinline__ float dpp_f(float v) { return __builtin_bit_cast(float, __builtin_amdgcn_update_dpp(0, __builtin_bit_cast(int, v), CTRL, 0xf, 0xf, true)); }
template <int CTRL> __device__ __forceinline__ int dpp_i(int v) { return __builtin_amdgcn_update_dpp(v, v, CTRL, 0xf, 0xf, false); }
__device__ __forceinline__ float wave_sum(float v) {
#pragma unroll
    for (int o = 1; o < 64; o <<= 1) v += __shfl_xor(v, o);
    return v;
}

namespace pg8 {
#define PG8_LAS __attribute__((address_space(3)))
typedef unsigned short bf16_t;
constexpr int BM = 256, BK = 64, HALF = 128, HTB = HALF * BK * 2, STAGE_BYTES = 8 * HTB, NXCD = 8, WGM = 8;
__host__ __device__ __forceinline__ int lds_byte(int r, int c) { const int st = (r >> 4) * 2 + (c >> 5), rr = r & 15, cc = c & 31, ob = rr * 64 + cc * 2; return st * 1024 + (ob ^ (((ob >> 9) & 1) << 5)); }
__host__ __device__ __forceinline__ void stage_rc(int b, int& R, int& C) { const int st = b / 1024, sb = b % 1024, swz = sb ^ (((sb >> 9) & 1) << 5); R = (st >> 1) * 16 + swz / 64; C = (st & 1) * 32 + (swz % 64) / 2; }
__host__ __device__ __forceinline__ int perm32(int rho) { const int n = rho >> 4, i = rho & 15; return 8 * (i >> 2) + 4 * n + (i & 3); }

struct Unit { int pm, pn, part; };
struct Gemm { const bf16_t* A; const bf16_t* Bt; const bf16_t* A2; const bf16_t* Bt2; int lda, ldb, K; };

struct StaticOrder {
    int nM, nN, nwg, G, c;
    __host__ __device__ void init(int M, int N, int G_, int c_) { nM = M / BM; nN = N / BM; nwg = nM * nN; G = G_; c = c_; }
    __host__ __device__ bool tile(long L, Unit& u) const {
        if (L >= nwg) return false;
        int wgid = (int)L; { const int q = nwg / NXCD, r = nwg % NXCD, xcd = wgid % NXCD, off = wgid / NXCD; wgid = (xcd < r ? xcd * (q + 1) : r * (q + 1) + (xcd - r) * q) + off; }
        const int nig = WGM * nN, gid = wgid / nig, fm = gid * WGM, gsz = (nM - fm) < WGM ? (nM - fm) : WGM;
        u.pm = fm + ((wgid % nig) % gsz); u.pn = (wgid % nig) / gsz; u.part = 0; return true;
    }
    __host__ __device__ bool next(int i, Unit& u) const { return tile((long)i * G + c, u); }
};
struct DualOrder : StaticOrder {
    __host__ __device__ bool next(int i, Unit& u) const { if (!tile((long)(i >> 1) * G + c, u)) return false; u.part = i & 1; return true; }
};

__device__ __forceinline__ unsigned cvt_pk_bf16(float lo, float hi) { unsigned r; asm volatile("v_cvt_pk_bf16_f32 %0, %1, %2" : "=v"(r) : "v"(lo), "v"(hi)); return r; }

struct EpiProj {
    static constexpr bool PERM = true;
    bf16_t *Q, *KV, *U, *BR, *GN, *GL, *MG;
    __device__ __forceinline__ void operator()(const f32x4 (&acc)[2][2][4][2], const Unit& u, int wr, int wc, int fr, int fq) const {
        const int pn = u.pn; bf16_t* base; int ldc, colt, act = 0;
        if (pn < 2) { base = Q; ldc = 512; colt = pn * 256; }
        else if (pn < 5) { base = KV; ldc = 768; colt = (pn - 2) * 256; }
        else if (pn < 7) { base = U; ldc = 512; colt = (pn - 5) * 256; }
        else if (pn < 8) { base = BR; ldc = 256; colt = 0; }
        else if (pn < 10) { base = GN; ldc = 512; colt = (pn - 8) * 256; act = 1; }
        else if (pn < 12) { base = GL; ldc = 512; colt = (pn - 10) * 256; act = 1; }
        else { base = MG; ldc = 2048; colt = (pn - 12) * 256; act = 2; }
        const int row0 = u.pm * BM + wr * 64 + fr, col0 = colt + wc * 32 + 8 * fq;
#pragma unroll
        for (int ai = 0; ai < 2; ++ai)
#pragma unroll
            for (int m = 0; m < 4; ++m) { bf16_t* rowp = base + (size_t)(row0 + ai * HALF + m * 16) * ldc + col0;
#pragma unroll
                for (int bj = 0; bj < 2; ++bj) { f32x4 v0 = acc[ai][bj][m][0], v1 = acc[ai][bj][m][1];
                    if (act) {
#pragma unroll
                        for (int e = 0; e < 4; ++e) { const float s0 = fsigmoid(v0[e]), s1 = fsigmoid(v1[e]); v0[e] = (act == 1) ? v0[e] * s0 : s0; v1[e] = (act == 1) ? v1[e] * s1 : s1; } }
                    u32x4 w; w.x = cvt_pk_bf16(v0[0], v0[1]); w.y = cvt_pk_bf16(v0[2], v0[3]); w.z = cvt_pk_bf16(v1[0], v1[1]); w.w = cvt_pk_bf16(v1[2], v1[3]);
                    *(u32x4*)(rowp + bj * HALF) = w; } }
    }
};
struct EpiMerge {
    static constexpr bool PERM = true;
    bf16_t* Mb; const bf16_t* MG;
    __device__ __forceinline__ void operator()(const f32x4 (&acc)[2][2][4][2], const Unit& u, int wr, int wc, int fr, int fq) const {
        const int row0 = u.pm * BM + wr * 64 + fr, col0 = u.pn * BM + wc * 32 + 8 * fq;
#pragma unroll
        for (int ai = 0; ai < 2; ++ai)
#pragma unroll
            for (int m = 0; m < 4; ++m) { const size_t r = (size_t)(row0 + ai * HALF + m * 16);
#pragma unroll
                for (int bj = 0; bj < 2; ++bj) { const f32x4 v0 = acc[ai][bj][m][0], v1 = acc[ai][bj][m][1];
                    const u32x4 gw = *(const u32x4*)(MG + r * 2048 + u.part * 1024 + col0 + bj * HALF);
                    float o[8] = {v0[0] * bflo(gw.x), v0[1] * bfhi(gw.x), v0[2] * bflo(gw.y), v0[3] * bfhi(gw.y), v1[0] * bflo(gw.z), v1[1] * bfhi(gw.z), v1[2] * bflo(gw.w), v1[3] * bfhi(gw.w)};
                    bf16_t* dst = Mb + r * 1024 + col0 + bj * HALF;
                    if (u.part) { const u32x4 pw = *(const u32x4*)dst;
                        o[0] += bflo(pw.x); o[1] += bfhi(pw.x); o[2] += bflo(pw.y); o[3] += bfhi(pw.y); o[4] += bflo(pw.z); o[5] += bfhi(pw.z); o[6] += bflo(pw.w); o[7] += bfhi(pw.w); }
                    u32x4 w; w.x = cvt_pk_bf16(o[0], o[1]); w.y = cvt_pk_bf16(o[2], o[3]); w.z = cvt_pk_bf16(o[4], o[5]); w.w = cvt_pk_bf16(o[6], o[7]);
                    *(u32x4*)dst = w; } }
    }
};
struct EpiOut {
    static constexpr bool PERM = false;
    const float* X; float* O;
    __device__ __forceinline__ void operator()(const f32x4 (&acc)[2][2][4][2], const Unit& u, int wr, int wc, int fr, int fq) const {
        const int row0 = u.pm * BM + wr * 64 + fr, col0 = u.pn * BM + wc * 32 + 4 * fq;
#pragma unroll
        for (int ai = 0; ai < 2; ++ai)
#pragma unroll
            for (int m = 0; m < 4; ++m) { const size_t off = (size_t)(row0 + ai * HALF + m * 16) * 1024 + col0;
#pragma unroll
                for (int bj = 0; bj < 2; ++bj)
#pragma unroll
                    for (int n = 0; n < 2; ++n) { const f32x4 xv = *(const f32x4*)(X + off + bj * HALF + n * 16); *(f32x4*)(O + off + bj * HALF + n * 16) = xv + acc[ai][bj][m][n]; } }
    }
};

template <class Epi, class Sched, bool ALIGN_EPI>
__device__ __forceinline__ void gemm_phase(PG8_LAS unsigned char* lds, const Gemm g, const Sched& S, const Epi& E) {
    const int tid = threadIdx.x, wid = __builtin_amdgcn_readfirstlane(tid >> 6), lane = tid & 63, wr = wid >> 2, wc = wid & 3, fr = lane & 15, fq = lane >> 4;
    const int K = g.K, nt = K / BK;
    unsigned voffA[2], voffB[2];
#pragma unroll
    for (int i = 0; i < 2; ++i) { int R, C; stage_rc(tid * 16 + i * 8192, R, C); const int Rb = Epi::PERM ? ((R & ~31) + perm32(R & 31)) : R;
        voffA[i] = (unsigned)(R * g.lda + C) * 2u; voffB[i] = (unsigned)(Rb * g.ldb + C) * 2u; }
    const size_t kstep = (size_t)(BK * 2);
    const size_t hstepA = (size_t)HALF * g.lda * 2, hstepB = (size_t)HALF * g.ldb * 2;
    const size_t tstepA = 2 * hstepA, tstepB = 2 * hstepB;
    const unsigned ldsw = (unsigned)wid * 1024u;
    const int aoff = lds_byte(wr * 64 + fr, fq * 8), boff = lds_byte(wc * 32 + fr, fq * 8);
#define PG8_SA(b, h) (((b) * 2 + (h)) * HTB)
#define PG8_SB(b, h) ((4 + (b) * 2 + (h)) * HTB)
#define PG8_STAGE(bufoff, gbase, voff) do { _Pragma("unroll") for (int _i = 0; _i < 2; ++_i) \
        __builtin_amdgcn_global_load_lds((const unsigned*)((const char*)(gbase) + (voff)[_i]), (PG8_LAS unsigned*)(lds + (bufoff) + ldsw + _i * 8192), 16, 0, 0); } while (0)
#define PG8_LDA(dst, b, h) do { _Pragma("unroll") for (int m = 0; m < 4; ++m) _Pragma("unroll") for (int k = 0; k < 2; ++k) dst[m][k] = *(const PG8_LAS bf16x8*)(lds + PG8_SA(b, h) + aoff + m * 2048 + k * 1024); } while (0)
#define PG8_LDB(dst, b, h) do { _Pragma("unroll") for (int n = 0; n < 2; ++n) _Pragma("unroll") for (int k = 0; k < 2; ++k) dst[n][k] = *(const PG8_LAS bf16x8*)(lds + PG8_SB(b, h) + boff + n * 2048 + k * 1024); } while (0)
#define PG8_MMA(ai, bj, At, Bt) do { __builtin_amdgcn_s_setprio(1); _Pragma("unroll") for (int m = 0; m < 4; ++m) _Pragma("unroll") for (int n = 0; n < 2; ++n) _Pragma("unroll") for (int k = 0; k < 2; ++k) \
        acc[ai][bj][m][n] = __builtin_amdgcn_mfma_f32_16x16x32_bf16(Bt[n][k], At[m][k], acc[ai][bj][m][n], 0, 0, 0); __builtin_amdgcn_s_setprio(0); } while (0)
#define PG8_WAIT_V(n) asm volatile("s_waitcnt vmcnt(" #n ")" ::: "memory")
#define PG8_WAIT_L(n) asm volatile("s_waitcnt lgkmcnt(" #n ")" ::: "memory")
#define PG8_BAR __builtin_amdgcn_s_barrier()
#define PG8_SCHED __builtin_amdgcn_sched_barrier(0)
#define PG8_UA(u) ((const char*)((u).part ? g.A2 : g.A) + (size_t)(u).pm * tstepA)
#define PG8_UB(u) ((const char*)((u).part ? g.Bt2 : g.Bt) + (size_t)(u).pn * tstepB)
    Unit cur, nxt; int ui = 0;
    if (!S.next(0, cur)) return;
    f32x4 acc[2][2][4][2];
#pragma unroll
    for (int a = 0; a < 2; ++a)
#pragma unroll
        for (int b = 0; b < 2; ++b)
#pragma unroll
            for (int m = 0; m < 4; ++m)
#pragma unroll
                for (int n = 0; n < 2; ++n) acc[a][b][m][n] = (f32x4){0.f, 0.f, 0.f, 0.f};
    bf16x8 At[4][2], B0[2][2], B1[2][2];
    const char* cA = PG8_UA(cur); const char* cB = PG8_UB(cur);
    PG8_STAGE(PG8_SB(0, 0), cB, voffB); PG8_STAGE(PG8_SB(0, 1), cB + hstepB, voffB); PG8_STAGE(PG8_SA(0, 0), cA, voffA); PG8_STAGE(PG8_SA(0, 1), cA + hstepA, voffA);
    if (wr == 1) PG8_BAR;
    PG8_WAIT_V(2); PG8_BAR;
    PG8_STAGE(PG8_SB(1, 0), cB + kstep, voffB); PG8_STAGE(PG8_SA(1, 0), cA + kstep, voffA); PG8_STAGE(PG8_SB(1, 1), cB + hstepB + kstep, voffB);
    PG8_WAIT_V(6); PG8_BAR;
    for (;;) {
        const bool has_next = S.next(ui + 1, nxt);
        const char* nA = has_next ? PG8_UA(nxt) : cA; const char* nB = has_next ? PG8_UB(nxt) : cB;
        for (int t = 0; t < nt; t += 2) {
            const bool last = (t == nt - 2);
            const char* a1 = cA + (size_t)(t + 1) * kstep;
            const char* a2 = last ? nA : cA + (size_t)(t + 2) * kstep; const char* b2 = last ? nB : cB + (size_t)(t + 2) * kstep;
            const char* a3 = a2 + kstep; const char* b3 = b2 + kstep;
            PG8_LDB(B0, 0, 0); PG8_LDB(B1, 0, 1); PG8_SCHED; PG8_LDA(At, 0, 0); PG8_STAGE(PG8_SA(1, 1), a1 + hstepA, voffA);
            PG8_WAIT_V(8); PG8_WAIT_L(0); PG8_BAR; PG8_MMA(0, 0, At, B0); PG8_MMA(0, 1, At, B1); PG8_BAR; PG8_SCHED;
            PG8_LDA(At, 0, 1); PG8_STAGE(PG8_SB(0, 0), b2, voffB); PG8_STAGE(PG8_SB(0, 1), b2 + hstepB, voffB); PG8_STAGE(PG8_SA(0, 0), a2, voffA);
            PG8_WAIT_V(8); PG8_WAIT_L(0); PG8_BAR; PG8_MMA(1, 0, At, B0); PG8_MMA(1, 1, At, B1); PG8_BAR; PG8_SCHED;
            PG8_LDB(B0, 1, 0); PG8_LDB(B1, 1, 1); PG8_SCHED; PG8_LDA(At, 1, 0); PG8_STAGE(PG8_SA(0, 1), a2 + hstepA, voffA);
            PG8_WAIT_V(8); PG8_WAIT_L(0); PG8_BAR; PG8_MMA(0, 0, At, B0); PG8_MMA(0, 1, At, B1); PG8_BAR; PG8_SCHED;
            PG8_LDA(At, 1, 1); PG8_STAGE(PG8_SB(1, 0), b3, voffB); PG8_STAGE(PG8_SB(1, 1), b3 + hstepB, voffB); PG8_STAGE(PG8_SA(1, 0), a3, voffA);
            PG8_WAIT_V(8); PG8_WAIT_L(0); PG8_BAR; PG8_MMA(1, 0, At, B0); PG8_MMA(1, 1, At, B1); PG8_BAR; PG8_SCHED;
        }
        if constexpr (ALIGN_EPI) { if (wr == 0) PG8_BAR; }
        E(acc, cur, wr, wc, fr, fq);
        if (!has_next) break;
#pragma unroll
        for (int a = 0; a < 2; ++a)
#pragma unroll
            for (int b = 0; b < 2; ++b)
#pragma unroll
                for (int m = 0; m < 4; ++m)
#pragma unroll
                    for (int n = 0; n < 2; ++n) acc[a][b][m][n] = (f32x4){0.f, 0.f, 0.f, 0.f};
        cur = nxt; cA = nA; cB = nB; ++ui;
        if constexpr (ALIGN_EPI) { if (wr == 1) PG8_BAR; }
    }
    PG8_WAIT_V(0);
    if constexpr (!ALIGN_EPI) { if (wr == 0) PG8_BAR; }
    PG8_BAR;
#undef PG8_SA
#undef PG8_SB
#undef PG8_STAGE
#undef PG8_LDA
#undef PG8_LDB
#undef PG8_MMA
#undef PG8_WAIT_V
#undef PG8_WAIT_L
#undef PG8_BAR
#undef PG8_SCHED
#undef PG8_UA
#undef PG8_UB
}
}

constexpr int NWAVES = 8;
constexpr int N_LAUNCHES = MK_N_LAUNCHES;
constexpr int PER_PHASE = 6;
constexpr size_t MiB = 1u << 20;
constexpr size_t WS_CTL = 0, CTL_ZERO_BYTES = 1 * MiB;
constexpr size_t WS_WIN = 1 * MiB;
constexpr size_t WS_WA = 11 * MiB;
constexpr size_t WS_WB = 12 * MiB;
constexpr size_t WS_WOUT = 13 * MiB;
constexpr size_t WS_W1T = 15 * MiB;
constexpr size_t WS_SMALL = 17 * MiB;
constexpr size_t WS_SUM = 18 * MiB;
constexpr size_t WS_KC = 19 * MiB;
constexpr size_t WS_XN = 20 * MiB;
constexpr size_t WS_Q = 52 * MiB;
constexpr size_t WS_KV = 68 * MiB;
constexpr size_t WS_MB = 52 * MiB;
constexpr size_t WS_U = 92 * MiB;
constexpr size_t WS_BR = 108 * MiB;
constexpr size_t WS_GN = 116 * MiB;
constexpr size_t WS_GL = 132 * MiB;
constexpr size_t WS_MG = 148 * MiB;
constexpr size_t WS_END = 212 * MiB;
constexpr size_t SM_W2T = 0;
constexpr size_t SM_LWA = 65536;
constexpr size_t SM_LWX = 131072;
constexpr size_t SM_C1 = 196608;
constexpr size_t SM_LUT = 200704;
constexpr int CW_BAR = 4096;

constexpr int RING_BYTES = 131072;
constexpr int LDSCTL_OFF = RING_BYTES, MISC_OFF = LDSCTL_OFF + 320;
constexpr int LDS_BYTES = 147456;

#define RLX_AGENT __ATOMIC_RELAXED, __HIP_MEMORY_SCOPE_AGENT
#define LDS_WAIT() asm volatile("s_waitcnt lgkmcnt(0)" ::: "memory")
#define VM_WAIT() asm volatile("s_waitcnt vmcnt(0)" ::: "memory")

#define XB_TMO      128
#define XB_XCNT(j)  (256  + 64 * (j))
#define XB_XSUB(j)  (1280 + 64 * (j))
#define XB_XGEN(j)  (2304 + 64 * (j))
#define XB_TOP      3328
#define XB_TOPGEN   3392
#define XCD_BAR_WORDS 3456
#define XB_SPIN_CAP (1u << 18)
__device__ __forceinline__ unsigned xb_ld(unsigned* p)              { return __hip_atomic_load(p, __ATOMIC_RELAXED, __HIP_MEMORY_SCOPE_AGENT); }
__device__ __forceinline__ unsigned xb_add(unsigned* p, unsigned v) { return __hip_atomic_fetch_add(p, v, __ATOMIC_RELAXED, __HIP_MEMORY_SCOPE_AGENT); }
__device__ __forceinline__ unsigned xb_xcc_id() { return (unsigned)__builtin_amdgcn_s_getreg((3 << 11) | 20) & 0xFu; }
#define XB_SPIN(cond, bar) do { unsigned _sp = 0; while (cond) { __builtin_amdgcn_s_sleep(1); \
    if ((++_sp & 255u) == 0u) { if (xb_ld(&(bar)[XB_TMO])) break; if (_sp > XB_SPIN_CAP) { atomicAdd(&(bar)[XB_TMO], 1u); break; } } } } while (0)
struct XcdBarrier { unsigned* bar; unsigned x; volatile LAS unsigned* st; };
__device__ __forceinline__ XcdBarrier xcd_barrier_post(unsigned* bar, volatile LAS unsigned* st) {
    XcdBarrier b; b.bar = bar; b.x = xb_xcc_id(); b.st = st;
    if (threadIdx.x == 0) (void)xb_add(&bar[XB_XCNT(b.x)], 1u);
    return b;
}
__device__ __forceinline__ void xcd_barrier_complete(unsigned* bar, unsigned x, unsigned& nloc, unsigned& nx) {
    const unsigned G = gridDim.x * gridDim.y * gridDim.z;
    unsigned sum, cnt, mine, sp = 0u;
    for (;;) {
        sum = 0u; cnt = 0u; mine = 0u;
#pragma unroll
        for (unsigned j = 0; j < 16; ++j) { const unsigned c = xb_ld(&bar[XB_XCNT(j)]); sum += c; cnt += (c > 0u) ? 1u : 0u; mine = (j == x) ? c : mine; }
        if (sum == G) break;
        __builtin_amdgcn_s_sleep(1);
        if ((++sp & 255u) == 0u) { if (xb_ld(&bar[XB_TMO])) break; if (sp > XB_SPIN_CAP) { atomicAdd(&bar[XB_TMO], 1u); break; } }
    }
    nloc = mine > 0u ? mine : 1u; nx = cnt > 0u ? cnt : 1u;
}
__device__ __forceinline__ void xcd_barrier(const XcdBarrier& b) {
    asm volatile("s_waitcnt vmcnt(0)" ::: "memory");
    __syncthreads();
    if (threadIdx.x == 0) {
        unsigned* bar = b.bar;
        __builtin_amdgcn_s_waitcnt(0);
        unsigned nloc = b.st[0], nx = b.st[1];
        if (nloc == 0u) { xcd_barrier_complete(bar, b.x, nloc, nx); b.st[0] = nloc; b.st[1] = nx; }
        const unsigned old = xb_add(&bar[XB_XSUB(b.x)], 1u);
        const unsigned gen = old / nloc;
        if (old + 1u == (gen + 1u) * nloc) {
            __builtin_amdgcn_fence(__ATOMIC_RELEASE, "agent");
            asm volatile("s_waitcnt vmcnt(0)" ::: "memory");
            const unsigned og = xb_add(&bar[XB_TOP], 1u);
            const unsigned tg = og / nx;
            if (og + 1u == (tg + 1u) * nx) xb_add(&bar[XB_TOPGEN], 1u);
            else XB_SPIN(xb_ld(&bar[XB_TOPGEN]) == tg, bar);
            __builtin_amdgcn_fence(__ATOMIC_ACQUIRE, "agent");
            xb_add(&bar[XB_XGEN(b.x)], 1u);
            asm volatile("s_waitcnt vmcnt(0)" ::: "memory");
        } else {
            XB_SPIN(xb_ld(&bar[XB_XGEN(b.x)]) == gen, bar);
            __builtin_amdgcn_fence(__ATOMIC_ACQUIRE, "agent");
            asm volatile("s_waitcnt vmcnt(0)" ::: "memory");
        }
    }
    __syncthreads();
}

struct Args { const float* in[20]; float* out; unsigned char* ws; int ph_lo, ph_hi, li, pad; };
struct Frame {
    LAS unsigned char* lds;
    volatile LAS unsigned* MISC;
    int tid, lane, wave;
    int vcu, G;
    unsigned char* ws;
#define WSP(name, T, off) __device__ __forceinline__ T* name() const { return (T*)(ws + (off)); }
    WSP(WinT, bf16, WS_WIN) WSP(WaT, bf16, WS_WA) WSP(WbT, bf16, WS_WB) WSP(WoutT, bf16, WS_WOUT) WSP(W1T, bf16, WS_W1T)
    WSP(W2T, bf16, WS_SMALL + SM_W2T) WSP(LWA, bf16, WS_SMALL + SM_LWA) WSP(LWX, bf16, WS_SMALL + SM_LWX)
    WSP(C1, float, WS_SMALL + SM_C1) WSP(LUT, float, WS_SMALL + SM_LUT) WSP(SUMA, float, WS_SUM) WSP(SUMB, float, WS_SUM + 524288)
    WSP(KC, bf16, WS_KC) WSP(VC, bf16, WS_KC + 524288) WSP(XN, bf16, WS_XN) WSP(Q, bf16, WS_Q) WSP(KV, bf16, WS_KV) WSP(MB, bf16, WS_MB)
    WSP(U, bf16, WS_U) WSP(BR, bf16, WS_BR) WSP(GN, bf16, WS_GN) WSP(GL, bf16, WS_GL) WSP(MG, bf16, WS_MG)
#undef WSP
};

__device__ __forceinline__ int t5_bucket(int n) {
    if (n < 16) return n;
    const int thr[15] = {19, 21, 24, 27, 31, 35, 40, 46, 52, 59, 67, 77, 87, 99, 113};
    int b = 16;
#pragma unroll
    for (int i = 0; i < 15; ++i) b += (n >= thr[i]) ? 1 : 0;
    return b;
}

__device__ __forceinline__ void p0_tr_item(const float* W, int ldw, int k0, int srccol0, int nvalid, bf16* WT, int ldt, int dstrow0, LAS float* scr, int lane) {
    const int c = lane & 31;
#pragma unroll 8
    for (int i = 0; i < 32; ++i) { const int kk = 2 * i + (lane >> 5); scr[kk * 33 + c] = (c < nvalid) ? W[(size_t)(k0 + kk) * ldw + srccol0 + c] : 0.f; }
    LDS_WAIT(); asm volatile("" ::: "memory");
    const int cc = lane & 7;
#pragma unroll
    for (int j = 0; j < 4; ++j) { const int n = (lane >> 3) + 8 * j; const LAS float* s = scr + (8 * cc) * 33 + n;
        u32x4 o; o.x = pk2(s[0 * 33], s[1 * 33]); o.y = pk2(s[2 * 33], s[3 * 33]); o.z = pk2(s[4 * 33], s[5 * 33]); o.w = pk2(s[6 * 33], s[7 * 33]);
        *(u32x4*)(WT + (size_t)(dstrow0 + n) * ldt + k0 + 8 * cc) = o; }
    LDS_WAIT(); asm volatile("" ::: "memory");
}
__device__ __forceinline__ void win_src(int n0, int& src, int& nvalid) {
    nvalid = 32;
    if (n0 < 1280) src = n0;
    else if (n0 < 1792) src = 1816 + (n0 - 1280);
    else if (n0 < 2048) { src = 1792 + (n0 - 1792); nvalid = (n0 == 1792) ? 24 : 0; if (n0 != 1792) src = 0; }
    else if (n0 < 2560) src = 1280 + (n0 - 2048);
    else if (n0 < 3072) src = 2328 + (n0 - 2560);
    else src = 2840 + (n0 - 3072);
}
__device__ __forceinline__ void p0_prologue(const Frame& F, const Args& A) {
    LAS float* scr = (LAS float*)(F.lds + F.wave * 16384);
    const int gw = F.vcu * NWAVES + F.wave, NGW = F.G * NWAVES, lane = F.lane;
    constexpr int I_WIN = 16 * 160, I_WA = 8 * 32, I_WO = 16 * 32, I_W1 = 32 * 8, I_W2 = 4 * 2, I_LR = 2;
    constexpr int NIT = I_WIN + 2 * I_WA + I_WO + 2 * I_W1 + 2 * I_W2 + 16 * I_LR + 8 + 1;
    for (int it = gw; it < NIT; it += NGW) {
        int r = it;
        if (r < I_WIN) { const int kb = r / 160, nb = r % 160; int src, nv; win_src(32 * nb, src, nv); p0_tr_item(A.in[2], 4888, 64 * kb, src, nv, F.WinT(), 1024, 32 * nb, scr, lane); continue; } r -= I_WIN;
        if (r < I_WA) { p0_tr_item(A.in[17], 1024, 64 * (r / 32), 32 * (r % 32), 32, F.WaT(), 512, 32 * (r % 32), scr, lane); continue; } r -= I_WA;
        if (r < I_WA) { p0_tr_item(A.in[18], 1024, 64 * (r / 32), 32 * (r % 32), 32, F.WbT(), 512, 32 * (r % 32), scr, lane); continue; } r -= I_WA;
        if (r < I_WO) { p0_tr_item(A.in[19], 1024, 64 * (r / 32), 32 * (r % 32), 32, F.WoutT(), 1024, 32 * (r % 32), scr, lane); continue; } r -= I_WO;
        if (r < 2 * I_W1) { const int kv = r / I_W1, q = r % I_W1; p0_tr_item(A.in[6] + (size_t)kv * 2048 * 256, 256, 64 * (q / 8), 32 * (q % 8), 32, F.W1T() + (size_t)kv * 256 * 2048, 2048, 32 * (q % 8), scr, lane); continue; } r -= 2 * I_W1;
        if (r < 2 * I_W2) { const int kv = r / I_W2, q = r % I_W2; p0_tr_item(A.in[8] + (size_t)kv * 256 * 64, 64, 64 * (q / 2), 32 * (q % 2), 32, F.W2T() + (size_t)kv * 64 * 256, 256, 32 * (q % 2), scr, lane); continue; } r -= 2 * I_W2;
        if (r < 16 * I_LR) { const int mtx = r / 2, nb = r % 2; const float* src = (mtx < 8 ? A.in[12] : A.in[14]) + (size_t)(mtx & 7) * 4096; bf16* dst = (mtx < 8 ? F.LWA() : F.LWX()) + (size_t)(mtx & 7) * 4096;
            p0_tr_item(src, 64, 0, 32 * nb, 32, dst, 64, 32 * nb, scr, lane); continue; } r -= 16 * I_LR;
        if (r < 8) {
            const int kv = r >> 2, n = (r & 3) * 64 + lane; const float* w1 = A.in[6] + (size_t)kv * 2048 * 256 + n; const float* pe = A.in[5] + kv * 2048;
            float s0 = 0.f, s1 = 0.f, s2 = 0.f, s3 = 0.f;
            for (int k = 0; k < 2048; k += 4) { s0 += pe[k] * w1[(size_t)k * 256]; s1 += pe[k + 1] * w1[(size_t)(k + 1) * 256]; s2 += pe[k + 2] * w1[(size_t)(k + 2) * 256]; s3 += pe[k + 3] * w1[(size_t)(k + 3) * 256]; }
            F.C1()[kv * 256 + n] = A.in[7][kv * 256 + n] + ((s0 + s1) + (s2 + s3)); continue; } r -= 8;
        {
            for (int e = lane; e < 1024; e += 64) { const int hd = e >> 7, n = e & 127; F.LUT()[e] = A.in[9][t5_bucket(n) * 8 + hd] * LOG2E; }
        }
    }
    const float* gain = A.in[1];
    for (int m = gw; m < SEQ; m += NGW) {
        const f32x4* xr = (const f32x4*)(A.in[0] + (size_t)m * DM) + lane;
        f32x4 v[4]; float s = 0.f;
#pragma unroll
        for (int j = 0; j < 4; ++j) { v[j] = xr[64 * j]; s += (v[j].x * v[j].x + v[j].y * v[j].y) + (v[j].z * v[j].z + v[j].w * v[j].w); }
        const float rs = 1.0f / sqrtf(wave_sum(s) * (1.f / DM) + RMS_EPS);
        unsigned long long* o8 = (unsigned long long*)(F.XN() + (size_t)m * DM) + lane;
#pragma unroll
        for (int j = 0; j < 4; ++j) { const f32x4 gv = ((const f32x4*)gain)[lane + 64 * j];
            o8[64 * j] = (unsigned long long)pk2(v[j].x * rs * gv.x, v[j].y * rs * gv.y) | ((unsigned long long)pk2(v[j].z * rs * gv.z, v[j].w * rs * gv.w) << 32); }
    }
}

template <bool FINAL>
__device__ __forceinline__ void lru_tile(const Frame& F, const Args& A, int tt) {
    const int lane = F.lane, w = F.wave, fr = lane & 15, fq = lane >> 4, ch0 = 64 * w, t0 = 64 * tt;
    LAS float* UC = (LAS float*)(F.lds + w * 16384);
#define UC_IDX(tok, ch) ((tok) * 64 + ((((ch) >> 2) ^ ((tok) & 15)) << 2) + ((ch) & 3))
    {
        const int ch = ch0 + lane; const float* cw = A.in[10]; const float cb = A.in[11][ch];
        const float w0 = cw[ch], w1 = cw[512 + ch], w2 = cw[1024 + ch], w3 = cw[1536 + ch];
        const bf16* up = F.U() + (size_t)t0 * 512 + ch;
        float u0 = 0.f, u1 = 0.f, u2 = 0.f;
        if (tt > 0) { u0 = bf2f(up[-3 * 512]); u1 = bf2f(up[-2 * 512]); u2 = bf2f(up[-1 * 512]); }
#pragma unroll 16
        for (int tok = 0; tok < 64; ++tok) { const float u3 = bf2f(up[(size_t)tok * 512]);
            UC[UC_IDX(tok, lane)] = cb + ((u0 * w0 + u1 * w1) + (u2 * w2 + u3 * w3)); u0 = u1; u1 = u2; u2 = u3; }
    }
    bf16x8 Ba[4][2], Bx[4][2];
#pragma unroll
    for (int nt = 0; nt < 4; ++nt)
#pragma unroll
        for (int ks = 0; ks < 2; ++ks) { const size_t o = (size_t)w * 4096 + (16 * nt + fr) * 64 + 32 * ks + 8 * fq; Ba[nt][ks] = *(const bf16x8*)(F.LWA() + o); Bx[nt][ks] = *(const bf16x8*)(F.LWX() + o); }
    float ba[4], bx[4], sp8[4], hin[4], acum[4];
#pragma unroll
    for (int nt = 0; nt < 4; ++nt) { const int ch = ch0 + 16 * nt + fr; ba[nt] = A.in[13][ch]; bx[nt] = A.in[15][ch];
        sp8[nt] = 8.0f * log1pf(expf(-A.in[16][ch])); hin[nt] = 0.f; acum[nt] = 1.f; }
    if (FINAL) {
        float H = 0.f; const float* sa = F.SUMA() + ch0 + lane; const float* sb = F.SUMB() + ch0 + lane;
#pragma unroll 8
        for (int i = 0; i < tt; ++i) H = sa[(size_t)i * 512] * H + sb[(size_t)i * 512];
#pragma unroll
        for (int nt = 0; nt < 4; ++nt) hin[nt] = __shfl(H, 16 * nt + fr);
    }
    LDS_WAIT();
#pragma unroll 1
    for (int mt = 0; mt < 4; ++mt) {
        bf16x8 Af[2];
#pragma unroll
        for (int ks = 0; ks < 2; ++ks) { const int tok = 16 * mt + fr, c0 = 8 * ks + 2 * fq;
            const f32x4 x0 = *(const LAS f32x4*)(UC + tok * 64 + ((c0 ^ (tok & 15)) << 2)), x1 = *(const LAS f32x4*)(UC + tok * 64 + (((c0 + 1) ^ (tok & 15)) << 2));
            u32x4 pw; pw.x = cvtpk(x0[0], x0[1]); pw.y = cvtpk(x0[2], x0[3]); pw.z = cvtpk(x1[0], x1[1]); pw.w = cvtpk(x1[2], x1[3]); Af[ks] = __builtin_bit_cast(bf16x8, pw); }
        f32x4 cr[4], ci[4];
#pragma unroll
        for (int nt = 0; nt < 4; ++nt) { cr[nt] = (f32x4){0.f, 0.f, 0.f, 0.f}; ci[nt] = (f32x4){0.f, 0.f, 0.f, 0.f};
#pragma unroll
            for (int ks = 0; ks < 2; ++ks) { cr[nt] = __builtin_amdgcn_mfma_f32_16x16x32_bf16(Af[ks], Ba[nt][ks], cr[nt], 0, 0, 0); ci[nt] = __builtin_amdgcn_mfma_f32_16x16x32_bf16(Af[ks], Bx[nt][ks], ci[nt], 0, 0, 0); } }
#pragma unroll
        for (int nt = 0; nt < 4; ++nt) {
            float P[4], Hh[4];
#pragma unroll
            for (int rg = 0; rg < 4; ++rg) { const int tok = 16 * mt + 4 * fq + rg, e = 16 * nt + fr;
                const float ucv = UC[UC_IDX(tok, e)];
                const float r = fsigmoid(cr[nt][rg] + ba[nt]), ig = fsigmoid(ci[nt][rg] + bx[nt]);
                const float la = -r * sp8[nt]; const float a = __expf(la);
                const float b = sqrtf(-expm1f(2.0f * la)) * (ig * ucv);
                if (rg == 0) { P[0] = a; Hh[0] = b; } else { P[rg] = P[rg - 1] * a; Hh[rg] = a * Hh[rg - 1] + b; } }
            float At = P[3], Bt = Hh[3];
            { const float Ap = __shfl_up(At, 16), Bp = __shfl_up(Bt, 16); if (fq >= 1) { Bt = At * Bp + Bt; At = Ap * At; } }
            { const float Ap = __shfl_up(At, 32), Bp = __shfl_up(Bt, 32); if (fq >= 2) { Bt = At * Bp + Bt; At = Ap * At; } }
            float Aex = __shfl_up(At, 16), Bex = __shfl_up(Bt, 16); if (fq == 0) { Aex = 1.f; Bex = 0.f; }
            const float hg = Aex * hin[nt] + Bex;
            float hv[4];
#pragma unroll
            for (int rg = 0; rg < 4; ++rg) hv[rg] = P[rg] * hg + Hh[rg];
            hin[nt] = __shfl(hv[3], 48 + fr);
            if (!FINAL) acum[nt] *= __shfl(At, 48 + fr);
            if (FINAL) {
#pragma unroll
                for (int rg = 0; rg < 4; ++rg) { const size_t t = (size_t)(t0 + 16 * mt + 4 * fq + rg); const int ch = ch0 + 16 * nt + fr;
                    F.XN()[t * 1024 + 512 + ch] = (bf16)f2bf(hv[rg] * bf2f(F.GL()[t * 512 + ch])); }
            }
        }
    }
    if (!FINAL && fq == 0) {
#pragma unroll
        for (int nt = 0; nt < 4; ++nt) { F.SUMA()[(size_t)tt * 512 + ch0 + 16 * nt + fr] = acum[nt]; F.SUMB()[(size_t)tt * 512 + ch0 + 16 * nt + fr] = hin[nt]; }
    }
    LDS_WAIT();
#undef UC_IDX
}

__device__ __forceinline__ void qk_norm_tile(const Frame& F, const Args& A, int tt) {
    const int lane = F.lane, sub = lane & 7;
#pragma unroll 2
    for (int it = 0; it < 12; ++it) {
        const int idx = it * 64 + F.wave * 8 + (lane >> 3), tok = idx / 12, hr = idx % 12; const size_t t = (size_t)(64 * tt + tok);
        bf16* p; const float* gain; float sc = 1.f;
        if (hr < 8) { p = F.Q() + t * 512 + hr * 64; gain = A.in[3]; sc = 0.125f * LOG2E; }
        else if (hr < 10) { p = F.KV() + t * 768 + 256 + (hr - 8) * 64; gain = A.in[4] + 64; }
        else { p = F.KV() + t * 768 + 512 + (hr - 10) * 64; gain = A.in[4] + 128; }
        const u32x4 w = *(const u32x4*)(p + sub * 8);
        float x[8] = {bflo(w.x), bfhi(w.x), bflo(w.y), bfhi(w.y), bflo(w.z), bfhi(w.z), bflo(w.w), bfhi(w.w)};
        float ss = 0.f;
#pragma unroll
        for (int j = 0; j < 8; ++j) ss += x[j] * x[j];
        ss += __shfl_xor(ss, 1); ss += __shfl_xor(ss, 2); ss += __shfl_xor(ss, 4);
        const float rs = sc / sqrtf(ss * (1.f / 64.f) + RMS_EPS);
        const f32x4 g0 = *(const f32x4*)(gain + sub * 8), g1 = *(const f32x4*)(gain + sub * 8 + 4);
        u32x4 o; o.x = pk2(x[0] * rs * g0.x, x[1] * rs * g0.y); o.y = pk2(x[2] * rs * g0.z, x[3] * rs * g0.w); o.z = pk2(x[4] * rs * g1.x, x[5] * rs * g1.y); o.w = pk2(x[6] * rs * g1.z, x[7] * rs * g1.w);
        *(u32x4*)(p + sub * 8) = o;
    }
}

__device__ __forceinline__ void compress_item(const Frame& F, const Args& A, int kv, int g, int ct) {
    const int tid = F.tid, lane = F.lane, w = F.wave, fr = lane & 15, fq = lane >> 4, c0 = 16 * ct, tb = 16 * c0;
    LAS unsigned char* T = F.lds;
    LAS bf16* HID = (LAS bf16*)(F.lds + 34816);
    LAS float* OUTF = (LAS float*)(F.lds + 34816 + 8448);
    for (int idx = tid; idx < 272 * 8; idx += 512) { const int tok = idx >> 3, chn = idx & 7, gt = tb + tok;
        u32x4 v = (u32x4){0u, 0u, 0u, 0u};
        if (gt < SEQ) v = *(const u32x4*)(F.KV() + (size_t)gt * 768 + kv * 128 + g * 64 + chn * 8);
        *(LAS u32x4*)(T + tok * 128 + ((chn ^ ((tok >> 4) & 7)) << 4)) = v; }
    LDS_WAIT(); __syncthreads();
    f32x4 acc[2] = {(f32x4){0.f, 0.f, 0.f, 0.f}, (f32x4){0.f, 0.f, 0.f, 0.f}};
    const bf16* w1t = F.W1T() + (size_t)kv * 256 * 2048 + (size_t)(32 * w + fr) * 2048 + 8 * fq;
#pragma unroll 8
    for (int ks = 0; ks < 64; ++ks) {
        const int tok = 16 * fr + (ks >> 1), chn = 4 * (ks & 1) + fq;
        const bf16x8 a = *(const LAS bf16x8*)(T + tok * 128 + ((chn ^ ((tok >> 4) & 7)) << 4));
        const bf16x8 b0 = *(const bf16x8*)(w1t + 32 * ks), b1 = *(const bf16x8*)(w1t + (size_t)16 * 2048 + 32 * ks);
        acc[0] = __builtin_amdgcn_mfma_f32_16x16x32_bf16(a, b0, acc[0], 0, 0, 0);
        acc[1] = __builtin_amdgcn_mfma_f32_16x16x32_bf16(a, b1, acc[1], 0, 0, 0);
    }
#pragma unroll
    for (int nt = 0; nt < 2; ++nt) { const int n = 32 * w + 16 * nt + fr; const float c1 = F.C1()[kv * 256 + n];
#pragma unroll
        for (int rg = 0; rg < 4; ++rg) { const float v = acc[nt][rg] + c1; HID[(4 * fq + rg) * 264 + n] = (bf16)f2bf(v * fsigmoid(v)); } }
    LDS_WAIT(); __syncthreads();
    if (w < 4) {
        f32x4 o = (f32x4){0.f, 0.f, 0.f, 0.f};
        const bf16* w2t = F.W2T() + (size_t)kv * 64 * 256 + (size_t)(16 * w + fr) * 256 + 8 * fq;
#pragma unroll
        for (int ks = 0; ks < 8; ++ks) { const bf16x8 a = *(const LAS bf16x8*)(HID + fr * 264 + 32 * ks + 8 * fq); const bf16x8 b = *(const bf16x8*)(w2t + 32 * ks);
            o = __builtin_amdgcn_mfma_f32_16x16x32_bf16(a, b, o, 0, 0, 0); }
#pragma unroll
        for (int rg = 0; rg < 4; ++rg) OUTF[(4 * fq + rg) * 64 + 16 * w + fr] = o[rg];
    }
    LDS_WAIT(); __syncthreads();
    {
        const int row = tid >> 5, e = 2 * (tid & 31), c = c0 + row;
        float v0 = OUTF[row * 64 + e], v1 = OUTF[row * 64 + e + 1];
        if (kv == 0) { float ss = v0 * v0 + v1 * v1;
#pragma unroll
            for (int o = 1; o < 32; o <<= 1) ss += __shfl_xor(ss, o);
            const float rs = 1.0f / sqrtf(ss * (1.f / 64.f) + RMS_EPS); v0 *= rs * A.in[4][e]; v1 *= rs * A.in[4][e + 1]; }
        if (c >= 1023) { v0 = 0.f; v1 = 0.f; }
        bf16* dst = (kv == 0 ? F.KC() : F.VC()) + ((size_t)g * 1024 + c) * 64 + e;
        *(unsigned*)dst = pk2(v0, v1);
    }
    LDS_WAIT(); __syncthreads();
}

namespace att {
constexpr int SLOTB = 8192, NSLOT = 3;
constexpr int L_K = 0, L_V = NSLOT * SLOTB, L_SC = 2 * NSLOT * SLOTB  , L_LUT = L_SC + 65536  ,
              L_WSF = L_LUT + 2048  , L_END = L_WSF + 2048;
static_assert(L_END <= RING_BYTES, "attention LDS map");
constexpr float THR = 8.0f;
#define SBAR() __builtin_amdgcn_sched_barrier(0)
__device__ __forceinline__ int crow(int r, int hi) { return (r & 3) + 8 * (r >> 2) + 4 * hi; }
__device__ __forceinline__ void glds16(const void* gsrc, unsigned lds_dst) { unsigned keep;
    asm volatile("s_mov_b32 %0, m0\n\ts_mov_b32 m0, %2\n\ts_nop 0\n\tglobal_load_lds_dwordx4 %1, off\n\ts_mov_b32 m0, %0" : "=&s"(keep) : "v"(gsrc), "s"(lds_dst) : "memory"); }
__device__ __forceinline__ void qkt(f32x16& p0, f32x16& p1, const LAS unsigned char* Kslot, const bf16x8* qr, float cinit, int r32, int hi) {
    const LAS unsigned char* kb = Kslot + hi * 1024 + r32 * 16;
#pragma unroll
    for (int r = 0; r < 16; ++r) { p0[r] = cinit; p1[r] = cinit; }
#pragma unroll
    for (int d0 = 0; d0 < 4; ++d0) {
        const bf16x8 b0 = *(const LAS bf16x8*)(kb + d0 * 2048);
        const bf16x8 b1 = *(const LAS bf16x8*)(kb + d0 * 2048 + 512);
        p0 = __builtin_amdgcn_mfma_f32_32x32x16_bf16(b0, qr[d0], p0, 0, 0, 0); p1 = __builtin_amdgcn_mfma_f32_32x32x16_bf16(b1, qr[d0], p1, 0, 0, 0); }
}
__device__ __forceinline__ void pv(f32x16* o, int vb, bf16x8 pa0, bf16x8 pa1, bf16x8 pa2, bf16x8 pa3) {
#pragma unroll
    for (int d0 = 0; d0 < 2; ++d0) { s16x4 lo[4], hi[4];
#pragma unroll
        for (int ks = 0; ks < 4; ++ks) {
            asm volatile("ds_read_b64_tr_b16 %0,%1 offset:%c2" : "=&v"(lo[ks]) : "v"(vb), "i"(d0 * 4096 + ks * 1024) : "memory");
            asm volatile("ds_read_b64_tr_b16 %0,%1 offset:%c2" : "=&v"(hi[ks]) : "v"(vb), "i"(d0 * 4096 + ks * 1024 + 512) : "memory"); }
        asm volatile("s_waitcnt lgkmcnt(0)" ::: "memory"); SBAR();
#define PK(k) (bf16x8){lo[k][0], lo[k][1], lo[k][2], lo[k][3], hi[k][0], hi[k][1], hi[k][2], hi[k][3]}
        o[d0] = __builtin_amdgcn_mfma_f32_32x32x16_bf16(pa0, PK(0), o[d0], 0, 0, 0);
        o[d0] = __builtin_amdgcn_mfma_f32_32x32x16_bf16(pa1, PK(1), o[d0], 0, 0, 0);
        o[d0] = __builtin_amdgcn_mfma_f32_32x32x16_bf16(pa2, PK(2), o[d0], 0, 0, 0);
        o[d0] = __builtin_amdgcn_mfma_f32_32x32x16_bf16(pa3, PK(3), o[d0], 0, 0, 0);
#undef PK
    }
}
__device__ __forceinline__ float rowmax(const f32x16& p0, const f32x16& p1) {
    float a = fmaxf(fmaxf(p0[0], p0[1]), p1[0]), b = fmaxf(fmaxf(p0[2], p0[3]), p1[1]); a = fmaxf(fmaxf(a, p1[2]), p1[3]);
#pragma unroll
    for (int r = 4; r < 16; r += 4) { a = fmaxf(fmaxf(a, p0[r]), p0[r + 1]); b = fmaxf(fmaxf(b, p0[r + 2]), p0[r + 3]); a = fmaxf(fmaxf(a, p1[r]), p1[r + 1]); b = fmaxf(fmaxf(b, p1[r + 2]), p1[r + 3]); }
    const float m = fmaxf(a, b);
    auto rr = __builtin_amdgcn_permlane32_swap(__float_as_uint(m), __float_as_uint(m), false, false);
    return fmaxf(__uint_as_float(rr[0]), __uint_as_float(rr[1]));
}
__device__ __forceinline__ float halfsum(float v) { auto rr = __builtin_amdgcn_permlane32_swap(__float_as_uint(v), __float_as_uint(v), false, false); return __uint_as_float(rr[0]) + __uint_as_float(rr[1]); }
template <int STEP, unsigned LIMIT>
__device__ __forceinline__ void near_apply(f32x16& p0, f32x16& p1, int dbase, const LAS float* lut) {
#pragma unroll
    for (int r = 0; r < 16; ++r) { const int koff = (r & 3) + 8 * (r >> 2); const int d0 = dbase - STEP * koff, d1 = d0 - STEP * 32;
        const int i0 = min(max(d0, 0), 127), i1 = min(max(d1, 0), 127);
        const float b0 = lut[i0], b1 = lut[i1];
        p0[r] = ((unsigned)d0 < LIMIT) ? p0[r] + b0 : -INFINITY; p1[r] = ((unsigned)d1 < LIMIT) ? p1[r] + b1 : -INFINITY; }
}
template <bool HASO>
__device__ __forceinline__ void sm_update(f32x16& p0, f32x16& p1, float& m, float& l, f32x16* o, LAS float* wsf, int r32, int hi) {
    const float rm = rowmax(p0, p1);
    const bool need = rm > m + THR;
    if (__any(need)) {
        const float mn = need ? rm : m; const float alpha = __builtin_amdgcn_exp2f(m - mn);
        l *= alpha; m = mn;
        if (HASO) { if (hi == 0) wsf[r32] = alpha; LDS_WAIT();
#pragma unroll
            for (int r = 0; r < 16; ++r) { const float f = wsf[crow(r, hi)]; o[0][r] *= f; o[1][r] *= f; } }
    }
    float s = 0.f;
#pragma unroll
    for (int r = 0; r < 16; ++r) { p0[r] = __builtin_amdgcn_exp2f(p0[r] - m); p1[r] = __builtin_amdgcn_exp2f(p1[r] - m); s += p0[r] + p1[r]; }
    l += s;
}
#define ATT_PACK(P0, P1) \
    const bf16x8 pa0 = __builtin_bit_cast(bf16x8, (u32x4){cvtpk(P0[0], P0[1]), cvtpk(P0[2], P0[3]), cvtpk(P0[4], P0[5]), cvtpk(P0[6], P0[7])}); \
    const bf16x8 pa1 = __builtin_bit_cast(bf16x8, (u32x4){cvtpk(P0[8], P0[9]), cvtpk(P0[10], P0[11]), cvtpk(P0[12], P0[13]), cvtpk(P0[14], P0[15])}); \
    const bf16x8 pa2 = __builtin_bit_cast(bf16x8, (u32x4){cvtpk(P1[0], P1[1]), cvtpk(P1[2], P1[3]), cvtpk(P1[4], P1[5]), cvtpk(P1[6], P1[7])}); \
    const bf16x8 pa3 = __builtin_bit_cast(bf16x8, (u32x4){cvtpk(P1[8], P1[9]), cvtpk(P1[10], P1[11]), cvtpk(P1[12], P1[13]), cvtpk(P1[14], P1[15])});
#define ATT_WAITBAR(N) asm volatile("s_waitcnt vmcnt(" #N ") lgkmcnt(0)\n\ts_barrier" ::: "memory")
#define ATT_FILL(V, x) do { _Pragma("unroll") for (int _r = 0; _r < 16; ++_r) V[_r] = (x); } while (0)

__device__ __forceinline__ unsigned rangemask(int k, int a, int b) {
    const int lo = max(a - 32 * k, 0), hi = min(b - 32 * k, 31);
    return (lo > hi) ? 0u : ((0xFFFFFFFFu >> (31 - hi)) & (0xFFFFFFFFu << lo));
}
__device__ __forceinline__ int wave_max_i32(int x) {
    x = max(x, dpp_i<0xB1>(x)); x = max(x, dpp_i<0x4E>(x)); x = max(x, dpp_i<0x141>(x)); x = max(x, dpp_i<0x140>(x));
    return max(max(__builtin_amdgcn_readlane(x, 0), __builtin_amdgcn_readlane(x, 16)), max(__builtin_amdgcn_readlane(x, 32), __builtin_amdgcn_readlane(x, 48)));
}

__device__ __forceinline__ void attn_item(const Frame& F, int qt, int g) {
    const int tid = F.tid, lane = F.lane, wid = F.wave, r32 = lane & 31, hi = lane >> 5;
    const int ql = r32 >> 2, h = r32 & 3, cur = qt, t = 64 * qt + 8 * wid + ql, head = 4 * g + h;
    LAS unsigned char* shm = F.lds;
    const unsigned lds0 = (unsigned)(uintptr_t)shm;
    LAS float* wsf = (LAS float*)(shm + L_WSF) + wid * 64;
    LAS float* SC = (LAS float*)(shm + L_SC);
    LAS float* lutl = (LAS float*)(shm + L_LUT);
    const LAS float* luth = lutl + h * 128;
    lutl[tid] = F.LUT()[(4 * g + (tid >> 7)) * 128 + (tid & 127)];
    bf16x8 qr[4];
    { const bf16* qp = F.Q() + (size_t)t * 512 + head * 64 + hi * 8;
#pragma unroll
        for (int d0 = 0; d0 < 4; ++d0) qr[d0] = *(const bf16x8*)(qp + d0 * 16); }
    const float b31 = F.LUT()[head * 128 + 127];
    const float gate_c = fsigmoid(bf2f(F.BR()[(size_t)t * 256 + head])), gate_s = fsigmoid(bf2f(F.BR()[(size_t)t * 256 + 8 + head])), gate_w = fsigmoid(bf2f(F.BR()[(size_t)t * 256 + 16 + head]));
    f32x16 o[2], p0, p1;
    LAS float* ostg = (LAS float*)(shm + L_SC) + wid * 2048;
    const unsigned kdst = lds0 + L_K + wid * 1024, vdst = lds0 + L_V + wid * 1024;
    const int vrow = 16 * (wid & 3) + (lane >> 2), vcol = (wid >> 2) * 32 + (lane & 3) * 8;
    const int vb0 = (int)(lds0 + L_V) + ((lane >> 4) & 1) * 32 + (lane & 3) * 8 + (4 * hi + ((lane & 15) >> 2)) * 64;
#define DMA_K(base, pitch, row0, slot) glds16((base) + (size_t)((row0) + lane) * (pitch) + wid * 8, (unsigned)__builtin_amdgcn_readfirstlane(kdst + (slot)))
#define DMA_V(base, pitch, row0, slot) glds16((base) + (size_t)((row0) + vrow) * (pitch) + vcol, (unsigned)__builtin_amdgcn_readfirstlane(vdst + (slot)))
#define ROT() do { sl_cur = sl_next; sl_next = (sl_next == (NSLOT - 1) * SLOTB) ? 0 : sl_next + SLOTB; } while (0)
    VM_WAIT(); LDS_WAIT(); __syncthreads();

    const bf16* KCg = F.KC() + (size_t)g * 1024 * 64; const bf16* VCg = F.VC() + (size_t)g * 1024 * 64;
    const int nkt = (qt >> 4) + 1;
    const int tminw = 64 * qt + 8 * wid;
    float m = -1e30f, l = 0.f;
    {
        int sl_cur = 0, sl_next = SLOTB;
        DMA_K(KCg, 64, 0, 0);
        for (int kt = 0; kt < nkt; ++kt) {
            if (kt + 1 < nkt) { DMA_K(KCg, 64, 64 * (kt + 1), sl_next); ATT_WAITBAR(1); } else { ATT_WAITBAR(0); }
            const bool far = (tminw - 31 - 16 * (64 * kt + 63)) >= 128;
            if (far) { qkt(p0, p1, shm + L_K + sl_cur, qr, b31, r32, hi); }
            else { qkt(p0, p1, shm + L_K + sl_cur, qr, 0.f, r32, hi); near_apply<16, 0x80000000u>(p0, p1, t - 31 - 16 * (64 * kt + 4 * hi), luth); }
            sm_update<false>(p0, p1, m, l, o, wsf, r32, hi);
            ROT();
        }
        LDS_WAIT(); __builtin_amdgcn_s_barrier();
    }
    {
        const float lt = halfsum(l); const float rl = lt > 0.f ? 1.0f / lt : 0.f;
        ATT_FILL(o[0], 0.f); ATT_FILL(o[1], 0.f);
        float carry = 0.f;
        int sl_cur = 0, sl_next = SLOTB;
        DMA_K(KCg, 64, 0, 0); DMA_V(VCg, 64, 0, 0);
        for (int kt = 0; kt < nkt; ++kt) {
            if (kt + 1 < nkt) { DMA_K(KCg, 64, 64 * (kt + 1), sl_next); DMA_V(VCg, 64, 64 * (kt + 1), sl_next); ATT_WAITBAR(2); } else { ATT_WAITBAR(0); }
            const bool far = (tminw - 31 - 16 * (64 * kt + 63)) >= 128;
            if (far) { qkt(p0, p1, shm + L_K + sl_cur, qr, b31, r32, hi); }
            else { qkt(p0, p1, shm + L_K + sl_cur, qr, 0.f, r32, hi); near_apply<16, 0x80000000u>(p0, p1, t - 31 - 16 * (64 * kt + 4 * hi), luth); }
#pragma unroll
            for (int r = 0; r < 16; ++r) { p0[r] = __builtin_amdgcn_exp2f(p0[r] - m) * rl; p1[r] = __builtin_amdgcn_exp2f(p1[r] - m) * rl; }
            {
                float q4[8], e[8];
#pragma unroll
                for (int i = 0; i < 4; ++i) { q4[i] = (p0[4 * i] + p0[4 * i + 1]) + (p0[4 * i + 2] + p0[4 * i + 3]); e[i] = p0[4 * i + 3];
                                              q4[4 + i] = (p1[4 * i] + p1[4 * i + 1]) + (p1[4 * i + 2] + p1[4 * i + 3]); e[4 + i] = p1[4 * i + 3]; }
                float newcarry = 0.f;
#pragma unroll
                for (int i = 0; i < 8; ++i) { auto rr = __builtin_amdgcn_permlane32_swap(__float_as_uint(e[i]), __float_as_uint(e[i]), false, false);
                    const float elo = __uint_as_float(rr[0]), ehi = __uint_as_float(rr[1]);
                    if (hi) q4[i] += elo; else if (i < 7) q4[i + 1] += ehi;
                    if (i == 7) newcarry = ehi; }
                if (!hi) q4[0] += carry;
                carry = newcarry;
#pragma unroll
                for (int i = 0; i < 8; ++i) { float v = q4[i]; v += dpp_f<0xB1>(v); v += dpp_f<0x4E>(v); q4[i] = v; }
                if (h == 0) {
#pragma unroll
                    for (int i = 0; i < 8; ++i) SC[(8 * wid + ql) * 256 + 16 * kt + 2 * i + hi] = q4[i]; }
            }
            { ATT_PACK(p0, p1); pv(o, vb0 + sl_cur, pa0, pa1, pa2, pa3); }
            ROT();
        }
        LDS_WAIT(); __builtin_amdgcn_s_barrier();
    }

    unsigned selm[8], un[8];
#pragma unroll
    for (int k = 0; k < 8; ++k) { selm[k] = 0u; un[k] = 0u; }
    {
        const int nelig = max(cur - 2, 0);
#pragma unroll 1
        for (int qq = 0; qq < 8; ++qq) {
            const LAS float* row = SC + (8 * wid + qq) * 256;
            int v0, v1, v2, v3;
            { const int x0 = __float_as_int(row[lane]), x1 = __float_as_int(row[lane + 64]), x2 = __float_as_int(row[lane + 128]), x3 = __float_as_int(row[lane + 192]);
              v0 = (lane >= 1 && lane <= cur - 2) ? x0 : -1; v1 = (lane + 64 <= cur - 2) ? x1 : -1; v2 = (lane + 128 <= cur - 2) ? x2 : -1; v3 = (lane + 192 <= cur - 2) ? x3 : -1; }
            unsigned mword = 0u;
            if (nelig <= 13) { mword = rangemask(lane & 7, 1, cur - 2); }
            else {
#pragma unroll 1
                for (int round = 0; round < 13; ++round) {
                    const int wm = wave_max_i32(max(max(v0, v1), max(v2, v3)));
                    const unsigned long long b0 = __ballot(v0 == wm), b1 = __ballot(v1 == wm), b2 = __ballot(v2 == wm), b3 = __ballot(v3 == wm);
                    int J;
                    if (b0) J = __builtin_ctzll(b0); else if (b1) J = 64 + __builtin_ctzll(b1); else if (b2) J = 128 + __builtin_ctzll(b2); else J = 192 + __builtin_ctzll(b3);
                    const bool mine = (lane == (J & 63));
                    if (mine && (J >> 6) == 0) v0 = -1; if (mine && (J >> 6) == 1) v1 = -1; if (mine && (J >> 6) == 2) v2 = -1; if (mine && (J >> 6) == 3) v3 = -1;
                    if (lane == (J >> 5)) mword |= 1u << (J & 31);
                }
            }
            if (lane == 0) mword |= 1u;
            if (lane == (cur >> 5)) mword |= 1u << (cur & 31);
            if (cur >= 1 && lane == ((cur - 1) >> 5)) mword |= 1u << ((cur - 1) & 31);
#pragma unroll
            for (int k = 0; k < 8; ++k) { const unsigned mk = (unsigned)__builtin_amdgcn_readlane((int)mword, k); un[k] |= mk; if (ql == qq) selm[k] = mk; }
        }
    }

    {
        if (hi == 0) wsf[r32] = gate_c; LDS_WAIT();
#pragma unroll
        for (int r = 0; r < 16; ++r) { const float f = wsf[crow(r, hi)]; const int orow = crow(r, hi); ostg[orow * 64 + r32] = o[0][r] * f; ostg[orow * 64 + 32 + r32] = o[1][r] * f; }
    }

    const bf16* Ks = F.KV() + 256 + g * 64; const bf16* Vs = F.KV() + 384 + g * 64;
    {
        m = -1e30f; l = 0.f; ATT_FILL(o[0], 0.f); ATT_FILL(o[1], 0.f);
        int sl_cur = 0, sl_next = SLOTB;
        DMA_K(Ks, 768, 0, 0); DMA_V(Vs, 768, 0, 0);
        unsigned uw = 0u, sw = 0u;
        for (int J = 0; J <= cur; ++J) {
            if (J + 1 <= cur) { DMA_K(Ks, 768, 64 * (J + 1), sl_next); DMA_V(Vs, 768, 64 * (J + 1), sl_next); ATT_WAITBAR(2); } else { ATT_WAITBAR(0); }
            if ((J & 31) == 0) { const int k = J >> 5;
                uw = k == 0 ? un[0] : k == 1 ? un[1] : k == 2 ? un[2] : k == 3 ? un[3] : k == 4 ? un[4] : k == 5 ? un[5] : k == 6 ? un[6] : un[7];
                sw = k == 0 ? selm[0] : k == 1 ? selm[1] : k == 2 ? selm[2] : k == 3 ? selm[3] : k == 4 ? selm[4] : k == 5 ? selm[5] : k == 6 ? selm[6] : selm[7]; }
            if ((uw >> (J & 31)) & 1u) {
                const bool sel = (sw >> (J & 31)) & 1u;
                if (J >= cur - 2) { qkt(p0, p1, shm + L_K + sl_cur, qr, 0.f, r32, hi); near_apply<1, 0x80000000u>(p0, p1, t - 64 * J - 4 * hi, luth);
                    if (!sel) { ATT_FILL(p0, -INFINITY); ATT_FILL(p1, -INFINITY); } }
                else { qkt(p0, p1, shm + L_K + sl_cur, qr, sel ? b31 : -INFINITY, r32, hi); }
                sm_update<true>(p0, p1, m, l, o, wsf, r32, hi);
                { ATT_PACK(p0, p1); pv(o, vb0 + sl_cur, pa0, pa1, pa2, pa3); }
            }
            ROT();
        }
        LDS_WAIT(); __builtin_amdgcn_s_barrier();
        const float lt = halfsum(l); const float fs = lt > 0.f ? gate_s / lt : 0.f;
        if (hi == 0) wsf[r32] = fs; LDS_WAIT();
#pragma unroll
        for (int r = 0; r < 16; ++r) { const float f = wsf[crow(r, hi)]; const int orow = crow(r, hi); ostg[orow * 64 + r32] += o[0][r] * f; ostg[orow * 64 + 32 + r32] += o[1][r] * f; }
    }

    const bf16* Kw = F.KV() + 512 + g * 64; const bf16* Vw = F.KV() + 640 + g * 64;
    {
        m = -1e30f; l = 0.f; ATT_FILL(o[0], 0.f); ATT_FILL(o[1], 0.f);
        const int J0 = max(cur - 8, 0);
        int sl_cur = 0, sl_next = SLOTB;
        DMA_K(Kw, 768, 64 * J0, 0); DMA_V(Vw, 768, 64 * J0, 0);
        for (int J = J0; J <= cur; ++J) {
            if (J + 1 <= cur) { DMA_K(Kw, 768, 64 * (J + 1), sl_next); DMA_V(Vw, 768, 64 * (J + 1), sl_next); ATT_WAITBAR(2); } else { ATT_WAITBAR(0); }
            if (J >= cur - 2 || J == cur - 8) { qkt(p0, p1, shm + L_K + sl_cur, qr, 0.f, r32, hi); near_apply<1, 512u>(p0, p1, t - 64 * J - 4 * hi, luth); }
            else { qkt(p0, p1, shm + L_K + sl_cur, qr, b31, r32, hi); }
            sm_update<true>(p0, p1, m, l, o, wsf, r32, hi);
            { ATT_PACK(p0, p1); pv(o, vb0 + sl_cur, pa0, pa1, pa2, pa3); }
            ROT();
        }
        LDS_WAIT(); __builtin_amdgcn_s_barrier();
        const float lt = halfsum(l); const float fw = lt > 0.f ? gate_w / lt : 0.f;
        if (hi == 0) wsf[r32] = fw; LDS_WAIT();
#pragma unroll
        for (int r = 0; r < 16; ++r) { const float f = wsf[crow(r, hi)]; const int orow = crow(r, hi); ostg[orow * 64 + r32] += o[0][r] * f; ostg[orow * 64 + 32 + r32] += o[1][r] * f; }
    }

    {
        LDS_WAIT();
#pragma unroll
        for (int i = 0; i < 4; ++i) { const int row = i * 8 + (lane >> 3), chn = lane & 7;
            const f32x4 v0 = *(const LAS f32x4*)(ostg + row * 64 + chn * 8), v1 = *(const LAS f32x4*)(ostg + row * 64 + chn * 8 + 4);
            const size_t tt = (size_t)(64 * qt + 8 * wid + (row >> 2)); const int col = (4 * g + (row & 3)) * 64 + chn * 8;
            const u32x4 gn = *(const u32x4*)(F.GN() + tt * 512 + col);
            u32x4 w; w.x = pk2(v0[0] * bflo(gn.x), v0[1] * bfhi(gn.x)); w.y = pk2(v0[2] * bflo(gn.y), v0[3] * bfhi(gn.y));
            w.z = pk2(v1[0] * bflo(gn.z), v1[1] * bfhi(gn.z)); w.w = pk2(v1[2] * bflo(gn.w), v1[3] * bfhi(gn.w));
            *(u32x4*)(F.XN() + tt * 1024 + col) = w; }
        VM_WAIT(); LDS_WAIT(); __syncthreads();
    }
#undef DMA_K
#undef DMA_V
#undef ROT
}
}

__global__ void __launch_bounds__(NWAVES * 64, 2) nsa_lru_fwd(Args args) {
    extern __shared__ __attribute__((aligned(16))) unsigned char lds[];
    Frame F;
    F.lds = (LAS unsigned char*)lds;
    F.MISC = (volatile LAS unsigned*)(F.lds + MISC_OFF);
    F.tid = threadIdx.x; F.lane = F.tid & 63; F.wave = __builtin_amdgcn_readfirstlane(F.tid >> 6);
    F.G = gridDim.x; { const int bx = blockIdx.x; F.vcu = (F.G % 8 == 0) ? (bx % 8) * (F.G / 8) + bx / 8 : bx; }
    F.ws = args.ws;
    gu32* ctl = (gu32*)(args.ws + WS_CTL);
    for (int u = F.tid; u < (LDS_BYTES - LDSCTL_OFF) / 4; u += NWAVES * 64) ((LAS unsigned*)(F.lds + LDSCTL_OFF))[u] = 0u;
    __syncthreads();
    const int bli = (N_LAUNCHES == PER_PHASE) ? 0 : args.li;
    XcdBarrier bar; bar.bar = (unsigned*)(ctl + CW_BAR) + bli * XCD_BAR_WORDS; bar.x = 0; bar.st = nullptr;
    if (N_LAUNCHES != PER_PHASE) bar = xcd_barrier_post((unsigned*)(ctl + CW_BAR) + bli * XCD_BAR_WORDS, F.MISC + 8);
#define GRID_BAR() do { if (N_LAUNCHES != PER_PHASE) xcd_barrier(bar); } while (0)
    const int lo = args.ph_lo, hi = args.ph_hi;
#define IN(k) (lo <= (k) && (k) < hi)
#define BOTH(k) (IN(k) && IN((k) + 1))

    if (IN(0)) { p0_prologue(F, args); if (BOTH(0)) GRID_BAR(); }

    if (IN(1)) {
        pg8::Gemm g{F.XN(), F.WinT(), F.XN(), F.WinT(), 1024, 1024, 1024}; pg8::StaticOrder S; S.init(SEQ, NPROJ, F.G, (int)blockIdx.x);
        pg8::EpiProj E{F.Q(), F.KV(), F.U(), F.BR(), F.GN(), F.GL(), F.MG()};
        pg8::gemm_phase<pg8::EpiProj, pg8::StaticOrder, true>(F.lds, g, S, E);
        if (BOTH(1)) GRID_BAR();
    }

    if (IN(2)) {
        for (int i = F.vcu; i < 256; i += F.G) {
            lru_tile<false>(F, args, i);
            qk_norm_tile(F, args, i);
            __syncthreads();
            compress_item(F, args, i & 1, (i >> 1) & 1, i >> 2);
        }
        if (BOTH(2)) GRID_BAR();
    }

    if (IN(3)) {
        for (int i = F.vcu; i < 256; i += F.G) { lru_tile<true>(F, args, i); }
        __syncthreads();
#pragma unroll 1
        for (int it = 2 * F.vcu; it < 512; it += 2 * F.G) {
#pragma unroll 1
            for (int j = 0; j < 2; ++j) { const int i = it >> 1; att::attn_item(F, j ? i : 255 - i, j ? 0 : 1); }
        }
        if (BOTH(3)) GRID_BAR();
    }

    if (IN(4)) {
        pg8::Gemm g{F.XN(), F.WaT(), F.XN() + 512, F.WbT(), 1024, 512, 512}; pg8::DualOrder S; S.init(SEQ, 1024, F.G, (int)blockIdx.x);
        pg8::EpiMerge E{F.MB(), F.MG()};
        pg8::gemm_phase<pg8::EpiMerge, pg8::DualOrder, true>(F.lds, g, S, E);
        if (BOTH(4)) GRID_BAR();
    }

    if (IN(5)) {
        pg8::Gemm g{F.MB(), F.WoutT(), F.MB(), F.WoutT(), 1024, 1024, 1024}; pg8::StaticOrder S; S.init(SEQ, 1024, F.G, (int)blockIdx.x);
        pg8::EpiOut E{args.in[0], args.out};
        pg8::gemm_phase<pg8::EpiOut, pg8::StaticOrder, true>(F.lds, g, S, E);
    }
#undef IN
#undef BOTH
}

extern "C" void kernel_launch(void* const* d_in, const int* in_sizes, int n_in, void* d_out, int out_size, void* d_ws, size_t ws_size, hipStream_t stream) {
    static int grid = 0;
    if (grid == 0) {
        if (n_in != 20 || in_sizes[0] != SEQ * DM || out_size != SEQ * DM || ws_size < WS_END) { fprintf(stderr, "kernel_launch: unexpected shapes (n_in %d, in0 %d, out %d, ws %zu)\n", n_in, n_in > 0 ? in_sizes[0] : -1, out_size, ws_size); grid = -1; return; }
        int dev = 0, cus = 0, per_cu = 0;
        if (hipGetDevice(&dev) != hipSuccess || hipDeviceGetAttribute(&cus, hipDeviceAttributeMultiprocessorCount, dev) != hipSuccess) { grid = -1; return; }
        if (hipFuncSetAttribute((const void*)nsa_lru_fwd, hipFuncAttributeMaxDynamicSharedMemorySize, LDS_BYTES) != hipSuccess) { fprintf(stderr, "kernel_launch: hipFuncSetAttribute failed\n"); grid = -1; return; }
        if (hipOccupancyMaxActiveBlocksPerMultiprocessor(&per_cu, (const void*)nsa_lru_fwd, NWAVES * 64, LDS_BYTES) != hipSuccess || per_cu < 1)
            fprintf(stderr, "kernel_launch: occupancy query reports %d workgroups per CU\n", per_cu);
        (void)hipGetLastError();
        grid = cus;
    }
    if (grid < 0) return;
    if (hipMemsetAsync((char*)d_ws + WS_CTL, 0, CTL_ZERO_BYTES, stream) != hipSuccess) { fprintf(stderr, "kernel_launch: hipMemsetAsync failed\n"); return; }
    Args a{};
    for (int i = 0; i < 20; ++i) a.in[i] = (const float*)d_in[i];
    a.out = (float*)d_out; a.ws = (unsigned char*)d_ws;
    for (int li = 0; li < N_LAUNCHES; ++li) {
        a.ph_lo = (N_LAUNCHES == PER_PHASE) ? li : 0; a.ph_hi = (N_LAUNCHES == PER_PHASE) ? li + 1 : PER_PHASE; a.li = li;
        hipLaunchKernelGGL(nsa_lru_fwd, dim3(grid), dim3(NWAVES * 64), LDS_BYTES, stream, a);
        const hipError_t le = hipPeekAtLastError();
        if (le != hipSuccess) { fprintf(stderr, "kernel_launch: launch %d failed: %s\n", li, hipGetErrorName(le)); break; }
    }
}
```

```cpp
#include <hip/hip_runtime.h>
#include <cstdio>
#include <cstdint>

#ifndef PROBE_DUP
#define PROBE_DUP -1
#endif
#ifndef MK_N_LAUNCHES
#define MK_N_LAUNCHES 1
#endif

#define GAS __attribute__((address_space(1)))
#define LAS __attribute__((address_space(3)))
typedef unsigned short bf16;
typedef short bf16x8 __attribute__((ext_vector_type(8)));
typedef short s16x4 __attribute__((ext_vector_type(4)));
typedef float f32x4 __attribute__((ext_vector_type(4)));
typedef float f32x16 __attribute__((ext_vector_type(16)));
typedef unsigned u32x4 __attribute__((ext_vector_type(4)));
typedef unsigned u32x2 __attribute__((ext_vector_type(2)));
typedef GAS unsigned gu32;

constexpr int SEQ = 16384, DM = 1024;
constexpr int NPROJ = 5120;
constexpr float LOG2E = 1.4426950408889634f;
constexpr float RMS_EPS = 1e-6f;

__device__ __forceinline__ unsigned f2bf(float f) { unsigned u = __builtin_bit_cast(unsigned, f); return (u + 0x7fffu + ((u >> 16) & 1u)) >> 16; }
__device__ __forceinline__ unsigned pk2(float lo, float hi) { return f2bf(lo) | (f2bf(hi) << 16); }
__device__ __forceinline__ float bf2f(unsigned h) { return __builtin_bit_cast(float, h << 16); }
__device__ __forceinline__ float bflo(unsigned w) { return __builtin_bit_cast(float, w << 16); }
__device__ __forceinline__ float bfhi(unsigned w) { return __builtin_bit_cast(float, w & 0xffff0000u); }
typedef float f32x2_t __attribute__((ext_vector_type(2))); typedef __bf16 bf16x2_t __attribute__((ext_vector_type(2)));
__device__ __forceinline__ unsigned cvtpk(float lo, float hi) { f32x2_t v = {lo, hi}; bf16x2_t b = __builtin_convertvector(v, bf16x2_t); return __builtin_bit_cast(unsigned, b); }
__device__ __forceinline__ float fsigmoid(float v) { return __builtin_amdgcn_rcpf(1.0f + __builtin_amdgcn_exp2f(-v * LOG2E)); }
template <int CTRL> __device__ __forceinline__ float dpp_f(float v) { return __builtin_bit_cast(float, __builtin_amdgcn_update_dpp(0, __builtin_bit_cast(int, v), CTRL, 0xf, 0xf, true)); }
template <int CTRL> __device__ __forceinline__ int dpp_i(int v) { return __builtin_amdgcn_update_dpp(v, v, CTRL, 0xf, 0xf, false); }
__device__ __forceinline__ int lane_id() { int l = (int)__builtin_amdgcn_mbcnt_hi(~0u, __builtin_amdgcn_mbcnt_lo(~0u, 0u)); asm volatile("" : "+v"(l)); return l; }
__device__ __forceinline__ float wave_sum(float v) {
#pragma unroll
    for (int o = 1; o < 64; o <<= 1) v += __shfl_xor(v, o);
    return v;
}

namespace pg8 {
#define PG8_LAS __attribute__((address_space(3)))
typedef unsigned short bf16_t;
constexpr int BM = 256, BK = 64, HALF = 128, HTB = HALF * BK * 2, STAGE_BYTES = 8 * HTB, NXCD = 8, WGM = 8;
__host__ __device__ __forceinline__ int lds_byte(int r, int c) { const int st = (r >> 4) * 2 + (c >> 5), rr = r & 15, cc = c & 31, ob = rr * 64 + cc * 2; return st * 1024 + (ob ^ (((ob >> 9) & 1) << 5)); }
__host__ __device__ __forceinline__ void stage_rc(int b, int& R, int& C) { const int st = b / 1024, sb = b % 1024, swz = sb ^ (((sb >> 9) & 1) << 5); R = (st >> 1) * 16 + swz / 64; C = (st & 1) * 32 + (swz % 64) / 2; }
__host__ __device__ __forceinline__ int perm32(int rho) { const int n = rho >> 4, i = rho & 15; return 8 * (i >> 2) + 4 * n + (i & 3); }

struct Unit { int pm, pn, part; };
struct Gemm { const bf16_t* A; const bf16_t* Bt; const bf16_t* A2; const bf16_t* Bt2; int lda, ldb, K; };

struct StaticOrder {
    int nM, nN, nwg, G, c;
    __host__ __device__ void init(int M, int N, int G_, int c_) { nM = M / BM; nN = N / BM; nwg = nM * nN; G = G_; c = c_; }
    __host__ __device__ bool tile(long L, Unit& u) const {
        if (L >= nwg) return false;
        int wgid = (int)L; { const int q = nwg / NXCD, r = nwg % NXCD, xcd = wgid % NXCD, off = wgid / NXCD; wgid = (xcd < r ? xcd * (q + 1) : r * (q + 1) + (xcd - r) * q) + off; }
        const int nig = WGM * nN, gid = wgid / nig, fm = gid * WGM, gsz = (nM - fm) < WGM ? (nM - fm) : WGM;
        u.pm = fm + ((wgid % nig) % gsz); u.pn = (wgid % nig) / gsz; u.part = 0; return true;
    }
    __host__ __device__ bool next(int i, Unit& u) const { return tile((long)i * G + c, u); }
};
struct DualOrder : StaticOrder {
    __host__ __device__ bool next(int i, Unit& u) const { if (!tile((long)(i >> 1) * G + c, u)) return false; u.part = i & 1; return true; }
};

__device__ __forceinline__ unsigned cvt_pk_bf16(float lo, float hi) { unsigned r; asm volatile("v_cvt_pk_bf16_f32 %0, %1, %2" : "=v"(r) : "v"(lo), "v"(hi)); return r; }

struct EpiProj {
    static constexpr bool PERM = true;
    bf16_t *Q, *KV, *U, *BR, *GN, *GL, *MG;
    __device__ __forceinline__ void operator()(const f32x4 (&acc)[2][2][4][2], const Unit& u, int wr, int wc, int fr, int fq) const {
        const int pn = u.pn; bf16_t* base; int ldc, colt, act = 0;
        if (pn < 2) { base = Q; ldc = 512; colt = pn * 256; }
        else if (pn < 5) { base = KV; ldc = 768; colt = (pn - 2) * 256; }
        else if (pn < 7) { base = U; ldc = 512; colt = (pn - 5) * 256; }
        else if (pn < 8) { base = BR; ldc = 256; colt = 0; }
        else if (pn < 10) { base = GN; ldc = 512; colt = (pn - 8) * 256; act = 1; }
        else if (pn < 12) { base = GL; ldc = 512; colt = (pn - 10) * 256; act = 1; }
        else { base = MG; ldc = 2048; colt = (pn - 12) * 256; act = 2; }
        const int row0 = u.pm * BM + wr * 64 + fr, col0 = colt + wc * 32 + 8 * fq;
#pragma unroll
        for (int ai = 0; ai < 2; ++ai)
#pragma unroll
            for (int m = 0; m < 4; ++m) { bf16_t* rowp = base + (size_t)(row0 + ai * HALF + m * 16) * ldc + col0;
#pragma unroll
                for (int bj = 0; bj < 2; ++bj) { f32x4 v0 = acc[ai][bj][m][0], v1 = acc[ai][bj][m][1];
                    if (act) {
#pragma unroll
                        for (int e = 0; e < 4; ++e) { const float s0 = fsigmoid(v0[e]), s1 = fsigmoid(v1[e]); v0[e] = (act == 1) ? v0[e] * s0 : s0; v1[e] = (act == 1) ? v1[e] * s1 : s1; } }
                    u32x4 w; w.x = cvt_pk_bf16(v0[0], v0[1]); w.y = cvt_pk_bf16(v0[2], v0[3]); w.z = cvt_pk_bf16(v1[0], v1[1]); w.w = cvt_pk_bf16(v1[2], v1[3]);
                    *(u32x4*)(rowp + bj * HALF) = w; } }
    }
};
struct EpiMerge {
    static constexpr bool PERM = true;
    bf16_t* Mb; const bf16_t* MG;
    __device__ __forceinline__ void operator()(const f32x4 (&acc)[2][2][4][2], const Unit& u, int wr, int wc, int fr, int fq) const {
        const int row0 = u.pm * BM + wr * 64 + fr, col0 = u.pn * BM + wc * 32 + 8 * fq;
#pragma unroll
        for (int ai = 0; ai < 2; ++ai)
#pragma unroll
            for (int m = 0; m < 4; ++m) { const size_t r = (size_t)(row0 + ai * HALF + m * 16);
#pragma unroll
                for (int bj = 0; bj < 2; ++bj) { const f32x4 v0 = acc[ai][bj][m][0], v1 = acc[ai][bj][m][1];
                    const u32x4 gw = *(const u32x4*)(MG + r * 2048 + u.part * 1024 + col0 + bj * HALF);
                    float o[8] = {v0[0] * bflo(gw.x), v0[1] * bfhi(gw.x), v0[2] * bflo(gw.y), v0[3] * bfhi(gw.y), v1[0] * bflo(gw.z), v1[1] * bfhi(gw.z), v1[2] * bflo(gw.w), v1[3] * bfhi(gw.w)};
                    bf16_t* dst = Mb + r * 1024 + col0 + bj * HALF;
                    if (u.part) { const u32x4 pw = *(const u32x4*)dst;
                        o[0] += bflo(pw.x); o[1] += bfhi(pw.x); o[2] += bflo(pw.y); o[3] += bfhi(pw.y); o[4] += bflo(pw.z); o[5] += bfhi(pw.z); o[6] += bflo(pw.w); o[7] += bfhi(pw.w); }
                    u32x4 w; w.x = cvt_pk_bf16(o[0], o[1]); w.y = cvt_pk_bf16(o[2], o[3]); w.z = cvt_pk_bf16(o[4], o[5]); w.w = cvt_pk_bf16(o[6], o[7]);
                    *(u32x4*)dst = w; } }
    }
};
struct EpiOut {
    static constexpr bool PERM = false;
    const float* X; float* O;
    __device__ __forceinline__ void operator()(const f32x4 (&acc)[2][2][4][2], const Unit& u, int wr, int wc, int fr, int fq) const {
        const int row0 = u.pm * BM + wr * 64 + fr, col0 = u.pn * BM + wc * 32 + 4 * fq;
#pragma unroll
        for (int ai = 0; ai < 2; ++ai)
#pragma unroll
            for (int m = 0; m < 4; ++m) { const size_t off = (size_t)(row0 + ai * HALF + m * 16) * 1024 + col0;
#pragma unroll
                for (int bj = 0; bj < 2; ++bj)
#pragma unroll
                    for (int n = 0; n < 2; ++n) { const f32x4 xv = *(const f32x4*)(X + off + bj * HALF + n * 16); *(f32x4*)(O + off + bj * HALF + n * 16) = xv + acc[ai][bj][m][n]; } }
    }
};

template <class Epi, class Sched, bool ALIGN_EPI>
__device__ __forceinline__ void gemm_phase(PG8_LAS unsigned char* lds, const Gemm g, const Sched& S, const Epi& E, int wid) {
    const int lane = lane_id(), tid = wid * 64 + lane, wr = wid >> 2, wc = wid & 3, fr = lane & 15, fq = lane >> 4;
    const int K = g.K, nt = K / BK;
    unsigned voffA[2], voffB[2];
#pragma unroll
    for (int i = 0; i < 2; ++i) { int R, C; stage_rc(tid * 16 + i * 8192, R, C); const int Rb = Epi::PERM ? ((R & ~31) + perm32(R & 31)) : R;
        voffA[i] = (unsigned)(R * g.lda + C) * 2u; voffB[i] = (unsigned)(Rb * g.ldb + C) * 2u; }
    const size_t kstep = (size_t)(BK * 2);
    const size_t hstepA = (size_t)HALF * g.lda * 2, hstepB = (size_t)HALF * g.ldb * 2;
    const size_t tstepA = 2 * hstepA, tstepB = 2 * hstepB;
    const unsigned ldsw = (unsigned)wid * 1024u;
    const int aoff = lds_byte(wr * 64 + fr, fq * 8), boff = lds_byte(wc * 32 + fr, fq * 8);
#define PG8_SA(b, h) (((b) * 2 + (h)) * HTB)
#define PG8_SB(b, h) ((4 + (b) * 2 + (h)) * HTB)
#define PG8_STAGE(bufoff, gbase, voff) do { _Pragma("unroll") for (int _i = 0; _i < 2; ++_i) \
        __builtin_amdgcn_global_load_lds((const unsigned*)((const char*)(gbase) + (voff)[_i]), (PG8_LAS unsigned*)(lds + (bufoff) + ldsw + _i * 8192), 16, 0, 0); } while (0)
#define PG8_LDA(dst, b, h) do { _Pragma("unroll") for (int m = 0; m < 4; ++m) _Pragma("unroll") for (int k = 0; k < 2; ++k) dst[m][k] = *(const PG8_LAS bf16x8*)(lds + PG8_SA(b, h) + aoff + m * 2048 + k * 1024); } while (0)
#define PG8_LDB(dst, b, h) do { _Pragma("unroll") for (int n = 0; n < 2; ++n) _Pragma("unroll") for (int k = 0; k < 2; ++k) dst[n][k] = *(const PG8_LAS bf16x8*)(lds + PG8_SB(b, h) + boff + n * 2048 + k * 1024); } while (0)
#define PG8_MMA(ai, bj, At, Bt) do { __builtin_amdgcn_s_setprio(1); _Pragma("unroll") for (int m = 0; m < 4; ++m) _Pragma("unroll") for (int n = 0; n < 2; ++n) _Pragma("unroll") for (int k = 0; k < 2; ++k) \
        acc[ai][bj][m][n] = __builtin_amdgcn_mfma_f32_16x16x32_bf16(Bt[n][k], At[m][k], acc[ai][bj][m][n], 0, 0, 0); __builtin_amdgcn_s_setprio(0); } while (0)
#define PG8_WAIT_V(n) asm volatile("s_waitcnt vmcnt(" #n ")" ::: "memory")
#define PG8_WAIT_L(n) asm volatile("s_waitcnt lgkmcnt(" #n ")" ::: "memory")
#define PG8_BAR __builtin_amdgcn_s_barrier()
#define PG8_SCHED __builtin_amdgcn_sched_barrier(0)
#define PG8_UA(u) ((const char*)((u).part ? g.A2 : g.A) + (size_t)(u).pm * tstepA)
#define PG8_UB(u) ((const char*)((u).part ? g.Bt2 : g.Bt) + (size_t)(u).pn * tstepB)
    Unit cur, nxt; int ui = 0;
    if (!S.next(0, cur)) return;
    f32x4 acc[2][2][4][2];
#pragma unroll
    for (int a = 0; a < 2; ++a)
#pragma unroll
        for (int b = 0; b < 2; ++b)
#pragma unroll
            for (int m = 0; m < 4; ++m)
#pragma unroll
                for (int n = 0; n < 2; ++n) acc[a][b][m][n] = (f32x4){0.f, 0.f, 0.f, 0.f};
    bf16x8 At[4][2], B0[2][2], B1[2][2];
    const char* cA = PG8_UA(cur); const char* cB = PG8_UB(cur);
    PG8_STAGE(PG8_SB(0, 0), cB, voffB); PG8_STAGE(PG8_SB(0, 1), cB + hstepB, voffB); PG8_STAGE(PG8_SA(0, 0), cA, voffA); PG8_STAGE(PG8_SA(0, 1), cA + hstepA, voffA);
    if (wr == 1) PG8_BAR;
    PG8_WAIT_V(2); PG8_BAR;
    PG8_STAGE(PG8_SB(1, 0), cB + kstep, voffB); PG8_STAGE(PG8_SA(1, 0), cA + kstep, voffA); PG8_STAGE(PG8_SB(1, 1), cB + hstepB + kstep, voffB);
    PG8_WAIT_V(6); PG8_BAR;
    for (;;) {
        const bool has_next = S.next(ui + 1, nxt);
        const char* nA = has_next ? PG8_UA(nxt) : cA; const char* nB = has_next ? PG8_UB(nxt) : cB;
        for (int t = 0; t < nt; t += 2) {
            const bool last = (t == nt - 2);
            const char* a1 = cA + (size_t)(t + 1) * kstep;
            const char* a2 = last ? nA : cA + (size_t)(t + 2) * kstep; const char* b2 = last ? nB : cB + (size_t)(t + 2) * kstep;
            const char* a3 = a2 + kstep; const char* b3 = b2 + kstep;
            PG8_LDB(B0, 0, 0); PG8_LDB(B1, 0, 1); PG8_SCHED; PG8_LDA(At, 0, 0); PG8_STAGE(PG8_SA(1, 1), a1 + hstepA, voffA);
            PG8_WAIT_V(8); PG8_WAIT_L(0); PG8_BAR; PG8_MMA(0, 0, At, B0); PG8_MMA(0, 1, At, B1); PG8_BAR; PG8_SCHED;
            PG8_LDA(At, 0, 1); PG8_STAGE(PG8_SB(0, 0), b2, voffB); PG8_STAGE(PG8_SB(0, 1), b2 + hstepB, voffB); PG8_STAGE(PG8_SA(0, 0), a2, voffA);
            PG8_WAIT_V(8); PG8_WAIT_L(0); PG8_BAR; PG8_MMA(1, 0, At, B0); PG8_MMA(1, 1, At, B1); PG8_BAR; PG8_SCHED;
            PG8_LDB(B0, 1, 0); PG8_LDB(B1, 1, 1); PG8_SCHED; PG8_LDA(At, 1, 0); PG8_STAGE(PG8_SA(0, 1), a2 + hstepA, voffA);
            PG8_WAIT_V(8); PG8_WAIT_L(0); PG8_BAR; PG8_MMA(0, 0, At, B0); PG8_MMA(0, 1, At, B1); PG8_BAR; PG8_SCHED;
            PG8_LDA(At, 1, 1); PG8_STAGE(PG8_SB(1, 0), b3, voffB); PG8_STAGE(PG8_SB(1, 1), b3 + hstepB, voffB); PG8_STAGE(PG8_SA(1, 0), a3, voffA);
            PG8_WAIT_V(8); PG8_WAIT_L(0); PG8_BAR; PG8_MMA(1, 0, At, B0); PG8_MMA(1, 1, At, B1); PG8_BAR; PG8_SCHED;
        }
        if constexpr (ALIGN_EPI) { if (wr == 0) PG8_BAR; }
        E(acc, cur, wr, wc, fr, fq);
        if (!has_next) break;
#pragma unroll
        for (int a = 0; a < 2; ++a)
#pragma unroll
            for (int b = 0; b < 2; ++b)
#pragma unroll
                for (int m = 0; m < 4; ++m)
#pragma unroll
                    for (int n = 0; n < 2; ++n) acc[a][b][m][n] = (f32x4){0.f, 0.f, 0.f, 0.f};
        cur = nxt; cA = nA; cB = nB; ++ui;
        if constexpr (ALIGN_EPI) { if (wr == 1) PG8_BAR; }
    }
    PG8_WAIT_V(0);
    if constexpr (!ALIGN_EPI) { if (wr == 0) PG8_BAR; }
    PG8_BAR;
#undef PG8_SA
#undef PG8_SB
#undef PG8_STAGE
#undef PG8_LDA
#undef PG8_LDB
#undef PG8_MMA
#undef PG8_WAIT_V
#undef PG8_WAIT_L
#undef PG8_BAR
#undef PG8_SCHED
#undef PG8_UA
#undef PG8_UB
}
}

constexpr int NWAVES = 8;
constexpr int N_LAUNCHES = MK_N_LAUNCHES;
constexpr int PER_PHASE = 6;
constexpr size_t MiB = 1u << 20;
constexpr size_t WS_CTL = 0, CTL_ZERO_BYTES = 1 * MiB;
constexpr size_t WS_WIN = 1 * MiB;
constexpr size_t WS_WA = 11 * MiB;
constexpr size_t WS_WB = 12 * MiB;
constexpr size_t WS_WOUT = 13 * MiB;
constexpr size_t WS_W1T = 15 * MiB;
constexpr size_t WS_SMALL = 17 * MiB;
constexpr size_t WS_SUM = 18 * MiB;
constexpr size_t WS_KC = 19 * MiB;
constexpr size_t WS_XN = 20 * MiB;
constexpr size_t WS_Q = 52 * MiB;
constexpr size_t WS_KV = 68 * MiB;
constexpr size_t WS_MB = 52 * MiB;
constexpr size_t WS_U = 92 * MiB;
constexpr size_t WS_BR = 108 * MiB;
constexpr size_t WS_GN = 116 * MiB;
constexpr size_t WS_GL = 132 * MiB;
constexpr size_t WS_MG = 148 * MiB;
constexpr size_t WS_VT = 212 * MiB;
constexpr size_t WS_KT = 216 * MiB;
constexpr size_t WS_Q2 = 220 * MiB;
constexpr size_t WS_END = 236 * MiB;
constexpr size_t SM_W2T = 0;
constexpr size_t SM_LWA = 65536;
constexpr size_t SM_LWX = 131072;
constexpr size_t SM_C1 = 262144;
constexpr size_t SM_LUT = 200704;
constexpr int CW_BAR = 4096;

constexpr int RING_BYTES = 159744;
constexpr int LDSCTL_OFF = RING_BYTES, MISC_OFF = LDSCTL_OFF + 320;
constexpr int LDS_BYTES = 163840;

#define RLX_AGENT __ATOMIC_RELAXED, __HIP_MEMORY_SCOPE_AGENT
#define LDS_WAIT() asm volatile("s_waitcnt lgkmcnt(0)" ::: "memory")
#define VM_WAIT() asm volatile("s_waitcnt vmcnt(0)" ::: "memory")

#define XB_TMO      128
#define XB_XCNT(j)  (256  + 64 * (j))
#define XB_XSUB(j)  (1280 + 64 * (j))
#define XB_XGEN(j)  (2304 + 64 * (j))
#define XB_TOP      3328
#define XB_TOPGEN   3392
#define XCD_BAR_WORDS 3456
#define XB_SPIN_CAP (1u << 18)
__device__ __forceinline__ unsigned xb_ld(unsigned* p)              { return __hip_atomic_load(p, __ATOMIC_RELAXED, __HIP_MEMORY_SCOPE_AGENT); }
__device__ __forceinline__ unsigned xb_add(unsigned* p, unsigned v) { return __hip_atomic_fetch_add(p, v, __ATOMIC_RELAXED, __HIP_MEMORY_SCOPE_AGENT); }
__device__ __forceinline__ unsigned xb_xcc_id() { return (unsigned)__builtin_amdgcn_s_getreg((3 << 11) | 20) & 0xFu; }
#define XB_SPIN(cond, bar) do { unsigned _sp = 0; while (cond) { __builtin_amdgcn_s_sleep(1); \
    if ((++_sp & 255u) == 0u) { if (xb_ld(&(bar)[XB_TMO])) break; if (_sp > XB_SPIN_CAP) { atomicAdd(&(bar)[XB_TMO], 1u); break; } } } } while (0)
struct XcdBarrier { unsigned* bar; unsigned x; volatile LAS unsigned* st; };
__device__ __forceinline__ XcdBarrier xcd_barrier_post(unsigned* bar, volatile LAS unsigned* st) {
    XcdBarrier b; b.bar = bar; b.x = xb_xcc_id(); b.st = st;
    if (threadIdx.x == 0) (void)xb_add(&bar[XB_XCNT(b.x)], 1u);
    return b;
}
__device__ __forceinline__ void xcd_barrier_complete(unsigned* bar, unsigned x, unsigned& nloc, unsigned& nx) {
    const unsigned G = gridDim.x * gridDim.y * gridDim.z;
    unsigned sum, cnt, mine, sp = 0u;
    for (;;) {
        sum = 0u; cnt = 0u; mine = 0u;
#pragma unroll
        for (unsigned j = 0; j < 16; ++j) { const unsigned c = xb_ld(&bar[XB_XCNT(j)]); sum += c; cnt += (c > 0u) ? 1u : 0u; mine = (j == x) ? c : mine; }
        if (sum == G) break;
        __builtin_amdgcn_s_sleep(1);
        if ((++sp & 255u) == 0u) { if (xb_ld(&bar[XB_TMO])) break; if (sp > XB_SPIN_CAP) { atomicAdd(&bar[XB_TMO], 1u); break; } }
    }
    nloc = mine > 0u ? mine : 1u; nx = cnt > 0u ? cnt : 1u;
}
__device__ __forceinline__ void xcd_barrier(const XcdBarrier& b) {
    asm volatile("s_waitcnt vmcnt(0)" ::: "memory");
    __syncthreads();
    if (threadIdx.x == 0) {
        unsigned* bar = b.bar;
        __builtin_amdgcn_s_waitcnt(0);
        unsigned nloc = b.st[0], nx = b.st[1];
        if (nloc == 0u) { xcd_barrier_complete(bar, b.x, nloc, nx); b.st[0] = nloc; b.st[1] = nx; }
        const unsigned old = xb_add(&bar[XB_XSUB(b.x)], 1u);
        const unsigned gen = old / nloc;
        if (old + 1u == (gen + 1u) * nloc) {
            __builtin_amdgcn_fence(__ATOMIC_RELEASE, "agent");
            asm volatile("s_waitcnt vmcnt(0)" ::: "memory");
            const unsigned og = xb_add(&bar[XB_TOP], 1u);
            const unsigned tg = og / nx;
            if (og + 1u == (tg + 1u) * nx) xb_add(&bar[XB_TOPGEN], 1u);
            else XB_SPIN(xb_ld(&bar[XB_TOPGEN]) == tg, bar);
            __builtin_amdgcn_fence(__ATOMIC_ACQUIRE, "agent");
            xb_add(&bar[XB_XGEN(b.x)], 1u);
            asm volatile("s_waitcnt vmcnt(0)" ::: "memory");
        } else {
            XB_SPIN(xb_ld(&bar[XB_XGEN(b.x)]) == gen, bar);
            __builtin_amdgcn_fence(__ATOMIC_ACQUIRE, "agent");
            asm volatile("s_waitcnt vmcnt(0)" ::: "memory");
        }
    }
    __syncthreads();
}

struct Args { const float* in[20]; float* out; unsigned char* ws; int ph_lo, ph_hi, li, pad; };
struct Frame {
    LAS unsigned char* lds;
    volatile LAS unsigned* MISC;
    int wave;
    int vcu, G;
    unsigned char* ws;
#define WSP(name, T, off) __device__ __forceinline__ T* name() const { return (T*)(ws + (off)); }
    WSP(WinT, bf16, WS_WIN) WSP(WaT, bf16, WS_WA) WSP(WbT, bf16, WS_WB) WSP(WoutT, bf16, WS_WOUT) WSP(W1T, bf16, WS_W1T)
    WSP(W2T, bf16, WS_SMALL + SM_W2T) WSP(LWA, bf16, WS_SMALL + SM_LWA) WSP(LWX, bf16, WS_SMALL + SM_LWX)
    WSP(C1, float, WS_SMALL + SM_C1) WSP(LUT, float, WS_SMALL + SM_LUT) WSP(SUMA, float, WS_SUM) WSP(SUMB, float, WS_SUM + 524288)
    WSP(KC, bf16, WS_KC) WSP(VC, bf16, WS_KC + 524288) WSP(XN, bf16, WS_XN) WSP(Q, bf16, WS_Q) WSP(KV, bf16, WS_KV) WSP(MB, bf16, WS_MB)
    WSP(VT, bf16, WS_VT) WSP(KT, bf16, WS_KT) WSP(Q2, bf16, WS_Q2) WSP(U, bf16, WS_U) WSP(BR, bf16, WS_BR) WSP(GN, bf16, WS_GN) WSP(GL, bf16, WS_GL) WSP(MG, bf16, WS_MG)
#undef WSP
};

__device__ __forceinline__ int t5_bucket(int n) {
    if (n < 16) return n;
    const int thr[15] = {19, 21, 24, 27, 31, 35, 40, 46, 52, 59, 67, 77, 87, 99, 113};
    int b = 16;
#pragma unroll
    for (int i = 0; i < 15; ++i) b += (n >= thr[i]) ? 1 : 0;
    return b;
}

__device__ __forceinline__ void p0_tr_item(const float* W, int ldw, int k0, int srccol0, int nvalid, bf16* WT, int ldt, int dstrow0, LAS float* scr, int lane) {
    const int c = lane & 31;
#pragma unroll 8
    for (int i = 0; i < 32; ++i) { const int kk = 2 * i + (lane >> 5); scr[kk * 33 + c] = (c < nvalid) ? W[(size_t)(k0 + kk) * ldw + srccol0 + c] : 0.f; }
    LDS_WAIT(); asm volatile("" ::: "memory");
    const int cc = lane & 7;
#pragma unroll
    for (int j = 0; j < 4; ++j) { const int n = (lane >> 3) + 8 * j; const LAS float* s = scr + (8 * cc) * 33 + n;
        u32x4 o; o.x = pk2(s[0 * 33], s[1 * 33]); o.y = pk2(s[2 * 33], s[3 * 33]); o.z = pk2(s[4 * 33], s[5 * 33]); o.w = pk2(s[6 * 33], s[7 * 33]);
        *(u32x4*)(WT + (size_t)(dstrow0 + n) * ldt + k0 + 8 * cc) = o; }
    LDS_WAIT(); asm volatile("" ::: "memory");
}
__device__ __forceinline__ void win_src(int n0, int& src, int& nvalid) {
    nvalid = 32;
    if (n0 < 1280) src = n0;
    else if (n0 < 1792) src = 1816 + (n0 - 1280);
    else if (n0 < 2048) { src = 1792 + (n0 - 1792); nvalid = (n0 == 1792) ? 24 : 0; if (n0 != 1792) src = 0; }
    else if (n0 < 2560) src = 1280 + (n0 - 2048);
    else if (n0 < 3072) src = 2328 + (n0 - 2560);
    else src = 2840 + (n0 - 3072);
}
__device__ __forceinline__ void p0_prologue(const Frame& F, const Args& A) {
    LAS float* scr = (LAS float*)(F.lds + F.wave * 16384);
    const int gw = F.vcu * NWAVES + F.wave, NGW = F.G * NWAVES, lane = lane_id();
    constexpr int I_WIN = 16 * 160, I_WA = 8 * 32, I_WO = 16 * 32, I_W1 = 32 * 8, I_W2 = 4 * 2, I_LR = 2;
    constexpr int NIT = I_WIN + 2 * I_WA + I_WO + 2 * I_W1 + 2 * I_W2 + 16 * I_LR + 256 + 1;
    for (int it = gw; it < NIT; it += NGW) {
        int r = it;
        if (r < I_WIN) { const int kb = r / 160, nb = r % 160; int src, nv; win_src(32 * nb, src, nv); p0_tr_item(A.in[2], 4888, 64 * kb, src, nv, F.WinT(), 1024, 32 * nb, scr, lane); continue; } r -= I_WIN;
        if (r < I_WA) { p0_tr_item(A.in[17], 1024, 64 * (r / 32), 32 * (r % 32), 32, F.WaT(), 512, 32 * (r % 32), scr, lane); continue; } r -= I_WA;
        if (r < I_WA) { p0_tr_item(A.in[18], 1024, 64 * (r / 32), 32 * (r % 32), 32, F.WbT(), 512, 32 * (r % 32), scr, lane); continue; } r -= I_WA;
        if (r < I_WO) { p0_tr_item(A.in[19], 1024, 64 * (r / 32), 32 * (r % 32), 32, F.WoutT(), 1024, 32 * (r % 32), scr, lane); continue; } r -= I_WO;
        if (r < 2 * I_W1) { const int kv = r / I_W1, q = r % I_W1; p0_tr_item(A.in[6] + (size_t)kv * 2048 * 256, 256, 64 * (q / 8), 32 * (q % 8), 32, F.W1T() + (size_t)kv * 256 * 2048, 2048, 32 * (q % 8), scr, lane); continue; } r -= 2 * I_W1;
        if (r < 2 * I_W2) { const int kv = r / I_W2, q = r % I_W2; p0_tr_item(A.in[8] + (size_t)kv * 256 * 64, 64, 64 * (q / 2), 32 * (q % 2), 32, F.W2T() + (size_t)kv * 64 * 256, 256, 32 * (q % 2), scr, lane); continue; } r -= 2 * I_W2;
        if (r < 16 * I_LR) { const int mtx = r / 2, nb = r % 2; const float* src = (mtx < 8 ? A.in[12] : A.in[14]) + (size_t)(mtx & 7) * 4096; bf16* dst = (mtx < 8 ? F.LWA() : F.LWX()) + (size_t)(mtx & 7) * 4096;
            p0_tr_item(src, 64, 0, 32 * nb, 32, dst, 64, 32 * nb, scr, lane); continue; } r -= 16 * I_LR;
        if (r < 256) {
            const int kc = r >> 3, kv = (r >> 2) & 1, n = (r & 3) * 64 + lane; const float* w1 = A.in[6] + (size_t)kv * 2048 * 256 + (size_t)(64 * kc) * 256 + n; const float* pe = A.in[5] + kv * 2048 + 64 * kc;
            float s0 = 0.f, s1 = 0.f, s2 = 0.f, s3 = 0.f;
#pragma unroll 4
            for (int k = 0; k < 64; k += 4) { s0 += pe[k] * w1[(size_t)k * 256]; s1 += pe[k + 1] * w1[(size_t)(k + 1) * 256]; s2 += pe[k + 2] * w1[(size_t)(k + 2) * 256]; s3 += pe[k + 3] * w1[(size_t)(k + 3) * 256]; }
            F.C1()[(kc * 2 + kv) * 256 + n] = (s0 + s1) + (s2 + s3); continue; } r -= 256;
        {
            for (int e = lane; e < 1024; e += 64) { const int hd = e >> 7, n = e & 127; F.LUT()[e] = A.in[9][t5_bucket(n) * 8 + hd] * LOG2E; }
        }
    }
    const float* gain = A.in[1];
    for (int m = gw; m < SEQ; m += NGW) {
        const f32x4* xr = (const f32x4*)(A.in[0] + (size_t)m * DM) + lane;
        f32x4 v[4]; float s = 0.f;
#pragma unroll
        for (int j = 0; j < 4; ++j) { v[j] = xr[64 * j]; s += (v[j].x * v[j].x + v[j].y * v[j].y) + (v[j].z * v[j].z + v[j].w * v[j].w); }
        const float rs = 1.0f / sqrtf(wave_sum(s) * (1.f / DM) + RMS_EPS);
        unsigned long long* o8 = (unsigned long long*)(F.XN() + (size_t)m * DM) + lane;
#pragma unroll
        for (int j = 0; j < 4; ++j) { const f32x4 gv = ((const f32x4*)gain)[lane + 64 * j];
            o8[64 * j] = (unsigned long long)pk2(v[j].x * rs * gv.x, v[j].y * rs * gv.y) | ((unsigned long long)pk2(v[j].z * rs * gv.z, v[j].w * rs * gv.w) << 32); }
    }
}

template <bool FINAL>
__device__ __forceinline__ void lru_tile(const Frame& F, const Args& A, int tt) {
    const int lane = lane_id();
    const int w = F.wave, fr = lane & 15, fq = lane >> 4, ch0 = 64 * w, t0 = 64 * tt;
    LAS float* UC = (LAS float*)(F.lds + w * 16384);
#define UC_IDX(tok, ch) ((tok) * 64 + ((((ch) >> 2) ^ ((tok) & 15)) << 2) + ((ch) & 3))
    float Hc = 0.f;
    if (FINAL) {
        const float* sa = F.SUMA() + ch0 + lane; const float* sb = F.SUMB() + ch0 + lane;
#pragma unroll 8
        for (int i = 0; i < tt; ++i) Hc = sa[(size_t)i * 512] * Hc + sb[(size_t)i * 512];
        asm volatile("" : "+v"(Hc));
    }
    {
        const int ch = ch0 + lane; const float* cw = A.in[10]; const float cb = A.in[11][ch];
        const float w0 = cw[ch], w1 = cw[512 + ch], w2 = cw[1024 + ch], w3 = cw[1536 + ch];
        const bf16* up = F.U() + (size_t)t0 * 512 + ch;
        float u0 = 0.f, u1 = 0.f, u2 = 0.f;
        if (tt > 0) { u0 = bf2f(up[-3 * 512]); u1 = bf2f(up[-2 * 512]); u2 = bf2f(up[-1 * 512]); }
#pragma unroll 16
        for (int tok = 0; tok < 64; ++tok) { const float u3 = bf2f(up[(size_t)tok * 512]);
            UC[UC_IDX(tok, lane)] = cb + ((u0 * w0 + u1 * w1) + (u2 * w2 + u3 * w3)); u0 = u1; u1 = u2; u2 = u3; }
    }
    bf16x8 Ba[4][2], Bx[4][2];
#pragma unroll
    for (int nt = 0; nt < 4; ++nt)
#pragma unroll
        for (int ks = 0; ks < 2; ++ks) { const size_t o = (size_t)w * 4096 + (16 * nt + fr) * 64 + 32 * ks + 8 * fq; Ba[nt][ks] = *(const bf16x8*)(F.LWA() + o); Bx[nt][ks] = *(const bf16x8*)(F.LWX() + o); }
    float ba[4], bx[4], sp8[4], hin[4], acum[4];
#pragma unroll
    for (int nt = 0; nt < 4; ++nt) { const int ch = ch0 + 16 * nt + fr; ba[nt] = A.in[13][ch]; bx[nt] = A.in[15][ch];
        sp8[nt] = 8.0f * log1pf(expf(-A.in[16][ch])); hin[nt] = 0.f; acum[nt] = 1.f; }
    if (FINAL) {
#pragma unroll
        for (int nt = 0; nt < 4; ++nt) hin[nt] = __shfl(Hc, 16 * nt + fr);
    }
    LDS_WAIT();
#pragma unroll 1
    for (int mt = 0; mt < 4; ++mt) {
        bf16x8 Af[2];
#pragma unroll
        for (int ks = 0; ks < 2; ++ks) { const int tok = 16 * mt + fr, c0 = 8 * ks + 2 * fq;
            const f32x4 x0 = *(const LAS f32x4*)(UC + tok * 64 + ((c0 ^ (tok & 15)) << 2)), x1 = *(const LAS f32x4*)(UC + tok * 64 + (((c0 + 1) ^ (tok & 15)) << 2));
            u32x4 pw; pw.x = cvtpk(x0[0], x0[1]); pw.y = cvtpk(x0[2], x0[3]); pw.z = cvtpk(x1[0], x1[1]); pw.w = cvtpk(x1[2], x1[3]); Af[ks] = __builtin_bit_cast(bf16x8, pw); }
        f32x4 cr[4], ci[4];
#pragma unroll
        for (int nt = 0; nt < 4; ++nt) { cr[nt] = (f32x4){0.f, 0.f, 0.f, 0.f}; ci[nt] = (f32x4){0.f, 0.f, 0.f, 0.f};
#pragma unroll
            for (int ks = 0; ks < 2; ++ks) { cr[nt] = __builtin_amdgcn_mfma_f32_16x16x32_bf16(Af[ks], Ba[nt][ks], cr[nt], 0, 0, 0); ci[nt] = __builtin_amdgcn_mfma_f32_16x16x32_bf16(Af[ks], Bx[nt][ks], ci[nt], 0, 0, 0); } }
#pragma unroll
        for (int nt = 0; nt < 4; ++nt) {
            float P[4], Hh[4];
#pragma unroll
            for (int rg = 0; rg < 4; ++rg) { const int tok = 16 * mt + 4 * fq + rg, e = 16 * nt + fr;
                const float ucv = UC[UC_IDX(tok, e)];
                const float r = fsigmoid(cr[nt][rg] + ba[nt]), ig = fsigmoid(ci[nt][rg] + bx[nt]);
                const float la = -r * sp8[nt]; const float a = __expf(la);
                const float b = sqrtf(-expm1f(2.0f * la)) * (ig * ucv);
                if (rg == 0) { P[0] = a; Hh[0] = b; } else { P[rg] = P[rg - 1] * a; Hh[rg] = a * Hh[rg - 1] + b; } }
            float At = P[3], Bt = Hh[3];
            { const float Ap = __shfl_up(At, 16), Bp = __shfl_up(Bt, 16); if (fq >= 1) { Bt = At * Bp + Bt; At = Ap * At; } }
            { const float Ap = __shfl_up(At, 32), Bp = __shfl_up(Bt, 32); if (fq >= 2) { Bt = At * Bp + Bt; At = Ap * At; } }
            float Aex = __shfl_up(At, 16), Bex = __shfl_up(Bt, 16); if (fq == 0) { Aex = 1.f; Bex = 0.f; }
            const float hg = Aex * hin[nt] + Bex;
            float hv[4];
#pragma unroll
            for (int rg = 0; rg < 4; ++rg) hv[rg] = P[rg] * hg + Hh[rg];
            hin[nt] = __shfl(hv[3], 48 + fr);
            if (!FINAL) acum[nt] *= __shfl(At, 48 + fr);
            if (FINAL) {
#pragma unroll
                for (int rg = 0; rg < 4; ++rg) { const size_t t = (size_t)(t0 + 16 * mt + 4 * fq + rg); const int ch = ch0 + 16 * nt + fr;
                    F.XN()[t * 1024 + 512 + ch] = (bf16)f2bf(hv[rg] * bf2f(F.GL()[t * 512 + ch])); }
            }
        }
    }
    if (!FINAL && fq == 0) {
#pragma unroll
        for (int nt = 0; nt < 4; ++nt) { F.SUMA()[(size_t)tt * 512 + ch0 + 16 * nt + fr] = acum[nt]; F.SUMB()[(size_t)tt * 512 + ch0 + 16 * nt + fr] = hin[nt]; }
    }
    LDS_WAIT();
#undef UC_IDX
}

__device__ __forceinline__ void qk_norm_tile(const Frame& F, const Args& A, int tt) {
    const int lane = lane_id(), sub = lane & 7;
#pragma unroll 2
    for (int it = 0; it < 12; ++it) {
        const int idx = it * 64 + F.wave * 8 + (lane >> 3), tok = idx / 12, hr = idx % 12; const size_t t = (size_t)(64 * tt + tok);
        bf16* p; bf16* dst; const float* gain; float sc = 1.f;
        if (hr < 8) { p = F.Q() + t * 512 + hr * 64; dst = F.Q2() + t * 512 + (hr >> 2) * 256 + (sub >> 1) * 64 + (hr & 3) * 16 + (sub & 1) * 8 - sub * 8; gain = A.in[3]; sc = 0.125f * LOG2E; }
        else if (hr < 10) { p = F.KV() + t * 768 + 256 + (hr - 8) * 64; dst = p; gain = A.in[4] + 64; }
        else { p = F.KV() + t * 768 + 512 + (hr - 10) * 64; dst = p; gain = A.in[4] + 128; }
        const u32x4 w = *(const u32x4*)(p + sub * 8);
        float x[8] = {bflo(w.x), bfhi(w.x), bflo(w.y), bfhi(w.y), bflo(w.z), bfhi(w.z), bflo(w.w), bfhi(w.w)};
        float ss = 0.f;
#pragma unroll
        for (int j = 0; j < 8; ++j) ss += x[j] * x[j];
        ss += __shfl_xor(ss, 1); ss += __shfl_xor(ss, 2); ss += __shfl_xor(ss, 4);
        const float rs = sc / sqrtf(ss * (1.f / 64.f) + RMS_EPS);
        const f32x4 g0 = *(const f32x4*)(gain + sub * 8), g1 = *(const f32x4*)(gain + sub * 8 + 4);
        u32x4 o; o.x = pk2(x[0] * rs * g0.x, x[1] * rs * g0.y); o.y = pk2(x[2] * rs * g0.z, x[3] * rs * g0.w); o.z = pk2(x[4] * rs * g1.x, x[5] * rs * g1.y); o.w = pk2(x[6] * rs * g1.z, x[7] * rs * g1.w);
        *(u32x4*)(dst + sub * 8) = o;
        if (hr >= 8 && hr < 10) *(u32x4*)(F.KT() + ((size_t)((hr - 8) * 256 + tt) * 8 + sub) * 512 + tok * 8) = o;
    }
}

__device__ __forceinline__ void vt_tile(const Frame& F, int J) {
    const int tid = F.wave * 64 + lane_id(), d = tid & 63, chunk = tid >> 6, s = chunk >> 1, hi = chunk & 1;
#pragma unroll
    for (int g = 0; g < 2; ++g) {
        const bf16* vp = F.KV() + (size_t)(64 * J) * 768 + 384 + 64 * g + d;
        unsigned short e[8];
#pragma unroll
        for (int j = 0; j < 8; ++j) { const int key = 16 * s + (j & 3) + 8 * (j >> 2) + 4 * hi; e[j] = vp[(size_t)key * 768]; }
        u32x4 w; w.x = e[0] | ((unsigned)e[1] << 16); w.y = e[2] | ((unsigned)e[3] << 16); w.z = e[4] | ((unsigned)e[5] << 16); w.w = e[6] | ((unsigned)e[7] << 16);
        *(u32x4*)(F.VT() + (size_t)(g * 256 + J) * 4096 + (((d >> 5) * 4 + s) * 32 + (d & 31)) * 16 + 8 * hi) = w;
    }
}

__device__ __forceinline__ void compress_item(const Frame& F, const Args& A, int kv, int g, int ct) {
    const int lane = lane_id(), w = F.wave, tid = w * 64 + lane, fr = lane & 15, fq = lane >> 4, c0 = 16 * ct, tb = 16 * c0;
    LAS unsigned char* T = F.lds;
    LAS bf16* HID = (LAS bf16*)(F.lds + 34816);
    LAS float* OUTF = (LAS float*)(F.lds + 34816 + 8448);
    for (int idx = tid; idx < 272 * 8; idx += 512) { const int tok = idx >> 3, chn = idx & 7, gt = tb + tok;
        u32x4 v = (u32x4){0u, 0u, 0u, 0u};
        if (gt < SEQ) v = *(const u32x4*)(F.KV() + (size_t)gt * 768 + kv * 128 + g * 64 + chn * 8);
        *(LAS u32x4*)(T + tok * 128 + ((chn ^ ((tok >> 4) & 7)) << 4)) = v; }
    LDS_WAIT(); __syncthreads();
    f32x4 acc[2] = {(f32x4){0.f, 0.f, 0.f, 0.f}, (f32x4){0.f, 0.f, 0.f, 0.f}};
    const bf16* w1t = F.W1T() + (size_t)kv * 256 * 2048 + (size_t)(32 * w + fr) * 2048 + 8 * fq;
#pragma unroll 8
    for (int ks = 0; ks < 64; ++ks) {
        const int tok = 16 * fr + (ks >> 1), chn = 4 * (ks & 1) + fq;
        const bf16x8 a = *(const LAS bf16x8*)(T + tok * 128 + ((chn ^ ((tok >> 4) & 7)) << 4));
        const bf16x8 b0 = *(const bf16x8*)(w1t + 32 * ks), b1 = *(const bf16x8*)(w1t + (size_t)16 * 2048 + 32 * ks);
        acc[0] = __builtin_amdgcn_mfma_f32_16x16x32_bf16(a, b0, acc[0], 0, 0, 0);
        acc[1] = __builtin_amdgcn_mfma_f32_16x16x32_bf16(a, b1, acc[1], 0, 0, 0);
    }
#pragma unroll
    for (int nt = 0; nt < 2; ++nt) { const int n = 32 * w + 16 * nt + fr; float c1 = A.in[7][kv * 256 + n];
#pragma unroll 8
        for (int kc = 0; kc < 32; ++kc) c1 += F.C1()[(kc * 2 + kv) * 256 + n];
#pragma unroll
        for (int rg = 0; rg < 4; ++rg) { const float v = acc[nt][rg] + c1; HID[(4 * fq + rg) * 264 + n] = (bf16)f2bf(v * fsigmoid(v)); } }
    LDS_WAIT(); __syncthreads();
    if (w < 4) {
        f32x4 o = (f32x4){0.f, 0.f, 0.f, 0.f};
        const bf16* w2t = F.W2T() + (size_t)kv * 64 * 256 + (size_t)(16 * w + fr) * 256 + 8 * fq;
#pragma unroll
        for (int ks = 0; ks < 8; ++ks) { const bf16x8 a = *(const LAS bf16x8*)(HID + fr * 264 + 32 * ks + 8 * fq); const bf16x8 b = *(const bf16x8*)(w2t + 32 * ks);
            o = __builtin_amdgcn_mfma_f32_16x16x32_bf16(a, b, o, 0, 0, 0); }
#pragma unroll
        for (int rg = 0; rg < 4; ++rg) OUTF[(4 * fq + rg) * 64 + 16 * w + fr] = o[rg];
    }
    LDS_WAIT(); __syncthreads();
    {
        const int row = tid >> 5, e = 2 * (tid & 31), c = c0 + row;
        float v0 = OUTF[row * 64 + e], v1 = OUTF[row * 64 + e + 1];
        if (kv == 0) { float ss = v0 * v0 + v1 * v1;
#pragma unroll
            for (int o = 1; o < 32; o <<= 1) ss += __shfl_xor(ss, o);
            const float rs = 1.0f / sqrtf(ss * (1.f / 64.f) + RMS_EPS); v0 *= rs * A.in[4][e]; v1 *= rs * A.in[4][e + 1]; }
        if (c >= 1023) { v0 = 0.f; v1 = 0.f; }
        bf16* dst = (kv == 0 ? F.KC() : F.VC()) + ((size_t)g * 1024 + c) * 64 + e;
        *(unsigned*)dst = pk2(v0, v1);
    }
    LDS_WAIT(); __syncthreads();
}

namespace att {
constexpr int SLOTB = 8192, NSLOT = 3;
constexpr int L_K = 0, L_V = NSLOT * SLOTB, L_SC = 2 * NSLOT * SLOTB, L_OUT = L_SC + 65536, L_LUT = L_OUT + 32768, L_WSF = L_LUT + 2048, L_BM = L_WSF + 2048, L_REF = L_BM + 2048, L_LACC = L_REF + 1024, L_TL = L_LACC + 1024  , L_END = L_TL + 4096;
static_assert(L_END <= RING_BYTES, "attention LDS map");
constexpr int L_EX = 0  , L_HDR = 32768  , L_LEX = 33024  , L_NT = 34048  ;
constexpr float CLAMP = 100.0f;
constexpr float THR = 8.0f;
#define SBAR() __builtin_amdgcn_sched_barrier(0)
__device__ __forceinline__ int crow(int r, int hi) { return (r & 3) + 8 * (r >> 2) + 4 * hi; }
__device__ __forceinline__ void glds16(const void* gsrc, unsigned lds_dst) { unsigned keep;
    asm volatile("s_mov_b32 %0, m0\n\ts_mov_b32 m0, %2\n\ts_nop 0\n\tglobal_load_lds_dwordx4 %1, off\n\ts_mov_b32 m0, %0" : "=&s"(keep) : "v"(gsrc), "s"(lds_dst) : "memory"); }
__device__ __forceinline__ void qkt(f32x16& p0, f32x16& p1, const LAS unsigned char* Kslot, const bf16x8* qr, float cinit, int r32, int hi) {
    const LAS unsigned char* kb = Kslot + hi * 1024 + r32 * 16;
#pragma unroll
    for (int r = 0; r < 16; ++r) { p0[r] = cinit; p1[r] = cinit; }
#pragma unroll
    for (int d0 = 0; d0 < 4; ++d0) {
        const bf16x8 b0 = *(const LAS bf16x8*)(kb + d0 * 2048);
        const bf16x8 b1 = *(const LAS bf16x8*)(kb + d0 * 2048 + 512);
        p0 = __builtin_amdgcn_mfma_f32_32x32x16_bf16(b0, qr[d0], p0, 0, 0, 0); p1 = __builtin_amdgcn_mfma_f32_32x32x16_bf16(b1, qr[d0], p1, 0, 0, 0); }
}
__device__ __forceinline__ void pv(f32x16* o, int vb, bf16x8 pa0, bf16x8 pa1, bf16x8 pa2, bf16x8 pa3) {
#pragma unroll
    for (int d0 = 0; d0 < 2; ++d0) { s16x4 lo[4], hi[4];
#pragma unroll
        for (int ks = 0; ks < 4; ++ks) {
            asm volatile("ds_read_b64_tr_b16 %0,%1 offset:%c2" : "=&v"(lo[ks]) : "v"(vb), "i"(d0 * 4096 + ks * 1024) : "memory");
            asm volatile("ds_read_b64_tr_b16 %0,%1 offset:%c2" : "=&v"(hi[ks]) : "v"(vb), "i"(d0 * 4096 + ks * 1024 + 512) : "memory"); }
        asm volatile("s_waitcnt lgkmcnt(0)" ::: "memory"); SBAR();
#define PK(k) (bf16x8){lo[k][0], lo[k][1], lo[k][2], lo[k][3], hi[k][0], hi[k][1], hi[k][2], hi[k][3]}
        o[d0] = __builtin_amdgcn_mfma_f32_32x32x16_bf16(pa0, PK(0), o[d0], 0, 0, 0);
        o[d0] = __builtin_amdgcn_mfma_f32_32x32x16_bf16(pa1, PK(1), o[d0], 0, 0, 0);
        o[d0] = __builtin_amdgcn_mfma_f32_32x32x16_bf16(pa2, PK(2), o[d0], 0, 0, 0);
        o[d0] = __builtin_amdgcn_mfma_f32_32x32x16_bf16(pa3, PK(3), o[d0], 0, 0, 0);
#undef PK
    }
}
__device__ __forceinline__ float rowmax(const f32x16& p0, const f32x16& p1) {
    float a = fmaxf(fmaxf(p0[0], p0[1]), p1[0]), b = fmaxf(fmaxf(p0[2], p0[3]), p1[1]); a = fmaxf(fmaxf(a, p1[2]), p1[3]);
#pragma unroll
    for (int r = 4; r < 16; r += 4) { a = fmaxf(fmaxf(a, p0[r]), p0[r + 1]); b = fmaxf(fmaxf(b, p0[r + 2]), p0[r + 3]); a = fmaxf(fmaxf(a, p1[r]), p1[r + 1]); b = fmaxf(fmaxf(b, p1[r + 2]), p1[r + 3]); }
    const float m = fmaxf(a, b);
    auto rr = __builtin_amdgcn_permlane32_swap(__float_as_uint(m), __float_as_uint(m), false, false);
    return fmaxf(__uint_as_float(rr[0]), __uint_as_float(rr[1]));
}
__device__ __forceinline__ float halfsum(float v) { auto rr = __builtin_amdgcn_permlane32_swap(__float_as_uint(v), __float_as_uint(v), false, false); return __uint_as_float(rr[0]) + __uint_as_float(rr[1]); }
template <int STEP, unsigned LIMIT>
__device__ __forceinline__ void near_apply(f32x16& p0, f32x16& p1, int dbase, const LAS float* lut) {
#pragma unroll
    for (int r = 0; r < 16; ++r) { const int koff = (r & 3) + 8 * (r >> 2); const int d0 = dbase - STEP * koff, d1 = d0 - STEP * 32;
        const int i0 = min(max(d0, 0), 127), i1 = min(max(d1, 0), 127);
        const float b0 = lut[i0], b1 = lut[i1];
        p0[r] = ((unsigned)d0 < LIMIT) ? p0[r] + b0 : -INFINITY; p1[r] = ((unsigned)d1 < LIMIT) ? p1[r] + b1 : -INFINITY; }
}
template <bool HASO>
__device__ __forceinline__ void sm_update(f32x16& p0, f32x16& p1, float& m, float& l, f32x16* o, LAS float* wsf, int r32, int hi) {
    const float rm = rowmax(p0, p1);
    const bool need = rm > m + THR;
    if (__any(need)) {
        const float mn = need ? rm : m; const float alpha = __builtin_amdgcn_exp2f(m - mn);
        l *= alpha; m = mn;
        if (HASO) { if (hi == 0) wsf[r32] = alpha; LDS_WAIT();
#pragma unroll
            for (int r = 0; r < 16; ++r) { const float f = wsf[crow(r, hi)]; o[0][r] *= f; o[1][r] *= f; } }
    }
    float s = 0.f;
#pragma unroll
    for (int r = 0; r < 16; ++r) { p0[r] = __builtin_amdgcn_exp2f(p0[r] - m); p1[r] = __builtin_amdgcn_exp2f(p1[r] - m); s += p0[r] + p1[r]; }
    l += s;
}
#define ATT_PACK(P0, P1) \
    const bf16x8 pa0 = __builtin_bit_cast(bf16x8, (u32x4){cvtpk(P0[0], P0[1]), cvtpk(P0[2], P0[3]), cvtpk(P0[4], P0[5]), cvtpk(P0[6], P0[7])}); \
    const bf16x8 pa1 = __builtin_bit_cast(bf16x8, (u32x4){cvtpk(P0[8], P0[9]), cvtpk(P0[10], P0[11]), cvtpk(P0[12], P0[13]), cvtpk(P0[14], P0[15])}); \
    const bf16x8 pa2 = __builtin_bit_cast(bf16x8, (u32x4){cvtpk(P1[0], P1[1]), cvtpk(P1[2], P1[3]), cvtpk(P1[4], P1[5]), cvtpk(P1[6], P1[7])}); \
    const bf16x8 pa3 = __builtin_bit_cast(bf16x8, (u32x4){cvtpk(P1[8], P1[9]), cvtpk(P1[10], P1[11]), cvtpk(P1[12], P1[13]), cvtpk(P1[14], P1[15])});
#define ATT_WAITBAR(N) asm volatile("s_waitcnt vmcnt(" #N ") lgkmcnt(0)\n\ts_barrier" ::: "memory")
#define ATT_FILL(V, x) do { _Pragma("unroll") for (int _r = 0; _r < 16; ++_r) V[_r] = (x); } while (0)

__device__ __forceinline__ unsigned rangemask(int k, int a, int b) {
    const int lo = max(a - 32 * k, 0), hi = min(b - 32 * k, 31);
    return (lo > hi) ? 0u : ((0xFFFFFFFFu >> (31 - hi)) & (0xFFFFFFFFu << lo));
}
__device__ __forceinline__ int wave_max_i32(int x) {
    x = max(x, dpp_i<0xB1>(x)); x = max(x, dpp_i<0x4E>(x)); x = max(x, dpp_i<0x141>(x)); x = max(x, dpp_i<0x140>(x));
    return max(max(__builtin_amdgcn_readlane(x, 0), __builtin_amdgcn_readlane(x, 16)), max(__builtin_amdgcn_readlane(x, 32), __builtin_amdgcn_readlane(x, 48)));
}

__device__ __forceinline__ void lds_add_f32(LAS float* p, float v) { (void)__hip_atomic_fetch_add(p, v, __ATOMIC_RELAXED, __HIP_MEMORY_SCOPE_WORKGROUP); }

__device__ __forceinline__ void attn_item(const Frame& F, int qt, int g) {
    const int lane = lane_id(), wid = F.wave, tid = wid * 64 + lane, r32 = lane & 31, hi = lane >> 5;
    const int ql = r32 >> 2, h = r32 & 3, cur = qt, t = 64 * qt + 8 * wid + ql, head = 4 * g + h;
    LAS unsigned char* shm = F.lds;
    const unsigned lds0 = (unsigned)(uintptr_t)shm;
    LAS float* wsf = (LAS float*)(shm + L_WSF) + wid * 64;
    LAS float* SC = (LAS float*)(shm + L_SC);
    LAS float* OACC = (LAS float*)(shm + L_SC);
    LAS bf16* OUTS = (LAS bf16*)(shm + L_OUT);
    LAS float* lutl = (LAS float*)(shm + L_LUT);
    const LAS float* luth = lutl + h * 128;
    LAS unsigned* BM = (LAS unsigned*)(shm + L_BM);
    LAS float* REF = (LAS float*)(shm + L_REF);
    LAS float* LACC = (LAS float*)(shm + L_LACC);
    lutl[tid] = F.LUT()[(4 * g + (tid >> 7)) * 128 + (tid & 127)];
    BM[tid] = 0u;
    bf16x8 qr[4];
    { const bf16* qp = F.Q2() + (size_t)t * 512 + g * 256 + h * 16 + hi * 8;
#pragma unroll
        for (int d0 = 0; d0 < 4; ++d0) qr[d0] = *(const bf16x8*)(qp + d0 * 64); }
    const float b31 = F.LUT()[head * 128 + 127];
    const float gate_c = fsigmoid(bf2f(F.BR()[(size_t)t * 256 + head])), gate_s = fsigmoid(bf2f(F.BR()[(size_t)t * 256 + 8 + head])), gate_w = fsigmoid(bf2f(F.BR()[(size_t)t * 256 + 16 + head]));
    f32x16 o[2], p0, p1;
    const unsigned kdst = lds0 + L_K + wid * 1024, vdst = lds0 + L_V + wid * 1024;
    const int vrow = 16 * (wid & 3) + (lane >> 2), vcol = (wid >> 2) * 32 + (lane & 3) * 8;
    const int vb0 = (int)(lds0 + L_V) + ((lane >> 4) & 1) * 32 + (lane & 3) * 8 + (4 * hi + ((lane & 15) >> 2)) * 64;
#define DMA_K(base, pitch, row0, slot) glds16((base) + (size_t)((row0) + lane) * (pitch) + wid * 8, (unsigned)__builtin_amdgcn_readfirstlane(kdst + (slot)))
#define DMA_V(base, pitch, row0, slot) glds16((base) + (size_t)((row0) + vrow) * (pitch) + vcol, (unsigned)__builtin_amdgcn_readfirstlane(vdst + (slot)))
#define ROT() do { sl_cur = sl_next; sl_next = (sl_next == (NSLOT - 1) * SLOTB) ? 0 : sl_next + SLOTB; } while (0)
    VM_WAIT(); LDS_WAIT(); __syncthreads();

    const bf16* KCg = F.KC() + (size_t)g * 1024 * 64; const bf16* VCg = F.VC() + (size_t)g * 1024 * 64;
    const int nkt = (qt >> 4) + 1;
    const int tminw = 64 * qt + 8 * wid;
    float m = -1e30f, l = 0.f;
    {
        int sl_cur = 0, sl_next = SLOTB;
        DMA_K(KCg, 64, 0, 0);
        for (int kt = 0; kt < nkt; ++kt) {
            if (kt + 1 < nkt) { DMA_K(KCg, 64, 64 * (kt + 1), sl_next); ATT_WAITBAR(1); } else { ATT_WAITBAR(0); }
            const bool far = (tminw - 31 - 16 * (64 * kt + 63)) >= 128;
            if (far) { qkt(p0, p1, shm + L_K + sl_cur, qr, b31, r32, hi); }
            else { qkt(p0, p1, shm + L_K + sl_cur, qr, 0.f, r32, hi); near_apply<16, 0x80000000u>(p0, p1, t - 31 - 16 * (64 * kt + 4 * hi), luth); }
            sm_update<false>(p0, p1, m, l, o, wsf, r32, hi);
            ROT();
        }
        LDS_WAIT(); __builtin_amdgcn_s_barrier();
    }
    {
        const float lt = halfsum(l); const float rl = lt > 0.f ? 1.0f / lt : 0.f;
        ATT_FILL(o[0], 0.f); ATT_FILL(o[1], 0.f);
        float carry = 0.f;
        int sl_cur = 0, sl_next = SLOTB;
        DMA_K(KCg, 64, 0, 0); DMA_V(VCg, 64, 0, 0);
        for (int kt = 0; kt < nkt; ++kt) {
            if (kt + 1 < nkt) { DMA_K(KCg, 64, 64 * (kt + 1), sl_next); DMA_V(VCg, 64, 64 * (kt + 1), sl_next); ATT_WAITBAR(2); } else { ATT_WAITBAR(0); }
            const bool far = (tminw - 31 - 16 * (64 * kt + 63)) >= 128;
            if (far) { qkt(p0, p1, shm + L_K + sl_cur, qr, b31, r32, hi); }
            else { qkt(p0, p1, shm + L_K + sl_cur, qr, 0.f, r32, hi); near_apply<16, 0x80000000u>(p0, p1, t - 31 - 16 * (64 * kt + 4 * hi), luth); }
#pragma unroll
            for (int r = 0; r < 16; ++r) { p0[r] = __builtin_amdgcn_exp2f(p0[r] - m) * rl; p1[r] = __builtin_amdgcn_exp2f(p1[r] - m) * rl; }
            {
                float q4[8], e[8];
#pragma unroll
                for (int i = 0; i < 4; ++i) { q4[i] = (p0[4 * i] + p0[4 * i + 1]) + (p0[4 * i + 2] + p0[4 * i + 3]); e[i] = p0[4 * i + 3];
                                              q4[4 + i] = (p1[4 * i] + p1[4 * i + 1]) + (p1[4 * i + 2] + p1[4 * i + 3]); e[4 + i] = p1[4 * i + 3]; }
                float newcarry = 0.f;
#pragma unroll
                for (int i = 0; i < 8; ++i) { auto rr = __builtin_amdgcn_permlane32_swap(__float_as_uint(e[i]), __float_as_uint(e[i]), false, false);
                    const float elo = __uint_as_float(rr[0]), ehi = __uint_as_float(rr[1]);
                    if (hi) q4[i] += elo; else if (i < 7) q4[i + 1] += ehi;
                    if (i == 7) newcarry = ehi; }
                if (!hi) q4[0] += carry;
                carry = newcarry;
#pragma unroll
                for (int i = 0; i < 8; ++i) { float v = q4[i]; v += dpp_f<0xB1>(v); v += dpp_f<0x4E>(v); q4[i] = v; }
                if (h == 0) {
#pragma unroll
                    for (int i = 0; i < 8; ++i) SC[(8 * wid + ql) * 256 + 16 * kt + 2 * i + hi] = q4[i]; }
            }
            { ATT_PACK(p0, p1); pv(o, vb0 + sl_cur, pa0, pa1, pa2, pa3); }
            ROT();
        }
        LDS_WAIT(); __builtin_amdgcn_s_barrier();
    }

    if (cur >= 16) {
#pragma unroll 1
        for (int qq = 0; qq < 8; ++qq) {
            const int qloc = 8 * wid + qq;
            const LAS float* row = SC + qloc * 256;
            int v0, v1, v2, v3;
            { const int x0 = __float_as_int(row[lane]), x1 = __float_as_int(row[lane + 64]), x2 = __float_as_int(row[lane + 128]), x3 = __float_as_int(row[lane + 192]);
              v0 = (lane >= 1 && lane <= cur - 2) ? x0 : -1; v1 = (lane + 64 <= cur - 2) ? x1 : -1; v2 = (lane + 128 <= cur - 2) ? x2 : -1; v3 = (lane + 192 <= cur - 2) ? x3 : -1; }
            const unsigned qbit = 1u << (qloc & 31); const int qw = qloc >> 5;
#pragma unroll 1
            for (int round = 0; round < 13; ++round) {
                const int wm = wave_max_i32(max(max(v0, v1), max(v2, v3)));
                const unsigned long long b0 = __ballot(v0 == wm), b1 = __ballot(v1 == wm), b2 = __ballot(v2 == wm), b3 = __ballot(v3 == wm);
                int J;
                if (b0) J = __builtin_ctzll(b0); else if (b1) J = 64 + __builtin_ctzll(b1); else if (b2) J = 128 + __builtin_ctzll(b2); else J = 192 + __builtin_ctzll(b3);
                const bool mine = (lane == (J & 63));
                if (mine && (J >> 6) == 0) v0 = -1; if (mine && (J >> 6) == 1) v1 = -1; if (mine && (J >> 6) == 2) v2 = -1; if (mine && (J >> 6) == 3) v3 = -1;
                if (lane == 0) __hip_atomic_fetch_or(BM + 2 * J + qw, qbit, __ATOMIC_RELAXED, __HIP_MEMORY_SCOPE_WORKGROUP);
            }
        }
    }
    LDS_WAIT();
    {
        if (hi == 0) wsf[r32] = gate_c; LDS_WAIT();
#pragma unroll
        for (int r = 0; r < 16; ++r) { const float f = wsf[crow(r, hi)]; const int orow = 32 * wid + crow(r, hi); OUTS[orow * 64 + r32] = (bf16)f2bf(o[0][r] * f); OUTS[orow * 64 + 32 + r32] = (bf16)f2bf(o[1][r] * f); }
    }

    const bf16* Kw = F.KV() + 512 + g * 64; const bf16* Vw = F.KV() + 640 + g * 64;
    {
        m = -1e30f; l = 0.f; ATT_FILL(o[0], 0.f); ATT_FILL(o[1], 0.f);
        const int J0 = max(cur - 8, 0);
        int sl_cur = 0, sl_next = SLOTB;
        DMA_K(Kw, 768, 64 * J0, 0); DMA_V(Vw, 768, 64 * J0, 0);
        for (int J = J0; J <= cur; ++J) {
            if (J + 1 <= cur) { DMA_K(Kw, 768, 64 * (J + 1), sl_next); DMA_V(Vw, 768, 64 * (J + 1), sl_next); ATT_WAITBAR(2); } else { ATT_WAITBAR(0); }
            if (J >= cur - 2 || J == cur - 8) { qkt(p0, p1, shm + L_K + sl_cur, qr, 0.f, r32, hi); near_apply<1, 512u>(p0, p1, t - 64 * J - 4 * hi, luth); }
            else { qkt(p0, p1, shm + L_K + sl_cur, qr, b31, r32, hi); }
            sm_update<true>(p0, p1, m, l, o, wsf, r32, hi);
            { ATT_PACK(p0, p1); pv(o, vb0 + sl_cur, pa0, pa1, pa2, pa3); }
            ROT();
        }
        LDS_WAIT(); __builtin_amdgcn_s_barrier();
        const float lt = halfsum(l); const float fw = lt > 0.f ? gate_w / lt : 0.f;
        if (hi == 0) wsf[r32] = fw; LDS_WAIT();
#pragma unroll
        for (int r = 0; r < 16; ++r) { const float f = wsf[crow(r, hi)]; const int orow = 32 * wid + crow(r, hi);
            OUTS[orow * 64 + r32] = (bf16)f2bf(bf2f(OUTS[orow * 64 + r32]) + o[0][r] * f); OUTS[orow * 64 + 32 + r32] = (bf16)f2bf(bf2f(OUTS[orow * 64 + 32 + r32]) + o[1][r] * f); }
    }

    const bf16* Ks = F.KV() + 256 + g * 64; const bf16* Vs = F.KV() + 384 + g * 64;
    {
        m = -1e30f; l = 0.f; ATT_FILL(o[0], 0.f); ATT_FILL(o[1], 0.f);
        const int nA = (cur < 16) ? cur + 1 : 3;
#define JA(i) ((cur < 16) ? (i) : ((i) == 0 ? 0 : cur - 2 + (i)))
        int sl_cur = 0, sl_next = SLOTB;
        DMA_K(Ks, 768, 0, 0); DMA_V(Vs, 768, 0, 0);
        for (int i = 0; i < nA; ++i) {
            const int J = JA(i);
            if (i + 1 < nA) { const int Jn = JA(i + 1); DMA_K(Ks, 768, 64 * Jn, sl_next); DMA_V(Vs, 768, 64 * Jn, sl_next); ATT_WAITBAR(2); } else { ATT_WAITBAR(0); }
            if (J >= cur - 2) { qkt(p0, p1, shm + L_K + sl_cur, qr, 0.f, r32, hi); near_apply<1, 0x80000000u>(p0, p1, t - 64 * J - 4 * hi, luth); }
            else { qkt(p0, p1, shm + L_K + sl_cur, qr, b31, r32, hi); }
            sm_update<true>(p0, p1, m, l, o, wsf, r32, hi);
            { ATT_PACK(p0, p1); pv(o, vb0 + sl_cur, pa0, pa1, pa2, pa3); }
            ROT();
        }
#undef JA
        LDS_WAIT(); __builtin_amdgcn_s_barrier();
        const float lt = halfsum(l);
        if (hi == 0) { REF[32 * wid + r32] = m; LACC[32 * wid + r32] = lt; }
#pragma unroll
        for (int r = 0; r < 16; ++r) { const int orow = 32 * wid + crow(r, hi); OACC[orow * 64 + r32] = o[0][r]; OACC[orow * 64 + 32 + r32] = o[1][r]; }
        LDS_WAIT(); __builtin_amdgcn_s_barrier();
    }

    if (cur >= 16) {
        const bf16* KTg = F.KT() + (size_t)g * 256 * 4096; const bf16* VTg = F.VT() + (size_t)g * 256 * 4096; const bf16* Q2g = F.Q2() + g * 256 + h * 16 + hi * 8;
        LAS unsigned short* TL = (LAS unsigned short*)(shm + L_TL) + wid * 256;
        int ntask = 0;
#pragma unroll 1
        for (int i4 = 0; i4 < 4; ++i4) {
            const int Jl = lane + 64 * i4; int nch = 0;
            if (Jl >= 1 && Jl <= cur - 2) nch = (__popc(BM[2 * Jl]) + __popc(BM[2 * Jl + 1]) + 7) >> 3;
#pragma unroll
            for (int c = 0; c < 8; ++c) { const bool has = (c < nch) && (((Jl + c) & 7) == wid); const unsigned long long bal = __ballot(has);
                if (has) TL[ntask + __popcll(bal & ((1ull << lane) - 1ull))] = (unsigned short)(Jl | (c << 8));
                ntask += __popcll(bal); }
        }
        LDS_WAIT();
        struct Task { bf16x8 kf[8], qg[4]; int J, tq, R, q0, q1, q2, q3; bool valid; };
#define PREP(n, T) do { const int e_ = __builtin_amdgcn_readfirstlane((int)TL[n]); const int J_ = e_ & 255, c_ = e_ >> 8; \
            unsigned long long mask_ = ((unsigned long long)(unsigned)__builtin_amdgcn_readfirstlane((int)BM[2 * J_ + 1]) << 32) | (unsigned)__builtin_amdgcn_readfirstlane((int)BM[2 * J_]); \
            for (int k_ = 0; k_ < 8 * c_; ++k_) mask_ &= mask_ - 1; \
            int qk_[8]; _Pragma("unroll") for (int k_ = 0; k_ < 8; ++k_) { if (mask_) { qk_[k_] = __builtin_ctzll(mask_); mask_ &= mask_ - 1; } else qk_[k_] = -1; } \
            const int qi_ = r32 >> 2; int myq_ = qi_ == 0 ? qk_[0] : qi_ == 1 ? qk_[1] : qi_ == 2 ? qk_[2] : qi_ == 3 ? qk_[3] : qi_ == 4 ? qk_[4] : qi_ == 5 ? qk_[5] : qi_ == 6 ? qk_[6] : qk_[7]; \
            T.valid = myq_ >= 0; if (!T.valid) myq_ = qk_[0]; T.J = J_; T.tq = 64 * qt + myq_; T.R = 4 * myq_ + h; \
            T.q0 = hi ? qk_[1] : qk_[0]; T.q1 = hi ? qk_[3] : qk_[2]; T.q2 = hi ? qk_[5] : qk_[4]; T.q3 = hi ? qk_[7] : qk_[6]; \
            const bf16* qp_ = Q2g + (size_t)T.tq * 512; const bf16* kp_ = KTg + (size_t)J_ * 4096 + hi * 512 + r32 * 8; \
            _Pragma("unroll") for (int d0 = 0; d0 < 4; ++d0) { T.qg[d0] = *(const bf16x8*)(qp_ + d0 * 64); T.kf[2 * d0] = *(const bf16x8*)(kp_ + d0 * 1024); T.kf[2 * d0 + 1] = *(const bf16x8*)(kp_ + d0 * 1024 + 256); } } while (0)
        LAS bf16* EX = (LAS bf16*)(shm + L_EX); LAS int* HDR = (LAS int*)(shm + L_HDR); LAS float* LEX = (LAS float*)(shm + L_LEX); LAS int* NT = (LAS int*)(shm + L_NT);
        if (lane == 0) NT[wid] = ntask;
        LDS_WAIT(); __builtin_amdgcn_s_barrier();
        int nround = 0;
#pragma unroll
        for (int k = 0; k < 8; ++k) nround = max(nround, __builtin_amdgcn_readfirstlane(NT[k]));
        Task tc, tn;
        if (ntask > 0) PREP(0, tc);
#pragma unroll 1
        for (int n = 0; n < nround; ++n) {
            if (n < ntask) {
                bf16x8 vf[8];
                { const bf16* vp = VTg + (size_t)tc.J * 4096 + r32 * 16 + 8 * hi;
#pragma unroll
                    for (int x = 0; x < 8; ++x) vf[x] = *(const bf16x8*)(vp + x * 512); }
                if (n + 1 < ntask) PREP(n + 1, tn);
                const float ref = REF[tc.R];
                const bool nearJ = (tc.J >= cur - 2);
                const float cinit = nearJ ? 0.f : (tc.valid ? b31 - ref : -INFINITY);
#pragma unroll
                for (int r = 0; r < 16; ++r) { p0[r] = cinit; p1[r] = cinit; }
#pragma unroll
                for (int d0 = 0; d0 < 4; ++d0) { p0 = __builtin_amdgcn_mfma_f32_32x32x16_bf16(tc.kf[2 * d0], tc.qg[d0], p0, 0, 0, 0); p1 = __builtin_amdgcn_mfma_f32_32x32x16_bf16(tc.kf[2 * d0 + 1], tc.qg[d0], p1, 0, 0, 0); }
                if (nearJ) { near_apply<1, 0x80000000u>(p0, p1, tc.tq - 64 * tc.J - 4 * hi, luth); const float sub = tc.valid ? ref : INFINITY;
#pragma unroll
                    for (int r = 0; r < 16; ++r) { p0[r] -= sub; p1[r] -= sub; } }
                float ls = 0.f;
#pragma unroll
                for (int r = 0; r < 16; ++r) { p0[r] = __builtin_amdgcn_exp2f(fminf(p0[r], CLAMP)); p1[r] = __builtin_amdgcn_exp2f(fminf(p1[r], CLAMP)); ls += p0[r] + p1[r]; }
                ls = halfsum(ls);
                if (hi == 0) { LEX[wid * 32 + r32] = ls; if (h == 0) HDR[wid * 8 + (r32 >> 2)] = tc.valid ? (tc.R >> 2) : -1; }
                f32x16 ob[2]; ATT_FILL(ob[0], 0.f); ATT_FILL(ob[1], 0.f);
                { ATT_PACK(p0, p1);
#pragma unroll
                    for (int d0 = 0; d0 < 2; ++d0) { ob[d0] = __builtin_amdgcn_mfma_f32_32x32x16_bf16(pa0, vf[d0 * 4 + 0], ob[d0], 0, 0, 0); ob[d0] = __builtin_amdgcn_mfma_f32_32x32x16_bf16(pa1, vf[d0 * 4 + 1], ob[d0], 0, 0, 0);
                                                       ob[d0] = __builtin_amdgcn_mfma_f32_32x32x16_bf16(pa2, vf[d0 * 4 + 2], ob[d0], 0, 0, 0); ob[d0] = __builtin_amdgcn_mfma_f32_32x32x16_bf16(pa3, vf[d0 * 4 + 3], ob[d0], 0, 0, 0); } }
                { LAS bf16* ex = EX + wid * 2048 + hi * 256 + r32;
#pragma unroll
                    for (int r = 0; r < 16; ++r) { ex[((r >> 2) * 8 + (r & 3)) * 64] = (bf16)f2bf(ob[0][r]); ex[((r >> 2) * 8 + (r & 3)) * 64 + 32] = (bf16)f2bf(ob[1][r]); } }
            } else if (lane < 8) HDR[wid * 8 + lane] = -1;
            LDS_WAIT(); __builtin_amdgcn_s_barrier();
            {
                const int hv = HDR[lane]; unsigned long long own = __ballot(hv >= 0 && (hv >> 3) == wid);
                const int hsel = lane >> 4, dc = lane & 15;
                while (own) { const int e = __builtin_ctzll(own); own &= own - 1; const int q = __builtin_amdgcn_readlane(hv, e);
                    const u32x2 xv = *(const LAS u32x2*)(EX + e * 256 + hsel * 64 + 4 * dc);
                    LAS f32x4* ap = (LAS f32x4*)(OACC + (4 * q + hsel) * 64 + 4 * dc); f32x4 a = *ap;
                    a[0] += bflo(xv.x); a[1] += bfhi(xv.x); a[2] += bflo(xv.y); a[3] += bfhi(xv.y); *ap = a;
                    if (dc == 0) LACC[4 * q + hsel] += LEX[e * 4 + hsel]; }
            }
            LDS_WAIT(); __builtin_amdgcn_s_barrier();
            tc = tn;
        }
#undef PREP
    }
    LDS_WAIT(); __builtin_amdgcn_s_barrier();

    {
        if (hi == 0) { const float lt = LACC[32 * wid + r32]; wsf[r32] = lt > 0.f ? gate_s / lt : 0.f; }
        LDS_WAIT();
#pragma unroll
        for (int i = 0; i < 4; ++i) { const int rowl = i * 8 + (lane >> 3), chn = lane & 7, row = 32 * wid + rowl;
            const float f = wsf[rowl];
            const f32x4 a0 = *(const LAS f32x4*)(OACC + row * 64 + chn * 8), a1 = *(const LAS f32x4*)(OACC + row * 64 + chn * 8 + 4);
            const u32x4 ov = *(const LAS u32x4*)(OUTS + row * 64 + chn * 8);
            const size_t tt = (size_t)(64 * qt + 8 * wid + (rowl >> 2)); const int col = (4 * g + (rowl & 3)) * 64 + chn * 8;
            const u32x4 gn = *(const u32x4*)(F.GN() + tt * 512 + col);
            u32x4 w; w.x = pk2((bflo(ov.x) + a0[0] * f) * bflo(gn.x), (bfhi(ov.x) + a0[1] * f) * bfhi(gn.x)); w.y = pk2((bflo(ov.y) + a0[2] * f) * bflo(gn.y), (bfhi(ov.y) + a0[3] * f) * bfhi(gn.y));
            w.z = pk2((bflo(ov.z) + a1[0] * f) * bflo(gn.z), (bfhi(ov.z) + a1[1] * f) * bfhi(gn.z)); w.w = pk2((bflo(ov.w) + a1[2] * f) * bflo(gn.w), (bfhi(ov.w) + a1[3] * f) * bfhi(gn.w));
            *(u32x4*)(F.XN() + tt * 1024 + col) = w; }
        VM_WAIT(); LDS_WAIT(); __syncthreads();
    }
#undef DMA_K
#undef DMA_V
#undef ROT
}
}

__global__ void __launch_bounds__(NWAVES * 64, 2) nsa_lru_fwd(Args args) {
    extern __shared__ __attribute__((aligned(16))) unsigned char lds[];
    Frame F;
    F.lds = (LAS unsigned char*)lds;
    F.MISC = (volatile LAS unsigned*)(F.lds + MISC_OFF);
    F.wave = __builtin_amdgcn_readfirstlane((int)(threadIdx.x >> 6));
    F.G = gridDim.x; { const int bx = blockIdx.x; F.vcu = (F.G % 8 == 0) ? (bx % 8) * (F.G / 8) + bx / 8 : bx; }
    F.ws = args.ws;
    gu32* ctl = (gu32*)(args.ws + WS_CTL);
    for (int u = F.wave * 64 + lane_id(); u < (LDS_BYTES - LDSCTL_OFF) / 4; u += NWAVES * 64) ((LAS unsigned*)(F.lds + LDSCTL_OFF))[u] = 0u;
    __syncthreads();
    const int bli = (N_LAUNCHES == PER_PHASE) ? 0 : args.li;
    XcdBarrier bar; bar.bar = (unsigned*)(ctl + CW_BAR) + bli * XCD_BAR_WORDS; bar.x = 0; bar.st = nullptr;
    if (N_LAUNCHES != PER_PHASE) bar = xcd_barrier_post((unsigned*)(ctl + CW_BAR) + bli * XCD_BAR_WORDS, F.MISC + 8);
#define GRID_BAR() do { if (N_LAUNCHES != PER_PHASE) xcd_barrier(bar); } while (0)
    const int lo = args.ph_lo, hi = args.ph_hi;
#define IN(k) (lo <= (k) && (k) < hi)
#define BOTH(k) (IN(k) && IN((k) + 1))

    if (IN(0)) { p0_prologue(F, args); if (BOTH(0)) GRID_BAR(); }

    if (IN(1)) {
        pg8::Gemm g{F.XN(), F.WinT(), F.XN(), F.WinT(), 1024, 1024, 1024}; pg8::StaticOrder S; S.init(SEQ, NPROJ, F.G, (int)blockIdx.x);
        pg8::EpiProj E{F.Q(), F.KV(), F.U(), F.BR(), F.GN(), F.GL(), F.MG()};
        pg8::gemm_phase<pg8::EpiProj, pg8::StaticOrder, true>(F.lds, g, S, E, F.wave);
        if (BOTH(1)) GRID_BAR();
    }

    if (IN(2)) {
        for (int i = F.vcu; i < 256; i += F.G) {
            lru_tile<false>(F, args, i);
            if (!args.pad) qk_norm_tile(F, args, i);
            vt_tile(F, i);
            __syncthreads();
            compress_item(F, args, i & 1, (i >> 1) & 1, i >> 2);
        }
        if (BOTH(2)) GRID_BAR();
    }

    if (IN(3)) {
        for (int i = F.vcu; i < 256; i += F.G) { lru_tile<true>(F, args, i); }
        __syncthreads();
#pragma unroll 1
        for (int it = 2 * F.vcu; it < 512; it += 2 * F.G) {
#pragma unroll 1
            for (int j = 0; j < 2; ++j) { const int i = it >> 1; att::attn_item(F, j ? i : 255 - i, j ? 0 : 1); }
        }
        if (BOTH(3)) GRID_BAR();
    }

    if (IN(4)) {
        pg8::Gemm g{F.XN(), F.WaT(), F.XN() + 512, F.WbT(), 1024, 512, 512}; pg8::DualOrder S; S.init(SEQ, 1024, F.G, (int)blockIdx.x);
        pg8::EpiMerge E{F.MB(), F.MG()};
        pg8::gemm_phase<pg8::EpiMerge, pg8::DualOrder, true>(F.lds, g, S, E, F.wave);
        if (BOTH(4)) GRID_BAR();
    }

    if (IN(5)) {
        pg8::Gemm g{F.MB(), F.WoutT(), F.MB(), F.WoutT(), 1024, 1024, 1024}; pg8::StaticOrder S; S.init(SEQ, 1024, F.G, (int)blockIdx.x);
        pg8::EpiOut E{args.in[0], args.out};
        pg8::gemm_phase<pg8::EpiOut, pg8::StaticOrder, true>(F.lds, g, S, E, F.wave);
    }
#undef IN
#undef BOTH
}

extern "C" void kernel_launch(void* const* d_in, const int* in_sizes, int n_in, void* d_out, int out_size, void* d_ws, size_t ws_size, hipStream_t stream) {
    static int grid = 0;
    if (grid == 0) {
        if (n_in != 20 || in_sizes[0] != SEQ * DM || out_size != SEQ * DM || ws_size < WS_END) { fprintf(stderr, "kernel_launch: unexpected shapes (n_in %d, in0 %d, out %d, ws %zu)\n", n_in, n_in > 0 ? in_sizes[0] : -1, out_size, ws_size); grid = -1; return; }
        int dev = 0, cus = 0, per_cu = 0;
        if (hipGetDevice(&dev) != hipSuccess || hipDeviceGetAttribute(&cus, hipDeviceAttributeMultiprocessorCount, dev) != hipSuccess) { grid = -1; return; }
        if (hipFuncSetAttribute((const void*)nsa_lru_fwd, hipFuncAttributeMaxDynamicSharedMemorySize, LDS_BYTES) != hipSuccess) { fprintf(stderr, "kernel_launch: hipFuncSetAttribute failed\n"); grid = -1; return; }
        if (hipOccupancyMaxActiveBlocksPerMultiprocessor(&per_cu, (const void*)nsa_lru_fwd, NWAVES * 64, LDS_BYTES) != hipSuccess || per_cu < 1)
            fprintf(stderr, "kernel_launch: occupancy query reports %d workgroups per CU\n", per_cu);
        (void)hipGetLastError();
        grid = cus;
    }
    if (grid < 0) return;
    if (hipMemsetAsync((char*)d_ws + WS_CTL, 0, CTL_ZERO_BYTES, stream) != hipSuccess) { fprintf(stderr, "kernel_launch: hipMemsetAsync failed\n"); return; }
    Args a{};
    for (int i = 0; i < 20; ++i) a.in[i] = (const float*)d_in[i];
    a.out = (float*)d_out; a.ws = (unsigned char*)d_ws;
    const int nl = (PROBE_DUP >= 0) ? 2 : N_LAUNCHES;
    for (int li = 0; li < nl; ++li) {
        if (PROBE_DUP >= 0) { a.ph_lo = li ? PROBE_DUP : 0; a.ph_hi = li ? PER_PHASE : PROBE_DUP + 1; a.li = li; a.pad = (li && PROBE_DUP == 2) ? 1 : 0; }
        else { a.ph_lo = (N_LAUNCHES == PER_PHASE) ? li : 0; a.ph_hi = (N_LAUNCHES == PER_PHASE) ? li + 1 : PER_PHASE; a.li = li; }
        hipLaunchKernelGGL(nsa_lru_fwd, dim3(grid), dim3(NWAVES * 64), LDS_BYTES, stream, a);
        const hipError_t le = hipPeekAtLastError();
        if (le != hipSuccess) { fprintf(stderr, "kernel_launch: launch %d failed: %s\n", li, hipGetErrorName(le)); break; }
    }
}
```

```cpp
#include <hip/hip_runtime.h>
#include <cstdio>
#include <cstdint>

#ifndef PROBE_DUP
#define PROBE_DUP -1
#endif
#ifndef MK_N_LAUNCHES
#define MK_N_LAUNCHES 1
#endif

#define GAS __attribute__((address_space(1)))
#define LAS __attribute__((address_space(3)))
typedef unsigned short bf16;
typedef short bf16x8 __attribute__((ext_vector_type(8)));
typedef short s16x4 __attribute__((ext_vector_type(4)));
typedef float f32x4 __attribute__((ext_vector_type(4)));
typedef float f32x16 __attribute__((ext_vector_type(16)));
typedef unsigned u32x4 __attribute__((ext_vector_type(4)));
typedef unsigned u32x2 __attribute__((ext_vector_type(2)));
typedef GAS unsigned gu32;

constexpr int SEQ = 16384, DM = 1024;
constexpr int NPROJ = 5120;
constexpr float LOG2E = 1.4426950408889634f;
constexpr float RMS_EPS = 1e-6f;

__device__ __forceinline__ unsigned f2bf(float f) { unsigned u = __builtin_bit_cast(unsigned, f); return (u + 0x7fffu + ((u >> 16) & 1u)) >> 16; }
__device__ __forceinline__ unsigned pk2(float lo, float hi) { return f2bf(lo) | (f2bf(hi) << 16); }
__device__ __forceinline__ float bf2f(unsigned h) { return __builtin_bit_cast(float, h << 16); }
__device__ __forceinline__ float bflo(unsigned w) { return __builtin_bit_cast(float, w << 16); }
__device__ __forceinline__ float bfhi(unsigned w) { return __builtin_bit_cast(float, w & 0xffff0000u); }
typedef float f32x2_t __attribute__((ext_vector_type(2))); typedef __bf16 bf16x2_t __attribute__((ext_vector_type(2)));
__device__ __forceinline__ unsigned cvtpk(float lo, float hi) { f32x2_t v = {lo, hi}; bf16x2_t b = __builtin_convertvector(v, bf16x2_t); return __builtin_bit_cast(unsigned, b); }
__device__ __forceinline__ float fsigmoid(float v) { return __builtin_amdgcn_rcpf(1.0f + __builtin_amdgcn_exp2f(-v * LOG2E)); }
template <int CTRL> __device__ __forceinline__ float dpp_f(float v) { return __builtin_bit_cast(float, __builtin_amdgcn_update_dpp(0, __builtin_bit_cast(int, v), CTRL, 0xf, 0xf, true)); }
template <int CTRL> __device__ __forceinline__ int dpp_i(int v) { return __builtin_amdgcn_update_dpp(v, v, CTRL, 0xf, 0xf, false); }
__device__ __forceinline__ int lane_id() { int l = (int)__builtin_amdgcn_mbcnt_hi(~0u, __builtin_amdgcn_mbcnt_lo(~0u, 0u)); asm volatile("" : "+v"(l)); return l; }
__device__ __forceinline__ float wave_sum(float v) {
#pragma unroll
    for (int o = 1; o < 64; o <<= 1) v += __shfl_xor(v, o);
    return v;
}

namespace pg8 {
#define PG8_LAS __attribute__((address_space(3)))
typedef unsigned short bf16_t;
constexpr int BM = 256, BK = 64, HALF = 128, HTB = HALF * BK * 2, STAGE_BYTES = 8 * HTB, NXCD = 8, WGM = 8;
__host__ __device__ __forceinline__ int lds_byte(int r, int c) { const int st = (r >> 4) * 2 + (c >> 5), rr = r & 15, cc = c & 31, ob = rr * 64 + cc * 2; return st * 1024 + (ob ^ (((ob >> 9) & 1) << 5)); }
__host__ __device__ __forceinline__ void stage_rc(int b, int& R, int& C) { const int st = b / 1024, sb = b % 1024, swz = sb ^ (((sb >> 9) & 1) << 5); R = (st >> 1) * 16 + swz / 64; C = (st & 1) * 32 + (swz % 64) / 2; }
__host__ __device__ __forceinline__ int perm32(int rho) { const int n = rho >> 4, i = rho & 15; return 8 * (i >> 2) + 4 * n + (i & 3); }

struct Unit { int pm, pn, part; };
struct Gemm { const bf16_t* A; const bf16_t* Bt; const bf16_t* A2; const bf16_t* Bt2; int lda, ldb, K; };

struct StaticOrder {
    int nM, nN, nwg, G, c;
    __host__ __device__ void init(int M, int N, int G_, int c_) { nM = M / BM; nN = N / BM; nwg = nM * nN; G = G_; c = c_; }
    __host__ __device__ bool tile(long L, Unit& u) const {
        if (L >= nwg) return false;
        int wgid = (int)L; { const int q = nwg / NXCD, r = nwg % NXCD, xcd = wgid % NXCD, off = wgid / NXCD; wgid = (xcd < r ? xcd * (q + 1) : r * (q + 1) + (xcd - r) * q) + off; }
        const int nig = WGM * nN, gid = wgid / nig, fm = gid * WGM, gsz = (nM - fm) < WGM ? (nM - fm) : WGM;
        u.pm = fm + ((wgid % nig) % gsz); u.pn = (wgid % nig) / gsz; u.part = 0; return true;
    }
    __host__ __device__ bool next(int i, Unit& u) const { return tile((long)i * G + c, u); }
};
struct DualOrder : StaticOrder {
    __host__ __device__ bool next(int i, Unit& u) const { if (!tile((long)(i >> 1) * G + c, u)) return false; u.part = i & 1; return true; }
};

__device__ __forceinline__ unsigned cvt_pk_bf16(float lo, float hi) { unsigned r; asm volatile("v_cvt_pk_bf16_f32 %0, %1, %2" : "=v"(r) : "v"(lo), "v"(hi)); return r; }

struct EpiProj {
    static constexpr bool PERM = true;
    bf16_t *Q, *KV, *U, *BR, *GN, *GL, *MG;
    __device__ __forceinline__ void operator()(const f32x4 (&acc)[2][2][4][2], const Unit& u, int wr, int wc, int fr, int fq) const {
        const int pn = u.pn; bf16_t* base; int ldc, colt, act = 0;
        if (pn < 2) { base = Q; ldc = 512; colt = pn * 256; }
        else if (pn < 5) { base = KV; ldc = 768; colt = (pn - 2) * 256; }
        else if (pn < 7) { base = U; ldc = 512; colt = (pn - 5) * 256; }
        else if (pn < 8) { base = BR; ldc = 256; colt = 0; }
        else if (pn < 10) { base = GN; ldc = 512; colt = (pn - 8) * 256; act = 1; }
        else if (pn < 12) { base = GL; ldc = 512; colt = (pn - 10) * 256; act = 1; }
        else { base = MG; ldc = 2048; colt = (pn - 12) * 256; act = 2; }
        const int row0 = u.pm * BM + wr * 64 + fr, col0 = colt + wc * 32 + 8 * fq;
#pragma unroll
        for (int ai = 0; ai < 2; ++ai)
#pragma unroll
            for (int m = 0; m < 4; ++m) { bf16_t* rowp = base + (size_t)(row0 + ai * HALF + m * 16) * ldc + col0;
#pragma unroll
                for (int bj = 0; bj < 2; ++bj) { f32x4 v0 = acc[ai][bj][m][0], v1 = acc[ai][bj][m][1];
                    if (act) {
#pragma unroll
                        for (int e = 0; e < 4; ++e) { const float s0 = fsigmoid(v0[e]), s1 = fsigmoid(v1[e]); v0[e] = (act == 1) ? v0[e] * s0 : s0; v1[e] = (act == 1) ? v1[e] * s1 : s1; } }
                    u32x4 w; w.x = cvt_pk_bf16(v0[0], v0[1]); w.y = cvt_pk_bf16(v0[2], v0[3]); w.z = cvt_pk_bf16(v1[0], v1[1]); w.w = cvt_pk_bf16(v1[2], v1[3]);
                    *(u32x4*)(rowp + bj * HALF) = w; } }
    }
};
struct EpiMerge {
    static constexpr bool PERM = true;
    bf16_t* Mb; const bf16_t* MG;
    __device__ __forceinline__ void operator()(const f32x4 (&acc)[2][2][4][2], const Unit& u, int wr, int wc, int fr, int fq) const {
        const int row0 = u.pm * BM + wr * 64 + fr, col0 = u.pn * BM + wc * 32 + 8 * fq;
#pragma unroll
        for (int ai = 0; ai < 2; ++ai)
#pragma unroll
            for (int m = 0; m < 4; ++m) { const size_t r = (size_t)(row0 + ai * HALF + m * 16);
#pragma unroll
                for (int bj = 0; bj < 2; ++bj) { const f32x4 v0 = acc[ai][bj][m][0], v1 = acc[ai][bj][m][1];
                    const u32x4 gw = *(const u32x4*)(MG + r * 2048 + u.part * 1024 + col0 + bj * HALF);
                    float o[8] = {v0[0] * bflo(gw.x), v0[1] * bfhi(gw.x), v0[2] * bflo(gw.y), v0[3] * bfhi(gw.y), v1[0] * bflo(gw.z), v1[1] * bfhi(gw.z), v1[2] * bflo(gw.w), v1[3] * bfhi(gw.w)};
                    bf16_t* dst = Mb + r * 1024 + col0 + bj * HALF;
                    if (u.part) { const u32x4 pw = *(const u32x4*)dst;
                        o[0] += bflo(pw.x); o[1] += bfhi(pw.x); o[2] += bflo(pw.y); o[3] += bfhi(pw.y); o[4] += bflo(pw.z); o[5] += bfhi(pw.z); o[6] += bflo(pw.w); o[7] += bfhi(pw.w); }
                    u32x4 w; w.x = cvt_pk_bf16(o[0], o[1]); w.y = cvt_pk_bf16(o[2], o[3]); w.z = cvt_pk_bf16(o[4], o[5]); w.w = cvt_pk_bf16(o[6], o[7]);
                    *(u32x4*)dst = w; } }
    }
};
struct EpiOut {
    static constexpr bool PERM = false;
    const float* X; float* O;
    __device__ __forceinline__ void operator()(const f32x4 (&acc)[2][2][4][2], const Unit& u, int wr, int wc, int fr, int fq) const {
        const int row0 = u.pm * BM + wr * 64 + fr, col0 = u.pn * BM + wc * 32 + 4 * fq;
#pragma unroll
        for (int ai = 0; ai < 2; ++ai)
#pragma unroll
            for (int m = 0; m < 4; ++m) { const size_t off = (size_t)(row0 + ai * HALF + m * 16) * 1024 + col0;
#pragma unroll
                for (int bj = 0; bj < 2; ++bj)
#pragma unroll
                    for (int n = 0; n < 2; ++n) { const f32x4 xv = *(const f32x4*)(X + off + bj * HALF + n * 16); *(f32x4*)(O + off + bj * HALF + n * 16) = xv + acc[ai][bj][m][n]; } }
    }
};

template <class Epi, class Sched, bool ALIGN_EPI>
__device__ __forceinline__ void gemm_phase(PG8_LAS unsigned char* lds, const Gemm g, const Sched& S, const Epi& E, int wid) {
    const int lane = lane_id(), tid = wid * 64 + lane, wr = wid >> 2, wc = wid & 3, fr = lane & 15, fq = lane >> 4;
    const int K = g.K, nt = K / BK;
    unsigned voffA[2], voffB[2];
#pragma unroll
    for (int i = 0; i < 2; ++i) { int R, C; stage_rc(tid * 16 + i * 8192, R, C); const int Rb = Epi::PERM ? ((R & ~31) + perm32(R & 31)) : R;
        voffA[i] = (unsigned)(R * g.lda + C) * 2u; voffB[i] = (unsigned)(Rb * g.ldb + C) * 2u; }
    const size_t kstep = (size_t)(BK * 2);
    const size_t hstepA = (size_t)HALF * g.lda * 2, hstepB = (size_t)HALF * g.ldb * 2;
    const size_t tstepA = 2 * hstepA, tstepB = 2 * hstepB;
    const unsigned ldsw = (unsigned)wid * 1024u;
    const int aoff = lds_byte(wr * 64 + fr, fq * 8), boff = lds_byte(wc * 32 + fr, fq * 8);
#define PG8_SA(b, h) (((b) * 2 + (h)) * HTB)
#define PG8_SB(b, h) ((4 + (b) * 2 + (h)) * HTB)
#define PG8_STAGE(bufoff, gbase, voff) do { _Pragma("unroll") for (int _i = 0; _i < 2; ++_i) \
        __builtin_amdgcn_global_load_lds((const unsigned*)((const char*)(gbase) + (voff)[_i]), (PG8_LAS unsigned*)(lds + (bufoff) + ldsw + _i * 8192), 16, 0, 0); } while (0)
#define PG8_LDA(dst, b, h) do { _Pragma("unroll") for (int m = 0; m < 4; ++m) _Pragma("unroll") for (int k = 0; k < 2; ++k) dst[m][k] = *(const PG8_LAS bf16x8*)(lds + PG8_SA(b, h) + aoff + m * 2048 + k * 1024); } while (0)
#define PG8_LDB(dst, b, h) do { _Pragma("unroll") for (int n = 0; n < 2; ++n) _Pragma("unroll") for (int k = 0; k < 2; ++k) dst[n][k] = *(const PG8_LAS bf16x8*)(lds + PG8_SB(b, h) + boff + n * 2048 + k * 1024); } while (0)
#define PG8_MMA(ai, bj, At, Bt) do { __builtin_amdgcn_s_setprio(1); _Pragma("unroll") for (int m = 0; m < 4; ++m) _Pragma("unroll") for (int n = 0; n < 2; ++n) _Pragma("unroll") for (int k = 0; k < 2; ++k) \
        acc[ai][bj][m][n] = __builtin_amdgcn_mfma_f32_16x16x32_bf16(Bt[n][k], At[m][k], acc[ai][bj][m][n], 0, 0, 0); __builtin_amdgcn_s_setprio(0); } while (0)
#define PG8_WAIT_V(n) asm volatile("s_waitcnt vmcnt(" #n ")" ::: "memory")
#define PG8_WAIT_L(n) asm volatile("s_waitcnt lgkmcnt(" #n ")" ::: "memory")
#define PG8_BAR __builtin_amdgcn_s_barrier()
#define PG8_SCHED __builtin_amdgcn_sched_barrier(0)
#define PG8_UA(u) ((const char*)((u).part ? g.A2 : g.A) + (size_t)(u).pm * tstepA)
#define PG8_UB(u) ((const char*)((u).part ? g.Bt2 : g.Bt) + (size_t)(u).pn * tstepB)
    Unit cur, nxt; int ui = 0;
    if (!S.next(0, cur)) return;
    f32x4 acc[2][2][4][2];
#pragma unroll
    for (int a = 0; a < 2; ++a)
#pragma unroll
        for (int b = 0; b < 2; ++b)
#pragma unroll
            for (int m = 0; m < 4; ++m)
#pragma unroll
                for (int n = 0; n < 2; ++n) acc[a][b][m][n] = (f32x4){0.f, 0.f, 0.f, 0.f};
    bf16x8 At[4][2], B0[2][2], B1[2][2];
    const char* cA = PG8_UA(cur); const char* cB = PG8_UB(cur);
    PG8_STAGE(PG8_SB(0, 0), cB, voffB); PG8_STAGE(PG8_SB(0, 1), cB + hstepB, voffB); PG8_STAGE(PG8_SA(0, 0), cA, voffA); PG8_STAGE(PG8_SA(0, 1), cA + hstepA, voffA);
    if (wr == 1) PG8_BAR;
    PG8_WAIT_V(2); PG8_BAR;
    PG8_STAGE(PG8_SB(1, 0), cB + kstep, voffB); PG8_STAGE(PG8_SA(1, 0), cA + kstep, voffA); PG8_STAGE(PG8_SB(1, 1), cB + hstepB + kstep, voffB);
    PG8_WAIT_V(6); PG8_BAR;
    for (;;) {
        const bool has_next = S.next(ui + 1, nxt);
        const char* nA = has_next ? PG8_UA(nxt) : cA; const char* nB = has_next ? PG8_UB(nxt) : cB;
        for (int t = 0; t < nt; t += 2) {
            const bool last = (t == nt - 2);
            const char* a1 = cA + (size_t)(t + 1) * kstep;
            const char* a2 = last ? nA : cA + (size_t)(t + 2) * kstep; const char* b2 = last ? nB : cB + (size_t)(t + 2) * kstep;
            const char* a3 = a2 + kstep; const char* b3 = b2 + kstep;
            PG8_LDB(B0, 0, 0); PG8_LDB(B1, 0, 1); PG8_SCHED; PG8_LDA(At, 0, 0); PG8_STAGE(PG8_SA(1, 1), a1 + hstepA, voffA);
            PG8_WAIT_V(8); PG8_WAIT_L(0); PG8_BAR; PG8_MMA(0, 0, At, B0); PG8_MMA(0, 1, At, B1); PG8_BAR; PG8_SCHED;
            PG8_LDA(At, 0, 1); PG8_STAGE(PG8_SB(0, 0), b2, voffB); PG8_STAGE(PG8_SB(0, 1), b2 + hstepB, voffB); PG8_STAGE(PG8_SA(0, 0), a2, voffA);
            PG8_WAIT_V(8); PG8_WAIT_L(0); PG8_BAR; PG8_MMA(1, 0, At, B0); PG8_MMA(1, 1, At, B1); PG8_BAR; PG8_SCHED;
            PG8_LDB(B0, 1, 0); PG8_LDB(B1, 1, 1); PG8_SCHED; PG8_LDA(At, 1, 0); PG8_STAGE(PG8_SA(0, 1), a2 + hstepA, voffA);
            PG8_WAIT_V(8); PG8_WAIT_L(0); PG8_BAR; PG8_MMA(0, 0, At, B0); PG8_MMA(0, 1, At, B1); PG8_BAR; PG8_SCHED;
            PG8_LDA(At, 1, 1); PG8_STAGE(PG8_SB(1, 0), b3, voffB); PG8_STAGE(PG8_SB(1, 1), b3 + hstepB, voffB); PG8_STAGE(PG8_SA(1, 0), a3, voffA);
            PG8_WAIT_V(8); PG8_WAIT_L(0); PG8_BAR; PG8_MMA(1, 0, At, B0); PG8_MMA(1, 1, At, B1); PG8_BAR; PG8_SCHED;
        }
        if constexpr (ALIGN_EPI) { if (wr == 0) PG8_BAR; }
        E(acc, cur, wr, wc, fr, fq);
        if (!has_next) break;
#pragma unroll
        for (int a = 0; a < 2; ++a)
#pragma unroll
            for (int b = 0; b < 2; ++b)
#pragma unroll
                for (int m = 0; m < 4; ++m)
#pragma unroll
                    for (int n = 0; n < 2; ++n) acc[a][b][m][n] = (f32x4){0.f, 0.f, 0.f, 0.f};
        cur = nxt; cA = nA; cB = nB; ++ui;
        if constexpr (ALIGN_EPI) { if (wr == 1) PG8_BAR; }
    }
    PG8_WAIT_V(0);
    if constexpr (!ALIGN_EPI) { if (wr == 0) PG8_BAR; }
    PG8_BAR;
#undef PG8_SA
#undef PG8_SB
#undef PG8_STAGE
#undef PG8_LDA
#undef PG8_LDB
#undef PG8_MMA
#undef PG8_WAIT_V
#undef PG8_WAIT_L
#undef PG8_BAR
#undef PG8_SCHED
#undef PG8_UA
#undef PG8_UB
}
}

constexpr int NWAVES = 8;
constexpr int N_LAUNCHES = MK_N_LAUNCHES;
constexpr int PER_PHASE = 6;
constexpr size_t MiB = 1u << 20;
constexpr size_t WS_CTL = 0, CTL_ZERO_BYTES = 1 * MiB;
constexpr size_t WS_WIN = 1 * MiB;
constexpr size_t WS_WA = 11 * MiB;
constexpr size_t WS_WB = 12 * MiB;
constexpr size_t WS_WOUT = 13 * MiB;
constexpr size_t WS_W1T = 15 * MiB;
constexpr size_t WS_SMALL = 17 * MiB;
constexpr size_t WS_SUM = 18 * MiB;
constexpr size_t WS_KC = 19 * MiB;
constexpr size_t WS_XN = 20 * MiB;
constexpr size_t WS_Q = 52 * MiB;
constexpr size_t WS_KV = 68 * MiB;
constexpr size_t WS_MB = 52 * MiB;
constexpr size_t WS_U = 92 * MiB;
constexpr size_t WS_BR = 108 * MiB;
constexpr size_t WS_GN = 116 * MiB;
constexpr size_t WS_GL = 132 * MiB;
constexpr size_t WS_MG = 148 * MiB;
constexpr size_t WS_VT = 212 * MiB;
constexpr size_t WS_KT = 216 * MiB;
constexpr size_t WS_Q2 = 220 * MiB;
constexpr size_t WS_END = 236 * MiB;
constexpr size_t SM_W2T = 0;
constexpr size_t SM_LWA = 65536;
constexpr size_t SM_LWX = 131072;
constexpr size_t SM_C1 = 262144;
constexpr size_t SM_LUT = 200704;
constexpr int CW_BAR = 4096;

constexpr int RING_BYTES = 159744;
constexpr int LDSCTL_OFF = RING_BYTES, MISC_OFF = LDSCTL_OFF + 320;
constexpr int LDS_BYTES = 163840;

#define RLX_AGENT __ATOMIC_RELAXED, __HIP_MEMORY_SCOPE_AGENT
#define LDS_WAIT() asm volatile("s_waitcnt lgkmcnt(0)" ::: "memory")
#define VM_WAIT() asm volatile("s_waitcnt vmcnt(0)" ::: "memory")

#define XB_TMO      128
#define XB_XCNT(j)  (256  + 64 * (j))
#define XB_XSUB(j)  (1280 + 64 * (j))
#define XB_XGEN(j)  (2304 + 64 * (j))
#define XB_TOP      3328
#define XB_TOPGEN   3392
#define XCD_BAR_WORDS 3456
#define XB_SPIN_CAP (1u << 18)
__device__ __forceinline__ unsigned xb_ld(unsigned* p)              { return __hip_atomic_load(p, __ATOMIC_RELAXED, __HIP_MEMORY_SCOPE_AGENT); }
__device__ __forceinline__ unsigned xb_add(unsigned* p, unsigned v) { return __hip_atomic_fetch_add(p, v, __ATOMIC_RELAXED, __HIP_MEMORY_SCOPE_AGENT); }
__device__ __forceinline__ unsigned xb_xcc_id() { return (unsigned)__builtin_amdgcn_s_getreg((3 << 11) | 20) & 0xFu; }
#define XB_SPIN(cond, bar) do { unsigned _sp = 0; while (cond) { __builtin_amdgcn_s_sleep(1); \
    if ((++_sp & 255u) == 0u) { if (xb_ld(&(bar)[XB_TMO])) break; if (_sp > XB_SPIN_CAP) { atomicAdd(&(bar)[XB_TMO], 1u); break; } } } } while (0)
struct XcdBarrier { unsigned* bar; unsigned x; volatile LAS unsigned* st; };
__device__ __forceinline__ XcdBarrier xcd_barrier_post(unsigned* bar, volatile LAS unsigned* st) {
    XcdBarrier b; b.bar = bar; b.x = xb_xcc_id(); b.st = st;
    if (threadIdx.x == 0) (void)xb_add(&bar[XB_XCNT(b.x)], 1u);
    return b;
}
__device__ __forceinline__ void xcd_barrier_complete(unsigned* bar, unsigned x, unsigned& nloc, unsigned& nx) {
    const unsigned G = gridDim.x * gridDim.y * gridDim.z;
    unsigned sum, cnt, mine, sp = 0u;
    for (;;) {
        sum = 0u; cnt = 0u; mine = 0u;
#pragma unroll
        for (unsigned j = 0; j < 16; ++j) { const unsigned c = xb_ld(&bar[XB_XCNT(j)]); sum += c; cnt += (c > 0u) ? 1u : 0u; mine = (j == x) ? c : mine; }
        if (sum == G) break;
        __builtin_amdgcn_s_sleep(1);
        if ((++sp & 255u) == 0u) { if (xb_ld(&bar[XB_TMO])) break; if (sp > XB_SPIN_CAP) { atomicAdd(&bar[XB_TMO], 1u); break; } }
    }
    nloc = mine > 0u ? mine : 1u; nx = cnt > 0u ? cnt : 1u;
}
__device__ __forceinline__ void xcd_barrier(const XcdBarrier& b) {
    asm volatile("s_waitcnt vmcnt(0)" ::: "memory");
    __syncthreads();
    if (threadIdx.x == 0) {
        unsigned* bar = b.bar;
        __builtin_amdgcn_s_waitcnt(0);
        unsigned nloc = b.st[0], nx = b.st[1];
        if (nloc == 0u) { xcd_barrier_complete(bar, b.x, nloc, nx); b.st[0] = nloc; b.st[1] = nx; }
        const unsigned old = xb_add(&bar[XB_XSUB(b.x)], 1u);
        const unsigned gen = old / nloc;
        if (old + 1u == (gen + 1u) * nloc) {
            __builtin_amdgcn_fence(__ATOMIC_RELEASE, "agent");
            asm volatile("s_waitcnt vmcnt(0)" ::: "memory");
            const unsigned og = xb_add(&bar[XB_TOP], 1u);
            const unsigned tg = og / nx;
            if (og + 1u == (tg + 1u) * nx) xb_add(&bar[XB_TOPGEN], 1u);
            else XB_SPIN(xb_ld(&bar[XB_TOPGEN]) == tg, bar);
            __builtin_amdgcn_fence(__ATOMIC_ACQUIRE, "agent");
            xb_add(&bar[XB_XGEN(b.x)], 1u);
            asm volatile("s_waitcnt vmcnt(0)" ::: "memory");
        } else {
            XB_SPIN(xb_ld(&bar[XB_XGEN(b.x)]) == gen, bar);
            __builtin_amdgcn_fence(__ATOMIC_ACQUIRE, "agent");
            asm volatile("s_waitcnt vmcnt(0)" ::: "memory");
        }
    }
    __syncthreads();
}

struct Args { const float* in[20]; float* out; unsigned char* ws; int ph_lo, ph_hi, li, pad; };
struct Frame {
    LAS unsigned char* lds;
    volatile LAS unsigned* MISC;
    int wave;
    int vcu, G;
    unsigned char* ws;
#define WSP(name, T, off) __device__ __forceinline__ T* name() const { return (T*)(ws + (off)); }
    WSP(WinT, bf16, WS_WIN) WSP(WaT, bf16, WS_WA) WSP(WbT, bf16, WS_WB) WSP(WoutT, bf16, WS_WOUT) WSP(W1T, bf16, WS_W1T)
    WSP(W2T, bf16, WS_SMALL + SM_W2T) WSP(LWA, bf16, WS_SMALL + SM_LWA) WSP(LWX, bf16, WS_SMALL + SM_LWX)
    WSP(C1, float, WS_SMALL + SM_C1) WSP(LUT, float, WS_SMALL + SM_LUT) WSP(SUMA, float, WS_SUM) WSP(SUMB, float, WS_SUM + 524288)
    WSP(KC, bf16, WS_KC) WSP(VC, bf16, WS_KC + 524288) WSP(XN, bf16, WS_XN) WSP(Q, bf16, WS_Q) WSP(KV, bf16, WS_KV) WSP(MB, bf16, WS_MB)
    WSP(VT, bf16, WS_VT) WSP(KT, bf16, WS_KT) WSP(Q2, bf16, WS_Q2) WSP(U, bf16, WS_U) WSP(BR, bf16, WS_BR) WSP(GN, bf16, WS_GN) WSP(GL, bf16, WS_GL) WSP(MG, bf16, WS_MG)
#undef WSP
};

__device__ __forceinline__ int t5_bucket(int n) {
    if (n < 16) return n;
    const int thr[15] = {19, 21, 24, 27, 31, 35, 40, 46, 52, 59, 67, 77, 87, 99, 113};
    int b = 16;
#pragma unroll
    for (int i = 0; i < 15; ++i) b += (n >= thr[i]) ? 1 : 0;
    return b;
}

__device__ __forceinline__ void p0_tr_item(const float* W, int ldw, int k0, int srccol0, int nvalid, bf16* WT, int ldt, int dstrow0, LAS float* scr, int lane) {
    const int c = lane & 31;
    float tv[32];
#pragma unroll
    for (int i = 0; i < 32; ++i) { const int kk = 2 * i + (lane >> 5); tv[i] = (c < nvalid) ? W[(size_t)(k0 + kk) * ldw + srccol0 + c] : 0.f; }
#pragma unroll
    for (int i = 0; i < 32; ++i) { const int kk = 2 * i + (lane >> 5); scr[kk * 33 + c] = tv[i]; }
    LDS_WAIT(); asm volatile("" ::: "memory");
    const int cc = lane & 7;
#pragma unroll
    for (int j = 0; j < 4; ++j) { const int n = (lane >> 3) + 8 * j; const LAS float* s = scr + (8 * cc) * 33 + n;
        u32x4 o; o.x = pk2(s[0 * 33], s[1 * 33]); o.y = pk2(s[2 * 33], s[3 * 33]); o.z = pk2(s[4 * 33], s[5 * 33]); o.w = pk2(s[6 * 33], s[7 * 33]);
        *(u32x4*)(WT + (size_t)(dstrow0 + n) * ldt + k0 + 8 * cc) = o; }
    LDS_WAIT(); asm volatile("" ::: "memory");
}
__device__ __forceinline__ void win_src(int n0, int& src, int& nvalid) {
    nvalid = 32;
    if (n0 < 1280) src = n0;
    else if (n0 < 1792) src = 1816 + (n0 - 1280);
    else if (n0 < 2048) { src = 1792 + (n0 - 1792); nvalid = (n0 == 1792) ? 24 : 0; if (n0 != 1792) src = 0; }
    else if (n0 < 2560) src = 1280 + (n0 - 2048);
    else if (n0 < 3072) src = 2328 + (n0 - 2560);
    else src = 2840 + (n0 - 3072);
}
__device__ __forceinline__ void p0_prologue(const Frame& F, const Args& A) {
    LAS float* scr = (LAS float*)(F.lds + F.wave * 16384);
    const int gw = F.vcu * NWAVES + F.wave, NGW = F.G * NWAVES, lane = lane_id();
    constexpr int I_WIN = 16 * 160, I_WA = 8 * 32, I_WO = 16 * 32, I_W1 = 32 * 8, I_W2 = 4 * 2, I_LR = 2;
    constexpr int NIT = I_WIN + 2 * I_WA + I_WO + 2 * I_W1 + 2 * I_W2 + 16 * I_LR + 256 + 1;
    for (int it = gw; it < NIT; it += NGW) {
        int r = it;
        if (r < I_WIN) { const int kb = r / 160, nb = r % 160; int src, nv; win_src(32 * nb, src, nv); p0_tr_item(A.in[2], 4888, 64 * kb, src, nv, F.WinT(), 1024, 32 * nb, scr, lane); continue; } r -= I_WIN;
        if (r < I_WA) { p0_tr_item(A.in[17], 1024, 64 * (r / 32), 32 * (r % 32), 32, F.WaT(), 512, 32 * (r % 32), scr, lane); continue; } r -= I_WA;
        if (r < I_WA) { p0_tr_item(A.in[18], 1024, 64 * (r / 32), 32 * (r % 32), 32, F.WbT(), 512, 32 * (r % 32), scr, lane); continue; } r -= I_WA;
        if (r < I_WO) { p0_tr_item(A.in[19], 1024, 64 * (r / 32), 32 * (r % 32), 32, F.WoutT(), 1024, 32 * (r % 32), scr, lane); continue; } r -= I_WO;
        if (r < 2 * I_W1) { const int kv = r / I_W1, q = r % I_W1; p0_tr_item(A.in[6] + (size_t)kv * 2048 * 256, 256, 64 * (q / 8), 32 * (q % 8), 32, F.W1T() + (size_t)kv * 256 * 2048, 2048, 32 * (q % 8), scr, lane); continue; } r -= 2 * I_W1;
        if (r < 2 * I_W2) { const int kv = r / I_W2, q = r % I_W2; p0_tr_item(A.in[8] + (size_t)kv * 256 * 64, 64, 64 * (q / 2), 32 * (q % 2), 32, F.W2T() + (size_t)kv * 64 * 256, 256, 32 * (q % 2), scr, lane); continue; } r -= 2 * I_W2;
        if (r < 16 * I_LR) { const int mtx = r / 2, nb = r % 2; const float* src = (mtx < 8 ? A.in[12] : A.in[14]) + (size_t)(mtx & 7) * 4096; bf16* dst = (mtx < 8 ? F.LWA() : F.LWX()) + (size_t)(mtx & 7) * 4096;
            p0_tr_item(src, 64, 0, 32 * nb, 32, dst, 64, 32 * nb, scr, lane); continue; } r -= 16 * I_LR;
        if (r < 256) {
            const int kc = r >> 3, kv = (r >> 2) & 1, n = (r & 3) * 64 + lane; const float* w1 = A.in[6] + (size_t)kv * 2048 * 256 + (size_t)(64 * kc) * 256 + n; const float* pe = A.in[5] + kv * 2048 + 64 * kc;
            float s0 = 0.f, s1 = 0.f, s2 = 0.f, s3 = 0.f;
#pragma unroll 4
            for (int k = 0; k < 64; k += 4) { s0 += pe[k] * w1[(size_t)k * 256]; s1 += pe[k + 1] * w1[(size_t)(k + 1) * 256]; s2 += pe[k + 2] * w1[(size_t)(k + 2) * 256]; s3 += pe[k + 3] * w1[(size_t)(k + 3) * 256]; }
            F.C1()[(kc * 2 + kv) * 256 + n] = (s0 + s1) + (s2 + s3); continue; } r -= 256;
        {
            for (int e = lane; e < 1024; e += 64) { const int hd = e >> 7, n = e & 127; F.LUT()[e] = A.in[9][t5_bucket(n) * 8 + hd] * LOG2E; }
        }
    }
    const float* gain = A.in[1];
    {
        f32x4 v[4], vn[4];
        if (gw < SEQ) { const f32x4* xr = (const f32x4*)(A.in[0] + (size_t)gw * DM) + lane;
#pragma unroll
            for (int j = 0; j < 4; ++j) v[j] = xr[64 * j]; }
        for (int m = gw; m < SEQ; m += NGW) {
            if (m + NGW < SEQ) { const f32x4* xr = (const f32x4*)(A.in[0] + (size_t)(m + NGW) * DM) + lane;
#pragma unroll
                for (int j = 0; j < 4; ++j) vn[j] = xr[64 * j]; }
            float s = 0.f;
#pragma unroll
            for (int j = 0; j < 4; ++j) s += (v[j].x * v[j].x + v[j].y * v[j].y) + (v[j].z * v[j].z + v[j].w * v[j].w);
            const float rs = 1.0f / sqrtf(wave_sum(s) * (1.f / DM) + RMS_EPS);
            unsigned long long* o8 = (unsigned long long*)(F.XN() + (size_t)m * DM) + lane;
#pragma unroll
            for (int j = 0; j < 4; ++j) { const f32x4 gv = ((const f32x4*)gain)[lane + 64 * j];
                o8[64 * j] = (unsigned long long)pk2(v[j].x * rs * gv.x, v[j].y * rs * gv.y) | ((unsigned long long)pk2(v[j].z * rs * gv.z, v[j].w * rs * gv.w) << 32); }
#pragma unroll
            for (int j = 0; j < 4; ++j) v[j] = vn[j];
        }
    }
}

template <bool FINAL>
__device__ __forceinline__ void lru_tile(const Frame& F, const Args& A, int tt) {
    const int lane = lane_id();
    const int w = F.wave, fr = lane & 15, fq = lane >> 4, ch0 = 64 * w, t0 = 64 * tt;
    LAS float* UC = (LAS float*)(F.lds + w * 16384);
#define UC_IDX(tok, ch) ((tok) * 64 + ((((ch) >> 2) ^ ((tok) & 15)) << 2) + ((ch) & 3))
    float Hc = 0.f;
    if (FINAL) {
        const float* sa = F.SUMA() + ch0 + lane; const float* sb = F.SUMB() + ch0 + lane;
        int i = 0;
        for (; i + 16 <= tt; i += 16) { float ta[16], tb[16];
#pragma unroll
            for (int k = 0; k < 16; ++k) { ta[k] = sa[(size_t)(i + k) * 512]; tb[k] = sb[(size_t)(i + k) * 512]; }
#pragma unroll
            for (int k = 0; k < 16; ++k) Hc = ta[k] * Hc + tb[k]; }
        for (; i < tt; ++i) Hc = sa[(size_t)i * 512] * Hc + sb[(size_t)i * 512];
        asm volatile("" : "+v"(Hc));
    }
    {
        const int ch = ch0 + lane; const float* cw = A.in[10]; const float cb = A.in[11][ch];
        const float w0 = cw[ch], w1 = cw[512 + ch], w2 = cw[1024 + ch], w3 = cw[1536 + ch];
        const bf16* up = F.U() + (size_t)t0 * 512 + ch;
        float u0 = 0.f, u1 = 0.f, u2 = 0.f;
        if (tt > 0) { u0 = bf2f(up[-3 * 512]); u1 = bf2f(up[-2 * 512]); u2 = bf2f(up[-1 * 512]); }
#pragma unroll 16
        for (int tok = 0; tok < 64; ++tok) { const float u3 = bf2f(up[(size_t)tok * 512]);
            UC[UC_IDX(tok, lane)] = cb + ((u0 * w0 + u1 * w1) + (u2 * w2 + u3 * w3)); u0 = u1; u1 = u2; u2 = u3; }
    }
    bf16x8 Ba[4][2], Bx[4][2];
#pragma unroll
    for (int nt = 0; nt < 4; ++nt)
#pragma unroll
        for (int ks = 0; ks < 2; ++ks) { const size_t o = (size_t)w * 4096 + (16 * nt + fr) * 64 + 32 * ks + 8 * fq; Ba[nt][ks] = *(const bf16x8*)(F.LWA() + o); Bx[nt][ks] = *(const bf16x8*)(F.LWX() + o); }
    float ba[4], bx[4], sp8[4], hin[4], acum[4];
#pragma unroll
    for (int nt = 0; nt < 4; ++nt) { const int ch = ch0 + 16 * nt + fr; ba[nt] = A.in[13][ch]; bx[nt] = A.in[15][ch];
        sp8[nt] = 8.0f * log1pf(expf(-A.in[16][ch])); hin[nt] = 0.f; acum[nt] = 1.f; }
    if (FINAL) {
#pragma unroll
        for (int nt = 0; nt < 4; ++nt) hin[nt] = __shfl(Hc, 16 * nt + fr);
    }
    LDS_WAIT();
#pragma unroll 1
    for (int mt = 0; mt < 4; ++mt) {
        bf16x8 Af[2];
#pragma unroll
        for (int ks = 0; ks < 2; ++ks) { const int tok = 16 * mt + fr, c0 = 8 * ks + 2 * fq;
            const f32x4 x0 = *(const LAS f32x4*)(UC + tok * 64 + ((c0 ^ (tok & 15)) << 2)), x1 = *(const LAS f32x4*)(UC + tok * 64 + (((c0 + 1) ^ (tok & 15)) << 2));
            u32x4 pw; pw.x = cvtpk(x0[0], x0[1]); pw.y = cvtpk(x0[2], x0[3]); pw.z = cvtpk(x1[0], x1[1]); pw.w = cvtpk(x1[2], x1[3]); Af[ks] = __builtin_bit_cast(bf16x8, pw); }
        f32x4 cr[4], ci[4];
#pragma unroll
        for (int nt = 0; nt < 4; ++nt) { cr[nt] = (f32x4){0.f, 0.f, 0.f, 0.f}; ci[nt] = (f32x4){0.f, 0.f, 0.f, 0.f};
#pragma unroll
            for (int ks = 0; ks < 2; ++ks) { cr[nt] = __builtin_amdgcn_mfma_f32_16x16x32_bf16(Af[ks], Ba[nt][ks], cr[nt], 0, 0, 0); ci[nt] = __builtin_amdgcn_mfma_f32_16x16x32_bf16(Af[ks], Bx[nt][ks], ci[nt], 0, 0, 0); } }
#pragma unroll
        for (int nt = 0; nt < 4; ++nt) {
            float P[4], Hh[4];
#pragma unroll
            for (int rg = 0; rg < 4; ++rg) { const int tok = 16 * mt + 4 * fq + rg, e = 16 * nt + fr;
                const float ucv = UC[UC_IDX(tok, e)];
                const float r = fsigmoid(cr[nt][rg] + ba[nt]), ig = fsigmoid(ci[nt][rg] + bx[nt]);
                const float la = -r * sp8[nt]; const float a = __builtin_amdgcn_exp2f(la * LOG2E);
                const float x2 = 2.0f * la;
                const float ser = -x2 * (1.0f + x2 * (0.5f + x2 * (0.16666667f + x2 * (0.041666668f + x2 * 0.008333334f))));
                const float om = (x2 > -0.25f) ? ser : 1.0f - a * a;
                const float b = __builtin_amdgcn_sqrtf(om) * (ig * ucv);
                if (rg == 0) { P[0] = a; Hh[0] = b; } else { P[rg] = P[rg - 1] * a; Hh[rg] = a * Hh[rg - 1] + b; } }
            float At = P[3], Bt = Hh[3];
            { const float Ap = __shfl_up(At, 16), Bp = __shfl_up(Bt, 16); if (fq >= 1) { Bt = At * Bp + Bt; At = Ap * At; } }
            { const float Ap = __shfl_up(At, 32), Bp = __shfl_up(Bt, 32); if (fq >= 2) { Bt = At * Bp + Bt; At = Ap * At; } }
            float Aex = __shfl_up(At, 16), Bex = __shfl_up(Bt, 16); if (fq == 0) { Aex = 1.f; Bex = 0.f; }
            const float hg = Aex * hin[nt] + Bex;
            float hv[4];
#pragma unroll
            for (int rg = 0; rg < 4; ++rg) hv[rg] = P[rg] * hg + Hh[rg];
            hin[nt] = __shfl(hv[3], 48 + fr);
            if (!FINAL) acum[nt] *= __shfl(At, 48 + fr);
            if (FINAL) {
#pragma unroll
                for (int rg = 0; rg < 4; ++rg) { const size_t t = (size_t)(t0 + 16 * mt + 4 * fq + rg); const int ch = ch0 + 16 * nt + fr;
                    F.XN()[t * 1024 + 512 + ch] = (bf16)f2bf(hv[rg] * bf2f(F.GL()[t * 512 + ch])); }
            }
        }
    }
    if (!FINAL && fq == 0) {
#pragma unroll
        for (int nt = 0; nt < 4; ++nt) { F.SUMA()[(size_t)tt * 512 + ch0 + 16 * nt + fr] = acum[nt]; F.SUMB()[(size_t)tt * 512 + ch0 + 16 * nt + fr] = hin[nt]; }
    }
    LDS_WAIT();
#undef UC_IDX
}

__device__ __forceinline__ void qk_norm_tile(const Frame& F, const Args& A, int tt) {
    const int lane = lane_id(), sub = lane & 7;
#pragma unroll 2
    for (int it = 0; it < 12; ++it) {
        const int idx = it * 64 + F.wave * 8 + (lane >> 3), tok = idx / 12, hr = idx % 12; const size_t t = (size_t)(64 * tt + tok);
        bf16* p; bf16* dst; const float* gain; float sc = 1.f;
        if (hr < 8) { p = F.Q() + t * 512 + hr * 64; dst = F.Q2() + t * 512 + (hr >> 2) * 256 + (sub >> 1) * 64 + (hr & 3) * 16 + (sub & 1) * 8 - sub * 8; gain = A.in[3]; sc = 0.125f * LOG2E; }
        else if (hr < 10) { p = F.KV() + t * 768 + 256 + (hr - 8) * 64; dst = p; gain = A.in[4] + 64; }
        else { p = F.KV() + t * 768 + 512 + (hr - 10) * 64; dst = p; gain = A.in[4] + 128; }
        const u32x4 w = *(const u32x4*)(p + sub * 8);
        float x[8] = {bflo(w.x), bfhi(w.x), bflo(w.y), bfhi(w.y), bflo(w.z), bfhi(w.z), bflo(w.w), bfhi(w.w)};
        float ss = 0.f;
#pragma unroll
        for (int j = 0; j < 8; ++j) ss += x[j] * x[j];
        ss += __shfl_xor(ss, 1); ss += __shfl_xor(ss, 2); ss += __shfl_xor(ss, 4);
        const float rs = sc / sqrtf(ss * (1.f / 64.f) + RMS_EPS);
        const f32x4 g0 = *(const f32x4*)(gain + sub * 8), g1 = *(const f32x4*)(gain + sub * 8 + 4);
        u32x4 o; o.x = pk2(x[0] * rs * g0.x, x[1] * rs * g0.y); o.y = pk2(x[2] * rs * g0.z, x[3] * rs * g0.w); o.z = pk2(x[4] * rs * g1.x, x[5] * rs * g1.y); o.w = pk2(x[6] * rs * g1.z, x[7] * rs * g1.w);
        *(u32x4*)(dst + sub * 8) = o;
        if (hr >= 8 && hr < 10) *(u32x4*)(F.KT() + ((size_t)((hr - 8) * 256 + tt) * 8 + sub) * 512 + tok * 8) = o;
    }
}

__device__ __forceinline__ void vt_tile(const Frame& F, int J) {
    const int tid = F.wave * 64 + lane_id(), d = tid & 63, chunk = tid >> 6, s = chunk >> 1, hi = chunk & 1;
#pragma unroll
    for (int g = 0; g < 2; ++g) {
        const bf16* vp = F.KV() + (size_t)(64 * J) * 768 + 384 + 64 * g + d;
        unsigned short e[8];
#pragma unroll
        for (int j = 0; j < 8; ++j) { const int key = 16 * s + (j & 3) + 8 * (j >> 2) + 4 * hi; e[j] = vp[(size_t)key * 768]; }
        u32x4 w; w.x = e[0] | ((unsigned)e[1] << 16); w.y = e[2] | ((unsigned)e[3] << 16); w.z = e[4] | ((unsigned)e[5] << 16); w.w = e[6] | ((unsigned)e[7] << 16);
        *(u32x4*)(F.VT() + (size_t)(g * 256 + J) * 4096 + (((d >> 5) * 4 + s) * 32 + (d & 31)) * 16 + 8 * hi) = w;
    }
}

__device__ __forceinline__ void compress_item(const Frame& F, const Args& A, int kv, int g, int ct) {
    const int lane = lane_id(), w = F.wave, tid = w * 64 + lane, fr = lane & 15, fq = lane >> 4, c0 = 16 * ct, tb = 16 * c0;
    LAS unsigned char* T = F.lds;
    LAS bf16* HID = (LAS bf16*)(F.lds + 34816);
    LAS float* OUTF = (LAS float*)(F.lds + 34816 + 8448);
    for (int idx = tid; idx < 272 * 8; idx += 512) { const int tok = idx >> 3, chn = idx & 7, gt = tb + tok;
        u32x4 v = (u32x4){0u, 0u, 0u, 0u};
        if (gt < SEQ) v = *(const u32x4*)(F.KV() + (size_t)gt * 768 + kv * 128 + g * 64 + chn * 8);
        *(LAS u32x4*)(T + tok * 128 + ((chn ^ ((tok >> 4) & 7)) << 4)) = v; }
    LDS_WAIT(); __syncthreads();
    f32x4 acc[2] = {(f32x4){0.f, 0.f, 0.f, 0.f}, (f32x4){0.f, 0.f, 0.f, 0.f}};
    const bf16* w1t = F.W1T() + (size_t)kv * 256 * 2048 + (size_t)(32 * w + fr) * 2048 + 8 * fq;
#pragma unroll 8
    for (int ks = 0; ks < 64; ++ks) {
        const int tok = 16 * fr + (ks >> 1), chn = 4 * (ks & 1) + fq;
        const bf16x8 a = *(const LAS bf16x8*)(T + tok * 128 + ((chn ^ ((tok >> 4) & 7)) << 4));
        const bf16x8 b0 = *(const bf16x8*)(w1t + 32 * ks), b1 = *(const bf16x8*)(w1t + (size_t)16 * 2048 + 32 * ks);
        acc[0] = __builtin_amdgcn_mfma_f32_16x16x32_bf16(a, b0, acc[0], 0, 0, 0);
        acc[1] = __builtin_amdgcn_mfma_f32_16x16x32_bf16(a, b1, acc[1], 0, 0, 0);
    }
#pragma unroll
    for (int nt = 0; nt < 2; ++nt) { const int n = 32 * w + 16 * nt + fr; float c1 = A.in[7][kv * 256 + n];
#pragma unroll 8
        for (int kc = 0; kc < 32; ++kc) c1 += F.C1()[(kc * 2 + kv) * 256 + n];
#pragma unroll
        for (int rg = 0; rg < 4; ++rg) { const float v = acc[nt][rg] + c1; HID[(4 * fq + rg) * 264 + n] = (bf16)f2bf(v * fsigmoid(v)); } }
    LDS_WAIT(); __syncthreads();
    if (w < 4) {
        f32x4 o = (f32x4){0.f, 0.f, 0.f, 0.f};
        const bf16* w2t = F.W2T() + (size_t)kv * 64 * 256 + (size_t)(16 * w + fr) * 256 + 8 * fq;
#pragma unroll
        for (int ks = 0; ks < 8; ++ks) { const bf16x8 a = *(const LAS bf16x8*)(HID + fr * 264 + 32 * ks + 8 * fq); const bf16x8 b = *(const bf16x8*)(w2t + 32 * ks);
            o = __builtin_amdgcn_mfma_f32_16x16x32_bf16(a, b, o, 0, 0, 0); }
#pragma unroll
        for (int rg = 0; rg < 4; ++rg) OUTF[(4 * fq + rg) * 64 + 16 * w + fr] = o[rg];
    }
    LDS_WAIT(); __syncthreads();
    {
        const int row = tid >> 5, e = 2 * (tid & 31), c = c0 + row;
        float v0 = OUTF[row * 64 + e], v1 = OUTF[row * 64 + e + 1];
        if (kv == 0) { float ss = v0 * v0 + v1 * v1;
#pragma unroll
            for (int o = 1; o < 32; o <<= 1) ss += __shfl_xor(ss, o);
            const float rs = 1.0f / sqrtf(ss * (1.f / 64.f) + RMS_EPS); v0 *= rs * A.in[4][e]; v1 *= rs * A.in[4][e + 1]; }
        if (c >= 1023) { v0 = 0.f; v1 = 0.f; }
        bf16* dst = (kv == 0 ? F.KC() : F.VC()) + ((size_t)g * 1024 + c) * 64 + e;
        *(unsigned*)dst = pk2(v0, v1);
    }
    LDS_WAIT(); __syncthreads();
}

namespace att {
constexpr int SLOTB = 8192, NSLOT = 3;
constexpr int L_K = 0, L_V = NSLOT * SLOTB, L_SC = 2 * NSLOT * SLOTB, L_OUT = L_SC + 65536, L_LUT = L_OUT + 32768, L_WSF = L_LUT + 2048, L_BM = L_WSF + 2048, L_REF = L_BM + 2048, L_LACC = L_REF + 1024, L_TL = L_LACC + 1024  , L_END = L_TL + 4096;
static_assert(L_END <= RING_BYTES, "attention LDS map");
constexpr int L_EX = 0  , L_HDR = 32768  , L_LEX = 33024  , L_NT = 34048  ;
constexpr float CLAMP = 100.0f;
constexpr float THR = 8.0f;
#define SBAR() __builtin_amdgcn_sched_barrier(0)
__device__ __forceinline__ int crow(int r, int hi) { return (r & 3) + 8 * (r >> 2) + 4 * hi; }
__device__ __forceinline__ void glds16(const void* gsrc, unsigned lds_dst) { unsigned keep;
    asm volatile("s_mov_b32 %0, m0\n\ts_mov_b32 m0, %2\n\ts_nop 0\n\tglobal_load_lds_dwordx4 %1, off\n\ts_mov_b32 m0, %0" : "=&s"(keep) : "v"(gsrc), "s"(lds_dst) : "memory"); }
__device__ __forceinline__ void qkt(f32x16& p0, f32x16& p1, const LAS unsigned char* Kslot, const bf16x8* qr, float cinit, int r32, int hi) {
    const LAS unsigned char* kb = Kslot + hi * 1024 + r32 * 16;
#pragma unroll
    for (int r = 0; r < 16; ++r) { p0[r] = cinit; p1[r] = cinit; }
#pragma unroll
    for (int d0 = 0; d0 < 4; ++d0) {
        const bf16x8 b0 = *(const LAS bf16x8*)(kb + d0 * 2048);
        const bf16x8 b1 = *(const LAS bf16x8*)(kb + d0 * 2048 + 512);
        p0 = __builtin_amdgcn_mfma_f32_32x32x16_bf16(b0, qr[d0], p0, 0, 0, 0); p1 = __builtin_amdgcn_mfma_f32_32x32x16_bf16(b1, qr[d0], p1, 0, 0, 0); }
}
__device__ __forceinline__ void pv(f32x16* o, int vb, bf16x8 pa0, bf16x8 pa1, bf16x8 pa2, bf16x8 pa3) {
#pragma unroll
    for (int d0 = 0; d0 < 2; ++d0) { s16x4 lo[4], hi[4];
#pragma unroll
        for (int ks = 0; ks < 4; ++ks) {
            asm volatile("ds_read_b64_tr_b16 %0,%1 offset:%c2" : "=&v"(lo[ks]) : "v"(vb), "i"(d0 * 4096 + ks * 1024) : "memory");
            asm volatile("ds_read_b64_tr_b16 %0,%1 offset:%c2" : "=&v"(hi[ks]) : "v"(vb), "i"(d0 * 4096 + ks * 1024 + 512) : "memory"); }
        asm volatile("s_waitcnt lgkmcnt(0)" ::: "memory"); SBAR();
#define PK(k) (bf16x8){lo[k][0], lo[k][1], lo[k][2], lo[k][3], hi[k][0], hi[k][1], hi[k][2], hi[k][3]}
        o[d0] = __builtin_amdgcn_mfma_f32_32x32x16_bf16(pa0, PK(0), o[d0], 0, 0, 0);
        o[d0] = __builtin_amdgcn_mfma_f32_32x32x16_bf16(pa1, PK(1), o[d0], 0, 0, 0);
        o[d0] = __builtin_amdgcn_mfma_f32_32x32x16_bf16(pa2, PK(2), o[d0], 0, 0, 0);
        o[d0] = __builtin_amdgcn_mfma_f32_32x32x16_bf16(pa3, PK(3), o[d0], 0, 0, 0);
#undef PK
    }
}
__device__ __forceinline__ float rowmax(const f32x16& p0, const f32x16& p1) {
    float a = fmaxf(fmaxf(p0[0], p0[1]), p1[0]), b = fmaxf(fmaxf(p0[2], p0[3]), p1[1]); a = fmaxf(fmaxf(a, p1[2]), p1[3]);
#pragma unroll
    for (int r = 4; r < 16; r += 4) { a = fmaxf(fmaxf(a, p0[r]), p0[r + 1]); b = fmaxf(fmaxf(b, p0[r + 2]), p0[r + 3]); a = fmaxf(fmaxf(a, p1[r]), p1[r + 1]); b = fmaxf(fmaxf(b, p1[r + 2]), p1[r + 3]); }
    const float m = fmaxf(a, b);
    auto rr = __builtin_amdgcn_permlane32_swap(__float_as_uint(m), __float_as_uint(m), false, false);
    return fmaxf(__uint_as_float(rr[0]), __uint_as_float(rr[1]));
}
__device__ __forceinline__ float halfsum(float v) { auto rr = __builtin_amdgcn_permlane32_swap(__float_as_uint(v), __float_as_uint(v), false, false); return __uint_as_float(rr[0]) + __uint_as_float(rr[1]); }
template <int STEP, unsigned LIMIT>
__device__ __forceinline__ void near_apply(f32x16& p0, f32x16& p1, int dbase, const LAS float* lut) {
#pragma unroll
    for (int r = 0; r < 16; ++r) { const int koff = (r & 3) + 8 * (r >> 2); const int d0 = dbase - STEP * koff, d1 = d0 - STEP * 32;
        const int i0 = min(max(d0, 0), 127), i1 = min(max(d1, 0), 127);
        const float b0 = lut[i0], b1 = lut[i1];
        p0[r] = ((unsigned)d0 < LIMIT) ? p0[r] + b0 : -INFINITY; p1[r] = ((unsigned)d1 < LIMIT) ? p1[r] + b1 : -INFINITY; }
}
template <bool HASO>
__device__ __forceinline__ void sm_update(f32x16& p0, f32x16& p1, float& m, float& l, f32x16* o, LAS float* wsf, int r32, int hi) {
    const float rm = rowmax(p0, p1);
    const bool need = rm > m + THR;
    if (__any(need)) {
        const float mn = need ? rm : m; const float alpha = __builtin_amdgcn_exp2f(m - mn);
        l *= alpha; m = mn;
        if (HASO) { if (hi == 0) wsf[r32] = alpha; LDS_WAIT();
#pragma unroll
            for (int r = 0; r < 16; ++r) { const float f = wsf[crow(r, hi)]; o[0][r] *= f; o[1][r] *= f; } }
    }
    float s = 0.f;
#pragma unroll
    for (int r = 0; r < 16; ++r) { p0[r] = __builtin_amdgcn_exp2f(p0[r] - m); p1[r] = __builtin_amdgcn_exp2f(p1[r] - m); s += p0[r] + p1[r]; }
    l += s;
}
#define ATT_PACK(P0, P1) \
    const bf16x8 pa0 = __builtin_bit_cast(bf16x8, (u32x4){cvtpk(P0[0], P0[1]), cvtpk(P0[2], P0[3]), cvtpk(P0[4], P0[5]), cvtpk(P0[6], P0[7])}); \
    const bf16x8 pa1 = __builtin_bit_cast(bf16x8, (u32x4){cvtpk(P0[8], P0[9]), cvtpk(P0[10], P0[11]), cvtpk(P0[12], P0[13]), cvtpk(P0[14], P0[15])}); \
    const bf16x8 pa2 = __builtin_bit_cast(bf16x8, (u32x4){cvtpk(P1[0], P1[1]), cvtpk(P1[2], P1[3]), cvtpk(P1[4], P1[5]), cvtpk(P1[6], P1[7])}); \
    const bf16x8 pa3 = __builtin_bit_cast(bf16x8, (u32x4){cvtpk(P1[8], P1[9]), cvtpk(P1[10], P1[11]), cvtpk(P1[12], P1[13]), cvtpk(P1[14], P1[15])});
#define ATT_WAITBAR(N) asm volatile("s_waitcnt vmcnt(" #N ") lgkmcnt(0)\n\ts_barrier" ::: "memory")
#define ATT_FILL(V, x) do { _Pragma("unroll") for (int _r = 0; _r < 16; ++_r) V[_r] = (x); } while (0)

__device__ __forceinline__ unsigned rangemask(int k, int a, int b) {
    const int lo = max(a - 32 * k, 0), hi = min(b - 32 * k, 31);
    return (lo > hi) ? 0u : ((0xFFFFFFFFu >> (31 - hi)) & (0xFFFFFFFFu << lo));
}
__device__ __forceinline__ int wave_max_i32(int x) {
    x = max(x, dpp_i<0xB1>(x)); x = max(x, dpp_i<0x4E>(x)); x = max(x, dpp_i<0x141>(x)); x = max(x, dpp_i<0x140>(x));
    return max(max(__builtin_amdgcn_readlane(x, 0), __builtin_amdgcn_readlane(x, 16)), max(__builtin_amdgcn_readlane(x, 32), __builtin_amdgcn_readlane(x, 48)));
}

__device__ __forceinline__ void lds_add_f32(LAS float* p, float v) { (void)__hip_atomic_fetch_add(p, v, __ATOMIC_RELAXED, __HIP_MEMORY_SCOPE_WORKGROUP); }

__device__ __forceinline__ void attn_item(const Frame& F, int qt, int g) {
    const int lane = lane_id(), wid = F.wave, tid = wid * 64 + lane, r32 = lane & 31, hi = lane >> 5;
    const int ql = r32 >> 2, h = r32 & 3, cur = qt, t = 64 * qt + 8 * wid + ql, head = 4 * g + h;
    LAS unsigned char* shm = F.lds;
    const unsigned lds0 = (unsigned)(uintptr_t)shm;
    LAS float* wsf = (LAS float*)(shm + L_WSF) + wid * 64;
    LAS float* SC = (LAS float*)(shm + L_SC);
    LAS float* OACC = (LAS float*)(shm + L_SC);
    LAS bf16* OUTS = (LAS bf16*)(shm + L_OUT);
    LAS float* lutl = (LAS float*)(shm + L_LUT);
    const LAS float* luth = lutl + h * 128;
    LAS unsigned* BM = (LAS unsigned*)(shm + L_BM);
    LAS float* REF = (LAS float*)(shm + L_REF);
    LAS float* LACC = (LAS float*)(shm + L_LACC);
    lutl[tid] = F.LUT()[(4 * g + (tid >> 7)) * 128 + (tid & 127)];
    BM[tid] = 0u;
    bf16x8 qr[4];
    { const bf16* qp = F.Q2() + (size_t)t * 512 + g * 256 + h * 16 + hi * 8;
#pragma unroll
        for (int d0 = 0; d0 < 4; ++d0) qr[d0] = *(const bf16x8*)(qp + d0 * 64); }
    const float b31 = F.LUT()[head * 128 + 127];
    const float gate_c = fsigmoid(bf2f(F.BR()[(size_t)t * 256 + head])), gate_s = fsigmoid(bf2f(F.BR()[(size_t)t * 256 + 8 + head])), gate_w = fsigmoid(bf2f(F.BR()[(size_t)t * 256 + 16 + head]));
    f32x16 o[2], p0, p1;
    const unsigned kdst = lds0 + L_K + wid * 1024, vdst = lds0 + L_V + wid * 1024;
    const int vrow = 16 * (wid & 3) + (lane >> 2), vcol = (wid >> 2) * 32 + (lane & 3) * 8;
    const int vb0 = (int)(lds0 + L_V) + ((lane >> 4) & 1) * 32 + (lane & 3) * 8 + (4 * hi + ((lane & 15) >> 2)) * 64;
#define DMA_K(base, pitch, row0, slot) glds16((base) + (size_t)((row0) + lane) * (pitch) + wid * 8, (unsigned)__builtin_amdgcn_readfirstlane(kdst + (slot)))
#define DMA_V(base, pitch, row0, slot) glds16((base) + (size_t)((row0) + vrow) * (pitch) + vcol, (unsigned)__builtin_amdgcn_readfirstlane(vdst + (slot)))
#define ROT() do { sl_cur = sl_next; sl_next = (sl_next == (NSLOT - 1) * SLOTB) ? 0 : sl_next + SLOTB; } while (0)
    VM_WAIT(); LDS_WAIT(); __syncthreads();

    const bf16* KCg = F.KC() + (size_t)g * 1024 * 64; const bf16* VCg = F.VC() + (size_t)g * 1024 * 64;
    const int nkt = (qt >> 4) + 1;
    const int tminw = 64 * qt + 8 * wid;
    float m = -1e30f, l = 0.f;
    {
        int sl_cur = 0, sl_next = SLOTB;
        DMA_K(KCg, 64, 0, 0);
        for (int kt = 0; kt < nkt; ++kt) {
            if (kt + 1 < nkt) { DMA_K(KCg, 64, 64 * (kt + 1), sl_next); ATT_WAITBAR(1); } else { ATT_WAITBAR(0); }
            const bool far = (tminw - 31 - 16 * (64 * kt + 63)) >= 128;
            if (far) { qkt(p0, p1, shm + L_K + sl_cur, qr, b31, r32, hi); }
            else { qkt(p0, p1, shm + L_K + sl_cur, qr, 0.f, r32, hi); near_apply<16, 0x80000000u>(p0, p1, t - 31 - 16 * (64 * kt + 4 * hi), luth); }
            sm_update<false>(p0, p1, m, l, o, wsf, r32, hi);
            ROT();
        }
        LDS_WAIT(); __builtin_amdgcn_s_barrier();
    }
    {
        const float lt = halfsum(l); const float rl = lt > 0.f ? 1.0f / lt : 0.f;
        ATT_FILL(o[0], 0.f); ATT_FILL(o[1], 0.f);
        float carry = 0.f;
        int sl_cur = 0, sl_next = SLOTB;
        DMA_K(KCg, 64, 0, 0); DMA_V(VCg, 64, 0, 0);
        for (int kt = 0; kt < nkt; ++kt) {
            if (kt + 1 < nkt) { DMA_K(KCg, 64, 64 * (kt + 1), sl_next); DMA_V(VCg, 64, 64 * (kt + 1), sl_next); ATT_WAITBAR(2); } else { ATT_WAITBAR(0); }
            const bool far = (tminw - 31 - 16 * (64 * kt + 63)) >= 128;
            if (far) { qkt(p0, p1, shm + L_K + sl_cur, qr, b31, r32, hi); }
            else { qkt(p0, p1, shm + L_K + sl_cur, qr, 0.f, r32, hi); near_apply<16, 0x80000000u>(p0, p1, t - 31 - 16 * (64 * kt + 4 * hi), luth); }
#pragma unroll
            for (int r = 0; r < 16; ++r) { p0[r] = __builtin_amdgcn_exp2f(p0[r] - m) * rl; p1[r] = __builtin_amdgcn_exp2f(p1[r] - m) * rl; }
            {
                float q4[8], e[8];
#pragma unroll
                for (int i = 0; i < 4; ++i) { q4[i] = (p0[4 * i] + p0[4 * i + 1]) + (p0[4 * i + 2] + p0[4 * i + 3]); e[i] = p0[4 * i + 3];
                                              q4[4 + i] = (p1[4 * i] + p1[4 * i + 1]) + (p1[4 * i + 2] + p1[4 * i + 3]); e[4 + i] = p1[4 * i + 3]; }
                float newcarry = 0.f;
#pragma unroll
                for (int i = 0; i < 8; ++i) { auto rr = __builtin_amdgcn_permlane32_swap(__float_as_uint(e[i]), __float_as_uint(e[i]), false, false);
                    const float elo = __uint_as_float(rr[0]), ehi = __uint_as_float(rr[1]);
                    if (hi) q4[i] += elo; else if (i < 7) q4[i + 1] += ehi;
                    if (i == 7) newcarry = ehi; }
                if (!hi) q4[0] += carry;
                carry = newcarry;
#pragma unroll
                for (int i = 0; i < 8; ++i) { float v = q4[i]; v += dpp_f<0xB1>(v); v += dpp_f<0x4E>(v); q4[i] = v; }
                if (h == 0) {
#pragma unroll
                    for (int i = 0; i < 8; ++i) SC[(8 * wid + ql) * 256 + 16 * kt + 2 * i + hi] = q4[i]; }
            }
            { ATT_PACK(p0, p1); pv(o, vb0 + sl_cur, pa0, pa1, pa2, pa3); }
            ROT();
        }
        LDS_WAIT(); __builtin_amdgcn_s_barrier();
    }

    if (cur >= 16) {
#pragma unroll 1
        for (int qb = 0; qb < 8; qb += 4) {
            int v[4][4];
#pragma unroll
            for (int u = 0; u < 4; ++u) { const LAS float* row = SC + (8 * wid + qb + u) * 256;
#pragma unroll
                for (int i = 0; i < 4; ++i) { const int J = lane + 64 * i; const int x = __float_as_int(row[J]); v[u][i] = (J >= 1 && J <= cur - 2) ? x : -1; } }
#pragma unroll 1
            for (int round = 0; round < 13; ++round) {
                int wm[4];
#pragma unroll
                for (int u = 0; u < 4; ++u) wm[u] = wave_max_i32(max(max(v[u][0], v[u][1]), max(v[u][2], v[u][3])));
#pragma unroll
                for (int u = 0; u < 4; ++u) {
                    const unsigned long long b0 = __ballot(v[u][0] == wm[u]), b1 = __ballot(v[u][1] == wm[u]), b2 = __ballot(v[u][2] == wm[u]), b3 = __ballot(v[u][3] == wm[u]);
                    int J;
                    if (b0) J = __builtin_ctzll(b0); else if (b1) J = 64 + __builtin_ctzll(b1); else if (b2) J = 128 + __builtin_ctzll(b2); else J = 192 + __builtin_ctzll(b3);
                    const bool mine = (lane == (J & 63));
                    if (mine && (J >> 6) == 0) v[u][0] = -1; if (mine && (J >> 6) == 1) v[u][1] = -1; if (mine && (J >> 6) == 2) v[u][2] = -1; if (mine && (J >> 6) == 3) v[u][3] = -1;
                    const int qloc = 8 * wid + qb + u;
                    if (lane == 0) __hip_atomic_fetch_or(BM + 2 * J + (qloc >> 5), 1u << (qloc & 31), __ATOMIC_RELAXED, __HIP_MEMORY_SCOPE_WORKGROUP);
                }
            }
        }
    }
    LDS_WAIT();
    {
        if (hi == 0) wsf[r32] = gate_c; LDS_WAIT();
#pragma unroll
        for (int r = 0; r < 16; ++r) { const float f = wsf[crow(r, hi)]; const int orow = 32 * wid + crow(r, hi); OUTS[orow * 64 + r32] = (bf16)f2bf(o[0][r] * f); OUTS[orow * 64 + 32 + r32] = (bf16)f2bf(o[1][r] * f); }
    }

    const bf16* Kw = F.KV() + 512 + g * 64; const bf16* Vw = F.KV() + 640 + g * 64;
    {
        m = -1e30f; l = 0.f; ATT_FILL(o[0], 0.f); ATT_FILL(o[1], 0.f);
        const int J0 = max(cur - 8, 0);
        int sl_cur = 0, sl_next = SLOTB;
        DMA_K(Kw, 768, 64 * J0, 0); DMA_V(Vw, 768, 64 * J0, 0);
        for (int J = J0; J <= cur; ++J) {
            if (J + 1 <= cur) { DMA_K(Kw, 768, 64 * (J + 1), sl_next); DMA_V(Vw, 768, 64 * (J + 1), sl_next); ATT_WAITBAR(2); } else { ATT_WAITBAR(0); }
            if (J >= cur - 2 || J == cur - 8) { qkt(p0, p1, shm + L_K + sl_cur, qr, 0.f, r32, hi); near_apply<1, 512u>(p0, p1, t - 64 * J - 4 * hi, luth); }
            else { qkt(p0, p1, shm + L_K + sl_cur, qr, b31, r32, hi); }
            sm_update<true>(p0, p1, m, l, o, wsf, r32, hi);
            { ATT_PACK(p0, p1); pv(o, vb0 + sl_cur, pa0, pa1, pa2, pa3); }
            ROT();
        }
        LDS_WAIT(); __builtin_amdgcn_s_barrier();
        const float lt = halfsum(l); const float fw = lt > 0.f ? gate_w / lt : 0.f;
        if (hi == 0) wsf[r32] = fw; LDS_WAIT();
#pragma unroll
        for (int r = 0; r < 16; ++r) { const float f = wsf[crow(r, hi)]; const int orow = 32 * wid + crow(r, hi);
            OUTS[orow * 64 + r32] = (bf16)f2bf(bf2f(OUTS[orow * 64 + r32]) + o[0][r] * f); OUTS[orow * 64 + 32 + r32] = (bf16)f2bf(bf2f(OUTS[orow * 64 + 32 + r32]) + o[1][r] * f); }
    }

    const bf16* Ks = F.KV() + 256 + g * 64; const bf16* Vs = F.KV() + 384 + g * 64;
    {
        m = -1e30f; l = 0.f; ATT_FILL(o[0], 0.f); ATT_FILL(o[1], 0.f);
        const int nA = (cur < 16) ? cur + 1 : 3;
#define JA(i) ((cur < 16) ? (i) : ((i) == 0 ? 0 : cur - 2 + (i)))
        int sl_cur = 0, sl_next = SLOTB;
        DMA_K(Ks, 768, 0, 0); DMA_V(Vs, 768, 0, 0);
        for (int i = 0; i < nA; ++i) {
            const int J = JA(i);
            if (i + 1 < nA) { const int Jn = JA(i + 1); DMA_K(Ks, 768, 64 * Jn, sl_next); DMA_V(Vs, 768, 64 * Jn, sl_next); ATT_WAITBAR(2); } else { ATT_WAITBAR(0); }
            if (J >= cur - 2) { qkt(p0, p1, shm + L_K + sl_cur, qr, 0.f, r32, hi); near_apply<1, 0x80000000u>(p0, p1, t - 64 * J - 4 * hi, luth); }
            else { qkt(p0, p1, shm + L_K + sl_cur, qr, b31, r32, hi); }
            sm_update<true>(p0, p1, m, l, o, wsf, r32, hi);
            { ATT_PACK(p0, p1); pv(o, vb0 + sl_cur, pa0, pa1, pa2, pa3); }
            ROT();
        }
#undef JA
        LDS_WAIT(); __builtin_amdgcn_s_barrier();
        const float lt = halfsum(l);
        if (hi == 0) { REF[32 * wid + r32] = m; LACC[32 * wid + r32] = lt; }
#pragma unroll
        for (int r = 0; r < 16; ++r) { const int orow = 32 * wid + crow(r, hi); OACC[orow * 64 + r32] = o[0][r]; OACC[orow * 64 + 32 + r32] = o[1][r]; }
        LDS_WAIT(); __builtin_amdgcn_s_barrier();
    }

    if (cur >= 16) {
        const bf16* KTg = F.KT() + (size_t)g * 256 * 4096; const bf16* VTg = F.VT() + (size_t)g * 256 * 4096; const bf16* Q2g = F.Q2() + g * 256 + h * 16 + hi * 8;
        LAS unsigned short* TL = (LAS unsigned short*)(shm + L_TL) + wid * 256;
        int ntask = 0;
#pragma unroll 1
        for (int i4 = 0; i4 < 4; ++i4) {
            const int Jl = lane + 64 * i4; int nch = 0;
            if (Jl >= 1 && Jl <= cur - 2) nch = (__popc(BM[2 * Jl]) + __popc(BM[2 * Jl + 1]) + 7) >> 3;
#pragma unroll
            for (int c = 0; c < 8; ++c) { const bool has = (c < nch) && (((Jl + c) & 7) == wid); const unsigned long long bal = __ballot(has);
                if (has) TL[ntask + __popcll(bal & ((1ull << lane) - 1ull))] = (unsigned short)(Jl | (c << 8));
                ntask += __popcll(bal); }
        }
        LDS_WAIT();
        struct Task { bf16x8 kf[8], qg[4]; int J, tq, R, q0, q1, q2, q3; bool valid; };
#define PREP(n, T) do { const int e_ = __builtin_amdgcn_readfirstlane((int)TL[n]); const int J_ = e_ & 255, c_ = e_ >> 8; \
            unsigned long long mask_ = ((unsigned long long)(unsigned)__builtin_amdgcn_readfirstlane((int)BM[2 * J_ + 1]) << 32) | (unsigned)__builtin_amdgcn_readfirstlane((int)BM[2 * J_]); \
            for (int k_ = 0; k_ < 8 * c_; ++k_) mask_ &= mask_ - 1; \
            int qk_[8]; _Pragma("unroll") for (int k_ = 0; k_ < 8; ++k_) { if (mask_) { qk_[k_] = __builtin_ctzll(mask_); mask_ &= mask_ - 1; } else qk_[k_] = -1; } \
            const int qi_ = r32 >> 2; int myq_ = qi_ == 0 ? qk_[0] : qi_ == 1 ? qk_[1] : qi_ == 2 ? qk_[2] : qi_ == 3 ? qk_[3] : qi_ == 4 ? qk_[4] : qi_ == 5 ? qk_[5] : qi_ == 6 ? qk_[6] : qk_[7]; \
            T.valid = myq_ >= 0; if (!T.valid) myq_ = qk_[0]; T.J = J_; T.tq = 64 * qt + myq_; T.R = 4 * myq_ + h; \
            T.q0 = hi ? qk_[1] : qk_[0]; T.q1 = hi ? qk_[3] : qk_[2]; T.q2 = hi ? qk_[5] : qk_[4]; T.q3 = hi ? qk_[7] : qk_[6]; \
            const bf16* qp_ = Q2g + (size_t)T.tq * 512; const bf16* kp_ = KTg + (size_t)J_ * 4096 + hi * 512 + r32 * 8; \
            _Pragma("unroll") for (int d0 = 0; d0 < 4; ++d0) { T.qg[d0] = *(const bf16x8*)(qp_ + d0 * 64); T.kf[2 * d0] = *(const bf16x8*)(kp_ + d0 * 1024); T.kf[2 * d0 + 1] = *(const bf16x8*)(kp_ + d0 * 1024 + 256); } } while (0)
        LAS bf16* EX = (LAS bf16*)(shm + L_EX); LAS int* HDR = (LAS int*)(shm + L_HDR); LAS float* LEX = (LAS float*)(shm + L_LEX); LAS int* NT = (LAS int*)(shm + L_NT);
        if (lane == 0) NT[wid] = ntask;
        LDS_WAIT(); __builtin_amdgcn_s_barrier();
        int nround = 0;
#pragma unroll
        for (int k = 0; k < 8; ++k) nround = max(nround, __builtin_amdgcn_readfirstlane(NT[k]));
        Task tc, tn;
        if (ntask > 0) PREP(0, tc);
#pragma unroll 1
        for (int n = 0; n < nround; ++n) {
            if (n < ntask) {
                bf16x8 vf[8];
                { const bf16* vp = VTg + (size_t)tc.J * 4096 + r32 * 16 + 8 * hi;
#pragma unroll
                    for (int x = 0; x < 8; ++x) vf[x] = *(const bf16x8*)(vp + x * 512); }
                if (n + 1 < ntask) PREP(n + 1, tn);
                const float ref = REF[tc.R];
                const bool nearJ = (tc.J >= cur - 2);
                const float cinit = nearJ ? 0.f : (tc.valid ? b31 - ref : -INFINITY);
#pragma unroll
                for (int r = 0; r < 16; ++r) { p0[r] = cinit; p1[r] = cinit; }
#pragma unroll
                for (int d0 = 0; d0 < 4; ++d0) { p0 = __builtin_amdgcn_mfma_f32_32x32x16_bf16(tc.kf[2 * d0], tc.qg[d0], p0, 0, 0, 0); p1 = __builtin_amdgcn_mfma_f32_32x32x16_bf16(tc.kf[2 * d0 + 1], tc.qg[d0], p1, 0, 0, 0); }
                if (nearJ) { near_apply<1, 0x80000000u>(p0, p1, tc.tq - 64 * tc.J - 4 * hi, luth); const float sub = tc.valid ? ref : INFINITY;
#pragma unroll
                    for (int r = 0; r < 16; ++r) { p0[r] -= sub; p1[r] -= sub; } }
                float ls = 0.f;
#pragma unroll
                for (int r = 0; r < 16; ++r) { p0[r] = __builtin_amdgcn_exp2f(fminf(p0[r], CLAMP)); p1[r] = __builtin_amdgcn_exp2f(fminf(p1[r], CLAMP)); ls += p0[r] + p1[r]; }
                ls = halfsum(ls);
                if (hi == 0) { LEX[wid * 32 + r32] = ls; if (h == 0) HDR[wid * 8 + (r32 >> 2)] = tc.valid ? (tc.R >> 2) : -1; }
                f32x16 ob[2]; ATT_FILL(ob[0], 0.f); ATT_FILL(ob[1], 0.f);
                { ATT_PACK(p0, p1);
#pragma unroll
                    for (int d0 = 0; d0 < 2; ++d0) { ob[d0] = __builtin_amdgcn_mfma_f32_32x32x16_bf16(pa0, vf[d0 * 4 + 0], ob[d0], 0, 0, 0); ob[d0] = __builtin_amdgcn_mfma_f32_32x32x16_bf16(pa1, vf[d0 * 4 + 1], ob[d0], 0, 0, 0);
                                                       ob[d0] = __builtin_amdgcn_mfma_f32_32x32x16_bf16(pa2, vf[d0 * 4 + 2], ob[d0], 0, 0, 0); ob[d0] = __builtin_amdgcn_mfma_f32_32x32x16_bf16(pa3, vf[d0 * 4 + 3], ob[d0], 0, 0, 0); } }
                { LAS bf16* ex = EX + wid * 2048 + hi * 256 + r32;
#pragma unroll
                    for (int r = 0; r < 16; ++r) { ex[((r >> 2) * 8 + (r & 3)) * 64] = (bf16)f2bf(ob[0][r]); ex[((r >> 2) * 8 + (r & 3)) * 64 + 32] = (bf16)f2bf(ob[1][r]); } }
            } else if (lane < 8) HDR[wid * 8 + lane] = -1;
            LDS_WAIT(); __builtin_amdgcn_s_barrier();
            {
                const int hv = HDR[lane]; unsigned long long own = __ballot(hv >= 0 && (hv >> 3) == wid);
                const int hsel = lane >> 4, dc = lane & 15;
                while (own) { const int e = __builtin_ctzll(own); own &= own - 1; const int q = __builtin_amdgcn_readlane(hv, e);
                    const u32x2 xv = *(const LAS u32x2*)(EX + e * 256 + hsel * 64 + 4 * dc);
                    LAS f32x4* ap = (LAS f32x4*)(OACC + (4 * q + hsel) * 64 + 4 * dc); f32x4 a = *ap;
                    a[0] += bflo(xv.x); a[1] += bfhi(xv.x); a[2] += bflo(xv.y); a[3] += bfhi(xv.y); *ap = a;
                    if (dc == 0) LACC[4 * q + hsel] += LEX[e * 4 + hsel]; }
            }
            LDS_WAIT(); __builtin_amdgcn_s_barrier();
            tc = tn;
        }
#undef PREP
    }
    LDS_WAIT(); __builtin_amdgcn_s_barrier();

    {
        if (hi == 0) { const float lt = LACC[32 * wid + r32]; wsf[r32] = lt > 0.f ? gate_s / lt : 0.f; }
        LDS_WAIT();
#pragma unroll
        for (int i = 0; i < 4; ++i) { const int rowl = i * 8 + (lane >> 3), chn = lane & 7, row = 32 * wid + rowl;
            const float f = wsf[rowl];
            const f32x4 a0 = *(const LAS f32x4*)(OACC + row * 64 + chn * 8), a1 = *(const LAS f32x4*)(OACC + row * 64 + chn * 8 + 4);
            const u32x4 ov = *(const LAS u32x4*)(OUTS + row * 64 + chn * 8);
            const size_t tt = (size_t)(64 * qt + 8 * wid + (rowl >> 2)); const int col = (4 * g + (rowl & 3)) * 64 + chn * 8;
            const u32x4 gn = *(const u32x4*)(F.GN() + tt * 512 + col);
            u32x4 w; w.x = pk2((bflo(ov.x) + a0[0] * f) * bflo(gn.x), (bfhi(ov.x) + a0[1] * f) * bfhi(gn.x)); w.y = pk2((bflo(ov.y) + a0[2] * f) * bflo(gn.y), (bfhi(ov.y) + a0[3] * f) * bfhi(gn.y));
            w.z = pk2((bflo(ov.z) + a1[0] * f) * bflo(gn.z), (bfhi(ov.z) + a1[1] * f) * bfhi(gn.z)); w.w = pk2((bflo(ov.w) + a1[2] * f) * bflo(gn.w), (bfhi(ov.w) + a1[3] * f) * bfhi(gn.w));
            *(u32x4*)(F.XN() + tt * 1024 + col) = w; }
        VM_WAIT(); LDS_WAIT(); __syncthreads();
    }
#undef DMA_K
#undef DMA_V
#undef ROT
}
}

__global__ void __launch_bounds__(NWAVES * 64, 2) nsa_lru_fwd(Args args) {
    extern __shared__ __attribute__((aligned(16))) unsigned char lds[];
    Frame F;
    F.lds = (LAS unsigned char*)lds;
    F.MISC = (volatile LAS unsigned*)(F.lds + MISC_OFF);
    F.wave = __builtin_amdgcn_readfirstlane((int)(threadIdx.x >> 6));
    F.G = gridDim.x; { const int bx = blockIdx.x; F.vcu = (F.G % 8 == 0) ? (bx % 8) * (F.G / 8) + bx / 8 : bx; }
    F.ws = args.ws;
    gu32* ctl = (gu32*)(args.ws + WS_CTL);
    for (int u = F.wave * 64 + lane_id(); u < (LDS_BYTES - LDSCTL_OFF) / 4; u += NWAVES * 64) ((LAS unsigned*)(F.lds + LDSCTL_OFF))[u] = 0u;
    __syncthreads();
    const int bli = (N_LAUNCHES == PER_PHASE) ? 0 : args.li;
    XcdBarrier bar; bar.bar = (unsigned*)(ctl + CW_BAR) + bli * XCD_BAR_WORDS; bar.x = 0; bar.st = nullptr;
    if (N_LAUNCHES != PER_PHASE) bar = xcd_barrier_post((unsigned*)(ctl + CW_BAR) + bli * XCD_BAR_WORDS, F.MISC + 8);
#define GRID_BAR() do { if (N_LAUNCHES != PER_PHASE) xcd_barrier(bar); } while (0)
    const int lo = args.ph_lo, hi = args.ph_hi;
#define IN(k) (lo <= (k) && (k) < hi)
#define BOTH(k) (IN(k) && IN((k) + 1))

    if (IN(0)) { p0_prologue(F, args); if (BOTH(0)) GRID_BAR(); }

    if (IN(1)) {
        pg8::Gemm g{F.XN(), F.WinT(), F.XN(), F.WinT(), 1024, 1024, 1024}; pg8::StaticOrder S; S.init(SEQ, NPROJ, F.G, (int)blockIdx.x);
        pg8::EpiProj E{F.Q(), F.KV(), F.U(), F.BR(), F.GN(), F.GL(), F.MG()};
        pg8::gemm_phase<pg8::EpiProj, pg8::StaticOrder, true>(F.lds, g, S, E, F.wave);
        if (BOTH(1)) GRID_BAR();
    }

    if (IN(2)) {
        for (int i = F.vcu; i < 256; i += F.G) {
            lru_tile<false>(F, args, i);
            if (!args.pad) qk_norm_tile(F, args, i);
            vt_tile(F, i);
            __syncthreads();
            compress_item(F, args, i & 1, (i >> 1) & 1, i >> 2);
        }
        if (BOTH(2)) GRID_BAR();
    }

    if (IN(3)) {
        for (int i = F.vcu; i < 256; i += F.G) { lru_tile<true>(F, args, i); }
        __syncthreads();
#pragma unroll 1
        for (int it = 2 * F.vcu; it < 512; it += 2 * F.G) {
#pragma unroll 1
            for (int j = 0; j < 2; ++j) { const int i = it >> 1; att::attn_item(F, j ? i : 255 - i, j ? 0 : 1); }
        }
        if (BOTH(3)) GRID_BAR();
    }

    if (IN(4)) {
        pg8::Gemm g{F.XN(), F.WaT(), F.XN() + 512, F.WbT(), 1024, 512, 512}; pg8::DualOrder S; S.init(SEQ, 1024, F.G, (int)blockIdx.x);
        pg8::EpiMerge E{F.MB(), F.MG()};
        pg8::gemm_phase<pg8::EpiMerge, pg8::DualOrder, true>(F.lds, g, S, E, F.wave);
        if (BOTH(4)) GRID_BAR();
    }

    if (IN(5)) {
        pg8::Gemm g{F.MB(), F.WoutT(), F.MB(), F.WoutT(), 1024, 1024, 1024}; pg8::StaticOrder S; S.init(SEQ, 1024, F.G, (int)blockIdx.x);
        pg8::EpiOut E{args.in[0], args.out};
        pg8::gemm_phase<pg8::EpiOut, pg8::StaticOrder, true>(F.lds, g, S, E, F.wave);
    }
#undef IN
#undef BOTH
}

extern "C" void kernel_launch(void* const* d_in, const int* in_sizes, int n_in, void* d_out, int out_size, void* d_ws, size_t ws_size, hipStream_t stream) {
    static int grid = 0;
    if (grid == 0) {
        if (n_in != 20 || in_sizes[0] != SEQ * DM || out_size != SEQ * DM || ws_size < WS_END) { fprintf(stderr, "kernel_launch: unexpected shapes (n_in %d, in0 %d, out %d, ws %zu)\n", n_in, n_in > 0 ? in_sizes[0] : -1, out_size, ws_size); grid = -1; return; }
        int dev = 0, cus = 0, per_cu = 0;
        if (hipGetDevice(&dev) != hipSuccess || hipDeviceGetAttribute(&cus, hipDeviceAttributeMultiprocessorCount, dev) != hipSuccess) { grid = -1; return; }
        if (hipFuncSetAttribute((const void*)nsa_lru_fwd, hipFuncAttributeMaxDynamicSharedMemorySize, LDS_BYTES) != hipSuccess) { fprintf(stderr, "kernel_launch: hipFuncSetAttribute failed\n"); grid = -1; return; }
        if (hipOccupancyMaxActiveBlocksPerMultiprocessor(&per_cu, (const void*)nsa_lru_fwd, NWAVES * 64, LDS_BYTES) != hipSuccess || per_cu < 1)
            fprintf(stderr, "kernel_launch: occupancy query reports %d workgroups per CU\n", per_cu);
        (void)hipGetLastError();
        grid = cus;
    }
    if (grid < 0) return;
    if (hipMemsetAsync((char*)d_ws + WS_CTL, 0, CTL_ZERO_BYTES, stream) != hipSuccess) { fprintf(stderr, "kernel_launch: hipMemsetAsync failed\n"); return; }
    Args a{};
    for (int i = 0; i < 20; ++i) a.in[i] = (const float*)d_in[i];
    a.out = (float*)d_out; a.ws = (unsigned char*)d_ws;
    const int nl = (PROBE_DUP >= 0) ? 2 : N_LAUNCHES;
    for (int li = 0; li < nl; ++li) {
        if (PROBE_DUP >= 0) { a.ph_lo = li ? PROBE_DUP : 0; a.ph_hi = li ? PER_PHASE : PROBE_DUP + 1; a.li = li; a.pad = (li && PROBE_DUP == 2) ? 1 : 0; }
        else { a.ph_lo = (N_LAUNCHES == PER_PHASE) ? li : 0; a.ph_hi = (N_LAUNCHES == PER_PHASE) ? li + 1 : PER_PHASE; a.li = li; }
        hipLaunchKernelGGL(nsa_lru_fwd, dim3(grid), dim3(NWAVES * 64), LDS_BYTES, stream, a);
        const hipError_t le = hipPeekAtLastError();
        if (le != hipSuccess) { fprintf(stderr, "kernel_launch: launch %d failed: %s\n", li, hipGetErrorName(le)); break; }
    }
}
```

```cpp
#include <hip/hip_runtime.h>
#include <cstdio>
#include <cstdint>

#ifndef PROBE_DUP
#define PROBE_DUP -1
#endif
#ifndef MK_N_LAUNCHES
#define MK_N_LAUNCHES 1
#endif

#define GAS __attribute__((address_space(1)))
#define LAS __attribute__((address_space(3)))
typedef unsigned short bf16;
typedef short bf16x8 __attribute__((ext_vector_type(8)));
typedef short s16x4 __attribute__((ext_vector_type(4)));
typedef float f32x4 __attribute__((ext_vector_type(4)));
typedef float f32x16 __attribute__((ext_vector_type(16)));
typedef unsigned u32x4 __attribute__((ext_vector_type(4)));
typedef unsigned u32x2 __attribute__((ext_vector_type(2)));
typedef GAS unsigned gu32;

constexpr int SEQ = 16384, DM = 1024;
constexpr int NPROJ = 5120;
constexpr float LOG2E = 1.4426950408889634f;
constexpr float RMS_EPS = 1e-6f;

__device__ __forceinline__ unsigned f2bf(float f) { unsigned u = __builtin_bit_cast(unsigned, f); return (u + 0x7fffu + ((u >> 16) & 1u)) >> 16; }
__device__ __forceinline__ unsigned pk2(float lo, float hi) { return f2bf(lo) | (f2bf(hi) << 16); }
__device__ __forceinline__ float bf2f(unsigned h) { return __builtin_bit_cast(float, h << 16); }
__device__ __forceinline__ float bflo(unsigned w) { return __builtin_bit_cast(float, w << 16); }
__device__ __forceinline__ float bfhi(unsigned w) { return __builtin_bit_cast(float, w & 0xffff0000u); }
typedef float f32x2_t __attribute__((ext_vector_type(2))); typedef __bf16 bf16x2_t __attribute__((ext_vector_type(2)));
__device__ __forceinline__ unsigned cvtpk(float lo, float hi) { f32x2_t v = {lo, hi}; bf16x2_t b = __builtin_convertvector(v, bf16x2_t); return __builtin_bit_cast(unsigned, b); }
__device__ __forceinline__ float fsigmoid(float v) { return __builtin_amdgcn_rcpf(1.0f + __builtin_amdgcn_exp2f(-v * LOG2E)); }
template <int CTRL> __device__ __forceinline__ float dpp_f(float v) { return __builtin_bit_cast(float, __builtin_amdgcn_update_dpp(0, __builtin_bit_cast(int, v), CTRL, 0xf, 0xf, true)); }
template <int CTRL> __device__ __forceinline__ int dpp_i(int v) { return __builtin_amdgcn_update_dpp(v, v, CTRL, 0xf, 0xf, false); }
__device__ __forceinline__ int lane_id() { int l = (int)__builtin_amdgcn_mbcnt_hi(~0u, __builtin_amdgcn_mbcnt_lo(~0u, 0u)); asm volatile("" : "+v"(l)); return l; }
__device__ __forceinline__ float wave_sum(float v) {
#pragma unroll
    for (int o = 1; o < 64; o <<= 1) v += __shfl_xor(v, o);
    return v;
}

namespace pg8 {
#define PG8_LAS __attribute__((address_space(3)))
typedef unsigned short bf16_t;
constexpr int BM = 256, BK = 64, HALF = 128, HTB = HALF * BK * 2, STAGE_BYTES = 8 * HTB, NXCD = 8, WGM = 8;
__host__ __device__ __forceinline__ int lds_byte(int r, int c) { const int st = (r >> 4) * 2 + (c >> 5), rr = r & 15, cc = c & 31, ob = rr * 64 + cc * 2; return st * 1024 + (ob ^ (((ob >> 9) & 1) << 5)); }
__host__ __device__ __forceinline__ void stage_rc(int b, int& R, int& C) { const int st = b / 1024, sb = b % 1024, swz = sb ^ (((sb >> 9) & 1) << 5); R = (st >> 1) * 16 + swz / 64; C = (st & 1) * 32 + (swz % 64) / 2; }
__host__ __device__ __forceinline__ int perm32(int rho) { const int n = rho >> 4, i = rho & 15; return 8 * (i >> 2) + 4 * n + (i & 3); }

struct Unit { int pm, pn, part; };
struct Gemm { const bf16_t* A; const bf16_t* Bt; const bf16_t* A2; const bf16_t* Bt2; int lda, ldb, K; };

struct StaticOrder {
    int nM, nN, nwg, G, c;
    __host__ __device__ void init(int M, int N, int G_, int c_) { nM = M / BM; nN = N / BM; nwg = nM * nN; G = G_; c = c_; }
    __host__ __device__ bool tile(long L, Unit& u) const {
        if (L >= nwg) return false;
        int wgid = (int)L; { const int q = nwg / NXCD, r = nwg % NXCD, xcd = wgid % NXCD, off = wgid / NXCD; wgid = (xcd < r ? xcd * (q + 1) : r * (q + 1) + (xcd - r) * q) + off; }
        const int nig = WGM * nN, gid = wgid / nig, fm = gid * WGM, gsz = (nM - fm) < WGM ? (nM - fm) : WGM;
        u.pm = fm + ((wgid % nig) % gsz); u.pn = (wgid % nig) / gsz; u.part = 0; return true;
    }
    __host__ __device__ bool next(int i, Unit& u) const { return tile((long)i * G + c, u); }
};
struct DualOrder : StaticOrder {
    __host__ __device__ bool next(int i, Unit& u) const { if (!tile((long)(i >> 1) * G + c, u)) return false; u.part = i & 1; return true; }
};

__device__ __forceinline__ unsigned cvt_pk_bf16(float lo, float hi) { unsigned r; asm volatile("v_cvt_pk_bf16_f32 %0, %1, %2" : "=v"(r) : "v"(lo), "v"(hi)); return r; }

struct EpiProj {
    static constexpr bool PERM = true;
    bf16_t *Q, *KV, *U, *BR, *GN, *GL, *MG;
    __device__ __forceinline__ void operator()(const f32x4 (&acc)[2][2][4][2], const Unit& u, int wr, int wc, int fr, int fq) const {
        const int pn = u.pn; bf16_t* base; int ldc, colt, act = 0;
        if (pn < 2) { base = Q; ldc = 512; colt = pn * 256; }
        else if (pn < 5) { base = KV; ldc = 768; colt = (pn - 2) * 256; }
        else if (pn < 7) { base = U; ldc = 512; colt = (pn - 5) * 256; }
        else if (pn < 8) { base = BR; ldc = 256; colt = 0; }
        else if (pn < 10) { base = GN; ldc = 512; colt = (pn - 8) * 256; act = 1; }
        else if (pn < 12) { base = GL; ldc = 512; colt = (pn - 10) * 256; act = 1; }
        else { base = MG; ldc = 2048; colt = (pn - 12) * 256; act = 2; }
        const int row0 = u.pm * BM + wr * 64 + fr, col0 = colt + wc * 32 + 8 * fq;
#pragma unroll
        for (int ai = 0; ai < 2; ++ai)
#pragma unroll
            for (int m = 0; m < 4; ++m) { bf16_t* rowp = base + (size_t)(row0 + ai * HALF + m * 16) * ldc + col0;
#pragma unroll
                for (int bj = 0; bj < 2; ++bj) { f32x4 v0 = acc[ai][bj][m][0], v1 = acc[ai][bj][m][1];
                    if (act) {
#pragma unroll
                        for (int e = 0; e < 4; ++e) { const float s0 = fsigmoid(v0[e]), s1 = fsigmoid(v1[e]); v0[e] = (act == 1) ? v0[e] * s0 : s0; v1[e] = (act == 1) ? v1[e] * s1 : s1; } }
                    u32x4 w; w.x = cvt_pk_bf16(v0[0], v0[1]); w.y = cvt_pk_bf16(v0[2], v0[3]); w.z = cvt_pk_bf16(v1[0], v1[1]); w.w = cvt_pk_bf16(v1[2], v1[3]);
                    *(u32x4*)(rowp + bj * HALF) = w; } }
    }
};
struct EpiMerge {
    static constexpr bool PERM = true;
    bf16_t* Mb; const bf16_t* MG;
    __device__ __forceinline__ void operator()(const f32x4 (&acc)[2][2][4][2], const Unit& u, int wr, int wc, int fr, int fq) const {
        const int row0 = u.pm * BM + wr * 64 + fr, col0 = u.pn * BM + wc * 32 + 8 * fq;
#pragma unroll
        for (int ai = 0; ai < 2; ++ai)
#pragma unroll
            for (int m = 0; m < 4; ++m) { const size_t r = (size_t)(row0 + ai * HALF + m * 16);
#pragma unroll
                for (int bj = 0; bj < 2; ++bj) { const f32x4 v0 = acc[ai][bj][m][0], v1 = acc[ai][bj][m][1];
                    const u32x4 gw = *(const u32x4*)(MG + r * 2048 + u.part * 1024 + col0 + bj * HALF);
                    float o[8] = {v0[0] * bflo(gw.x), v0[1] * bfhi(gw.x), v0[2] * bflo(gw.y), v0[3] * bfhi(gw.y), v1[0] * bflo(gw.z), v1[1] * bfhi(gw.z), v1[2] * bflo(gw.w), v1[3] * bfhi(gw.w)};
                    bf16_t* dst = Mb + r * 1024 + col0 + bj * HALF;
                    if (u.part) { const u32x4 pw = *(const u32x4*)dst;
                        o[0] += bflo(pw.x); o[1] += bfhi(pw.x); o[2] += bflo(pw.y); o[3] += bfhi(pw.y); o[4] += bflo(pw.z); o[5] += bfhi(pw.z); o[6] += bflo(pw.w); o[7] += bfhi(pw.w); }
                    u32x4 w; w.x = cvt_pk_bf16(o[0], o[1]); w.y = cvt_pk_bf16(o[2], o[3]); w.z = cvt_pk_bf16(o[4], o[5]); w.w = cvt_pk_bf16(o[6], o[7]);
                    *(u32x4*)dst = w; } }
    }
};
struct EpiOut {
    static constexpr bool PERM = false;
    const float* X; float* O;
    __device__ __forceinline__ void operator()(const f32x4 (&acc)[2][2][4][2], const Unit& u, int wr, int wc, int fr, int fq) const {
        const int row0 = u.pm * BM + wr * 64 + fr, col0 = u.pn * BM + wc * 32 + 4 * fq;
#pragma unroll
        for (int ai = 0; ai < 2; ++ai)
#pragma unroll
            for (int m = 0; m < 4; ++m) { const size_t off = (size_t)(row0 + ai * HALF + m * 16) * 1024 + col0;
#pragma unroll
                for (int bj = 0; bj < 2; ++bj)
#pragma unroll
                    for (int n = 0; n < 2; ++n) { const f32x4 xv = *(const f32x4*)(X + off + bj * HALF + n * 16); *(f32x4*)(O + off + bj * HALF + n * 16) = xv + acc[ai][bj][m][n]; } }
    }
};

template <class Epi, class Sched, bool ALIGN_EPI>
__device__ __forceinline__ void gemm_phase(PG8_LAS unsigned char* lds, const Gemm g, const Sched& S, const Epi& E, int wid) {
    const int lane = lane_id(), tid = wid * 64 + lane, wr = wid >> 2, wc = wid & 3, fr = lane & 15, fq = lane >> 4;
    const int K = g.K, nt = K / BK;
    unsigned voffA[2], voffB[2];
#pragma unroll
    for (int i = 0; i < 2; ++i) { int R, C; stage_rc(tid * 16 + i * 8192, R, C); const int Rb = Epi::PERM ? ((R & ~31) + perm32(R & 31)) : R;
        voffA[i] = (unsigned)(R * g.lda + C) * 2u; voffB[i] = (unsigned)(Rb * g.ldb + C) * 2u; }
    const size_t kstep = (size_t)(BK * 2);
    const size_t hstepA = (size_t)HALF * g.lda * 2, hstepB = (size_t)HALF * g.ldb * 2;
    const size_t tstepA = 2 * hstepA, tstepB = 2 * hstepB;
    const unsigned ldsw = (unsigned)wid * 1024u;
    const int aoff = lds_byte(wr * 64 + fr, fq * 8), boff = lds_byte(wc * 32 + fr, fq * 8);
#define PG8_SA(b, h) (((b) * 2 + (h)) * HTB)
#define PG8_SB(b, h) ((4 + (b) * 2 + (h)) * HTB)
#define PG8_STAGE(bufoff, gbase, voff) do { _Pragma("unroll") for (int _i = 0; _i < 2; ++_i) \
        __builtin_amdgcn_global_load_lds((const unsigned*)((const char*)(gbase) + (voff)[_i]), (PG8_LAS unsigned*)(lds + (bufoff) + ldsw + _i * 8192), 16, 0, 0); } while (0)
#define PG8_LDA(dst, b, h) do { _Pragma("unroll") for (int m = 0; m < 4; ++m) _Pragma("unroll") for (int k = 0; k < 2; ++k) dst[m][k] = *(const PG8_LAS bf16x8*)(lds + PG8_SA(b, h) + aoff + m * 2048 + k * 1024); } while (0)
#define PG8_LDB(dst, b, h) do { _Pragma("unroll") for (int n = 0; n < 2; ++n) _Pragma("unroll") for (int k = 0; k < 2; ++k) dst[n][k] = *(const PG8_LAS bf16x8*)(lds + PG8_SB(b, h) + boff + n * 2048 + k * 1024); } while (0)
#define PG8_MMA(ai, bj, At, Bt) do { __builtin_amdgcn_s_setprio(1); _Pragma("unroll") for (int m = 0; m < 4; ++m) _Pragma("unroll") for (int n = 0; n < 2; ++n) _Pragma("unroll") for (int k = 0; k < 2; ++k) \
        acc[ai][bj][m][n] = __builtin_amdgcn_mfma_f32_16x16x32_bf16(Bt[n][k], At[m][k], acc[ai][bj][m][n], 0, 0, 0); __builtin_amdgcn_s_setprio(0); } while (0)
#define PG8_WAIT_V(n) asm volatile("s_waitcnt vmcnt(" #n ")" ::: "memory")
#define PG8_WAIT_L(n) asm volatile("s_waitcnt lgkmcnt(" #n ")" ::: "memory")
#define PG8_BAR __builtin_amdgcn_s_barrier()
#define PG8_SCHED __builtin_amdgcn_sched_barrier(0)
#define PG8_UA(u) ((const char*)((u).part ? g.A2 : g.A) + (size_t)(u).pm * tstepA)
#define PG8_UB(u) ((const char*)((u).part ? g.Bt2 : g.Bt) + (size_t)(u).pn * tstepB)
    Unit cur, nxt; int ui = 0;
    if (!S.next(0, cur)) return;
    f32x4 acc[2][2][4][2];
#pragma unroll
    for (int a = 0; a < 2; ++a)
#pragma unroll
        for (int b = 0; b < 2; ++b)
#pragma unroll
            for (int m = 0; m < 4; ++m)
#pragma unroll
                for (int n = 0; n < 2; ++n) acc[a][b][m][n] = (f32x4){0.f, 0.f, 0.f, 0.f};
    bf16x8 At[4][2], B0[2][2], B1[2][2];
    const char* cA = PG8_UA(cur); const char* cB = PG8_UB(cur);
    PG8_STAGE(PG8_SB(0, 0), cB, voffB); PG8_STAGE(PG8_SB(0, 1), cB + hstepB, voffB); PG8_STAGE(PG8_SA(0, 0), cA, voffA); PG8_STAGE(PG8_SA(0, 1), cA + hstepA, voffA);
    if (wr == 1) PG8_BAR;
    PG8_WAIT_V(2); PG8_BAR;
    PG8_STAGE(PG8_SB(1, 0), cB + kstep, voffB); PG8_STAGE(PG8_SA(1, 0), cA + kstep, voffA); PG8_STAGE(PG8_SB(1, 1), cB + hstepB + kstep, voffB);
    PG8_WAIT_V(6); PG8_BAR;
    for (;;) {
        const bool has_next = S.next(ui + 1, nxt);
        const char* nA = has_next ? PG8_UA(nxt) : cA; const char* nB = has_next ? PG8_UB(nxt) : cB;
        for (int t = 0; t < nt; t += 2) {
            const bool last = (t == nt - 2);
            const char* a1 = cA + (size_t)(t + 1) * kstep;
            const char* a2 = last ? nA : cA + (size_t)(t + 2) * kstep; const char* b2 = last ? nB : cB + (size_t)(t + 2) * kstep;
            const char* a3 = a2 + kstep; const char* b3 = b2 + kstep;
            PG8_LDB(B0, 0, 0); PG8_LDB(B1, 0, 1); PG8_SCHED; PG8_LDA(At, 0, 0); PG8_STAGE(PG8_SA(1, 1), a1 + hstepA, voffA);
            PG8_WAIT_V(8); PG8_WAIT_L(0); PG8_BAR; PG8_MMA(0, 0, At, B0); PG8_MMA(0, 1, At, B1); PG8_BAR; PG8_SCHED;
            PG8_LDA(At, 0, 1); PG8_STAGE(PG8_SB(0, 0), b2, voffB); PG8_STAGE(PG8_SB(0, 1), b2 + hstepB, voffB); PG8_STAGE(PG8_SA(0, 0), a2, voffA);
            PG8_WAIT_V(8); PG8_WAIT_L(0); PG8_BAR; PG8_MMA(1, 0, At, B0); PG8_MMA(1, 1, At, B1); PG8_BAR; PG8_SCHED;
            PG8_LDB(B0, 1, 0); PG8_LDB(B1, 1, 1); PG8_SCHED; PG8_LDA(At, 1, 0); PG8_STAGE(PG8_SA(0, 1), a2 + hstepA, voffA);
            PG8_WAIT_V(8); PG8_WAIT_L(0); PG8_BAR; PG8_MMA(0, 0, At, B0); PG8_MMA(0, 1, At, B1); PG8_BAR; PG8_SCHED;
            PG8_LDA(At, 1, 1); PG8_STAGE(PG8_SB(1, 0), b3, voffB); PG8_STAGE(PG8_SB(1, 1), b3 + hstepB, voffB); PG8_STAGE(PG8_SA(1, 0), a3, voffA);
            PG8_WAIT_V(8); PG8_WAIT_L(0); PG8_BAR; PG8_MMA(1, 0, At, B0); PG8_MMA(1, 1, At, B1); PG8_BAR; PG8_SCHED;
        }
        if constexpr (ALIGN_EPI) { if (wr == 0) PG8_BAR; }
        E(acc, cur, wr, wc, fr, fq);
        if (!has_next) break;
#pragma unroll
        for (int a = 0; a < 2; ++a)
#pragma unroll
            for (int b = 0; b < 2; ++b)
#pragma unroll
                for (int m = 0; m < 4; ++m)
#pragma unroll
                    for (int n = 0; n < 2; ++n) acc[a][b][m][n] = (f32x4){0.f, 0.f, 0.f, 0.f};
        cur = nxt; cA = nA; cB = nB; ++ui;
        if constexpr (ALIGN_EPI) { if (wr == 1) PG8_BAR; }
    }
    PG8_WAIT_V(0);
    if constexpr (!ALIGN_EPI) { if (wr == 0) PG8_BAR; }
    PG8_BAR;
#undef PG8_SA
#undef PG8_SB
#undef PG8_STAGE
#undef PG8_LDA
#undef PG8_LDB
#undef PG8_MMA
#undef PG8_WAIT_V
#undef PG8_WAIT_L
#undef PG8_BAR
#undef PG8_SCHED
#undef PG8_UA
#undef PG8_UB
}
}

constexpr int NWAVES = 8;
constexpr int N_LAUNCHES = MK_N_LAUNCHES;
constexpr int PER_PHASE = 6;
constexpr size_t MiB = 1u << 20;
constexpr size_t WS_CTL = 0, CTL_ZERO_BYTES = 1 * MiB;
constexpr size_t WS_WIN = 1 * MiB;
constexpr size_t WS_WA = 11 * MiB;
constexpr size_t WS_WB = 12 * MiB;
constexpr size_t WS_WOUT = 13 * MiB;
constexpr size_t WS_W1T = 15 * MiB;
constexpr size_t WS_SMALL = 17 * MiB;
constexpr size_t WS_SUM = 18 * MiB;
constexpr size_t WS_KC = 19 * MiB;
constexpr size_t WS_XN = 20 * MiB;
constexpr size_t WS_Q = 52 * MiB;
constexpr size_t WS_KV = 68 * MiB;
constexpr size_t WS_MB = 52 * MiB;
constexpr size_t WS_U = 92 * MiB;
constexpr size_t WS_BR = 108 * MiB;
constexpr size_t WS_GN = 116 * MiB;
constexpr size_t WS_GL = 132 * MiB;
constexpr size_t WS_MG = 148 * MiB;
constexpr size_t WS_VT = 212 * MiB;
constexpr size_t WS_KT = 216 * MiB;
constexpr size_t WS_Q2 = 220 * MiB;
constexpr size_t WS_END = 236 * MiB;
constexpr size_t SM_W2T = 0;
constexpr size_t SM_LWA = 65536;
constexpr size_t SM_LWX = 131072;
constexpr size_t SM_C1 = 262144;
constexpr size_t SM_LUT = 200704;
constexpr int CW_BAR = 4096;

constexpr int RING_BYTES = 159744;
constexpr int LDSCTL_OFF = RING_BYTES, MISC_OFF = LDSCTL_OFF + 320;
constexpr int LDS_BYTES = 163840;

#define RLX_AGENT __ATOMIC_RELAXED, __HIP_MEMORY_SCOPE_AGENT
#define LDS_WAIT() asm volatile("s_waitcnt lgkmcnt(0)" ::: "memory")
#define VM_WAIT() asm volatile("s_waitcnt vmcnt(0)" ::: "memory")

#define XB_TMO      128
#define XB_XCNT(j)  (256  + 64 * (j))
#define XB_XSUB(j)  (1280 + 64 * (j))
#define XB_XGEN(j)  (2304 + 64 * (j))
#define XB_TOP      3328
#define XB_TOPGEN   3392
#define XCD_BAR_WORDS 3456
#define XB_SPIN_CAP (1u << 18)
__device__ __forceinline__ unsigned xb_ld(unsigned* p)              { return __hip_atomic_load(p, __ATOMIC_RELAXED, __HIP_MEMORY_SCOPE_AGENT); }
__device__ __forceinline__ unsigned xb_add(unsigned* p, unsigned v) { return __hip_atomic_fetch_add(p, v, __ATOMIC_RELAXED, __HIP_MEMORY_SCOPE_AGENT); }
__device__ __forceinline__ unsigned xb_xcc_id() { return (unsigned)__builtin_amdgcn_s_getreg((3 << 11) | 20) & 0xFu; }
#define XB_SPIN(cond, bar) do { unsigned _sp = 0; while (cond) { __builtin_amdgcn_s_sleep(1); \
    if ((++_sp & 255u) == 0u) { if (xb_ld(&(bar)[XB_TMO])) break; if (_sp > XB_SPIN_CAP) { atomicAdd(&(bar)[XB_TMO], 1u); break; } } } } while (0)
struct XcdBarrier { unsigned* bar; unsigned x; volatile LAS unsigned* st; };
__device__ __forceinline__ XcdBarrier xcd_barrier_post(unsigned* bar, volatile LAS unsigned* st) {
    XcdBarrier b; b.bar = bar; b.x = xb_xcc_id(); b.st = st;
    if (threadIdx.x == 0) (void)xb_add(&bar[XB_XCNT(b.x)], 1u);
    return b;
}
__device__ __forceinline__ void xcd_barrier_complete(unsigned* bar, unsigned x, unsigned& nloc, unsigned& nx) {
    const unsigned G = gridDim.x * gridDim.y * gridDim.z;
    unsigned sum, cnt, mine, sp = 0u;
    for (;;) {
        sum = 0u; cnt = 0u; mine = 0u;
#pragma unroll
        for (unsigned j = 0; j < 16; ++j) { const unsigned c = xb_ld(&bar[XB_XCNT(j)]); sum += c; cnt += (c > 0u) ? 1u : 0u; mine = (j == x) ? c : mine; }
        if (sum == G) break;
        __builtin_amdgcn_s_sleep(1);
        if ((++sp & 255u) == 0u) { if (xb_ld(&bar[XB_TMO])) break; if (sp > XB_SPIN_CAP) { atomicAdd(&bar[XB_TMO], 1u); break; } }
    }
    nloc = mine > 0u ? mine : 1u; nx = cnt > 0u ? cnt : 1u;
}
__device__ __forceinline__ void xcd_barrier(const XcdBarrier& b) {
    asm volatile("s_waitcnt vmcnt(0)" ::: "memory");
    __syncthreads();
    if (threadIdx.x == 0) {
        unsigned* bar = b.bar;
        __builtin_amdgcn_s_waitcnt(0);
        unsigned nloc = b.st[0], nx = b.st[1];
        if (nloc == 0u) { xcd_barrier_complete(bar, b.x, nloc, nx); b.st[0] = nloc; b.st[1] = nx; }
        const unsigned old = xb_add(&bar[XB_XSUB(b.x)], 1u);
        const unsigned gen = old / nloc;
        if (old + 1u == (gen + 1u) * nloc) {
            __builtin_amdgcn_fence(__ATOMIC_RELEASE, "agent");
            asm volatile("s_waitcnt vmcnt(0)" ::: "memory");
            const unsigned og = xb_add(&bar[XB_TOP], 1u);
            const unsigned tg = og / nx;
            if (og + 1u == (tg + 1u) * nx) xb_add(&bar[XB_TOPGEN], 1u);
            else XB_SPIN(xb_ld(&bar[XB_TOPGEN]) == tg, bar);
            __builtin_amdgcn_fence(__ATOMIC_ACQUIRE, "agent");
            xb_add(&bar[XB_XGEN(b.x)], 1u);
            asm volatile("s_waitcnt vmcnt(0)" ::: "memory");
        } else {
            XB_SPIN(xb_ld(&bar[XB_XGEN(b.x)]) == gen, bar);
            __builtin_amdgcn_fence(__ATOMIC_ACQUIRE, "agent");
            asm volatile("s_waitcnt vmcnt(0)" ::: "memory");
        }
    }
    __syncthreads();
}

struct Args { const float* in[20]; float* out; unsigned char* ws; int ph_lo, ph_hi, li, pad; };
struct Frame {
    LAS unsigned char* lds;
    volatile LAS unsigned* MISC;
    int wave;
    int vcu, G;
    unsigned char* ws;
#define WSP(name, T, off) __device__ __forceinline__ T* name() const { return (T*)(ws + (off)); }
    WSP(WinT, bf16, WS_WIN) WSP(WaT, bf16, WS_WA) WSP(WbT, bf16, WS_WB) WSP(WoutT, bf16, WS_WOUT) WSP(W1T, bf16, WS_W1T)
    WSP(W2T, bf16, WS_SMALL + SM_W2T) WSP(LWA, bf16, WS_SMALL + SM_LWA) WSP(LWX, bf16, WS_SMALL + SM_LWX)
    WSP(C1, float, WS_SMALL + SM_C1) WSP(LUT, float, WS_SMALL + SM_LUT) WSP(SUMA, float, WS_SUM) WSP(SUMB, float, WS_SUM + 524288)
    WSP(KC, bf16, WS_KC) WSP(VC, bf16, WS_KC + 524288) WSP(XN, bf16, WS_XN) WSP(Q, bf16, WS_Q) WSP(KV, bf16, WS_KV) WSP(MB, bf16, WS_MB)
    WSP(VT, bf16, WS_VT) WSP(KT, bf16, WS_KT) WSP(Q2, bf16, WS_Q2) WSP(U, bf16, WS_U) WSP(BR, bf16, WS_BR) WSP(GN, bf16, WS_GN) WSP(GL, bf16, WS_GL) WSP(MG, bf16, WS_MG)
#undef WSP
};

__device__ __forceinline__ int t5_bucket(int n) {
    if (n < 16) return n;
    const int thr[15] = {19, 21, 24, 27, 31, 35, 40, 46, 52, 59, 67, 77, 87, 99, 113};
    int b = 16;
#pragma unroll
    for (int i = 0; i < 15; ++i) b += (n >= thr[i]) ? 1 : 0;
    return b;
}

__device__ __forceinline__ void p0_tr_item(const float* W, int ldw, int k0, int srccol0, int nvalid, bf16* WT, int ldt, int dstrow0, LAS float* scr, int lane) {
    const int c = lane & 31;
    float tv[32];
#pragma unroll
    for (int i = 0; i < 32; ++i) { const int kk = 2 * i + (lane >> 5); tv[i] = (c < nvalid) ? W[(size_t)(k0 + kk) * ldw + srccol0 + c] : 0.f; }
#pragma unroll
    for (int i = 0; i < 32; ++i) { const int kk = 2 * i + (lane >> 5); scr[kk * 33 + c] = tv[i]; }
    LDS_WAIT(); asm volatile("" ::: "memory");
    const int cc = lane & 7;
#pragma unroll
    for (int j = 0; j < 4; ++j) { const int n = (lane >> 3) + 8 * j; const LAS float* s = scr + (8 * cc) * 33 + n;
        u32x4 o; o.x = pk2(s[0 * 33], s[1 * 33]); o.y = pk2(s[2 * 33], s[3 * 33]); o.z = pk2(s[4 * 33], s[5 * 33]); o.w = pk2(s[6 * 33], s[7 * 33]);
        *(u32x4*)(WT + (size_t)(dstrow0 + n) * ldt + k0 + 8 * cc) = o; }
    LDS_WAIT(); asm volatile("" ::: "memory");
}
__device__ __forceinline__ void win_src(int n0, int& src, int& nvalid) {
    nvalid = 32;
    if (n0 < 1280) src = n0;
    else if (n0 < 1792) src = 1816 + (n0 - 1280);
    else if (n0 < 2048) { src = 1792 + (n0 - 1792); nvalid = (n0 == 1792) ? 24 : 0; if (n0 != 1792) src = 0; }
    else if (n0 < 2560) src = 1280 + (n0 - 2048);
    else if (n0 < 3072) src = 2328 + (n0 - 2560);
    else src = 2840 + (n0 - 3072);
}
__device__ __forceinline__ void p0_prologue(const Frame& F, const Args& A) {
    LAS float* scr = (LAS float*)(F.lds + F.wave * 16384);
    const int gw = F.vcu * NWAVES + F.wave, NGW = F.G * NWAVES, lane = lane_id();
    constexpr int I_WIN = 16 * 160, I_WA = 8 * 32, I_WO = 16 * 32, I_W1 = 32 * 8, I_W2 = 4 * 2, I_LR = 2;
    constexpr int NIT = I_WIN + 2 * I_WA + I_WO + 2 * I_W1 + 2 * I_W2 + 16 * I_LR + 256 + 1;
    for (int it = gw; it < NIT; it += NGW) {
        int r = it;
        if (r < I_WIN) { const int kb = r / 160, nb = r % 160; int src, nv; win_src(32 * nb, src, nv); p0_tr_item(A.in[2], 4888, 64 * kb, src, nv, F.WinT(), 1024, 32 * nb, scr, lane); continue; } r -= I_WIN;
        if (r < I_WA) { p0_tr_item(A.in[17], 1024, 64 * (r / 32), 32 * (r % 32), 32, F.WaT(), 512, 32 * (r % 32), scr, lane); continue; } r -= I_WA;
        if (r < I_WA) { p0_tr_item(A.in[18], 1024, 64 * (r / 32), 32 * (r % 32), 32, F.WbT(), 512, 32 * (r % 32), scr, lane); continue; } r -= I_WA;
        if (r < I_WO) { p0_tr_item(A.in[19], 1024, 64 * (r / 32), 32 * (r % 32), 32, F.WoutT(), 1024, 32 * (r % 32), scr, lane); continue; } r -= I_WO;
        if (r < 2 * I_W1) { const int kv = r / I_W1, q = r % I_W1; p0_tr_item(A.in[6] + (size_t)kv * 2048 * 256, 256, 64 * (q / 8), 32 * (q % 8), 32, F.W1T() + (size_t)kv * 256 * 2048, 2048, 32 * (q % 8), scr, lane); continue; } r -= 2 * I_W1;
        if (r < 2 * I_W2) { const int kv = r / I_W2, q = r % I_W2; p0_tr_item(A.in[8] + (size_t)kv * 256 * 64, 64, 64 * (q / 2), 32 * (q % 2), 32, F.W2T() + (size_t)kv * 64 * 256, 256, 32 * (q % 2), scr, lane); continue; } r -= 2 * I_W2;
        if (r < 16 * I_LR) { const int mtx = r / 2, nb = r % 2; const float* src = (mtx < 8 ? A.in[12] : A.in[14]) + (size_t)(mtx & 7) * 4096; bf16* dst = (mtx < 8 ? F.LWA() : F.LWX()) + (size_t)(mtx & 7) * 4096;
            p0_tr_item(src, 64, 0, 32 * nb, 32, dst, 64, 32 * nb, scr, lane); continue; } r -= 16 * I_LR;
        if (r < 256) {
            const int kc = r >> 3, kv = (r >> 2) & 1, n = (r & 3) * 64 + lane; const float* w1 = A.in[6] + (size_t)kv * 2048 * 256 + (size_t)(64 * kc) * 256 + n; const float* pe = A.in[5] + kv * 2048 + 64 * kc;
            float s0 = 0.f, s1 = 0.f, s2 = 0.f, s3 = 0.f;
#pragma unroll 4
            for (int k = 0; k < 64; k += 4) { s0 += pe[k] * w1[(size_t)k * 256]; s1 += pe[k + 1] * w1[(size_t)(k + 1) * 256]; s2 += pe[k + 2] * w1[(size_t)(k + 2) * 256]; s3 += pe[k + 3] * w1[(size_t)(k + 3) * 256]; }
            F.C1()[(kc * 2 + kv) * 256 + n] = (s0 + s1) + (s2 + s3); continue; } r -= 256;
        {
            for (int e = lane; e < 1024; e += 64) { const int hd = e >> 7, n = e & 127; F.LUT()[e] = A.in[9][t5_bucket(n) * 8 + hd] * LOG2E; }
        }
    }
    const float* gain = A.in[1];
    {
        f32x4 v[4], vn[4];
        if (gw < SEQ) { const f32x4* xr = (const f32x4*)(A.in[0] + (size_t)gw * DM) + lane;
#pragma unroll
            for (int j = 0; j < 4; ++j) v[j] = xr[64 * j]; }
        for (int m = gw; m < SEQ; m += NGW) {
            if (m + NGW < SEQ) { const f32x4* xr = (const f32x4*)(A.in[0] + (size_t)(m + NGW) * DM) + lane;
#pragma unroll
                for (int j = 0; j < 4; ++j) vn[j] = xr[64 * j]; }
            float s = 0.f;
#pragma unroll
            for (int j = 0; j < 4; ++j) s += (v[j].x * v[j].x + v[j].y * v[j].y) + (v[j].z * v[j].z + v[j].w * v[j].w);
            const float rs = 1.0f / sqrtf(wave_sum(s) * (1.f / DM) + RMS_EPS);
            unsigned long long* o8 = (unsigned long long*)(F.XN() + (size_t)m * DM) + lane;
#pragma unroll
            for (int j = 0; j < 4; ++j) { const f32x4 gv = ((const f32x4*)gain)[lane + 64 * j];
                o8[64 * j] = (unsigned long long)pk2(v[j].x * rs * gv.x, v[j].y * rs * gv.y) | ((unsigned long long)pk2(v[j].z * rs * gv.z, v[j].w * rs * gv.w) << 32); }
#pragma unroll
            for (int j = 0; j < 4; ++j) v[j] = vn[j];
        }
    }
}

template <bool FINAL>
__device__ __forceinline__ void lru_tile(const Frame& F, const Args& A, int tt) {
    const int lane = lane_id();
    const int w = F.wave, fr = lane & 15, fq = lane >> 4, ch0 = 64 * w, t0 = 64 * tt;
    LAS float* UC = (LAS float*)(F.lds + w * 16384);
#define UC_IDX(tok, ch) ((tok) * 64 + ((((ch) >> 2) ^ ((tok) & 15)) << 2) + ((ch) & 3))
    float Hc = 0.f;
    if (FINAL) {
        const float* sa = F.SUMA() + ch0 + lane; const float* sb = F.SUMB() + ch0 + lane;
        int i = 0;
        for (; i + 16 <= tt; i += 16) { float ta[16], tb[16];
#pragma unroll
            for (int k = 0; k < 16; ++k) { ta[k] = sa[(size_t)(i + k) * 512]; tb[k] = sb[(size_t)(i + k) * 512]; }
#pragma unroll
            for (int k = 0; k < 16; ++k) Hc = ta[k] * Hc + tb[k]; }
        for (; i < tt; ++i) Hc = sa[(size_t)i * 512] * Hc + sb[(size_t)i * 512];
        asm volatile("" : "+v"(Hc));
    }
    {
        const int ch = ch0 + lane; const float* cw = A.in[10]; const float cb = A.in[11][ch];
        const float w0 = cw[ch], w1 = cw[512 + ch], w2 = cw[1024 + ch], w3 = cw[1536 + ch];
        const bf16* up = F.U() + (size_t)t0 * 512 + ch;
        float u0 = 0.f, u1 = 0.f, u2 = 0.f;
        if (tt > 0) { u0 = bf2f(up[-3 * 512]); u1 = bf2f(up[-2 * 512]); u2 = bf2f(up[-1 * 512]); }
#pragma unroll 16
        for (int tok = 0; tok < 64; ++tok) { const float u3 = bf2f(up[(size_t)tok * 512]);
            UC[UC_IDX(tok, lane)] = cb + ((u0 * w0 + u1 * w1) + (u2 * w2 + u3 * w3)); u0 = u1; u1 = u2; u2 = u3; }
    }
    bf16x8 Ba[4][2], Bx[4][2];
#pragma unroll
    for (int nt = 0; nt < 4; ++nt)
#pragma unroll
        for (int ks = 0; ks < 2; ++ks) { const size_t o = (size_t)w * 4096 + (16 * nt + fr) * 64 + 32 * ks + 8 * fq; Ba[nt][ks] = *(const bf16x8*)(F.LWA() + o); Bx[nt][ks] = *(const bf16x8*)(F.LWX() + o); }
    float ba[4], bx[4], sp8[4], hin[4], acum[4];
#pragma unroll
    for (int nt = 0; nt < 4; ++nt) { const int ch = ch0 + 16 * nt + fr; ba[nt] = A.in[13][ch]; bx[nt] = A.in[15][ch];
        sp8[nt] = 8.0f * log1pf(expf(-A.in[16][ch])); hin[nt] = 0.f; acum[nt] = 1.f; }
    if (FINAL) {
#pragma unroll
        for (int nt = 0; nt < 4; ++nt) hin[nt] = __shfl(Hc, 16 * nt + fr);
    }
    LDS_WAIT();
#pragma unroll 1
    for (int mt = 0; mt < 4; ++mt) {
        bf16x8 Af[2];
#pragma unroll
        for (int ks = 0; ks < 2; ++ks) { const int tok = 16 * mt + fr, c0 = 8 * ks + 2 * fq;
            const f32x4 x0 = *(const LAS f32x4*)(UC + tok * 64 + ((c0 ^ (tok & 15)) << 2)), x1 = *(const LAS f32x4*)(UC + tok * 64 + (((c0 + 1) ^ (tok & 15)) << 2));
            u32x4 pw; pw.x = cvtpk(x0[0], x0[1]); pw.y = cvtpk(x0[2], x0[3]); pw.z = cvtpk(x1[0], x1[1]); pw.w = cvtpk(x1[2], x1[3]); Af[ks] = __builtin_bit_cast(bf16x8, pw); }
        f32x4 cr[4], ci[4];
#pragma unroll
        for (int nt = 0; nt < 4; ++nt) { cr[nt] = (f32x4){0.f, 0.f, 0.f, 0.f}; ci[nt] = (f32x4){0.f, 0.f, 0.f, 0.f};
#pragma unroll
            for (int ks = 0; ks < 2; ++ks) { cr[nt] = __builtin_amdgcn_mfma_f32_16x16x32_bf16(Af[ks], Ba[nt][ks], cr[nt], 0, 0, 0); ci[nt] = __builtin_amdgcn_mfma_f32_16x16x32_bf16(Af[ks], Bx[nt][ks], ci[nt], 0, 0, 0); } }
#pragma unroll
        for (int nt = 0; nt < 4; ++nt) {
            float P[4], Hh[4];
#pragma unroll
            for (int rg = 0; rg < 4; ++rg) { const int tok = 16 * mt + 4 * fq + rg, e = 16 * nt + fr;
                const float ucv = UC[UC_IDX(tok, e)];
                const float r = fsigmoid(cr[nt][rg] + ba[nt]), ig = fsigmoid(ci[nt][rg] + bx[nt]);
                const float la = -r * sp8[nt]; const float a = __builtin_amdgcn_exp2f(la * LOG2E);
                const float x2 = 2.0f * la;
                const float ser = -x2 * (1.0f + x2 * (0.5f + x2 * (0.16666667f + x2 * (0.041666668f + x2 * 0.008333334f))));
                const float om = (x2 > -0.25f) ? ser : 1.0f - a * a;
                const float b = __builtin_amdgcn_sqrtf(om) * (ig * ucv);
                if (rg == 0) { P[0] = a; Hh[0] = b; } else { P[rg] = P[rg - 1] * a; Hh[rg] = a * Hh[rg - 1] + b; } }
            float At = P[3], Bt = Hh[3];
            { const float Ap = __shfl_up(At, 16), Bp = __shfl_up(Bt, 16); if (fq >= 1) { Bt = At * Bp + Bt; At = Ap * At; } }
            { const float Ap = __shfl_up(At, 32), Bp = __shfl_up(Bt, 32); if (fq >= 2) { Bt = At * Bp + Bt; At = Ap * At; } }
            float Aex = __shfl_up(At, 16), Bex = __shfl_up(Bt, 16); if (fq == 0) { Aex = 1.f; Bex = 0.f; }
            const float hg = Aex * hin[nt] + Bex;
            float hv[4];
#pragma unroll
            for (int rg = 0; rg < 4; ++rg) hv[rg] = P[rg] * hg + Hh[rg];
            hin[nt] = __shfl(hv[3], 48 + fr);
            if (!FINAL) acum[nt] *= __shfl(At, 48 + fr);
            if (FINAL) {
#pragma unroll
                for (int rg = 0; rg < 4; ++rg) { const size_t t = (size_t)(t0 + 16 * mt + 4 * fq + rg); const int ch = ch0 + 16 * nt + fr;
                    F.XN()[t * 1024 + 512 + ch] = (bf16)f2bf(hv[rg] * bf2f(F.GL()[t * 512 + ch])); }
            }
        }
    }
    if (!FINAL && fq == 0) {
#pragma unroll
        for (int nt = 0; nt < 4; ++nt) { F.SUMA()[(size_t)tt * 512 + ch0 + 16 * nt + fr] = acum[nt]; F.SUMB()[(size_t)tt * 512 + ch0 + 16 * nt + fr] = hin[nt]; }
    }
    LDS_WAIT();
#undef UC_IDX
}

__device__ __forceinline__ void qk_norm_tile(const Frame& F, const Args& A, int tt) {
    const int lane = lane_id(), sub = lane & 7;
#pragma unroll 2
    for (int it = 0; it < 12; ++it) {
        const int idx = it * 64 + F.wave * 8 + (lane >> 3), tok = idx / 12, hr = idx % 12; const size_t t = (size_t)(64 * tt + tok);
        bf16* p; bf16* dst; const float* gain; float sc = 1.f;
        if (hr < 8) { p = F.Q() + t * 512 + hr * 64; dst = F.Q2() + t * 512 + (hr >> 2) * 256 + (sub >> 1) * 64 + (hr & 3) * 16 + (sub & 1) * 8 - sub * 8; gain = A.in[3]; sc = 0.125f * LOG2E; }
        else if (hr < 10) { p = F.KV() + t * 768 + 256 + (hr - 8) * 64; dst = p; gain = A.in[4] + 64; }
        else { p = F.KV() + t * 768 + 512 + (hr - 10) * 64; dst = p; gain = A.in[4] + 128; }
        const u32x4 w = *(const u32x4*)(p + sub * 8);
        float x[8] = {bflo(w.x), bfhi(w.x), bflo(w.y), bfhi(w.y), bflo(w.z), bfhi(w.z), bflo(w.w), bfhi(w.w)};
        float ss = 0.f;
#pragma unroll
        for (int j = 0; j < 8; ++j) ss += x[j] * x[j];
        ss += __shfl_xor(ss, 1); ss += __shfl_xor(ss, 2); ss += __shfl_xor(ss, 4);
        const float rs = sc / sqrtf(ss * (1.f / 64.f) + RMS_EPS);
        const f32x4 g0 = *(const f32x4*)(gain + sub * 8), g1 = *(const f32x4*)(gain + sub * 8 + 4);
        u32x4 o; o.x = pk2(x[0] * rs * g0.x, x[1] * rs * g0.y); o.y = pk2(x[2] * rs * g0.z, x[3] * rs * g0.w); o.z = pk2(x[4] * rs * g1.x, x[5] * rs * g1.y); o.w = pk2(x[6] * rs * g1.z, x[7] * rs * g1.w);
        *(u32x4*)(dst + sub * 8) = o;
        if (hr >= 8 && hr < 10) *(u32x4*)(F.KT() + ((size_t)((hr - 8) * 256 + tt) * 8 + sub) * 512 + tok * 8) = o;
    }
}

__device__ __forceinline__ void vt_tile(const Frame& F, int J) {
    const int tid = F.wave * 64 + lane_id(), d = tid & 63, ks = (tid >> 6) & 1, gp = tid >> 7;
#pragma unroll
    for (int g = 0; g < 2; ++g) {
        const bf16* vp = F.KV() + (size_t)(64 * J) * 768 + 384 + 64 * g + d;
        unsigned short e[8];
#pragma unroll
        for (int j = 0; j < 8; ++j) { const int key = 32 * ks + 4 * gp + (j & 3) + 16 * (j >> 2); e[j] = vp[(size_t)key * 768]; }
        u32x4 w; w.x = e[0] | ((unsigned)e[1] << 16); w.y = e[2] | ((unsigned)e[3] << 16); w.z = e[4] | ((unsigned)e[5] << 16); w.w = e[6] | ((unsigned)e[7] << 16);
        *(u32x4*)(F.VT() + (size_t)(g * 256 + J) * 4096 + ((((d >> 4) * 2 + ks) * 16 + (d & 15)) * 32) + 8 * gp) = w;
    }
}

__device__ __forceinline__ void compress_item(const Frame& F, const Args& A, int kv, int g, int ct) {
    const int lane = lane_id(), w = F.wave, tid = w * 64 + lane, fr = lane & 15, fq = lane >> 4, c0 = 16 * ct, tb = 16 * c0;
    LAS unsigned char* T = F.lds;
    LAS bf16* HID = (LAS bf16*)(F.lds + 34816);
    LAS float* OUTF = (LAS float*)(F.lds + 34816 + 8448);
    for (int idx = tid; idx < 272 * 8; idx += 512) { const int tok = idx >> 3, chn = idx & 7, gt = tb + tok;
        u32x4 v = (u32x4){0u, 0u, 0u, 0u};
        if (gt < SEQ) v = *(const u32x4*)(F.KV() + (size_t)gt * 768 + kv * 128 + g * 64 + chn * 8);
        *(LAS u32x4*)(T + tok * 128 + ((chn ^ ((tok >> 4) & 7)) << 4)) = v; }
    LDS_WAIT(); __syncthreads();
    f32x4 acc[2] = {(f32x4){0.f, 0.f, 0.f, 0.f}, (f32x4){0.f, 0.f, 0.f, 0.f}};
    const bf16* w1t = F.W1T() + (size_t)kv * 256 * 2048 + (size_t)(32 * w + fr) * 2048 + 8 * fq;
#pragma unroll 8
    for (int ks = 0; ks < 64; ++ks) {
        const int tok = 16 * fr + (ks >> 1), chn = 4 * (ks & 1) + fq;
        const bf16x8 a = *(const LAS bf16x8*)(T + tok * 128 + ((chn ^ ((tok >> 4) & 7)) << 4));
        const bf16x8 b0 = *(const bf16x8*)(w1t + 32 * ks), b1 = *(const bf16x8*)(w1t + (size_t)16 * 2048 + 32 * ks);
        acc[0] = __builtin_amdgcn_mfma_f32_16x16x32_bf16(a, b0, acc[0], 0, 0, 0);
        acc[1] = __builtin_amdgcn_mfma_f32_16x16x32_bf16(a, b1, acc[1], 0, 0, 0);
    }
#pragma unroll
    for (int nt = 0; nt < 2; ++nt) { const int n = 32 * w + 16 * nt + fr; float c1 = A.in[7][kv * 256 + n];
#pragma unroll 8
        for (int kc = 0; kc < 32; ++kc) c1 += F.C1()[(kc * 2 + kv) * 256 + n];
#pragma unroll
        for (int rg = 0; rg < 4; ++rg) { const float v = acc[nt][rg] + c1; HID[(4 * fq + rg) * 264 + n] = (bf16)f2bf(v * fsigmoid(v)); } }
    LDS_WAIT(); __syncthreads();
    if (w < 4) {
        f32x4 o = (f32x4){0.f, 0.f, 0.f, 0.f};
        const bf16* w2t = F.W2T() + (size_t)kv * 64 * 256 + (size_t)(16 * w + fr) * 256 + 8 * fq;
#pragma unroll
        for (int ks = 0; ks < 8; ++ks) { const bf16x8 a = *(const LAS bf16x8*)(HID + fr * 264 + 32 * ks + 8 * fq); const bf16x8 b = *(const bf16x8*)(w2t + 32 * ks);
            o = __builtin_amdgcn_mfma_f32_16x16x32_bf16(a, b, o, 0, 0, 0); }
#pragma unroll
        for (int rg = 0; rg < 4; ++rg) OUTF[(4 * fq + rg) * 64 + 16 * w + fr] = o[rg];
    }
    LDS_WAIT(); __syncthreads();
    {
        const int row = tid >> 5, e = 2 * (tid & 31), c = c0 + row;
        float v0 = OUTF[row * 64 + e], v1 = OUTF[row * 64 + e + 1];
        if (kv == 0) { float ss = v0 * v0 + v1 * v1;
#pragma unroll
            for (int o = 1; o < 32; o <<= 1) ss += __shfl_xor(ss, o);
            const float rs = 1.0f / sqrtf(ss * (1.f / 64.f) + RMS_EPS); v0 *= rs * A.in[4][e]; v1 *= rs * A.in[4][e + 1]; }
        if (c >= 1023) { v0 = 0.f; v1 = 0.f; }
        bf16* dst = (kv == 0 ? F.KC() : F.VC()) + ((size_t)g * 1024 + c) * 64 + e;
        *(unsigned*)dst = pk2(v0, v1);
    }
    LDS_WAIT(); __syncthreads();
}

namespace att {
constexpr int SLOTB = 8192, NSLOT = 3;
constexpr int L_K = 0, L_V = NSLOT * SLOTB, L_SC = 2 * NSLOT * SLOTB, L_OUT = L_SC + 65536, L_LUT = L_OUT + 32768, L_WSF = L_LUT + 2048, L_BM = L_WSF + 2048, L_REF = L_BM + 2048, L_LACC = L_REF + 1024, L_TL = L_LACC + 1024  , L_END = L_TL + 4096;
static_assert(L_END <= RING_BYTES, "attention LDS map");
constexpr int L_EX = 0  , L_HDR = 32768  , L_LEX = 33024  , L_NT = 34048  ;
constexpr float CLAMP = 100.0f;
constexpr float THR = 8.0f;
#define SBAR() __builtin_amdgcn_sched_barrier(0)
__device__ __forceinline__ int crow(int r, int hi) { return (r & 3) + 8 * (r >> 2) + 4 * hi; }
__device__ __forceinline__ void glds16(const void* gsrc, unsigned lds_dst) { unsigned keep;
    asm volatile("s_mov_b32 %0, m0\n\ts_mov_b32 m0, %2\n\ts_nop 0\n\tglobal_load_lds_dwordx4 %1, off\n\ts_mov_b32 m0, %0" : "=&s"(keep) : "v"(gsrc), "s"(lds_dst) : "memory"); }
__device__ __forceinline__ void qkt(f32x16& p0, f32x16& p1, const LAS unsigned char* Kslot, const bf16x8* qr, float cinit, int r32, int hi) {
    const LAS unsigned char* kb = Kslot + hi * 1024 + r32 * 16;
#pragma unroll
    for (int r = 0; r < 16; ++r) { p0[r] = cinit; p1[r] = cinit; }
#pragma unroll
    for (int d0 = 0; d0 < 4; ++d0) {
        const bf16x8 b0 = *(const LAS bf16x8*)(kb + d0 * 2048);
        const bf16x8 b1 = *(const LAS bf16x8*)(kb + d0 * 2048 + 512);
        p0 = __builtin_amdgcn_mfma_f32_32x32x16_bf16(b0, qr[d0], p0, 0, 0, 0); p1 = __builtin_amdgcn_mfma_f32_32x32x16_bf16(b1, qr[d0], p1, 0, 0, 0); }
}
__device__ __forceinline__ void pv(f32x16* o, int vb, bf16x8 pa0, bf16x8 pa1, bf16x8 pa2, bf16x8 pa3) {
#pragma unroll
    for (int d0 = 0; d0 < 2; ++d0) { s16x4 lo[4], hi[4];
#pragma unroll
        for (int ks = 0; ks < 4; ++ks) {
            asm volatile("ds_read_b64_tr_b16 %0,%1 offset:%c2" : "=&v"(lo[ks]) : "v"(vb), "i"(d0 * 4096 + ks * 1024) : "memory");
            asm volatile("ds_read_b64_tr_b16 %0,%1 offset:%c2" : "=&v"(hi[ks]) : "v"(vb), "i"(d0 * 4096 + ks * 1024 + 512) : "memory"); }
        asm volatile("s_waitcnt lgkmcnt(0)" ::: "memory"); SBAR();
#define PK(k) (bf16x8){lo[k][0], lo[k][1], lo[k][2], lo[k][3], hi[k][0], hi[k][1], hi[k][2], hi[k][3]}
        o[d0] = __builtin_amdgcn_mfma_f32_32x32x16_bf16(pa0, PK(0), o[d0], 0, 0, 0);
        o[d0] = __builtin_amdgcn_mfma_f32_32x32x16_bf16(pa1, PK(1), o[d0], 0, 0, 0);
        o[d0] = __builtin_amdgcn_mfma_f32_32x32x16_bf16(pa2, PK(2), o[d0], 0, 0, 0);
        o[d0] = __builtin_amdgcn_mfma_f32_32x32x16_bf16(pa3, PK(3), o[d0], 0, 0, 0);
#undef PK
    }
}
__device__ __forceinline__ float rowmax(const f32x16& p0, const f32x16& p1) {
    float a = fmaxf(fmaxf(p0[0], p0[1]), p1[0]), b = fmaxf(fmaxf(p0[2], p0[3]), p1[1]); a = fmaxf(fmaxf(a, p1[2]), p1[3]);
#pragma unroll
    for (int r = 4; r < 16; r += 4) { a = fmaxf(fmaxf(a, p0[r]), p0[r + 1]); b = fmaxf(fmaxf(b, p0[r + 2]), p0[r + 3]); a = fmaxf(fmaxf(a, p1[r]), p1[r + 1]); b = fmaxf(fmaxf(b, p1[r + 2]), p1[r + 3]); }
    const float m = fmaxf(a, b);
    auto rr = __builtin_amdgcn_permlane32_swap(__float_as_uint(m), __float_as_uint(m), false, false);
    return fmaxf(__uint_as_float(rr[0]), __uint_as_float(rr[1]));
}
__device__ __forceinline__ float halfsum(float v) { auto rr = __builtin_amdgcn_permlane32_swap(__float_as_uint(v), __float_as_uint(v), false, false); return __uint_as_float(rr[0]) + __uint_as_float(rr[1]); }
template <int STEP, unsigned LIMIT>
__device__ __forceinline__ void near_apply(f32x16& p0, f32x16& p1, int dbase, const LAS float* lut) {
#pragma unroll
    for (int r = 0; r < 16; ++r) { const int koff = (r & 3) + 8 * (r >> 2); const int d0 = dbase - STEP * koff, d1 = d0 - STEP * 32;
        const int i0 = min(max(d0, 0), 127), i1 = min(max(d1, 0), 127);
        const float b0 = lut[i0], b1 = lut[i1];
        p0[r] = ((unsigned)d0 < LIMIT) ? p0[r] + b0 : -INFINITY; p1[r] = ((unsigned)d1 < LIMIT) ? p1[r] + b1 : -INFINITY; }
}
template <bool HASO>
__device__ __forceinline__ void sm_update(f32x16& p0, f32x16& p1, float& m, float& l, f32x16* o, LAS float* wsf, int r32, int hi) {
    const float rm = rowmax(p0, p1);
    const bool need = rm > m + THR;
    if (__any(need)) {
        const float mn = need ? rm : m; const float alpha = __builtin_amdgcn_exp2f(m - mn);
        l *= alpha; m = mn;
        if (HASO) { if (hi == 0) wsf[r32] = alpha; LDS_WAIT();
#pragma unroll
            for (int r = 0; r < 16; ++r) { const float f = wsf[crow(r, hi)]; o[0][r] *= f; o[1][r] *= f; } }
    }
    float s = 0.f;
#pragma unroll
    for (int r = 0; r < 16; ++r) { p0[r] = __builtin_amdgcn_exp2f(p0[r] - m); p1[r] = __builtin_amdgcn_exp2f(p1[r] - m); s += p0[r] + p1[r]; }
    l += s;
}
#define ATT_PACK(P0, P1) \
    const bf16x8 pa0 = __builtin_bit_cast(bf16x8, (u32x4){cvtpk(P0[0], P0[1]), cvtpk(P0[2], P0[3]), cvtpk(P0[4], P0[5]), cvtpk(P0[6], P0[7])}); \
    const bf16x8 pa1 = __builtin_bit_cast(bf16x8, (u32x4){cvtpk(P0[8], P0[9]), cvtpk(P0[10], P0[11]), cvtpk(P0[12], P0[13]), cvtpk(P0[14], P0[15])}); \
    const bf16x8 pa2 = __builtin_bit_cast(bf16x8, (u32x4){cvtpk(P1[0], P1[1]), cvtpk(P1[2], P1[3]), cvtpk(P1[4], P1[5]), cvtpk(P1[6], P1[7])}); \
    const bf16x8 pa3 = __builtin_bit_cast(bf16x8, (u32x4){cvtpk(P1[8], P1[9]), cvtpk(P1[10], P1[11]), cvtpk(P1[12], P1[13]), cvtpk(P1[14], P1[15])});
#define ATT_WAITBAR(N) asm volatile("s_waitcnt vmcnt(" #N ") lgkmcnt(0)\n\ts_barrier" ::: "memory")
#define ATT_FILL(V, x) do { _Pragma("unroll") for (int _r = 0; _r < 16; ++_r) V[_r] = (x); } while (0)

__device__ __forceinline__ unsigned rangemask(int k, int a, int b) {
    const int lo = max(a - 32 * k, 0), hi = min(b - 32 * k, 31);
    return (lo > hi) ? 0u : ((0xFFFFFFFFu >> (31 - hi)) & (0xFFFFFFFFu << lo));
}
__device__ __forceinline__ int wave_max_i32(int x) {
    x = max(x, dpp_i<0xB1>(x)); x = max(x, dpp_i<0x4E>(x)); x = max(x, dpp_i<0x141>(x)); x = max(x, dpp_i<0x140>(x));
    return max(max(__builtin_amdgcn_readlane(x, 0), __builtin_amdgcn_readlane(x, 16)), max(__builtin_amdgcn_readlane(x, 32), __builtin_amdgcn_readlane(x, 48)));
}

__device__ __forceinline__ void lds_add_f32(LAS float* p, float v) { (void)__hip_atomic_fetch_add(p, v, __ATOMIC_RELAXED, __HIP_MEMORY_SCOPE_WORKGROUP); }

__device__ __forceinline__ void attn_item(const Frame& F, int qt, int g) {
    const int lane = lane_id(), wid = F.wave, tid = wid * 64 + lane, r32 = lane & 31, hi = lane >> 5;
    const int ql = r32 >> 2, h = r32 & 3, cur = qt, t = 64 * qt + 8 * wid + ql, head = 4 * g + h;
    LAS unsigned char* shm = F.lds;
    const unsigned lds0 = (unsigned)(uintptr_t)shm;
    LAS float* wsf = (LAS float*)(shm + L_WSF) + wid * 64;
    LAS float* SC = (LAS float*)(shm + L_SC);
    LAS float* OACC = (LAS float*)(shm + L_SC);
    LAS bf16* OUTS = (LAS bf16*)(shm + L_OUT);
    LAS float* lutl = (LAS float*)(shm + L_LUT);
    const LAS float* luth = lutl + h * 128;
    LAS unsigned* BM = (LAS unsigned*)(shm + L_BM);
    LAS float* REF = (LAS float*)(shm + L_REF);
    LAS float* LACC = (LAS float*)(shm + L_LACC);
    lutl[tid] = F.LUT()[(4 * g + (tid >> 7)) * 128 + (tid & 127)];
    BM[tid] = 0u;
    bf16x8 qr[4];
    { const bf16* qp = F.Q2() + (size_t)t * 512 + g * 256 + h * 16 + hi * 8;
#pragma unroll
        for (int d0 = 0; d0 < 4; ++d0) qr[d0] = *(const bf16x8*)(qp + d0 * 64); }
    const float b31 = F.LUT()[head * 128 + 127];
    const float gate_c = fsigmoid(bf2f(F.BR()[(size_t)t * 256 + head])), gate_s = fsigmoid(bf2f(F.BR()[(size_t)t * 256 + 8 + head])), gate_w = fsigmoid(bf2f(F.BR()[(size_t)t * 256 + 16 + head]));
    f32x16 o[2], p0, p1;
    const unsigned kdst = lds0 + L_K + wid * 1024, vdst = lds0 + L_V + wid * 1024;
    const int vrow = 16 * (wid & 3) + (lane >> 2), vcol = (wid >> 2) * 32 + (lane & 3) * 8;
    const int vb0 = (int)(lds0 + L_V) + ((lane >> 4) & 1) * 32 + (lane & 3) * 8 + (4 * hi + ((lane & 15) >> 2)) * 64;
#define DMA_K(base, pitch, row0, slot) glds16((base) + (size_t)((row0) + lane) * (pitch) + wid * 8, (unsigned)__builtin_amdgcn_readfirstlane(kdst + (slot)))
#define DMA_V(base, pitch, row0, slot) glds16((base) + (size_t)((row0) + vrow) * (pitch) + vcol, (unsigned)__builtin_amdgcn_readfirstlane(vdst + (slot)))
#define ROT() do { sl_cur = sl_next; sl_next = (sl_next == (NSLOT - 1) * SLOTB) ? 0 : sl_next + SLOTB; } while (0)
    VM_WAIT(); LDS_WAIT(); __syncthreads();

    const bf16* KCg = F.KC() + (size_t)g * 1024 * 64; const bf16* VCg = F.VC() + (size_t)g * 1024 * 64;
    const int nkt = (qt >> 4) + 1;
    const int tminw = 64 * qt + 8 * wid;
    float m = -1e30f, l = 0.f;
    {
        int sl_cur = 0, sl_next = SLOTB;
        DMA_K(KCg, 64, 0, 0);
        for (int kt = 0; kt < nkt; ++kt) {
            if (kt + 1 < nkt) { DMA_K(KCg, 64, 64 * (kt + 1), sl_next); ATT_WAITBAR(1); } else { ATT_WAITBAR(0); }
            const bool far = (tminw - 31 - 16 * (64 * kt + 63)) >= 128;
            if (far) { qkt(p0, p1, shm + L_K + sl_cur, qr, b31, r32, hi); }
            else { qkt(p0, p1, shm + L_K + sl_cur, qr, 0.f, r32, hi); near_apply<16, 0x80000000u>(p0, p1, t - 31 - 16 * (64 * kt + 4 * hi), luth); }
            sm_update<false>(p0, p1, m, l, o, wsf, r32, hi);
            ROT();
        }
        LDS_WAIT(); __builtin_amdgcn_s_barrier();
    }
    {
        const float lt = halfsum(l); const float rl = lt > 0.f ? 1.0f / lt : 0.f;
        ATT_FILL(o[0], 0.f); ATT_FILL(o[1], 0.f);
        float carry = 0.f;
        int sl_cur = 0, sl_next = SLOTB;
        DMA_K(KCg, 64, 0, 0); DMA_V(VCg, 64, 0, 0);
        for (int kt = 0; kt < nkt; ++kt) {
            if (kt + 1 < nkt) { DMA_K(KCg, 64, 64 * (kt + 1), sl_next); DMA_V(VCg, 64, 64 * (kt + 1), sl_next); ATT_WAITBAR(2); } else { ATT_WAITBAR(0); }
            const bool far = (tminw - 31 - 16 * (64 * kt + 63)) >= 128;
            if (far) { qkt(p0, p1, shm + L_K + sl_cur, qr, b31, r32, hi); }
            else { qkt(p0, p1, shm + L_K + sl_cur, qr, 0.f, r32, hi); near_apply<16, 0x80000000u>(p0, p1, t - 31 - 16 * (64 * kt + 4 * hi), luth); }
#pragma unroll
            for (int r = 0; r < 16; ++r) { p0[r] = __builtin_amdgcn_exp2f(p0[r] - m) * rl; p1[r] = __builtin_amdgcn_exp2f(p1[r] - m) * rl; }
            {
                float q4[8], e[8];
#pragma unroll
                for (int i = 0; i < 4; ++i) { q4[i] = (p0[4 * i] + p0[4 * i + 1]) + (p0[4 * i + 2] + p0[4 * i + 3]); e[i] = p0[4 * i + 3];
                                              q4[4 + i] = (p1[4 * i] + p1[4 * i + 1]) + (p1[4 * i + 2] + p1[4 * i + 3]); e[4 + i] = p1[4 * i + 3]; }
                float newcarry = 0.f;
#pragma unroll
                for (int i = 0; i < 8; ++i) { auto rr = __builtin_amdgcn_permlane32_swap(__float_as_uint(e[i]), __float_as_uint(e[i]), false, false);
                    const float elo = __uint_as_float(rr[0]), ehi = __uint_as_float(rr[1]);
                    if (hi) q4[i] += elo; else if (i < 7) q4[i + 1] += ehi;
                    if (i == 7) newcarry = ehi; }
                if (!hi) q4[0] += carry;
                carry = newcarry;
#pragma unroll
                for (int i = 0; i < 8; ++i) { float v = q4[i]; v += dpp_f<0xB1>(v); v += dpp_f<0x4E>(v); q4[i] = v; }
                if (h == 0) {
#pragma unroll
                    for (int i = 0; i < 8; ++i) SC[(8 * wid + ql) * 256 + 16 * kt + 2 * i + hi] = q4[i]; }
            }
            { ATT_PACK(p0, p1); pv(o, vb0 + sl_cur, pa0, pa1, pa2, pa3); }
            ROT();
        }
        LDS_WAIT(); __builtin_amdgcn_s_barrier();
    }

    if (cur >= 16) {
#pragma unroll 1
        for (int qb = 0; qb < 8; qb += 4) {
            int v[4][4];
#pragma unroll
            for (int u = 0; u < 4; ++u) { const LAS float* row = SC + (8 * wid + qb + u) * 256;
#pragma unroll
                for (int i = 0; i < 4; ++i) { const int J = lane + 64 * i; const int x = __float_as_int(row[J]); v[u][i] = (J >= 1 && J <= cur - 2) ? x : -1; } }
#pragma unroll 1
            for (int round = 0; round < 13; ++round) {
                int wm[4];
#pragma unroll
                for (int u = 0; u < 4; ++u) wm[u] = wave_max_i32(max(max(v[u][0], v[u][1]), max(v[u][2], v[u][3])));
#pragma unroll
                for (int u = 0; u < 4; ++u) {
                    const unsigned long long b0 = __ballot(v[u][0] == wm[u]), b1 = __ballot(v[u][1] == wm[u]), b2 = __ballot(v[u][2] == wm[u]), b3 = __ballot(v[u][3] == wm[u]);
                    int J;
                    if (b0) J = __builtin_ctzll(b0); else if (b1) J = 64 + __builtin_ctzll(b1); else if (b2) J = 128 + __builtin_ctzll(b2); else J = 192 + __builtin_ctzll(b3);
                    const bool mine = (lane == (J & 63));
                    if (mine && (J >> 6) == 0) v[u][0] = -1; if (mine && (J >> 6) == 1) v[u][1] = -1; if (mine && (J >> 6) == 2) v[u][2] = -1; if (mine && (J >> 6) == 3) v[u][3] = -1;
                    const int qloc = 8 * wid + qb + u;
                    if (lane == 0) __hip_atomic_fetch_or(BM + 2 * J + (qloc >> 5), 1u << (qloc & 31), __ATOMIC_RELAXED, __HIP_MEMORY_SCOPE_WORKGROUP);
                }
            }
        }
    }
    LDS_WAIT();
    {
        if (hi == 0) wsf[r32] = gate_c; LDS_WAIT();
#pragma unroll
        for (int r = 0; r < 16; ++r) { const float f = wsf[crow(r, hi)]; const int orow = 32 * wid + crow(r, hi); OUTS[orow * 64 + r32] = (bf16)f2bf(o[0][r] * f); OUTS[orow * 64 + 32 + r32] = (bf16)f2bf(o[1][r] * f); }
    }

    const bf16* Kw = F.KV() + 512 + g * 64; const bf16* Vw = F.KV() + 640 + g * 64;
    {
        m = -1e30f; l = 0.f; ATT_FILL(o[0], 0.f); ATT_FILL(o[1], 0.f);
        const int J0 = max(cur - 8, 0);
        int sl_cur = 0, sl_next = SLOTB;
        DMA_K(Kw, 768, 64 * J0, 0); DMA_V(Vw, 768, 64 * J0, 0);
        for (int J = J0; J <= cur; ++J) {
            if (J + 1 <= cur) { DMA_K(Kw, 768, 64 * (J + 1), sl_next); DMA_V(Vw, 768, 64 * (J + 1), sl_next); ATT_WAITBAR(2); } else { ATT_WAITBAR(0); }
            if (J >= cur - 2 || J == cur - 8) { qkt(p0, p1, shm + L_K + sl_cur, qr, 0.f, r32, hi); near_apply<1, 512u>(p0, p1, t - 64 * J - 4 * hi, luth); }
            else { qkt(p0, p1, shm + L_K + sl_cur, qr, b31, r32, hi); }
            sm_update<true>(p0, p1, m, l, o, wsf, r32, hi);
            { ATT_PACK(p0, p1); pv(o, vb0 + sl_cur, pa0, pa1, pa2, pa3); }
            ROT();
        }
        LDS_WAIT(); __builtin_amdgcn_s_barrier();
        const float lt = halfsum(l); const float fw = lt > 0.f ? gate_w / lt : 0.f;
        if (hi == 0) wsf[r32] = fw; LDS_WAIT();
#pragma unroll
        for (int r = 0; r < 16; ++r) { const float f = wsf[crow(r, hi)]; const int orow = 32 * wid + crow(r, hi);
            OUTS[orow * 64 + r32] = (bf16)f2bf(bf2f(OUTS[orow * 64 + r32]) + o[0][r] * f); OUTS[orow * 64 + 32 + r32] = (bf16)f2bf(bf2f(OUTS[orow * 64 + 32 + r32]) + o[1][r] * f); }
    }

    const bf16* Ks = F.KV() + 256 + g * 64; const bf16* Vs = F.KV() + 384 + g * 64;
    {
        m = -1e30f; l = 0.f; ATT_FILL(o[0], 0.f); ATT_FILL(o[1], 0.f);
        const int nA = (cur < 16) ? cur + 1 : 3;
#define JA(i) ((cur < 16) ? (i) : ((i) == 0 ? 0 : cur - 2 + (i)))
        int sl_cur = 0, sl_next = SLOTB;
        DMA_K(Ks, 768, 0, 0); DMA_V(Vs, 768, 0, 0);
        for (int i = 0; i < nA; ++i) {
            const int J = JA(i);
            if (i + 1 < nA) { const int Jn = JA(i + 1); DMA_K(Ks, 768, 64 * Jn, sl_next); DMA_V(Vs, 768, 64 * Jn, sl_next); ATT_WAITBAR(2); } else { ATT_WAITBAR(0); }
            if (J >= cur - 2) { qkt(p0, p1, shm + L_K + sl_cur, qr, 0.f, r32, hi); near_apply<1, 0x80000000u>(p0, p1, t - 64 * J - 4 * hi, luth); }
            else { qkt(p0, p1, shm + L_K + sl_cur, qr, b31, r32, hi); }
            sm_update<true>(p0, p1, m, l, o, wsf, r32, hi);
            { ATT_PACK(p0, p1); pv(o, vb0 + sl_cur, pa0, pa1, pa2, pa3); }
            ROT();
        }
#undef JA
        LDS_WAIT(); __builtin_amdgcn_s_barrier();
        const float lt = halfsum(l);
        if (hi == 0) { REF[32 * wid + r32] = m; LACC[32 * wid + r32] = lt; }
#pragma unroll
        for (int r = 0; r < 16; ++r) { const int orow = 32 * wid + crow(r, hi); OACC[orow * 64 + r32] = o[0][r]; OACC[orow * 64 + 32 + r32] = o[1][r]; }
        LDS_WAIT(); __builtin_amdgcn_s_barrier();
    }

    if (cur >= 16) {
        const int c16 = lane & 15, gq = lane >> 4, qi4 = c16 >> 2;
        const bf16* KTg = F.KT() + (size_t)g * 256 * 4096 + gq * 512 + c16 * 8; const bf16* VTg = F.VT() + (size_t)g * 256 * 4096 + c16 * 32 + 8 * gq;
        const bf16* Q2g = F.Q2() + g * 256 + (gq >> 1) * 64 + h * 16 + 8 * (gq & 1);
        LAS unsigned short* TL = (LAS unsigned short*)(shm + L_TL) + wid * 256;
        int ntask = 0;
#pragma unroll 1
        for (int i4 = 0; i4 < 4; ++i4) {
            const int Jl = lane + 64 * i4; int nch = 0;
            if (Jl >= 1 && Jl <= cur - 2) nch = (__popc(BM[2 * Jl]) + __popc(BM[2 * Jl + 1]) + 3) >> 2;
#pragma unroll 1
            for (int c = 0; c < 16; ++c) { const bool has = (c < nch) && (((Jl + c) & 7) == wid); const unsigned long long bal = __ballot(has); if (!bal) continue;
                const int pos = ntask + __popcll(bal & ((1ull << lane) - 1ull));
                if (has && pos < 256) TL[pos] = (unsigned short)(Jl | (c << 8));
                ntask += __popcll(bal); }
        }
        ntask = min(ntask, 256);
        LAS bf16* EX = (LAS bf16*)(shm + L_EX); LAS int* HDR = (LAS int*)(shm + L_HDR); LAS float* LEX = (LAS float*)(shm + L_LEX); LAS int* NT = (LAS int*)(shm + L_NT);
        if (lane == 0) NT[wid] = ntask;
        LDS_WAIT(); __builtin_amdgcn_s_barrier();
        int nround = 0;
#pragma unroll
        for (int k = 0; k < 8; ++k) nround = max(nround, __builtin_amdgcn_readfirstlane(NT[k]));
        struct Task { bf16x8 kf[8], vf[8], qg[2]; int J, tq, myq; bool valid; };
#define PREP(n, T) do { const int e_ = __builtin_amdgcn_readfirstlane((int)TL[n]); const int J_ = e_ & 255, c_ = e_ >> 8; \
            unsigned long long mask_ = ((unsigned long long)(unsigned)__builtin_amdgcn_readfirstlane((int)BM[2 * J_ + 1]) << 32) | (unsigned)__builtin_amdgcn_readfirstlane((int)BM[2 * J_]); \
            for (int k_ = 0; k_ < 4 * c_; ++k_) mask_ &= mask_ - 1; \
            int qk_[4]; _Pragma("unroll") for (int k_ = 0; k_ < 4; ++k_) { if (mask_) { qk_[k_] = __builtin_ctzll(mask_); mask_ &= mask_ - 1; } else qk_[k_] = -1; } \
            int myq_ = qi4 == 0 ? qk_[0] : qi4 == 1 ? qk_[1] : qi4 == 2 ? qk_[2] : qk_[3]; \
            T.valid = myq_ >= 0; if (!T.valid) myq_ = qk_[0]; T.J = J_; T.myq = myq_; T.tq = 64 * qt + myq_; \
            const bf16* qp_ = Q2g + (size_t)T.tq * 512; const bf16* kp_ = KTg + (size_t)J_ * 4096; \
            T.qg[0] = *(const bf16x8*)(qp_); T.qg[1] = *(const bf16x8*)(qp_ + 128); \
            _Pragma("unroll") for (int kt = 0; kt < 4; ++kt) { T.kf[2 * kt] = *(const bf16x8*)(kp_ + kt * 128); T.kf[2 * kt + 1] = *(const bf16x8*)(kp_ + 2048 + kt * 128); } \
            const bf16* vp_ = VTg + (size_t)J_ * 4096; _Pragma("unroll") for (int x = 0; x < 8; ++x) T.vf[x] = *(const bf16x8*)(vp_ + x * 512); } while (0)
        Task tc, tn;
        if (ntask > 0) PREP(0, tc);
#pragma unroll 1
        for (int n = 0; n < nround; ++n) {
            const int buf = n & 1;
            if (n < ntask) {
                if (n + 1 < ntask) PREP(n + 1, tn);
                const float ref = REF[4 * tc.myq + h];
                const bool nearJ = (tc.J >= cur - 2);
                const float cinit = nearJ ? 0.f : (tc.valid ? b31 - ref : -INFINITY);
                f32x4 s[4];
#pragma unroll
                for (int kt = 0; kt < 4; ++kt) { s[kt] = (f32x4){cinit, cinit, cinit, cinit};
                    s[kt] = __builtin_amdgcn_mfma_f32_16x16x32_bf16(tc.kf[2 * kt], tc.qg[0], s[kt], 0, 0, 0); s[kt] = __builtin_amdgcn_mfma_f32_16x16x32_bf16(tc.kf[2 * kt + 1], tc.qg[1], s[kt], 0, 0, 0); }
                if (nearJ) { const float sub = tc.valid ? ref : INFINITY;
#pragma unroll
                    for (int kt = 0; kt < 4; ++kt)
#pragma unroll
                        for (int r = 0; r < 4; ++r) { const int dd = tc.tq - 64 * tc.J - (16 * kt + 4 * gq + r); const float bb = luth[min(max(dd, 0), 127)];
                            s[kt][r] = (dd >= 0) ? s[kt][r] + bb - sub : -INFINITY; } }
                float ls = 0.f;
#pragma unroll
                for (int kt = 0; kt < 4; ++kt)
#pragma unroll
                    for (int r = 0; r < 4; ++r) { s[kt][r] = __builtin_amdgcn_exp2f(fminf(s[kt][r], CLAMP)); ls += s[kt][r]; }
                ls += __shfl_xor(ls, 16); ls += __shfl_xor(ls, 32);
                bf16x8 pb[2];
#pragma unroll
                for (int ks = 0; ks < 2; ++ks) pb[ks] = __builtin_bit_cast(bf16x8, (u32x4){cvtpk(s[2 * ks][0], s[2 * ks][1]), cvtpk(s[2 * ks][2], s[2 * ks][3]), cvtpk(s[2 * ks + 1][0], s[2 * ks + 1][1]), cvtpk(s[2 * ks + 1][2], s[2 * ks + 1][3])});
                LAS bf16* ex = EX + buf * 8192 + ((wid * 4 + qi4) * 4 + h) * 64 + 4 * gq;
#pragma unroll
                for (int mt = 0; mt < 4; ++mt) { f32x4 ot = (f32x4){0.f, 0.f, 0.f, 0.f};
                    ot = __builtin_amdgcn_mfma_f32_16x16x32_bf16(tc.vf[2 * mt], pb[0], ot, 0, 0, 0); ot = __builtin_amdgcn_mfma_f32_16x16x32_bf16(tc.vf[2 * mt + 1], pb[1], ot, 0, 0, 0);
                    *(LAS u32x2*)(ex + 16 * mt) = (u32x2){cvtpk(ot[0], ot[1]), cvtpk(ot[2], ot[3])}; }
                if (gq == 0) { LEX[buf * 128 + wid * 16 + c16] = ls; if (h == 0) HDR[buf * 32 + wid * 4 + qi4] = tc.valid ? tc.myq : -1; }
            } else if (lane < 4) HDR[buf * 32 + wid * 4 + lane] = -1;
            LDS_WAIT(); __builtin_amdgcn_s_barrier();
            {
                const int hv = (lane < 32) ? HDR[buf * 32 + lane] : -1;
                const int li = lane & 15, hsel = li >> 2, dq = (li & 3) * 16;
#pragma unroll
                for (int pass = 0; pass < 2; ++pass) {
                    const unsigned m0 = (unsigned)__ballot(hv == 8 * wid + 4 * pass + 0), m1 = (unsigned)__ballot(hv == 8 * wid + 4 * pass + 1), m2 = (unsigned)__ballot(hv == 8 * wid + 4 * pass + 2), m3 = (unsigned)__ballot(hv == 8 * wid + 4 * pass + 3);
                    if ((m0 | m1 | m2 | m3) == 0u) continue;
                    unsigned mm = gq == 0 ? m0 : gq == 1 ? m1 : gq == 2 ? m2 : m3;
                    if (mm) { const int q = 8 * wid + 4 * pass + gq;
                        LAS f32x4* ap = (LAS f32x4*)(OACC + (4 * q + hsel) * 64 + dq); f32x4 a0 = ap[0], a1 = ap[1], a2 = ap[2], a3 = ap[3]; float la = 0.f;
                        while (mm) { const int e = __builtin_ctz(mm); mm &= mm - 1;
                            const u32x4 x0 = *(const LAS u32x4*)(EX + buf * 8192 + e * 256 + hsel * 64 + dq), x1 = *(const LAS u32x4*)(EX + buf * 8192 + e * 256 + hsel * 64 + dq + 8);
                            a0[0] += bflo(x0.x); a0[1] += bfhi(x0.x); a0[2] += bflo(x0.y); a0[3] += bfhi(x0.y); a1[0] += bflo(x0.z); a1[1] += bfhi(x0.z); a1[2] += bflo(x0.w); a1[3] += bfhi(x0.w);
                            a2[0] += bflo(x1.x); a2[1] += bfhi(x1.x); a2[2] += bflo(x1.y); a2[3] += bfhi(x1.y); a3[0] += bflo(x1.z); a3[1] += bfhi(x1.z); a3[2] += bflo(x1.w); a3[3] += bfhi(x1.w);
                            la += LEX[buf * 128 + e * 4 + hsel]; }
                        ap[0] = a0; ap[1] = a1; ap[2] = a2; ap[3] = a3;
                        if ((li & 3) == 0) LACC[4 * q + hsel] += la; }
                }
            }
            tc = tn;
        }
#undef PREP
    }
    LDS_WAIT(); __builtin_amdgcn_s_barrier();

    {
        if (hi == 0) { const float lt = LACC[32 * wid + r32]; wsf[r32] = lt > 0.f ? gate_s / lt : 0.f; }
        LDS_WAIT();
#pragma unroll
        for (int i = 0; i < 4; ++i) { const int rowl = i * 8 + (lane >> 3), chn = lane & 7, row = 32 * wid + rowl;
            const float f = wsf[rowl];
            const f32x4 a0 = *(const LAS f32x4*)(OACC + row * 64 + chn * 8), a1 = *(const LAS f32x4*)(OACC + row * 64 + chn * 8 + 4);
            const u32x4 ov = *(const LAS u32x4*)(OUTS + row * 64 + chn * 8);
            const size_t tt = (size_t)(64 * qt + 8 * wid + (rowl >> 2)); const int col = (4 * g + (rowl & 3)) * 64 + chn * 8;
            const u32x4 gn = *(const u32x4*)(F.GN() + tt * 512 + col);
            u32x4 w; w.x = pk2((bflo(ov.x) + a0[0] * f) * bflo(gn.x), (bfhi(ov.x) + a0[1] * f) * bfhi(gn.x)); w.y = pk2((bflo(ov.y) + a0[2] * f) * bflo(gn.y), (bfhi(ov.y) + a0[3] * f) * bfhi(gn.y));
            w.z = pk2((bflo(ov.z) + a1[0] * f) * bflo(gn.z), (bfhi(ov.z) + a1[1] * f) * bfhi(gn.z)); w.w = pk2((bflo(ov.w) + a1[2] * f) * bflo(gn.w), (bfhi(ov.w) + a1[3] * f) * bfhi(gn.w));
            *(u32x4*)(F.XN() + tt * 1024 + col) = w; }
        VM_WAIT(); LDS_WAIT(); __syncthreads();
    }
#undef DMA_K
#undef DMA_V
#undef ROT
}
}

__global__ void __launch_bounds__(NWAVES * 64, 2) nsa_lru_fwd(Args args) {
    extern __shared__ __attribute__((aligned(16))) unsigned char lds[];
    Frame F;
    F.lds = (LAS unsigned char*)lds;
    F.MISC = (volatile LAS unsigned*)(F.lds + MISC_OFF);
    F.wave = __builtin_amdgcn_readfirstlane((int)(threadIdx.x >> 6));
    F.G = gridDim.x; { const int bx = blockIdx.x; F.vcu = (F.G % 8 == 0) ? (bx % 8) * (F.G / 8) + bx / 8 : bx; }
    F.ws = args.ws;
    gu32* ctl = (gu32*)(args.ws + WS_CTL);
    for (int u = F.wave * 64 + lane_id(); u < (LDS_BYTES - LDSCTL_OFF) / 4; u += NWAVES * 64) ((LAS unsigned*)(F.lds + LDSCTL_OFF))[u] = 0u;
    __syncthreads();
    const int bli = (N_LAUNCHES == PER_PHASE) ? 0 : args.li;
    XcdBarrier bar; bar.bar = (unsigned*)(ctl + CW_BAR) + bli * XCD_BAR_WORDS; bar.x = 0; bar.st = nullptr;
    if (N_LAUNCHES != PER_PHASE) bar = xcd_barrier_post((unsigned*)(ctl + CW_BAR) + bli * XCD_BAR_WORDS, F.MISC + 8);
#define GRID_BAR() do { if (N_LAUNCHES != PER_PHASE) xcd_barrier(bar); } while (0)
    const int lo = args.ph_lo, hi = args.ph_hi;
#define IN(k) (lo <= (k) && (k) < hi)
#define BOTH(k) (IN(k) && IN((k) + 1))

    if (IN(0)) { p0_prologue(F, args); if (BOTH(0)) GRID_BAR(); }

    if (IN(1)) {
        pg8::Gemm g{F.XN(), F.WinT(), F.XN(), F.WinT(), 1024, 1024, 1024}; pg8::StaticOrder S; S.init(SEQ, NPROJ, F.G, (int)blockIdx.x);
        pg8::EpiProj E{F.Q(), F.KV(), F.U(), F.BR(), F.GN(), F.GL(), F.MG()};
        pg8::gemm_phase<pg8::EpiProj, pg8::StaticOrder, true>(F.lds, g, S, E, F.wave);
        if (BOTH(1)) GRID_BAR();
    }

    if (IN(2)) {
        for (int i = F.vcu; i < 256; i += F.G) {
            lru_tile<false>(F, args, i);
            if (!args.pad) qk_norm_tile(F, args, i);
            vt_tile(F, i);
            __syncthreads();
            compress_item(F, args, i & 1, (i >> 1) & 1, i >> 2);
        }
        if (BOTH(2)) GRID_BAR();
    }

    if (IN(3)) {
        for (int i = F.vcu; i < 256; i += F.G) { lru_tile<true>(F, args, i); }
        __syncthreads();
#pragma unroll 1
        for (int it = 2 * F.vcu; it < 512; it += 2 * F.G) {
#pragma unroll 1
            for (int j = 0; j < 2; ++j) { const int i = it >> 1; att::attn_item(F, j ? i : 255 - i, j ? 0 : 1); }
        }
        if (BOTH(3)) GRID_BAR();
    }

    if (IN(4)) {
        pg8::Gemm g{F.XN(), F.WaT(), F.XN() + 512, F.WbT(), 1024, 512, 512}; pg8::DualOrder S; S.init(SEQ, 1024, F.G, (int)blockIdx.x);
        pg8::EpiMerge E{F.MB(), F.MG()};
        pg8::gemm_phase<pg8::EpiMerge, pg8::DualOrder, true>(F.lds, g, S, E, F.wave);
        if (BOTH(4)) GRID_BAR();
    }

    if (IN(5)) {
        pg8::Gemm g{F.MB(), F.WoutT(), F.MB(), F.WoutT(), 1024, 1024, 1024}; pg8::StaticOrder S; S.init(SEQ, 1024, F.G, (int)blockIdx.x);
        pg8::EpiOut E{args.in[0], args.out};
        pg8::gemm_phase<pg8::EpiOut, pg8::StaticOrder, true>(F.lds, g, S, E, F.wave);
    }
#undef IN
#undef BOTH
}

extern "C" void kernel_launch(void* const* d_in, const int* in_sizes, int n_in, void* d_out, int out_size, void* d_ws, size_t ws_size, hipStream_t stream) {
    static int grid = 0;
    if (grid == 0) {
        if (n_in != 20 || in_sizes[0] != SEQ * DM || out_size != SEQ * DM || ws_size < WS_END) { fprintf(stderr, "kernel_launch: unexpected shapes (n_in %d, in0 %d, out %d, ws %zu)\n", n_in, n_in > 0 ? in_sizes[0] : -1, out_size, ws_size); grid = -1; return; }
        int dev = 0, cus = 0, per_cu = 0;
        if (hipGetDevice(&dev) != hipSuccess || hipDeviceGetAttribute(&cus, hipDeviceAttributeMultiprocessorCount, dev) != hipSuccess) { grid = -1; return; }
        if (hipFuncSetAttribute((const void*)nsa_lru_fwd, hipFuncAttributeMaxDynamicSharedMemorySize, LDS_BYTES) != hipSuccess) { fprintf(stderr, "kernel_launch: hipFuncSetAttribute failed\n"); grid = -1; return; }
        if (hipOccupancyMaxActiveBlocksPerMultiprocessor(&per_cu, (const void*)nsa_lru_fwd, NWAVES * 64, LDS_BYTES) != hipSuccess || per_cu < 1)
            fprintf(stderr, "kernel_launch: occupancy query reports %d workgroups per CU\n", per_cu);
        (void)hipGetLastError();
        grid = cus;
    }
    if (grid < 0) return;
    if (hipMemsetAsync((char*)d_ws + WS_CTL, 0, CTL_ZERO_BYTES, stream) != hipSuccess) { fprintf(stderr, "kernel_launch: hipMemsetAsync failed\n"); return; }
    Args a{};
    for (int i = 0; i < 20; ++i) a.in[i] = (const float*)d_in[i];
    a.out = (float*)d_out; a.ws = (unsigned char*)d_ws;
    const int nl = (PROBE_DUP >= 0) ? 2 : N_LAUNCHES;
    for (int li = 0; li < nl; ++li) {
        if (PROBE_DUP >= 0) { a.ph_lo = li ? PROBE_DUP : 0; a.ph_hi = li ? PER_PHASE : PROBE_DUP + 1; a.li = li; a.pad = (li && PROBE_DUP == 2) ? 1 : 0; }
        else { a.ph_lo = (N_LAUNCHES == PER_PHASE) ? li : 0; a.ph_hi = (N_LAUNCHES == PER_PHASE) ? li + 1 : PER_PHASE; a.li = li; }
        hipLaunchKernelGGL(nsa_lru_fwd, dim3(grid), dim3(NWAVES * 64), LDS_BYTES, stream, a);
        const hipError_t le = hipPeekAtLastError();
        if (le != hipSuccess) { fprintf(stderr, "kernel_launch: launch %d failed: %s\n", li, hipGetErrorName(le)); break; }
    }
}
```

```cpp
#include <hip/hip_runtime.h>
#include <cstdio>
#include <cstdint>

#ifndef PROBE_DUP
#define PROBE_DUP -1
#endif
#ifndef MK_N_LAUNCHES
#define MK_N_LAUNCHES 1
#endif

#define GAS __attribute__((address_space(1)))
#define LAS __attribute__((address_space(3)))
typedef unsigned short bf16;
typedef short bf16x8 __attribute__((ext_vector_type(8)));
typedef short s16x4 __attribute__((ext_vector_type(4)));
typedef float f32x4 __attribute__((ext_vector_type(4)));
typedef float f32x16 __attribute__((ext_vector_type(16)));
typedef unsigned u32x4 __attribute__((ext_vector_type(4)));
typedef unsigned u32x2 __attribute__((ext_vector_type(2)));
typedef GAS unsigned gu32;

constexpr int SEQ = 16384, DM = 1024;
constexpr int NPROJ = 5120;
constexpr float LOG2E = 1.4426950408889634f;
constexpr float RMS_EPS = 1e-6f;

__device__ __forceinline__ unsigned f2bf(float f) { unsigned u = __builtin_bit_cast(unsigned, f); return (u + 0x7fffu + ((u >> 16) & 1u)) >> 16; }
__device__ __forceinline__ unsigned pk2(float lo, float hi) { return f2bf(lo) | (f2bf(hi) << 16); }
__device__ __forceinline__ float bf2f(unsigned h) { return __builtin_bit_cast(float, h << 16); }
__device__ __forceinline__ float bflo(unsigned w) { return __builtin_bit_cast(float, w << 16); }
__device__ __forceinline__ float bfhi(unsigned w) { return __builtin_bit_cast(float, w & 0xffff0000u); }
typedef float f32x2_t __attribute__((ext_vector_type(2))); typedef __bf16 bf16x2_t __attribute__((ext_vector_type(2)));
__device__ __forceinline__ unsigned cvtpk(float lo, float hi) { f32x2_t v = {lo, hi}; bf16x2_t b = __builtin_convertvector(v, bf16x2_t); return __builtin_bit_cast(unsigned, b); }
__device__ __forceinline__ float fsigmoid(float v) { return __builtin_amdgcn_rcpf(1.0f + __builtin_amdgcn_exp2f(-v * LOG2E)); }
template <int CTRL> __device__ __forceinline__ float dpp_f(float v) { return __builtin_bit_cast(float, __builtin_amdgcn_update_dpp(0, __builtin_bit_cast(int, v), CTRL, 0xf, 0xf, true)); }
template <int CTRL> __device__ __forceinline__ int dpp_i(int v) { return __builtin_amdgcn_update_dpp(v, v, CTRL, 0xf, 0xf, false); }
__device__ __forceinline__ int lane_id() { int l = (int)__builtin_amdgcn_mbcnt_hi(~0u, __builtin_amdgcn_mbcnt_lo(~0u, 0u)); asm volatile("" : "+v"(l)); return l; }
__device__ __forceinline__ float wave_sum(float v) {
#pragma unroll
    for (int o = 1; o < 64; o <<= 1) v += __shfl_xor(v, o);
    return v;
}

namespace pg8 {
#define PG8_LAS __attribute__((address_space(3)))
typedef unsigned short bf16_t;
constexpr int BM = 256, BK = 64, HALF = 128, HTB = HALF * BK * 2, STAGE_BYTES = 8 * HTB, NXCD = 8, WGM = 8;
__host__ __device__ __forceinline__ int lds_byte(int r, int c) { const int st = (r >> 4) * 2 + (c >> 5), rr = r & 15, cc = c & 31, ob = rr * 64 + cc * 2; return st * 1024 + (ob ^ (((ob >> 9) & 1) << 5)); }
__host__ __device__ __forceinline__ void stage_rc(int b, int& R, int& C) { const int st = b / 1024, sb = b % 1024, swz = sb ^ (((sb >> 9) & 1) << 5); R = (st >> 1) * 16 + swz / 64; C = (st & 1) * 32 + (swz % 64) / 2; }
__host__ __device__ __forceinline__ int perm32(int rho) { const int n = rho >> 4, i = rho & 15; return 8 * (i >> 2) + 4 * n + (i & 3); }

struct Unit { int pm, pn, part; };
struct Gemm { const bf16_t* A; const bf16_t* Bt; const bf16_t* A2; const bf16_t* Bt2; int lda, ldb, K; };

struct StaticOrder {
    int nM, nN, nwg, G, c;
    __host__ __device__ void init(int M, int N, int G_, int c_) { nM = M / BM; nN = N / BM; nwg = nM * nN; G = G_; c = c_; }
    __host__ __device__ bool tile(long L, Unit& u) const {
        if (L >= nwg) return false;
        int wgid = (int)L; { const int q = nwg / NXCD, r = nwg % NXCD, xcd = wgid % NXCD, off = wgid / NXCD; wgid = (xcd < r ? xcd * (q + 1) : r * (q + 1) + (xcd - r) * q) + off; }
        const int nig = WGM * nN, gid = wgid / nig, fm = gid * WGM, gsz = (nM - fm) < WGM ? (nM - fm) : WGM;
        u.pm = fm + ((wgid % nig) % gsz); u.pn = (wgid % nig) / gsz; u.part = 0; return true;
    }
    __host__ __device__ bool next(int i, Unit& u) const { return tile((long)i * G + c, u); }
};
struct DualOrder : StaticOrder {
    __host__ __device__ bool next(int i, Unit& u) const { if (!tile((long)(i >> 1) * G + c, u)) return false; u.part = i & 1; return true; }
};

__device__ __forceinline__ unsigned cvt_pk_bf16(float lo, float hi) { unsigned r; asm volatile("v_cvt_pk_bf16_f32 %0, %1, %2" : "=v"(r) : "v"(lo), "v"(hi)); return r; }

struct EpiProj {
    static constexpr bool PERM = true, INIT = false;
    bf16_t *Q, *KV, *U, *BR, *GN, *GL, *MG;
    __device__ __forceinline__ void operator()(const f32x4 (&acc)[2][2][4][2], const Unit& u, int wr, int wc, int fr, int fq) const {
        const int pn = u.pn; bf16_t* base; int ldc, colt, act = 0;
        if (pn < 2) { base = Q; ldc = 512; colt = pn * 256; }
        else if (pn < 5) { base = KV; ldc = 768; colt = (pn - 2) * 256; }
        else if (pn < 7) { base = U; ldc = 512; colt = (pn - 5) * 256; }
        else if (pn < 8) { base = BR; ldc = 256; colt = 0; }
        else if (pn < 10) { base = GN; ldc = 512; colt = (pn - 8) * 256; act = 1; }
        else if (pn < 12) { base = GL; ldc = 512; colt = (pn - 10) * 256; act = 1; }
        else { base = MG; ldc = 2048; colt = (pn - 12) * 256; act = 2; }
        const int row0 = u.pm * BM + wr * 64 + fr, col0 = colt + wc * 32 + 8 * fq;
#pragma unroll
        for (int ai = 0; ai < 2; ++ai)
#pragma unroll
            for (int m = 0; m < 4; ++m) { bf16_t* rowp = base + (size_t)(row0 + ai * HALF + m * 16) * ldc + col0;
#pragma unroll
                for (int bj = 0; bj < 2; ++bj) { f32x4 v0 = acc[ai][bj][m][0], v1 = acc[ai][bj][m][1];
                    if (act) {
#pragma unroll
                        for (int e = 0; e < 4; ++e) { const float s0 = fsigmoid(v0[e]), s1 = fsigmoid(v1[e]); v0[e] = (act == 1) ? v0[e] * s0 : s0; v1[e] = (act == 1) ? v1[e] * s1 : s1; } }
                    u32x4 w; w.x = cvt_pk_bf16(v0[0], v0[1]); w.y = cvt_pk_bf16(v0[2], v0[3]); w.z = cvt_pk_bf16(v1[0], v1[1]); w.w = cvt_pk_bf16(v1[2], v1[3]);
                    *(u32x4*)(rowp + bj * HALF) = w; } }
    }
};
struct EpiMerge {
    static constexpr bool PERM = true, INIT = false;
    bf16_t* Mb; const bf16_t* MG;
    __device__ __forceinline__ void operator()(const f32x4 (&acc)[2][2][4][2], const Unit& u, int wr, int wc, int fr, int fq) const {
        const int row0 = u.pm * BM + wr * 64 + fr, col0 = u.pn * BM + wc * 32 + 8 * fq;
#pragma unroll
        for (int ai = 0; ai < 2; ++ai)
#pragma unroll
            for (int m = 0; m < 4; ++m) { const size_t r = (size_t)(row0 + ai * HALF + m * 16);
#pragma unroll
                for (int bj = 0; bj < 2; ++bj) { const f32x4 v0 = acc[ai][bj][m][0], v1 = acc[ai][bj][m][1];
                    const u32x4 gw = *(const u32x4*)(MG + r * 2048 + u.part * 1024 + col0 + bj * HALF);
                    float o[8] = {v0[0] * bflo(gw.x), v0[1] * bfhi(gw.x), v0[2] * bflo(gw.y), v0[3] * bfhi(gw.y), v1[0] * bflo(gw.z), v1[1] * bfhi(gw.z), v1[2] * bflo(gw.w), v1[3] * bfhi(gw.w)};
                    bf16_t* dst = Mb + r * 1024 + col0 + bj * HALF;
                    if (u.part) { const u32x4 pw = *(const u32x4*)dst;
                        o[0] += bflo(pw.x); o[1] += bfhi(pw.x); o[2] += bflo(pw.y); o[3] += bfhi(pw.y); o[4] += bflo(pw.z); o[5] += bfhi(pw.z); o[6] += bflo(pw.w); o[7] += bfhi(pw.w); }
                    u32x4 w; w.x = cvt_pk_bf16(o[0], o[1]); w.y = cvt_pk_bf16(o[2], o[3]); w.z = cvt_pk_bf16(o[4], o[5]); w.w = cvt_pk_bf16(o[6], o[7]);
                    *(u32x4*)dst = w; } }
    }
};
struct EpiOut {
    static constexpr bool PERM = false, INIT = true;
    const float* X; float* O;
    __device__ __forceinline__ void init(f32x4 (&acc)[2][2][4][2], const Unit& u, int wr, int wc, int fr, int fq) const {
        const int row0 = u.pm * BM + wr * 64 + fr, col0 = u.pn * BM + wc * 32 + 4 * fq;
#pragma unroll
        for (int ai = 0; ai < 2; ++ai)
#pragma unroll
            for (int m = 0; m < 4; ++m) { const size_t off = (size_t)(row0 + ai * HALF + m * 16) * 1024 + col0;
#pragma unroll
                for (int bj = 0; bj < 2; ++bj)
#pragma unroll
                    for (int n = 0; n < 2; ++n) acc[ai][bj][m][n] = *(const f32x4*)(X + off + bj * HALF + n * 16); }
    }
    __device__ __forceinline__ void operator()(const f32x4 (&acc)[2][2][4][2], const Unit& u, int wr, int wc, int fr, int fq) const {
        const int row0 = u.pm * BM + wr * 64 + fr, col0 = u.pn * BM + wc * 32 + 4 * fq;
#pragma unroll
        for (int ai = 0; ai < 2; ++ai)
#pragma unroll
            for (int m = 0; m < 4; ++m) { const size_t off = (size_t)(row0 + ai * HALF + m * 16) * 1024 + col0;
#pragma unroll
                for (int bj = 0; bj < 2; ++bj)
#pragma unroll
                    for (int n = 0; n < 2; ++n) *(f32x4*)(O + off + bj * HALF + n * 16) = acc[ai][bj][m][n]; }
    }
};

template <class Epi, class Sched, bool ALIGN_EPI>
__device__ __forceinline__ void gemm_phase(PG8_LAS unsigned char* lds, const Gemm g, const Sched& S, const Epi& E, int wid) {
    const int lane = lane_id(), tid = wid * 64 + lane, wr = wid >> 2, wc = wid & 3, fr = lane & 15, fq = lane >> 4;
    const int K = g.K, nt = K / BK;
    unsigned voffA[2], voffB[2];
#pragma unroll
    for (int i = 0; i < 2; ++i) { int R, C; stage_rc(tid * 16 + i * 8192, R, C); const int Rb = Epi::PERM ? ((R & ~31) + perm32(R & 31)) : R;
        voffA[i] = (unsigned)(R * g.lda + C) * 2u; voffB[i] = (unsigned)(Rb * g.ldb + C) * 2u; }
    const size_t kstep = (size_t)(BK * 2);
    const size_t hstepA = (size_t)HALF * g.lda * 2, hstepB = (size_t)HALF * g.ldb * 2;
    const size_t tstepA = 2 * hstepA, tstepB = 2 * hstepB;
    const unsigned ldsw = (unsigned)wid * 1024u;
    const int aoff = lds_byte(wr * 64 + fr, fq * 8), boff = lds_byte(wc * 32 + fr, fq * 8);
#define PG8_SA(b, h) (((b) * 2 + (h)) * HTB)
#define PG8_SB(b, h) ((4 + (b) * 2 + (h)) * HTB)
#define PG8_STAGE(bufoff, gbase, voff) do { _Pragma("unroll") for (int _i = 0; _i < 2; ++_i) \
        __builtin_amdgcn_global_load_lds((const unsigned*)((const char*)(gbase) + (voff)[_i]), (PG8_LAS unsigned*)(lds + (bufoff) + ldsw + _i * 8192), 16, 0, 0); } while (0)
#define PG8_LDA(dst, b, h) do { _Pragma("unroll") for (int m = 0; m < 4; ++m) _Pragma("unroll") for (int k = 0; k < 2; ++k) dst[m][k] = *(const PG8_LAS bf16x8*)(lds + PG8_SA(b, h) + aoff + m * 2048 + k * 1024); } while (0)
#define PG8_LDB(dst, b, h) do { _Pragma("unroll") for (int n = 0; n < 2; ++n) _Pragma("unroll") for (int k = 0; k < 2; ++k) dst[n][k] = *(const PG8_LAS bf16x8*)(lds + PG8_SB(b, h) + boff + n * 2048 + k * 1024); } while (0)
#define PG8_MMA(ai, bj, At, Bt) do { __builtin_amdgcn_s_setprio(1); _Pragma("unroll") for (int m = 0; m < 4; ++m) _Pragma("unroll") for (int n = 0; n < 2; ++n) _Pragma("unroll") for (int k = 0; k < 2; ++k) \
        acc[ai][bj][m][n] = __builtin_amdgcn_mfma_f32_16x16x32_bf16(Bt[n][k], At[m][k], acc[ai][bj][m][n], 0, 0, 0); __builtin_amdgcn_s_setprio(0); } while (0)
#define PG8_WAIT_V(n) asm volatile("s_waitcnt vmcnt(" #n ")" ::: "memory")
#define PG8_WAIT_L(n) asm volatile("s_waitcnt lgkmcnt(" #n ")" ::: "memory")
#define PG8_BAR __builtin_amdgcn_s_barrier()
#define PG8_SCHED __builtin_amdgcn_sched_barrier(0)
#define PG8_UA(u) ((const char*)((u).part ? g.A2 : g.A) + (size_t)(u).pm * tstepA)
#define PG8_UB(u) ((const char*)((u).part ? g.Bt2 : g.Bt) + (size_t)(u).pn * tstepB)
    Unit cur, nxt; int ui = 0;
    if (!S.next(0, cur)) return;
    f32x4 acc[2][2][4][2];
    if constexpr (Epi::INIT) E.init(acc, cur, wr, wc, fr, fq);
    else {
#pragma unroll
    for (int a = 0; a < 2; ++a)
#pragma unroll
        for (int b = 0; b < 2; ++b)
#pragma unroll
            for (int m = 0; m < 4; ++m)
#pragma unroll
                for (int n = 0; n < 2; ++n) acc[a][b][m][n] = (f32x4){0.f, 0.f, 0.f, 0.f};
    }
    bf16x8 At[4][2], B0[2][2], B1[2][2];
    const char* cA = PG8_UA(cur); const char* cB = PG8_UB(cur);
    PG8_STAGE(PG8_SB(0, 0), cB, voffB); PG8_STAGE(PG8_SB(0, 1), cB + hstepB, voffB); PG8_STAGE(PG8_SA(0, 0), cA, voffA); PG8_STAGE(PG8_SA(0, 1), cA + hstepA, voffA);
    if (wr == 1) PG8_BAR;
    PG8_WAIT_V(2); PG8_BAR;
    PG8_STAGE(PG8_SB(1, 0), cB + kstep, voffB); PG8_STAGE(PG8_SA(1, 0), cA + kstep, voffA); PG8_STAGE(PG8_SB(1, 1), cB + hstepB + kstep, voffB);
    PG8_WAIT_V(6); PG8_BAR;
    for (;;) {
        const bool has_next = S.next(ui + 1, nxt);
        const char* nA = has_next ? PG8_UA(nxt) : cA; const char* nB = has_next ? PG8_UB(nxt) : cB;
        for (int t = 0; t < nt; t += 2) {
            const bool last = (t == nt - 2);
            const char* a1 = cA + (size_t)(t + 1) * kstep;
            const char* a2 = last ? nA : cA + (size_t)(t + 2) * kstep; const char* b2 = last ? nB : cB + (size_t)(t + 2) * kstep;
            const char* a3 = a2 + kstep; const char* b3 = b2 + kstep;
            PG8_LDB(B0, 0, 0); PG8_LDB(B1, 0, 1); PG8_SCHED; PG8_LDA(At, 0, 0); PG8_STAGE(PG8_SA(1, 1), a1 + hstepA, voffA);
            PG8_WAIT_V(8); PG8_WAIT_L(0); PG8_BAR; PG8_MMA(0, 0, At, B0); PG8_MMA(0, 1, At, B1); PG8_BAR; PG8_SCHED;
            PG8_LDA(At, 0, 1); PG8_STAGE(PG8_SB(0, 0), b2, voffB); PG8_STAGE(PG8_SB(0, 1), b2 + hstepB, voffB); PG8_STAGE(PG8_SA(0, 0), a2, voffA);
            PG8_WAIT_V(8); PG8_WAIT_L(0); PG8_BAR; PG8_MMA(1, 0, At, B0); PG8_MMA(1, 1, At, B1); PG8_BAR; PG8_SCHED;
            PG8_LDB(B0, 1, 0); PG8_LDB(B1, 1, 1); PG8_SCHED; PG8_LDA(At, 1, 0); PG8_STAGE(PG8_SA(0, 1), a2 + hstepA, voffA);
            PG8_WAIT_V(8); PG8_WAIT_L(0); PG8_BAR; PG8_MMA(0, 0, At, B0); PG8_MMA(0, 1, At, B1); PG8_BAR; PG8_SCHED;
            PG8_LDA(At, 1, 1); PG8_STAGE(PG8_SB(1, 0), b3, voffB); PG8_STAGE(PG8_SB(1, 1), b3 + hstepB, voffB); PG8_STAGE(PG8_SA(1, 0), a3, voffA);
            PG8_WAIT_V(8); PG8_WAIT_L(0); PG8_BAR; PG8_MMA(1, 0, At, B0); PG8_MMA(1, 1, At, B1); PG8_BAR; PG8_SCHED;
        }
        if constexpr (ALIGN_EPI) { if (wr == 0) PG8_BAR; }
        E(acc, cur, wr, wc, fr, fq);
        if (!has_next) break;
        if constexpr (Epi::INIT) E.init(acc, nxt, wr, wc, fr, fq);
        else {
#pragma unroll
        for (int a = 0; a < 2; ++a)
#pragma unroll
            for (int b = 0; b < 2; ++b)
#pragma unroll
                for (int m = 0; m < 4; ++m)
#pragma unroll
                    for (int n = 0; n < 2; ++n) acc[a][b][m][n] = (f32x4){0.f, 0.f, 0.f, 0.f};
        }
        cur = nxt; cA = nA; cB = nB; ++ui;
        if constexpr (ALIGN_EPI) { if (wr == 1) PG8_BAR; }
    }
    PG8_WAIT_V(0);
    if constexpr (!ALIGN_EPI) { if (wr == 0) PG8_BAR; }
    PG8_BAR;
#undef PG8_SA
#undef PG8_SB
#undef PG8_STAGE
#undef PG8_LDA
#undef PG8_LDB
#undef PG8_MMA
#undef PG8_WAIT_V
#undef PG8_WAIT_L
#undef PG8_BAR
#undef PG8_SCHED
#undef PG8_UA
#undef PG8_UB
}
}

constexpr int NWAVES = 8;
constexpr int N_LAUNCHES = MK_N_LAUNCHES;
constexpr int PER_PHASE = 6;
constexpr size_t MiB = 1u << 20;
constexpr size_t WS_CTL = 0, CTL_ZERO_BYTES = 65536;
constexpr size_t WS_WIN = 1 * MiB;
constexpr size_t WS_WA = 11 * MiB;
constexpr size_t WS_WB = 12 * MiB;
constexpr size_t WS_WOUT = 13 * MiB;
constexpr size_t WS_W1T = 15 * MiB;
constexpr size_t WS_SMALL = 17 * MiB;
constexpr size_t WS_SUM = 18 * MiB;
constexpr size_t WS_KC = 19 * MiB;
constexpr size_t WS_XN = 20 * MiB;
constexpr size_t WS_Q = 52 * MiB;
constexpr size_t WS_KV = 68 * MiB;
constexpr size_t WS_MB = 52 * MiB;
constexpr size_t WS_U = 92 * MiB;
constexpr size_t WS_BR = 108 * MiB;
constexpr size_t WS_GN = 116 * MiB;
constexpr size_t WS_GL = 132 * MiB;
constexpr size_t WS_MG = 148 * MiB;
constexpr size_t WS_VT = 212 * MiB;
constexpr size_t WS_KT = 216 * MiB;
constexpr size_t WS_Q2 = 220 * MiB;
constexpr size_t WS_END = 236 * MiB;
constexpr size_t SM_W2T = 0;
constexpr size_t SM_LWA = 65536;
constexpr size_t SM_LWX = 131072;
constexpr size_t SM_C1 = 262144;
constexpr size_t SM_LUT = 200704;
constexpr int CW_BAR = 4096;

constexpr int RING_BYTES = 160768;
constexpr int LDSCTL_OFF = RING_BYTES, MISC_OFF = LDSCTL_OFF + 320;
constexpr int LDS_BYTES = 163840;

#define RLX_AGENT __ATOMIC_RELAXED, __HIP_MEMORY_SCOPE_AGENT
#define LDS_WAIT() asm volatile("s_waitcnt lgkmcnt(0)" ::: "memory")
#define VM_WAIT() asm volatile("s_waitcnt vmcnt(0)" ::: "memory")

#define XB_TMO      128
#define XB_XCNT(j)  (256  + 64 * (j))
#define XB_XSUB(j)  (1280 + 64 * (j))
#define XB_XGEN(j)  (2304 + 64 * (j))
#define XB_TOP      3328
#define XB_TOPGEN   3392
#define XCD_BAR_WORDS 3456
#define XB_SPIN_CAP (1u << 18)
__device__ __forceinline__ unsigned xb_ld(unsigned* p)              { return __hip_atomic_load(p, __ATOMIC_RELAXED, __HIP_MEMORY_SCOPE_AGENT); }
__device__ __forceinline__ unsigned xb_add(unsigned* p, unsigned v) { return __hip_atomic_fetch_add(p, v, __ATOMIC_RELAXED, __HIP_MEMORY_SCOPE_AGENT); }
__device__ __forceinline__ unsigned xb_xcc_id() { return (unsigned)__builtin_amdgcn_s_getreg((3 << 11) | 20) & 0xFu; }
#define XB_SPIN(cond, bar) do { unsigned _sp = 0; while (cond) { __builtin_amdgcn_s_sleep(1); \
    if ((++_sp & 255u) == 0u) { if (xb_ld(&(bar)[XB_TMO])) break; if (_sp > XB_SPIN_CAP) { atomicAdd(&(bar)[XB_TMO], 1u); break; } } } } while (0)
struct XcdBarrier { unsigned* bar; unsigned x; volatile LAS unsigned* st; };
__device__ __forceinline__ XcdBarrier xcd_barrier_post(unsigned* bar, volatile LAS unsigned* st) {
    XcdBarrier b; b.bar = bar; b.x = xb_xcc_id(); b.st = st;
    if (threadIdx.x == 0) (void)xb_add(&bar[XB_XCNT(b.x)], 1u);
    return b;
}
__device__ __forceinline__ void xcd_barrier_complete(unsigned* bar, unsigned x, unsigned& nloc, unsigned& nx) {
    const unsigned G = gridDim.x * gridDim.y * gridDim.z;
    unsigned sum, cnt, mine, sp = 0u;
    for (;;) {
        sum = 0u; cnt = 0u; mine = 0u;
#pragma unroll
        for (unsigned j = 0; j < 16; ++j) { const unsigned c = xb_ld(&bar[XB_XCNT(j)]); sum += c; cnt += (c > 0u) ? 1u : 0u; mine = (j == x) ? c : mine; }
        if (sum == G) break;
        __builtin_amdgcn_s_sleep(1);
        if ((++sp & 255u) == 0u) { if (xb_ld(&bar[XB_TMO])) break; if (sp > XB_SPIN_CAP) { atomicAdd(&bar[XB_TMO], 1u); break; } }
    }
    nloc = mine > 0u ? mine : 1u; nx = cnt > 0u ? cnt : 1u;
}
__device__ __forceinline__ void xcd_barrier(const XcdBarrier& b) {
    asm volatile("s_waitcnt vmcnt(0)" ::: "memory");
    __syncthreads();
    if (threadIdx.x == 0) {
        unsigned* bar = b.bar;
        __builtin_amdgcn_s_waitcnt(0);
        unsigned nloc = b.st[0], nx = b.st[1];
        if (nloc == 0u) { xcd_barrier_complete(bar, b.x, nloc, nx); b.st[0] = nloc; b.st[1] = nx; }
        const unsigned old = xb_add(&bar[XB_XSUB(b.x)], 1u);
        const unsigned gen = old / nloc;
        if (old + 1u == (gen + 1u) * nloc) {
            __builtin_amdgcn_fence(__ATOMIC_RELEASE, "agent");
            asm volatile("s_waitcnt vmcnt(0)" ::: "memory");
            const unsigned og = xb_add(&bar[XB_TOP], 1u);
            const unsigned tg = og / nx;
            if (og + 1u == (tg + 1u) * nx) xb_add(&bar[XB_TOPGEN], 1u);
            else XB_SPIN(xb_ld(&bar[XB_TOPGEN]) == tg, bar);
            __builtin_amdgcn_fence(__ATOMIC_ACQUIRE, "agent");
            xb_add(&bar[XB_XGEN(b.x)], 1u);
            asm volatile("s_waitcnt vmcnt(0)" ::: "memory");
        } else {
            XB_SPIN(xb_ld(&bar[XB_XGEN(b.x)]) == gen, bar);
            __builtin_amdgcn_fence(__ATOMIC_ACQUIRE, "agent");
            asm volatile("s_waitcnt vmcnt(0)" ::: "memory");
        }
    }
    __syncthreads();
}

struct Args { const float* in[20]; float* out; unsigned char* ws; int ph_lo, ph_hi, li, pad; };
struct Frame {
    LAS unsigned char* lds;
    volatile LAS unsigned* MISC;
    int wave;
    int vcu, G;
    unsigned char* ws;
#define WSP(name, T, off) __device__ __forceinline__ T* name() const { return (T*)(ws + (off)); }
    WSP(WinT, bf16, WS_WIN) WSP(WaT, bf16, WS_WA) WSP(WbT, bf16, WS_WB) WSP(WoutT, bf16, WS_WOUT) WSP(W1T, bf16, WS_W1T)
    WSP(W2T, bf16, WS_SMALL + SM_W2T) WSP(LWA, bf16, WS_SMALL + SM_LWA) WSP(LWX, bf16, WS_SMALL + SM_LWX)
    WSP(C1, float, WS_SMALL + SM_C1) WSP(LUT, float, WS_SMALL + SM_LUT) WSP(SUMA, float, WS_SUM) WSP(SUMB, float, WS_SUM + 524288)
    WSP(KC, bf16, WS_KC) WSP(VC, bf16, WS_KC + 524288) WSP(XN, bf16, WS_XN) WSP(Q, bf16, WS_Q) WSP(KV, bf16, WS_KV) WSP(MB, bf16, WS_MB)
    WSP(VT, bf16, WS_VT) WSP(KT, bf16, WS_KT) WSP(Q2, bf16, WS_Q2) WSP(U, bf16, WS_U) WSP(BR, bf16, WS_BR) WSP(GN, bf16, WS_GN) WSP(GL, bf16, WS_GL) WSP(MG, bf16, WS_MG)
#undef WSP
};

__device__ __forceinline__ int t5_bucket(int n) {
    if (n < 16) return n;
    const int thr[15] = {19, 21, 24, 27, 31, 35, 40, 46, 52, 59, 67, 77, 87, 99, 113};
    int b = 16;
#pragma unroll
    for (int i = 0; i < 15; ++i) b += (n >= thr[i]) ? 1 : 0;
    return b;
}

__device__ __forceinline__ void p0_tr_item(const float* W, int ldw, int k0, int srccol0, int nvalid, bf16* WT, int ldt, int dstrow0, LAS float* scr, int lane) {
    const int c = lane & 31;
    float tv[32];
#pragma unroll
    for (int i = 0; i < 32; ++i) { const int kk = 2 * i + (lane >> 5); tv[i] = (c < nvalid) ? W[(size_t)(k0 + kk) * ldw + srccol0 + c] : 0.f; }
#pragma unroll
    for (int i = 0; i < 32; ++i) { const int kk = 2 * i + (lane >> 5); scr[kk * 33 + c] = tv[i]; }
    LDS_WAIT(); asm volatile("" ::: "memory");
    const int cc = lane & 7;
#pragma unroll
    for (int j = 0; j < 4; ++j) { const int n = (lane >> 3) + 8 * j; const LAS float* s = scr + (8 * cc) * 33 + n;
        u32x4 o; o.x = pk2(s[0 * 33], s[1 * 33]); o.y = pk2(s[2 * 33], s[3 * 33]); o.z = pk2(s[4 * 33], s[5 * 33]); o.w = pk2(s[6 * 33], s[7 * 33]);
        *(u32x4*)(WT + (size_t)(dstrow0 + n) * ldt + k0 + 8 * cc) = o; }
    LDS_WAIT(); asm volatile("" ::: "memory");
}
__device__ __forceinline__ void win_src(int n0, int& src, int& nvalid) {
    nvalid = 32;
    if (n0 < 1280) src = n0;
    else if (n0 < 1792) src = 1816 + (n0 - 1280);
    else if (n0 < 2048) { src = 1792 + (n0 - 1792); nvalid = (n0 == 1792) ? 24 : 0; if (n0 != 1792) src = 0; }
    else if (n0 < 2560) src = 1280 + (n0 - 2048);
    else if (n0 < 3072) src = 2328 + (n0 - 2560);
    else src = 2840 + (n0 - 3072);
}
__device__ __forceinline__ void p0_prologue(const Frame& F, const Args& A) {
    LAS float* scr = (LAS float*)(F.lds + F.wave * 16384);
    const int gw = F.vcu * NWAVES + F.wave, NGW = F.G * NWAVES, lane = lane_id();
    constexpr int I_WIN = 16 * 160, I_WA = 8 * 32, I_WO = 16 * 32, I_W1 = 32 * 8, I_W2 = 4 * 2, I_LR = 2;
    constexpr int NIT = I_WIN + 2 * I_WA + I_WO + 2 * I_W1 + 2 * I_W2 + 16 * I_LR + 256 + 1;
    for (int it = gw; it < NIT; it += NGW) {
        int r = it;
        if (r < I_WIN) { const int kb = r / 160, nb = r % 160; int src, nv; win_src(32 * nb, src, nv); p0_tr_item(A.in[2], 4888, 64 * kb, src, nv, F.WinT(), 1024, 32 * nb, scr, lane); continue; } r -= I_WIN;
        if (r < I_WA) { p0_tr_item(A.in[17], 1024, 64 * (r / 32), 32 * (r % 32), 32, F.WaT(), 512, 32 * (r % 32), scr, lane); continue; } r -= I_WA;
        if (r < I_WA) { p0_tr_item(A.in[18], 1024, 64 * (r / 32), 32 * (r % 32), 32, F.WbT(), 512, 32 * (r % 32), scr, lane); continue; } r -= I_WA;
        if (r < I_WO) { p0_tr_item(A.in[19], 1024, 64 * (r / 32), 32 * (r % 32), 32, F.WoutT(), 1024, 32 * (r % 32), scr, lane); continue; } r -= I_WO;
        if (r < 2 * I_W1) { const int kv = r / I_W1, q = r % I_W1; p0_tr_item(A.in[6] + (size_t)kv * 2048 * 256, 256, 64 * (q / 8), 32 * (q % 8), 32, F.W1T() + (size_t)kv * 256 * 2048, 2048, 32 * (q % 8), scr, lane); continue; } r -= 2 * I_W1;
        if (r < 2 * I_W2) { const int kv = r / I_W2, q = r % I_W2; p0_tr_item(A.in[8] + (size_t)kv * 256 * 64, 64, 64 * (q / 2), 32 * (q % 2), 32, F.W2T() + (size_t)kv * 64 * 256, 256, 32 * (q % 2), scr, lane); continue; } r -= 2 * I_W2;
        if (r < 16 * I_LR) { const int mtx = r / 2, nb = r % 2; const float* src = (mtx < 8 ? A.in[12] : A.in[14]) + (size_t)(mtx & 7) * 4096; bf16* dst = (mtx < 8 ? F.LWA() : F.LWX()) + (size_t)(mtx & 7) * 4096;
            p0_tr_item(src, 64, 0, 32 * nb, 32, dst, 64, 32 * nb, scr, lane); continue; } r -= 16 * I_LR;
        if (r < 256) {
            const int kc = r >> 3, kv = (r >> 2) & 1, n = (r & 3) * 64 + lane; const float* w1 = A.in[6] + (size_t)kv * 2048 * 256 + (size_t)(64 * kc) * 256 + n; const float* pe = A.in[5] + kv * 2048 + 64 * kc;
            float s0 = 0.f, s1 = 0.f, s2 = 0.f, s3 = 0.f;
#pragma unroll 4
            for (int k = 0; k < 64; k += 4) { s0 += pe[k] * w1[(size_t)k * 256]; s1 += pe[k + 1] * w1[(size_t)(k + 1) * 256]; s2 += pe[k + 2] * w1[(size_t)(k + 2) * 256]; s3 += pe[k + 3] * w1[(size_t)(k + 3) * 256]; }
            F.C1()[(kc * 2 + kv) * 256 + n] = (s0 + s1) + (s2 + s3); continue; } r -= 256;
        {
            for (int e = lane; e < 1024; e += 64) { const int hd = e >> 7, n = e & 127; F.LUT()[e] = A.in[9][t5_bucket(n) * 8 + hd] * LOG2E; }
        }
    }
    const float* gain = A.in[1];
    {
        f32x4 v[4], vn[4];
        if (gw < SEQ) { const f32x4* xr = (const f32x4*)(A.in[0] + (size_t)gw * DM) + lane;
#pragma unroll
            for (int j = 0; j < 4; ++j) v[j] = xr[64 * j]; }
        for (int m = gw; m < SEQ; m += NGW) {
            if (m + NGW < SEQ) { const f32x4* xr = (const f32x4*)(A.in[0] + (size_t)(m + NGW) * DM) + lane;
#pragma unroll
                for (int j = 0; j < 4; ++j) vn[j] = xr[64 * j]; }
            float s = 0.f;
#pragma unroll
            for (int j = 0; j < 4; ++j) s += (v[j].x * v[j].x + v[j].y * v[j].y) + (v[j].z * v[j].z + v[j].w * v[j].w);
            const float rs = 1.0f / sqrtf(wave_sum(s) * (1.f / DM) + RMS_EPS);
            unsigned long long* o8 = (unsigned long long*)(F.XN() + (size_t)m * DM) + lane;
#pragma unroll
            for (int j = 0; j < 4; ++j) { const f32x4 gv = ((const f32x4*)gain)[lane + 64 * j];
                o8[64 * j] = (unsigned long long)pk2(v[j].x * rs * gv.x, v[j].y * rs * gv.y) | ((unsigned long long)pk2(v[j].z * rs * gv.z, v[j].w * rs * gv.w) << 32); }
#pragma unroll
            for (int j = 0; j < 4; ++j) v[j] = vn[j];
        }
    }
}

template <bool FINAL>
__device__ __forceinline__ void lru_tile(const Frame& F, const Args& A, int tt) {
    const int lane = lane_id();
    const int w = F.wave, fr = lane & 15, fq = lane >> 4, ch0 = 64 * w, t0 = 64 * tt;
    LAS float* UC = (LAS float*)(F.lds + w * 16384);
#define UC_IDX(tok, ch) ((tok) * 64 + ((((ch) >> 2) ^ ((tok) & 15)) << 2) + ((ch) & 3))
    float Hc = 0.f;
    if (FINAL) {
        const float* sa = F.SUMA() + ch0 + lane; const float* sb = F.SUMB() + ch0 + lane;
        int i = 0;
        for (; i + 16 <= tt; i += 16) { float ta[16], tb[16];
#pragma unroll
            for (int k = 0; k < 16; ++k) { ta[k] = sa[(size_t)(i + k) * 512]; tb[k] = sb[(size_t)(i + k) * 512]; }
#pragma unroll
            for (int k = 0; k < 16; ++k) Hc = ta[k] * Hc + tb[k]; }
        for (; i < tt; ++i) Hc = sa[(size_t)i * 512] * Hc + sb[(size_t)i * 512];
        asm volatile("" : "+v"(Hc));
    }
    {
        const int ch = ch0 + lane; const float* cw = A.in[10]; const float cb = A.in[11][ch];
        const float w0 = cw[ch], w1 = cw[512 + ch], w2 = cw[1024 + ch], w3 = cw[1536 + ch];
        const bf16* up = F.U() + (size_t)t0 * 512 + ch;
        float u0 = 0.f, u1 = 0.f, u2 = 0.f;
        if (tt > 0) { u0 = bf2f(up[-3 * 512]); u1 = bf2f(up[-2 * 512]); u2 = bf2f(up[-1 * 512]); }
#pragma unroll 16
        for (int tok = 0; tok < 64; ++tok) { const float u3 = bf2f(up[(size_t)tok * 512]);
            UC[UC_IDX(tok, lane)] = cb + ((u0 * w0 + u1 * w1) + (u2 * w2 + u3 * w3)); u0 = u1; u1 = u2; u2 = u3; }
    }
    bf16x8 Ba[4][2], Bx[4][2];
#pragma unroll
    for (int nt = 0; nt < 4; ++nt)
#pragma unroll
        for (int ks = 0; ks < 2; ++ks) { const size_t o = (size_t)w * 4096 + (16 * nt + fr) * 64 + 32 * ks + 8 * fq; Ba[nt][ks] = *(const bf16x8*)(F.LWA() + o); Bx[nt][ks] = *(const bf16x8*)(F.LWX() + o); }
    float ba[4], bx[4], sp8[4], hin[4], acum[4];
#pragma unroll
    for (int nt = 0; nt < 4; ++nt) { const int ch = ch0 + 16 * nt + fr; ba[nt] = A.in[13][ch]; bx[nt] = A.in[15][ch];
        sp8[nt] = 8.0f * log1pf(expf(-A.in[16][ch])); hin[nt] = 0.f; acum[nt] = 1.f; }
    if (FINAL) {
#pragma unroll
        for (int nt = 0; nt < 4; ++nt) hin[nt] = __shfl(Hc, 16 * nt + fr);
    }
    LDS_WAIT();
#pragma unroll 1
    for (int mt = 0; mt < 4; ++mt) {
        bf16x8 Af[2];
#pragma unroll
        for (int ks = 0; ks < 2; ++ks) { const int tok = 16 * mt + fr, c0 = 8 * ks + 2 * fq;
            const f32x4 x0 = *(const LAS f32x4*)(UC + tok * 64 + ((c0 ^ (tok & 15)) << 2)), x1 = *(const LAS f32x4*)(UC + tok * 64 + (((c0 + 1) ^ (tok & 15)) << 2));
            u32x4 pw; pw.x = cvtpk(x0[0], x0[1]); pw.y = cvtpk(x0[2], x0[3]); pw.z = cvtpk(x1[0], x1[1]); pw.w = cvtpk(x1[2], x1[3]); Af[ks] = __builtin_bit_cast(bf16x8, pw); }
        f32x4 cr[4], ci[4];
#pragma unroll
        for (int nt = 0; nt < 4; ++nt) { cr[nt] = (f32x4){0.f, 0.f, 0.f, 0.f}; ci[nt] = (f32x4){0.f, 0.f, 0.f, 0.f};
#pragma unroll
            for (int ks = 0; ks < 2; ++ks) { cr[nt] = __builtin_amdgcn_mfma_f32_16x16x32_bf16(Af[ks], Ba[nt][ks], cr[nt], 0, 0, 0); ci[nt] = __builtin_amdgcn_mfma_f32_16x16x32_bf16(Af[ks], Bx[nt][ks], ci[nt], 0, 0, 0); } }
#pragma unroll
        for (int nt = 0; nt < 4; ++nt) {
            float P[4], Hh[4];
#pragma unroll
            for (int rg = 0; rg < 4; ++rg) { const int tok = 16 * mt + 4 * fq + rg, e = 16 * nt + fr;
                const float ucv = UC[UC_IDX(tok, e)];
                const float r = fsigmoid(cr[nt][rg] + ba[nt]), ig = fsigmoid(ci[nt][rg] + bx[nt]);
                const float la = -r * sp8[nt]; const float a = __builtin_amdgcn_exp2f(la * LOG2E);
                const float x2 = 2.0f * la;
                const float ser = -x2 * (1.0f + x2 * (0.5f + x2 * (0.16666667f + x2 * (0.041666668f + x2 * 0.008333334f))));
                const float om = (x2 > -0.25f) ? ser : 1.0f - a * a;
                const float b = __builtin_amdgcn_sqrtf(om) * (ig * ucv);
                if (rg == 0) { P[0] = a; Hh[0] = b; } else { P[rg] = P[rg - 1] * a; Hh[rg] = a * Hh[rg - 1] + b; } }
            float At = P[3], Bt = Hh[3];
            { const float Ap = __shfl_up(At, 16), Bp = __shfl_up(Bt, 16); if (fq >= 1) { Bt = At * Bp + Bt; At = Ap * At; } }
            { const float Ap = __shfl_up(At, 32), Bp = __shfl_up(Bt, 32); if (fq >= 2) { Bt = At * Bp + Bt; At = Ap * At; } }
            float Aex = __shfl_up(At, 16), Bex = __shfl_up(Bt, 16); if (fq == 0) { Aex = 1.f; Bex = 0.f; }
            const float hg = Aex * hin[nt] + Bex;
            float hv[4];
#pragma unroll
            for (int rg = 0; rg < 4; ++rg) hv[rg] = P[rg] * hg + Hh[rg];
            hin[nt] = __shfl(hv[3], 48 + fr);
            if (!FINAL) acum[nt] *= __shfl(At, 48 + fr);
            if (FINAL) {
#pragma unroll
                for (int rg = 0; rg < 4; ++rg) { const size_t t = (size_t)(t0 + 16 * mt + 4 * fq + rg); const int ch = ch0 + 16 * nt + fr;
                    F.XN()[t * 1024 + 512 + ch] = (bf16)f2bf(hv[rg] * bf2f(F.GL()[t * 512 + ch])); }
            }
        }
    }
    if (!FINAL && fq == 0) {
#pragma unroll
        for (int nt = 0; nt < 4; ++nt) { F.SUMA()[(size_t)tt * 512 + ch0 + 16 * nt + fr] = acum[nt]; F.SUMB()[(size_t)tt * 512 + ch0 + 16 * nt + fr] = hin[nt]; }
    }
    LDS_WAIT();
#undef UC_IDX
}

__device__ __forceinline__ void qk_norm_tile(const Frame& F, const Args& A, int tt) {
    const int lane = lane_id(), sub = lane & 7;
#pragma unroll 2
    for (int it = 0; it < 12; ++it) {
        const int idx = it * 64 + F.wave * 8 + (lane >> 3), tok = idx / 12, hr = idx % 12; const size_t t = (size_t)(64 * tt + tok);
        bf16* p; bf16* dst; const float* gain; float sc = 1.f;
        if (hr < 8) { p = F.Q() + t * 512 + hr * 64; dst = F.Q2() + t * 512 + (hr >> 2) * 256 + (sub >> 1) * 64 + (hr & 3) * 16 + (sub & 1) * 8 - sub * 8; gain = A.in[3]; sc = 0.125f * LOG2E; }
        else if (hr < 10) { p = F.KV() + t * 768 + 256 + (hr - 8) * 64; dst = p; gain = A.in[4] + 64; }
        else { p = F.KV() + t * 768 + 512 + (hr - 10) * 64; dst = p; gain = A.in[4] + 128; }
        const u32x4 w = *(const u32x4*)(p + sub * 8);
        float x[8] = {bflo(w.x), bfhi(w.x), bflo(w.y), bfhi(w.y), bflo(w.z), bfhi(w.z), bflo(w.w), bfhi(w.w)};
        float ss = 0.f;
#pragma unroll
        for (int j = 0; j < 8; ++j) ss += x[j] * x[j];
        ss += __shfl_xor(ss, 1); ss += __shfl_xor(ss, 2); ss += __shfl_xor(ss, 4);
        const float rs = sc / sqrtf(ss * (1.f / 64.f) + RMS_EPS);
        const f32x4 g0 = *(const f32x4*)(gain + sub * 8), g1 = *(const f32x4*)(gain + sub * 8 + 4);
        u32x4 o; o.x = pk2(x[0] * rs * g0.x, x[1] * rs * g0.y); o.y = pk2(x[2] * rs * g0.z, x[3] * rs * g0.w); o.z = pk2(x[4] * rs * g1.x, x[5] * rs * g1.y); o.w = pk2(x[6] * rs * g1.z, x[7] * rs * g1.w);
        *(u32x4*)(dst + sub * 8) = o;
        if (hr >= 8 && hr < 10) *(u32x4*)(F.KT() + ((size_t)((hr - 8) * 256 + tt) * 8 + sub) * 512 + tok * 8) = o;
    }
}

__device__ __forceinline__ void vt_tile(const Frame& F, int J) {
    const int tid = F.wave * 64 + lane_id(), d = tid & 63, ks = (tid >> 6) & 1, gp = tid >> 7;
#pragma unroll
    for (int g = 0; g < 2; ++g) {
        const bf16* vp = F.KV() + (size_t)(64 * J) * 768 + 384 + 64 * g + d;
        unsigned short e[8];
#pragma unroll
        for (int j = 0; j < 8; ++j) { const int key = 32 * ks + 4 * gp + (j & 3) + 16 * (j >> 2); e[j] = vp[(size_t)key * 768]; }
        u32x4 w; w.x = e[0] | ((unsigned)e[1] << 16); w.y = e[2] | ((unsigned)e[3] << 16); w.z = e[4] | ((unsigned)e[5] << 16); w.w = e[6] | ((unsigned)e[7] << 16);
        *(u32x4*)(F.VT() + (size_t)(g * 256 + J) * 4096 + ((((d >> 4) * 2 + ks) * 16 + (d & 15)) * 32) + 8 * gp) = w;
    }
}

__device__ __forceinline__ void compress_item(const Frame& F, const Args& A, int kv, int g, int ct) {
    const int lane = lane_id(), w = F.wave, tid = w * 64 + lane, fr = lane & 15, fq = lane >> 4, c0 = 16 * ct, tb = 16 * c0;
    LAS unsigned char* T = F.lds;
    LAS bf16* HID = (LAS bf16*)(F.lds + 34816);
    LAS float* OUTF = (LAS float*)(F.lds + 34816 + 8448);
    for (int idx = tid; idx < 272 * 8; idx += 512) { const int tok = idx >> 3, chn = idx & 7, gt = tb + tok;
        u32x4 v = (u32x4){0u, 0u, 0u, 0u};
        if (gt < SEQ) v = *(const u32x4*)(F.KV() + (size_t)gt * 768 + kv * 128 + g * 64 + chn * 8);
        *(LAS u32x4*)(T + tok * 128 + ((chn ^ ((tok >> 4) & 7)) << 4)) = v; }
    LDS_WAIT(); __syncthreads();
    f32x4 acc[2] = {(f32x4){0.f, 0.f, 0.f, 0.f}, (f32x4){0.f, 0.f, 0.f, 0.f}};
    const bf16* w1t = F.W1T() + (size_t)kv * 256 * 2048 + (size_t)(32 * w + fr) * 2048 + 8 * fq;
#pragma unroll 8
    for (int ks = 0; ks < 64; ++ks) {
        const int tok = 16 * fr + (ks >> 1), chn = 4 * (ks & 1) + fq;
        const bf16x8 a = *(const LAS bf16x8*)(T + tok * 128 + ((chn ^ ((tok >> 4) & 7)) << 4));
        const bf16x8 b0 = *(const bf16x8*)(w1t + 32 * ks), b1 = *(const bf16x8*)(w1t + (size_t)16 * 2048 + 32 * ks);
        acc[0] = __builtin_amdgcn_mfma_f32_16x16x32_bf16(a, b0, acc[0], 0, 0, 0);
        acc[1] = __builtin_amdgcn_mfma_f32_16x16x32_bf16(a, b1, acc[1], 0, 0, 0);
    }
#pragma unroll
    for (int nt = 0; nt < 2; ++nt) { const int n = 32 * w + 16 * nt + fr; float c1 = A.in[7][kv * 256 + n];
#pragma unroll 8
        for (int kc = 0; kc < 32; ++kc) c1 += F.C1()[(kc * 2 + kv) * 256 + n];
#pragma unroll
        for (int rg = 0; rg < 4; ++rg) { const float v = acc[nt][rg] + c1; HID[(4 * fq + rg) * 264 + n] = (bf16)f2bf(v * fsigmoid(v)); } }
    LDS_WAIT(); __syncthreads();
    if (w < 4) {
        f32x4 o = (f32x4){0.f, 0.f, 0.f, 0.f};
        const bf16* w2t = F.W2T() + (size_t)kv * 64 * 256 + (size_t)(16 * w + fr) * 256 + 8 * fq;
#pragma unroll
        for (int ks = 0; ks < 8; ++ks) { const bf16x8 a = *(const LAS bf16x8*)(HID + fr * 264 + 32 * ks + 8 * fq); const bf16x8 b = *(const bf16x8*)(w2t + 32 * ks);
            o = __builtin_amdgcn_mfma_f32_16x16x32_bf16(a, b, o, 0, 0, 0); }
#pragma unroll
        for (int rg = 0; rg < 4; ++rg) OUTF[(4 * fq + rg) * 64 + 16 * w + fr] = o[rg];
    }
    LDS_WAIT(); __syncthreads();
    {
        const int row = tid >> 5, e = 2 * (tid & 31), c = c0 + row;
        float v0 = OUTF[row * 64 + e], v1 = OUTF[row * 64 + e + 1];
        if (kv == 0) { float ss = v0 * v0 + v1 * v1;
#pragma unroll
            for (int o = 1; o < 32; o <<= 1) ss += __shfl_xor(ss, o);
            const float rs = 1.0f / sqrtf(ss * (1.f / 64.f) + RMS_EPS); v0 *= rs * A.in[4][e]; v1 *= rs * A.in[4][e + 1]; }
        if (c >= 1023) { v0 = 0.f; v1 = 0.f; }
        bf16* dst = (kv == 0 ? F.KC() : F.VC()) + ((size_t)g * 1024 + c) * 64 + e;
        *(unsigned*)dst = pk2(v0, v1);
    }
    LDS_WAIT(); __syncthreads();
}

namespace att {
constexpr int SLOTB = 8192, NSLOT = 3;
constexpr int L_K = 0, L_V = NSLOT * SLOTB, L_SC = 2 * NSLOT * SLOTB, L_OUT = L_SC + 65536, L_LUT = L_OUT + 32768, L_WSF = L_LUT + 2048, L_BM = L_WSF + 2048, L_REF = L_BM + 2048, L_LACC = L_REF + 1024, L_TL = L_LACC + 1024  , L_END = L_TL + 5120;
static_assert(L_END <= RING_BYTES, "attention LDS map");
constexpr int L_EX = 0  , L_HDR = 32768  , L_LEX = 33024  , L_NT = 34048  ;
constexpr float CLAMP = 100.0f;
constexpr float THR = 8.0f;
#define SBAR() __builtin_amdgcn_sched_barrier(0)
__device__ __forceinline__ int crow(int r, int hi) { return (r & 3) + 8 * (r >> 2) + 4 * hi; }
__device__ __forceinline__ void glds16(const void* gsrc, unsigned lds_dst) { unsigned keep;
    asm volatile("s_mov_b32 %0, m0\n\ts_mov_b32 m0, %2\n\ts_nop 0\n\tglobal_load_lds_dwordx4 %1, off\n\ts_mov_b32 m0, %0" : "=&s"(keep) : "v"(gsrc), "s"(lds_dst) : "memory"); }
__device__ __forceinline__ void qkt(f32x16& p0, f32x16& p1, const LAS unsigned char* Kslot, const bf16x8* qr, float cinit, int r32, int hi) {
    const LAS unsigned char* kb = Kslot + hi * 1024 + r32 * 16;
#pragma unroll
    for (int r = 0; r < 16; ++r) { p0[r] = cinit; p1[r] = cinit; }
#pragma unroll
    for (int d0 = 0; d0 < 4; ++d0) {
        const bf16x8 b0 = *(const LAS bf16x8*)(kb + d0 * 2048);
        const bf16x8 b1 = *(const LAS bf16x8*)(kb + d0 * 2048 + 512);
        p0 = __builtin_amdgcn_mfma_f32_32x32x16_bf16(b0, qr[d0], p0, 0, 0, 0); p1 = __builtin_amdgcn_mfma_f32_32x32x16_bf16(b1, qr[d0], p1, 0, 0, 0); }
}
__device__ __forceinline__ void pv(f32x16* o, int vb, bf16x8 pa0, bf16x8 pa1, bf16x8 pa2, bf16x8 pa3) {
#pragma unroll
    for (int d0 = 0; d0 < 2; ++d0) { s16x4 lo[4], hi[4];
#pragma unroll
        for (int ks = 0; ks < 4; ++ks) {
            asm volatile("ds_read_b64_tr_b16 %0,%1 offset:%c2" : "=&v"(lo[ks]) : "v"(vb), "i"(d0 * 4096 + ks * 1024) : "memory");
            asm volatile("ds_read_b64_tr_b16 %0,%1 offset:%c2" : "=&v"(hi[ks]) : "v"(vb), "i"(d0 * 4096 + ks * 1024 + 512) : "memory"); }
        asm volatile("s_waitcnt lgkmcnt(0)" ::: "memory"); SBAR();
#define PK(k) (bf16x8){lo[k][0], lo[k][1], lo[k][2], lo[k][3], hi[k][0], hi[k][1], hi[k][2], hi[k][3]}
        o[d0] = __builtin_amdgcn_mfma_f32_32x32x16_bf16(pa0, PK(0), o[d0], 0, 0, 0);
        o[d0] = __builtin_amdgcn_mfma_f32_32x32x16_bf16(pa1, PK(1), o[d0], 0, 0, 0);
        o[d0] = __builtin_amdgcn_mfma_f32_32x32x16_bf16(pa2, PK(2), o[d0], 0, 0, 0);
        o[d0] = __builtin_amdgcn_mfma_f32_32x32x16_bf16(pa3, PK(3), o[d0], 0, 0, 0);
#undef PK
    }
}
__device__ __forceinline__ float rowmax(const f32x16& p0, const f32x16& p1) {
    float a = fmaxf(fmaxf(p0[0], p0[1]), p1[0]), b = fmaxf(fmaxf(p0[2], p0[3]), p1[1]); a = fmaxf(fmaxf(a, p1[2]), p1[3]);
#pragma unroll
    for (int r = 4; r < 16; r += 4) { a = fmaxf(fmaxf(a, p0[r]), p0[r + 1]); b = fmaxf(fmaxf(b, p0[r + 2]), p0[r + 3]); a = fmaxf(fmaxf(a, p1[r]), p1[r + 1]); b = fmaxf(fmaxf(b, p1[r + 2]), p1[r + 3]); }
    const float m = fmaxf(a, b);
    auto rr = __builtin_amdgcn_permlane32_swap(__float_as_uint(m), __float_as_uint(m), false, false);
    return fmaxf(__uint_as_float(rr[0]), __uint_as_float(rr[1]));
}
__device__ __forceinline__ float halfsum(float v) { auto rr = __builtin_amdgcn_permlane32_swap(__float_as_uint(v), __float_as_uint(v), false, false); return __uint_as_float(rr[0]) + __uint_as_float(rr[1]); }
template <int STEP, unsigned LIMIT>
__device__ __forceinline__ void near_apply(f32x16& p0, f32x16& p1, int dbase, const LAS float* lut) {
#pragma unroll
    for (int r = 0; r < 16; ++r) { const int koff = (r & 3) + 8 * (r >> 2); const int d0 = dbase - STEP * koff, d1 = d0 - STEP * 32;
        const int i0 = min(max(d0, 0), 127), i1 = min(max(d1, 0), 127);
        const float b0 = lut[i0], b1 = lut[i1];
        p0[r] = ((unsigned)d0 < LIMIT) ? p0[r] + b0 : -INFINITY; p1[r] = ((unsigned)d1 < LIMIT) ? p1[r] + b1 : -INFINITY; }
}
template <bool HASO>
__device__ __forceinline__ void sm_update(f32x16& p0, f32x16& p1, float& m, float& l, f32x16* o, LAS float* wsf, int r32, int hi) {
    const float rm = rowmax(p0, p1);
    const bool need = rm > m + THR;
    if (__any(need)) {
        const float mn = need ? rm : m; const float alpha = __builtin_amdgcn_exp2f(m - mn);
        l *= alpha; m = mn;
        if (HASO) { if (hi == 0) wsf[r32] = alpha; LDS_WAIT();
#pragma unroll
            for (int r = 0; r < 16; ++r) { const float f = wsf[crow(r, hi)]; o[0][r] *= f; o[1][r] *= f; } }
    }
    float s = 0.f;
#pragma unroll
    for (int r = 0; r < 16; ++r) { p0[r] = __builtin_amdgcn_exp2f(p0[r] - m); p1[r] = __builtin_amdgcn_exp2f(p1[r] - m); s += p0[r] + p1[r]; }
    l += s;
}
#define ATT_PACK(P0, P1) \
    const bf16x8 pa0 = __builtin_bit_cast(bf16x8, (u32x4){cvtpk(P0[0], P0[1]), cvtpk(P0[2], P0[3]), cvtpk(P0[4], P0[5]), cvtpk(P0[6], P0[7])}); \
    const bf16x8 pa1 = __builtin_bit_cast(bf16x8, (u32x4){cvtpk(P0[8], P0[9]), cvtpk(P0[10], P0[11]), cvtpk(P0[12], P0[13]), cvtpk(P0[14], P0[15])}); \
    const bf16x8 pa2 = __builtin_bit_cast(bf16x8, (u32x4){cvtpk(P1[0], P1[1]), cvtpk(P1[2], P1[3]), cvtpk(P1[4], P1[5]), cvtpk(P1[6], P1[7])}); \
    const bf16x8 pa3 = __builtin_bit_cast(bf16x8, (u32x4){cvtpk(P1[8], P1[9]), cvtpk(P1[10], P1[11]), cvtpk(P1[12], P1[13]), cvtpk(P1[14], P1[15])});
#define ATT_WAITBAR(N) asm volatile("s_waitcnt vmcnt(" #N ") lgkmcnt(0)\n\ts_barrier" ::: "memory")
#define ATT_FILL(V, x) do { _Pragma("unroll") for (int _r = 0; _r < 16; ++_r) V[_r] = (x); } while (0)

__device__ __forceinline__ unsigned rangemask(int k, int a, int b) {
    const int lo = max(a - 32 * k, 0), hi = min(b - 32 * k, 31);
    return (lo > hi) ? 0u : ((0xFFFFFFFFu >> (31 - hi)) & (0xFFFFFFFFu << lo));
}
__device__ __forceinline__ int wave_max_i32(int x) {
    x = max(x, dpp_i<0xB1>(x)); x = max(x, dpp_i<0x4E>(x)); x = max(x, dpp_i<0x141>(x)); x = max(x, dpp_i<0x140>(x));
    return max(max(__builtin_amdgcn_readlane(x, 0), __builtin_amdgcn_readlane(x, 16)), max(__builtin_amdgcn_readlane(x, 32), __builtin_amdgcn_readlane(x, 48)));
}

__device__ __forceinline__ void lds_add_f32(LAS float* p, float v) { (void)__hip_atomic_fetch_add(p, v, __ATOMIC_RELAXED, __HIP_MEMORY_SCOPE_WORKGROUP); }

__device__ __forceinline__ void attn_item(const Frame& F, int qt, int g) {
    const int lane = lane_id(), wid = F.wave, tid = wid * 64 + lane, r32 = lane & 31, hi = lane >> 5;
    const int ql = r32 >> 2, h = r32 & 3, cur = qt, t = 64 * qt + 8 * wid + ql, head = 4 * g + h;
    LAS unsigned char* shm = F.lds;
    const unsigned lds0 = (unsigned)(uintptr_t)shm;
    LAS float* wsf = (LAS float*)(shm + L_WSF) + wid * 64;
    LAS float* SC = (LAS float*)(shm + L_SC);
    LAS float* OACC = (LAS float*)(shm + L_SC);
    LAS float* lutl = (LAS float*)(shm + L_LUT);
    const LAS float* luth = lutl + h * 128;
    LAS unsigned* BM = (LAS unsigned*)(shm + L_BM);
    LAS float* REF = (LAS float*)(shm + L_REF);
    LAS float* LACC = (LAS float*)(shm + L_LACC);
    lutl[tid] = F.LUT()[(4 * g + (tid >> 7)) * 128 + (tid & 127)];
    BM[tid] = 0u;
    LAS bf16* QL = (LAS bf16*)(shm + L_OUT);
#pragma unroll
    for (int i = 0; i < 4; ++i) { const int chn = tid + 512 * i;
        *(LAS u32x4*)(QL + (chn >> 5) * 256 + (chn & 31) * 8) = *(const u32x4*)(F.Q2() + (size_t)(64 * qt + (chn >> 5)) * 512 + g * 256 + (chn & 31) * 8); }
    bf16x8 qr[4];
    { const bf16* qp = F.Q2() + (size_t)t * 512 + g * 256 + h * 16 + hi * 8;
#pragma unroll
        for (int d0 = 0; d0 < 4; ++d0) qr[d0] = *(const bf16x8*)(qp + d0 * 64); }
    const float b31 = F.LUT()[head * 128 + 127];
    const float gate_c = fsigmoid(bf2f(F.BR()[(size_t)t * 256 + head])), gate_s = fsigmoid(bf2f(F.BR()[(size_t)t * 256 + 8 + head])), gate_w = fsigmoid(bf2f(F.BR()[(size_t)t * 256 + 16 + head]));
    f32x16 o[2], p0, p1;
    const unsigned kdst = lds0 + L_K + wid * 1024, vdst = lds0 + L_V + wid * 1024;
    const int vrow = 16 * (wid & 3) + (lane >> 2), vcol = (wid >> 2) * 32 + (lane & 3) * 8;
    const int vb0 = (int)(lds0 + L_V) + ((lane >> 4) & 1) * 32 + (lane & 3) * 8 + (4 * hi + ((lane & 15) >> 2)) * 64;
#define DMA_K(base, pitch, row0, slot) glds16((base) + (size_t)((row0) + lane) * (pitch) + wid * 8, (unsigned)__builtin_amdgcn_readfirstlane(kdst + (slot)))
#define DMA_V(base, pitch, row0, slot) glds16((base) + (size_t)((row0) + vrow) * (pitch) + vcol, (unsigned)__builtin_amdgcn_readfirstlane(vdst + (slot)))
#define ROT() do { sl_cur = sl_next; sl_next = (sl_next == (NSLOT - 1) * SLOTB) ? 0 : sl_next + SLOTB; } while (0)
    VM_WAIT(); LDS_WAIT(); __syncthreads();

    const bf16* KCg = F.KC() + (size_t)g * 1024 * 64; const bf16* VCg = F.VC() + (size_t)g * 1024 * 64;
    const int nkt = (qt >> 4) + 1;
    const int tminw = 64 * qt + 8 * wid;
    float m = -1e30f, l = 0.f;
    {
        int sl_cur = 0, sl_next = SLOTB;
        DMA_K(KCg, 64, 0, 0);
        for (int kt = 0; kt < nkt; ++kt) {
            if (kt + 1 < nkt) { DMA_K(KCg, 64, 64 * (kt + 1), sl_next); ATT_WAITBAR(1); } else { ATT_WAITBAR(0); }
            const bool far = (tminw - 31 - 16 * (64 * kt + 63)) >= 128;
            if (far) { qkt(p0, p1, shm + L_K + sl_cur, qr, b31, r32, hi); }
            else { qkt(p0, p1, shm + L_K + sl_cur, qr, 0.f, r32, hi); near_apply<16, 0x80000000u>(p0, p1, t - 31 - 16 * (64 * kt + 4 * hi), luth); }
            sm_update<false>(p0, p1, m, l, o, wsf, r32, hi);
            ROT();
        }
        LDS_WAIT(); __builtin_amdgcn_s_barrier();
    }
    {
        const float lt = halfsum(l); const float rl = lt > 0.f ? 1.0f / lt : 0.f;
        ATT_FILL(o[0], 0.f); ATT_FILL(o[1], 0.f);
        float carry = 0.f;
        int sl_cur = 0, sl_next = SLOTB;
        DMA_K(KCg, 64, 0, 0); DMA_V(VCg, 64, 0, 0);
        for (int kt = 0; kt < nkt; ++kt) {
            if (kt + 1 < nkt) { DMA_K(KCg, 64, 64 * (kt + 1), sl_next); DMA_V(VCg, 64, 64 * (kt + 1), sl_next); ATT_WAITBAR(2); } else { ATT_WAITBAR(0); }
            const bool far = (tminw - 31 - 16 * (64 * kt + 63)) >= 128;
            if (far) { qkt(p0, p1, shm + L_K + sl_cur, qr, b31, r32, hi); }
            else { qkt(p0, p1, shm + L_K + sl_cur, qr, 0.f, r32, hi); near_apply<16, 0x80000000u>(p0, p1, t - 31 - 16 * (64 * kt + 4 * hi), luth); }
#pragma unroll
            for (int r = 0; r < 16; ++r) { p0[r] = __builtin_amdgcn_exp2f(p0[r] - m) * rl; p1[r] = __builtin_amdgcn_exp2f(p1[r] - m) * rl; }
            {
                float q4[8], e[8];
#pragma unroll
                for (int i = 0; i < 4; ++i) { q4[i] = (p0[4 * i] + p0[4 * i + 1]) + (p0[4 * i + 2] + p0[4 * i + 3]); e[i] = p0[4 * i + 3];
                                              q4[4 + i] = (p1[4 * i] + p1[4 * i + 1]) + (p1[4 * i + 2] + p1[4 * i + 3]); e[4 + i] = p1[4 * i + 3]; }
                float newcarry = 0.f;
#pragma unroll
                for (int i = 0; i < 8; ++i) { auto rr = __builtin_amdgcn_permlane32_swap(__float_as_uint(e[i]), __float_as_uint(e[i]), false, false);
                    const float elo = __uint_as_float(rr[0]), ehi = __uint_as_float(rr[1]);
                    if (hi) q4[i] += elo; else if (i < 7) q4[i + 1] += ehi;
                    if (i == 7) newcarry = ehi; }
                if (!hi) q4[0] += carry;
                carry = newcarry;
#pragma unroll
                for (int i = 0; i < 8; ++i) { float v = q4[i]; v += dpp_f<0xB1>(v); v += dpp_f<0x4E>(v); q4[i] = v; }
                if (h == 0) {
#pragma unroll
                    for (int i = 0; i < 8; ++i) SC[(8 * wid + ql) * 256 + 16 * kt + 2 * i + hi] = q4[i]; }
            }
            { ATT_PACK(p0, p1); pv(o, vb0 + sl_cur, pa0, pa1, pa2, pa3); }
            ROT();
        }
        LDS_WAIT(); __builtin_amdgcn_s_barrier();
    }

    if (cur >= 16) {
#pragma unroll 1
        for (int qb = 0; qb < 8; qb += 4) {
            int v[4][4];
#pragma unroll
            for (int u = 0; u < 4; ++u) { const LAS float* row = SC + (8 * wid + qb + u) * 256;
#pragma unroll
                for (int i = 0; i < 4; ++i) { const int J = lane + 64 * i; const int x = __float_as_int(row[J]); v[u][i] = (J >= 1 && J <= cur - 2) ? x : -1; } }
#pragma unroll 1
            for (int round = 0; round < 13; ++round) {
                int wm[4];
#pragma unroll
                for (int u = 0; u < 4; ++u) wm[u] = wave_max_i32(max(max(v[u][0], v[u][1]), max(v[u][2], v[u][3])));
#pragma unroll
                for (int u = 0; u < 4; ++u) {
                    const unsigned long long b0 = __ballot(v[u][0] == wm[u]), b1 = __ballot(v[u][1] == wm[u]), b2 = __ballot(v[u][2] == wm[u]), b3 = __ballot(v[u][3] == wm[u]);
                    int J;
                    if (b0) J = __builtin_ctzll(b0); else if (b1) J = 64 + __builtin_ctzll(b1); else if (b2) J = 128 + __builtin_ctzll(b2); else J = 192 + __builtin_ctzll(b3);
                    const bool mine = (lane == (J & 63));
                    if (mine && (J >> 6) == 0) v[u][0] = -1; if (mine && (J >> 6) == 1) v[u][1] = -1; if (mine && (J >> 6) == 2) v[u][2] = -1; if (mine && (J >> 6) == 3) v[u][3] = -1;
                    const int qloc = 8 * wid + qb + u;
                    if (lane == 0) __hip_atomic_fetch_or(BM + 2 * J + (qloc >> 5), 1u << (qloc & 31), __ATOMIC_RELAXED, __HIP_MEMORY_SCOPE_WORKGROUP);
                }
            }
        }
    }
    LDS_WAIT();
    LAS float* ostg = (LAS float*)(shm + L_SC) + wid * 2048;
    {
        if (hi == 0) wsf[r32] = gate_c; LDS_WAIT();
#pragma unroll
        for (int r = 0; r < 16; ++r) { const float f = wsf[crow(r, hi)]; const int orow = crow(r, hi); ostg[orow * 64 + r32] = o[0][r] * f; ostg[orow * 64 + 32 + r32] = o[1][r] * f; }
    }

    const bf16* Kw = F.KV() + 512 + g * 64; const bf16* Vw = F.KV() + 640 + g * 64;
    {
        m = -1e30f; l = 0.f; ATT_FILL(o[0], 0.f); ATT_FILL(o[1], 0.f);
        const int J0 = max(cur - 8, 0);
        int sl_cur = 0, sl_next = SLOTB;
        DMA_K(Kw, 768, 64 * J0, 0); DMA_V(Vw, 768, 64 * J0, 0);
        for (int J = J0; J <= cur; ++J) {
            if (J + 1 <= cur) { DMA_K(Kw, 768, 64 * (J + 1), sl_next); DMA_V(Vw, 768, 64 * (J + 1), sl_next); ATT_WAITBAR(2); } else { ATT_WAITBAR(0); }
            if (J >= cur - 2 || J == cur - 8) { qkt(p0, p1, shm + L_K + sl_cur, qr, 0.f, r32, hi); near_apply<1, 512u>(p0, p1, t - 64 * J - 4 * hi, luth); }
            else { qkt(p0, p1, shm + L_K + sl_cur, qr, b31, r32, hi); }
            sm_update<true>(p0, p1, m, l, o, wsf, r32, hi);
            { ATT_PACK(p0, p1); pv(o, vb0 + sl_cur, pa0, pa1, pa2, pa3); }
            ROT();
        }
        LDS_WAIT(); __builtin_amdgcn_s_barrier();
        const float lt = halfsum(l); const float fw = lt > 0.f ? gate_w / lt : 0.f;
        if (hi == 0) wsf[r32] = fw; LDS_WAIT();
#pragma unroll
        for (int r = 0; r < 16; ++r) { const float f = wsf[crow(r, hi)]; const int orow = crow(r, hi); ostg[orow * 64 + r32] += o[0][r] * f; ostg[orow * 64 + 32 + r32] += o[1][r] * f; }
        LDS_WAIT();
#pragma unroll
        for (int i = 0; i < 4; ++i) { const int rowl = i * 8 + (lane >> 3), chn = lane & 7;
            const f32x4 a0 = *(const LAS f32x4*)(ostg + rowl * 64 + chn * 8), a1 = *(const LAS f32x4*)(ostg + rowl * 64 + chn * 8 + 4);
            const size_t tt = (size_t)(64 * qt + 8 * wid + (rowl >> 2)); const int col = (4 * g + (rowl & 3)) * 64 + chn * 8;
            *(u32x4*)(F.XN() + tt * 1024 + col) = (u32x4){cvtpk(a0[0], a0[1]), cvtpk(a0[2], a0[3]), cvtpk(a1[0], a1[1]), cvtpk(a1[2], a1[3])}; }
        LDS_WAIT();
    }

    const bf16* Ks = F.KV() + 256 + g * 64; const bf16* Vs = F.KV() + 384 + g * 64;
    {
        m = -1e30f; l = 0.f; ATT_FILL(o[0], 0.f); ATT_FILL(o[1], 0.f);
        const int nA = (cur < 16) ? cur + 1 : 3;
#define JA(i) ((cur < 16) ? (i) : ((i) == 0 ? 0 : cur - 2 + (i)))
        int sl_cur = 0, sl_next = SLOTB;
        DMA_K(Ks, 768, 0, 0); DMA_V(Vs, 768, 0, 0);
        for (int i = 0; i < nA; ++i) {
            const int J = JA(i);
            if (i + 1 < nA) { const int Jn = JA(i + 1); DMA_K(Ks, 768, 64 * Jn, sl_next); DMA_V(Vs, 768, 64 * Jn, sl_next); ATT_WAITBAR(2); } else { ATT_WAITBAR(0); }
            if (J >= cur - 2) { qkt(p0, p1, shm + L_K + sl_cur, qr, 0.f, r32, hi); near_apply<1, 0x80000000u>(p0, p1, t - 64 * J - 4 * hi, luth); }
            else { qkt(p0, p1, shm + L_K + sl_cur, qr, b31, r32, hi); }
            sm_update<true>(p0, p1, m, l, o, wsf, r32, hi);
            { ATT_PACK(p0, p1); pv(o, vb0 + sl_cur, pa0, pa1, pa2, pa3); }
            ROT();
        }
#undef JA
        LDS_WAIT(); __builtin_amdgcn_s_barrier();
        const float lt = halfsum(l);
        if (hi == 0) { REF[32 * wid + r32] = m; LACC[32 * wid + r32] = lt; }
#pragma unroll
        for (int r = 0; r < 16; ++r) { const int orow = 32 * wid + crow(r, hi); OACC[orow * 64 + r32] = o[0][r]; OACC[orow * 64 + 32 + r32] = o[1][r]; }
        LDS_WAIT(); __builtin_amdgcn_s_barrier();
    }

    if (cur >= 16) {
        const int c16 = lane & 15, gq = lane >> 4, qi4 = c16 >> 2;
        const bf16* KTg = F.KT() + (size_t)g * 256 * 4096 + gq * 512 + c16 * 8; const bf16* VTg = F.VT() + (size_t)g * 256 * 4096 + c16 * 32 + 8 * gq;
        const LAS bf16* QLg = QL + (gq >> 1) * 64 + h * 16 + 8 * (gq & 1);
        LAS unsigned* TL = (LAS unsigned*)(shm + L_TL) + wid * 160;
        int ntask = 0;
#pragma unroll 1
        for (int i4 = 0; i4 < 4; ++i4) {
            const int Jl = lane + 64 * i4; int nch = 0;
            unsigned long long mk = 0ull;
            if (Jl >= 1 && Jl <= cur - 2 && (Jl & 7) == wid) { mk = ((unsigned long long)BM[2 * Jl + 1] << 32) | BM[2 * Jl]; nch = (__popcll(mk) + 3) >> 2; }
            int incl = nch;
#pragma unroll
            for (int o = 1; o < 64; o <<= 1) { const int up = __shfl_up(incl, o); if (lane >= o) incl += up; }
            const int base = ntask + incl - nch;
            for (int c = 0; c < nch; ++c) { unsigned e = (unsigned)Jl; int q0 = 0;
#pragma unroll
                for (int k = 0; k < 4; ++k) { int q = q0; if (mk) { q = __builtin_ctzll(mk); mk &= mk - 1; } if (k == 0) q0 = q; e |= (unsigned)q << (8 + 6 * k); }
                if (base + c < 160) TL[base + c] = e; }
            ntask += __shfl(incl, 63);
        }
        ntask = min(ntask, 160);
        LAS bf16* EX = (LAS bf16*)(shm + L_EX); LAS int* HDR = (LAS int*)(shm + L_HDR); LAS float* LEX = (LAS float*)(shm + L_LEX); LAS int* NT = (LAS int*)(shm + L_NT);
        if (lane == 0) NT[wid] = ntask;
        LDS_WAIT(); __builtin_amdgcn_s_barrier();
        int nround = 0;
#pragma unroll
        for (int k = 0; k < 8; ++k) nround = max(nround, __builtin_amdgcn_readfirstlane(NT[k]));
        bf16x8 kfC[8], vfC[8], kfN[8];
#define LOADK(J_, KF) do { const bf16* kp_ = KTg + (size_t)(J_) * 4096; \
            _Pragma("unroll") for (int kt = 0; kt < 4; ++kt) { KF[2 * kt] = *(const bf16x8*)(kp_ + kt * 128); KF[2 * kt + 1] = *(const bf16x8*)(kp_ + 2048 + kt * 128); } } while (0)
#define LOADV(J_, VF) do { const bf16* vp_ = VTg + (size_t)(J_) * 4096; _Pragma("unroll") for (int x = 0; x < 8; ++x) VF[x] = *(const bf16x8*)(vp_ + x * 512); } while (0)
        int n = 0;
        if (ntask > 0) { const int J0 = (int)((unsigned)__builtin_amdgcn_readfirstlane((int)TL[0]) & 255u); LOADK(J0, kfN); }
#pragma unroll 1
        while (n < nround) {
            int Jb = -1, nb = 1;
            if (n < ntask) {
                Jb = (int)((unsigned)__builtin_amdgcn_readfirstlane((int)TL[n]) & 255u);
#pragma unroll
                for (int x = 0; x < 8; ++x) kfC[x] = kfN[x];
                LOADV(Jb, vfC);
                nb = 1; while (n + nb < ntask && (int)((unsigned)__builtin_amdgcn_readfirstlane((int)TL[n + nb]) & 255u) == Jb) ++nb;
                if (n + nb < ntask) { const int Jn = (int)((unsigned)__builtin_amdgcn_readfirstlane((int)TL[n + nb]) & 255u); LOADK(Jn, kfN); }
            }
#pragma unroll 1
            for (int cix = 0; cix < nb; ++cix, ++n) {
                const int buf = n & 1;
                if (Jb >= 0) {
                    const unsigned e_ = (unsigned)__builtin_amdgcn_readfirstlane((int)TL[n]); const int q0_ = (e_ >> 8) & 63;
                    const int myq = (e_ >> (8 + 6 * qi4)) & 63; const bool valid = (qi4 == 0) || (myq != q0_); const int tq = 64 * qt + myq;
                    const LAS bf16* qp_ = QLg + myq * 256; const bf16x8 qg0 = *(const LAS bf16x8*)(qp_), qg1 = *(const LAS bf16x8*)(qp_ + 128);
                    const float ref = REF[4 * myq + h];
                    const bool nearJ = (Jb >= cur - 2);
                    const float cinit = nearJ ? 0.f : (valid ? b31 - ref : -INFINITY);
                    f32x4 s[4];
#pragma unroll
                    for (int kt = 0; kt < 4; ++kt) { s[kt] = (f32x4){cinit, cinit, cinit, cinit};
                        s[kt] = __builtin_amdgcn_mfma_f32_16x16x32_bf16(kfC[2 * kt], qg0, s[kt], 0, 0, 0); s[kt] = __builtin_amdgcn_mfma_f32_16x16x32_bf16(kfC[2 * kt + 1], qg1, s[kt], 0, 0, 0); }
                    if (nearJ) { const float sub = valid ? ref : INFINITY;
#pragma unroll
                        for (int kt = 0; kt < 4; ++kt)
#pragma unroll
                            for (int r = 0; r < 4; ++r) { const int dd = tq - 64 * Jb - (16 * kt + 4 * gq + r); const float bb = luth[min(max(dd, 0), 127)];
                                s[kt][r] = (dd >= 0) ? s[kt][r] + bb - sub : -INFINITY; } }
#pragma unroll
                    for (int kt = 0; kt < 4; ++kt)
#pragma unroll
                        for (int r = 0; r < 4; ++r) s[kt][r] = __builtin_amdgcn_exp2f(fminf(s[kt][r], CLAMP));
                    float ls = (((s[0][0] + s[0][1]) + (s[0][2] + s[0][3])) + ((s[1][0] + s[1][1]) + (s[1][2] + s[1][3]))) + (((s[2][0] + s[2][1]) + (s[2][2] + s[2][3])) + ((s[3][0] + s[3][1]) + (s[3][2] + s[3][3])));
                    { auto r16 = __builtin_amdgcn_permlane16_swap(__float_as_uint(ls), __float_as_uint(ls), false, false); ls = __uint_as_float(r16[0]) + __uint_as_float(r16[1]); }
                    ls = halfsum(ls);
                    bf16x8 pb[2];
#pragma unroll
                    for (int ks = 0; ks < 2; ++ks) pb[ks] = __builtin_bit_cast(bf16x8, (u32x4){cvtpk(s[2 * ks][0], s[2 * ks][1]), cvtpk(s[2 * ks][2], s[2 * ks][3]), cvtpk(s[2 * ks + 1][0], s[2 * ks + 1][1]), cvtpk(s[2 * ks + 1][2], s[2 * ks + 1][3])});
                    LAS bf16* ex = EX + buf * 8192 + ((wid * 4 + qi4) * 4 + h) * 64 + 4 * gq;
#pragma unroll
                    for (int mt = 0; mt < 4; ++mt) { f32x4 ot = (f32x4){0.f, 0.f, 0.f, 0.f};
                        ot = __builtin_amdgcn_mfma_f32_16x16x32_bf16(vfC[2 * mt], pb[0], ot, 0, 0, 0); ot = __builtin_amdgcn_mfma_f32_16x16x32_bf16(vfC[2 * mt + 1], pb[1], ot, 0, 0, 0);
                        *(LAS u32x2*)(ex + 16 * mt) = (u32x2){cvtpk(ot[0], ot[1]), cvtpk(ot[2], ot[3])}; }
                    if (gq == 0) { LEX[buf * 128 + wid * 16 + c16] = ls; if (h == 0) HDR[buf * 32 + wid * 4 + qi4] = valid ? myq : -1; }
                } else if (lane < 4) HDR[buf * 32 + wid * 4 + lane] = -1;
                LDS_WAIT(); __builtin_amdgcn_s_barrier();
                {
                    const int hv = (lane < 32) ? HDR[buf * 32 + lane] : -1;
                    const int li = lane & 15, hsel = li >> 2, dq = (li & 3) * 16;
#pragma unroll
                    for (int pass = 0; pass < 2; ++pass) {
                        const unsigned m0 = (unsigned)__ballot(hv == 8 * wid + 4 * pass + 0), m1 = (unsigned)__ballot(hv == 8 * wid + 4 * pass + 1), m2 = (unsigned)__ballot(hv == 8 * wid + 4 * pass + 2), m3 = (unsigned)__ballot(hv == 8 * wid + 4 * pass + 3);
                        if ((m0 | m1 | m2 | m3) == 0u) continue;
                        unsigned mm = gq == 0 ? m0 : gq == 1 ? m1 : gq == 2 ? m2 : m3;
                        if (mm) { const int q = 8 * wid + 4 * pass + gq;
                            LAS f32x4* ap = (LAS f32x4*)(OACC + (4 * q + hsel) * 64 + dq); f32x4 a0 = ap[0], a1 = ap[1], a2 = ap[2], a3 = ap[3]; float la = 0.f;
                            while (mm) { const int e = __builtin_ctz(mm); mm &= mm - 1;
                                const u32x4 x0 = *(const LAS u32x4*)(EX + buf * 8192 + e * 256 + hsel * 64 + dq), x1 = *(const LAS u32x4*)(EX + buf * 8192 + e * 256 + hsel * 64 + dq + 8);
                                a0[0] += bflo(x0.x); a0[1] += bfhi(x0.x); a0[2] += bflo(x0.y); a0[3] += bfhi(x0.y); a1[0] += bflo(x0.z); a1[1] += bfhi(x0.z); a1[2] += bflo(x0.w); a1[3] += bfhi(x0.w);
                                a2[0] += bflo(x1.x); a2[1] += bfhi(x1.x); a2[2] += bflo(x1.y); a2[3] += bfhi(x1.y); a3[0] += bflo(x1.z); a3[1] += bfhi(x1.z); a3[2] += bflo(x1.w); a3[3] += bfhi(x1.w);
                                la += LEX[buf * 128 + e * 4 + hsel]; }
                            ap[0] = a0; ap[1] = a1; ap[2] = a2; ap[3] = a3;
                            if ((li & 3) == 0) LACC[4 * q + hsel] += la; }
                    }
                }
            }
        }
#undef LOADK
#undef LOADV
    }
    LDS_WAIT(); __builtin_amdgcn_s_barrier();

    {
        if (hi == 0) { const float lt = LACC[32 * wid + r32]; wsf[r32] = lt > 0.f ? gate_s / lt : 0.f; }
        LDS_WAIT();
#pragma unroll
        for (int i = 0; i < 4; ++i) { const int rowl = i * 8 + (lane >> 3), chn = lane & 7, row = 32 * wid + rowl;
            const float f = wsf[rowl];
            const f32x4 a0 = *(const LAS f32x4*)(OACC + row * 64 + chn * 8), a1 = *(const LAS f32x4*)(OACC + row * 64 + chn * 8 + 4);
            const size_t tt = (size_t)(64 * qt + 8 * wid + (rowl >> 2)); const int col = (4 * g + (rowl & 3)) * 64 + chn * 8;
            const u32x4 ov = *(const u32x4*)(F.XN() + tt * 1024 + col);
            const u32x4 gn = *(const u32x4*)(F.GN() + tt * 512 + col);
            u32x4 w; w.x = pk2((bflo(ov.x) + a0[0] * f) * bflo(gn.x), (bfhi(ov.x) + a0[1] * f) * bfhi(gn.x)); w.y = pk2((bflo(ov.y) + a0[2] * f) * bflo(gn.y), (bfhi(ov.y) + a0[3] * f) * bfhi(gn.y));
            w.z = pk2((bflo(ov.z) + a1[0] * f) * bflo(gn.z), (bfhi(ov.z) + a1[1] * f) * bfhi(gn.z)); w.w = pk2((bflo(ov.w) + a1[2] * f) * bflo(gn.w), (bfhi(ov.w) + a1[3] * f) * bfhi(gn.w));
            *(u32x4*)(F.XN() + tt * 1024 + col) = w; }
        VM_WAIT(); LDS_WAIT(); __syncthreads();
    }
#undef DMA_K
#undef DMA_V
#undef ROT
}
}

__global__ void __launch_bounds__(NWAVES * 64, 2) nsa_lru_fwd(Args args) {
    extern __shared__ __attribute__((aligned(16))) unsigned char lds[];
    Frame F;
    F.lds = (LAS unsigned char*)lds;
    F.MISC = (volatile LAS unsigned*)(F.lds + MISC_OFF);
    F.wave = __builtin_amdgcn_readfirstlane((int)(threadIdx.x >> 6));
    F.G = gridDim.x; { const int bx = blockIdx.x; F.vcu = (F.G % 8 == 0) ? (bx % 8) * (F.G / 8) + bx / 8 : bx; }
    F.ws = args.ws;
    gu32* ctl = (gu32*)(args.ws + WS_CTL);
    for (int u = F.wave * 64 + lane_id(); u < (LDS_BYTES - LDSCTL_OFF) / 4; u += NWAVES * 64) ((LAS unsigned*)(F.lds + LDSCTL_OFF))[u] = 0u;
    __syncthreads();
    const int bli = (N_LAUNCHES == PER_PHASE) ? 0 : args.li;
    XcdBarrier bar; bar.bar = (unsigned*)(ctl + CW_BAR) + bli * XCD_BAR_WORDS; bar.x = 0; bar.st = nullptr;
    if (N_LAUNCHES != PER_PHASE) bar = xcd_barrier_post((unsigned*)(ctl + CW_BAR) + bli * XCD_BAR_WORDS, F.MISC + 8);
#define GRID_BAR() do { if (N_LAUNCHES != PER_PHASE) xcd_barrier(bar); } while (0)
    const int lo = args.ph_lo, hi = args.ph_hi;
#define IN(k) (lo <= (k) && (k) < hi)
#define BOTH(k) (IN(k) && IN((k) + 1))

    if (IN(0)) { p0_prologue(F, args); if (BOTH(0)) GRID_BAR(); }

    if (IN(1)) {
        pg8::Gemm g{F.XN(), F.WinT(), F.XN(), F.WinT(), 1024, 1024, 1024}; pg8::StaticOrder S; S.init(SEQ, NPROJ, F.G, (int)blockIdx.x);
        pg8::EpiProj E{F.Q(), F.KV(), F.U(), F.BR(), F.GN(), F.GL(), F.MG()};
        pg8::gemm_phase<pg8::EpiProj, pg8::StaticOrder, true>(F.lds, g, S, E, F.wave);
        if (BOTH(1)) GRID_BAR();
    }

    if (IN(2)) {
        for (int i = F.vcu; i < 256; i += F.G) {
            lru_tile<false>(F, args, i);
            if (!args.pad) qk_norm_tile(F, args, i);
            vt_tile(F, i);
            __syncthreads();
            compress_item(F, args, i & 1, (i >> 1) & 1, i >> 2);
        }
        if (BOTH(2)) GRID_BAR();
    }

    if (IN(3)) {
        for (int i = F.vcu; i < 256; i += F.G) { lru_tile<true>(F, args, i); }
        __syncthreads();
#pragma unroll 1
        for (int it = 2 * F.vcu; it < 512; it += 2 * F.G) {
#pragma unroll 1
            for (int j = 0; j < 2; ++j) { const int i = it >> 1; att::attn_item(F, j ? i : 255 - i, j ? 0 : 1); }
        }
        if (BOTH(3)) GRID_BAR();
    }

    if (IN(4)) {
        pg8::Gemm g{F.XN(), F.WaT(), F.XN() + 512, F.WbT(), 1024, 512, 512}; pg8::DualOrder S; S.init(SEQ, 1024, F.G, (int)blockIdx.x);
        pg8::EpiMerge E{F.MB(), F.MG()};
        pg8::gemm_phase<pg8::EpiMerge, pg8::DualOrder, true>(F.lds, g, S, E, F.wave);
        if (BOTH(4)) GRID_BAR();
    }

    if (IN(5)) {
        pg8::Gemm g{F.MB(), F.WoutT(), F.MB(), F.WoutT(), 1024, 1024, 1024}; pg8::StaticOrder S; S.init(SEQ, 1024, F.G, (int)blockIdx.x);
        pg8::EpiOut E{args.in[0], args.out};
        pg8::gemm_phase<pg8::EpiOut, pg8::StaticOrder, true>(F.lds, g, S, E, F.wave);
    }
#undef IN
#undef BOTH
}

extern "C" void kernel_launch(void* const* d_in, const int* in_sizes, int n_in, void* d_out, int out_size, void* d_ws, size_t ws_size, hipStream_t stream) {
    static int grid = 0;
    if (grid == 0) {
        if (n_in != 20 || in_sizes[0] != SEQ * DM || out_size != SEQ * DM || ws_size < WS_END) { fprintf(stderr, "kernel_launch: unexpected shapes (n_in %d, in0 %d, out %d, ws %zu)\n", n_in, n_in > 0 ? in_sizes[0] : -1, out_size, ws_size); grid = -1; return; }
        int dev = 0, cus = 0, per_cu = 0;
        if (hipGetDevice(&dev) != hipSuccess || hipDeviceGetAttribute(&cus, hipDeviceAttributeMultiprocessorCount, dev) != hipSuccess) { grid = -1; return; }
        if (hipFuncSetAttribute((const void*)nsa_lru_fwd, hipFuncAttributeMaxDynamicSharedMemorySize, LDS_BYTES) != hipSuccess) { fprintf(stderr, "kernel_launch: hipFuncSetAttribute failed\n"); grid = -1; return; }
        if (hipOccupancyMaxActiveBlocksPerMultiprocessor(&per_cu, (const void*)nsa_lru_fwd, NWAVES * 64, LDS_BYTES) != hipSuccess || per_cu < 1)
            fprintf(stderr, "kernel_launch: occupancy query reports %d workgroups per CU\n", per_cu);
        (void)hipGetLastError();
        grid = cus;
    }
    if (grid < 0) return;
    if (hipMemsetAsync((char*)d_ws + WS_CTL, 0, CTL_ZERO_BYTES, stream) != hipSuccess) { fprintf(stderr, "kernel_launch: hipMemsetAsync failed\n"); return; }
    Args a{};
    for (int i = 0; i < 20; ++i) a.in[i] = (const float*)d_in[i];
    a.out = (float*)d_out; a.ws = (unsigned char*)d_ws;
    const int nl = (PROBE_DUP >= 0) ? 2 : N_LAUNCHES;
    for (int li = 0; li < nl; ++li) {
        if (PROBE_DUP >= 0) { a.ph_lo = li ? PROBE_DUP : 0; a.ph_hi = li ? PER_PHASE : PROBE_DUP + 1; a.li = li; a.pad = (li && PROBE_DUP == 2) ? 1 : 0; }
        else { a.ph_lo = (N_LAUNCHES == PER_PHASE) ? li : 0; a.ph_hi = (N_LAUNCHES == PER_PHASE) ? li + 1 : PER_PHASE; a.li = li; }
        hipLaunchKernelGGL(nsa_lru_fwd, dim3(grid), dim3(NWAVES * 64), LDS_BYTES, stream, a);
        const hipError_t le = hipPeekAtLastError();
        if (le != hipSuccess) { fprintf(stderr, "kernel_launch: launch %d failed: %s\n", li, hipGetErrorName(le)); break; }
    }
}
```

```cpp
#include <hip/hip_runtime.h>
#include <cstdio>
#include <cstdint>

#ifndef PROBE_DUP
#define PROBE_DUP -1
#endif
#ifndef MK_N_LAUNCHES
#define MK_N_LAUNCHES 1
#endif

#define GAS __attribute__((address_space(1)))
#define LAS __attribute__((address_space(3)))
typedef unsigned short bf16;
typedef short bf16x8 __attribute__((ext_vector_type(8)));
typedef short s16x4 __attribute__((ext_vector_type(4)));
typedef float f32x4 __attribute__((ext_vector_type(4)));
typedef float f32x16 __attribute__((ext_vector_type(16)));
typedef unsigned u32x4 __attribute__((ext_vector_type(4)));
typedef unsigned u32x2 __attribute__((ext_vector_type(2)));
typedef GAS unsigned gu32;

constexpr int SEQ = 16384, DM = 1024;
constexpr int NPROJ = 5120;
constexpr float LOG2E = 1.4426950408889634f;
constexpr float RMS_EPS = 1e-6f;

__device__ __forceinline__ unsigned f2bf(float f) { unsigned u = __builtin_bit_cast(unsigned, f); return (u + 0x7fffu + ((u >> 16) & 1u)) >> 16; }
__device__ __forceinline__ unsigned pk2(float lo, float hi) { return f2bf(lo) | (f2bf(hi) << 16); }
__device__ __forceinline__ float bf2f(unsigned h) { return __builtin_bit_cast(float, h << 16); }
__device__ __forceinline__ float bflo(unsigned w) { return __builtin_bit_cast(float, w << 16); }
__device__ __forceinline__ float bfhi(unsigned w) { return __builtin_bit_cast(float, w & 0xffff0000u); }
typedef float f32x2_t __attribute__((ext_vector_type(2))); typedef __bf16 bf16x2_t __attribute__((ext_vector_type(2)));
__device__ __forceinline__ unsigned cvtpk(float lo, float hi) { f32x2_t v = {lo, hi}; bf16x2_t b = __builtin_convertvector(v, bf16x2_t); return __builtin_bit_cast(unsigned, b); }
__device__ __forceinline__ float fsigmoid(float v) { return __builtin_amdgcn_rcpf(1.0f + __builtin_amdgcn_exp2f(-v * LOG2E)); }
template <int CTRL> __device__ __forceinline__ float dpp_f(float v) { return __builtin_bit_cast(float, __builtin_amdgcn_update_dpp(0, __builtin_bit_cast(int, v), CTRL, 0xf, 0xf, true)); }
template <int CTRL> __device__ __forceinline__ int dpp_i(int v) { return __builtin_amdgcn_update_dpp(v, v, CTRL, 0xf, 0xf, false); }
__device__ __forceinline__ int lane_id() { int l = (int)__builtin_amdgcn_mbcnt_hi(~0u, __builtin_amdgcn_mbcnt_lo(~0u, 0u)); asm volatile("" : "+v"(l)); return l; }
__device__ __forceinline__ float wave_sum(float v) {
#pragma unroll
    for (int o = 1; o < 64; o <<= 1) v += __shfl_xor(v, o);
    return v;
}

namespace pg8 {
#define PG8_LAS __attribute__((address_space(3)))
typedef unsigned short bf16_t;
constexpr int BM = 256, BK = 64, HALF = 128, HTB = HALF * BK * 2, STAGE_BYTES = 8 * HTB, NXCD = 8, WGM = 8;
__host__ __device__ __forceinline__ int lds_byte(int r, int c) { const int st = (r >> 4) * 2 + (c >> 5), rr = r & 15, cc = c & 31, ob = rr * 64 + cc * 2; return st * 1024 + (ob ^ (((ob >> 9) & 1) << 5)); }
__host__ __device__ __forceinline__ void stage_rc(int b, int& R, int& C) { const int st = b / 1024, sb = b % 1024, swz = sb ^ (((sb >> 9) & 1) << 5); R = (st >> 1) * 16 + swz / 64; C = (st & 1) * 32 + (swz % 64) / 2; }
__host__ __device__ __forceinline__ int perm32(int rho) { const int n = rho >> 4, i = rho & 15; return 8 * (i >> 2) + 4 * n + (i & 3); }

struct Unit { int pm, pn, part; };
struct Gemm { const bf16_t* A; const bf16_t* Bt; const bf16_t* A2; const bf16_t* Bt2; int lda, ldb, K; };

struct StaticOrder {
    int nM, nN, nwg, G, c;
    __host__ __device__ void init(int M, int N, int G_, int c_) { nM = M / BM; nN = N / BM; nwg = nM * nN; G = G_; c = c_; }
    __host__ __device__ bool tile(long L, Unit& u) const {
        if (L >= nwg) return false;
        int wgid = (int)L; { const int q = nwg / NXCD, r = nwg % NXCD, xcd = wgid % NXCD, off = wgid / NXCD; wgid = (xcd < r ? xcd * (q + 1) : r * (q + 1) + (xcd - r) * q) + off; }
        const int nig = WGM * nN, gid = wgid / nig, fm = gid * WGM, gsz = (nM - fm) < WGM ? (nM - fm) : WGM;
        u.pm = fm + ((wgid % nig) % gsz); u.pn = (wgid % nig) / gsz; u.part = 0; return true;
    }
    __host__ __device__ bool next(int i, Unit& u) const { return tile((long)i * G + c, u); }
};
struct DualOrder : StaticOrder {
    __host__ __device__ bool next(int i, Unit& u) const { if (!tile((long)(i >> 1) * G + c, u)) return false; u.part = i & 1; return true; }
};

__device__ __forceinline__ unsigned cvt_pk_bf16(float lo, float hi) { unsigned r; asm volatile("v_cvt_pk_bf16_f32 %0, %1, %2" : "=v"(r) : "v"(lo), "v"(hi)); return r; }

struct EpiProj {
    static constexpr bool PERM = true, INIT = false;
    bf16_t *Q, *KV, *U, *BR, *GN, *GL, *MG;
    __device__ __forceinline__ void operator()(const f32x4 (&acc)[2][2][4][2], const Unit& u, int wr, int wc, int fr, int fq) const {
        const int pn = u.pn; bf16_t* base; int ldc, colt, act = 0;
        if (pn < 2) { base = Q; ldc = 512; colt = pn * 256; }
        else if (pn < 5) { base = KV; ldc = 768; colt = (pn - 2) * 256; }
        else if (pn < 7) { base = U; ldc = 512; colt = (pn - 5) * 256; }
        else if (pn < 8) { base = BR; ldc = 256; colt = 0; }
        else if (pn < 10) { base = GN; ldc = 512; colt = (pn - 8) * 256; act = 1; }
        else if (pn < 12) { base = GL; ldc = 512; colt = (pn - 10) * 256; act = 1; }
        else { base = MG; ldc = 2048; colt = (pn - 12) * 256; act = 2; }
        const int row0 = u.pm * BM + wr * 64 + fr, col0 = colt + wc * 32 + 8 * fq;
#pragma unroll
        for (int ai = 0; ai < 2; ++ai)
#pragma unroll
            for (int m = 0; m < 4; ++m) { bf16_t* rowp = base + (size_t)(row0 + ai * HALF + m * 16) * ldc + col0;
#pragma unroll
                for (int bj = 0; bj < 2; ++bj) { f32x4 v0 = acc[ai][bj][m][0], v1 = acc[ai][bj][m][1];
                    if (act) {
#pragma unroll
                        for (int e = 0; e < 4; ++e) { const float s0 = fsigmoid(v0[e]), s1 = fsigmoid(v1[e]); v0[e] = (act == 1) ? v0[e] * s0 : s0; v1[e] = (act == 1) ? v1[e] * s1 : s1; } }
                    u32x4 w; w.x = cvt_pk_bf16(v0[0], v0[1]); w.y = cvt_pk_bf16(v0[2], v0[3]); w.z = cvt_pk_bf16(v1[0], v1[1]); w.w = cvt_pk_bf16(v1[2], v1[3]);
                    *(u32x4*)(rowp + bj * HALF) = w; } }
    }
};
struct EpiMerge {
    static constexpr bool PERM = true, INIT = false;
    bf16_t* Mb; const bf16_t* MG;
    __device__ __forceinline__ void operator()(const f32x4 (&acc)[2][2][4][2], const Unit& u, int wr, int wc, int fr, int fq) const {
        const int row0 = u.pm * BM + wr * 64 + fr, col0 = u.pn * BM + wc * 32 + 8 * fq;
#pragma unroll
        for (int ai = 0; ai < 2; ++ai)
#pragma unroll
            for (int m = 0; m < 4; ++m) { const size_t r = (size_t)(row0 + ai * HALF + m * 16);
#pragma unroll
                for (int bj = 0; bj < 2; ++bj) { const f32x4 v0 = acc[ai][bj][m][0], v1 = acc[ai][bj][m][1];
                    const u32x4 gw = *(const u32x4*)(MG + r * 2048 + u.part * 1024 + col0 + bj * HALF);
                    float o[8] = {v0[0] * bflo(gw.x), v0[1] * bfhi(gw.x), v0[2] * bflo(gw.y), v0[3] * bfhi(gw.y), v1[0] * bflo(gw.z), v1[1] * bfhi(gw.z), v1[2] * bflo(gw.w), v1[3] * bfhi(gw.w)};
                    bf16_t* dst = Mb + r * 1024 + col0 + bj * HALF;
                    if (u.part) { const u32x4 pw = *(const u32x4*)dst;
                        o[0] += bflo(pw.x); o[1] += bfhi(pw.x); o[2] += bflo(pw.y); o[3] += bfhi(pw.y); o[4] += bflo(pw.z); o[5] += bfhi(pw.z); o[6] += bflo(pw.w); o[7] += bfhi(pw.w); }
                    u32x4 w; w.x = cvt_pk_bf16(o[0], o[1]); w.y = cvt_pk_bf16(o[2], o[3]); w.z = cvt_pk_bf16(o[4], o[5]); w.w = cvt_pk_bf16(o[6], o[7]);
                    *(u32x4*)dst = w; } }
    }
};
struct EpiOut {
    static constexpr bool PERM = false, INIT = true;
    const float* X; float* O;
    __device__ __forceinline__ void init(f32x4 (&acc)[2][2][4][2], const Unit& u, int wr, int wc, int fr, int fq) const {
        const int row0 = u.pm * BM + wr * 64 + fr, col0 = u.pn * BM + wc * 32 + 4 * fq;
#pragma unroll
        for (int ai = 0; ai < 2; ++ai)
#pragma unroll
            for (int m = 0; m < 4; ++m) { const size_t off = (size_t)(row0 + ai * HALF + m * 16) * 1024 + col0;
#pragma unroll
                for (int bj = 0; bj < 2; ++bj)
#pragma unroll
                    for (int n = 0; n < 2; ++n) acc[ai][bj][m][n] = *(const f32x4*)(X + off + bj * HALF + n * 16); }
    }
    __device__ __forceinline__ void operator()(const f32x4 (&acc)[2][2][4][2], const Unit& u, int wr, int wc, int fr, int fq) const {
        const int row0 = u.pm * BM + wr * 64 + fr, col0 = u.pn * BM + wc * 32 + 4 * fq;
#pragma unroll
        for (int ai = 0; ai < 2; ++ai)
#pragma unroll
            for (int m = 0; m < 4; ++m) { const size_t off = (size_t)(row0 + ai * HALF + m * 16) * 1024 + col0;
#pragma unroll
                for (int bj = 0; bj < 2; ++bj)
#pragma unroll
                    for (int n = 0; n < 2; ++n) *(f32x4*)(O + off + bj * HALF + n * 16) = acc[ai][bj][m][n]; }
    }
};

template <class Epi, class Sched, bool ALIGN_EPI>
__device__ __forceinline__ void gemm_phase(PG8_LAS unsigned char* lds, const Gemm g, const Sched& S, const Epi& E, int wid) {
    const int lane = lane_id(), tid = wid * 64 + lane, wr = wid >> 2, wc = wid & 3, fr = lane & 15, fq = lane >> 4;
    const int K = g.K, nt = K / BK;
    unsigned voffA[2], voffB[2];
#pragma unroll
    for (int i = 0; i < 2; ++i) { int R, C; stage_rc(tid * 16 + i * 8192, R, C); const int Rb = Epi::PERM ? ((R & ~31) + perm32(R & 31)) : R;
        voffA[i] = (unsigned)(R * g.lda + C) * 2u; voffB[i] = (unsigned)(Rb * g.ldb + C) * 2u; }
    const size_t kstep = (size_t)(BK * 2);
    const size_t hstepA = (size_t)HALF * g.lda * 2, hstepB = (size_t)HALF * g.ldb * 2;
    const size_t tstepA = 2 * hstepA, tstepB = 2 * hstepB;
    const unsigned ldsw = (unsigned)wid * 1024u;
    const int aoff = lds_byte(wr * 64 + fr, fq * 8), boff = lds_byte(wc * 32 + fr, fq * 8);
#define PG8_SA(b, h) (((b) * 2 + (h)) * HTB)
#define PG8_SB(b, h) ((4 + (b) * 2 + (h)) * HTB)
#define PG8_STAGE(bufoff, gbase, voff) do { _Pragma("unroll") for (int _i = 0; _i < 2; ++_i) \
        __builtin_amdgcn_global_load_lds((const unsigned*)((const char*)(gbase) + (voff)[_i]), (PG8_LAS unsigned*)(lds + (bufoff) + ldsw + _i * 8192), 16, 0, 0); } while (0)
#define PG8_LDA(dst, b, h) do { _Pragma("unroll") for (int m = 0; m < 4; ++m) _Pragma("unroll") for (int k = 0; k < 2; ++k) dst[m][k] = *(const PG8_LAS bf16x8*)(lds + PG8_SA(b, h) + aoff + m * 2048 + k * 1024); } while (0)
#define PG8_LDB(dst, b, h) do { _Pragma("unroll") for (int n = 0; n < 2; ++n) _Pragma("unroll") for (int k = 0; k < 2; ++k) dst[n][k] = *(const PG8_LAS bf16x8*)(lds + PG8_SB(b, h) + boff + n * 2048 + k * 1024); } while (0)
#define PG8_MMA(ai, bj, At, Bt) do { __builtin_amdgcn_s_setprio(1); _Pragma("unroll") for (int m = 0; m < 4; ++m) _Pragma("unroll") for (int n = 0; n < 2; ++n) _Pragma("unroll") for (int k = 0; k < 2; ++k) \
        acc[ai][bj][m][n] = __builtin_amdgcn_mfma_f32_16x16x32_bf16(Bt[n][k], At[m][k], acc[ai][bj][m][n], 0, 0, 0); __builtin_amdgcn_s_setprio(0); } while (0)
#define PG8_WAIT_V(n) asm volatile("s_waitcnt vmcnt(" #n ")" ::: "memory")
#define PG8_WAIT_L(n) asm volatile("s_waitcnt lgkmcnt(" #n ")" ::: "memory")
#define PG8_BAR __builtin_amdgcn_s_barrier()
#define PG8_SCHED __builtin_amdgcn_sched_barrier(0)
#define PG8_UA(u) ((const char*)((u).part ? g.A2 : g.A) + (size_t)(u).pm * tstepA)
#define PG8_UB(u) ((const char*)((u).part ? g.Bt2 : g.Bt) + (size_t)(u).pn * tstepB)
    Unit cur, nxt; int ui = 0;
    if (!S.next(0, cur)) return;
    f32x4 acc[2][2][4][2];
    if constexpr (Epi::INIT) E.init(acc, cur, wr, wc, fr, fq);
    else {
#pragma unroll
    for (int a = 0; a < 2; ++a)
#pragma unroll
        for (int b = 0; b < 2; ++b)
#pragma unroll
            for (int m = 0; m < 4; ++m)
#pragma unroll
                for (int n = 0; n < 2; ++n) acc[a][b][m][n] = (f32x4){0.f, 0.f, 0.f, 0.f};
    }
    bf16x8 At[4][2], B0[2][2], B1[2][2];
    const char* cA = PG8_UA(cur); const char* cB = PG8_UB(cur);
    PG8_STAGE(PG8_SB(0, 0), cB, voffB); PG8_STAGE(PG8_SB(0, 1), cB + hstepB, voffB); PG8_STAGE(PG8_SA(0, 0), cA, voffA); PG8_STAGE(PG8_SA(0, 1), cA + hstepA, voffA);
    if (wr == 1) PG8_BAR;
    PG8_WAIT_V(2); PG8_BAR;
    PG8_STAGE(PG8_SB(1, 0), cB + kstep, voffB); PG8_STAGE(PG8_SA(1, 0), cA + kstep, voffA); PG8_STAGE(PG8_SB(1, 1), cB + hstepB + kstep, voffB);
    PG8_WAIT_V(6); PG8_BAR;
    for (;;) {
        const bool has_next = S.next(ui + 1, nxt);
        const char* nA = has_next ? PG8_UA(nxt) : cA; const char* nB = has_next ? PG8_UB(nxt) : cB;
        for (int t = 0; t < nt; t += 2) {
            const bool last = (t == nt - 2);
            const char* a1 = cA + (size_t)(t + 1) * kstep;
            const char* a2 = last ? nA : cA + (size_t)(t + 2) * kstep; const char* b2 = last ? nB : cB + (size_t)(t + 2) * kstep;
            const char* a3 = a2 + kstep; const char* b3 = b2 + kstep;
            PG8_LDB(B0, 0, 0); PG8_LDB(B1, 0, 1); PG8_SCHED; PG8_LDA(At, 0, 0); PG8_STAGE(PG8_SA(1, 1), a1 + hstepA, voffA);
            PG8_WAIT_V(8); PG8_WAIT_L(0); PG8_BAR; PG8_MMA(0, 0, At, B0); PG8_MMA(0, 1, At, B1); PG8_BAR; PG8_SCHED;
            PG8_LDA(At, 0, 1); PG8_STAGE(PG8_SB(0, 0), b2, voffB); PG8_STAGE(PG8_SB(0, 1), b2 + hstepB, voffB); PG8_STAGE(PG8_SA(0, 0), a2, voffA);
            PG8_WAIT_V(8); PG8_WAIT_L(0); PG8_BAR; PG8_MMA(1, 0, At, B0); PG8_MMA(1, 1, At, B1); PG8_BAR; PG8_SCHED;
            PG8_LDB(B0, 1, 0); PG8_LDB(B1, 1, 1); PG8_SCHED; PG8_LDA(At, 1, 0); PG8_STAGE(PG8_SA(0, 1), a2 + hstepA, voffA);
            PG8_WAIT_V(8); PG8_WAIT_L(0); PG8_BAR; PG8_MMA(0, 0, At, B0); PG8_MMA(0, 1, At, B1); PG8_BAR; PG8_SCHED;
            PG8_LDA(At, 1, 1); PG8_STAGE(PG8_SB(1, 0), b3, voffB); PG8_STAGE(PG8_SB(1, 1), b3 + hstepB, voffB); PG8_STAGE(PG8_SA(1, 0), a3, voffA);
            PG8_WAIT_V(8); PG8_WAIT_L(0); PG8_BAR; PG8_MMA(1, 0, At, B0); PG8_MMA(1, 1, At, B1); PG8_BAR; PG8_SCHED;
        }
        if constexpr (ALIGN_EPI) { if (wr == 0) PG8_BAR; }
        E(acc, cur, wr, wc, fr, fq);
        if (!has_next) break;
        if constexpr (Epi::INIT) E.init(acc, nxt, wr, wc, fr, fq);
        else {
#pragma unroll
        for (int a = 0; a < 2; ++a)
#pragma unroll
            for (int b = 0; b < 2; ++b)
#pragma unroll
                for (int m = 0; m < 4; ++m)
#pragma unroll
                    for (int n = 0; n < 2; ++n) acc[a][b][m][n] = (f32x4){0.f, 0.f, 0.f, 0.f};
        }
        cur = nxt; cA = nA; cB = nB; ++ui;
        if constexpr (ALIGN_EPI) { if (wr == 1) PG8_BAR; }
    }
    PG8_WAIT_V(0);
    if constexpr (!ALIGN_EPI) { if (wr == 0) PG8_BAR; }
    PG8_BAR;
#undef PG8_SA
#undef PG8_SB
#undef PG8_STAGE
#undef PG8_LDA
#undef PG8_LDB
#undef PG8_MMA
#undef PG8_WAIT_V
#undef PG8_WAIT_L
#undef PG8_BAR
#undef PG8_SCHED
#undef PG8_UA
#undef PG8_UB
}
}

constexpr int NWAVES = 8;
constexpr int N_LAUNCHES = MK_N_LAUNCHES;
constexpr int PER_PHASE = 6;
constexpr size_t MiB = 1u << 20;
constexpr size_t WS_CTL = 0, CTL_ZERO_BYTES = 65536;
constexpr size_t WS_WIN = 1 * MiB;
constexpr size_t WS_WA = 11 * MiB;
constexpr size_t WS_WB = 12 * MiB;
constexpr size_t WS_WOUT = 13 * MiB;
constexpr size_t WS_W1T = 15 * MiB;
constexpr size_t WS_SMALL = 17 * MiB;
constexpr size_t WS_SUM = 18 * MiB;
constexpr size_t WS_KC = 19 * MiB;
constexpr size_t WS_XN = 20 * MiB;
constexpr size_t WS_Q = 52 * MiB;
constexpr size_t WS_KV = 68 * MiB;
constexpr size_t WS_MB = 52 * MiB;
constexpr size_t WS_U = 92 * MiB;
constexpr size_t WS_BR = 108 * MiB;
constexpr size_t WS_GN = 116 * MiB;
constexpr size_t WS_GL = 132 * MiB;
constexpr size_t WS_MG = 148 * MiB;
constexpr size_t WS_VT = 212 * MiB;
constexpr size_t WS_KT = 216 * MiB;
constexpr size_t WS_Q2 = 220 * MiB;
constexpr size_t WS_END = 236 * MiB;
constexpr size_t SM_W2T = 0;
constexpr size_t SM_LWA = 65536;
constexpr size_t SM_LWX = 131072;
constexpr size_t SM_C1 = 262144;
constexpr size_t SM_LUT = 200704;
constexpr int CW_BAR = 4096;

constexpr int RING_BYTES = 160768;
constexpr int LDSCTL_OFF = RING_BYTES, MISC_OFF = LDSCTL_OFF + 320;
constexpr int LDS_BYTES = 163840;

#define RLX_AGENT __ATOMIC_RELAXED, __HIP_MEMORY_SCOPE_AGENT
#define LDS_WAIT() asm volatile("s_waitcnt lgkmcnt(0)" ::: "memory")
#define VM_WAIT() asm volatile("s_waitcnt vmcnt(0)" ::: "memory")

#define XB_TMO      128
#define XB_XCNT(j)  (256  + 64 * (j))
#define XB_XSUB(j)  (1280 + 64 * (j))
#define XB_XGEN(j)  (2304 + 64 * (j))
#define XB_TOP      3328
#define XB_TOPGEN   3392
#define XCD_BAR_WORDS 3456
#define XB_SPIN_CAP (1u << 18)
__device__ __forceinline__ unsigned xb_ld(unsigned* p)              { return __hip_atomic_load(p, __ATOMIC_RELAXED, __HIP_MEMORY_SCOPE_AGENT); }
__device__ __forceinline__ unsigned xb_add(unsigned* p, unsigned v) { return __hip_atomic_fetch_add(p, v, __ATOMIC_RELAXED, __HIP_MEMORY_SCOPE_AGENT); }
__device__ __forceinline__ unsigned xb_xcc_id() { return (unsigned)__builtin_amdgcn_s_getreg((3 << 11) | 20) & 0xFu; }
#define XB_SPIN(cond, bar) do { unsigned _sp = 0; while (cond) { __builtin_amdgcn_s_sleep(1); \
    if ((++_sp & 255u) == 0u) { if (xb_ld(&(bar)[XB_TMO])) break; if (_sp > XB_SPIN_CAP) { atomicAdd(&(bar)[XB_TMO], 1u); break; } } } } while (0)
struct XcdBarrier { unsigned* bar; unsigned x; volatile LAS unsigned* st; };
__device__ __forceinline__ XcdBarrier xcd_barrier_post(unsigned* bar, volatile LAS unsigned* st) {
    XcdBarrier b; b.bar = bar; b.x = xb_xcc_id(); b.st = st;
    if (threadIdx.x == 0) (void)xb_add(&bar[XB_XCNT(b.x)], 1u);
    return b;
}
__device__ __forceinline__ void xcd_barrier_complete(unsigned* bar, unsigned x, unsigned& nloc, unsigned& nx) {
    const unsigned G = gridDim.x * gridDim.y * gridDim.z;
    unsigned sum, cnt, mine, sp = 0u;
    for (;;) {
        sum = 0u; cnt = 0u; mine = 0u;
#pragma unroll
        for (unsigned j = 0; j < 16; ++j) { const unsigned c = xb_ld(&bar[XB_XCNT(j)]); sum += c; cnt += (c > 0u) ? 1u : 0u; mine = (j == x) ? c : mine; }
        if (sum == G) break;
        __builtin_amdgcn_s_sleep(1);
        if ((++sp & 255u) == 0u) { if (xb_ld(&bar[XB_TMO])) break; if (sp > XB_SPIN_CAP) { atomicAdd(&bar[XB_TMO], 1u); break; } }
    }
    nloc = mine > 0u ? mine : 1u; nx = cnt > 0u ? cnt : 1u;
}
__device__ __forceinline__ void xcd_barrier(const XcdBarrier& b) {
    asm volatile("s_waitcnt vmcnt(0)" ::: "memory");
    __syncthreads();
    if (threadIdx.x == 0) {
        unsigned* bar = b.bar;
        __builtin_amdgcn_s_waitcnt(0);
        unsigned nloc = b.st[0], nx = b.st[1];
        if (nloc == 0u) { xcd_barrier_complete(bar, b.x, nloc, nx); b.st[0] = nloc; b.st[1] = nx; }
        const unsigned old = xb_add(&bar[XB_XSUB(b.x)], 1u);
        const unsigned gen = old / nloc;
        if (old + 1u == (gen + 1u) * nloc) {
            __builtin_amdgcn_fence(__ATOMIC_RELEASE, "agent");
            asm volatile("s_waitcnt vmcnt(0)" ::: "memory");
            const unsigned og = xb_add(&bar[XB_TOP], 1u);
            const unsigned tg = og / nx;
            if (og + 1u == (tg + 1u) * nx) xb_add(&bar[XB_TOPGEN], 1u);
            else XB_SPIN(xb_ld(&bar[XB_TOPGEN]) == tg, bar);
            __builtin_amdgcn_fence(__ATOMIC_ACQUIRE, "agent");
            xb_add(&bar[XB_XGEN(b.x)], 1u);
            asm volatile("s_waitcnt vmcnt(0)" ::: "memory");
        } else {
            XB_SPIN(xb_ld(&bar[XB_XGEN(b.x)]) == gen, bar);
            __builtin_amdgcn_fence(__ATOMIC_ACQUIRE, "agent");
            asm volatile("s_waitcnt vmcnt(0)" ::: "memory");
        }
    }
    __syncthreads();
}

struct Args { const float* in[20]; float* out; unsigned char* ws; int ph_lo, ph_hi, li, pad; };
struct Frame {
    LAS unsigned char* lds;
    volatile LAS unsigned* MISC;
    int wave;
    int vcu, G;
    unsigned char* ws;
#define WSP(name, T, off) __device__ __forceinline__ T* name() const { return (T*)(ws + (off)); }
    WSP(WinT, bf16, WS_WIN) WSP(WaT, bf16, WS_WA) WSP(WbT, bf16, WS_WB) WSP(WoutT, bf16, WS_WOUT) WSP(W1T, bf16, WS_W1T)
    WSP(W2T, bf16, WS_SMALL + SM_W2T) WSP(LWA, bf16, WS_SMALL + SM_LWA) WSP(LWX, bf16, WS_SMALL + SM_LWX)
    WSP(C1, float, WS_SMALL + SM_C1) WSP(LUT, float, WS_SMALL + SM_LUT) WSP(SUMA, float, WS_SUM) WSP(SUMB, float, WS_SUM + 524288)
    WSP(KC, bf16, WS_KC) WSP(VC, bf16, WS_KC + 524288) WSP(XN, bf16, WS_XN) WSP(Q, bf16, WS_Q) WSP(KV, bf16, WS_KV) WSP(MB, bf16, WS_MB)
    WSP(VT, bf16, WS_VT) WSP(KT, bf16, WS_KT) WSP(Q2, bf16, WS_Q2) WSP(U, bf16, WS_U) WSP(BR, bf16, WS_BR) WSP(GN, bf16, WS_GN) WSP(GL, bf16, WS_GL) WSP(MG, bf16, WS_MG)
#undef WSP
};

__device__ __forceinline__ int t5_bucket(int n) {
    if (n < 16) return n;
    const int thr[15] = {19, 21, 24, 27, 31, 35, 40, 46, 52, 59, 67, 77, 87, 99, 113};
    int b = 16;
#pragma unroll
    for (int i = 0; i < 15; ++i) b += (n >= thr[i]) ? 1 : 0;
    return b;
}

__device__ __forceinline__ void p0_tr_item(const float* W, int ldw, int k0, int srccol0, int nvalid, bf16* WT, int ldt, int dstrow0, LAS float* scr, int lane) {
    const int c = lane & 31;
    float tv[32];
#pragma unroll
    for (int i = 0; i < 32; ++i) { const int kk = 2 * i + (lane >> 5); tv[i] = (c < nvalid) ? W[(size_t)(k0 + kk) * ldw + srccol0 + c] : 0.f; }
#pragma unroll
    for (int i = 0; i < 32; ++i) { const int kk = 2 * i + (lane >> 5); scr[kk * 33 + c] = tv[i]; }
    LDS_WAIT(); asm volatile("" ::: "memory");
    const int cc = lane & 7;
#pragma unroll
    for (int j = 0; j < 4; ++j) { const int n = (lane >> 3) + 8 * j; const LAS float* s = scr + (8 * cc) * 33 + n;
        u32x4 o; o.x = pk2(s[0 * 33], s[1 * 33]); o.y = pk2(s[2 * 33], s[3 * 33]); o.z = pk2(s[4 * 33], s[5 * 33]); o.w = pk2(s[6 * 33], s[7 * 33]);
        *(u32x4*)(WT + (size_t)(dstrow0 + n) * ldt + k0 + 8 * cc) = o; }
    LDS_WAIT(); asm volatile("" ::: "memory");
}
__device__ __forceinline__ void win_src(int n0, int& src, int& nvalid) {
    nvalid = 32;
    if (n0 < 1280) src = n0;
    else if (n0 < 1792) src = 1816 + (n0 - 1280);
    else if (n0 < 2048) { src = 1792 + (n0 - 1792); nvalid = (n0 == 1792) ? 24 : 0; if (n0 != 1792) src = 0; }
    else if (n0 < 2560) src = 1280 + (n0 - 2048);
    else if (n0 < 3072) src = 2328 + (n0 - 2560);
    else src = 2840 + (n0 - 3072);
}
__device__ __forceinline__ void p0_prologue(const Frame& F, const Args& A) {
    LAS float* scr = (LAS float*)(F.lds + F.wave * 16384);
    const int gw = F.vcu * NWAVES + F.wave, NGW = F.G * NWAVES, lane = lane_id();
    constexpr int I_WIN = 16 * 160, I_WA = 8 * 32, I_WO = 16 * 32, I_W1 = 32 * 8, I_W2 = 4 * 2, I_LR = 2;
    constexpr int NIT = I_WIN + 2 * I_WA + I_WO + 2 * I_W1 + 2 * I_W2 + 16 * I_LR + 256 + 1;
    for (int it = gw; it < NIT; it += NGW) {
        int r = it;
        if (r < I_WIN) { const int kb = r / 160, nb = r % 160; int src, nv; win_src(32 * nb, src, nv); p0_tr_item(A.in[2], 4888, 64 * kb, src, nv, F.WinT(), 1024, 32 * nb, scr, lane); continue; } r -= I_WIN;
        if (r < I_WA) { p0_tr_item(A.in[17], 1024, 64 * (r / 32), 32 * (r % 32), 32, F.WaT(), 512, 32 * (r % 32), scr, lane); continue; } r -= I_WA;
        if (r < I_WA) { p0_tr_item(A.in[18], 1024, 64 * (r / 32), 32 * (r % 32), 32, F.WbT(), 512, 32 * (r % 32), scr, lane); continue; } r -= I_WA;
        if (r < I_WO) { p0_tr_item(A.in[19], 1024, 64 * (r / 32), 32 * (r % 32), 32, F.WoutT(), 1024, 32 * (r % 32), scr, lane); continue; } r -= I_WO;
        if (r < 2 * I_W1) { const int kv = r / I_W1, q = r % I_W1; p0_tr_item(A.in[6] + (size_t)kv * 2048 * 256, 256, 64 * (q / 8), 32 * (q % 8), 32, F.W1T() + (size_t)kv * 256 * 2048, 2048, 32 * (q % 8), scr, lane); continue; } r -= 2 * I_W1;
        if (r < 2 * I_W2) { const int kv = r / I_W2, q = r % I_W2; p0_tr_item(A.in[8] + (size_t)kv * 256 * 64, 64, 64 * (q / 2), 32 * (q % 2), 32, F.W2T() + (size_t)kv * 64 * 256, 256, 32 * (q % 2), scr, lane); continue; } r -= 2 * I_W2;
        if (r < 16 * I_LR) { const int mtx = r / 2, nb = r % 2; const float* src = (mtx < 8 ? A.in[12] : A.in[14]) + (size_t)(mtx & 7) * 4096; bf16* dst = (mtx < 8 ? F.LWA() : F.LWX()) + (size_t)(mtx & 7) * 4096;
            p0_tr_item(src, 64, 0, 32 * nb, 32, dst, 64, 32 * nb, scr, lane); continue; } r -= 16 * I_LR;
        if (r < 256) {
            const int kc = r >> 3, kv = (r >> 2) & 1, n = (r & 3) * 64 + lane; const float* w1 = A.in[6] + (size_t)kv * 2048 * 256 + (size_t)(64 * kc) * 256 + n; const float* pe = A.in[5] + kv * 2048 + 64 * kc;
            float s0 = 0.f, s1 = 0.f, s2 = 0.f, s3 = 0.f;
#pragma unroll 4
            for (int k = 0; k < 64; k += 4) { s0 += pe[k] * w1[(size_t)k * 256]; s1 += pe[k + 1] * w1[(size_t)(k + 1) * 256]; s2 += pe[k + 2] * w1[(size_t)(k + 2) * 256]; s3 += pe[k + 3] * w1[(size_t)(k + 3) * 256]; }
            F.C1()[(kc * 2 + kv) * 256 + n] = (s0 + s1) + (s2 + s3); continue; } r -= 256;
        {
            for (int e = lane; e < 1024; e += 64) { const int hd = e >> 7, n = e & 127; F.LUT()[e] = A.in[9][t5_bucket(n) * 8 + hd] * LOG2E; }
        }
    }
    const float* gain = A.in[1];
    {
        f32x4 v[4], vn[4];
        if (gw < SEQ) { const f32x4* xr = (const f32x4*)(A.in[0] + (size_t)gw * DM) + lane;
#pragma unroll
            for (int j = 0; j < 4; ++j) v[j] = xr[64 * j]; }
        for (int m = gw; m < SEQ; m += NGW) {
            if (m + NGW < SEQ) { const f32x4* xr = (const f32x4*)(A.in[0] + (size_t)(m + NGW) * DM) + lane;
#pragma unroll
                for (int j = 0; j < 4; ++j) vn[j] = xr[64 * j]; }
            float s = 0.f;
#pragma unroll
            for (int j = 0; j < 4; ++j) s += (v[j].x * v[j].x + v[j].y * v[j].y) + (v[j].z * v[j].z + v[j].w * v[j].w);
            const float rs = 1.0f / sqrtf(wave_sum(s) * (1.f / DM) + RMS_EPS);
            unsigned long long* o8 = (unsigned long long*)(F.XN() + (size_t)m * DM) + lane;
#pragma unroll
            for (int j = 0; j < 4; ++j) { const f32x4 gv = ((const f32x4*)gain)[lane + 64 * j];
                o8[64 * j] = (unsigned long long)pk2(v[j].x * rs * gv.x, v[j].y * rs * gv.y) | ((unsigned long long)pk2(v[j].z * rs * gv.z, v[j].w * rs * gv.w) << 32); }
#pragma unroll
            for (int j = 0; j < 4; ++j) v[j] = vn[j];
        }
    }
}

template <bool FINAL>
__device__ __forceinline__ void lru_tile(const Frame& F, const Args& A, int tt) {
    const int lane = lane_id();
    const int w = F.wave, fr = lane & 15, fq = lane >> 4, ch0 = 64 * w, t0 = 64 * tt;
    LAS float* UC = (LAS float*)(F.lds + w * 16384);
#define UC_IDX(tok, ch) ((tok) * 64 + ((((ch) >> 2) ^ ((tok) & 15)) << 2) + ((ch) & 3))
    float Hc = 0.f;
    if (FINAL) {
        const float* sa = F.SUMA() + ch0 + lane; const float* sb = F.SUMB() + ch0 + lane;
        int i = 0;
        for (; i + 16 <= tt; i += 16) { float ta[16], tb[16];
#pragma unroll
            for (int k = 0; k < 16; ++k) { ta[k] = sa[(size_t)(i + k) * 512]; tb[k] = sb[(size_t)(i + k) * 512]; }
#pragma unroll
            for (int k = 0; k < 16; ++k) Hc = ta[k] * Hc + tb[k]; }
        for (; i < tt; ++i) Hc = sa[(size_t)i * 512] * Hc + sb[(size_t)i * 512];
        asm volatile("" : "+v"(Hc));
    }
    {
        const int ch = ch0 + lane; const float* cw = A.in[10]; const float cb = A.in[11][ch];
        const float w0 = cw[ch], w1 = cw[512 + ch], w2 = cw[1024 + ch], w3 = cw[1536 + ch];
        const bf16* up = F.U() + (size_t)t0 * 512 + ch;
        float u0 = 0.f, u1 = 0.f, u2 = 0.f;
        if (tt > 0) { u0 = bf2f(up[-3 * 512]); u1 = bf2f(up[-2 * 512]); u2 = bf2f(up[-1 * 512]); }
        unsigned short ur[64];
#pragma unroll
        for (int tok = 0; tok < 64; ++tok) ur[tok] = up[(size_t)tok * 512];
#pragma unroll
        for (int tok = 0; tok < 64; ++tok) { const float u3 = bf2f(ur[tok]);
            UC[UC_IDX(tok, lane)] = cb + ((u0 * w0 + u1 * w1) + (u2 * w2 + u3 * w3)); u0 = u1; u1 = u2; u2 = u3; }
    }
    bf16x8 Ba[4][2], Bx[4][2];
#pragma unroll
    for (int nt = 0; nt < 4; ++nt)
#pragma unroll
        for (int ks = 0; ks < 2; ++ks) { const size_t o = (size_t)w * 4096 + (16 * nt + fr) * 64 + 32 * ks + 8 * fq; Ba[nt][ks] = *(const bf16x8*)(F.LWA() + o); Bx[nt][ks] = *(const bf16x8*)(F.LWX() + o); }
    float ba[4], bx[4], sp8[4], hin[4], acum[4];
#pragma unroll
    for (int nt = 0; nt < 4; ++nt) { const int ch = ch0 + 16 * nt + fr; ba[nt] = A.in[13][ch]; bx[nt] = A.in[15][ch];
        sp8[nt] = 8.0f * log1pf(expf(-A.in[16][ch])); hin[nt] = 0.f; acum[nt] = 1.f; }
    if (FINAL) {
#pragma unroll
        for (int nt = 0; nt < 4; ++nt) hin[nt] = __shfl(Hc, 16 * nt + fr);
    }
    LDS_WAIT();
    unsigned short glv[16], gln[16];
    if (FINAL) {
#pragma unroll
        for (int nt = 0; nt < 4; ++nt)
#pragma unroll
            for (int rg = 0; rg < 4; ++rg) glv[nt * 4 + rg] = F.GL()[(size_t)(t0 + 4 * fq + rg) * 512 + ch0 + 16 * nt + fr];
    }
#pragma unroll 1
    for (int mt = 0; mt < 4; ++mt) {
        if (FINAL && mt < 3) {
#pragma unroll
            for (int nt = 0; nt < 4; ++nt)
#pragma unroll
                for (int rg = 0; rg < 4; ++rg) gln[nt * 4 + rg] = F.GL()[(size_t)(t0 + 16 * (mt + 1) + 4 * fq + rg) * 512 + ch0 + 16 * nt + fr];
        }
        bf16x8 Af[2];
#pragma unroll
        for (int ks = 0; ks < 2; ++ks) { const int tok = 16 * mt + fr, c0 = 8 * ks + 2 * fq;
            const f32x4 x0 = *(const LAS f32x4*)(UC + tok * 64 + ((c0 ^ (tok & 15)) << 2)), x1 = *(const LAS f32x4*)(UC + tok * 64 + (((c0 + 1) ^ (tok & 15)) << 2));
            u32x4 pw; pw.x = cvtpk(x0[0], x0[1]); pw.y = cvtpk(x0[2], x0[3]); pw.z = cvtpk(x1[0], x1[1]); pw.w = cvtpk(x1[2], x1[3]); Af[ks] = __builtin_bit_cast(bf16x8, pw); }
        f32x4 cr[4], ci[4];
#pragma unroll
        for (int nt = 0; nt < 4; ++nt) { cr[nt] = (f32x4){0.f, 0.f, 0.f, 0.f}; ci[nt] = (f32x4){0.f, 0.f, 0.f, 0.f};
#pragma unroll
            for (int ks = 0; ks < 2; ++ks) { cr[nt] = __builtin_amdgcn_mfma_f32_16x16x32_bf16(Af[ks], Ba[nt][ks], cr[nt], 0, 0, 0); ci[nt] = __builtin_amdgcn_mfma_f32_16x16x32_bf16(Af[ks], Bx[nt][ks], ci[nt], 0, 0, 0); } }
#pragma unroll
        for (int nt = 0; nt < 4; ++nt) {
            float P[4], Hh[4];
#pragma unroll
            for (int rg = 0; rg < 4; ++rg) { const int tok = 16 * mt + 4 * fq + rg, e = 16 * nt + fr;
                const float ucv = UC[UC_IDX(tok, e)];
                const float r = fsigmoid(cr[nt][rg] + ba[nt]), ig = fsigmoid(ci[nt][rg] + bx[nt]);
                const float la = -r * sp8[nt]; const float a = __builtin_amdgcn_exp2f(la * LOG2E);
                const float x2 = 2.0f * la;
                const float ser = -x2 * (1.0f + x2 * (0.5f + x2 * (0.16666667f + x2 * (0.041666668f + x2 * 0.008333334f))));
                const float om = (x2 > -0.25f) ? ser : 1.0f - a * a;
                const float b = __builtin_amdgcn_sqrtf(om) * (ig * ucv);
                if (rg == 0) { P[0] = a; Hh[0] = b; } else { P[rg] = P[rg - 1] * a; Hh[rg] = a * Hh[rg - 1] + b; } }
            float At = P[3], Bt = Hh[3];
            { const float Ap = __shfl_up(At, 16), Bp = __shfl_up(Bt, 16); if (fq >= 1) { Bt = At * Bp + Bt; At = Ap * At; } }
            { const float Ap = __shfl_up(At, 32), Bp = __shfl_up(Bt, 32); if (fq >= 2) { Bt = At * Bp + Bt; At = Ap * At; } }
            float Aex = __shfl_up(At, 16), Bex = __shfl_up(Bt, 16); if (fq == 0) { Aex = 1.f; Bex = 0.f; }
            const float hg = Aex * hin[nt] + Bex;
            float hv[4];
#pragma unroll
            for (int rg = 0; rg < 4; ++rg) hv[rg] = P[rg] * hg + Hh[rg];
            hin[nt] = __shfl(hv[3], 48 + fr);
            if (!FINAL) acum[nt] *= __shfl(At, 48 + fr);
            if (FINAL) {
#pragma unroll
                for (int rg = 0; rg < 4; ++rg) { const size_t t = (size_t)(t0 + 16 * mt + 4 * fq + rg); const int ch = ch0 + 16 * nt + fr;
                    F.XN()[t * 1024 + 512 + ch] = (bf16)f2bf(hv[rg] * bf2f(glv[nt * 4 + rg])); }
            }
        }
        if (FINAL) {
#pragma unroll
            for (int x = 0; x < 16; ++x) glv[x] = gln[x];
        }
    }
    if (!FINAL && fq == 0) {
#pragma unroll
        for (int nt = 0; nt < 4; ++nt) { F.SUMA()[(size_t)tt * 512 + ch0 + 16 * nt + fr] = acum[nt]; F.SUMB()[(size_t)tt * 512 + ch0 + 16 * nt + fr] = hin[nt]; }
    }
    LDS_WAIT();
#undef UC_IDX
}

__device__ __forceinline__ void qk_norm_tile(const Frame& F, const Args& A, int tt) {
    const int lane = lane_id(), sub = lane & 7;
#pragma unroll 4
    for (int it = 0; it < 12; ++it) {
        const int idx = it * 64 + F.wave * 8 + (lane >> 3), tok = idx / 12, hr = idx % 12; const size_t t = (size_t)(64 * tt + tok);
        bf16* p; bf16* dst; const float* gain; float sc = 1.f;
        if (hr < 8) { p = F.Q() + t * 512 + hr * 64; dst = F.Q2() + t * 512 + (hr >> 2) * 256 + (sub >> 1) * 64 + (hr & 3) * 16 + (sub & 1) * 8 - sub * 8; gain = A.in[3]; sc = 0.125f * LOG2E; }
        else if (hr < 10) { p = F.KV() + t * 768 + 256 + (hr - 8) * 64; dst = p; gain = A.in[4] + 64; }
        else { p = F.KV() + t * 768 + 512 + (hr - 10) * 64; dst = p; gain = A.in[4] + 128; }
        const u32x4 w = *(const u32x4*)(p + sub * 8);
        float x[8] = {bflo(w.x), bfhi(w.x), bflo(w.y), bfhi(w.y), bflo(w.z), bfhi(w.z), bflo(w.w), bfhi(w.w)};
        float ss = 0.f;
#pragma unroll
        for (int j = 0; j < 8; ++j) ss += x[j] * x[j];
        ss += __shfl_xor(ss, 1); ss += __shfl_xor(ss, 2); ss += __shfl_xor(ss, 4);
        const float rs = sc / sqrtf(ss * (1.f / 64.f) + RMS_EPS);
        const f32x4 g0 = *(const f32x4*)(gain + sub * 8), g1 = *(const f32x4*)(gain + sub * 8 + 4);
        u32x4 o; o.x = pk2(x[0] * rs * g0.x, x[1] * rs * g0.y); o.y = pk2(x[2] * rs * g0.z, x[3] * rs * g0.w); o.z = pk2(x[4] * rs * g1.x, x[5] * rs * g1.y); o.w = pk2(x[6] * rs * g1.z, x[7] * rs * g1.w);
        *(u32x4*)(dst + sub * 8) = o;
        if (hr >= 8 && hr < 10) *(u32x4*)(F.KT() + ((size_t)((hr - 8) * 256 + tt) * 8 + sub) * 512 + tok * 8) = o;
    }
}

__device__ __forceinline__ void vt_tile(const Frame& F, int J) {
    const int tid = F.wave * 64 + lane_id(), d = tid & 63, ks = (tid >> 6) & 1, gp = tid >> 7;
#pragma unroll
    for (int g = 0; g < 2; ++g) {
        const bf16* vp = F.KV() + (size_t)(64 * J) * 768 + 384 + 64 * g + d;
        unsigned short e[8];
#pragma unroll
        for (int j = 0; j < 8; ++j) { const int key = 32 * ks + 4 * gp + (j & 3) + 16 * (j >> 2); e[j] = vp[(size_t)key * 768]; }
        u32x4 w; w.x = e[0] | ((unsigned)e[1] << 16); w.y = e[2] | ((unsigned)e[3] << 16); w.z = e[4] | ((unsigned)e[5] << 16); w.w = e[6] | ((unsigned)e[7] << 16);
        *(u32x4*)(F.VT() + (size_t)(g * 256 + J) * 4096 + ((((d >> 4) * 2 + ks) * 16 + (d & 15)) * 32) + 8 * gp) = w;
    }
}

__device__ __forceinline__ void compress_item(const Frame& F, const Args& A, int kv, int g, int ct) {
    const int lane = lane_id(), w = F.wave, tid = w * 64 + lane, fr = lane & 15, fq = lane >> 4, c0 = 16 * ct, tb = 16 * c0;
    LAS unsigned char* T = F.lds;
    LAS bf16* HID = (LAS bf16*)(F.lds + 34816);
    LAS float* OUTF = (LAS float*)(F.lds + 34816 + 8448);
    LAS float* C1L = (LAS float*)(F.lds + 34816 + 8448 + 4096);
    {
        u32x4 tv[5];
#pragma unroll
        for (int i = 0; i < 5; ++i) { const int idx = tid + 512 * i, tok = idx >> 3, chn = idx & 7, gt = tb + tok; tv[i] = (u32x4){0u, 0u, 0u, 0u};
            if (idx < 272 * 8 && gt < SEQ) tv[i] = *(const u32x4*)(F.KV() + (size_t)gt * 768 + kv * 128 + g * 64 + chn * 8); }
        { const int n = tid & 255, hf = tid >> 8; float pc[16];
#pragma unroll
            for (int k = 0; k < 16; ++k) pc[k] = F.C1()[((hf * 16 + k) * 2 + kv) * 256 + n];
            float s = hf ? 0.f : A.in[7][kv * 256 + n];
#pragma unroll
            for (int k = 0; k < 16; ++k) s += pc[k];
            C1L[hf * 256 + n] = s; }
#pragma unroll
        for (int i = 0; i < 5; ++i) { const int idx = tid + 512 * i, tok = idx >> 3, chn = idx & 7;
            if (idx < 272 * 8) *(LAS u32x4*)(T + tok * 128 + ((chn ^ ((tok >> 4) & 7)) << 4)) = tv[i]; }
    }
    LDS_WAIT(); __syncthreads();
    f32x4 acc[2] = {(f32x4){0.f, 0.f, 0.f, 0.f}, (f32x4){0.f, 0.f, 0.f, 0.f}};
    const bf16* w1t = F.W1T() + (size_t)kv * 256 * 2048 + (size_t)(32 * w + fr) * 2048 + 8 * fq;
#pragma unroll 32
    for (int ks = 0; ks < 64; ++ks) {
        const int tok = 16 * fr + (ks >> 1), chn = 4 * (ks & 1) + fq;
        const bf16x8 a = *(const LAS bf16x8*)(T + tok * 128 + ((chn ^ ((tok >> 4) & 7)) << 4));
        const bf16x8 b0 = *(const bf16x8*)(w1t + 32 * ks), b1 = *(const bf16x8*)(w1t + (size_t)16 * 2048 + 32 * ks);
        acc[0] = __builtin_amdgcn_mfma_f32_16x16x32_bf16(a, b0, acc[0], 0, 0, 0);
        acc[1] = __builtin_amdgcn_mfma_f32_16x16x32_bf16(a, b1, acc[1], 0, 0, 0);
    }
#pragma unroll
    for (int nt = 0; nt < 2; ++nt) { const int n = 32 * w + 16 * nt + fr; const float c1 = C1L[n] + C1L[256 + n];
#pragma unroll
        for (int rg = 0; rg < 4; ++rg) { const float v = acc[nt][rg] + c1; HID[(4 * fq + rg) * 264 + n] = (bf16)f2bf(v * fsigmoid(v)); } }
    LDS_WAIT(); __syncthreads();
    if (w < 4) {
        f32x4 o = (f32x4){0.f, 0.f, 0.f, 0.f};
        const bf16* w2t = F.W2T() + (size_t)kv * 64 * 256 + (size_t)(16 * w + fr) * 256 + 8 * fq;
#pragma unroll
        for (int ks = 0; ks < 8; ++ks) { const bf16x8 a = *(const LAS bf16x8*)(HID + fr * 264 + 32 * ks + 8 * fq); const bf16x8 b = *(const bf16x8*)(w2t + 32 * ks);
            o = __builtin_amdgcn_mfma_f32_16x16x32_bf16(a, b, o, 0, 0, 0); }
#pragma unroll
        for (int rg = 0; rg < 4; ++rg) OUTF[(4 * fq + rg) * 64 + 16 * w + fr] = o[rg];
    }
    LDS_WAIT(); __syncthreads();
    {
        const int row = tid >> 5, e = 2 * (tid & 31), c = c0 + row;
        float v0 = OUTF[row * 64 + e], v1 = OUTF[row * 64 + e + 1];
        if (kv == 0) { float ss = v0 * v0 + v1 * v1;
#pragma unroll
            for (int o = 1; o < 32; o <<= 1) ss += __shfl_xor(ss, o);
            const float rs = 1.0f / sqrtf(ss * (1.f / 64.f) + RMS_EPS); v0 *= rs * A.in[4][e]; v1 *= rs * A.in[4][e + 1]; }
        if (c >= 1023) { v0 = 0.f; v1 = 0.f; }
        bf16* dst = (kv == 0 ? F.KC() : F.VC()) + ((size_t)g * 1024 + c) * 64 + e;
        *(unsigned*)dst = pk2(v0, v1);
    }
    LDS_WAIT(); __syncthreads();
}

namespace att {
constexpr int SLOTB = 8192, NSLOT = 3;
constexpr int L_K = 0, L_V = NSLOT * SLOTB, L_SC = 2 * NSLOT * SLOTB, L_OUT = L_SC + 65536, L_LUT = L_OUT + 32768, L_WSF = L_LUT + 2048, L_BM = L_WSF + 2048, L_REF = L_BM + 2048, L_LACC = L_REF + 1024, L_TL = L_LACC + 1024  , L_END = L_TL + 5120;
static_assert(L_END <= RING_BYTES, "attention LDS map");
constexpr int L_EX = 0  , L_HDR = 32768  , L_LEX = 33024  , L_NT = 34048  ;
constexpr float CLAMP = 100.0f;
constexpr float THR = 8.0f;
#define SBAR() __builtin_amdgcn_sched_barrier(0)
__device__ __forceinline__ int crow(int r, int hi) { return (r & 3) + 8 * (r >> 2) + 4 * hi; }
__device__ __forceinline__ void glds16(const void* gsrc, unsigned lds_dst) { unsigned keep;
    asm volatile("s_mov_b32 %0, m0\n\ts_mov_b32 m0, %2\n\ts_nop 0\n\tglobal_load_lds_dwordx4 %1, off\n\ts_mov_b32 m0, %0" : "=&s"(keep) : "v"(gsrc), "s"(lds_dst) : "memory"); }
__device__ __forceinline__ void qkt(f32x16& p0, f32x16& p1, const LAS unsigned char* Kslot, const bf16x8* qr, float cinit, int r32, int hi) {
    const LAS unsigned char* kb = Kslot + hi * 1024 + r32 * 16;
#pragma unroll
    for (int r = 0; r < 16; ++r) { p0[r] = cinit; p1[r] = cinit; }
#pragma unroll
    for (int d0 = 0; d0 < 4; ++d0) {
        const bf16x8 b0 = *(const LAS bf16x8*)(kb + d0 * 2048);
        const bf16x8 b1 = *(const LAS bf16x8*)(kb + d0 * 2048 + 512);
        p0 = __builtin_amdgcn_mfma_f32_32x32x16_bf16(b0, qr[d0], p0, 0, 0, 0); p1 = __builtin_amdgcn_mfma_f32_32x32x16_bf16(b1, qr[d0], p1, 0, 0, 0); }
}
__device__ __forceinline__ void pv(f32x16* o, int vb, bf16x8 pa0, bf16x8 pa1, bf16x8 pa2, bf16x8 pa3) {
#pragma unroll
    for (int d0 = 0; d0 < 2; ++d0) { s16x4 lo[4], hi[4];
#pragma unroll
        for (int ks = 0; ks < 4; ++ks) {
            asm volatile("ds_read_b64_tr_b16 %0,%1 offset:%c2" : "=&v"(lo[ks]) : "v"(vb), "i"(d0 * 4096 + ks * 1024) : "memory");
            asm volatile("ds_read_b64_tr_b16 %0,%1 offset:%c2" : "=&v"(hi[ks]) : "v"(vb), "i"(d0 * 4096 + ks * 1024 + 512) : "memory"); }
        asm volatile("s_waitcnt lgkmcnt(0)" ::: "memory"); SBAR();
#define PK(k) (bf16x8){lo[k][0], lo[k][1], lo[k][2], lo[k][3], hi[k][0], hi[k][1], hi[k][2], hi[k][3]}
        o[d0] = __builtin_amdgcn_mfma_f32_32x32x16_bf16(pa0, PK(0), o[d0], 0, 0, 0);
        o[d0] = __builtin_amdgcn_mfma_f32_32x32x16_bf16(pa1, PK(1), o[d0], 0, 0, 0);
        o[d0] = __builtin_amdgcn_mfma_f32_32x32x16_bf16(pa2, PK(2), o[d0], 0, 0, 0);
        o[d0] = __builtin_amdgcn_mfma_f32_32x32x16_bf16(pa3, PK(3), o[d0], 0, 0, 0);
#undef PK
    }
}
__device__ __forceinline__ float rowmax(const f32x16& p0, const f32x16& p1) {
    float a = fmaxf(fmaxf(p0[0], p0[1]), p1[0]), b = fmaxf(fmaxf(p0[2], p0[3]), p1[1]); a = fmaxf(fmaxf(a, p1[2]), p1[3]);
#pragma unroll
    for (int r = 4; r < 16; r += 4) { a = fmaxf(fmaxf(a, p0[r]), p0[r + 1]); b = fmaxf(fmaxf(b, p0[r + 2]), p0[r + 3]); a = fmaxf(fmaxf(a, p1[r]), p1[r + 1]); b = fmaxf(fmaxf(b, p1[r + 2]), p1[r + 3]); }
    const float m = fmaxf(a, b);
    auto rr = __builtin_amdgcn_permlane32_swap(__float_as_uint(m), __float_as_uint(m), false, false);
    return fmaxf(__uint_as_float(rr[0]), __uint_as_float(rr[1]));
}
__device__ __forceinline__ float halfsum(float v) { auto rr = __builtin_amdgcn_permlane32_swap(__float_as_uint(v), __float_as_uint(v), false, false); return __uint_as_float(rr[0]) + __uint_as_float(rr[1]); }
template <int STEP, unsigned LIMIT>
__device__ __forceinline__ void near_apply(f32x16& p0, f32x16& p1, int dbase, const LAS float* lut) {
#pragma unroll
    for (int r = 0; r < 16; ++r) { const int koff = (r & 3) + 8 * (r >> 2); const int d0 = dbase - STEP * koff, d1 = d0 - STEP * 32;
        const int i0 = min(max(d0, 0), 127), i1 = min(max(d1, 0), 127);
        const float b0 = lut[i0], b1 = lut[i1];
        p0[r] = ((unsigned)d0 < LIMIT) ? p0[r] + b0 : -INFINITY; p1[r] = ((unsigned)d1 < LIMIT) ? p1[r] + b1 : -INFINITY; }
}
template <bool HASO>
__device__ __forceinline__ void sm_update(f32x16& p0, f32x16& p1, float& m, float& l, f32x16* o, LAS float* wsf, int r32, int hi) {
    const float rm = rowmax(p0, p1);
    const bool need = rm > m + THR;
    if (__any(need)) {
        const float mn = need ? rm : m; const float alpha = __builtin_amdgcn_exp2f(m - mn);
        l *= alpha; m = mn;
        if (HASO) { if (hi == 0) wsf[r32] = alpha; LDS_WAIT();
#pragma unroll
            for (int r = 0; r < 16; ++r) { const float f = wsf[crow(r, hi)]; o[0][r] *= f; o[1][r] *= f; } }
    }
    float s = 0.f;
#pragma unroll
    for (int r = 0; r < 16; ++r) { p0[r] = __builtin_amdgcn_exp2f(p0[r] - m); p1[r] = __builtin_amdgcn_exp2f(p1[r] - m); s += p0[r] + p1[r]; }
    l += s;
}
#define ATT_PACK(P0, P1) \
    const bf16x8 pa0 = __builtin_bit_cast(bf16x8, (u32x4){cvtpk(P0[0], P0[1]), cvtpk(P0[2], P0[3]), cvtpk(P0[4], P0[5]), cvtpk(P0[6], P0[7])}); \
    const bf16x8 pa1 = __builtin_bit_cast(bf16x8, (u32x4){cvtpk(P0[8], P0[9]), cvtpk(P0[10], P0[11]), cvtpk(P0[12], P0[13]), cvtpk(P0[14], P0[15])}); \
    const bf16x8 pa2 = __builtin_bit_cast(bf16x8, (u32x4){cvtpk(P1[0], P1[1]), cvtpk(P1[2], P1[3]), cvtpk(P1[4], P1[5]), cvtpk(P1[6], P1[7])}); \
    const bf16x8 pa3 = __builtin_bit_cast(bf16x8, (u32x4){cvtpk(P1[8], P1[9]), cvtpk(P1[10], P1[11]), cvtpk(P1[12], P1[13]), cvtpk(P1[14], P1[15])});
#define ATT_WAITBAR(N) asm volatile("s_waitcnt vmcnt(" #N ") lgkmcnt(0)\n\ts_barrier" ::: "memory")
#define ATT_FILL(V, x) do { _Pragma("unroll") for (int _r = 0; _r < 16; ++_r) V[_r] = (x); } while (0)

__device__ __forceinline__ unsigned rangemask(int k, int a, int b) {
    const int lo = max(a - 32 * k, 0), hi = min(b - 32 * k, 31);
    return (lo > hi) ? 0u : ((0xFFFFFFFFu >> (31 - hi)) & (0xFFFFFFFFu << lo));
}
__device__ __forceinline__ int wave_max_i32(int x) {
    x = max(x, dpp_i<0xB1>(x)); x = max(x, dpp_i<0x4E>(x)); x = max(x, dpp_i<0x141>(x)); x = max(x, dpp_i<0x140>(x));
    return max(max(__builtin_amdgcn_readlane(x, 0), __builtin_amdgcn_readlane(x, 16)), max(__builtin_amdgcn_readlane(x, 32), __builtin_amdgcn_readlane(x, 48)));
}

__device__ __forceinline__ void lds_add_f32(LAS float* p, float v) { (void)__hip_atomic_fetch_add(p, v, __ATOMIC_RELAXED, __HIP_MEMORY_SCOPE_WORKGROUP); }

__device__ __forceinline__ void attn_item(const Frame& F, int qt, int g) {
    const int lane = lane_id(), wid = F.wave, tid = wid * 64 + lane, r32 = lane & 31, hi = lane >> 5;
    const int ql = r32 >> 2, h = r32 & 3, cur = qt, t = 64 * qt + 8 * wid + ql, head = 4 * g + h;
    LAS unsigned char* shm = F.lds;
    const unsigned lds0 = (unsigned)(uintptr_t)shm;
    LAS float* wsf = (LAS float*)(shm + L_WSF) + wid * 64;
    LAS float* SC = (LAS float*)(shm + L_SC);
    LAS float* OACC = (LAS float*)(shm + L_SC);
    LAS float* lutl = (LAS float*)(shm + L_LUT);
    const LAS float* luth = lutl + h * 128;
    LAS unsigned* BM = (LAS unsigned*)(shm + L_BM);
    LAS float* REF = (LAS float*)(shm + L_REF);
    LAS float* LACC = (LAS float*)(shm + L_LACC);
    lutl[tid] = F.LUT()[(4 * g + (tid >> 7)) * 128 + (tid & 127)];
    BM[tid] = 0u;
    LAS bf16* QL = (LAS bf16*)(shm + L_OUT);
#pragma unroll
    for (int i = 0; i < 4; ++i) { const int chn = tid + 512 * i;
        *(LAS u32x4*)(QL + (chn >> 5) * 256 + (chn & 31) * 8) = *(const u32x4*)(F.Q2() + (size_t)(64 * qt + (chn >> 5)) * 512 + g * 256 + (chn & 31) * 8); }
    bf16x8 qr[4];
    { const bf16* qp = F.Q2() + (size_t)t * 512 + g * 256 + h * 16 + hi * 8;
#pragma unroll
        for (int d0 = 0; d0 < 4; ++d0) qr[d0] = *(const bf16x8*)(qp + d0 * 64); }
    const float b31 = F.LUT()[head * 128 + 127];
    const float gate_c = fsigmoid(bf2f(F.BR()[(size_t)t * 256 + head])), gate_s = fsigmoid(bf2f(F.BR()[(size_t)t * 256 + 8 + head])), gate_w = fsigmoid(bf2f(F.BR()[(size_t)t * 256 + 16 + head]));
    f32x16 o[2], p0, p1;
    const unsigned kdst = lds0 + L_K + wid * 1024, vdst = lds0 + L_V + wid * 1024;
    const int vrow = 16 * (wid & 3) + (lane >> 2), vcol = (wid >> 2) * 32 + (lane & 3) * 8;
    const int vb0 = (int)(lds0 + L_V) + ((lane >> 4) & 1) * 32 + (lane & 3) * 8 + (4 * hi + ((lane & 15) >> 2)) * 64;
#define DMA_K(base, pitch, row0, slot) glds16((base) + (size_t)((row0) + lane) * (pitch) + wid * 8, (unsigned)__builtin_amdgcn_readfirstlane(kdst + (slot)))
#define DMA_V(base, pitch, row0, slot) glds16((base) + (size_t)((row0) + vrow) * (pitch) + vcol, (unsigned)__builtin_amdgcn_readfirstlane(vdst + (slot)))
#define ROT() do { sl_cur = sl_next; sl_next = (sl_next == (NSLOT - 1) * SLOTB) ? 0 : sl_next + SLOTB; } while (0)
    VM_WAIT(); LDS_WAIT(); __syncthreads();

    const bf16* KCg = F.KC() + (size_t)g * 1024 * 64; const bf16* VCg = F.VC() + (size_t)g * 1024 * 64;
    const int nkt = (qt >> 4) + 1;
    const int tminw = 64 * qt + 8 * wid;
    float m = -1e30f, l = 0.f;
    {
        int sl_cur = 0, sl_next = SLOTB;
        DMA_K(KCg, 64, 0, 0);
        for (int kt = 0; kt < nkt; ++kt) {
            if (kt + 1 < nkt) { DMA_K(KCg, 64, 64 * (kt + 1), sl_next); ATT_WAITBAR(1); } else { ATT_WAITBAR(0); }
            const bool far = (tminw - 31 - 16 * (64 * kt + 63)) >= 128;
            if (far) { qkt(p0, p1, shm + L_K + sl_cur, qr, b31, r32, hi); }
            else { qkt(p0, p1, shm + L_K + sl_cur, qr, 0.f, r32, hi); near_apply<16, 0x80000000u>(p0, p1, t - 31 - 16 * (64 * kt + 4 * hi), luth); }
            sm_update<false>(p0, p1, m, l, o, wsf, r32, hi);
            ROT();
        }
        LDS_WAIT(); __builtin_amdgcn_s_barrier();
    }
    {
        const float lt = halfsum(l); const float rl = lt > 0.f ? 1.0f / lt : 0.f;
        ATT_FILL(o[0], 0.f); ATT_FILL(o[1], 0.f);
        float carry = 0.f;
        int sl_cur = 0, sl_next = SLOTB;
        DMA_K(KCg, 64, 0, 0); DMA_V(VCg, 64, 0, 0);
        for (int kt = 0; kt < nkt; ++kt) {
            if (kt + 1 < nkt) { DMA_K(KCg, 64, 64 * (kt + 1), sl_next); DMA_V(VCg, 64, 64 * (kt + 1), sl_next); ATT_WAITBAR(2); } else { ATT_WAITBAR(0); }
            const bool far = (tminw - 31 - 16 * (64 * kt + 63)) >= 128;
            if (far) { qkt(p0, p1, shm + L_K + sl_cur, qr, b31, r32, hi); }
            else { qkt(p0, p1, shm + L_K + sl_cur, qr, 0.f, r32, hi); near_apply<16, 0x80000000u>(p0, p1, t - 31 - 16 * (64 * kt + 4 * hi), luth); }
#pragma unroll
            for (int r = 0; r < 16; ++r) { p0[r] = __builtin_amdgcn_exp2f(p0[r] - m) * rl; p1[r] = __builtin_amdgcn_exp2f(p1[r] - m) * rl; }
            {
                float q4[8], e[8];
#pragma unroll
                for (int i = 0; i < 4; ++i) { q4[i] = (p0[4 * i] + p0[4 * i + 1]) + (p0[4 * i + 2] + p0[4 * i + 3]); e[i] = p0[4 * i + 3];
                                              q4[4 + i] = (p1[4 * i] + p1[4 * i + 1]) + (p1[4 * i + 2] + p1[4 * i + 3]); e[4 + i] = p1[4 * i + 3]; }
                float newcarry = 0.f;
#pragma unroll
                for (int i = 0; i < 8; ++i) { auto rr = __builtin_amdgcn_permlane32_swap(__float_as_uint(e[i]), __float_as_uint(e[i]), false, false);
                    const float elo = __uint_as_float(rr[0]), ehi = __uint_as_float(rr[1]);
                    if (hi) q4[i] += elo; else if (i < 7) q4[i + 1] += ehi;
                    if (i == 7) newcarry = ehi; }
                if (!hi) q4[0] += carry;
                carry = newcarry;
#pragma unroll
                for (int i = 0; i < 8; ++i) { float v = q4[i]; v += dpp_f<0xB1>(v); v += dpp_f<0x4E>(v); q4[i] = v; }
                if (h == 0) {
#pragma unroll
                    for (int i = 0; i < 8; ++i) SC[(8 * wid + ql) * 256 + 16 * kt + 2 * i + hi] = q4[i]; }
            }
            { ATT_PACK(p0, p1); pv(o, vb0 + sl_cur, pa0, pa1, pa2, pa3); }
            ROT();
        }
        LDS_WAIT(); __builtin_amdgcn_s_barrier();
    }

    if (cur >= 16) {
#pragma unroll 1
        for (int qb = 0; qb < 8; qb += 4) {
            int v[4][4];
#pragma unroll
            for (int u = 0; u < 4; ++u) { const LAS float* row = SC + (8 * wid + qb + u) * 256;
#pragma unroll
                for (int i = 0; i < 4; ++i) { const int J = lane + 64 * i; const int x = (__float_as_int(row[J]) & ~255) | (255 - J); v[u][i] = (J >= 1 && J <= cur - 2) ? x : -1; } }
#pragma unroll 1
            for (int round = 0; round < 13; ++round) {
                int wm[4];
#pragma unroll
                for (int u = 0; u < 4; ++u) wm[u] = wave_max_i32(max(max(v[u][0], v[u][1]), max(v[u][2], v[u][3])));
#pragma unroll
                for (int u = 0; u < 4; ++u) {
#pragma unroll
                    for (int i = 0; i < 4; ++i) v[u][i] = (v[u][i] == wm[u]) ? -1 : v[u][i];
                    const int J = 255 - (wm[u] & 255); const int qloc = 8 * wid + qb + u;
                    if (lane == 0) __hip_atomic_fetch_or(BM + 2 * J + (qloc >> 5), 1u << (qloc & 31), __ATOMIC_RELAXED, __HIP_MEMORY_SCOPE_WORKGROUP);
                }
            }
        }
    }
    LDS_WAIT();
    LAS float* ostg = (LAS float*)(shm + L_SC) + wid * 2048;
    {
        if (hi == 0) wsf[r32] = gate_c; LDS_WAIT();
#pragma unroll
        for (int r = 0; r < 16; ++r) { const float f = wsf[crow(r, hi)]; const int orow = crow(r, hi); ostg[orow * 64 + r32] = o[0][r] * f; ostg[orow * 64 + 32 + r32] = o[1][r] * f; }
    }

    const bf16* Kw = F.KV() + 512 + g * 64; const bf16* Vw = F.KV() + 640 + g * 64;
    {
        m = -1e30f; l = 0.f; ATT_FILL(o[0], 0.f); ATT_FILL(o[1], 0.f);
        const int J0 = max(cur - 8, 0);
        int sl_cur = 0, sl_next = SLOTB;
        DMA_K(Kw, 768, 64 * J0, 0); DMA_V(Vw, 768, 64 * J0, 0);
        for (int J = J0; J <= cur; ++J) {
            if (J + 1 <= cur) { DMA_K(Kw, 768, 64 * (J + 1), sl_next); DMA_V(Vw, 768, 64 * (J + 1), sl_next); ATT_WAITBAR(2); } else { ATT_WAITBAR(0); }
            if (J >= cur - 2 || J == cur - 8) { qkt(p0, p1, shm + L_K + sl_cur, qr, 0.f, r32, hi); near_apply<1, 512u>(p0, p1, t - 64 * J - 4 * hi, luth); }
            else { qkt(p0, p1, shm + L_K + sl_cur, qr, b31, r32, hi); }
            sm_update<true>(p0, p1, m, l, o, wsf, r32, hi);
            { ATT_PACK(p0, p1); pv(o, vb0 + sl_cur, pa0, pa1, pa2, pa3); }
            ROT();
        }
        LDS_WAIT(); __builtin_amdgcn_s_barrier();
        const float lt = halfsum(l); const float fw = lt > 0.f ? gate_w / lt : 0.f;
        if (hi == 0) wsf[r32] = fw; LDS_WAIT();
#pragma unroll
        for (int r = 0; r < 16; ++r) { const float f = wsf[crow(r, hi)]; const int orow = crow(r, hi); ostg[orow * 64 + r32] += o[0][r] * f; ostg[orow * 64 + 32 + r32] += o[1][r] * f; }
        LDS_WAIT();
#pragma unroll
        for (int i = 0; i < 4; ++i) { const int rowl = i * 8 + (lane >> 3), chn = lane & 7;
            const f32x4 a0 = *(const LAS f32x4*)(ostg + rowl * 64 + chn * 8), a1 = *(const LAS f32x4*)(ostg + rowl * 64 + chn * 8 + 4);
            const size_t tt = (size_t)(64 * qt + 8 * wid + (rowl >> 2)); const int col = (4 * g + (rowl & 3)) * 64 + chn * 8;
            *(u32x4*)(F.XN() + tt * 1024 + col) = (u32x4){cvtpk(a0[0], a0[1]), cvtpk(a0[2], a0[3]), cvtpk(a1[0], a1[1]), cvtpk(a1[2], a1[3])}; }
        LDS_WAIT();
    }

    const bf16* Ks = F.KV() + 256 + g * 64; const bf16* Vs = F.KV() + 384 + g * 64;
    {
        m = -1e30f; l = 0.f; ATT_FILL(o[0], 0.f); ATT_FILL(o[1], 0.f);
        const int nA = (cur < 16) ? cur + 1 : 3;
#define JA(i) ((cur < 16) ? (i) : ((i) == 0 ? 0 : cur - 2 + (i)))
        int sl_cur = 0, sl_next = SLOTB;
        DMA_K(Ks, 768, 0, 0); DMA_V(Vs, 768, 0, 0);
        for (int i = 0; i < nA; ++i) {
            const int J = JA(i);
            if (i + 1 < nA) { const int Jn = JA(i + 1); DMA_K(Ks, 768, 64 * Jn, sl_next); DMA_V(Vs, 768, 64 * Jn, sl_next); ATT_WAITBAR(2); } else { ATT_WAITBAR(0); }
            if (J >= cur - 2) { qkt(p0, p1, shm + L_K + sl_cur, qr, 0.f, r32, hi); near_apply<1, 0x80000000u>(p0, p1, t - 64 * J - 4 * hi, luth); }
            else { qkt(p0, p1, shm + L_K + sl_cur, qr, b31, r32, hi); }
            sm_update<true>(p0, p1, m, l, o, wsf, r32, hi);
            { ATT_PACK(p0, p1); pv(o, vb0 + sl_cur, pa0, pa1, pa2, pa3); }
            ROT();
        }
#undef JA
        LDS_WAIT(); __builtin_amdgcn_s_barrier();
        const float lt = halfsum(l);
        if (hi == 0) { REF[32 * wid + r32] = m; LACC[32 * wid + r32] = lt; }
#pragma unroll
        for (int r = 0; r < 16; ++r) { const int orow = 32 * wid + crow(r, hi); OACC[orow * 64 + r32] = o[0][r]; OACC[orow * 64 + 32 + r32] = o[1][r]; }
        LDS_WAIT(); __builtin_amdgcn_s_barrier();
    }

    if (cur >= 16) {
        const int c16 = lane & 15, gq = lane >> 4, qi4 = c16 >> 2;
        const bf16* KTg = F.KT() + (size_t)g * 256 * 4096 + gq * 512 + c16 * 8; const bf16* VTg = F.VT() + (size_t)g * 256 * 4096 + c16 * 32 + 8 * gq;
        const LAS bf16* QLg = QL + (gq >> 1) * 64 + h * 16 + 8 * (gq & 1);
        LAS unsigned* TL = (LAS unsigned*)(shm + L_TL) + wid * 160;
        int ntask = 0;
#pragma unroll 1
        for (int i4 = 0; i4 < 4; ++i4) {
            const int Jl = lane + 64 * i4; int nch = 0;
            unsigned long long mk = 0ull;
            if (Jl >= 1 && Jl <= cur - 2 && (Jl & 7) == wid) { mk = ((unsigned long long)BM[2 * Jl + 1] << 32) | BM[2 * Jl]; nch = (__popcll(mk) + 3) >> 2; }
            int incl = nch;
#pragma unroll
            for (int o = 1; o < 64; o <<= 1) { const int up = __shfl_up(incl, o); if (lane >= o) incl += up; }
            const int base = ntask + incl - nch;
            for (int c = 0; c < nch; ++c) { unsigned e = (unsigned)Jl; int q0 = 0;
#pragma unroll
                for (int k = 0; k < 4; ++k) { int q = q0; if (mk) { q = __builtin_ctzll(mk); mk &= mk - 1; } if (k == 0) q0 = q; e |= (unsigned)q << (8 + 6 * k); }
                if (base + c < 160) TL[base + c] = e; }
            ntask += __shfl(incl, 63);
        }
        ntask = min(ntask, 160);
        LAS bf16* EX = (LAS bf16*)(shm + L_EX); LAS int* HDR = (LAS int*)(shm + L_HDR); LAS float* LEX = (LAS float*)(shm + L_LEX); LAS int* NT = (LAS int*)(shm + L_NT);
        if (lane == 0) NT[wid] = ntask;
        LDS_WAIT(); __builtin_amdgcn_s_barrier();
        int nround = 0;
#pragma unroll
        for (int k = 0; k < 8; ++k) nround = max(nround, __builtin_amdgcn_readfirstlane(NT[k]));
        bf16x8 kfC[8], vfC[8];
#define LOADK(J_, KF) do { const bf16* kp_ = KTg + (size_t)(J_) * 4096; \
            _Pragma("unroll") for (int kt = 0; kt < 4; ++kt) { KF[2 * kt] = *(const bf16x8*)(kp_ + kt * 128); KF[2 * kt + 1] = *(const bf16x8*)(kp_ + 2048 + kt * 128); } } while (0)
#define LOADV(J_, VF) do { const bf16* vp_ = VTg + (size_t)(J_) * 4096; _Pragma("unroll") for (int x = 0; x < 8; ++x) VF[x] = *(const bf16x8*)(vp_ + x * 512); } while (0)
        unsigned e_cur = 0xffu;
        if (ntask > 0) { e_cur = (unsigned)__builtin_amdgcn_readfirstlane((int)TL[0]); LOADK(e_cur & 255u, kfC); LOADV(e_cur & 255u, vfC); }
#pragma unroll 1
        for (int n = 0; n < nround; ++n) {
            const int buf = n & 1;
            if (n < ntask) {
                const unsigned e_nxt = (n + 1 < ntask) ? (unsigned)__builtin_amdgcn_readfirstlane((int)TL[n + 1]) : 0xffu;
                const unsigned e_ = e_cur; const int Jb = e_ & 255, Jn = e_nxt & 255; const bool reload = (Jn != Jb) && (Jn != 255);
                const int q0_ = (e_ >> 8) & 63;
                const int myq = (e_ >> (8 + 6 * qi4)) & 63; const bool valid = (qi4 == 0) || (myq != q0_); const int tq = 64 * qt + myq;
                const LAS bf16* qp_ = QLg + myq * 256; const bf16x8 qg0 = *(const LAS bf16x8*)(qp_), qg1 = *(const LAS bf16x8*)(qp_ + 128);
                const float ref = REF[4 * myq + h];
                const bool nearJ = (Jb >= cur - 2);
                const float cinit = nearJ ? 0.f : (valid ? b31 - ref : -INFINITY);
                f32x4 s[4];
#pragma unroll
                for (int kt = 0; kt < 4; ++kt) { s[kt] = (f32x4){cinit, cinit, cinit, cinit};
                    s[kt] = __builtin_amdgcn_mfma_f32_16x16x32_bf16(kfC[2 * kt], qg0, s[kt], 0, 0, 0); s[kt] = __builtin_amdgcn_mfma_f32_16x16x32_bf16(kfC[2 * kt + 1], qg1, s[kt], 0, 0, 0); }
                if (reload) LOADK(Jn, kfC);
                if (nearJ) { const float sub = valid ? ref : INFINITY;
#pragma unroll
                    for (int kt = 0; kt < 4; ++kt)
#pragma unroll
                        for (int r = 0; r < 4; ++r) { const int dd = tq - 64 * Jb - (16 * kt + 4 * gq + r); const float bb = luth[min(max(dd, 0), 127)];
                            s[kt][r] = (dd >= 0) ? s[kt][r] + bb - sub : -INFINITY; } }
#pragma unroll
                for (int kt = 0; kt < 4; ++kt)
#pragma unroll
                    for (int r = 0; r < 4; ++r) s[kt][r] = __builtin_amdgcn_exp2f(fminf(s[kt][r], CLAMP));
                float ls = (((s[0][0] + s[0][1]) + (s[0][2] + s[0][3])) + ((s[1][0] + s[1][1]) + (s[1][2] + s[1][3]))) + (((s[2][0] + s[2][1]) + (s[2][2] + s[2][3])) + ((s[3][0] + s[3][1]) + (s[3][2] + s[3][3])));
                { auto r16 = __builtin_amdgcn_permlane16_swap(__float_as_uint(ls), __float_as_uint(ls), false, false); ls = __uint_as_float(r16[0]) + __uint_as_float(r16[1]); }
                ls = halfsum(ls);
                bf16x8 pb[2];
#pragma unroll
                for (int ks = 0; ks < 2; ++ks) pb[ks] = __builtin_bit_cast(bf16x8, (u32x4){cvtpk(s[2 * ks][0], s[2 * ks][1]), cvtpk(s[2 * ks][2], s[2 * ks][3]), cvtpk(s[2 * ks + 1][0], s[2 * ks + 1][1]), cvtpk(s[2 * ks + 1][2], s[2 * ks + 1][3])});
                LAS bf16* ex = EX + buf * 8192 + ((wid * 4 + qi4) * 4 + h) * 64 + 4 * gq;
                f32x4 ot[4];
#pragma unroll
                for (int mt = 0; mt < 4; ++mt) { ot[mt] = (f32x4){0.f, 0.f, 0.f, 0.f};
                    ot[mt] = __builtin_amdgcn_mfma_f32_16x16x32_bf16(vfC[2 * mt], pb[0], ot[mt], 0, 0, 0); ot[mt] = __builtin_amdgcn_mfma_f32_16x16x32_bf16(vfC[2 * mt + 1], pb[1], ot[mt], 0, 0, 0); }
                if (reload) LOADV(Jn, vfC);
#pragma unroll
                for (int mt = 0; mt < 4; ++mt) *(LAS u32x2*)(ex + 16 * mt) = (u32x2){cvtpk(ot[mt][0], ot[mt][1]), cvtpk(ot[mt][2], ot[mt][3])};
                if (gq == 0) { LEX[buf * 128 + wid * 16 + c16] = ls; if (h == 0) HDR[buf * 32 + wid * 4 + qi4] = valid ? myq : -1; }
                e_cur = e_nxt;
            } else if (lane < 4) HDR[buf * 32 + wid * 4 + lane] = -1;
            LDS_WAIT(); __builtin_amdgcn_s_barrier();
            {
                const int hv = (lane < 32) ? HDR[buf * 32 + lane] : -1;
                const int li = lane & 15, hsel = li >> 2, dq = (li & 3) * 16;
#pragma unroll
                for (int pass = 0; pass < 2; ++pass) {
                    const unsigned m0 = (unsigned)__ballot(hv == 8 * wid + 4 * pass + 0), m1 = (unsigned)__ballot(hv == 8 * wid + 4 * pass + 1), m2 = (unsigned)__ballot(hv == 8 * wid + 4 * pass + 2), m3 = (unsigned)__ballot(hv == 8 * wid + 4 * pass + 3);
                    if ((m0 | m1 | m2 | m3) == 0u) continue;
                    unsigned mm = gq == 0 ? m0 : gq == 1 ? m1 : gq == 2 ? m2 : m3;
                    if (mm) { const int q = 8 * wid + 4 * pass + gq;
                        LAS f32x4* ap = (LAS f32x4*)(OACC + (4 * q + hsel) * 64 + dq); f32x4 a0 = ap[0], a1 = ap[1], a2 = ap[2], a3 = ap[3]; float la = 0.f;
                        while (mm) { const int e = __builtin_ctz(mm); mm &= mm - 1;
                            const u32x4 x0 = *(const LAS u32x4*)(EX + buf * 8192 + e * 256 + hsel * 64 + dq), x1 = *(const LAS u32x4*)(EX + buf * 8192 + e * 256 + hsel * 64 + dq + 8);
                            a0[0] += bflo(x0.x); a0[1] += bfhi(x0.x); a0[2] += bflo(x0.y); a0[3] += bfhi(x0.y); a1[0] += bflo(x0.z); a1[1] += bfhi(x0.z); a1[2] += bflo(x0.w); a1[3] += bfhi(x0.w);
                            a2[0] += bflo(x1.x); a2[1] += bfhi(x1.x); a2[2] += bflo(x1.y); a2[3] += bfhi(x1.y); a3[0] += bflo(x1.z); a3[1] += bfhi(x1.z); a3[2] += bflo(x1.w); a3[3] += bfhi(x1.w);
                            la += LEX[buf * 128 + e * 4 + hsel]; }
                        ap[0] = a0; ap[1] = a1; ap[2] = a2; ap[3] = a3;
                        if ((li & 3) == 0) LACC[4 * q + hsel] += la; }
                }
            }
        }
#undef LOADK
#undef LOADV
    }
    LDS_WAIT(); __builtin_amdgcn_s_barrier();

    {
        if (hi == 0) { const float lt = LACC[32 * wid + r32]; wsf[r32] = lt > 0.f ? gate_s / lt : 0.f; }
        LDS_WAIT();
#pragma unroll
        for (int i = 0; i < 4; ++i) { const int rowl = i * 8 + (lane >> 3), chn = lane & 7, row = 32 * wid + rowl;
            const float f = wsf[rowl];
            const f32x4 a0 = *(const LAS f32x4*)(OACC + row * 64 + chn * 8), a1 = *(const LAS f32x4*)(OACC + row * 64 + chn * 8 + 4);
            const size_t tt = (size_t)(64 * qt + 8 * wid + (rowl >> 2)); const int col = (4 * g + (rowl & 3)) * 64 + chn * 8;
            const u32x4 ov = *(const u32x4*)(F.XN() + tt * 1024 + col);
            const u32x4 gn = *(const u32x4*)(F.GN() + tt * 512 + col);
            u32x4 w; w.x = pk2((bflo(ov.x) + a0[0] * f) * bflo(gn.x), (bfhi(ov.x) + a0[1] * f) * bfhi(gn.x)); w.y = pk2((bflo(ov.y) + a0[2] * f) * bflo(gn.y), (bfhi(ov.y) + a0[3] * f) * bfhi(gn.y));
            w.z = pk2((bflo(ov.z) + a1[0] * f) * bflo(gn.z), (bfhi(ov.z) + a1[1] * f) * bfhi(gn.z)); w.w = pk2((bflo(ov.w) + a1[2] * f) * bflo(gn.w), (bfhi(ov.w) + a1[3] * f) * bfhi(gn.w));
            *(u32x4*)(F.XN() + tt * 1024 + col) = w; }
        VM_WAIT(); LDS_WAIT(); __syncthreads();
    }
#undef DMA_K
#undef DMA_V
#undef ROT
}
}

__global__ void __launch_bounds__(NWAVES * 64, 2) nsa_lru_fwd(Args args) {
    extern __shared__ __attribute__((aligned(16))) unsigned char lds[];
    Frame F;
    F.lds = (LAS unsigned char*)lds;
    F.MISC = (volatile LAS unsigned*)(F.lds + MISC_OFF);
    F.wave = __builtin_amdgcn_readfirstlane((int)(threadIdx.x >> 6));
    F.G = gridDim.x; { const int bx = blockIdx.x; F.vcu = (F.G % 8 == 0) ? (bx % 8) * (F.G / 8) + bx / 8 : bx; }
    F.ws = args.ws;
    gu32* ctl = (gu32*)(args.ws + WS_CTL);
    for (int u = F.wave * 64 + lane_id(); u < (LDS_BYTES - LDSCTL_OFF) / 4; u += NWAVES * 64) ((LAS unsigned*)(F.lds + LDSCTL_OFF))[u] = 0u;
    __syncthreads();
    const int bli = (N_LAUNCHES == PER_PHASE) ? 0 : args.li;
    XcdBarrier bar; bar.bar = (unsigned*)(ctl + CW_BAR) + bli * XCD_BAR_WORDS; bar.x = 0; bar.st = nullptr;
    if (N_LAUNCHES != PER_PHASE) bar = xcd_barrier_post((unsigned*)(ctl + CW_BAR) + bli * XCD_BAR_WORDS, F.MISC + 8);
#define GRID_BAR() do { if (N_LAUNCHES != PER_PHASE) xcd_barrier(bar); } while (0)
    const int lo = args.ph_lo, hi = args.ph_hi;
#define IN(k) (lo <= (k) && (k) < hi)
#define BOTH(k) (IN(k) && IN((k) + 1))

    if (IN(0)) { p0_prologue(F, args); if (BOTH(0)) GRID_BAR(); }

    if (IN(1)) {
        pg8::Gemm g{F.XN(), F.WinT(), F.XN(), F.WinT(), 1024, 1024, 1024}; pg8::StaticOrder S; S.init(SEQ, NPROJ, F.G, (int)blockIdx.x);
        pg8::EpiProj E{F.Q(), F.KV(), F.U(), F.BR(), F.GN(), F.GL(), F.MG()};
        pg8::gemm_phase<pg8::EpiProj, pg8::StaticOrder, true>(F.lds, g, S, E, F.wave);
        if (BOTH(1)) GRID_BAR();
    }

    if (IN(2)) {
        for (int i = F.vcu; i < 256; i += F.G) {
            lru_tile<false>(F, args, i);
            if (!args.pad) qk_norm_tile(F, args, i);
            vt_tile(F, i);
            __syncthreads();
            compress_item(F, args, i & 1, (i >> 1) & 1, i >> 2);
        }
        if (BOTH(2)) GRID_BAR();
    }

    if (IN(3)) {
        for (int i = F.vcu; i < 256; i += F.G) { lru_tile<true>(F, args, i); }
        __syncthreads();
#pragma unroll 1
        for (int it = 2 * F.vcu; it < 512; it += 2 * F.G) {
#pragma unroll 1
            for (int j = 0; j < 2; ++j) { const int i = it >> 1; att::attn_item(F, j ? i : 255 - i, j ? 0 : 1); }
        }
        if (BOTH(3)) GRID_BAR();
    }

    if (IN(4)) {
        pg8::Gemm g{F.XN(), F.WaT(), F.XN() + 512, F.WbT(), 1024, 512, 512}; pg8::DualOrder S; S.init(SEQ, 1024, F.G, (int)blockIdx.x);
        pg8::EpiMerge E{F.MB(), F.MG()};
        pg8::gemm_phase<pg8::EpiMerge, pg8::DualOrder, true>(F.lds, g, S, E, F.wave);
        if (BOTH(4)) GRID_BAR();
    }

    if (IN(5)) {
        pg8::Gemm g{F.MB(), F.WoutT(), F.MB(), F.WoutT(), 1024, 1024, 1024}; pg8::StaticOrder S; S.init(SEQ, 1024, F.G, (int)blockIdx.x);
        pg8::EpiOut E{args.in[0], args.out};
        pg8::gemm_phase<pg8::EpiOut, pg8::StaticOrder, true>(F.lds, g, S, E, F.wave);
    }
#undef IN
#undef BOTH
}

extern "C" void kernel_launch(void* const* d_in, const int* in_sizes, int n_in, void* d_out, int out_size, void* d_ws, size_t ws_size, hipStream_t stream) {
    static int grid = 0;
    if (grid == 0) {
        if (n_in != 20 || in_sizes[0] != SEQ * DM || out_size != SEQ * DM || ws_size < WS_END) { fprintf(stderr, "kernel_launch: unexpected shapes (n_in %d, in0 %d, out %d, ws %zu)\n", n_in, n_in > 0 ? in_sizes[0] : -1, out_size, ws_size); grid = -1; return; }
        int dev = 0, cus = 0, per_cu = 0;
        if (hipGetDevice(&dev) != hipSuccess || hipDeviceGetAttribute(&cus, hipDeviceAttributeMultiprocessorCount, dev) != hipSuccess) { grid = -1; return; }
        if (hipFuncSetAttribute((const void*)nsa_lru_fwd, hipFuncAttributeMaxDynamicSharedMemorySize, LDS_BYTES) != hipSuccess) { fprintf(stderr, "kernel_launch: hipFuncSetAttribute failed\n"); grid = -1; return; }
        if (hipOccupancyMaxActiveBlocksPerMultiprocessor(&per_cu, (const void*)nsa_lru_fwd, NWAVES * 64, LDS_BYTES) != hipSuccess || per_cu < 1)
            fprintf(stderr, "kernel_launch: occupancy query reports %d workgroups per CU\n", per_cu);
        (void)hipGetLastError();
        grid = cus;
    }
    if (grid < 0) return;
    if (hipMemsetAsync((char*)d_ws + WS_CTL, 0, CTL_ZERO_BYTES, stream) != hipSuccess) { fprintf(stderr, "kernel_launch: hipMemsetAsync failed\n"); return; }
    Args a{};
    for (int i = 0; i < 20; ++i) a.in[i] = (const float*)d_in[i];
    a.out = (float*)d_out; a.ws = (unsigned char*)d_ws;
    const int nl = (PROBE_DUP >= 0) ? 2 : N_LAUNCHES;
    for (int li = 0; li < nl; ++li) {
        if (PROBE_DUP >= 0) { a.ph_lo = li ? PROBE_DUP : 0; a.ph_hi = li ? PER_PHASE : PROBE_DUP + 1; a.li = li; a.pad = (li && PROBE_DUP == 2) ? 1 : 0; }
        else { a.ph_lo = (N_LAUNCHES == PER_PHASE) ? li : 0; a.ph_hi = (N_LAUNCHES == PER_PHASE) ? li + 1 : PER_PHASE; a.li = li; }
        hipLaunchKernelGGL(nsa_lru_fwd, dim3(grid), dim3(NWAVES * 64), LDS_BYTES, stream, a);
        const hipError_t le = hipPeekAtLastError();
        if (le != hipSuccess) { fprintf(stderr, "kernel_launch: launch %d failed: %s\n", li, hipGetErrorName(le)); break; }
    }
}
```

```cpp
#include <hip/hip_runtime.h>
#include <cstdio>
#include <cstdint>

#ifndef PROBE_DUP
#define PROBE_DUP -1
#endif
#ifndef MK_N_LAUNCHES
#define MK_N_LAUNCHES 1
#endif

#define GAS __attribute__((address_space(1)))
#define LAS __attribute__((address_space(3)))
typedef unsigned short bf16;
typedef short bf16x8 __attribute__((ext_vector_type(8)));
typedef short s16x4 __attribute__((ext_vector_type(4)));
typedef float f32x4 __attribute__((ext_vector_type(4)));
typedef float f32x16 __attribute__((ext_vector_type(16)));
typedef unsigned u32x4 __attribute__((ext_vector_type(4)));
typedef unsigned u32x2 __attribute__((ext_vector_type(2)));
typedef GAS unsigned gu32;

constexpr int SEQ = 16384, DM = 1024;
constexpr int NPROJ = 5120;
constexpr float LOG2E = 1.4426950408889634f;
constexpr float RMS_EPS = 1e-6f;

__device__ __forceinline__ unsigned f2bf(float f) { unsigned u = __builtin_bit_cast(unsigned, f); return (u + 0x7fffu + ((u >> 16) & 1u)) >> 16; }
__device__ __forceinline__ unsigned pk2(float lo, float hi) { return f2bf(lo) | (f2bf(hi) << 16); }
__device__ __forceinline__ float bf2f(unsigned h) { return __builtin_bit_cast(float, h << 16); }
__device__ __forceinline__ float bflo(unsigned w) { return __builtin_bit_cast(float, w << 16); }
__device__ __forceinline__ float bfhi(unsigned w) { return __builtin_bit_cast(float, w & 0xffff0000u); }
typedef float f32x2_t __attribute__((ext_vector_type(2))); typedef __bf16 bf16x2_t __attribute__((ext_vector_type(2)));
__device__ __forceinline__ unsigned cvtpk(float lo, float hi) { f32x2_t v = {lo, hi}; bf16x2_t b = __builtin_convertvector(v, bf16x2_t); return __builtin_bit_cast(unsigned, b); }
__device__ __forceinline__ float fsigmoid(float v) { return __builtin_amdgcn_rcpf(1.0f + __builtin_amdgcn_exp2f(-v * LOG2E)); }
template <int CTRL> __device__ __forceinline__ float dpp_f(float v) { return __builtin_bit_cast(float, __builtin_amdgcn_update_dpp(0, __builtin_bit_cast(int, v), CTRL, 0xf, 0xf, true)); }
template <int CTRL> __device__ __forceinline__ int dpp_i(int v) { return __builtin_amdgcn_update_dpp(v, v, CTRL, 0xf, 0xf, false); }
__device__ __forceinline__ int lane_id() { int l = (int)__builtin_amdgcn_mbcnt_hi(~0u, __builtin_amdgcn_mbcnt_lo(~0u, 0u)); asm volatile("" : "+v"(l)); return l; }
__device__ __forceinline__ float wave_sum(float v) {
#pragma unroll
    for (int o = 1; o < 64; o <<= 1) v += __shfl_xor(v, o);
    return v;
}

namespace pg8 {
#define PG8_LAS __attribute__((address_space(3)))
typedef unsigned short bf16_t;
constexpr int BM = 256, BK = 64, HALF = 128, HTB = HALF * BK * 2, STAGE_BYTES = 8 * HTB, NXCD = 8, WGM = 8;
__host__ __device__ __forceinline__ int lds_byte(int r, int c) { const int st = (r >> 4) * 2 + (c >> 5), rr = r & 15, cc = c & 31, ob = rr * 64 + cc * 2; return st * 1024 + (ob ^ (((ob >> 9) & 1) << 5)); }
__host__ __device__ __forceinline__ void stage_rc(int b, int& R, int& C) { const int st = b / 1024, sb = b % 1024, swz = sb ^ (((sb >> 9) & 1) << 5); R = (st >> 1) * 16 + swz / 64; C = (st & 1) * 32 + (swz % 64) / 2; }
__host__ __device__ __forceinline__ int perm32(int rho) { const int n = rho >> 4, i = rho & 15; return 8 * (i >> 2) + 4 * n + (i & 3); }

struct Unit { int pm, pn, part; };
struct Gemm { const bf16_t* A; const bf16_t* Bt; const bf16_t* A2; const bf16_t* Bt2; int lda, ldb, K; };

struct StaticOrder {
    int nM, nN, nwg, G, c;
    __host__ __device__ void init(int M, int N, int G_, int c_) { nM = M / BM; nN = N / BM; nwg = nM * nN; G = G_; c = c_; }
    __host__ __device__ bool tile(long L, Unit& u) const {
        if (L >= nwg) return false;
        int wgid = (int)L; { const int q = nwg / NXCD, r = nwg % NXCD, xcd = wgid % NXCD, off = wgid / NXCD; wgid = (xcd < r ? xcd * (q + 1) : r * (q + 1) + (xcd - r) * q) + off; }
        const int nig = WGM * nN, gid = wgid / nig, fm = gid * WGM, gsz = (nM - fm) < WGM ? (nM - fm) : WGM;
        u.pm = fm + ((wgid % nig) % gsz); u.pn = (wgid % nig) / gsz; u.part = 0; return true;
    }
    __host__ __device__ bool next(int i, Unit& u) const { return tile((long)i * G + c, u); }
};
struct DualOrder : StaticOrder {
    __host__ __device__ bool next(int i, Unit& u) const { if (!tile((long)(i >> 1) * G + c, u)) return false; u.part = i & 1; return true; }
};

__device__ __forceinline__ unsigned cvt_pk_bf16(float lo, float hi) { unsigned r; asm volatile("v_cvt_pk_bf16_f32 %0, %1, %2" : "=v"(r) : "v"(lo), "v"(hi)); return r; }

struct EpiProj {
    static constexpr bool PERM = true, INIT = false;
    bf16_t *Q, *KV, *U, *BR, *GN, *GL, *MG;
    __device__ __forceinline__ void operator()(const f32x4 (&acc)[2][2][4][2], const Unit& u, int wr, int wc, int fr, int fq) const {
        const int pn = u.pn; bf16_t* base; int ldc, colt, act = 0;
        if (pn < 2) { base = Q; ldc = 512; colt = pn * 256; }
        else if (pn < 5) { base = KV; ldc = 768; colt = (pn - 2) * 256; }
        else if (pn < 7) { base = U; ldc = 512; colt = (pn - 5) * 256; }
        else if (pn < 8) { base = BR; ldc = 256; colt = 0; }
        else if (pn < 10) { base = GN; ldc = 512; colt = (pn - 8) * 256; act = 1; }
        else if (pn < 12) { base = GL; ldc = 512; colt = (pn - 10) * 256; act = 1; }
        else { base = MG; ldc = 2048; colt = (pn - 12) * 256; act = 2; }
        const int row0 = u.pm * BM + wr * 64 + fr, col0 = colt + wc * 32 + 8 * fq;
#pragma unroll
        for (int ai = 0; ai < 2; ++ai)
#pragma unroll
            for (int m = 0; m < 4; ++m) { bf16_t* rowp = base + (size_t)(row0 + ai * HALF + m * 16) * ldc + col0;
#pragma unroll
                for (int bj = 0; bj < 2; ++bj) { f32x4 v0 = acc[ai][bj][m][0], v1 = acc[ai][bj][m][1];
                    if (act) {
#pragma unroll
                        for (int e = 0; e < 4; ++e) { const float s0 = fsigmoid(v0[e]), s1 = fsigmoid(v1[e]); v0[e] = (act == 1) ? v0[e] * s0 : s0; v1[e] = (act == 1) ? v1[e] * s1 : s1; } }
                    u32x4 w; w.x = cvt_pk_bf16(v0[0], v0[1]); w.y = cvt_pk_bf16(v0[2], v0[3]); w.z = cvt_pk_bf16(v1[0], v1[1]); w.w = cvt_pk_bf16(v1[2], v1[3]);
                    *(u32x4*)(rowp + bj * HALF) = w; } }
    }
};
struct EpiMerge {
    static constexpr bool PERM = true, INIT = false;
    bf16_t* Mb; const bf16_t* MG;
    __device__ __forceinline__ void operator()(const f32x4 (&acc)[2][2][4][2], const Unit& u, int wr, int wc, int fr, int fq) const {
        const int row0 = u.pm * BM + wr * 64 + fr, col0 = u.pn * BM + wc * 32 + 8 * fq;
#pragma unroll
        for (int ai = 0; ai < 2; ++ai)
#pragma unroll
            for (int m = 0; m < 4; ++m) { const size_t r = (size_t)(row0 + ai * HALF + m * 16);
#pragma unroll
                for (int bj = 0; bj < 2; ++bj) { const f32x4 v0 = acc[ai][bj][m][0], v1 = acc[ai][bj][m][1];
                    const u32x4 gw = *(const u32x4*)(MG + r * 2048 + u.part * 1024 + col0 + bj * HALF);
                    float o[8] = {v0[0] * bflo(gw.x), v0[1] * bfhi(gw.x), v0[2] * bflo(gw.y), v0[3] * bfhi(gw.y), v1[0] * bflo(gw.z), v1[1] * bfhi(gw.z), v1[2] * bflo(gw.w), v1[3] * bfhi(gw.w)};
                    bf16_t* dst = Mb + r * 1024 + col0 + bj * HALF;
                    if (u.part) { const u32x4 pw = *(const u32x4*)dst;
                        o[0] += bflo(pw.x); o[1] += bfhi(pw.x); o[2] += bflo(pw.y); o[3] += bfhi(pw.y); o[4] += bflo(pw.z); o[5] += bfhi(pw.z); o[6] += bflo(pw.w); o[7] += bfhi(pw.w); }
                    u32x4 w; w.x = cvt_pk_bf16(o[0], o[1]); w.y = cvt_pk_bf16(o[2], o[3]); w.z = cvt_pk_bf16(o[4], o[5]); w.w = cvt_pk_bf16(o[6], o[7]);
                    *(u32x4*)dst = w; } }
    }
};
struct EpiOut {
    static constexpr bool PERM = false, INIT = true;
    const float* X; float* O;
    __device__ __forceinline__ void init(f32x4 (&acc)[2][2][4][2], const Unit& u, int wr, int wc, int fr, int fq) const {
        const int row0 = u.pm * BM + wr * 64 + fr, col0 = u.pn * BM + wc * 32 + 4 * fq;
#pragma unroll
        for (int ai = 0; ai < 2; ++ai)
#pragma unroll
            for (int m = 0; m < 4; ++m) { const size_t off = (size_t)(row0 + ai * HALF + m * 16) * 1024 + col0;
#pragma unroll
                for (int bj = 0; bj < 2; ++bj)
#pragma unroll
                    for (int n = 0; n < 2; ++n) acc[ai][bj][m][n] = *(const f32x4*)(X + off + bj * HALF + n * 16); }
    }
    __device__ __forceinline__ void operator()(const f32x4 (&acc)[2][2][4][2], const Unit& u, int wr, int wc, int fr, int fq) const {
        const int row0 = u.pm * BM + wr * 64 + fr, col0 = u.pn * BM + wc * 32 + 4 * fq;
#pragma unroll
        for (int ai = 0; ai < 2; ++ai)
#pragma unroll
            for (int m = 0; m < 4; ++m) { const size_t off = (size_t)(row0 + ai * HALF + m * 16) * 1024 + col0;
#pragma unroll
                for (int bj = 0; bj < 2; ++bj)
#pragma unroll
                    for (int n = 0; n < 2; ++n) *(f32x4*)(O + off + bj * HALF + n * 16) = acc[ai][bj][m][n]; }
    }
};

template <class Epi, class Sched, bool ALIGN_EPI>
__device__ __forceinline__ void gemm_phase(PG8_LAS unsigned char* lds, const Gemm g, const Sched& S, const Epi& E, int wid) {
    const int lane = lane_id(), tid = wid * 64 + lane, wr = wid >> 2, wc = wid & 3, fr = lane & 15, fq = lane >> 4;
    const int K = g.K, nt = K / BK;
    unsigned voffA[2], voffB[2];
#pragma unroll
    for (int i = 0; i < 2; ++i) { int R, C; stage_rc(tid * 16 + i * 8192, R, C); const int Rb = Epi::PERM ? ((R & ~31) + perm32(R & 31)) : R;
        voffA[i] = (unsigned)(R * g.lda + C) * 2u; voffB[i] = (unsigned)(Rb * g.ldb + C) * 2u; }
    const size_t kstep = (size_t)(BK * 2);
    const size_t hstepA = (size_t)HALF * g.lda * 2, hstepB = (size_t)HALF * g.ldb * 2;
    const size_t tstepA = 2 * hstepA, tstepB = 2 * hstepB;
    const unsigned ldsw = (unsigned)wid * 1024u;
    const int aoff = lds_byte(wr * 64 + fr, fq * 8), boff = lds_byte(wc * 32 + fr, fq * 8);
#define PG8_SA(b, h) (((b) * 2 + (h)) * HTB)
#define PG8_SB(b, h) ((4 + (b) * 2 + (h)) * HTB)
#define PG8_STAGE(bufoff, gbase, voff) do { _Pragma("unroll") for (int _i = 0; _i < 2; ++_i) \
        __builtin_amdgcn_global_load_lds((const unsigned*)((const char*)(gbase) + (voff)[_i]), (PG8_LAS unsigned*)(lds + (bufoff) + ldsw + _i * 8192), 16, 0, 0); } while (0)
#define PG8_LDA(dst, b, h) do { _Pragma("unroll") for (int m = 0; m < 4; ++m) _Pragma("unroll") for (int k = 0; k < 2; ++k) dst[m][k] = *(const PG8_LAS bf16x8*)(lds + PG8_SA(b, h) + aoff + m * 2048 + k * 1024); } while (0)
#define PG8_LDB(dst, b, h) do { _Pragma("unroll") for (int n = 0; n < 2; ++n) _Pragma("unroll") for (int k = 0; k < 2; ++k) dst[n][k] = *(const PG8_LAS bf16x8*)(lds + PG8_SB(b, h) + boff + n * 2048 + k * 1024); } while (0)
#define PG8_MMA(ai, bj, At, Bt) do { __builtin_amdgcn_s_setprio(1); _Pragma("unroll") for (int m = 0; m < 4; ++m) _Pragma("unroll") for (int n = 0; n < 2; ++n) _Pragma("unroll") for (int k = 0; k < 2; ++k) \
        acc[ai][bj][m][n] = __builtin_amdgcn_mfma_f32_16x16x32_bf16(Bt[n][k], At[m][k], acc[ai][bj][m][n], 0, 0, 0); __builtin_amdgcn_s_setprio(0); } while (0)
#define PG8_WAIT_V(n) asm volatile("s_waitcnt vmcnt(" #n ")" ::: "memory")
#define PG8_WAIT_L(n) asm volatile("s_waitcnt lgkmcnt(" #n ")" ::: "memory")
#define PG8_BAR __builtin_amdgcn_s_barrier()
#define PG8_SCHED __builtin_amdgcn_sched_barrier(0)
#define PG8_UA(u) ((const char*)((u).part ? g.A2 : g.A) + (size_t)(u).pm * tstepA)
#define PG8_UB(u) ((const char*)((u).part ? g.Bt2 : g.Bt) + (size_t)(u).pn * tstepB)
    Unit cur, nxt; int ui = 0;
    if (!S.next(0, cur)) return;
    f32x4 acc[2][2][4][2];
    if constexpr (Epi::INIT) E.init(acc, cur, wr, wc, fr, fq);
    else {
#pragma unroll
    for (int a = 0; a < 2; ++a)
#pragma unroll
        for (int b = 0; b < 2; ++b)
#pragma unroll
            for (int m = 0; m < 4; ++m)
#pragma unroll
                for (int n = 0; n < 2; ++n) acc[a][b][m][n] = (f32x4){0.f, 0.f, 0.f, 0.f};
    }
    bf16x8 At[4][2], B0[2][2], B1[2][2];
    const char* cA = PG8_UA(cur); const char* cB = PG8_UB(cur);
    PG8_STAGE(PG8_SB(0, 0), cB, voffB); PG8_STAGE(PG8_SB(0, 1), cB + hstepB, voffB); PG8_STAGE(PG8_SA(0, 0), cA, voffA); PG8_STAGE(PG8_SA(0, 1), cA + hstepA, voffA);
    if (wr == 1) PG8_BAR;
    PG8_WAIT_V(2); PG8_BAR;
    PG8_STAGE(PG8_SB(1, 0), cB + kstep, voffB); PG8_STAGE(PG8_SA(1, 0), cA + kstep, voffA); PG8_STAGE(PG8_SB(1, 1), cB + hstepB + kstep, voffB);
    PG8_WAIT_V(6); PG8_BAR;
    for (;;) {
        const bool has_next = S.next(ui + 1, nxt);
        const char* nA = has_next ? PG8_UA(nxt) : cA; const char* nB = has_next ? PG8_UB(nxt) : cB;
        for (int t = 0; t < nt; t += 2) {
            const bool last = (t == nt - 2);
            const char* a1 = cA + (size_t)(t + 1) * kstep;
            const char* a2 = last ? nA : cA + (size_t)(t + 2) * kstep; const char* b2 = last ? nB : cB + (size_t)(t + 2) * kstep;
            const char* a3 = a2 + kstep; const char* b3 = b2 + kstep;
            PG8_LDB(B0, 0, 0); PG8_LDB(B1, 0, 1); PG8_SCHED; PG8_LDA(At, 0, 0); PG8_STAGE(PG8_SA(1, 1), a1 + hstepA, voffA);
            PG8_WAIT_V(8); PG8_WAIT_L(0); PG8_BAR; PG8_MMA(0, 0, At, B0); PG8_MMA(0, 1, At, B1); PG8_BAR; PG8_SCHED;
            PG8_LDA(At, 0, 1); PG8_STAGE(PG8_SB(0, 0), b2, voffB); PG8_STAGE(PG8_SB(0, 1), b2 + hstepB, voffB); PG8_STAGE(PG8_SA(0, 0), a2, voffA);
            PG8_WAIT_V(8); PG8_WAIT_L(0); PG8_BAR; PG8_MMA(1, 0, At, B0); PG8_MMA(1, 1, At, B1); PG8_BAR; PG8_SCHED;
            PG8_LDB(B0, 1, 0); PG8_LDB(B1, 1, 1); PG8_SCHED; PG8_LDA(At, 1, 0); PG8_STAGE(PG8_SA(0, 1), a2 + hstepA, voffA);
            PG8_WAIT_V(8); PG8_WAIT_L(0); PG8_BAR; PG8_MMA(0, 0, At, B0); PG8_MMA(0, 1, At, B1); PG8_BAR; PG8_SCHED;
            PG8_LDA(At, 1, 1); PG8_STAGE(PG8_SB(1, 0), b3, voffB); PG8_STAGE(PG8_SB(1, 1), b3 + hstepB, voffB); PG8_STAGE(PG8_SA(1, 0), a3, voffA);
            PG8_WAIT_V(8); PG8_WAIT_L(0); PG8_BAR; PG8_MMA(1, 0, At, B0); PG8_MMA(1, 1, At, B1); PG8_BAR; PG8_SCHED;
        }
        if constexpr (ALIGN_EPI) { if (wr == 0) PG8_BAR; }
        E(acc, cur, wr, wc, fr, fq);
        if (!has_next) break;
        if constexpr (Epi::INIT) E.init(acc, nxt, wr, wc, fr, fq);
        else {
#pragma unroll
        for (int a = 0; a < 2; ++a)
#pragma unroll
            for (int b = 0; b < 2; ++b)
#pragma unroll
                for (int m = 0; m < 4; ++m)
#pragma unroll
                    for (int n = 0; n < 2; ++n) acc[a][b][m][n] = (f32x4){0.f, 0.f, 0.f, 0.f};
        }
        cur = nxt; cA = nA; cB = nB; ++ui;
        if constexpr (ALIGN_EPI) { if (wr == 1) PG8_BAR; }
    }
    PG8_WAIT_V(0);
    if constexpr (!ALIGN_EPI) { if (wr == 0) PG8_BAR; }
    PG8_BAR;
#undef PG8_SA
#undef PG8_SB
#undef PG8_STAGE
#undef PG8_LDA
#undef PG8_LDB
#undef PG8_MMA
#undef PG8_WAIT_V
#undef PG8_WAIT_L
#undef PG8_BAR
#undef PG8_SCHED
#undef PG8_UA
#undef PG8_UB
}
}

constexpr int NWAVES = 8;
constexpr int N_LAUNCHES = MK_N_LAUNCHES;
constexpr int PER_PHASE = 6;
constexpr size_t MiB = 1u << 20;
constexpr size_t WS_CTL = 0, CTL_ZERO_BYTES = 65536;
constexpr size_t WS_WIN = 1 * MiB;
constexpr size_t WS_WA = 11 * MiB;
constexpr size_t WS_WB = 12 * MiB;
constexpr size_t WS_WOUT = 13 * MiB;
constexpr size_t WS_W1T = 15 * MiB;
constexpr size_t WS_SMALL = 17 * MiB;
constexpr size_t WS_SUM = 18 * MiB;
constexpr size_t WS_KC = 19 * MiB;
constexpr size_t WS_XN = 20 * MiB;
constexpr size_t WS_Q = 52 * MiB;
constexpr size_t WS_KV = 68 * MiB;
constexpr size_t WS_MB = 52 * MiB;
constexpr size_t WS_U = 92 * MiB;
constexpr size_t WS_BR = 108 * MiB;
constexpr size_t WS_GN = 116 * MiB;
constexpr size_t WS_GL = 132 * MiB;
constexpr size_t WS_MG = 148 * MiB;
constexpr size_t WS_VT = 212 * MiB;
constexpr size_t WS_KT = 216 * MiB;
constexpr size_t WS_Q2 = 220 * MiB;
constexpr size_t WS_END = 236 * MiB;
constexpr size_t SM_W2T = 0;
constexpr size_t SM_LWA = 65536;
constexpr size_t SM_LWX = 131072;
constexpr size_t SM_C1 = 262144;
constexpr size_t SM_LUT = 200704;
constexpr int CW_BAR = 4096;

constexpr int RING_BYTES = 160768;
constexpr int LDSCTL_OFF = RING_BYTES, MISC_OFF = LDSCTL_OFF + 320;
constexpr int LDS_BYTES = 163840;

#define RLX_AGENT __ATOMIC_RELAXED, __HIP_MEMORY_SCOPE_AGENT
#define LDS_WAIT() asm volatile("s_waitcnt lgkmcnt(0)" ::: "memory")
#define VM_WAIT() asm volatile("s_waitcnt vmcnt(0)" ::: "memory")

#define XB_TMO      128
#define XB_XCNT(j)  (256  + 64 * (j))
#define XB_XSUB(j)  (1280 + 64 * (j))
#define XB_XGEN(j)  (2304 + 64 * (j))
#define XB_TOP      3328
#define XB_TOPGEN   3392
#define XCD_BAR_WORDS 3456
#define XB_SPIN_CAP (1u << 18)
__device__ __forceinline__ unsigned xb_ld(unsigned* p)              { return __hip_atomic_load(p, __ATOMIC_RELAXED, __HIP_MEMORY_SCOPE_AGENT); }
__device__ __forceinline__ unsigned xb_add(unsigned* p, unsigned v) { return __hip_atomic_fetch_add(p, v, __ATOMIC_RELAXED, __HIP_MEMORY_SCOPE_AGENT); }
__device__ __forceinline__ unsigned xb_xcc_id() { return (unsigned)__builtin_amdgcn_s_getreg((3 << 11) | 20) & 0xFu; }
#define XB_SPIN(cond, bar) do { unsigned _sp = 0; while (cond) { __builtin_amdgcn_s_sleep(1); \
    if ((++_sp & 255u) == 0u) { if (xb_ld(&(bar)[XB_TMO])) break; if (_sp > XB_SPIN_CAP) { atomicAdd(&(bar)[XB_TMO], 1u); break; } } } } while (0)
struct XcdBarrier { unsigned* bar; unsigned x; volatile LAS unsigned* st; };
__device__ __forceinline__ XcdBarrier xcd_barrier_post(unsigned* bar, volatile LAS unsigned* st) {
    XcdBarrier b; b.bar = bar; b.x = xb_xcc_id(); b.st = st;
    if (threadIdx.x == 0) (void)xb_add(&bar[XB_XCNT(b.x)], 1u);
    return b;
}
__device__ __forceinline__ void xcd_barrier_complete(unsigned* bar, unsigned x, unsigned& nloc, unsigned& nx) {
    const unsigned G = gridDim.x * gridDim.y * gridDim.z;
    unsigned sum, cnt, mine, sp = 0u;
    for (;;) {
        sum = 0u; cnt = 0u; mine = 0u;
#pragma unroll
        for (unsigned j = 0; j < 16; ++j) { const unsigned c = xb_ld(&bar[XB_XCNT(j)]); sum += c; cnt += (c > 0u) ? 1u : 0u; mine = (j == x) ? c : mine; }
        if (sum == G) break;
        __builtin_amdgcn_s_sleep(1);
        if ((++sp & 255u) == 0u) { if (xb_ld(&bar[XB_TMO])) break; if (sp > XB_SPIN_CAP) { atomicAdd(&bar[XB_TMO], 1u); break; } }
    }
    nloc = mine > 0u ? mine : 1u; nx = cnt > 0u ? cnt : 1u;
}
__device__ __forceinline__ void xcd_barrier(const XcdBarrier& b) {
    asm volatile("s_waitcnt vmcnt(0)" ::: "memory");
    __syncthreads();
    if (threadIdx.x == 0) {
        unsigned* bar = b.bar;
        __builtin_amdgcn_s_waitcnt(0);
        unsigned nloc = b.st[0], nx = b.st[1];
        if (nloc == 0u) { xcd_barrier_complete(bar, b.x, nloc, nx); b.st[0] = nloc; b.st[1] = nx; }
        const unsigned old = xb_add(&bar[XB_XSUB(b.x)], 1u);
        const unsigned gen = old / nloc;
        if (old + 1u == (gen + 1u) * nloc) {
            __builtin_amdgcn_fence(__ATOMIC_RELEASE, "agent");
            asm volatile("s_waitcnt vmcnt(0)" ::: "memory");
            const unsigned og = xb_add(&bar[XB_TOP], 1u);
            const unsigned tg = og / nx;
            if (og + 1u == (tg + 1u) * nx) xb_add(&bar[XB_TOPGEN], 1u);
            else XB_SPIN(xb_ld(&bar[XB_TOPGEN]) == tg, bar);
            __builtin_amdgcn_fence(__ATOMIC_ACQUIRE, "agent");
            xb_add(&bar[XB_XGEN(b.x)], 1u);
            asm volatile("s_waitcnt vmcnt(0)" ::: "memory");
        } else {
            XB_SPIN(xb_ld(&bar[XB_XGEN(b.x)]) == gen, bar);
            __builtin_amdgcn_fence(__ATOMIC_ACQUIRE, "agent");
            asm volatile("s_waitcnt vmcnt(0)" ::: "memory");
        }
    }
    __syncthreads();
}

struct Args { const float* in[20]; float* out; unsigned char* ws; int ph_lo, ph_hi, li, pad; };
struct Frame {
    LAS unsigned char* lds;
    volatile LAS unsigned* MISC;
    int wave;
    int vcu, G;
    unsigned char* ws;
#define WSP(name, T, off) __device__ __forceinline__ T* name() const { return (T*)(ws + (off)); }
    WSP(WinT, bf16, WS_WIN) WSP(WaT, bf16, WS_WA) WSP(WbT, bf16, WS_WB) WSP(WoutT, bf16, WS_WOUT) WSP(W1T, bf16, WS_W1T)
    WSP(W2T, bf16, WS_SMALL + SM_W2T) WSP(LWA, bf16, WS_SMALL + SM_LWA) WSP(LWX, bf16, WS_SMALL + SM_LWX)
    WSP(C1, float, WS_SMALL + SM_C1) WSP(LUT, float, WS_SMALL + SM_LUT) WSP(SUMA, float, WS_SUM) WSP(SUMB, float, WS_SUM + 524288)
    WSP(KC, bf16, WS_KC) WSP(VC, bf16, WS_KC + 524288) WSP(XN, bf16, WS_XN) WSP(Q, bf16, WS_Q) WSP(KV, bf16, WS_KV) WSP(MB, bf16, WS_MB)
    WSP(VT, bf16, WS_VT) WSP(KT, bf16, WS_KT) WSP(Q2, bf16, WS_Q2) WSP(U, bf16, WS_U) WSP(BR, bf16, WS_BR) WSP(GN, bf16, WS_GN) WSP(GL, bf16, WS_GL) WSP(MG, bf16, WS_MG)
#undef WSP
};

__device__ __forceinline__ int t5_bucket(int n) {
    if (n < 16) return n;
    const int thr[15] = {19, 21, 24, 27, 31, 35, 40, 46, 52, 59, 67, 77, 87, 99, 113};
    int b = 16;
#pragma unroll
    for (int i = 0; i < 15; ++i) b += (n >= thr[i]) ? 1 : 0;
    return b;
}

__device__ __forceinline__ void p0_tr_item(const float* W, int ldw, int k0, int srccol0, int nvalid, bf16* WT, int ldt, int dstrow0, LAS float* scr, int lane) {
    const int c = lane & 31;
    float tv[32];
#pragma unroll
    for (int i = 0; i < 32; ++i) { const int kk = 2 * i + (lane >> 5); tv[i] = (c < nvalid) ? W[(size_t)(k0 + kk) * ldw + srccol0 + c] : 0.f; }
#pragma unroll
    for (int i = 0; i < 32; ++i) { const int kk = 2 * i + (lane >> 5); scr[kk * 33 + c] = tv[i]; }
    LDS_WAIT(); asm volatile("" ::: "memory");
    const int cc = lane & 7;
#pragma unroll
    for (int j = 0; j < 4; ++j) { const int n = (lane >> 3) + 8 * j; const LAS float* s = scr + (8 * cc) * 33 + n;
        u32x4 o; o.x = pk2(s[0 * 33], s[1 * 33]); o.y = pk2(s[2 * 33], s[3 * 33]); o.z = pk2(s[4 * 33], s[5 * 33]); o.w = pk2(s[6 * 33], s[7 * 33]);
        *(u32x4*)(WT + (size_t)(dstrow0 + n) * ldt + k0 + 8 * cc) = o; }
    LDS_WAIT(); asm volatile("" ::: "memory");
}
__device__ __forceinline__ void win_src(int n0, int& src, int& nvalid) {
    nvalid = 32;
    if (n0 < 1280) src = n0;
    else if (n0 < 1792) src = 1816 + (n0 - 1280);
    else if (n0 < 2048) { src = 1792 + (n0 - 1792); nvalid = (n0 == 1792) ? 24 : 0; if (n0 != 1792) src = 0; }
    else if (n0 < 2560) src = 1280 + (n0 - 2048);
    else if (n0 < 3072) src = 2328 + (n0 - 2560);
    else src = 2840 + (n0 - 3072);
}
__device__ __forceinline__ void p0_prologue(const Frame& F, const Args& A) {
    LAS float* scr = (LAS float*)(F.lds + F.wave * 16384);
    const int gw = F.vcu * NWAVES + F.wave, NGW = F.G * NWAVES, lane = lane_id();
    constexpr int I_WIN = 16 * 160, I_WA = 8 * 32, I_WO = 16 * 32, I_W1 = 32 * 8, I_W2 = 4 * 2, I_LR = 2;
    constexpr int NIT = I_WIN + 2 * I_WA + I_WO + 2 * I_W1 + 2 * I_W2 + 16 * I_LR + 256 + 1;
    for (int it = gw; it < NIT; it += NGW) {
        int r = it;
        if (r < I_WIN) { const int kb = r / 160, nb = r % 160; int src, nv; win_src(32 * nb, src, nv); p0_tr_item(A.in[2], 4888, 64 * kb, src, nv, F.WinT(), 1024, 32 * nb, scr, lane); continue; } r -= I_WIN;
        if (r < I_WA) { p0_tr_item(A.in[17], 1024, 64 * (r / 32), 32 * (r % 32), 32, F.WaT(), 512, 32 * (r % 32), scr, lane); continue; } r -= I_WA;
        if (r < I_WA) { p0_tr_item(A.in[18], 1024, 64 * (r / 32), 32 * (r % 32), 32, F.WbT(), 512, 32 * (r % 32), scr, lane); continue; } r -= I_WA;
        if (r < I_WO) { p0_tr_item(A.in[19], 1024, 64 * (r / 32), 32 * (r % 32), 32, F.WoutT(), 1024, 32 * (r % 32), scr, lane); continue; } r -= I_WO;
        if (r < 2 * I_W1) { const int kv = r / I_W1, q = r % I_W1; p0_tr_item(A.in[6] + (size_t)kv * 2048 * 256, 256, 64 * (q / 8), 32 * (q % 8), 32, F.W1T() + (size_t)kv * 256 * 2048, 2048, 32 * (q % 8), scr, lane); continue; } r -= 2 * I_W1;
        if (r < 2 * I_W2) { const int kv = r / I_W2, q = r % I_W2; p0_tr_item(A.in[8] + (size_t)kv * 256 * 64, 64, 64 * (q / 2), 32 * (q % 2), 32, F.W2T() + (size_t)kv * 64 * 256, 256, 32 * (q % 2), scr, lane); continue; } r -= 2 * I_W2;
        if (r < 16 * I_LR) { const int mtx = r / 2, nb = r % 2; const float* src = (mtx < 8 ? A.in[12] : A.in[14]) + (size_t)(mtx & 7) * 4096; bf16* dst = (mtx < 8 ? F.LWA() : F.LWX()) + (size_t)(mtx & 7) * 4096;
            p0_tr_item(src, 64, 0, 32 * nb, 32, dst, 64, 32 * nb, scr, lane); continue; } r -= 16 * I_LR;
        if (r < 256) {
            const int kc = r >> 3, kv = (r >> 2) & 1, n = (r & 3) * 64 + lane; const float* w1 = A.in[6] + (size_t)kv * 2048 * 256 + (size_t)(64 * kc) * 256 + n; const float* pe = A.in[5] + kv * 2048 + 64 * kc;
            float s0 = 0.f, s1 = 0.f, s2 = 0.f, s3 = 0.f;
#pragma unroll 4
            for (int k = 0; k < 64; k += 4) { s0 += pe[k] * w1[(size_t)k * 256]; s1 += pe[k + 1] * w1[(size_t)(k + 1) * 256]; s2 += pe[k + 2] * w1[(size_t)(k + 2) * 256]; s3 += pe[k + 3] * w1[(size_t)(k + 3) * 256]; }
            F.C1()[(kc * 2 + kv) * 256 + n] = (s0 + s1) + (s2 + s3); continue; } r -= 256;
        {
            for (int e = lane; e < 1024; e += 64) { const int hd = e >> 7, n = e & 127; F.LUT()[e] = A.in[9][t5_bucket(n) * 8 + hd] * LOG2E; }
        }
    }
    const float* gain = A.in[1];
    {
        f32x4 v[4], vn[4];
        if (gw < SEQ) { const f32x4* xr = (const f32x4*)(A.in[0] + (size_t)gw * DM) + lane;
#pragma unroll
            for (int j = 0; j < 4; ++j) v[j] = xr[64 * j]; }
        for (int m = gw; m < SEQ; m += NGW) {
            if (m + NGW < SEQ) { const f32x4* xr = (const f32x4*)(A.in[0] + (size_t)(m + NGW) * DM) + lane;
#pragma unroll
                for (int j = 0; j < 4; ++j) vn[j] = xr[64 * j]; }
            float s = 0.f;
#pragma unroll
            for (int j = 0; j < 4; ++j) s += (v[j].x * v[j].x + v[j].y * v[j].y) + (v[j].z * v[j].z + v[j].w * v[j].w);
            const float rs = 1.0f / sqrtf(wave_sum(s) * (1.f / DM) + RMS_EPS);
            unsigned long long* o8 = (unsigned long long*)(F.XN() + (size_t)m * DM) + lane;
#pragma unroll
            for (int j = 0; j < 4; ++j) { const f32x4 gv = ((const f32x4*)gain)[lane + 64 * j];
                o8[64 * j] = (unsigned long long)pk2(v[j].x * rs * gv.x, v[j].y * rs * gv.y) | ((unsigned long long)pk2(v[j].z * rs * gv.z, v[j].w * rs * gv.w) << 32); }
#pragma unroll
            for (int j = 0; j < 4; ++j) v[j] = vn[j];
        }
    }
}

template <bool FINAL>
__device__ __forceinline__ void lru_tile(const Frame& F, const Args& A, int tt) {
    const int lane = lane_id();
    const int w = F.wave, fr = lane & 15, fq = lane >> 4, ch0 = 64 * w, t0 = 64 * tt;
    LAS float* UC = (LAS float*)(F.lds + w * 16384);
#define UC_IDX(tok, ch) ((tok) * 64 + ((((ch) >> 2) ^ ((tok) & 15)) << 2) + ((ch) & 3))
    float Hc = 0.f;
    if (FINAL) {
        const float* sa = F.SUMA() + ch0 + lane; const float* sb = F.SUMB() + ch0 + lane;
        int i = 0;
        for (; i + 16 <= tt; i += 16) { float ta[16], tb[16];
#pragma unroll
            for (int k = 0; k < 16; ++k) { ta[k] = sa[(size_t)(i + k) * 512]; tb[k] = sb[(size_t)(i + k) * 512]; }
#pragma unroll
            for (int k = 0; k < 16; ++k) Hc = ta[k] * Hc + tb[k]; }
        for (; i < tt; ++i) Hc = sa[(size_t)i * 512] * Hc + sb[(size_t)i * 512];
        asm volatile("" : "+v"(Hc));
    }
    {
        const int ch = ch0 + lane; const float* cw = A.in[10]; const float cb = A.in[11][ch];
        const float w0 = cw[ch], w1 = cw[512 + ch], w2 = cw[1024 + ch], w3 = cw[1536 + ch];
        const bf16* up = F.U() + (size_t)t0 * 512 + ch;
        float u0 = 0.f, u1 = 0.f, u2 = 0.f;
        if (tt > 0) { u0 = bf2f(up[-3 * 512]); u1 = bf2f(up[-2 * 512]); u2 = bf2f(up[-1 * 512]); }
        unsigned short ur[64];
#pragma unroll
        for (int tok = 0; tok < 64; ++tok) ur[tok] = up[(size_t)tok * 512];
#pragma unroll
        for (int tok = 0; tok < 64; ++tok) { const float u3 = bf2f(ur[tok]);
            UC[UC_IDX(tok, lane)] = cb + ((u0 * w0 + u1 * w1) + (u2 * w2 + u3 * w3)); u0 = u1; u1 = u2; u2 = u3; }
    }
    bf16x8 Ba[4][2], Bx[4][2];
#pragma unroll
    for (int nt = 0; nt < 4; ++nt)
#pragma unroll
        for (int ks = 0; ks < 2; ++ks) { const size_t o = (size_t)w * 4096 + (16 * nt + fr) * 64 + 32 * ks + 8 * fq; Ba[nt][ks] = *(const bf16x8*)(F.LWA() + o); Bx[nt][ks] = *(const bf16x8*)(F.LWX() + o); }
    float ba[4], bx[4], sp8[4], hin[4], acum[4];
#pragma unroll
    for (int nt = 0; nt < 4; ++nt) { const int ch = ch0 + 16 * nt + fr; ba[nt] = A.in[13][ch]; bx[nt] = A.in[15][ch];
        sp8[nt] = 8.0f * log1pf(expf(-A.in[16][ch])); hin[nt] = 0.f; acum[nt] = 1.f; }
    if (FINAL) {
#pragma unroll
        for (int nt = 0; nt < 4; ++nt) hin[nt] = __shfl(Hc, 16 * nt + fr);
    }
    LDS_WAIT();
    unsigned short glv[16], gln[16];
    if (FINAL) {
#pragma unroll
        for (int nt = 0; nt < 4; ++nt)
#pragma unroll
            for (int rg = 0; rg < 4; ++rg) glv[nt * 4 + rg] = F.GL()[(size_t)(t0 + 4 * fq + rg) * 512 + ch0 + 16 * nt + fr];
    }
#pragma unroll 1
    for (int mt = 0; mt < 4; ++mt) {
        if (FINAL && mt < 3) {
#pragma unroll
            for (int nt = 0; nt < 4; ++nt)
#pragma unroll
                for (int rg = 0; rg < 4; ++rg) gln[nt * 4 + rg] = F.GL()[(size_t)(t0 + 16 * (mt + 1) + 4 * fq + rg) * 512 + ch0 + 16 * nt + fr];
        }
        bf16x8 Af[2];
#pragma unroll
        for (int ks = 0; ks < 2; ++ks) { const int tok = 16 * mt + fr, c0 = 8 * ks + 2 * fq;
            const f32x4 x0 = *(const LAS f32x4*)(UC + tok * 64 + ((c0 ^ (tok & 15)) << 2)), x1 = *(const LAS f32x4*)(UC + tok * 64 + (((c0 + 1) ^ (tok & 15)) << 2));
            u32x4 pw; pw.x = cvtpk(x0[0], x0[1]); pw.y = cvtpk(x0[2], x0[3]); pw.z = cvtpk(x1[0], x1[1]); pw.w = cvtpk(x1[2], x1[3]); Af[ks] = __builtin_bit_cast(bf16x8, pw); }
        f32x4 cr[4], ci[4];
#pragma unroll
        for (int nt = 0; nt < 4; ++nt) { cr[nt] = (f32x4){0.f, 0.f, 0.f, 0.f}; ci[nt] = (f32x4){0.f, 0.f, 0.f, 0.f};
#pragma unroll
            for (int ks = 0; ks < 2; ++ks) { cr[nt] = __builtin_amdgcn_mfma_f32_16x16x32_bf16(Af[ks], Ba[nt][ks], cr[nt], 0, 0, 0); ci[nt] = __builtin_amdgcn_mfma_f32_16x16x32_bf16(Af[ks], Bx[nt][ks], ci[nt], 0, 0, 0); } }
#pragma unroll
        for (int nt = 0; nt < 4; ++nt) {
            float P[4], Hh[4];
#pragma unroll
            for (int rg = 0; rg < 4; ++rg) { const int tok = 16 * mt + 4 * fq + rg, e = 16 * nt + fr;
                const float ucv = UC[UC_IDX(tok, e)];
                const float r = fsigmoid(cr[nt][rg] + ba[nt]), ig = fsigmoid(ci[nt][rg] + bx[nt]);
                const float la = -r * sp8[nt]; const float a = __builtin_amdgcn_exp2f(la * LOG2E);
                const float x2 = 2.0f * la;
                const float ser = -x2 * (1.0f + x2 * (0.5f + x2 * (0.16666667f + x2 * (0.041666668f + x2 * 0.008333334f))));
                const float om = (x2 > -0.25f) ? ser : 1.0f - a * a;
                const float b = __builtin_amdgcn_sqrtf(om) * (ig * ucv);
                if (rg == 0) { P[0] = a; Hh[0] = b; } else { P[rg] = P[rg - 1] * a; Hh[rg] = a * Hh[rg - 1] + b; } }
            float At = P[3], Bt = Hh[3];
            { const float Ap = __shfl_up(At, 16), Bp = __shfl_up(Bt, 16); if (fq >= 1) { Bt = At * Bp + Bt; At = Ap * At; } }
            { const float Ap = __shfl_up(At, 32), Bp = __shfl_up(Bt, 32); if (fq >= 2) { Bt = At * Bp + Bt; At = Ap * At; } }
            float Aex = __shfl_up(At, 16), Bex = __shfl_up(Bt, 16); if (fq == 0) { Aex = 1.f; Bex = 0.f; }
            const float hg = Aex * hin[nt] + Bex;
            float hv[4];
#pragma unroll
            for (int rg = 0; rg < 4; ++rg) hv[rg] = P[rg] * hg + Hh[rg];
            hin[nt] = __shfl(hv[3], 48 + fr);
            if (!FINAL) acum[nt] *= __shfl(At, 48 + fr);
            if (FINAL) {
#pragma unroll
                for (int rg = 0; rg < 4; ++rg) { const size_t t = (size_t)(t0 + 16 * mt + 4 * fq + rg); const int ch = ch0 + 16 * nt + fr;
                    F.XN()[t * 1024 + 512 + ch] = (bf16)f2bf(hv[rg] * bf2f(glv[nt * 4 + rg])); }
            }
        }
        if (FINAL) {
#pragma unroll
            for (int x = 0; x < 16; ++x) glv[x] = gln[x];
        }
    }
    if (!FINAL && fq == 0) {
#pragma unroll
        for (int nt = 0; nt < 4; ++nt) { F.SUMA()[(size_t)tt * 512 + ch0 + 16 * nt + fr] = acum[nt]; F.SUMB()[(size_t)tt * 512 + ch0 + 16 * nt + fr] = hin[nt]; }
    }
    LDS_WAIT();
#undef UC_IDX
}

__device__ __forceinline__ void qk_norm_tile(const Frame& F, const Args& A, int tt) {
    const int lane = lane_id(), sub = lane & 7;
#pragma unroll 4
    for (int it = 0; it < 12; ++it) {
        const int idx = it * 64 + F.wave * 8 + (lane >> 3), tok = idx / 12, hr = idx % 12; const size_t t = (size_t)(64 * tt + tok);
        bf16* p; bf16* dst; const float* gain; float sc = 1.f;
        if (hr < 8) { p = F.Q() + t * 512 + hr * 64; dst = F.Q2() + t * 512 + (hr >> 2) * 256 + (sub >> 1) * 64 + (hr & 3) * 16 + (sub & 1) * 8 - sub * 8; gain = A.in[3]; sc = 0.125f * LOG2E; }
        else if (hr < 10) { p = F.KV() + t * 768 + 256 + (hr - 8) * 64; dst = p; gain = A.in[4] + 64; }
        else { p = F.KV() + t * 768 + 512 + (hr - 10) * 64; dst = p; gain = A.in[4] + 128; }
        const u32x4 w = *(const u32x4*)(p + sub * 8);
        float x[8] = {bflo(w.x), bfhi(w.x), bflo(w.y), bfhi(w.y), bflo(w.z), bfhi(w.z), bflo(w.w), bfhi(w.w)};
        float ss = 0.f;
#pragma unroll
        for (int j = 0; j < 8; ++j) ss += x[j] * x[j];
        ss += __shfl_xor(ss, 1); ss += __shfl_xor(ss, 2); ss += __shfl_xor(ss, 4);
        const float rs = sc / sqrtf(ss * (1.f / 64.f) + RMS_EPS);
        const f32x4 g0 = *(const f32x4*)(gain + sub * 8), g1 = *(const f32x4*)(gain + sub * 8 + 4);
        u32x4 o; o.x = pk2(x[0] * rs * g0.x, x[1] * rs * g0.y); o.y = pk2(x[2] * rs * g0.z, x[3] * rs * g0.w); o.z = pk2(x[4] * rs * g1.x, x[5] * rs * g1.y); o.w = pk2(x[6] * rs * g1.z, x[7] * rs * g1.w);
        *(u32x4*)(dst + sub * 8) = o;
        if (hr >= 8 && hr < 10) *(u32x4*)(F.KT() + ((size_t)((hr - 8) * 256 + tt) * 8 + sub) * 512 + tok * 8) = o;
    }
}

__device__ __forceinline__ void vt_tile(const Frame& F, int J) {
    const int tid = F.wave * 64 + lane_id(), d = tid & 63, ks = (tid >> 6) & 1, gp = tid >> 7;
#pragma unroll
    for (int g = 0; g < 2; ++g) {
        const bf16* vp = F.KV() + (size_t)(64 * J) * 768 + 384 + 64 * g + d;
        unsigned short e[8];
#pragma unroll
        for (int j = 0; j < 8; ++j) { const int key = 32 * ks + 4 * gp + (j & 3) + 16 * (j >> 2); e[j] = vp[(size_t)key * 768]; }
        u32x4 w; w.x = e[0] | ((unsigned)e[1] << 16); w.y = e[2] | ((unsigned)e[3] << 16); w.z = e[4] | ((unsigned)e[5] << 16); w.w = e[6] | ((unsigned)e[7] << 16);
        *(u32x4*)(F.VT() + (size_t)(g * 256 + J) * 4096 + ((((d >> 4) * 2 + ks) * 16 + (d & 15)) * 32) + 8 * gp) = w;
    }
}

__device__ __forceinline__ void compress_item(const Frame& F, const Args& A, int kv, int g, int ct) {
    const int lane = lane_id(), w = F.wave, tid = w * 64 + lane, fr = lane & 15, fq = lane >> 4, c0 = 16 * ct, tb = 16 * c0;
    LAS unsigned char* T = F.lds;
    LAS bf16* HID = (LAS bf16*)(F.lds + 34816);
    LAS float* OUTF = (LAS float*)(F.lds + 34816 + 8448);
    LAS float* C1L = (LAS float*)(F.lds + 34816 + 8448 + 4096);
    {
        u32x4 tv[5];
#pragma unroll
        for (int i = 0; i < 5; ++i) { const int idx = tid + 512 * i, tok = idx >> 3, chn = idx & 7, gt = tb + tok; tv[i] = (u32x4){0u, 0u, 0u, 0u};
            if (idx < 272 * 8 && gt < SEQ) tv[i] = *(const u32x4*)(F.KV() + (size_t)gt * 768 + kv * 128 + g * 64 + chn * 8); }
        { const int n = tid & 255, hf = tid >> 8; float pc[16];
#pragma unroll
            for (int k = 0; k < 16; ++k) pc[k] = F.C1()[((hf * 16 + k) * 2 + kv) * 256 + n];
            float s = hf ? 0.f : A.in[7][kv * 256 + n];
#pragma unroll
            for (int k = 0; k < 16; ++k) s += pc[k];
            C1L[hf * 256 + n] = s; }
#pragma unroll
        for (int i = 0; i < 5; ++i) { const int idx = tid + 512 * i, tok = idx >> 3, chn = idx & 7;
            if (idx < 272 * 8) *(LAS u32x4*)(T + tok * 128 + ((chn ^ ((tok >> 4) & 7)) << 4)) = tv[i]; }
    }
    LDS_WAIT(); __syncthreads();
    f32x4 acc[2] = {(f32x4){0.f, 0.f, 0.f, 0.f}, (f32x4){0.f, 0.f, 0.f, 0.f}};
    const bf16* w1t = F.W1T() + (size_t)kv * 256 * 2048 + (size_t)(32 * w + fr) * 2048 + 8 * fq;
#pragma unroll 32
    for (int ks = 0; ks < 64; ++ks) {
        const int tok = 16 * fr + (ks >> 1), chn = 4 * (ks & 1) + fq;
        const bf16x8 a = *(const LAS bf16x8*)(T + tok * 128 + ((chn ^ ((tok >> 4) & 7)) << 4));
        const bf16x8 b0 = *(const bf16x8*)(w1t + 32 * ks), b1 = *(const bf16x8*)(w1t + (size_t)16 * 2048 + 32 * ks);
        acc[0] = __builtin_amdgcn_mfma_f32_16x16x32_bf16(a, b0, acc[0], 0, 0, 0);
        acc[1] = __builtin_amdgcn_mfma_f32_16x16x32_bf16(a, b1, acc[1], 0, 0, 0);
    }
#pragma unroll
    for (int nt = 0; nt < 2; ++nt) { const int n = 32 * w + 16 * nt + fr; const float c1 = C1L[n] + C1L[256 + n];
#pragma unroll
        for (int rg = 0; rg < 4; ++rg) { const float v = acc[nt][rg] + c1; HID[(4 * fq + rg) * 264 + n] = (bf16)f2bf(v * fsigmoid(v)); } }
    LDS_WAIT(); __syncthreads();
    if (w < 4) {
        f32x4 o = (f32x4){0.f, 0.f, 0.f, 0.f};
        const bf16* w2t = F.W2T() + (size_t)kv * 64 * 256 + (size_t)(16 * w + fr) * 256 + 8 * fq;
#pragma unroll
        for (int ks = 0; ks < 8; ++ks) { const bf16x8 a = *(const LAS bf16x8*)(HID + fr * 264 + 32 * ks + 8 * fq); const bf16x8 b = *(const bf16x8*)(w2t + 32 * ks);
            o = __builtin_amdgcn_mfma_f32_16x16x32_bf16(a, b, o, 0, 0, 0); }
#pragma unroll
        for (int rg = 0; rg < 4; ++rg) OUTF[(4 * fq + rg) * 64 + 16 * w + fr] = o[rg];
    }
    LDS_WAIT(); __syncthreads();
    {
        const int row = tid >> 5, e = 2 * (tid & 31), c = c0 + row;
        float v0 = OUTF[row * 64 + e], v1 = OUTF[row * 64 + e + 1];
        if (kv == 0) { float ss = v0 * v0 + v1 * v1;
#pragma unroll
            for (int o = 1; o < 32; o <<= 1) ss += __shfl_xor(ss, o);
            const float rs = 1.0f / sqrtf(ss * (1.f / 64.f) + RMS_EPS); v0 *= rs * A.in[4][e]; v1 *= rs * A.in[4][e + 1]; }
        if (c >= 1023) { v0 = 0.f; v1 = 0.f; }
        bf16* dst = (kv == 0 ? F.KC() : F.VC()) + ((size_t)g * 1024 + c) * 64 + e;
        *(unsigned*)dst = pk2(v0, v1);
    }
    LDS_WAIT(); __syncthreads();
}

namespace att {
constexpr int SLOTB = 8192, NSLOT = 3;
constexpr int L_K = 0, L_V = NSLOT * SLOTB, L_SC = 2 * NSLOT * SLOTB, L_OUT = L_SC + 65536, L_LUT = L_OUT + 32768, L_WSF = L_LUT + 2048, L_BM = L_WSF + 2048, L_REF = L_BM + 2048, L_LACC = L_REF + 1024, L_TL = L_LACC + 1024  , L_END = L_TL + 5120;
static_assert(L_END <= RING_BYTES, "attention LDS map");
constexpr int L_EX = 0  , L_HDR = 32768  , L_LEX = 33024  , L_NT = 34048  ;
constexpr float CLAMP = 100.0f;
constexpr float THR = 8.0f;
#define SBAR() __builtin_amdgcn_sched_barrier(0)
__device__ __forceinline__ int crow(int r, int hi) { return (r & 3) + 8 * (r >> 2) + 4 * hi; }
__device__ __forceinline__ void glds16(const void* gsrc, unsigned lds_dst) { unsigned keep;
    asm volatile("s_mov_b32 %0, m0\n\ts_mov_b32 m0, %2\n\ts_nop 0\n\tglobal_load_lds_dwordx4 %1, off\n\ts_mov_b32 m0, %0" : "=&s"(keep) : "v"(gsrc), "s"(lds_dst) : "memory"); }
__device__ __forceinline__ void qkt(f32x16& p0, f32x16& p1, const LAS unsigned char* Kslot, const bf16x8* qr, float cinit, int r32, int hi) {
    const LAS unsigned char* kb = Kslot + hi * 1024 + r32 * 16;
#pragma unroll
    for (int r = 0; r < 16; ++r) { p0[r] = cinit; p1[r] = cinit; }
#pragma unroll
    for (int d0 = 0; d0 < 4; ++d0) {
        const bf16x8 b0 = *(const LAS bf16x8*)(kb + d0 * 2048);
        const bf16x8 b1 = *(const LAS bf16x8*)(kb + d0 * 2048 + 512);
        p0 = __builtin_amdgcn_mfma_f32_32x32x16_bf16(b0, qr[d0], p0, 0, 0, 0); p1 = __builtin_amdgcn_mfma_f32_32x32x16_bf16(b1, qr[d0], p1, 0, 0, 0); }
}
__device__ __forceinline__ void pv(f32x16* o, int vb, bf16x8 pa0, bf16x8 pa1, bf16x8 pa2, bf16x8 pa3) {
#pragma unroll
    for (int d0 = 0; d0 < 2; ++d0) { s16x4 lo[4], hi[4];
#pragma unroll
        for (int ks = 0; ks < 4; ++ks) {
            asm volatile("ds_read_b64_tr_b16 %0,%1 offset:%c2" : "=&v"(lo[ks]) : "v"(vb), "i"(d0 * 4096 + ks * 1024) : "memory");
            asm volatile("ds_read_b64_tr_b16 %0,%1 offset:%c2" : "=&v"(hi[ks]) : "v"(vb), "i"(d0 * 4096 + ks * 1024 + 512) : "memory"); }
        asm volatile("s_waitcnt lgkmcnt(0)" ::: "memory"); SBAR();
#define PK(k) (bf16x8){lo[k][0], lo[k][1], lo[k][2], lo[k][3], hi[k][0], hi[k][1], hi[k][2], hi[k][3]}
        o[d0] = __builtin_amdgcn_mfma_f32_32x32x16_bf16(pa0, PK(0), o[d0], 0, 0, 0);
        o[d0] = __builtin_amdgcn_mfma_f32_32x32x16_bf16(pa1, PK(1), o[d0], 0, 0, 0);
        o[d0] = __builtin_amdgcn_mfma_f32_32x32x16_bf16(pa2, PK(2), o[d0], 0, 0, 0);
        o[d0] = __builtin_amdgcn_mfma_f32_32x32x16_bf16(pa3, PK(3), o[d0], 0, 0, 0);
#undef PK
    }
}
__device__ __forceinline__ float rowmax(const f32x16& p0, const f32x16& p1) {
    float a = fmaxf(fmaxf(p0[0], p0[1]), p1[0]), b = fmaxf(fmaxf(p0[2], p0[3]), p1[1]); a = fmaxf(fmaxf(a, p1[2]), p1[3]);
#pragma unroll
    for (int r = 4; r < 16; r += 4) { a = fmaxf(fmaxf(a, p0[r]), p0[r + 1]); b = fmaxf(fmaxf(b, p0[r + 2]), p0[r + 3]); a = fmaxf(fmaxf(a, p1[r]), p1[r + 1]); b = fmaxf(fmaxf(b, p1[r + 2]), p1[r + 3]); }
    const float m = fmaxf(a, b);
    auto rr = __builtin_amdgcn_permlane32_swap(__float_as_uint(m), __float_as_uint(m), false, false);
    return fmaxf(__uint_as_float(rr[0]), __uint_as_float(rr[1]));
}
__device__ __forceinline__ float halfsum(float v) { auto rr = __builtin_amdgcn_permlane32_swap(__float_as_uint(v), __float_as_uint(v), false, false); return __uint_as_float(rr[0]) + __uint_as_float(rr[1]); }
template <int STEP, unsigned LIMIT>
__device__ __forceinline__ void near_apply(f32x16& p0, f32x16& p1, int dbase, const LAS float* lut) {
    float b0[16], b1[16];
#pragma unroll
    for (int r = 0; r < 16; ++r) { const int koff = (r & 3) + 8 * (r >> 2); const int d0 = dbase - STEP * koff, d1 = d0 - STEP * 32;
        b0[r] = lut[min(max(d0, 0), 127)]; b1[r] = lut[min(max(d1, 0), 127)]; }
#pragma unroll
    for (int r = 0; r < 16; ++r) { asm volatile("" : "+v"(b0[r]), "+v"(b1[r])); }
#pragma unroll
    for (int r = 0; r < 16; ++r) { const int koff = (r & 3) + 8 * (r >> 2); const int d0 = dbase - STEP * koff, d1 = d0 - STEP * 32;
        const float t0 = p0[r] + b0[r], t1 = p1[r] + b1[r];
        p0[r] = ((unsigned)d0 < LIMIT) ? t0 : -INFINITY; p1[r] = ((unsigned)d1 < LIMIT) ? t1 : -INFINITY; }
}
template <bool HASO>
__device__ __forceinline__ void sm_update(f32x16& p0, f32x16& p1, float& m, float& l, f32x16* o, LAS float* wsf, int r32, int hi) {
    const float rm = rowmax(p0, p1);
    const bool need = rm > m + THR;
    if (__any(need)) {
        const float mn = need ? rm : m; const float alpha = __builtin_amdgcn_exp2f(m - mn);
        l *= alpha; m = mn;
        if (HASO) { if (hi == 0) wsf[r32] = alpha; LDS_WAIT();
#pragma unroll
            for (int r = 0; r < 16; ++r) { const float f = wsf[crow(r, hi)]; o[0][r] *= f; o[1][r] *= f; } }
    }
    float s = 0.f;
#pragma unroll
    for (int r = 0; r < 16; ++r) { p0[r] = __builtin_amdgcn_exp2f(p0[r] - m); p1[r] = __builtin_amdgcn_exp2f(p1[r] - m); s += p0[r] + p1[r]; }
    l += s;
}
#define ATT_PACK(P0, P1) \
    const bf16x8 pa0 = __builtin_bit_cast(bf16x8, (u32x4){cvtpk(P0[0], P0[1]), cvtpk(P0[2], P0[3]), cvtpk(P0[4], P0[5]), cvtpk(P0[6], P0[7])}); \
    const bf16x8 pa1 = __builtin_bit_cast(bf16x8, (u32x4){cvtpk(P0[8], P0[9]), cvtpk(P0[10], P0[11]), cvtpk(P0[12], P0[13]), cvtpk(P0[14], P0[15])}); \
    const bf16x8 pa2 = __builtin_bit_cast(bf16x8, (u32x4){cvtpk(P1[0], P1[1]), cvtpk(P1[2], P1[3]), cvtpk(P1[4], P1[5]), cvtpk(P1[6], P1[7])}); \
    const bf16x8 pa3 = __builtin_bit_cast(bf16x8, (u32x4){cvtpk(P1[8], P1[9]), cvtpk(P1[10], P1[11]), cvtpk(P1[12], P1[13]), cvtpk(P1[14], P1[15])});
#define ATT_WAITBAR(N) asm volatile("s_waitcnt vmcnt(" #N ") lgkmcnt(0)\n\ts_barrier" ::: "memory")
#define ATT_FILL(V, x) do { _Pragma("unroll") for (int _r = 0; _r < 16; ++_r) V[_r] = (x); } while (0)

__device__ __forceinline__ unsigned rangemask(int k, int a, int b) {
    const int lo = max(a - 32 * k, 0), hi = min(b - 32 * k, 31);
    return (lo > hi) ? 0u : ((0xFFFFFFFFu >> (31 - hi)) & (0xFFFFFFFFu << lo));
}
__device__ __forceinline__ int wave_max_i32(int x) {
    x = max(x, dpp_i<0xB1>(x)); x = max(x, dpp_i<0x4E>(x)); x = max(x, dpp_i<0x141>(x)); x = max(x, dpp_i<0x140>(x));
    return max(max(__builtin_amdgcn_readlane(x, 0), __builtin_amdgcn_readlane(x, 16)), max(__builtin_amdgcn_readlane(x, 32), __builtin_amdgcn_readlane(x, 48)));
}

__device__ __forceinline__ void lds_add_f32(LAS float* p, float v) { (void)__hip_atomic_fetch_add(p, v, __ATOMIC_RELAXED, __HIP_MEMORY_SCOPE_WORKGROUP); }

__device__ __forceinline__ void attn_item(const Frame& F, int qt, int g) {
    const int lane = lane_id(), wid = F.wave, tid = wid * 64 + lane, r32 = lane & 31, hi = lane >> 5;
    const int ql = r32 >> 2, h = r32 & 3, cur = qt, t = 64 * qt + 8 * wid + ql, head = 4 * g + h;
    LAS unsigned char* shm = F.lds;
    const unsigned lds0 = (unsigned)(uintptr_t)shm;
    LAS float* wsf = (LAS float*)(shm + L_WSF) + wid * 64;
    LAS float* SC = (LAS float*)(shm + L_SC);
    LAS float* OACC = (LAS float*)(shm + L_SC);
    LAS float* lutl = (LAS float*)(shm + L_LUT);
    const LAS float* luth = lutl + h * 128;
    LAS unsigned* BM = (LAS unsigned*)(shm + L_BM);
    LAS float* REF = (LAS float*)(shm + L_REF);
    LAS float* LACC = (LAS float*)(shm + L_LACC);
    lutl[tid] = F.LUT()[(4 * g + (tid >> 7)) * 128 + (tid & 127)];
    BM[tid] = 0u;
    LAS bf16* QL = (LAS bf16*)(shm + L_OUT);
#pragma unroll
    for (int i = 0; i < 4; ++i) { const int chn = tid + 512 * i;
        *(LAS u32x4*)(QL + (chn >> 5) * 256 + (chn & 31) * 8) = *(const u32x4*)(F.Q2() + (size_t)(64 * qt + (chn >> 5)) * 512 + g * 256 + (chn & 31) * 8); }
    bf16x8 qr[4];
    { const bf16* qp = F.Q2() + (size_t)t * 512 + g * 256 + h * 16 + hi * 8;
#pragma unroll
        for (int d0 = 0; d0 < 4; ++d0) qr[d0] = *(const bf16x8*)(qp + d0 * 64); }
    const float b31 = F.LUT()[head * 128 + 127];
    const float gate_c = fsigmoid(bf2f(F.BR()[(size_t)t * 256 + head])), gate_s = fsigmoid(bf2f(F.BR()[(size_t)t * 256 + 8 + head])), gate_w = fsigmoid(bf2f(F.BR()[(size_t)t * 256 + 16 + head]));
    f32x16 o[2], p0, p1;
    const unsigned kdst = lds0 + L_K + wid * 1024, vdst = lds0 + L_V + wid * 1024;
    const int vrow = 16 * (wid & 3) + (lane >> 2), vcol = (wid >> 2) * 32 + (lane & 3) * 8;
    const int vb0 = (int)(lds0 + L_V) + ((lane >> 4) & 1) * 32 + (lane & 3) * 8 + (4 * hi + ((lane & 15) >> 2)) * 64;
#define DMA_K(base, pitch, row0, slot) glds16((base) + (size_t)((row0) + lane) * (pitch) + wid * 8, (unsigned)__builtin_amdgcn_readfirstlane(kdst + (slot)))
#define DMA_V(base, pitch, row0, slot) glds16((base) + (size_t)((row0) + vrow) * (pitch) + vcol, (unsigned)__builtin_amdgcn_readfirstlane(vdst + (slot)))
#define ROT() do { sl_cur = sl_next; sl_next = (sl_next == (NSLOT - 1) * SLOTB) ? 0 : sl_next + SLOTB; } while (0)
    VM_WAIT(); LDS_WAIT(); __syncthreads();

    const bf16* KCg = F.KC() + (size_t)g * 1024 * 64; const bf16* VCg = F.VC() + (size_t)g * 1024 * 64;
    const int nkt = (qt >> 4) + 1;
    const int tminw = 64 * qt + 8 * wid;
    float m = -1e30f, l = 0.f;
    {
        int sl_cur = 0, sl_next = SLOTB;
        DMA_K(KCg, 64, 0, 0);
        for (int kt = 0; kt < nkt; ++kt) {
            if (kt + 1 < nkt) { DMA_K(KCg, 64, 64 * (kt + 1), sl_next); ATT_WAITBAR(1); } else { ATT_WAITBAR(0); }
            const bool far = (tminw - 31 - 16 * (64 * kt + 63)) >= 128;
            if (far) { qkt(p0, p1, shm + L_K + sl_cur, qr, b31, r32, hi); }
            else { qkt(p0, p1, shm + L_K + sl_cur, qr, 0.f, r32, hi); near_apply<16, 0x80000000u>(p0, p1, t - 31 - 16 * (64 * kt + 4 * hi), luth); }
            sm_update<false>(p0, p1, m, l, o, wsf, r32, hi);
            ROT();
        }
        LDS_WAIT(); __builtin_amdgcn_s_barrier();
    }
    {
        const float lt = halfsum(l); const float rl = lt > 0.f ? 1.0f / lt : 0.f;
        ATT_FILL(o[0], 0.f); ATT_FILL(o[1], 0.f);
        float carry = 0.f;
        int sl_cur = 0, sl_next = SLOTB;
        DMA_K(KCg, 64, 0, 0); DMA_V(VCg, 64, 0, 0);
        for (int kt = 0; kt < nkt; ++kt) {
            if (kt + 1 < nkt) { DMA_K(KCg, 64, 64 * (kt + 1), sl_next); DMA_V(VCg, 64, 64 * (kt + 1), sl_next); ATT_WAITBAR(2); } else { ATT_WAITBAR(0); }
            const bool far = (tminw - 31 - 16 * (64 * kt + 63)) >= 128;
            if (far) { qkt(p0, p1, shm + L_K + sl_cur, qr, b31, r32, hi); }
            else { qkt(p0, p1, shm + L_K + sl_cur, qr, 0.f, r32, hi); near_apply<16, 0x80000000u>(p0, p1, t - 31 - 16 * (64 * kt + 4 * hi), luth); }
#pragma unroll
            for (int r = 0; r < 16; ++r) { p0[r] = __builtin_amdgcn_exp2f(p0[r] - m) * rl; p1[r] = __builtin_amdgcn_exp2f(p1[r] - m) * rl; }
            {
                float q4[8], e[8];
#pragma unroll
                for (int i = 0; i < 4; ++i) { q4[i] = (p0[4 * i] + p0[4 * i + 1]) + (p0[4 * i + 2] + p0[4 * i + 3]); e[i] = p0[4 * i + 3];
                                              q4[4 + i] = (p1[4 * i] + p1[4 * i + 1]) + (p1[4 * i + 2] + p1[4 * i + 3]); e[4 + i] = p1[4 * i + 3]; }
                float newcarry = 0.f;
#pragma unroll
                for (int i = 0; i < 8; ++i) { auto rr = __builtin_amdgcn_permlane32_swap(__float_as_uint(e[i]), __float_as_uint(e[i]), false, false);
                    const float elo = __uint_as_float(rr[0]), ehi = __uint_as_float(rr[1]);
                    if (hi) q4[i] += elo; else if (i < 7) q4[i + 1] += ehi;
                    if (i == 7) newcarry = ehi; }
                if (!hi) q4[0] += carry;
                carry = newcarry;
#pragma unroll
                for (int i = 0; i < 8; ++i) { float v = q4[i]; v += dpp_f<0xB1>(v); v += dpp_f<0x4E>(v); q4[i] = v; }
                if (h == 0) {
#pragma unroll
                    for (int i = 0; i < 8; ++i) SC[(8 * wid + ql) * 256 + 16 * kt + 2 * i + hi] = q4[i]; }
            }
            { ATT_PACK(p0, p1); pv(o, vb0 + sl_cur, pa0, pa1, pa2, pa3); }
            ROT();
        }
        LDS_WAIT(); __builtin_amdgcn_s_barrier();
    }

    if (cur >= 16) {
#pragma unroll 1
        for (int qb = 0; qb < 8; qb += 4) {
            int v[4][4];
#pragma unroll
            for (int u = 0; u < 4; ++u) { const LAS float* row = SC + (8 * wid + qb + u) * 256;
#pragma unroll
                for (int i = 0; i < 4; ++i) { const int J = lane + 64 * i; const int x = (__float_as_int(row[J]) & ~255) | (255 - J); v[u][i] = (J >= 1 && J <= cur - 2) ? x : -1; } }
#pragma unroll 1
            for (int round = 0; round < 13; ++round) {
                int wm[4];
#pragma unroll
                for (int u = 0; u < 4; ++u) wm[u] = wave_max_i32(max(max(v[u][0], v[u][1]), max(v[u][2], v[u][3])));
#pragma unroll
                for (int u = 0; u < 4; ++u) {
#pragma unroll
                    for (int i = 0; i < 4; ++i) v[u][i] = (v[u][i] == wm[u]) ? -1 : v[u][i];
                    const int J = 255 - (wm[u] & 255); const int qloc = 8 * wid + qb + u;
                    if (lane == 0) __hip_atomic_fetch_or(BM + 2 * J + (qloc >> 5), 1u << (qloc & 31), __ATOMIC_RELAXED, __HIP_MEMORY_SCOPE_WORKGROUP);
                }
            }
        }
    }
    LDS_WAIT();
    LAS float* ostg = (LAS float*)(shm + L_SC) + wid * 2048;
    {
        if (hi == 0) wsf[r32] = gate_c; LDS_WAIT();
#pragma unroll
        for (int r = 0; r < 16; ++r) { const float f = wsf[crow(r, hi)]; const int orow = crow(r, hi); ostg[orow * 64 + r32] = o[0][r] * f; ostg[orow * 64 + 32 + r32] = o[1][r] * f; }
    }

    const bf16* Kw = F.KV() + 512 + g * 64; const bf16* Vw = F.KV() + 640 + g * 64;
    {
        m = -1e30f; l = 0.f; ATT_FILL(o[0], 0.f); ATT_FILL(o[1], 0.f);
        const int J0 = max(cur - 8, 0);
        int sl_cur = 0, sl_next = SLOTB;
        DMA_K(Kw, 768, 64 * J0, 0); DMA_V(Vw, 768, 64 * J0, 0);
        for (int J = J0; J <= cur; ++J) {
            if (J + 1 <= cur) { DMA_K(Kw, 768, 64 * (J + 1), sl_next); DMA_V(Vw, 768, 64 * (J + 1), sl_next); ATT_WAITBAR(2); } else { ATT_WAITBAR(0); }
            if (J >= cur - 2 || J == cur - 8) { qkt(p0, p1, shm + L_K + sl_cur, qr, 0.f, r32, hi); near_apply<1, 512u>(p0, p1, t - 64 * J - 4 * hi, luth); }
            else { qkt(p0, p1, shm + L_K + sl_cur, qr, b31, r32, hi); }
            sm_update<true>(p0, p1, m, l, o, wsf, r32, hi);
            { ATT_PACK(p0, p1); pv(o, vb0 + sl_cur, pa0, pa1, pa2, pa3); }
            ROT();
        }
        LDS_WAIT(); __builtin_amdgcn_s_barrier();
        const float lt = halfsum(l); const float fw = lt > 0.f ? gate_w / lt : 0.f;
        if (hi == 0) wsf[r32] = fw; LDS_WAIT();
#pragma unroll
        for (int r = 0; r < 16; ++r) { const float f = wsf[crow(r, hi)]; const int orow = crow(r, hi); ostg[orow * 64 + r32] += o[0][r] * f; ostg[orow * 64 + 32 + r32] += o[1][r] * f; }
        LDS_WAIT();
#pragma unroll
        for (int i = 0; i < 4; ++i) { const int rowl = i * 8 + (lane >> 3), chn = lane & 7;
            const f32x4 a0 = *(const LAS f32x4*)(ostg + rowl * 64 + chn * 8), a1 = *(const LAS f32x4*)(ostg + rowl * 64 + chn * 8 + 4);
            const size_t tt = (size_t)(64 * qt + 8 * wid + (rowl >> 2)); const int col = (4 * g + (rowl & 3)) * 64 + chn * 8;
            *(u32x4*)(F.XN() + tt * 1024 + col) = (u32x4){cvtpk(a0[0], a0[1]), cvtpk(a0[2], a0[3]), cvtpk(a1[0], a1[1]), cvtpk(a1[2], a1[3])}; }
        LDS_WAIT();
    }

    const bf16* Ks = F.KV() + 256 + g * 64; const bf16* Vs = F.KV() + 384 + g * 64;
    {
        m = -1e30f; l = 0.f; ATT_FILL(o[0], 0.f); ATT_FILL(o[1], 0.f);
        const int nA = (cur < 16) ? cur + 1 : 3;
#define JA(i) ((cur < 16) ? (i) : ((i) == 0 ? 0 : cur - 2 + (i)))
        int sl_cur = 0, sl_next = SLOTB;
        DMA_K(Ks, 768, 0, 0); DMA_V(Vs, 768, 0, 0);
        for (int i = 0; i < nA; ++i) {
            const int J = JA(i);
            if (i + 1 < nA) { const int Jn = JA(i + 1); DMA_K(Ks, 768, 64 * Jn, sl_next); DMA_V(Vs, 768, 64 * Jn, sl_next); ATT_WAITBAR(2); } else { ATT_WAITBAR(0); }
            if (J >= cur - 2) { qkt(p0, p1, shm + L_K + sl_cur, qr, 0.f, r32, hi); near_apply<1, 0x80000000u>(p0, p1, t - 64 * J - 4 * hi, luth); }
            else { qkt(p0, p1, shm + L_K + sl_cur, qr, b31, r32, hi); }
            sm_update<true>(p0, p1, m, l, o, wsf, r32, hi);
            { ATT_PACK(p0, p1); pv(o, vb0 + sl_cur, pa0, pa1, pa2, pa3); }
            ROT();
        }
#undef JA
        LDS_WAIT(); __builtin_amdgcn_s_barrier();
        const float lt = halfsum(l);
        if (hi == 0) { REF[32 * wid + r32] = m; LACC[32 * wid + r32] = lt; }
#pragma unroll
        for (int r = 0; r < 16; ++r) { const int orow = 32 * wid + crow(r, hi); OACC[orow * 64 + r32] = o[0][r]; OACC[orow * 64 + 32 + r32] = o[1][r]; }
        LDS_WAIT(); __builtin_amdgcn_s_barrier();
    }

    if (cur >= 16) {
        const int c16 = lane & 15, gq = lane >> 4, qi4 = c16 >> 2;
        const bf16* KTg = F.KT() + (size_t)g * 256 * 4096 + gq * 512 + c16 * 8; const bf16* VTg = F.VT() + (size_t)g * 256 * 4096 + c16 * 32 + 8 * gq;
        const LAS bf16* QLg = QL + (gq >> 1) * 64 + h * 16 + 8 * (gq & 1);
        LAS unsigned* TL = (LAS unsigned*)(shm + L_TL) + wid * 160;
        int ntask = 0;
#pragma unroll 1
        for (int i4 = 0; i4 < 4; ++i4) {
            const int Jl = lane + 64 * i4; int nch = 0;
            unsigned long long mk = 0ull;
            if (Jl >= 1 && Jl <= cur - 2 && (Jl & 7) == wid) { mk = ((unsigned long long)BM[2 * Jl + 1] << 32) | BM[2 * Jl]; nch = (__popcll(mk) + 3) >> 2; }
            int incl = nch;
#pragma unroll
            for (int o = 1; o < 64; o <<= 1) { const int up = __shfl_up(incl, o); if (lane >= o) incl += up; }
            const int base = ntask + incl - nch;
            for (int c = 0; c < nch; ++c) { unsigned e = (unsigned)Jl; int q0 = 0;
#pragma unroll
                for (int k = 0; k < 4; ++k) { int q = q0; if (mk) { q = __builtin_ctzll(mk); mk &= mk - 1; } if (k == 0) q0 = q; e |= (unsigned)q << (8 + 6 * k); }
                if (base + c < 160) TL[base + c] = e; }
            ntask += __shfl(incl, 63);
        }
        ntask = min(ntask, 160);
        LAS bf16* EX = (LAS bf16*)(shm + L_EX); LAS int* HDR = (LAS int*)(shm + L_HDR); LAS float* LEX = (LAS float*)(shm + L_LEX); LAS int* NT = (LAS int*)(shm + L_NT);
        if (lane == 0) NT[wid] = ntask;
        LDS_WAIT(); __builtin_amdgcn_s_barrier();
        int nround = 0;
#pragma unroll
        for (int k = 0; k < 8; ++k) nround = max(nround, __builtin_amdgcn_readfirstlane(NT[k]));
        bf16x8 kfC[8], vfC[8];
#define LOADK(J_, KF) do { const bf16* kp_ = KTg + (size_t)(J_) * 4096; \
            _Pragma("unroll") for (int kt = 0; kt < 4; ++kt) { KF[2 * kt] = *(const bf16x8*)(kp_ + kt * 128); KF[2 * kt + 1] = *(const bf16x8*)(kp_ + 2048 + kt * 128); } } while (0)
#define LOADV(J_, VF) do { const bf16* vp_ = VTg + (size_t)(J_) * 4096; _Pragma("unroll") for (int x = 0; x < 8; ++x) VF[x] = *(const bf16x8*)(vp_ + x * 512); } while (0)
        unsigned e_cur = 0xffu;
        if (ntask > 0) { e_cur = (unsigned)__builtin_amdgcn_readfirstlane((int)TL[0]); LOADK(e_cur & 255u, kfC); LOADV(e_cur & 255u, vfC); }
        float oa[2][16], la2[2];
#pragma unroll
        for (int p = 0; p < 2; ++p) { la2[p] = 0.f;
#pragma unroll
            for (int k = 0; k < 16; ++k) oa[p][k] = 0.f; }
#pragma unroll 1
        for (int n = 0; n < nround; ++n) {
            const int buf = n & 1;
            if (n < ntask) {
                const unsigned e_nxt = (n + 1 < ntask) ? (unsigned)__builtin_amdgcn_readfirstlane((int)TL[n + 1]) : 0xffu;
                const unsigned e_ = e_cur; const int Jb = e_ & 255, Jn = e_nxt & 255; const bool reload = (Jn != Jb) && (Jn != 255);
                const int q0_ = (e_ >> 8) & 63;
                const int myq = (e_ >> (8 + 6 * qi4)) & 63; const bool valid = (qi4 == 0) || (myq != q0_); const int tq = 64 * qt + myq;
                const LAS bf16* qp_ = QLg + myq * 256; const bf16x8 qg0 = *(const LAS bf16x8*)(qp_), qg1 = *(const LAS bf16x8*)(qp_ + 128);
                const float ref = REF[4 * myq + h];
                const bool nearJ = (Jb >= cur - 2);
                const float cinit = nearJ ? 0.f : (valid ? b31 - ref : -INFINITY);
                f32x4 s[4];
#pragma unroll
                for (int kt = 0; kt < 4; ++kt) { s[kt] = (f32x4){cinit, cinit, cinit, cinit};
                    s[kt] = __builtin_amdgcn_mfma_f32_16x16x32_bf16(kfC[2 * kt], qg0, s[kt], 0, 0, 0); s[kt] = __builtin_amdgcn_mfma_f32_16x16x32_bf16(kfC[2 * kt + 1], qg1, s[kt], 0, 0, 0); }
                if (reload) LOADK(Jn, kfC);
                if (nearJ) { const float sub = valid ? ref : INFINITY;
                    float bb[16];
#pragma unroll
                    for (int kt = 0; kt < 4; ++kt)
#pragma unroll
                        for (int r = 0; r < 4; ++r) { const int dd = tq - 64 * Jb - (16 * kt + 4 * gq + r); bb[kt * 4 + r] = luth[min(max(dd, 0), 127)]; }
#pragma unroll
                    for (int x = 0; x < 16; ++x) asm volatile("" : "+v"(bb[x]));
#pragma unroll
                    for (int kt = 0; kt < 4; ++kt)
#pragma unroll
                        for (int r = 0; r < 4; ++r) { const int dd = tq - 64 * Jb - (16 * kt + 4 * gq + r); const float tt = s[kt][r] + bb[kt * 4 + r] - sub;
                            s[kt][r] = (dd >= 0) ? tt : -INFINITY; } }
#pragma unroll
                for (int kt = 0; kt < 4; ++kt)
#pragma unroll
                    for (int r = 0; r < 4; ++r) s[kt][r] = __builtin_amdgcn_exp2f(fminf(s[kt][r], CLAMP));
                float ls = (((s[0][0] + s[0][1]) + (s[0][2] + s[0][3])) + ((s[1][0] + s[1][1]) + (s[1][2] + s[1][3]))) + (((s[2][0] + s[2][1]) + (s[2][2] + s[2][3])) + ((s[3][0] + s[3][1]) + (s[3][2] + s[3][3])));
                { auto r16 = __builtin_amdgcn_permlane16_swap(__float_as_uint(ls), __float_as_uint(ls), false, false); ls = __uint_as_float(r16[0]) + __uint_as_float(r16[1]); }
                ls = halfsum(ls);
                bf16x8 pb[2];
#pragma unroll
                for (int ks = 0; ks < 2; ++ks) pb[ks] = __builtin_bit_cast(bf16x8, (u32x4){cvtpk(s[2 * ks][0], s[2 * ks][1]), cvtpk(s[2 * ks][2], s[2 * ks][3]), cvtpk(s[2 * ks + 1][0], s[2 * ks + 1][1]), cvtpk(s[2 * ks + 1][2], s[2 * ks + 1][3])});
                LAS bf16* ex = EX + buf * 8192 + ((wid * 4 + qi4) * 4 + h) * 64 + 4 * gq;
                f32x4 ot[4];
#pragma unroll
                for (int mt = 0; mt < 4; ++mt) { ot[mt] = (f32x4){0.f, 0.f, 0.f, 0.f};
                    ot[mt] = __builtin_amdgcn_mfma_f32_16x16x32_bf16(vfC[2 * mt], pb[0], ot[mt], 0, 0, 0); ot[mt] = __builtin_amdgcn_mfma_f32_16x16x32_bf16(vfC[2 * mt + 1], pb[1], ot[mt], 0, 0, 0); }
                if (reload) LOADV(Jn, vfC);
#pragma unroll
                for (int mt = 0; mt < 4; ++mt) *(LAS u32x2*)(ex + 16 * mt) = (u32x2){cvtpk(ot[mt][0], ot[mt][1]), cvtpk(ot[mt][2], ot[mt][3])};
                if (gq == 0) { LEX[buf * 128 + wid * 16 + c16] = ls; if (h == 0) HDR[buf * 32 + wid * 4 + qi4] = valid ? myq : -1; }
                e_cur = e_nxt;
            } else if (lane < 4) HDR[buf * 32 + wid * 4 + lane] = -1;
            LDS_WAIT(); __builtin_amdgcn_s_barrier();
            {
                const int hv = (lane < 32) ? HDR[buf * 32 + lane] : -1;
                const int li = lane & 15, hsel = li >> 2, dq = (li & 3) * 16;
#pragma unroll
                for (int pass = 0; pass < 2; ++pass) {
                    const unsigned m0 = (unsigned)__ballot(hv == 8 * wid + 4 * pass + 0), m1 = (unsigned)__ballot(hv == 8 * wid + 4 * pass + 1), m2 = (unsigned)__ballot(hv == 8 * wid + 4 * pass + 2), m3 = (unsigned)__ballot(hv == 8 * wid + 4 * pass + 3);
                    if ((m0 | m1 | m2 | m3) == 0u) continue;
                    unsigned mm = gq == 0 ? m0 : gq == 1 ? m1 : gq == 2 ? m2 : m3;
                    while (mm) { const int e = __builtin_ctz(mm); mm &= mm - 1;
                        const u32x4 x0 = *(const LAS u32x4*)(EX + buf * 8192 + e * 256 + hsel * 64 + dq), x1 = *(const LAS u32x4*)(EX + buf * 8192 + e * 256 + hsel * 64 + dq + 8);
                        oa[pass][0] += bflo(x0.x); oa[pass][1] += bfhi(x0.x); oa[pass][2] += bflo(x0.y); oa[pass][3] += bfhi(x0.y); oa[pass][4] += bflo(x0.z); oa[pass][5] += bfhi(x0.z); oa[pass][6] += bflo(x0.w); oa[pass][7] += bfhi(x0.w);
                        oa[pass][8] += bflo(x1.x); oa[pass][9] += bfhi(x1.x); oa[pass][10] += bflo(x1.y); oa[pass][11] += bfhi(x1.y); oa[pass][12] += bflo(x1.z); oa[pass][13] += bfhi(x1.z); oa[pass][14] += bflo(x1.w); oa[pass][15] += bfhi(x1.w);
                        la2[pass] += LEX[buf * 128 + e * 4 + hsel]; }
                }
            }
        }
        {
            const int li = lane & 15, hsel = li >> 2, dq = (li & 3) * 16;
#pragma unroll
            for (int pass = 0; pass < 2; ++pass) { const int q = 8 * wid + 4 * pass + gq; LAS f32x4* ap = (LAS f32x4*)(OACC + (4 * q + hsel) * 64 + dq);
#pragma unroll
                for (int k = 0; k < 4; ++k) { f32x4 a = ap[k]; a[0] += oa[pass][4 * k]; a[1] += oa[pass][4 * k + 1]; a[2] += oa[pass][4 * k + 2]; a[3] += oa[pass][4 * k + 3]; ap[k] = a; }
                if ((li & 3) == 0) LACC[4 * q + hsel] += la2[pass]; }
        }
#undef LOADK
#undef LOADV
    }
    LDS_WAIT(); __builtin_amdgcn_s_barrier();

    {
        if (hi == 0) { const float lt = LACC[32 * wid + r32]; wsf[r32] = lt > 0.f ? gate_s / lt : 0.f; }
        LDS_WAIT();
#pragma unroll
        for (int i = 0; i < 4; ++i) { const int rowl = i * 8 + (lane >> 3), chn = lane & 7, row = 32 * wid + rowl;
            const float f = wsf[rowl];
            const f32x4 a0 = *(const LAS f32x4*)(OACC + row * 64 + chn * 8), a1 = *(const LAS f32x4*)(OACC + row * 64 + chn * 8 + 4);
            const size_t tt = (size_t)(64 * qt + 8 * wid + (rowl >> 2)); const int col = (4 * g + (rowl & 3)) * 64 + chn * 8;
            const u32x4 ov = *(const u32x4*)(F.XN() + tt * 1024 + col);
            const u32x4 gn = *(const u32x4*)(F.GN() + tt * 512 + col);
            u32x4 w; w.x = pk2((bflo(ov.x) + a0[0] * f) * bflo(gn.x), (bfhi(ov.x) + a0[1] * f) * bfhi(gn.x)); w.y = pk2((bflo(ov.y) + a0[2] * f) * bflo(gn.y), (bfhi(ov.y) + a0[3] * f) * bfhi(gn.y));
            w.z = pk2((bflo(ov.z) + a1[0] * f) * bflo(gn.z), (bfhi(ov.z) + a1[1] * f) * bfhi(gn.z)); w.w = pk2((bflo(ov.w) + a1[2] * f) * bflo(gn.w), (bfhi(ov.w) + a1[3] * f) * bfhi(gn.w));
            *(u32x4*)(F.XN() + tt * 1024 + col) = w; }
        VM_WAIT(); LDS_WAIT(); __syncthreads();
    }
#undef DMA_K
#undef DMA_V
#undef ROT
}
}

__global__ void __launch_bounds__(NWAVES * 64, 2) nsa_lru_fwd(Args args) {
    extern __shared__ __attribute__((aligned(16))) unsigned char lds[];
    Frame F;
    F.lds = (LAS unsigned char*)lds;
    F.MISC = (volatile LAS unsigned*)(F.lds + MISC_OFF);
    F.wave = __builtin_amdgcn_readfirstlane((int)(threadIdx.x >> 6));
    F.G = gridDim.x; { const int bx = blockIdx.x; F.vcu = (F.G % 8 == 0) ? (bx % 8) * (F.G / 8) + bx / 8 : bx; }
    F.ws = args.ws;
    gu32* ctl = (gu32*)(args.ws + WS_CTL);
    for (int u = F.wave * 64 + lane_id(); u < (LDS_BYTES - LDSCTL_OFF) / 4; u += NWAVES * 64) ((LAS unsigned*)(F.lds + LDSCTL_OFF))[u] = 0u;
    __syncthreads();
    const int bli = (N_LAUNCHES == PER_PHASE) ? 0 : args.li;
    XcdBarrier bar; bar.bar = (unsigned*)(ctl + CW_BAR) + bli * XCD_BAR_WORDS; bar.x = 0; bar.st = nullptr;
    if (N_LAUNCHES != PER_PHASE) bar = xcd_barrier_post((unsigned*)(ctl + CW_BAR) + bli * XCD_BAR_WORDS, F.MISC + 8);
#define GRID_BAR() do { if (N_LAUNCHES != PER_PHASE) xcd_barrier(bar); } while (0)
    const int lo = args.ph_lo, hi = args.ph_hi;
#define IN(k) (lo <= (k) && (k) < hi)
#define BOTH(k) (IN(k) && IN((k) + 1))

    if (IN(0)) { p0_prologue(F, args); if (BOTH(0)) GRID_BAR(); }

    if (IN(1)) {
        pg8::Gemm g{F.XN(), F.WinT(), F.XN(), F.WinT(), 1024, 1024, 1024}; pg8::StaticOrder S; S.init(SEQ, NPROJ, F.G, (int)blockIdx.x);
        pg8::EpiProj E{F.Q(), F.KV(), F.U(), F.BR(), F.GN(), F.GL(), F.MG()};
        pg8::gemm_phase<pg8::EpiProj, pg8::StaticOrder, true>(F.lds, g, S, E, F.wave);
        if (BOTH(1)) GRID_BAR();
    }

    if (IN(2)) {
        for (int i = F.vcu; i < 256; i += F.G) {
            lru_tile<false>(F, args, i);
            if (!args.pad) qk_norm_tile(F, args, i);
            vt_tile(F, i);
            __syncthreads();
            compress_item(F, args, i & 1, (i >> 1) & 1, i >> 2);
        }
        if (BOTH(2)) GRID_BAR();
    }

    if (IN(3)) {
        for (int i = F.vcu; i < 256; i += F.G) { lru_tile<true>(F, args, i); }
        __syncthreads();
#pragma unroll 1
        for (int it = 2 * F.vcu; it < 512; it += 2 * F.G) {
#pragma unroll 1
            for (int j = 0; j < 2; ++j) { const int i = it >> 1; att::attn_item(F, j ? i : 255 - i, j ? 0 : 1); }
        }
        if (BOTH(3)) GRID_BAR();
    }

    if (IN(4)) {
        pg8::Gemm g{F.XN(), F.WaT(), F.XN() + 512, F.WbT(), 1024, 512, 512}; pg8::DualOrder S; S.init(SEQ, 1024, F.G, (int)blockIdx.x);
        pg8::EpiMerge E{F.MB(), F.MG()};
        pg8::gemm_phase<pg8::EpiMerge, pg8::DualOrder, true>(F.lds, g, S, E, F.wave);
        if (BOTH(4)) GRID_BAR();
    }

    if (IN(5)) {
        pg8::Gemm g{F.MB(), F.WoutT(), F.MB(), F.WoutT(), 1024, 1024, 1024}; pg8::StaticOrder S; S.init(SEQ, 1024, F.G, (int)blockIdx.x);
        pg8::EpiOut E{args.in[0], args.out};
        pg8::gemm_phase<pg8::EpiOut, pg8::StaticOrder, true>(F.lds, g, S, E, F.wave);
    }
#undef IN
#undef BOTH
}

extern "C" void kernel_launch(void* const* d_in, const int* in_sizes, int n_in, void* d_out, int out_size, void* d_ws, size_t ws_size, hipStream_t stream) {
    static int grid = 0;
    if (grid == 0) {
        if (n_in != 20 || in_sizes[0] != SEQ * DM || out_size != SEQ * DM || ws_size < WS_END) { fprintf(stderr, "kernel_launch: unexpected shapes (n_in %d, in0 %d, out %d, ws %zu)\n", n_in, n_in > 0 ? in_sizes[0] : -1, out_size, ws_size); grid = -1; return; }
        int dev = 0, cus = 0, per_cu = 0;
        if (hipGetDevice(&dev) != hipSuccess || hipDeviceGetAttribute(&cus, hipDeviceAttributeMultiprocessorCount, dev) != hipSuccess) { grid = -1; return; }
        if (hipFuncSetAttribute((const void*)nsa_lru_fwd, hipFuncAttributeMaxDynamicSharedMemorySize, LDS_BYTES) != hipSuccess) { fprintf(stderr, "kernel_launch: hipFuncSetAttribute failed\n"); grid = -1; return; }
        if (hipOccupancyMaxActiveBlocksPerMultiprocessor(&per_cu, (const void*)nsa_lru_fwd, NWAVES * 64, LDS_BYTES) != hipSuccess || per_cu < 1)
            fprintf(stderr, "kernel_launch: occupancy query reports %d workgroups per CU\n", per_cu);
        (void)hipGetLastError();
        grid = cus;
    }
    if (grid < 0) return;
    if (hipMemsetAsync((char*)d_ws + WS_CTL, 0, CTL_ZERO_BYTES, stream) != hipSuccess) { fprintf(stderr, "kernel_launch: hipMemsetAsync failed\n"); return; }
    Args a{};
    for (int i = 0; i < 20; ++i) a.in[i] = (const float*)d_in[i];
    a.out = (float*)d_out; a.ws = (unsigned char*)d_ws;
    const int nl = (PROBE_DUP >= 0) ? 2 : N_LAUNCHES;
    for (int li = 0; li < nl; ++li) {
        if (PROBE_DUP >= 0) { a.ph_lo = li ? PROBE_DUP : 0; a.ph_hi = li ? PER_PHASE : PROBE_DUP + 1; a.li = li; a.pad = (li && PROBE_DUP == 2) ? 1 : 0; }
        else { a.ph_lo = (N_LAUNCHES == PER_PHASE) ? li : 0; a.ph_hi = (N_LAUNCHES == PER_PHASE) ? li + 1 : PER_PHASE; a.li = li; }
        hipLaunchKernelGGL(nsa_lru_fwd, dim3(grid), dim3(NWAVES * 64), LDS_BYTES, stream, a);
        const hipError_t le = hipPeekAtLastError();
        if (le != hipSuccess) { fprintf(stderr, "kernel_launch: launch %d failed: %s\n", li, hipGetErrorName(le)); break; }
    }
}
```

```cpp
#include <hip/hip_runtime.h>
#include <cstdio>
#include <cstdint>

#ifndef PROBE_DUP
#define PROBE_DUP -1
#endif
#ifndef MK_N_LAUNCHES
#define MK_N_LAUNCHES 1
#endif

#define GAS __attribute__((address_space(1)))
#define LAS __attribute__((address_space(3)))
typedef unsigned short bf16;
typedef short bf16x8 __attribute__((ext_vector_type(8)));
typedef short s16x4 __attribute__((ext_vector_type(4)));
typedef float f32x4 __attribute__((ext_vector_type(4)));
typedef float f32x16 __attribute__((ext_vector_type(16)));
typedef unsigned u32x4 __attribute__((ext_vector_type(4)));
typedef unsigned u32x2 __attribute__((ext_vector_type(2)));
typedef GAS unsigned gu32;

constexpr int SEQ = 16384, DM = 1024;
constexpr int NPROJ = 5120;
constexpr float LOG2E = 1.4426950408889634f;
constexpr float RMS_EPS = 1e-6f;

__device__ __forceinline__ unsigned f2bf(float f) { unsigned u = __builtin_bit_cast(unsigned, f); return (u + 0x7fffu + ((u >> 16) & 1u)) >> 16; }
__device__ __forceinline__ unsigned pk2(float lo, float hi) { return f2bf(lo) | (f2bf(hi) << 16); }
__device__ __forceinline__ float bf2f(unsigned h) { return __builtin_bit_cast(float, h << 16); }
__device__ __forceinline__ float bflo(unsigned w) { return __builtin_bit_cast(float, w << 16); }
__device__ __forceinline__ float bfhi(unsigned w) { return __builtin_bit_cast(float, w & 0xffff0000u); }
typedef float f32x2_t __attribute__((ext_vector_type(2))); typedef __bf16 bf16x2_t __attribute__((ext_vector_type(2)));
__device__ __forceinline__ unsigned cvtpk(float lo, float hi) { f32x2_t v = {lo, hi}; bf16x2_t b = __builtin_convertvector(v, bf16x2_t); return __builtin_bit_cast(unsigned, b); }
__device__ __forceinline__ float fsigmoid(float v) { return __builtin_amdgcn_rcpf(1.0f + __builtin_amdgcn_exp2f(-v * LOG2E)); }
template <int CTRL> __device__ __forceinline__ float dpp_f(float v) { return __builtin_bit_cast(float, __builtin_amdgcn_update_dpp(0, __builtin_bit_cast(int, v), CTRL, 0xf, 0xf, true)); }
template <int CTRL> __device__ __forceinline__ int dpp_i(int v) { return __builtin_amdgcn_update_dpp(v, v, CTRL, 0xf, 0xf, false); }
__device__ __forceinline__ int lane_id() { int l = (int)__builtin_amdgcn_mbcnt_hi(~0u, __builtin_amdgcn_mbcnt_lo(~0u, 0u)); asm volatile("" : "+v"(l)); return l; }
__device__ __forceinline__ float wave_sum(float v) {
#pragma unroll
    for (int o = 1; o < 64; o <<= 1) v += __shfl_xor(v, o);
    return v;
}

namespace pg8 {
#define PG8_LAS __attribute__((address_space(3)))
typedef unsigned short bf16_t;
constexpr int BM = 256, BK = 64, HALF = 128, HTB = HALF * BK * 2, STAGE_BYTES = 8 * HTB, NXCD = 8, WGM = 8;
__host__ __device__ __forceinline__ int lds_byte(int r, int c) { const int st = (r >> 4) * 2 + (c >> 5), rr = r & 15, cc = c & 31, ob = rr * 64 + cc * 2; return st * 1024 + (ob ^ (((ob >> 9) & 1) << 5)); }
__host__ __device__ __forceinline__ void stage_rc(int b, int& R, int& C) { const int st = b / 1024, sb = b % 1024, swz = sb ^ (((sb >> 9) & 1) << 5); R = (st >> 1) * 16 + swz / 64; C = (st & 1) * 32 + (swz % 64) / 2; }
__host__ __device__ __forceinline__ int perm32(int rho) { const int n = rho >> 4, i = rho & 15; return 8 * (i >> 2) + 4 * n + (i & 3); }

struct Unit { int pm, pn, part; };
struct Gemm { const bf16_t* A; const bf16_t* Bt; const bf16_t* A2; const bf16_t* Bt2; int lda, ldb, K; };

struct StaticOrder {
    int nM, nN, nwg, G, c;
    __host__ __device__ void init(int M, int N, int G_, int c_) { nM = M / BM; nN = N / BM; nwg = nM * nN; G = G_; c = c_; }
    __host__ __device__ bool tile(long L, Unit& u) const {
        if (L >= nwg) return false;
        int wgid = (int)L; { const int q = nwg / NXCD, r = nwg % NXCD, xcd = wgid % NXCD, off = wgid / NXCD; wgid = (xcd < r ? xcd * (q + 1) : r * (q + 1) + (xcd - r) * q) + off; }
        const int nig = WGM * nN, gid = wgid / nig, fm = gid * WGM, gsz = (nM - fm) < WGM ? (nM - fm) : WGM;
        u.pm = fm + ((wgid % nig) % gsz); u.pn = (wgid % nig) / gsz; u.part = 0; return true;
    }
    __host__ __device__ bool next(int i, Unit& u) const { return tile((long)i * G + c, u); }
};
struct DualOrder : StaticOrder {
    __host__ __device__ bool next(int i, Unit& u) const { if (!tile((long)(i >> 1) * G + c, u)) return false; u.part = i & 1; return true; }
};

__device__ __forceinline__ unsigned cvt_pk_bf16(float lo, float hi) { unsigned r; asm volatile("v_cvt_pk_bf16_f32 %0, %1, %2" : "=v"(r) : "v"(lo), "v"(hi)); return r; }

struct EpiProj {
    static constexpr bool PERM = true, INIT = false;
    bf16_t *Q, *KV, *U, *BR, *GN, *GL, *MG;
    __device__ __forceinline__ void operator()(const f32x4 (&acc)[2][2][4][2], const Unit& u, int wr, int wc, int fr, int fq) const {
        const int pn = u.pn; bf16_t* base; int ldc, colt, act = 0;
        if (pn < 2) { base = Q; ldc = 512; colt = pn * 256; }
        else if (pn < 5) { base = KV; ldc = 768; colt = (pn - 2) * 256; }
        else if (pn < 7) { base = U; ldc = 512; colt = (pn - 5) * 256; }
        else if (pn < 8) { base = BR; ldc = 256; colt = 0; }
        else if (pn < 10) { base = GN; ldc = 512; colt = (pn - 8) * 256; act = 1; }
        else if (pn < 12) { base = GL; ldc = 512; colt = (pn - 10) * 256; act = 1; }
        else { base = MG; ldc = 2048; colt = (pn - 12) * 256; act = 2; }
        const int row0 = u.pm * BM + wr * 64 + fr, col0 = colt + wc * 32 + 8 * fq;
#pragma unroll
        for (int ai = 0; ai < 2; ++ai)
#pragma unroll
            for (int m = 0; m < 4; ++m) { bf16_t* rowp = base + (size_t)(row0 + ai * HALF + m * 16) * ldc + col0;
#pragma unroll
                for (int bj = 0; bj < 2; ++bj) { f32x4 v0 = acc[ai][bj][m][0], v1 = acc[ai][bj][m][1];
                    if (act) {
#pragma unroll
                        for (int e = 0; e < 4; ++e) { const float s0 = fsigmoid(v0[e]), s1 = fsigmoid(v1[e]); v0[e] = (act == 1) ? v0[e] * s0 : s0; v1[e] = (act == 1) ? v1[e] * s1 : s1; } }
                    u32x4 w; w.x = cvt_pk_bf16(v0[0], v0[1]); w.y = cvt_pk_bf16(v0[2], v0[3]); w.z = cvt_pk_bf16(v1[0], v1[1]); w.w = cvt_pk_bf16(v1[2], v1[3]);
                    *(u32x4*)(rowp + bj * HALF) = w; } }
    }
};
struct EpiMerge {
    static constexpr bool PERM = true, INIT = false;
    bf16_t* Mb; const bf16_t* MG;
    __device__ __forceinline__ void operator()(const f32x4 (&acc)[2][2][4][2], const Unit& u, int wr, int wc, int fr, int fq) const {
        const int row0 = u.pm * BM + wr * 64 + fr, col0 = u.pn * BM + wc * 32 + 8 * fq;
#pragma unroll
        for (int ai = 0; ai < 2; ++ai)
#pragma unroll
            for (int m = 0; m < 4; ++m) { const size_t r = (size_t)(row0 + ai * HALF + m * 16);
#pragma unroll
                for (int bj = 0; bj < 2; ++bj) { const f32x4 v0 = acc[ai][bj][m][0], v1 = acc[ai][bj][m][1];
                    const u32x4 gw = *(const u32x4*)(MG + r * 2048 + u.part * 1024 + col0 + bj * HALF);
                    float o[8] = {v0[0] * bflo(gw.x), v0[1] * bfhi(gw.x), v0[2] * bflo(gw.y), v0[3] * bfhi(gw.y), v1[0] * bflo(gw.z), v1[1] * bfhi(gw.z), v1[2] * bflo(gw.w), v1[3] * bfhi(gw.w)};
                    bf16_t* dst = Mb + r * 1024 + col0 + bj * HALF;
                    if (u.part) { const u32x4 pw = *(const u32x4*)dst;
                        o[0] += bflo(pw.x); o[1] += bfhi(pw.x); o[2] += bflo(pw.y); o[3] += bfhi(pw.y); o[4] += bflo(pw.z); o[5] += bfhi(pw.z); o[6] += bflo(pw.w); o[7] += bfhi(pw.w); }
                    u32x4 w; w.x = cvt_pk_bf16(o[0], o[1]); w.y = cvt_pk_bf16(o[2], o[3]); w.z = cvt_pk_bf16(o[4], o[5]); w.w = cvt_pk_bf16(o[6], o[7]);
                    *(u32x4*)dst = w; } }
    }
};
struct EpiOut {
    static constexpr bool PERM = false, INIT = true;
    const float* X; float* O;
    __device__ __forceinline__ void init(f32x4 (&acc)[2][2][4][2], const Unit& u, int wr, int wc, int fr, int fq) const {
        const int row0 = u.pm * BM + wr * 64 + fr, col0 = u.pn * BM + wc * 32 + 4 * fq;
#pragma unroll
        for (int ai = 0; ai < 2; ++ai)
#pragma unroll
            for (int m = 0; m < 4; ++m) { const size_t off = (size_t)(row0 + ai * HALF + m * 16) * 1024 + col0;
#pragma unroll
                for (int bj = 0; bj < 2; ++bj)
#pragma unroll
                    for (int n = 0; n < 2; ++n) acc[ai][bj][m][n] = *(const f32x4*)(X + off + bj * HALF + n * 16); }
    }
    __device__ __forceinline__ void operator()(const f32x4 (&acc)[2][2][4][2], const Unit& u, int wr, int wc, int fr, int fq) const {
        const int row0 = u.pm * BM + wr * 64 + fr, col0 = u.pn * BM + wc * 32 + 4 * fq;
#pragma unroll
        for (int ai = 0; ai < 2; ++ai)
#pragma unroll
            for (int m = 0; m < 4; ++m) { const size_t off = (size_t)(row0 + ai * HALF + m * 16) * 1024 + col0;
#pragma unroll
                for (int bj = 0; bj < 2; ++bj)
#pragma unroll
                    for (int n = 0; n < 2; ++n) *(f32x4*)(O + off + bj * HALF + n * 16) = acc[ai][bj][m][n]; }
    }
};

template <class Epi, class Sched, bool ALIGN_EPI>
__device__ __forceinline__ void gemm_phase(PG8_LAS unsigned char* lds, const Gemm g, const Sched& S, const Epi& E, int wid) {
    const int lane = lane_id(), tid = wid * 64 + lane, wr = wid >> 2, wc = wid & 3, fr = lane & 15, fq = lane >> 4;
    const int K = g.K, nt = K / BK;
    unsigned voffA[2], voffB[2];
#pragma unroll
    for (int i = 0; i < 2; ++i) { int R, C; stage_rc(tid * 16 + i * 8192, R, C); const int Rb = Epi::PERM ? ((R & ~31) + perm32(R & 31)) : R;
        voffA[i] = (unsigned)(R * g.lda + C) * 2u; voffB[i] = (unsigned)(Rb * g.ldb + C) * 2u; }
    const size_t kstep = (size_t)(BK * 2);
    const size_t hstepA = (size_t)HALF * g.lda * 2, hstepB = (size_t)HALF * g.ldb * 2;
    const size_t tstepA = 2 * hstepA, tstepB = 2 * hstepB;
    const unsigned ldsw = (unsigned)wid * 1024u;
    const int aoff = lds_byte(wr * 64 + fr, fq * 8), boff = lds_byte(wc * 32 + fr, fq * 8);
#define PG8_SA(b, h) (((b) * 2 + (h)) * HTB)
#define PG8_SB(b, h) ((4 + (b) * 2 + (h)) * HTB)
#define PG8_STAGE(bufoff, gbase, voff) do { _Pragma("unroll") for (int _i = 0; _i < 2; ++_i) \
        __builtin_amdgcn_global_load_lds((const unsigned*)((const char*)(gbase) + (voff)[_i]), (PG8_LAS unsigned*)(lds + (bufoff) + ldsw + _i * 8192), 16, 0, 0); } while (0)
#define PG8_LDA(dst, b, h) do { _Pragma("unroll") for (int m = 0; m < 4; ++m) _Pragma("unroll") for (int k = 0; k < 2; ++k) dst[m][k] = *(const PG8_LAS bf16x8*)(lds + PG8_SA(b, h) + aoff + m * 2048 + k * 1024); } while (0)
#define PG8_LDB(dst, b, h) do { _Pragma("unroll") for (int n = 0; n < 2; ++n) _Pragma("unroll") for (int k = 0; k < 2; ++k) dst[n][k] = *(const PG8_LAS bf16x8*)(lds + PG8_SB(b, h) + boff + n * 2048 + k * 1024); } while (0)
#define PG8_MMA(ai, bj, At, Bt) do { __builtin_amdgcn_s_setprio(1); _Pragma("unroll") for (int m = 0; m < 4; ++m) _Pragma("unroll") for (int n = 0; n < 2; ++n) _Pragma("unroll") for (int k = 0; k < 2; ++k) \
        acc[ai][bj][m][n] = __builtin_amdgcn_mfma_f32_16x16x32_bf16(Bt[n][k], At[m][k], acc[ai][bj][m][n], 0, 0, 0); __builtin_amdgcn_s_setprio(0); } while (0)
#define PG8_WAIT_V(n) asm volatile("s_waitcnt vmcnt(" #n ")" ::: "memory")
#define PG8_WAIT_L(n) asm volatile("s_waitcnt lgkmcnt(" #n ")" ::: "memory")
#define PG8_BAR __builtin_amdgcn_s_barrier()
#define PG8_SCHED __builtin_amdgcn_sched_barrier(0)
#define PG8_UA(u) ((const char*)((u).part ? g.A2 : g.A) + (size_t)(u).pm * tstepA)
#define PG8_UB(u) ((const char*)((u).part ? g.Bt2 : g.Bt) + (size_t)(u).pn * tstepB)
    Unit cur, nxt; int ui = 0;
    if (!S.next(0, cur)) return;
    f32x4 acc[2][2][4][2];
    if constexpr (Epi::INIT) E.init(acc, cur, wr, wc, fr, fq);
    else {
#pragma unroll
    for (int a = 0; a < 2; ++a)
#pragma unroll
        for (int b = 0; b < 2; ++b)
#pragma unroll
            for (int m = 0; m < 4; ++m)
#pragma unroll
                for (int n = 0; n < 2; ++n) acc[a][b][m][n] = (f32x4){0.f, 0.f, 0.f, 0.f};
    }
    bf16x8 At[4][2], B0[2][2], B1[2][2];
    const char* cA = PG8_UA(cur); const char* cB = PG8_UB(cur);
    PG8_STAGE(PG8_SB(0, 0), cB, voffB); PG8_STAGE(PG8_SB(0, 1), cB + hstepB, voffB); PG8_STAGE(PG8_SA(0, 0), cA, voffA); PG8_STAGE(PG8_SA(0, 1), cA + hstepA, voffA);
    if (wr == 1) PG8_BAR;
    PG8_WAIT_V(2); PG8_BAR;
    PG8_STAGE(PG8_SB(1, 0), cB + kstep, voffB); PG8_STAGE(PG8_SA(1, 0), cA + kstep, voffA); PG8_STAGE(PG8_SB(1, 1), cB + hstepB + kstep, voffB);
    PG8_WAIT_V(6); PG8_BAR;
    for (;;) {
        const bool has_next = S.next(ui + 1, nxt);
        const char* nA = has_next ? PG8_UA(nxt) : cA; const char* nB = has_next ? PG8_UB(nxt) : cB;
        for (int t = 0; t < nt; t += 2) {
            const bool last = (t == nt - 2);
            const char* a1 = cA + (size_t)(t + 1) * kstep;
            const char* a2 = last ? nA : cA + (size_t)(t + 2) * kstep; const char* b2 = last ? nB : cB + (size_t)(t + 2) * kstep;
            const char* a3 = a2 + kstep; const char* b3 = b2 + kstep;
            PG8_LDB(B0, 0, 0); PG8_LDB(B1, 0, 1); PG8_SCHED; PG8_LDA(At, 0, 0); PG8_STAGE(PG8_SA(1, 1), a1 + hstepA, voffA);
            PG8_WAIT_V(8); PG8_WAIT_L(0); PG8_BAR; PG8_MMA(0, 0, At, B0); PG8_MMA(0, 1, At, B1); PG8_BAR; PG8_SCHED;
            PG8_LDA(At, 0, 1); PG8_STAGE(PG8_SB(0, 0), b2, voffB); PG8_STAGE(PG8_SB(0, 1), b2 + hstepB, voffB); PG8_STAGE(PG8_SA(0, 0), a2, voffA);
            PG8_WAIT_V(8); PG8_WAIT_L(0); PG8_BAR; PG8_MMA(1, 0, At, B0); PG8_MMA(1, 1, At, B1); PG8_BAR; PG8_SCHED;
            PG8_LDB(B0, 1, 0); PG8_LDB(B1, 1, 1); PG8_SCHED; PG8_LDA(At, 1, 0); PG8_STAGE(PG8_SA(0, 1), a2 + hstepA, voffA);
            PG8_WAIT_V(8); PG8_WAIT_L(0); PG8_BAR; PG8_MMA(0, 0, At, B0); PG8_MMA(0, 1, At, B1); PG8_BAR; PG8_SCHED;
            PG8_LDA(At, 1, 1); PG8_STAGE(PG8_SB(1, 0), b3, voffB); PG8_STAGE(PG8_SB(1, 1), b3 + hstepB, voffB); PG8_STAGE(PG8_SA(1, 0), a3, voffA);
            PG8_WAIT_V(8); PG8_WAIT_L(0); PG8_BAR; PG8_MMA(1, 0, At, B0); PG8_MMA(1, 1, At, B1); PG8_BAR; PG8_SCHED;
        }
        if constexpr (ALIGN_EPI) { if (wr == 0) PG8_BAR; }
        E(acc, cur, wr, wc, fr, fq);
        if (!has_next) break;
        if constexpr (Epi::INIT) E.init(acc, nxt, wr, wc, fr, fq);
        else {
#pragma unroll
        for (int a = 0; a < 2; ++a)
#pragma unroll
            for (int b = 0; b < 2; ++b)
#pragma unroll
                for (int m = 0; m < 4; ++m)
#pragma unroll
                    for (int n = 0; n < 2; ++n) acc[a][b][m][n] = (f32x4){0.f, 0.f, 0.f, 0.f};
        }
        cur = nxt; cA = nA; cB = nB; ++ui;
        if constexpr (ALIGN_EPI) { if (wr == 1) PG8_BAR; }
    }
    PG8_WAIT_V(0);
    if constexpr (!ALIGN_EPI) { if (wr == 0) PG8_BAR; }
    PG8_BAR;
#undef PG8_SA
#undef PG8_SB
#undef PG8_STAGE
#undef PG8_LDA
#undef PG8_LDB
#undef PG8_MMA
#undef PG8_WAIT_V
#undef PG8_WAIT_L
#undef PG8_BAR
#undef PG8_SCHED
#undef PG8_UA
#undef PG8_UB
}
}

constexpr int NWAVES = 8;
constexpr int N_LAUNCHES = MK_N_LAUNCHES;
constexpr int PER_PHASE = 6;
constexpr size_t MiB = 1u << 20;
constexpr size_t WS_CTL = 0, CTL_ZERO_BYTES = 65536;
constexpr size_t WS_WIN = 1 * MiB;
constexpr size_t WS_WA = 11 * MiB;
constexpr size_t WS_WB = 12 * MiB;
constexpr size_t WS_WOUT = 13 * MiB;
constexpr size_t WS_W1T = 15 * MiB;
constexpr size_t WS_SMALL = 17 * MiB;
constexpr size_t WS_SUM = 18 * MiB;
constexpr size_t WS_KC = 19 * MiB;
constexpr size_t WS_XN = 20 * MiB;
constexpr size_t WS_Q = 52 * MiB;
constexpr size_t WS_KV = 68 * MiB;
constexpr size_t WS_MB = 52 * MiB;
constexpr size_t WS_U = 92 * MiB;
constexpr size_t WS_BR = 108 * MiB;
constexpr size_t WS_GN = 116 * MiB;
constexpr size_t WS_GL = 132 * MiB;
constexpr size_t WS_MG = 148 * MiB;
constexpr size_t WS_VT = 212 * MiB;
constexpr size_t WS_KT = 216 * MiB;
constexpr size_t WS_Q2 = 220 * MiB;
constexpr size_t WS_END = 236 * MiB;
constexpr size_t SM_W2T = 0;
constexpr size_t SM_LWA = 65536;
constexpr size_t SM_LWX = 131072;
constexpr size_t SM_C1 = 262144;
constexpr size_t SM_LUT = 200704;
constexpr int CW_BAR = 4096;

constexpr int RING_BYTES = 160768;
constexpr int LDSCTL_OFF = RING_BYTES, MISC_OFF = LDSCTL_OFF + 320;
constexpr int LDS_BYTES = 163840;

#define RLX_AGENT __ATOMIC_RELAXED, __HIP_MEMORY_SCOPE_AGENT
#define LDS_WAIT() asm volatile("s_waitcnt lgkmcnt(0)" ::: "memory")
#define VM_WAIT() asm volatile("s_waitcnt vmcnt(0)" ::: "memory")

#define XB_TMO      128
#define XB_XCNT(j)  (256  + 64 * (j))
#define XB_XSUB(j)  (1280 + 64 * (j))
#define XB_XGEN(j)  (2304 + 64 * (j))
#define XB_TOP      3328
#define XB_TOPGEN   3392
#define XCD_BAR_WORDS 3456
#define XB_SPIN_CAP (1u << 18)
__device__ __forceinline__ unsigned xb_ld(unsigned* p)              { return __hip_atomic_load(p, __ATOMIC_RELAXED, __HIP_MEMORY_SCOPE_AGENT); }
__device__ __forceinline__ unsigned xb_add(unsigned* p, unsigned v) { return __hip_atomic_fetch_add(p, v, __ATOMIC_RELAXED, __HIP_MEMORY_SCOPE_AGENT); }
__device__ __forceinline__ unsigned xb_xcc_id() { return (unsigned)__builtin_amdgcn_s_getreg((3 << 11) | 20) & 0xFu; }
#define XB_SPIN(cond, bar) do { unsigned _sp = 0; while (cond) { __builtin_amdgcn_s_sleep(1); \
    if ((++_sp & 255u) == 0u) { if (xb_ld(&(bar)[XB_TMO])) break; if (_sp > XB_SPIN_CAP) { atomicAdd(&(bar)[XB_TMO], 1u); break; } } } } while (0)
struct XcdBarrier { unsigned* bar; unsigned x; volatile LAS unsigned* st; };
__device__ __forceinline__ XcdBarrier xcd_barrier_post(unsigned* bar, volatile LAS unsigned* st) {
    XcdBarrier b; b.bar = bar; b.x = xb_xcc_id(); b.st = st;
    if (threadIdx.x == 0) (void)xb_add(&bar[XB_XCNT(b.x)], 1u);
    return b;
}
__device__ __forceinline__ void xcd_barrier_complete(unsigned* bar, unsigned x, unsigned& nloc, unsigned& nx) {
    const unsigned G = gridDim.x * gridDim.y * gridDim.z;
    unsigned sum, cnt, mine, sp = 0u;
    for (;;) {
        sum = 0u; cnt = 0u; mine = 0u;
#pragma unroll
        for (unsigned j = 0; j < 16; ++j) { const unsigned c = xb_ld(&bar[XB_XCNT(j)]); sum += c; cnt += (c > 0u) ? 1u : 0u; mine = (j == x) ? c : mine; }
        if (sum == G) break;
        __builtin_amdgcn_s_sleep(1);
        if ((++sp & 255u) == 0u) { if (xb_ld(&bar[XB_TMO])) break; if (sp > XB_SPIN_CAP) { atomicAdd(&bar[XB_TMO], 1u); break; } }
    }
    nloc = mine > 0u ? mine : 1u; nx = cnt > 0u ? cnt : 1u;
}
__device__ __forceinline__ void xcd_barrier(const XcdBarrier& b) {
    asm volatile("s_waitcnt vmcnt(0)" ::: "memory");
    __syncthreads();
    if (threadIdx.x == 0) {
        unsigned* bar = b.bar;
        __builtin_amdgcn_s_waitcnt(0);
        unsigned nloc = b.st[0], nx = b.st[1];
        if (nloc == 0u) { xcd_barrier_complete(bar, b.x, nloc, nx); b.st[0] = nloc; b.st[1] = nx; }
        const unsigned old = xb_add(&bar[XB_XSUB(b.x)], 1u);
        const unsigned gen = old / nloc;
        if (old + 1u == (gen + 1u) * nloc) {
            __builtin_amdgcn_fence(__ATOMIC_RELEASE, "agent");
            asm volatile("s_waitcnt vmcnt(0)" ::: "memory");
            const unsigned og = xb_add(&bar[XB_TOP], 1u);
            const unsigned tg = og / nx;
            if (og + 1u == (tg + 1u) * nx) xb_add(&bar[XB_TOPGEN], 1u);
            else XB_SPIN(xb_ld(&bar[XB_TOPGEN]) == tg, bar);
            __builtin_amdgcn_fence(__ATOMIC_ACQUIRE, "agent");
            xb_add(&bar[XB_XGEN(b.x)], 1u);
            asm volatile("s_waitcnt vmcnt(0)" ::: "memory");
        } else {
            XB_SPIN(xb_ld(&bar[XB_XGEN(b.x)]) == gen, bar);
            __builtin_amdgcn_fence(__ATOMIC_ACQUIRE, "agent");
            asm volatile("s_waitcnt vmcnt(0)" ::: "memory");
        }
    }
    __syncthreads();
}

struct Args { const float* in[20]; float* out; unsigned char* ws; int ph_lo, ph_hi, li, pad; };
struct Frame {
    LAS unsigned char* lds;
    volatile LAS unsigned* MISC;
    int wave;
    int vcu, G;
    unsigned char* ws;
#define WSP(name, T, off) __device__ __forceinline__ T* name() const { return (T*)(ws + (off)); }
    WSP(WinT, bf16, WS_WIN) WSP(WaT, bf16, WS_WA) WSP(WbT, bf16, WS_WB) WSP(WoutT, bf16, WS_WOUT) WSP(W1T, bf16, WS_W1T)
    WSP(W2T, bf16, WS_SMALL + SM_W2T) WSP(LWA, bf16, WS_SMALL + SM_LWA) WSP(LWX, bf16, WS_SMALL + SM_LWX)
    WSP(C1, float, WS_SMALL + SM_C1) WSP(LUT, float, WS_SMALL + SM_LUT) WSP(SUMA, float, WS_SUM) WSP(SUMB, float, WS_SUM + 524288)
    WSP(KC, bf16, WS_KC) WSP(VC, bf16, WS_KC + 524288) WSP(XN, bf16, WS_XN) WSP(Q, bf16, WS_Q) WSP(KV, bf16, WS_KV) WSP(MB, bf16, WS_MB)
    WSP(VT, bf16, WS_VT) WSP(KT, bf16, WS_KT) WSP(Q2, bf16, WS_Q2) WSP(U, bf16, WS_U) WSP(BR, bf16, WS_BR) WSP(GN, bf16, WS_GN) WSP(GL, bf16, WS_GL) WSP(MG, bf16, WS_MG)
#undef WSP
};

__device__ __forceinline__ int t5_bucket(int n) {
    if (n < 16) return n;
    const int thr[15] = {19, 21, 24, 27, 31, 35, 40, 46, 52, 59, 67, 77, 87, 99, 113};
    int b = 16;
#pragma unroll
    for (int i = 0; i < 15; ++i) b += (n >= thr[i]) ? 1 : 0;
    return b;
}

__device__ __forceinline__ void p0_tr_item(const float* W, int ldw, int k0, int srccol0, int nvalid, bf16* WT, int ldt, int dstrow0, LAS float* scr, int lane) {
    const int c = lane & 31;
    float tv[32];
#pragma unroll
    for (int i = 0; i < 32; ++i) { const int kk = 2 * i + (lane >> 5); tv[i] = (c < nvalid) ? W[(size_t)(k0 + kk) * ldw + srccol0 + c] : 0.f; }
#pragma unroll
    for (int i = 0; i < 32; ++i) { const int kk = 2 * i + (lane >> 5); scr[kk * 33 + c] = tv[i]; }
    LDS_WAIT(); asm volatile("" ::: "memory");
    const int cc = lane & 7;
#pragma unroll
    for (int j = 0; j < 4; ++j) { const int n = (lane >> 3) + 8 * j; const LAS float* s = scr + (8 * cc) * 33 + n;
        u32x4 o; o.x = pk2(s[0 * 33], s[1 * 33]); o.y = pk2(s[2 * 33], s[3 * 33]); o.z = pk2(s[4 * 33], s[5 * 33]); o.w = pk2(s[6 * 33], s[7 * 33]);
        *(u32x4*)(WT + (size_t)(dstrow0 + n) * ldt + k0 + 8 * cc) = o; }
    LDS_WAIT(); asm volatile("" ::: "memory");
}
__device__ __forceinline__ void win_src(int n0, int& src, int& nvalid) {
    nvalid = 32;
    if (n0 < 1280) src = n0;
    else if (n0 < 1792) src = 1816 + (n0 - 1280);
    else if (n0 < 2048) { src = 1792 + (n0 - 1792); nvalid = (n0 == 1792) ? 24 : 0; if (n0 != 1792) src = 0; }
    else if (n0 < 2560) src = 1280 + (n0 - 2048);
    else if (n0 < 3072) src = 2328 + (n0 - 2560);
    else src = 2840 + (n0 - 3072);
}
__device__ __forceinline__ void p0_prologue(const Frame& F, const Args& A) {
    LAS float* scr = (LAS float*)(F.lds + F.wave * 16384);
    const int gw = F.vcu * NWAVES + F.wave, NGW = F.G * NWAVES, lane = lane_id();
    constexpr int I_WIN = 16 * 160, I_WA = 8 * 32, I_WO = 16 * 32, I_W1 = 32 * 8, I_W2 = 4 * 2, I_LR = 2;
    constexpr int NIT = I_WIN + 2 * I_WA + I_WO + 2 * I_W1 + 2 * I_W2 + 16 * I_LR + 256 + 1;
    for (int it = gw; it < NIT; it += NGW) {
        int r = it;
        if (r < I_WIN) { const int kb = r / 160, nb = r % 160; int src, nv; win_src(32 * nb, src, nv); p0_tr_item(A.in[2], 4888, 64 * kb, src, nv, F.WinT(), 1024, 32 * nb, scr, lane); continue; } r -= I_WIN;
        if (r < I_WA) { p0_tr_item(A.in[17], 1024, 64 * (r / 32), 32 * (r % 32), 32, F.WaT(), 512, 32 * (r % 32), scr, lane); continue; } r -= I_WA;
        if (r < I_WA) { p0_tr_item(A.in[18], 1024, 64 * (r / 32), 32 * (r % 32), 32, F.WbT(), 512, 32 * (r % 32), scr, lane); continue; } r -= I_WA;
        if (r < I_WO) { p0_tr_item(A.in[19], 1024, 64 * (r / 32), 32 * (r % 32), 32, F.WoutT(), 1024, 32 * (r % 32), scr, lane); continue; } r -= I_WO;
        if (r < 2 * I_W1) { const int kv = r / I_W1, q = r % I_W1; p0_tr_item(A.in[6] + (size_t)kv * 2048 * 256, 256, 64 * (q / 8), 32 * (q % 8), 32, F.W1T() + (size_t)kv * 256 * 2048, 2048, 32 * (q % 8), scr, lane); continue; } r -= 2 * I_W1;
        if (r < 2 * I_W2) { const int kv = r / I_W2, q = r % I_W2; p0_tr_item(A.in[8] + (size_t)kv * 256 * 64, 64, 64 * (q / 2), 32 * (q % 2), 32, F.W2T() + (size_t)kv * 64 * 256, 256, 32 * (q % 2), scr, lane); continue; } r -= 2 * I_W2;
        if (r < 16 * I_LR) { const int mtx = r / 2, nb = r % 2; const float* src = (mtx < 8 ? A.in[12] : A.in[14]) + (size_t)(mtx & 7) * 4096; bf16* dst = (mtx < 8 ? F.LWA() : F.LWX()) + (size_t)(mtx & 7) * 4096;
            p0_tr_item(src, 64, 0, 32 * nb, 32, dst, 64, 32 * nb, scr, lane); continue; } r -= 16 * I_LR;
        if (r < 256) {
            const int kc = r >> 3, kv = (r >> 2) & 1, n = (r & 3) * 64 + lane; const float* w1 = A.in[6] + (size_t)kv * 2048 * 256 + (size_t)(64 * kc) * 256 + n; const float* pe = A.in[5] + kv * 2048 + 64 * kc;
            float s0 = 0.f, s1 = 0.f, s2 = 0.f, s3 = 0.f;
#pragma unroll 4
            for (int k = 0; k < 64; k += 4) { s0 += pe[k] * w1[(size_t)k * 256]; s1 += pe[k + 1] * w1[(size_t)(k + 1) * 256]; s2 += pe[k + 2] * w1[(size_t)(k + 2) * 256]; s3 += pe[k + 3] * w1[(size_t)(k + 3) * 256]; }
            F.C1()[(kc * 2 + kv) * 256 + n] = (s0 + s1) + (s2 + s3); continue; } r -= 256;
        {
            for (int e = lane; e < 1024; e += 64) { const int hd = e >> 7, n = e & 127; F.LUT()[e] = A.in[9][t5_bucket(n) * 8 + hd] * LOG2E; }
        }
    }
    const float* gain = A.in[1];
    {
        f32x4 v[4], vn[4];
        if (gw < SEQ) { const f32x4* xr = (const f32x4*)(A.in[0] + (size_t)gw * DM) + lane;
#pragma unroll
            for (int j = 0; j < 4; ++j) v[j] = xr[64 * j]; }
        for (int m = gw; m < SEQ; m += NGW) {
            if (m + NGW < SEQ) { const f32x4* xr = (const f32x4*)(A.in[0] + (size_t)(m + NGW) * DM) + lane;
#pragma unroll
                for (int j = 0; j < 4; ++j) vn[j] = xr[64 * j]; }
            float s = 0.f;
#pragma unroll
            for (int j = 0; j < 4; ++j) s += (v[j].x * v[j].x + v[j].y * v[j].y) + (v[j].z * v[j].z + v[j].w * v[j].w);
            const float rs = 1.0f / sqrtf(wave_sum(s) * (1.f / DM) + RMS_EPS);
            unsigned long long* o8 = (unsigned long long*)(F.XN() + (size_t)m * DM) + lane;
#pragma unroll
            for (int j = 0; j < 4; ++j) { const f32x4 gv = ((const f32x4*)gain)[lane + 64 * j];
                o8[64 * j] = (unsigned long long)pk2(v[j].x * rs * gv.x, v[j].y * rs * gv.y) | ((unsigned long long)pk2(v[j].z * rs * gv.z, v[j].w * rs * gv.w) << 32); }
#pragma unroll
            for (int j = 0; j < 4; ++j) v[j] = vn[j];
        }
    }
}

template <bool FINAL>
__device__ __forceinline__ void lru_tile(const Frame& F, const Args& A, int tt) {
    const int lane = lane_id();
    const int w = F.wave, fr = lane & 15, fq = lane >> 4, ch0 = 64 * w, t0 = 64 * tt;
    LAS float* UC = (LAS float*)(F.lds + w * 16384);
#define UC_IDX(tok, ch) ((tok) * 64 + ((((ch) >> 2) ^ ((tok) & 15)) << 2) + ((ch) & 3))
    float Hc = 0.f;
    if (FINAL) {
        const float* sa = F.SUMA() + ch0 + lane; const float* sb = F.SUMB() + ch0 + lane;
        int i = 0;
        for (; i + 16 <= tt; i += 16) { float ta[16], tb[16];
#pragma unroll
            for (int k = 0; k < 16; ++k) { ta[k] = sa[(size_t)(i + k) * 512]; tb[k] = sb[(size_t)(i + k) * 512]; }
#pragma unroll
            for (int k = 0; k < 16; ++k) Hc = ta[k] * Hc + tb[k]; }
        for (; i < tt; ++i) Hc = sa[(size_t)i * 512] * Hc + sb[(size_t)i * 512];
        asm volatile("" : "+v"(Hc));
    }
    {
        const int ch = ch0 + lane; const float* cw = A.in[10]; const float cb = A.in[11][ch];
        const float w0 = cw[ch], w1 = cw[512 + ch], w2 = cw[1024 + ch], w3 = cw[1536 + ch];
        const bf16* up = F.U() + (size_t)t0 * 512 + ch;
        float u0 = 0.f, u1 = 0.f, u2 = 0.f;
        if (tt > 0) { u0 = bf2f(up[-3 * 512]); u1 = bf2f(up[-2 * 512]); u2 = bf2f(up[-1 * 512]); }
        unsigned short ur[64];
#pragma unroll
        for (int tok = 0; tok < 64; ++tok) ur[tok] = up[(size_t)tok * 512];
#pragma unroll
        for (int tok = 0; tok < 64; ++tok) { const float u3 = bf2f(ur[tok]);
            UC[UC_IDX(tok, lane)] = cb + ((u0 * w0 + u1 * w1) + (u2 * w2 + u3 * w3)); u0 = u1; u1 = u2; u2 = u3; }
    }
    bf16x8 Ba[4][2], Bx[4][2];
#pragma unroll
    for (int nt = 0; nt < 4; ++nt)
#pragma unroll
        for (int ks = 0; ks < 2; ++ks) { const size_t o = (size_t)w * 4096 + (16 * nt + fr) * 64 + 32 * ks + 8 * fq; Ba[nt][ks] = *(const bf16x8*)(F.LWA() + o); Bx[nt][ks] = *(const bf16x8*)(F.LWX() + o); }
    float ba[4], bx[4], sp8[4], hin[4], acum[4];
#pragma unroll
    for (int nt = 0; nt < 4; ++nt) { const int ch = ch0 + 16 * nt + fr; ba[nt] = A.in[13][ch]; bx[nt] = A.in[15][ch];
        sp8[nt] = 8.0f * log1pf(expf(-A.in[16][ch])); hin[nt] = 0.f; acum[nt] = 1.f; }
    if (FINAL) {
#pragma unroll
        for (int nt = 0; nt < 4; ++nt) hin[nt] = __shfl(Hc, 16 * nt + fr);
    }
    LDS_WAIT();
    unsigned short glv[16], gln[16];
    if (FINAL) {
#pragma unroll
        for (int nt = 0; nt < 4; ++nt)
#pragma unroll
            for (int rg = 0; rg < 4; ++rg) glv[nt * 4 + rg] = F.GL()[(size_t)(t0 + 4 * fq + rg) * 512 + ch0 + 16 * nt + fr];
    }
#pragma unroll 1
    for (int mt = 0; mt < 4; ++mt) {
        if (FINAL && mt < 3) {
#pragma unroll
            for (int nt = 0; nt < 4; ++nt)
#pragma unroll
                for (int rg = 0; rg < 4; ++rg) gln[nt * 4 + rg] = F.GL()[(size_t)(t0 + 16 * (mt + 1) + 4 * fq + rg) * 512 + ch0 + 16 * nt + fr];
        }
        bf16x8 Af[2];
#pragma unroll
        for (int ks = 0; ks < 2; ++ks) { const int tok = 16 * mt + fr, c0 = 8 * ks + 2 * fq;
            const f32x4 x0 = *(const LAS f32x4*)(UC + tok * 64 + ((c0 ^ (tok & 15)) << 2)), x1 = *(const LAS f32x4*)(UC + tok * 64 + (((c0 + 1) ^ (tok & 15)) << 2));
            u32x4 pw; pw.x = cvtpk(x0[0], x0[1]); pw.y = cvtpk(x0[2], x0[3]); pw.z = cvtpk(x1[0], x1[1]); pw.w = cvtpk(x1[2], x1[3]); Af[ks] = __builtin_bit_cast(bf16x8, pw); }
        f32x4 cr[4], ci[4];
#pragma unroll
        for (int nt = 0; nt < 4; ++nt) { cr[nt] = (f32x4){0.f, 0.f, 0.f, 0.f}; ci[nt] = (f32x4){0.f, 0.f, 0.f, 0.f};
#pragma unroll
            for (int ks = 0; ks < 2; ++ks) { cr[nt] = __builtin_amdgcn_mfma_f32_16x16x32_bf16(Af[ks], Ba[nt][ks], cr[nt], 0, 0, 0); ci[nt] = __builtin_amdgcn_mfma_f32_16x16x32_bf16(Af[ks], Bx[nt][ks], ci[nt], 0, 0, 0); } }
#pragma unroll
        for (int nt = 0; nt < 4; ++nt) {
            float P[4], Hh[4];
#pragma unroll
            for (int rg = 0; rg < 4; ++rg) { const int tok = 16 * mt + 4 * fq + rg, e = 16 * nt + fr;
                const float ucv = UC[UC_IDX(tok, e)];
                const float r = fsigmoid(cr[nt][rg] + ba[nt]), ig = fsigmoid(ci[nt][rg] + bx[nt]);
                const float la = -r * sp8[nt]; const float a = __builtin_amdgcn_exp2f(la * LOG2E);
                const float x2 = 2.0f * la;
                const float ser = -x2 * (1.0f + x2 * (0.5f + x2 * (0.16666667f + x2 * (0.041666668f + x2 * 0.008333334f))));
                const float om = (x2 > -0.25f) ? ser : 1.0f - a * a;
                const float b = __builtin_amdgcn_sqrtf(om) * (ig * ucv);
                if (rg == 0) { P[0] = a; Hh[0] = b; } else { P[rg] = P[rg - 1] * a; Hh[rg] = a * Hh[rg - 1] + b; } }
            float At = P[3], Bt = Hh[3];
            { const float Ap = __shfl_up(At, 16), Bp = __shfl_up(Bt, 16); if (fq >= 1) { Bt = At * Bp + Bt; At = Ap * At; } }
            { const float Ap = __shfl_up(At, 32), Bp = __shfl_up(Bt, 32); if (fq >= 2) { Bt = At * Bp + Bt; At = Ap * At; } }
            float Aex = __shfl_up(At, 16), Bex = __shfl_up(Bt, 16); if (fq == 0) { Aex = 1.f; Bex = 0.f; }
            const float hg = Aex * hin[nt] + Bex;
            float hv[4];
#pragma unroll
            for (int rg = 0; rg < 4; ++rg) hv[rg] = P[rg] * hg + Hh[rg];
            hin[nt] = __shfl(hv[3], 48 + fr);
            if (!FINAL) acum[nt] *= __shfl(At, 48 + fr);
            if (FINAL) {
#pragma unroll
                for (int rg = 0; rg < 4; ++rg) { const size_t t = (size_t)(t0 + 16 * mt + 4 * fq + rg); const int ch = ch0 + 16 * nt + fr;
                    F.XN()[t * 1024 + 512 + ch] = (bf16)f2bf(hv[rg] * bf2f(glv[nt * 4 + rg])); }
            }
        }
        if (FINAL) {
#pragma unroll
            for (int x = 0; x < 16; ++x) glv[x] = gln[x];
        }
    }
    if (!FINAL && fq == 0) {
#pragma unroll
        for (int nt = 0; nt < 4; ++nt) { F.SUMA()[(size_t)tt * 512 + ch0 + 16 * nt + fr] = acum[nt]; F.SUMB()[(size_t)tt * 512 + ch0 + 16 * nt + fr] = hin[nt]; }
    }
    LDS_WAIT();
#undef UC_IDX
}

__device__ __forceinline__ void qk_norm_tile(const Frame& F, const Args& A, int tt) {
    const int lane = lane_id(), sub = lane & 7;
#pragma unroll 4
    for (int it = 0; it < 12; ++it) {
        const int idx = it * 64 + F.wave * 8 + (lane >> 3), tok = idx / 12, hr = idx % 12; const size_t t = (size_t)(64 * tt + tok);
        bf16* p; bf16* dst; const float* gain; float sc = 1.f;
        if (hr < 8) { p = F.Q() + t * 512 + hr * 64; dst = F.Q2() + t * 512 + (hr >> 2) * 256 + (sub >> 1) * 64 + (hr & 3) * 16 + (sub & 1) * 8 - sub * 8; gain = A.in[3]; sc = 0.125f * LOG2E; }
        else if (hr < 10) { p = F.KV() + t * 768 + 256 + (hr - 8) * 64; dst = p; gain = A.in[4] + 64; }
        else { p = F.KV() + t * 768 + 512 + (hr - 10) * 64; dst = p; gain = A.in[4] + 128; }
        const u32x4 w = *(const u32x4*)(p + sub * 8);
        float x[8] = {bflo(w.x), bfhi(w.x), bflo(w.y), bfhi(w.y), bflo(w.z), bfhi(w.z), bflo(w.w), bfhi(w.w)};
        float ss = 0.f;
#pragma unroll
        for (int j = 0; j < 8; ++j) ss += x[j] * x[j];
        ss += __shfl_xor(ss, 1); ss += __shfl_xor(ss, 2); ss += __shfl_xor(ss, 4);
        const float rs = sc / sqrtf(ss * (1.f / 64.f) + RMS_EPS);
        const f32x4 g0 = *(const f32x4*)(gain + sub * 8), g1 = *(const f32x4*)(gain + sub * 8 + 4);
        u32x4 o; o.x = pk2(x[0] * rs * g0.x, x[1] * rs * g0.y); o.y = pk2(x[2] * rs * g0.z, x[3] * rs * g0.w); o.z = pk2(x[4] * rs * g1.x, x[5] * rs * g1.y); o.w = pk2(x[6] * rs * g1.z, x[7] * rs * g1.w);
        *(u32x4*)(dst + sub * 8) = o;
        if (hr >= 8 && hr < 10) *(u32x4*)(F.KT() + ((size_t)((hr - 8) * 256 + tt) * 8 + sub) * 512 + tok * 8) = o;
    }
}

__device__ __forceinline__ void vt_tile(const Frame& F, int J) {
    const int tid = F.wave * 64 + lane_id(), d = tid & 63, ks = (tid >> 6) & 1, gp = tid >> 7;
#pragma unroll
    for (int g = 0; g < 2; ++g) {
        const bf16* vp = F.KV() + (size_t)(64 * J) * 768 + 384 + 64 * g + d;
        unsigned short e[8];
#pragma unroll
        for (int j = 0; j < 8; ++j) { const int key = 32 * ks + 4 * gp + (j & 3) + 16 * (j >> 2); e[j] = vp[(size_t)key * 768]; }
        u32x4 w; w.x = e[0] | ((unsigned)e[1] << 16); w.y = e[2] | ((unsigned)e[3] << 16); w.z = e[4] | ((unsigned)e[5] << 16); w.w = e[6] | ((unsigned)e[7] << 16);
        *(u32x4*)(F.VT() + (size_t)(g * 256 + J) * 4096 + ((((d >> 4) * 2 + ks) * 16 + (d & 15)) * 32) + 8 * gp) = w;
    }
}

__device__ __forceinline__ void compress_item(const Frame& F, const Args& A, int kv, int g, int ct) {
    const int lane = lane_id(), w = F.wave, tid = w * 64 + lane, fr = lane & 15, fq = lane >> 4, c0 = 16 * ct, tb = 16 * c0;
    LAS unsigned char* T = F.lds;
    LAS bf16* HID = (LAS bf16*)(F.lds + 34816);
    LAS float* OUTF = (LAS float*)(F.lds + 34816 + 8448);
    LAS float* C1L = (LAS float*)(F.lds + 34816 + 8448 + 4096);
    {
        u32x4 tv[5];
#pragma unroll
        for (int i = 0; i < 5; ++i) { const int idx = tid + 512 * i, tok = idx >> 3, chn = idx & 7, gt = tb + tok; tv[i] = (u32x4){0u, 0u, 0u, 0u};
            if (idx < 272 * 8 && gt < SEQ) tv[i] = *(const u32x4*)(F.KV() + (size_t)gt * 768 + kv * 128 + g * 64 + chn * 8); }
        { const int n = tid & 255, hf = tid >> 8; float pc[16];
#pragma unroll
            for (int k = 0; k < 16; ++k) pc[k] = F.C1()[((hf * 16 + k) * 2 + kv) * 256 + n];
            float s = hf ? 0.f : A.in[7][kv * 256 + n];
#pragma unroll
            for (int k = 0; k < 16; ++k) s += pc[k];
            C1L[hf * 256 + n] = s; }
#pragma unroll
        for (int i = 0; i < 5; ++i) { const int idx = tid + 512 * i, tok = idx >> 3, chn = idx & 7;
            if (idx < 272 * 8) *(LAS u32x4*)(T + tok * 128 + ((chn ^ ((tok >> 4) & 7)) << 4)) = tv[i]; }
    }
    LDS_WAIT(); __syncthreads();
    f32x4 acc[2] = {(f32x4){0.f, 0.f, 0.f, 0.f}, (f32x4){0.f, 0.f, 0.f, 0.f}};
    const bf16* w1t = F.W1T() + (size_t)kv * 256 * 2048 + (size_t)(32 * w + fr) * 2048 + 8 * fq;
#pragma unroll 32
    for (int ks = 0; ks < 64; ++ks) {
        const int tok = 16 * fr + (ks >> 1), chn = 4 * (ks & 1) + fq;
        const bf16x8 a = *(const LAS bf16x8*)(T + tok * 128 + ((chn ^ ((tok >> 4) & 7)) << 4));
        const bf16x8 b0 = *(const bf16x8*)(w1t + 32 * ks), b1 = *(const bf16x8*)(w1t + (size_t)16 * 2048 + 32 * ks);
        acc[0] = __builtin_amdgcn_mfma_f32_16x16x32_bf16(a, b0, acc[0], 0, 0, 0);
        acc[1] = __builtin_amdgcn_mfma_f32_16x16x32_bf16(a, b1, acc[1], 0, 0, 0);
    }
#pragma unroll
    for (int nt = 0; nt < 2; ++nt) { const int n = 32 * w + 16 * nt + fr; const float c1 = C1L[n] + C1L[256 + n];
#pragma unroll
        for (int rg = 0; rg < 4; ++rg) { const float v = acc[nt][rg] + c1; HID[(4 * fq + rg) * 264 + n] = (bf16)f2bf(v * fsigmoid(v)); } }
    LDS_WAIT(); __syncthreads();
    if (w < 4) {
        f32x4 o = (f32x4){0.f, 0.f, 0.f, 0.f};
        const bf16* w2t = F.W2T() + (size_t)kv * 64 * 256 + (size_t)(16 * w + fr) * 256 + 8 * fq;
#pragma unroll
        for (int ks = 0; ks < 8; ++ks) { const bf16x8 a = *(const LAS bf16x8*)(HID + fr * 264 + 32 * ks + 8 * fq); const bf16x8 b = *(const bf16x8*)(w2t + 32 * ks);
            o = __builtin_amdgcn_mfma_f32_16x16x32_bf16(a, b, o, 0, 0, 0); }
#pragma unroll
        for (int rg = 0; rg < 4; ++rg) OUTF[(4 * fq + rg) * 64 + 16 * w + fr] = o[rg];
    }
    LDS_WAIT(); __syncthreads();
    {
        const int row = tid >> 5, e = 2 * (tid & 31), c = c0 + row;
        float v0 = OUTF[row * 64 + e], v1 = OUTF[row * 64 + e + 1];
        if (kv == 0) { float ss = v0 * v0 + v1 * v1;
#pragma unroll
            for (int o = 1; o < 32; o <<= 1) ss += __shfl_xor(ss, o);
            const float rs = 1.0f / sqrtf(ss * (1.f / 64.f) + RMS_EPS); v0 *= rs * A.in[4][e]; v1 *= rs * A.in[4][e + 1]; }
        if (c >= 1023) { v0 = 0.f; v1 = 0.f; }
        bf16* dst = (kv == 0 ? F.KC() : F.VC()) + ((size_t)g * 1024 + c) * 64 + e;
        *(unsigned*)dst = pk2(v0, v1);
    }
    LDS_WAIT(); __syncthreads();
}

namespace att {
constexpr int SLOTB = 8192, NSLOT = 3;
constexpr int L_K = 0, L_V = NSLOT * SLOTB, L_SC = 2 * NSLOT * SLOTB, L_OUT = L_SC + 65536, L_LUT = L_OUT + 32768, L_WSF = L_LUT + 2048, L_BM = L_WSF + 2048, L_REF = L_BM + 2048, L_LACC = L_REF + 1024, L_TL = L_LACC + 1024  , L_END = L_TL + 5120;
static_assert(L_END <= RING_BYTES, "attention LDS map");
constexpr int L_EX = 0  , L_HDR = 34816  , L_LEX = 35072  , L_NT = 36096  ;
constexpr float CLAMP = 100.0f;
constexpr float THR = 8.0f;
#define SBAR() __builtin_amdgcn_sched_barrier(0)
__device__ __forceinline__ int crow(int r, int hi) { return (r & 3) + 8 * (r >> 2) + 4 * hi; }
__device__ __forceinline__ void glds16(const void* gsrc, unsigned lds_dst) { unsigned keep;
    asm volatile("s_mov_b32 %0, m0\n\ts_mov_b32 m0, %2\n\ts_nop 0\n\tglobal_load_lds_dwordx4 %1, off\n\ts_mov_b32 m0, %0" : "=&s"(keep) : "v"(gsrc), "s"(lds_dst) : "memory"); }
__device__ __forceinline__ void qkt(f32x16& p0, f32x16& p1, const LAS unsigned char* Kslot, const bf16x8* qr, int r32, int hi) {
    const LAS unsigned char* kb = Kslot + hi * 1024 + r32 * 16;
    const f32x16 z = {0.f, 0.f, 0.f, 0.f, 0.f, 0.f, 0.f, 0.f, 0.f, 0.f, 0.f, 0.f, 0.f, 0.f, 0.f, 0.f};
#pragma unroll
    for (int d0 = 0; d0 < 4; ++d0) {
        const bf16x8 b0 = *(const LAS bf16x8*)(kb + d0 * 2048);
        const bf16x8 b1 = *(const LAS bf16x8*)(kb + d0 * 2048 + 512);
        if (d0 == 0) { p0 = __builtin_amdgcn_mfma_f32_32x32x16_bf16(b0, qr[0], z, 0, 0, 0); p1 = __builtin_amdgcn_mfma_f32_32x32x16_bf16(b1, qr[0], z, 0, 0, 0); }
        else { p0 = __builtin_amdgcn_mfma_f32_32x32x16_bf16(b0, qr[d0], p0, 0, 0, 0); p1 = __builtin_amdgcn_mfma_f32_32x32x16_bf16(b1, qr[d0], p1, 0, 0, 0); } }
}
__device__ __forceinline__ void pv(f32x16* o, int vb, bf16x8 pa0, bf16x8 pa1, bf16x8 pa2, bf16x8 pa3) {
    s16x4 lo[8], hi[8];
#pragma unroll
    for (int x = 0; x < 8; ++x) {
        asm volatile("ds_read_b64_tr_b16 %0,%1 offset:%c2" : "=&v"(lo[x]) : "v"(vb), "i"((x >> 2) * 4096 + (x & 3) * 1024) : "memory");
        asm volatile("ds_read_b64_tr_b16 %0,%1 offset:%c2" : "=&v"(hi[x]) : "v"(vb), "i"((x >> 2) * 4096 + (x & 3) * 1024 + 512) : "memory"); }
    asm volatile("s_waitcnt lgkmcnt(0)" ::: "memory"); SBAR();
#define PK(k) (bf16x8){lo[k][0], lo[k][1], lo[k][2], lo[k][3], hi[k][0], hi[k][1], hi[k][2], hi[k][3]}
    o[0] = __builtin_amdgcn_mfma_f32_32x32x16_bf16(pa0, PK(0), o[0], 0, 0, 0); o[1] = __builtin_amdgcn_mfma_f32_32x32x16_bf16(pa0, PK(4), o[1], 0, 0, 0);
    o[0] = __builtin_amdgcn_mfma_f32_32x32x16_bf16(pa1, PK(1), o[0], 0, 0, 0); o[1] = __builtin_amdgcn_mfma_f32_32x32x16_bf16(pa1, PK(5), o[1], 0, 0, 0);
    o[0] = __builtin_amdgcn_mfma_f32_32x32x16_bf16(pa2, PK(2), o[0], 0, 0, 0); o[1] = __builtin_amdgcn_mfma_f32_32x32x16_bf16(pa2, PK(6), o[1], 0, 0, 0);
    o[0] = __builtin_amdgcn_mfma_f32_32x32x16_bf16(pa3, PK(3), o[0], 0, 0, 0); o[1] = __builtin_amdgcn_mfma_f32_32x32x16_bf16(pa3, PK(7), o[1], 0, 0, 0);
#undef PK
}
__device__ __forceinline__ float rowmax(const f32x16& p0, const f32x16& p1) {
    float a = fmaxf(fmaxf(p0[0], p0[1]), p1[0]), b = fmaxf(fmaxf(p0[2], p0[3]), p1[1]); a = fmaxf(fmaxf(a, p1[2]), p1[3]);
#pragma unroll
    for (int r = 4; r < 16; r += 4) { a = fmaxf(fmaxf(a, p0[r]), p0[r + 1]); b = fmaxf(fmaxf(b, p0[r + 2]), p0[r + 3]); a = fmaxf(fmaxf(a, p1[r]), p1[r + 1]); b = fmaxf(fmaxf(b, p1[r + 2]), p1[r + 3]); }
    const float m = fmaxf(a, b);
    auto rr = __builtin_amdgcn_permlane32_swap(__float_as_uint(m), __float_as_uint(m), false, false);
    return fmaxf(__uint_as_float(rr[0]), __uint_as_float(rr[1]));
}
__device__ __forceinline__ float halfsum(float v) { auto rr = __builtin_amdgcn_permlane32_swap(__float_as_uint(v), __float_as_uint(v), false, false); return __uint_as_float(rr[0]) + __uint_as_float(rr[1]); }
template <int STEP, unsigned LIMIT>
__device__ __forceinline__ void near_apply(f32x16& p0, f32x16& p1, int dbase, const LAS float* lut) {
    float b0[16], b1[16];
#pragma unroll
    for (int r = 0; r < 16; ++r) { const int koff = (r & 3) + 8 * (r >> 2); const int d0 = dbase - STEP * koff, d1 = d0 - STEP * 32;
        b0[r] = lut[min(max(d0, 0), 127)]; b1[r] = lut[min(max(d1, 0), 127)]; }
#pragma unroll
    for (int r = 0; r < 16; ++r) { asm volatile("" : "+v"(b0[r]), "+v"(b1[r])); }
#pragma unroll
    for (int r = 0; r < 16; ++r) { const int koff = (r & 3) + 8 * (r >> 2); const int d0 = dbase - STEP * koff, d1 = d0 - STEP * 32;
        const float t0 = p0[r] + b0[r], t1 = p1[r] + b1[r];
        p0[r] = ((unsigned)d0 < LIMIT) ? t0 : -INFINITY; p1[r] = ((unsigned)d1 < LIMIT) ? t1 : -INFINITY; }
}
template <bool HASO>
__device__ __forceinline__ void sm_update(f32x16& p0, f32x16& p1, float bias, float& m, float& l, f32x16* o, LAS float* wsf, int r32, int hi) {
    const float rm = rowmax(p0, p1) + bias;
    const bool need = rm > m + THR;
    if (__any(need)) {
        const float mn = need ? rm : m; const float alpha = __builtin_amdgcn_exp2f(m - mn);
        l *= alpha; m = mn;
        if (HASO) { if (hi == 0) wsf[r32] = alpha; LDS_WAIT();
#pragma unroll
            for (int r = 0; r < 16; ++r) { const float f = wsf[crow(r, hi)]; o[0][r] *= f; o[1][r] *= f; } }
    }
    const float mb = m - bias;
#pragma unroll
    for (int r = 0; r < 16; ++r) { p0[r] = __builtin_amdgcn_exp2f(p0[r] - mb); p1[r] = __builtin_amdgcn_exp2f(p1[r] - mb); }
    float t[8];
#pragma unroll
    for (int r = 0; r < 8; ++r) t[r] = (p0[2 * r] + p0[2 * r + 1]) + (p1[2 * r] + p1[2 * r + 1]);
    l += ((t[0] + t[1]) + (t[2] + t[3])) + ((t[4] + t[5]) + (t[6] + t[7]));
}
#define ATT_PACK(P0, P1) \
    const bf16x8 pa0 = __builtin_bit_cast(bf16x8, (u32x4){cvtpk(P0[0], P0[1]), cvtpk(P0[2], P0[3]), cvtpk(P0[4], P0[5]), cvtpk(P0[6], P0[7])}); \
    const bf16x8 pa1 = __builtin_bit_cast(bf16x8, (u32x4){cvtpk(P0[8], P0[9]), cvtpk(P0[10], P0[11]), cvtpk(P0[12], P0[13]), cvtpk(P0[14], P0[15])}); \
    const bf16x8 pa2 = __builtin_bit_cast(bf16x8, (u32x4){cvtpk(P1[0], P1[1]), cvtpk(P1[2], P1[3]), cvtpk(P1[4], P1[5]), cvtpk(P1[6], P1[7])}); \
    const bf16x8 pa3 = __builtin_bit_cast(bf16x8, (u32x4){cvtpk(P1[8], P1[9]), cvtpk(P1[10], P1[11]), cvtpk(P1[12], P1[13]), cvtpk(P1[14], P1[15])});
#define ATT_WAITBAR(N) asm volatile("s_waitcnt vmcnt(" #N ") lgkmcnt(0)\n\ts_barrier" ::: "memory")
#define ATT_FILL(V, x) do { _Pragma("unroll") for (int _r = 0; _r < 16; ++_r) V[_r] = (x); } while (0)

__device__ __forceinline__ unsigned rangemask(int k, int a, int b) {
    const int lo = max(a - 32 * k, 0), hi = min(b - 32 * k, 31);
    return (lo > hi) ? 0u : ((0xFFFFFFFFu >> (31 - hi)) & (0xFFFFFFFFu << lo));
}
__device__ __forceinline__ int wave_max_i32(int x) {
    x = max(x, dpp_i<0xB1>(x)); x = max(x, dpp_i<0x4E>(x)); x = max(x, dpp_i<0x141>(x)); x = max(x, dpp_i<0x140>(x));
    return max(max(__builtin_amdgcn_readlane(x, 0), __builtin_amdgcn_readlane(x, 16)), max(__builtin_amdgcn_readlane(x, 32), __builtin_amdgcn_readlane(x, 48)));
}

__device__ __forceinline__ void lds_add_f32(LAS float* p, float v) { (void)__hip_atomic_fetch_add(p, v, __ATOMIC_RELAXED, __HIP_MEMORY_SCOPE_WORKGROUP); }

__device__ __forceinline__ void attn_item(const Frame& F, int qt, int g) {
    const int lane = lane_id(), wid = F.wave, tid = wid * 64 + lane, r32 = lane & 31, hi = lane >> 5;
    const int ql = r32 >> 2, h = r32 & 3, cur = qt, t = 64 * qt + 8 * wid + ql, head = 4 * g + h;
    LAS unsigned char* shm = F.lds;
    const unsigned lds0 = (unsigned)(uintptr_t)shm;
    LAS float* wsf = (LAS float*)(shm + L_WSF) + wid * 64;
    LAS float* SC = (LAS float*)(shm + L_SC);
    LAS float* OACC = (LAS float*)(shm + L_SC);
    LAS float* lutl = (LAS float*)(shm + L_LUT);
    const LAS float* luth = lutl + h * 128;
    LAS unsigned* BM = (LAS unsigned*)(shm + L_BM);
    LAS float* REF = (LAS float*)(shm + L_REF);
    LAS float* LACC = (LAS float*)(shm + L_LACC);
    lutl[tid] = F.LUT()[(4 * g + (tid >> 7)) * 128 + (tid & 127)];
    BM[tid] = 0u;
    LAS bf16* QL = (LAS bf16*)(shm + L_OUT);
#pragma unroll
    for (int i = 0; i < 4; ++i) { const int chn = tid + 512 * i;
        *(LAS u32x4*)(QL + (chn >> 5) * 256 + (chn & 31) * 8) = *(const u32x4*)(F.Q2() + (size_t)(64 * qt + (chn >> 5)) * 512 + g * 256 + (chn & 31) * 8); }
    bf16x8 qr[4];
    { const bf16* qp = F.Q2() + (size_t)t * 512 + g * 256 + h * 16 + hi * 8;
#pragma unroll
        for (int d0 = 0; d0 < 4; ++d0) qr[d0] = *(const bf16x8*)(qp + d0 * 64); }
    const float b31 = F.LUT()[head * 128 + 127];
    const float gate_c = fsigmoid(bf2f(F.BR()[(size_t)t * 256 + head])), gate_s = fsigmoid(bf2f(F.BR()[(size_t)t * 256 + 8 + head])), gate_w = fsigmoid(bf2f(F.BR()[(size_t)t * 256 + 16 + head]));
    f32x16 o[2], p0, p1;
    const unsigned kdst = lds0 + L_K + wid * 1024, vdst = lds0 + L_V + wid * 1024;
    const int vrow = 16 * (wid & 3) + (lane >> 2), vcol = (wid >> 2) * 32 + (lane & 3) * 8;
    const int vb0 = (int)(lds0 + L_V) + ((lane >> 4) & 1) * 32 + (lane & 3) * 8 + (4 * hi + ((lane & 15) >> 2)) * 64;
#define DMA_K(base, pitch, row0, slot) glds16((base) + (size_t)((row0) + lane) * (pitch) + wid * 8, (unsigned)__builtin_amdgcn_readfirstlane(kdst + (slot)))
#define DMA_V(base, pitch, row0, slot) glds16((base) + (size_t)((row0) + vrow) * (pitch) + vcol, (unsigned)__builtin_amdgcn_readfirstlane(vdst + (slot)))
#define ROT() do { sl_cur = sl_next; sl_next = (sl_next == (NSLOT - 1) * SLOTB) ? 0 : sl_next + SLOTB; } while (0)
    VM_WAIT(); LDS_WAIT(); __syncthreads();

    const bf16* KCg = F.KC() + (size_t)g * 1024 * 64; const bf16* VCg = F.VC() + (size_t)g * 1024 * 64;
    const int nkt = (qt >> 4) + 1;
    const int tminw = 64 * qt + 8 * wid;
    float m = -1e30f, l = 0.f;
    {
        int sl_cur = 0, sl_next = SLOTB;
        DMA_K(KCg, 64, 0, 0);
        for (int kt = 0; kt < nkt; ++kt) {
            if (kt + 1 < nkt) { DMA_K(KCg, 64, 64 * (kt + 1), sl_next); ATT_WAITBAR(1); } else { ATT_WAITBAR(0); }
            const bool far = (tminw - 31 - 16 * (64 * kt + 63)) >= 128;
            qkt(p0, p1, shm + L_K + sl_cur, qr, r32, hi);
            if (!far) near_apply<16, 0x80000000u>(p0, p1, t - 31 - 16 * (64 * kt + 4 * hi), luth);
            sm_update<false>(p0, p1, far ? b31 : 0.f, m, l, o, wsf, r32, hi);
            ROT();
        }
        LDS_WAIT(); __builtin_amdgcn_s_barrier();
    }
    {
        const float lt = halfsum(l); const float rl = lt > 0.f ? 1.0f / lt : 0.f;
        ATT_FILL(o[0], 0.f); ATT_FILL(o[1], 0.f);
        float carry = 0.f;
        int sl_cur = 0, sl_next = SLOTB;
        DMA_K(KCg, 64, 0, 0); DMA_V(VCg, 64, 0, 0);
        for (int kt = 0; kt < nkt; ++kt) {
            if (kt + 1 < nkt) { DMA_K(KCg, 64, 64 * (kt + 1), sl_next); DMA_V(VCg, 64, 64 * (kt + 1), sl_next); ATT_WAITBAR(2); } else { ATT_WAITBAR(0); }
            const bool far = (tminw - 31 - 16 * (64 * kt + 63)) >= 128;
            qkt(p0, p1, shm + L_K + sl_cur, qr, r32, hi);
            if (!far) near_apply<16, 0x80000000u>(p0, p1, t - 31 - 16 * (64 * kt + 4 * hi), luth);
            const float mb2 = far ? m - b31 : m;
#pragma unroll
            for (int r = 0; r < 16; ++r) { p0[r] = __builtin_amdgcn_exp2f(p0[r] - mb2) * rl; p1[r] = __builtin_amdgcn_exp2f(p1[r] - mb2) * rl; }
            {
                float q4[8], e[8];
#pragma unroll
                for (int i = 0; i < 4; ++i) { q4[i] = (p0[4 * i] + p0[4 * i + 1]) + (p0[4 * i + 2] + p0[4 * i + 3]); e[i] = p0[4 * i + 3];
                                              q4[4 + i] = (p1[4 * i] + p1[4 * i + 1]) + (p1[4 * i + 2] + p1[4 * i + 3]); e[4 + i] = p1[4 * i + 3]; }
                float newcarry = 0.f;
#pragma unroll
                for (int i = 0; i < 8; ++i) { auto rr = __builtin_amdgcn_permlane32_swap(__float_as_uint(e[i]), __float_as_uint(e[i]), false, false);
                    const float elo = __uint_as_float(rr[0]), ehi = __uint_as_float(rr[1]);
                    if (hi) q4[i] += elo; else if (i < 7) q4[i + 1] += ehi;
                    if (i == 7) newcarry = ehi; }
                if (!hi) q4[0] += carry;
                carry = newcarry;
#pragma unroll
                for (int i = 0; i < 8; ++i) { float v = q4[i]; v += dpp_f<0xB1>(v); v += dpp_f<0x4E>(v); q4[i] = v; }
                if (h == 0) {
#pragma unroll
                    for (int i = 0; i < 8; ++i) SC[(8 * wid + ql) * 256 + 16 * kt + 2 * i + hi] = q4[i]; }
            }
            { ATT_PACK(p0, p1); pv(o, vb0 + sl_cur, pa0, pa1, pa2, pa3); }
            ROT();
        }
        LDS_WAIT(); __builtin_amdgcn_s_barrier();
    }

    if (cur >= 16) {
        const int u4 = lane >> 4, li16 = lane & 15;
#pragma unroll 1
        for (int qb = 0; qb < 8; qb += 4) {
            const int qloc = 8 * wid + qb + u4;
            const LAS float* row = SC + qloc * 256 + li16;
            int v[16];
#pragma unroll
            for (int k = 0; k < 16; ++k) { const int J = li16 + 16 * k; const int x = (__float_as_int(row[16 * k]) & ~255) | (255 - J); v[k] = (J >= 1 && J <= cur - 2) ? x : -1; }
            LAS unsigned* bmq = BM + (qloc >> 5); const unsigned qbit = 1u << (qloc & 31);
#pragma unroll 1
            for (int round = 0; round < 13; ++round) {
                int lm = max(max(max(v[0], v[1]), max(v[2], v[3])), max(max(v[4], v[5]), max(v[6], v[7])));
                lm = max(lm, max(max(max(v[8], v[9]), max(v[10], v[11])), max(max(v[12], v[13]), max(v[14], v[15]))));
                int rm = lm; rm = max(rm, dpp_i<0xB1>(rm)); rm = max(rm, dpp_i<0x4E>(rm)); rm = max(rm, dpp_i<0x141>(rm)); rm = max(rm, dpp_i<0x140>(rm));
                if (lm == rm) {
#pragma unroll
                    for (int k = 0; k < 16; ++k) v[k] = (v[k] == rm) ? -1 : v[k];
                    __hip_atomic_fetch_or(bmq + 2 * (255 - (rm & 255)), qbit, __ATOMIC_RELAXED, __HIP_MEMORY_SCOPE_WORKGROUP);
                }
            }
        }
    }
    LDS_WAIT();
    LAS float* ostg = (LAS float*)(shm + L_SC) + wid * 2048;
    {
        if (hi == 0) wsf[r32] = gate_c; LDS_WAIT();
#pragma unroll
        for (int r = 0; r < 16; ++r) { const float f = wsf[crow(r, hi)]; const int orow = crow(r, hi); ostg[orow * 64 + r32] = o[0][r] * f; ostg[orow * 64 + 32 + r32] = o[1][r] * f; }
    }

    const bf16* Kw = F.KV() + 512 + g * 64; const bf16* Vw = F.KV() + 640 + g * 64;
    {
        m = -1e30f; l = 0.f; ATT_FILL(o[0], 0.f); ATT_FILL(o[1], 0.f);
        const int J0 = max(cur - 8, 0);
        int sl_cur = 0, sl_next = SLOTB;
        DMA_K(Kw, 768, 64 * J0, 0); DMA_V(Vw, 768, 64 * J0, 0);
        for (int J = J0; J <= cur; ++J) {
            if (J + 1 <= cur) { DMA_K(Kw, 768, 64 * (J + 1), sl_next); DMA_V(Vw, 768, 64 * (J + 1), sl_next); ATT_WAITBAR(2); } else { ATT_WAITBAR(0); }
            const bool nearw = (J >= cur - 2 || J == cur - 8);
            qkt(p0, p1, shm + L_K + sl_cur, qr, r32, hi);
            if (nearw) near_apply<1, 512u>(p0, p1, t - 64 * J - 4 * hi, luth);
            sm_update<true>(p0, p1, nearw ? 0.f : b31, m, l, o, wsf, r32, hi);
            { ATT_PACK(p0, p1); pv(o, vb0 + sl_cur, pa0, pa1, pa2, pa3); }
            ROT();
        }
        LDS_WAIT(); __builtin_amdgcn_s_barrier();
        const float lt = halfsum(l); const float fw = lt > 0.f ? gate_w / lt : 0.f;
        if (hi == 0) wsf[r32] = fw; LDS_WAIT();
#pragma unroll
        for (int r = 0; r < 16; ++r) { const float f = wsf[crow(r, hi)]; const int orow = crow(r, hi); ostg[orow * 64 + r32] += o[0][r] * f; ostg[orow * 64 + 32 + r32] += o[1][r] * f; }
        LDS_WAIT();
#pragma unroll
        for (int i = 0; i < 4; ++i) { const int rowl = i * 8 + (lane >> 3), chn = lane & 7;
            const f32x4 a0 = *(const LAS f32x4*)(ostg + rowl * 64 + chn * 8), a1 = *(const LAS f32x4*)(ostg + rowl * 64 + chn * 8 + 4);
            const size_t tt = (size_t)(64 * qt + 8 * wid + (rowl >> 2)); const int col = (4 * g + (rowl & 3)) * 64 + chn * 8;
            *(u32x4*)(F.XN() + tt * 1024 + col) = (u32x4){cvtpk(a0[0], a0[1]), cvtpk(a0[2], a0[3]), cvtpk(a1[0], a1[1]), cvtpk(a1[2], a1[3])}; }
        LDS_WAIT();
    }

    const bf16* Ks = F.KV() + 256 + g * 64; const bf16* Vs = F.KV() + 384 + g * 64;
    {
        m = -1e30f; l = 0.f; ATT_FILL(o[0], 0.f); ATT_FILL(o[1], 0.f);
        const int nA = (cur < 16) ? cur + 1 : 3;
#define JA(i) ((cur < 16) ? (i) : ((i) == 0 ? 0 : cur - 2 + (i)))
        int sl_cur = 0, sl_next = SLOTB;
        DMA_K(Ks, 768, 0, 0); DMA_V(Vs, 768, 0, 0);
        for (int i = 0; i < nA; ++i) {
            const int J = JA(i);
            if (i + 1 < nA) { const int Jn = JA(i + 1); DMA_K(Ks, 768, 64 * Jn, sl_next); DMA_V(Vs, 768, 64 * Jn, sl_next); ATT_WAITBAR(2); } else { ATT_WAITBAR(0); }
            const bool neara = (J >= cur - 2);
            qkt(p0, p1, shm + L_K + sl_cur, qr, r32, hi);
            if (neara) near_apply<1, 0x80000000u>(p0, p1, t - 64 * J - 4 * hi, luth);
            sm_update<true>(p0, p1, neara ? 0.f : b31, m, l, o, wsf, r32, hi);
            { ATT_PACK(p0, p1); pv(o, vb0 + sl_cur, pa0, pa1, pa2, pa3); }
            ROT();
        }
#undef JA
        LDS_WAIT(); __builtin_amdgcn_s_barrier();
        const float lt = halfsum(l);
        if (hi == 0) { REF[32 * wid + r32] = m; LACC[32 * wid + r32] = lt; }
#pragma unroll
        for (int r = 0; r < 16; ++r) { const int orow = 32 * wid + crow(r, hi); OACC[orow * 64 + r32] = o[0][r]; OACC[orow * 64 + 32 + r32] = o[1][r]; }
        LDS_WAIT(); __builtin_amdgcn_s_barrier();
    }

    if (cur >= 16) {
        const int c16 = lane & 15, gq = lane >> 4, qi4 = c16 >> 2;
        const bf16* KTg = F.KT() + (size_t)g * 256 * 4096 + gq * 512 + c16 * 8; const bf16* VTg = F.VT() + (size_t)g * 256 * 4096 + c16 * 32 + 8 * gq;
        const LAS bf16* QLg = QL + (gq >> 1) * 64 + h * 16 + 8 * (gq & 1);
        LAS unsigned* TL = (LAS unsigned*)(shm + L_TL) + wid * 160;
        int ntask = 0;
#pragma unroll 1
        for (int i4 = 0; i4 < 4; ++i4) {
            const int Jl = lane + 64 * i4; int nch = 0;
            unsigned long long mk = 0ull;
            if (Jl >= 1 && Jl <= cur - 2 && (Jl & 7) == wid) { mk = ((unsigned long long)BM[2 * Jl + 1] << 32) | BM[2 * Jl]; nch = (__popcll(mk) + 3) >> 2; }
            int incl = nch;
#pragma unroll
            for (int o = 1; o < 64; o <<= 1) { const int up = __shfl_up(incl, o); if (lane >= o) incl += up; }
            const int base = ntask + incl - nch;
            for (int c = 0; c < nch; ++c) { unsigned e = (unsigned)Jl; int q0 = 0;
#pragma unroll
                for (int k = 0; k < 4; ++k) { int q = q0; if (mk) { q = __builtin_ctzll(mk); mk &= mk - 1; } if (k == 0) q0 = q; e |= (unsigned)q << (8 + 6 * k); }
                if (base + c < 160) TL[base + c] = e; }
            ntask += __shfl(incl, 63);
        }
        ntask = min(ntask, 160);
        LAS bf16* EX = (LAS bf16*)(shm + L_EX); LAS int* HDR = (LAS int*)(shm + L_HDR); LAS float* LEX = (LAS float*)(shm + L_LEX); LAS int* NT = (LAS int*)(shm + L_NT);
        if (lane == 0) NT[wid] = ntask;
        LDS_WAIT(); __builtin_amdgcn_s_barrier();
        int nround = 0;
#pragma unroll
        for (int k = 0; k < 8; ++k) nround = max(nround, __builtin_amdgcn_readfirstlane(NT[k]));
        bf16x8 kfC[8], vfC[8];
#define LOADK(J_, KF) do { const bf16* kp_ = KTg + (size_t)(J_) * 4096; \
            _Pragma("unroll") for (int kt = 0; kt < 4; ++kt) { KF[2 * kt] = *(const bf16x8*)(kp_ + kt * 128); KF[2 * kt + 1] = *(const bf16x8*)(kp_ + 2048 + kt * 128); } } while (0)
#define LOADV(J_, VF) do { const bf16* vp_ = VTg + (size_t)(J_) * 4096; _Pragma("unroll") for (int x = 0; x < 8; ++x) VF[x] = *(const bf16x8*)(vp_ + x * 512); } while (0)
        unsigned e_cur = 0xffu;
        bf16x8 qg0 = {0, 0, 0, 0, 0, 0, 0, 0}, qg1 = {0, 0, 0, 0, 0, 0, 0, 0}; float ref = 0.f;
#define QFETCH(E) do { const int mq_ = ((E) >> (8 + 6 * qi4)) & 63; const LAS bf16* qp_ = QLg + mq_ * 256; qg0 = *(const LAS bf16x8*)(qp_); qg1 = *(const LAS bf16x8*)(qp_ + 128); ref = REF[4 * mq_ + h]; } while (0)
        if (ntask > 0) { e_cur = (unsigned)__builtin_amdgcn_readfirstlane((int)TL[0]); LOADK(e_cur & 255u, kfC); LOADV(e_cur & 255u, vfC); QFETCH(e_cur); }
        float oa[2][16], la2[2];
#pragma unroll
        for (int p = 0; p < 2; ++p) { la2[p] = 0.f;
#pragma unroll
            for (int k = 0; k < 16; ++k) oa[p][k] = 0.f; }
#pragma unroll 1
        for (int n = 0; n < nround; ++n) {
            const int buf = n & 1;
            if (n < ntask) {
                const unsigned e_nxt = (n + 1 < ntask) ? (unsigned)__builtin_amdgcn_readfirstlane((int)TL[n + 1]) : 0xffu;
                const unsigned e_ = e_cur; const int Jb = e_ & 255, Jn = e_nxt & 255; const bool reload = (Jn != Jb) && (Jn != 255);
                const int q0_ = (e_ >> 8) & 63;
                const int myq = (e_ >> (8 + 6 * qi4)) & 63; const bool valid = (qi4 == 0) || (myq != q0_); const int tq = 64 * qt + myq;
                const bool nearJ = (Jb >= cur - 2);
                const float cinit = nearJ ? 0.f : (valid ? b31 - ref : -INFINITY);
                f32x4 s[4];
#pragma unroll
                for (int kt = 0; kt < 4; ++kt) { s[kt] = (f32x4){cinit, cinit, cinit, cinit};
                    s[kt] = __builtin_amdgcn_mfma_f32_16x16x32_bf16(kfC[2 * kt], qg0, s[kt], 0, 0, 0); s[kt] = __builtin_amdgcn_mfma_f32_16x16x32_bf16(kfC[2 * kt + 1], qg1, s[kt], 0, 0, 0); }
                if (reload) LOADK(Jn, kfC);
                const float refc = ref;
                if (n + 1 < ntask) QFETCH(e_nxt);
                if (nearJ) { const float sub = valid ? refc : INFINITY;
                    float bb[16];
#pragma unroll
                    for (int kt = 0; kt < 4; ++kt)
#pragma unroll
                        for (int r = 0; r < 4; ++r) { const int dd = tq - 64 * Jb - (16 * kt + 4 * gq + r); bb[kt * 4 + r] = luth[min(max(dd, 0), 127)]; }
#pragma unroll
                    for (int x = 0; x < 16; ++x) asm volatile("" : "+v"(bb[x]));
#pragma unroll
                    for (int kt = 0; kt < 4; ++kt)
#pragma unroll
                        for (int r = 0; r < 4; ++r) { const int dd = tq - 64 * Jb - (16 * kt + 4 * gq + r); const float tt = s[kt][r] + bb[kt * 4 + r] - sub;
                            s[kt][r] = (dd >= 0) ? tt : -INFINITY; } }
#pragma unroll
                for (int kt = 0; kt < 4; ++kt)
#pragma unroll
                    for (int r = 0; r < 4; ++r) s[kt][r] = __builtin_amdgcn_exp2f(fminf(s[kt][r], CLAMP));
                float ls = (((s[0][0] + s[0][1]) + (s[0][2] + s[0][3])) + ((s[1][0] + s[1][1]) + (s[1][2] + s[1][3]))) + (((s[2][0] + s[2][1]) + (s[2][2] + s[2][3])) + ((s[3][0] + s[3][1]) + (s[3][2] + s[3][3])));
                { auto r16 = __builtin_amdgcn_permlane16_swap(__float_as_uint(ls), __float_as_uint(ls), false, false); ls = __uint_as_float(r16[0]) + __uint_as_float(r16[1]); }
                ls = halfsum(ls);
                bf16x8 pb[2];
#pragma unroll
                for (int ks = 0; ks < 2; ++ks) pb[ks] = __builtin_bit_cast(bf16x8, (u32x4){cvtpk(s[2 * ks][0], s[2 * ks][1]), cvtpk(s[2 * ks][2], s[2 * ks][3]), cvtpk(s[2 * ks + 1][0], s[2 * ks + 1][1]), cvtpk(s[2 * ks + 1][2], s[2 * ks + 1][3])});
                LAS bf16* ex = EX + buf * 8704 + ((wid * 4 + qi4) * 4 + h) * 68 + 4 * gq;
                f32x4 ot[4];
#pragma unroll
                for (int mt = 0; mt < 4; ++mt) { ot[mt] = (f32x4){0.f, 0.f, 0.f, 0.f};
                    ot[mt] = __builtin_amdgcn_mfma_f32_16x16x32_bf16(vfC[2 * mt], pb[0], ot[mt], 0, 0, 0); ot[mt] = __builtin_amdgcn_mfma_f32_16x16x32_bf16(vfC[2 * mt + 1], pb[1], ot[mt], 0, 0, 0); }
                if (reload) LOADV(Jn, vfC);
#pragma unroll
                for (int mt = 0; mt < 4; ++mt) *(LAS u32x2*)(ex + 16 * mt) = (u32x2){cvtpk(ot[mt][0], ot[mt][1]), cvtpk(ot[mt][2], ot[mt][3])};
                if (gq == 0) { LEX[buf * 128 + wid * 16 + c16] = ls; if (h == 0) HDR[buf * 32 + wid * 4 + qi4] = valid ? myq : -1; }
                e_cur = e_nxt;
            } else if (lane < 4) HDR[buf * 32 + wid * 4 + lane] = -1;
            LDS_WAIT(); __builtin_amdgcn_s_barrier();
            {
                const int hv = (lane < 32) ? HDR[buf * 32 + lane] : -1;
                const int li = lane & 15, hsel = li >> 2, dq = (li & 3) * 16;
#pragma unroll
                for (int pass = 0; pass < 2; ++pass) {
                    const unsigned m0 = (unsigned)__ballot(hv == 8 * wid + 4 * pass + 0), m1 = (unsigned)__ballot(hv == 8 * wid + 4 * pass + 1), m2 = (unsigned)__ballot(hv == 8 * wid + 4 * pass + 2), m3 = (unsigned)__ballot(hv == 8 * wid + 4 * pass + 3);
                    if ((m0 | m1 | m2 | m3) == 0u) continue;
                    unsigned mm = gq == 0 ? m0 : gq == 1 ? m1 : gq == 2 ? m2 : m3;
                    while (mm) { const int e = __builtin_ctz(mm); mm &= mm - 1;
                        const LAS bf16* xr = EX + buf * 8704 + (e * 4 + hsel) * 68 + dq;
                        const u32x2 y0 = *(const LAS u32x2*)(xr), y1 = *(const LAS u32x2*)(xr + 4), y2 = *(const LAS u32x2*)(xr + 8), y3 = *(const LAS u32x2*)(xr + 12);
                        const u32x4 x0 = {y0.x, y0.y, y1.x, y1.y}, x1 = {y2.x, y2.y, y3.x, y3.y};
                        oa[pass][0] += bflo(x0.x); oa[pass][1] += bfhi(x0.x); oa[pass][2] += bflo(x0.y); oa[pass][3] += bfhi(x0.y); oa[pass][4] += bflo(x0.z); oa[pass][5] += bfhi(x0.z); oa[pass][6] += bflo(x0.w); oa[pass][7] += bfhi(x0.w);
                        oa[pass][8] += bflo(x1.x); oa[pass][9] += bfhi(x1.x); oa[pass][10] += bflo(x1.y); oa[pass][11] += bfhi(x1.y); oa[pass][12] += bflo(x1.z); oa[pass][13] += bfhi(x1.z); oa[pass][14] += bflo(x1.w); oa[pass][15] += bfhi(x1.w);
                        la2[pass] += LEX[buf * 128 + e * 4 + hsel]; }
                }
            }
        }
        {
            const int li = lane & 15, hsel = li >> 2, dq = (li & 3) * 16;
#pragma unroll
            for (int pass = 0; pass < 2; ++pass) { const int q = 8 * wid + 4 * pass + gq; LAS f32x4* ap = (LAS f32x4*)(OACC + (4 * q + hsel) * 64 + dq);
#pragma unroll
                for (int k = 0; k < 4; ++k) { f32x4 a = ap[k]; a[0] += oa[pass][4 * k]; a[1] += oa[pass][4 * k + 1]; a[2] += oa[pass][4 * k + 2]; a[3] += oa[pass][4 * k + 3]; ap[k] = a; }
                if ((li & 3) == 0) LACC[4 * q + hsel] += la2[pass]; }
        }
#undef LOADK
#undef LOADV
#undef QFETCH
    }
    LDS_WAIT(); __builtin_amdgcn_s_barrier();

    {
        if (hi == 0) { const float lt = LACC[32 * wid + r32]; wsf[r32] = lt > 0.f ? gate_s / lt : 0.f; }
        LDS_WAIT();
#pragma unroll
        for (int i = 0; i < 4; ++i) { const int rowl = i * 8 + (lane >> 3), chn = lane & 7, row = 32 * wid + rowl;
            const float f = wsf[rowl];
            const f32x4 a0 = *(const LAS f32x4*)(OACC + row * 64 + chn * 8), a1 = *(const LAS f32x4*)(OACC + row * 64 + chn * 8 + 4);
            const size_t tt = (size_t)(64 * qt + 8 * wid + (rowl >> 2)); const int col = (4 * g + (rowl & 3)) * 64 + chn * 8;
            const u32x4 ov = *(const u32x4*)(F.XN() + tt * 1024 + col);
            const u32x4 gn = *(const u32x4*)(F.GN() + tt * 512 + col);
            u32x4 w; w.x = pk2((bflo(ov.x) + a0[0] * f) * bflo(gn.x), (bfhi(ov.x) + a0[1] * f) * bfhi(gn.x)); w.y = pk2((bflo(ov.y) + a0[2] * f) * bflo(gn.y), (bfhi(ov.y) + a0[3] * f) * bfhi(gn.y));
            w.z = pk2((bflo(ov.z) + a1[0] * f) * bflo(gn.z), (bfhi(ov.z) + a1[1] * f) * bfhi(gn.z)); w.w = pk2((bflo(ov.w) + a1[2] * f) * bflo(gn.w), (bfhi(ov.w) + a1[3] * f) * bfhi(gn.w));
            *(u32x4*)(F.XN() + tt * 1024 + col) = w; }
        VM_WAIT(); LDS_WAIT(); __syncthreads();
    }
#undef DMA_K
#undef DMA_V
#undef ROT
}
}

__global__ void __launch_bounds__(NWAVES * 64, 2) nsa_lru_fwd(Args args) {
    extern __shared__ __attribute__((aligned(16))) unsigned char lds[];
    Frame F;
    F.lds = (LAS unsigned char*)lds;
    F.MISC = (volatile LAS unsigned*)(F.lds + MISC_OFF);
    F.wave = __builtin_amdgcn_readfirstlane((int)(threadIdx.x >> 6));
    F.G = gridDim.x; { const int bx = blockIdx.x; F.vcu = (F.G % 8 == 0) ? (bx % 8) * (F.G / 8) + bx / 8 : bx; }
    F.ws = args.ws;
    gu32* ctl = (gu32*)(args.ws + WS_CTL);
    for (int u = F.wave * 64 + lane_id(); u < (LDS_BYTES - LDSCTL_OFF) / 4; u += NWAVES * 64) ((LAS unsigned*)(F.lds + LDSCTL_OFF))[u] = 0u;
    __syncthreads();
    const int bli = (N_LAUNCHES == PER_PHASE) ? 0 : args.li;
    XcdBarrier bar; bar.bar = (unsigned*)(ctl + CW_BAR) + bli * XCD_BAR_WORDS; bar.x = 0; bar.st = nullptr;
    if (N_LAUNCHES != PER_PHASE) bar = xcd_barrier_post((unsigned*)(ctl + CW_BAR) + bli * XCD_BAR_WORDS, F.MISC + 8);
#define GRID_BAR() do { if (N_LAUNCHES != PER_PHASE) xcd_barrier(bar); } while (0)
    const int lo = args.ph_lo, hi = args.ph_hi;
#define IN(k) (lo <= (k) && (k) < hi)
#define BOTH(k) (IN(k) && IN((k) + 1))

    if (IN(0)) { p0_prologue(F, args); if (BOTH(0)) GRID_BAR(); }

    if (IN(1)) {
        pg8::Gemm g{F.XN(), F.WinT(), F.XN(), F.WinT(), 1024, 1024, 1024}; pg8::StaticOrder S; S.init(SEQ, NPROJ, F.G, (int)blockIdx.x);
        pg8::EpiProj E{F.Q(), F.KV(), F.U(), F.BR(), F.GN(), F.GL(), F.MG()};
        pg8::gemm_phase<pg8::EpiProj, pg8::StaticOrder, true>(F.lds, g, S, E, F.wave);
        if (BOTH(1)) GRID_BAR();
    }

    if (IN(2)) {
        for (int i = F.vcu; i < 256; i += F.G) {
            lru_tile<false>(F, args, i);
            if (!args.pad) qk_norm_tile(F, args, i);
            vt_tile(F, i);
            __syncthreads();
            compress_item(F, args, i & 1, (i >> 1) & 1, i >> 2);
        }
        if (BOTH(2)) GRID_BAR();
    }

    if (IN(3)) {
        for (int i = F.vcu; i < 256; i += F.G) { lru_tile<true>(F, args, i); }
        __syncthreads();
#pragma unroll 1
        for (int it = 2 * F.vcu; it < 512; it += 2 * F.G) {
#pragma unroll 1
            for (int j = 0; j < 2; ++j) { const int i = it >> 1; att::attn_item(F, j ? i : 255 - i, j ? 0 : 1); }
        }
        if (BOTH(3)) GRID_BAR();
    }

    if (IN(4)) {
        pg8::Gemm g{F.XN(), F.WaT(), F.XN() + 512, F.WbT(), 1024, 512, 512}; pg8::DualOrder S; S.init(SEQ, 1024, F.G, (int)blockIdx.x);
        pg8::EpiMerge E{F.MB(), F.MG()};
        pg8::gemm_phase<pg8::EpiMerge, pg8::DualOrder, true>(F.lds, g, S, E, F.wave);
        if (BOTH(4)) GRID_BAR();
    }

    if (IN(5)) {
        pg8::Gemm g{F.MB(), F.WoutT(), F.MB(), F.WoutT(), 1024, 1024, 1024}; pg8::StaticOrder S; S.init(SEQ, 1024, F.G, (int)blockIdx.x);
        pg8::EpiOut E{args.in[0], args.out};
        pg8::gemm_phase<pg8::EpiOut, pg8::StaticOrder, true>(F.lds, g, S, E, F.wave);
    }
#undef IN
#undef BOTH
}

extern "C" void kernel_launch(void* const* d_in, const int* in_sizes, int n_in, void* d_out, int out_size, void* d_ws, size_t ws_size, hipStream_t stream) {
    static int grid = 0;
    if (grid == 0) {
        if (n_in != 20 || in_sizes[0] != SEQ * DM || out_size != SEQ * DM || ws_size < WS_END) { fprintf(stderr, "kernel_launch: unexpected shapes (n_in %d, in0 %d, out %d, ws %zu)\n", n_in, n_in > 0 ? in_sizes[0] : -1, out_size, ws_size); grid = -1; return; }
        int dev = 0, cus = 0, per_cu = 0;
        if (hipGetDevice(&dev) != hipSuccess || hipDeviceGetAttribute(&cus, hipDeviceAttributeMultiprocessorCount, dev) != hipSuccess) { grid = -1; return; }
        if (hipFuncSetAttribute((const void*)nsa_lru_fwd, hipFuncAttributeMaxDynamicSharedMemorySize, LDS_BYTES) != hipSuccess) { fprintf(stderr, "kernel_launch: hipFuncSetAttribute failed\n"); grid = -1; return; }
        if (hipOccupancyMaxActiveBlocksPerMultiprocessor(&per_cu, (const void*)nsa_lru_fwd, NWAVES * 64, LDS_BYTES) != hipSuccess || per_cu < 1)
            fprintf(stderr, "kernel_launch: occupancy query reports %d workgroups per CU\n", per_cu);
        (void)hipGetLastError();
        grid = cus;
    }
    if (grid < 0) return;
    if (hipMemsetAsync((char*)d_ws + WS_CTL, 0, CTL_ZERO_BYTES, stream) != hipSuccess) { fprintf(stderr, "kernel_launch: hipMemsetAsync failed\n"); return; }
    Args a{};
    for (int i = 0; i < 20; ++i) a.in[i] = (const float*)d_in[i];
    a.out = (float*)d_out; a.ws = (unsigned char*)d_ws;
    const int nl = (PROBE_DUP >= 0) ? 2 : N_LAUNCHES;
    for (int li = 0; li < nl; ++li) {
        if (PROBE_DUP >= 0) { a.ph_lo = li ? PROBE_DUP : 0; a.ph_hi = li ? PER_PHASE : PROBE_DUP + 1; a.li = li; a.pad = (li && PROBE_DUP == 2) ? 1 : 0; }
        else { a.ph_lo = (N_LAUNCHES == PER_PHASE) ? li : 0; a.ph_hi = (N_LAUNCHES == PER_PHASE) ? li + 1 : PER_PHASE; a.li = li; }
        hipLaunchKernelGGL(nsa_lru_fwd, dim3(grid), dim3(NWAVES * 64), LDS_BYTES, stream, a);
        const hipError_t le = hipPeekAtLastError();
        if (le != hipSuccess) { fprintf(stderr, "kernel_launch: launch %d failed: %s\n", li, hipGetErrorName(le)); break; }
    }
}
```

```cpp
#include <hip/hip_runtime.h>
#include <cstdio>
#include <cstdint>

#ifndef PROBE_DUP
#define PROBE_DUP -1
#endif
#ifndef MK_N_LAUNCHES
#define MK_N_LAUNCHES 1
#endif

#define GAS __attribute__((address_space(1)))
#define LAS __attribute__((address_space(3)))
typedef unsigned short bf16;
typedef short bf16x8 __attribute__((ext_vector_type(8)));
typedef short s16x4 __attribute__((ext_vector_type(4)));
typedef float f32x4 __attribute__((ext_vector_type(4)));
typedef float f32x16 __attribute__((ext_vector_type(16)));
typedef unsigned u32x4 __attribute__((ext_vector_type(4)));
typedef unsigned u32x2 __attribute__((ext_vector_type(2)));
typedef GAS unsigned gu32;

constexpr int SEQ = 16384, DM = 1024;
constexpr int NPROJ = 5120;
constexpr float LOG2E = 1.4426950408889634f;
constexpr float RMS_EPS = 1e-6f;

__device__ __forceinline__ unsigned f2bf(float f) { unsigned u = __builtin_bit_cast(unsigned, f); return (u + 0x7fffu + ((u >> 16) & 1u)) >> 16; }
__device__ __forceinline__ unsigned pk2(float lo, float hi) { return f2bf(lo) | (f2bf(hi) << 16); }
__device__ __forceinline__ float bf2f(unsigned h) { return __builtin_bit_cast(float, h << 16); }
__device__ __forceinline__ float bflo(unsigned w) { return __builtin_bit_cast(float, w << 16); }
__device__ __forceinline__ float bfhi(unsigned w) { return __builtin_bit_cast(float, w & 0xffff0000u); }
typedef float f32x2_t __attribute__((ext_vector_type(2))); typedef __bf16 bf16x2_t __attribute__((ext_vector_type(2)));
__device__ __forceinline__ unsigned cvtpk(float lo, float hi) { f32x2_t v = {lo, hi}; bf16x2_t b = __builtin_convertvector(v, bf16x2_t); return __builtin_bit_cast(unsigned, b); }
__device__ __forceinline__ float fsigmoid(float v) { return __builtin_amdgcn_rcpf(1.0f + __builtin_amdgcn_exp2f(-v * LOG2E)); }
template <int CTRL> __device__ __forceinline__ float dpp_f(float v) { return __builtin_bit_cast(float, __builtin_amdgcn_update_dpp(0, __builtin_bit_cast(int, v), CTRL, 0xf, 0xf, true)); }
template <int CTRL> __device__ __forceinline__ int dpp_i(int v) { return __builtin_amdgcn_update_dpp(v, v, CTRL, 0xf, 0xf, false); }
__device__ __forceinline__ int lane_id() { int l = (int)__builtin_amdgcn_mbcnt_hi(~0u, __builtin_amdgcn_mbcnt_lo(~0u, 0u)); asm volatile("" : "+v"(l)); return l; }
__device__ __forceinline__ float wave_sum(float v) {
#pragma unroll
    for (int o = 1; o < 64; o <<= 1) v += __shfl_xor(v, o);
    return v;
}

namespace pg8 {
#define PG8_LAS __attribute__((address_space(3)))
typedef unsigned short bf16_t;
constexpr int BM = 256, BK = 64, HALF = 128, HTB = HALF * BK * 2, STAGE_BYTES = 8 * HTB, NXCD = 8, WGM = 8;
__host__ __device__ __forceinline__ int lds_byte(int r, int c) { const int st = (r >> 4) * 2 + (c >> 5), rr = r & 15, cc = c & 31, ob = rr * 64 + cc * 2; return st * 1024 + (ob ^ (((ob >> 9) & 1) << 5)); }
__host__ __device__ __forceinline__ void stage_rc(int b, int& R, int& C) { const int st = b / 1024, sb = b % 1024, swz = sb ^ (((sb >> 9) & 1) << 5); R = (st >> 1) * 16 + swz / 64; C = (st & 1) * 32 + (swz % 64) / 2; }
__host__ __device__ __forceinline__ int perm32(int rho) { const int n = rho >> 4, i = rho & 15; return 8 * (i >> 2) + 4 * n + (i & 3); }

struct Unit { int pm, pn, part; };
struct Gemm { const bf16_t* A; const bf16_t* Bt; const bf16_t* A2; const bf16_t* Bt2; int lda, ldb, K; };

struct StaticOrder {
    int nM, nN, nwg, G, c;
    __host__ __device__ void init(int M, int N, int G_, int c_) { nM = M / BM; nN = N / BM; nwg = nM * nN; G = G_; c = c_; }
    __host__ __device__ bool tile(long L, Unit& u) const {
        if (L >= nwg) return false;
        int wgid = (int)L; { const int q = nwg / NXCD, r = nwg % NXCD, xcd = wgid % NXCD, off = wgid / NXCD; wgid = (xcd < r ? xcd * (q + 1) : r * (q + 1) + (xcd - r) * q) + off; }
        const int nig = WGM * nN, gid = wgid / nig, fm = gid * WGM, gsz = (nM - fm) < WGM ? (nM - fm) : WGM;
        u.pm = fm + ((wgid % nig) % gsz); u.pn = (wgid % nig) / gsz; u.part = 0; return true;
    }
    __host__ __device__ bool next(int i, Unit& u) const { return tile((long)i * G + c, u); }
};
struct DualOrder : StaticOrder {
    __host__ __device__ bool next(int i, Unit& u) const { if (!tile((long)(i >> 1) * G + c, u)) return false; u.part = i & 1; return true; }
};

__device__ __forceinline__ unsigned cvt_pk_bf16(float lo, float hi) { unsigned r; asm volatile("v_cvt_pk_bf16_f32 %0, %1, %2" : "=v"(r) : "v"(lo), "v"(hi)); return r; }

struct EpiProj {
    static constexpr bool PERM = true, INIT = false;
    bf16_t *Q, *KV, *U, *BR, *GN, *GL, *MG;
    __device__ __forceinline__ void operator()(const f32x4 (&acc)[2][2][4][2], const Unit& u, int wr, int wc, int fr, int fq) const {
        const int pn = u.pn; bf16_t* base; int ldc, colt, act = 0;
        if (pn < 2) { base = Q; ldc = 512; colt = pn * 256; }
        else if (pn < 5) { base = KV; ldc = 768; colt = (pn - 2) * 256; }
        else if (pn < 7) { base = U; ldc = 512; colt = (pn - 5) * 256; }
        else if (pn < 8) { base = BR; ldc = 256; colt = 0; }
        else if (pn < 10) { base = GN; ldc = 512; colt = (pn - 8) * 256; act = 1; }
        else if (pn < 12) { base = GL; ldc = 512; colt = (pn - 10) * 256; act = 1; }
        else { base = MG; ldc = 2048; colt = (pn - 12) * 256; act = 2; }
        const int row0 = u.pm * BM + wr * 64 + fr, col0 = colt + wc * 32 + 8 * fq;
#pragma unroll
        for (int ai = 0; ai < 2; ++ai)
#pragma unroll
            for (int m = 0; m < 4; ++m) { bf16_t* rowp = base + (size_t)(row0 + ai * HALF + m * 16) * ldc + col0;
#pragma unroll
                for (int bj = 0; bj < 2; ++bj) { f32x4 v0 = acc[ai][bj][m][0], v1 = acc[ai][bj][m][1];
                    if (act) {
#pragma unroll
                        for (int e = 0; e < 4; ++e) { const float s0 = fsigmoid(v0[e]), s1 = fsigmoid(v1[e]); v0[e] = (act == 1) ? v0[e] * s0 : s0; v1[e] = (act == 1) ? v1[e] * s1 : s1; } }
                    u32x4 w; w.x = cvt_pk_bf16(v0[0], v0[1]); w.y = cvt_pk_bf16(v0[2], v0[3]); w.z = cvt_pk_bf16(v1[0], v1[1]); w.w = cvt_pk_bf16(v1[2], v1[3]);
                    *(u32x4*)(rowp + bj * HALF) = w; } }
    }
};
struct EpiMerge {
    static constexpr bool PERM = true, INIT = false;
    bf16_t* Mb; const bf16_t* MG;
    __device__ __forceinline__ void operator()(const f32x4 (&acc)[2][2][4][2], const Unit& u, int wr, int wc, int fr, int fq) const {
        const int row0 = u.pm * BM + wr * 64 + fr, col0 = u.pn * BM + wc * 32 + 8 * fq;
#pragma unroll
        for (int ai = 0; ai < 2; ++ai)
#pragma unroll
            for (int m = 0; m < 4; ++m) { const size_t r = (size_t)(row0 + ai * HALF + m * 16);
#pragma unroll
                for (int bj = 0; bj < 2; ++bj) { const f32x4 v0 = acc[ai][bj][m][0], v1 = acc[ai][bj][m][1];
                    const u32x4 gw = *(const u32x4*)(MG + r * 2048 + u.part * 1024 + col0 + bj * HALF);
                    float o[8] = {v0[0] * bflo(gw.x), v0[1] * bfhi(gw.x), v0[2] * bflo(gw.y), v0[3] * bfhi(gw.y), v1[0] * bflo(gw.z), v1[1] * bfhi(gw.z), v1[2] * bflo(gw.w), v1[3] * bfhi(gw.w)};
                    bf16_t* dst = Mb + r * 1024 + col0 + bj * HALF;
                    if (u.part) { const u32x4 pw = *(const u32x4*)dst;
                        o[0] += bflo(pw.x); o[1] += bfhi(pw.x); o[2] += bflo(pw.y); o[3] += bfhi(pw.y); o[4] += bflo(pw.z); o[5] += bfhi(pw.z); o[6] += bflo(pw.w); o[7] += bfhi(pw.w); }
                    u32x4 w; w.x = cvt_pk_bf16(o[0], o[1]); w.y = cvt_pk_bf16(o[2], o[3]); w.z = cvt_pk_bf16(o[4], o[5]); w.w = cvt_pk_bf16(o[6], o[7]);
                    *(u32x4*)dst = w; } }
    }
};
struct EpiOut {
    static constexpr bool PERM = false, INIT = true;
    const float* X; float* O;
    __device__ __forceinline__ void init(f32x4 (&acc)[2][2][4][2], const Unit& u, int wr, int wc, int fr, int fq) const {
        const int row0 = u.pm * BM + wr * 64 + fr, col0 = u.pn * BM + wc * 32 + 4 * fq;
#pragma unroll
        for (int ai = 0; ai < 2; ++ai)
#pragma unroll
            for (int m = 0; m < 4; ++m) { const size_t off = (size_t)(row0 + ai * HALF + m * 16) * 1024 + col0;
#pragma unroll
                for (int bj = 0; bj < 2; ++bj)
#pragma unroll
                    for (int n = 0; n < 2; ++n) acc[ai][bj][m][n] = *(const f32x4*)(X + off + bj * HALF + n * 16); }
    }
    __device__ __forceinline__ void operator()(const f32x4 (&acc)[2][2][4][2], const Unit& u, int wr, int wc, int fr, int fq) const {
        const int row0 = u.pm * BM + wr * 64 + fr, col0 = u.pn * BM + wc * 32 + 4 * fq;
#pragma unroll
        for (int ai = 0; ai < 2; ++ai)
#pragma unroll
            for (int m = 0; m < 4; ++m) { const size_t off = (size_t)(row0 + ai * HALF + m * 16) * 1024 + col0;
#pragma unroll
                for (int bj = 0; bj < 2; ++bj)
#pragma unroll
                    for (int n = 0; n < 2; ++n) *(f32x4*)(O + off + bj * HALF + n * 16) = acc[ai][bj][m][n]; }
    }
};

template <class Epi, class Sched, bool ALIGN_EPI>
__device__ __forceinline__ void gemm_phase(PG8_LAS unsigned char* lds, const Gemm g, const Sched& S, const Epi& E, int wid) {
    const int lane = lane_id(), tid = wid * 64 + lane, wr = wid >> 2, wc = wid & 3, fr = lane & 15, fq = lane >> 4;
    const int K = g.K, nt = K / BK;
    unsigned voffA[2], voffB[2];
#pragma unroll
    for (int i = 0; i < 2; ++i) { int R, C; stage_rc(tid * 16 + i * 8192, R, C); const int Rb = Epi::PERM ? ((R & ~31) + perm32(R & 31)) : R;
        voffA[i] = (unsigned)(R * g.lda + C) * 2u; voffB[i] = (unsigned)(Rb * g.ldb + C) * 2u; }
    const size_t kstep = (size_t)(BK * 2);
    const size_t hstepA = (size_t)HALF * g.lda * 2, hstepB = (size_t)HALF * g.ldb * 2;
    const size_t tstepA = 2 * hstepA, tstepB = 2 * hstepB;
    const unsigned ldsw = (unsigned)wid * 1024u;
    const int aoff = lds_byte(wr * 64 + fr, fq * 8), boff = lds_byte(wc * 32 + fr, fq * 8);
#define PG8_SA(b, h) (((b) * 2 + (h)) * HTB)
#define PG8_SB(b, h) ((4 + (b) * 2 + (h)) * HTB)
#define PG8_STAGE(bufoff, gbase, voff) do { _Pragma("unroll") for (int _i = 0; _i < 2; ++_i) \
        __builtin_amdgcn_global_load_lds((const unsigned*)((const char*)(gbase) + (voff)[_i]), (PG8_LAS unsigned*)(lds + (bufoff) + ldsw + _i * 8192), 16, 0, 0); } while (0)
#define PG8_LDA(dst, b, h) do { _Pragma("unroll") for (int m = 0; m < 4; ++m) _Pragma("unroll") for (int k = 0; k < 2; ++k) dst[m][k] = *(const PG8_LAS bf16x8*)(lds + PG8_SA(b, h) + aoff + m * 2048 + k * 1024); } while (0)
#define PG8_LDB(dst, b, h) do { _Pragma("unroll") for (int n = 0; n < 2; ++n) _Pragma("unroll") for (int k = 0; k < 2; ++k) dst[n][k] = *(const PG8_LAS bf16x8*)(lds + PG8_SB(b, h) + boff + n * 2048 + k * 1024); } while (0)
#define PG8_MMA(ai, bj, At, Bt) do { __builtin_amdgcn_s_setprio(1); _Pragma("unroll") for (int m = 0; m < 4; ++m) _Pragma("unroll") for (int n = 0; n < 2; ++n) _Pragma("unroll") for (int k = 0; k < 2; ++k) \
        acc[ai][bj][m][n] = __builtin_amdgcn_mfma_f32_16x16x32_bf16(Bt[n][k], At[m][k], acc[ai][bj][m][n], 0, 0, 0); __builtin_amdgcn_s_setprio(0); } while (0)
#define PG8_WAIT_V(n) asm volatile("s_waitcnt vmcnt(" #n ")" ::: "memory")
#define PG8_WAIT_L(n) asm volatile("s_waitcnt lgkmcnt(" #n ")" ::: "memory")
#define PG8_BAR __builtin_amdgcn_s_barrier()
#define PG8_SCHED __builtin_amdgcn_sched_barrier(0)
#define PG8_UA(u) ((const char*)((u).part ? g.A2 : g.A) + (size_t)(u).pm * tstepA)
#define PG8_UB(u) ((const char*)((u).part ? g.Bt2 : g.Bt) + (size_t)(u).pn * tstepB)
    Unit cur, nxt; int ui = 0;
    if (!S.next(0, cur)) return;
    f32x4 acc[2][2][4][2];
    if constexpr (Epi::INIT) E.init(acc, cur, wr, wc, fr, fq);
    else {
#pragma unroll
    for (int a = 0; a < 2; ++a)
#pragma unroll
        for (int b = 0; b < 2; ++b)
#pragma unroll
            for (int m = 0; m < 4; ++m)
#pragma unroll
                for (int n = 0; n < 2; ++n) acc[a][b][m][n] = (f32x4){0.f, 0.f, 0.f, 0.f};
    }
    bf16x8 At[4][2], B0[2][2], B1[2][2];
    const char* cA = PG8_UA(cur); const char* cB = PG8_UB(cur);
    PG8_STAGE(PG8_SB(0, 0), cB, voffB); PG8_STAGE(PG8_SB(0, 1), cB + hstepB, voffB); PG8_STAGE(PG8_SA(0, 0), cA, voffA); PG8_STAGE(PG8_SA(0, 1), cA + hstepA, voffA);
    if (wr == 1) PG8_BAR;
    PG8_WAIT_V(2); PG8_BAR;
    PG8_STAGE(PG8_SB(1, 0), cB + kstep, voffB); PG8_STAGE(PG8_SA(1, 0), cA + kstep, voffA); PG8_STAGE(PG8_SB(1, 1), cB + hstepB + kstep, voffB);
    PG8_WAIT_V(6); PG8_BAR;
    for (;;) {
        const bool has_next = S.next(ui + 1, nxt);
        const char* nA = has_next ? PG8_UA(nxt) : cA; const char* nB = has_next ? PG8_UB(nxt) : cB;
        for (int t = 0; t < nt; t += 2) {
            const bool last = (t == nt - 2);
            const char* a1 = cA + (size_t)(t + 1) * kstep;
            const char* a2 = last ? nA : cA + (size_t)(t + 2) * kstep; const char* b2 = last ? nB : cB + (size_t)(t + 2) * kstep;
            const char* a3 = a2 + kstep; const char* b3 = b2 + kstep;
            PG8_LDB(B0, 0, 0); PG8_LDB(B1, 0, 1); PG8_SCHED; PG8_LDA(At, 0, 0); PG8_STAGE(PG8_SA(1, 1), a1 + hstepA, voffA);
            PG8_WAIT_V(8); PG8_WAIT_L(0); PG8_BAR; PG8_MMA(0, 0, At, B0); PG8_MMA(0, 1, At, B1); PG8_BAR; PG8_SCHED;
            PG8_LDA(At, 0, 1); PG8_STAGE(PG8_SB(0, 0), b2, voffB); PG8_STAGE(PG8_SB(0, 1), b2 + hstepB, voffB); PG8_STAGE(PG8_SA(0, 0), a2, voffA);
            PG8_WAIT_V(8); PG8_WAIT_L(0); PG8_BAR; PG8_MMA(1, 0, At, B0); PG8_MMA(1, 1, At, B1); PG8_BAR; PG8_SCHED;
            PG8_LDB(B0, 1, 0); PG8_LDB(B1, 1, 1); PG8_SCHED; PG8_LDA(At, 1, 0); PG8_STAGE(PG8_SA(0, 1), a2 + hstepA, voffA);
            PG8_WAIT_V(8); PG8_WAIT_L(0); PG8_BAR; PG8_MMA(0, 0, At, B0); PG8_MMA(0, 1, At, B1); PG8_BAR; PG8_SCHED;
            PG8_LDA(At, 1, 1); PG8_STAGE(PG8_SB(1, 0), b3, voffB); PG8_STAGE(PG8_SB(1, 1), b3 + hstepB, voffB); PG8_STAGE(PG8_SA(1, 0), a3, voffA);
            PG8_WAIT_V(8); PG8_WAIT_L(0); PG8_BAR; PG8_MMA(1, 0, At, B0); PG8_MMA(1, 1, At, B1); PG8_BAR; PG8_SCHED;
        }
        if constexpr (ALIGN_EPI) { if (wr == 0) PG8_BAR; }
        E(acc, cur, wr, wc, fr, fq);
        if (!has_next) break;
        if constexpr (Epi::INIT) E.init(acc, nxt, wr, wc, fr, fq);
        else {
#pragma unroll
        for (int a = 0; a < 2; ++a)
#pragma unroll
            for (int b = 0; b < 2; ++b)
#pragma unroll
                for (int m = 0; m < 4; ++m)
#pragma unroll
                    for (int n = 0; n < 2; ++n) acc[a][b][m][n] = (f32x4){0.f, 0.f, 0.f, 0.f};
        }
        cur = nxt; cA = nA; cB = nB; ++ui;
        if constexpr (ALIGN_EPI) { if (wr == 1) PG8_BAR; }
    }
    PG8_WAIT_V(0);
    if constexpr (!ALIGN_EPI) { if (wr == 0) PG8_BAR; }
    PG8_BAR;
#undef PG8_SA
#undef PG8_SB
#undef PG8_STAGE
#undef PG8_LDA
#undef PG8_LDB
#undef PG8_MMA
#undef PG8_WAIT_V
#undef PG8_WAIT_L
#undef PG8_BAR
#undef PG8_SCHED
#undef PG8_UA
#undef PG8_UB
}
}

constexpr int NWAVES = 8;
constexpr int N_LAUNCHES = MK_N_LAUNCHES;
constexpr int PER_PHASE = 6;
constexpr size_t MiB = 1u << 20;
constexpr size_t WS_CTL = 0, CTL_ZERO_BYTES = 65536;
constexpr size_t WS_WIN = 1 * MiB;
constexpr size_t WS_WA = 11 * MiB;
constexpr size_t WS_WB = 12 * MiB;
constexpr size_t WS_WOUT = 13 * MiB;
constexpr size_t WS_W1T = 15 * MiB;
constexpr size_t WS_SMALL = 17 * MiB;
constexpr size_t WS_SUM = 18 * MiB;
constexpr size_t WS_KC = 19 * MiB;
constexpr size_t WS_XN = 20 * MiB;
constexpr size_t WS_Q = 52 * MiB;
constexpr size_t WS_KV = 68 * MiB;
constexpr size_t WS_MB = 52 * MiB;
constexpr size_t WS_U = 92 * MiB;
constexpr size_t WS_BR = 108 * MiB;
constexpr size_t WS_GN = 116 * MiB;
constexpr size_t WS_GL = 132 * MiB;
constexpr size_t WS_MG = 148 * MiB;
constexpr size_t WS_VT = 212 * MiB;
constexpr size_t WS_KT = 216 * MiB;
constexpr size_t WS_Q2 = 220 * MiB;
constexpr size_t WS_END = 236 * MiB;
constexpr size_t SM_W2T = 0;
constexpr size_t SM_LWA = 65536;
constexpr size_t SM_LWX = 131072;
constexpr size_t SM_C1 = 262144;
constexpr size_t SM_LUT = 200704;
constexpr int CW_BAR = 4096;

constexpr int RING_BYTES = 160768;
constexpr int LDSCTL_OFF = RING_BYTES, MISC_OFF = LDSCTL_OFF + 320;
constexpr int LDS_BYTES = 163840;

#define RLX_AGENT __ATOMIC_RELAXED, __HIP_MEMORY_SCOPE_AGENT
#define LDS_WAIT() asm volatile("s_waitcnt lgkmcnt(0)" ::: "memory")
#define VM_WAIT() asm volatile("s_waitcnt vmcnt(0)" ::: "memory")

#define XB_TMO      128
#define XB_XCNT(j)  (256  + 64 * (j))
#define XB_XSUB(j)  (1280 + 64 * (j))
#define XB_XGEN(j)  (2304 + 64 * (j))
#define XB_TOP      3328
#define XB_TOPGEN   3392
#define XCD_BAR_WORDS 3456
#define XB_SPIN_CAP (1u << 18)
__device__ __forceinline__ unsigned xb_ld(unsigned* p)              { return __hip_atomic_load(p, __ATOMIC_RELAXED, __HIP_MEMORY_SCOPE_AGENT); }
__device__ __forceinline__ unsigned xb_add(unsigned* p, unsigned v) { return __hip_atomic_fetch_add(p, v, __ATOMIC_RELAXED, __HIP_MEMORY_SCOPE_AGENT); }
__device__ __forceinline__ unsigned xb_xcc_id() { return (unsigned)__builtin_amdgcn_s_getreg((3 << 11) | 20) & 0xFu; }
#define XB_SPIN(cond, bar) do { unsigned _sp = 0; while (cond) { __builtin_amdgcn_s_sleep(1); \
    if ((++_sp & 255u) == 0u) { if (xb_ld(&(bar)[XB_TMO])) break; if (_sp > XB_SPIN_CAP) { atomicAdd(&(bar)[XB_TMO], 1u); break; } } } } while (0)
struct XcdBarrier { unsigned* bar; unsigned x; volatile LAS unsigned* st; };
__device__ __forceinline__ XcdBarrier xcd_barrier_post(unsigned* bar, volatile LAS unsigned* st) {
    XcdBarrier b; b.bar = bar; b.x = xb_xcc_id(); b.st = st;
    if (threadIdx.x == 0) (void)xb_add(&bar[XB_XCNT(b.x)], 1u);
    return b;
}
__device__ __forceinline__ void xcd_barrier_complete(unsigned* bar, unsigned x, unsigned& nloc, unsigned& nx) {
    const unsigned G = gridDim.x * gridDim.y * gridDim.z;
    unsigned sum, cnt, mine, sp = 0u;
    for (;;) {
        sum = 0u; cnt = 0u; mine = 0u;
#pragma unroll
        for (unsigned j = 0; j < 16; ++j) { const unsigned c = xb_ld(&bar[XB_XCNT(j)]); sum += c; cnt += (c > 0u) ? 1u : 0u; mine = (j == x) ? c : mine; }
        if (sum == G) break;
        __builtin_amdgcn_s_sleep(1);
        if ((++sp & 255u) == 0u) { if (xb_ld(&bar[XB_TMO])) break; if (sp > XB_SPIN_CAP) { atomicAdd(&bar[XB_TMO], 1u); break; } }
    }
    nloc = mine > 0u ? mine : 1u; nx = cnt > 0u ? cnt : 1u;
}
__device__ __forceinline__ void xcd_barrier(const XcdBarrier& b) {
    asm volatile("s_waitcnt vmcnt(0)" ::: "memory");
    __syncthreads();
    if (threadIdx.x == 0) {
        unsigned* bar = b.bar;
        __builtin_amdgcn_s_waitcnt(0);
        unsigned nloc = b.st[0], nx = b.st[1];
        if (nloc == 0u) { xcd_barrier_complete(bar, b.x, nloc, nx); b.st[0] = nloc; b.st[1] = nx; }
        const unsigned old = xb_add(&bar[XB_XSUB(b.x)], 1u);
        const unsigned gen = old / nloc;
        if (old + 1u == (gen + 1u) * nloc) {
            __builtin_amdgcn_fence(__ATOMIC_RELEASE, "agent");
            asm volatile("s_waitcnt vmcnt(0)" ::: "memory");
            const unsigned og = xb_add(&bar[XB_TOP], 1u);
            const unsigned tg = og / nx;
            if (og + 1u == (tg + 1u) * nx) xb_add(&bar[XB_TOPGEN], 1u);
            else XB_SPIN(xb_ld(&bar[XB_TOPGEN]) == tg, bar);
            __builtin_amdgcn_fence(__ATOMIC_ACQUIRE, "agent");
            xb_add(&bar[XB_XGEN(b.x)], 1u);
            asm volatile("s_waitcnt vmcnt(0)" ::: "memory");
        } else {
            XB_SPIN(xb_ld(&bar[XB_XGEN(b.x)]) == gen, bar);
            __builtin_amdgcn_fence(__ATOMIC_ACQUIRE, "agent");
            asm volatile("s_waitcnt vmcnt(0)" ::: "memory");
        }
    }
    __syncthreads();
}

struct Args { const float* in[20]; float* out; unsigned char* ws; int ph_lo, ph_hi, li, pad; };
struct Frame {
    LAS unsigned char* lds;
    volatile LAS unsigned* MISC;
    int wave;
    int vcu, G;
    unsigned char* ws;
#define WSP(name, T, off) __device__ __forceinline__ T* name() const { return (T*)(ws + (off)); }
    WSP(WinT, bf16, WS_WIN) WSP(WaT, bf16, WS_WA) WSP(WbT, bf16, WS_WB) WSP(WoutT, bf16, WS_WOUT) WSP(W1T, bf16, WS_W1T)
    WSP(W2T, bf16, WS_SMALL + SM_W2T) WSP(LWA, bf16, WS_SMALL + SM_LWA) WSP(LWX, bf16, WS_SMALL + SM_LWX)
    WSP(C1, float, WS_SMALL + SM_C1) WSP(LUT, float, WS_SMALL + SM_LUT) WSP(SUMA, float, WS_SUM) WSP(SUMB, float, WS_SUM + 524288)
    WSP(KC, bf16, WS_KC) WSP(VC, bf16, WS_KC + 524288) WSP(XN, bf16, WS_XN) WSP(Q, bf16, WS_Q) WSP(KV, bf16, WS_KV) WSP(MB, bf16, WS_MB)
    WSP(VT, bf16, WS_VT) WSP(KT, bf16, WS_KT) WSP(Q2, bf16, WS_Q2) WSP(U, bf16, WS_U) WSP(BR, bf16, WS_BR) WSP(GN, bf16, WS_GN) WSP(GL, bf16, WS_GL) WSP(MG, bf16, WS_MG)
#undef WSP
};

__device__ __forceinline__ int t5_bucket(int n) {
    if (n < 16) return n;
    const int thr[15] = {19, 21, 24, 27, 31, 35, 40, 46, 52, 59, 67, 77, 87, 99, 113};
    int b = 16;
#pragma unroll
    for (int i = 0; i < 15; ++i) b += (n >= thr[i]) ? 1 : 0;
    return b;
}

__device__ __forceinline__ void p0_tr_item(const float* W, int ldw, int k0, int srccol0, int nvalid, bf16* WT, int ldt, int dstrow0, LAS float* scr, int lane) {
    const int c = lane & 31;
    float tv[32];
#pragma unroll
    for (int i = 0; i < 32; ++i) { const int kk = 2 * i + (lane >> 5); tv[i] = (c < nvalid) ? W[(size_t)(k0 + kk) * ldw + srccol0 + c] : 0.f; }
#pragma unroll
    for (int i = 0; i < 32; ++i) { const int kk = 2 * i + (lane >> 5); scr[kk * 33 + c] = tv[i]; }
    LDS_WAIT(); asm volatile("" ::: "memory");
    const int cc = lane & 7;
#pragma unroll
    for (int j = 0; j < 4; ++j) { const int n = (lane >> 3) + 8 * j; const LAS float* s = scr + (8 * cc) * 33 + n;
        u32x4 o; o.x = pk2(s[0 * 33], s[1 * 33]); o.y = pk2(s[2 * 33], s[3 * 33]); o.z = pk2(s[4 * 33], s[5 * 33]); o.w = pk2(s[6 * 33], s[7 * 33]);
        *(u32x4*)(WT + (size_t)(dstrow0 + n) * ldt + k0 + 8 * cc) = o; }
    LDS_WAIT(); asm volatile("" ::: "memory");
}
__device__ __forceinline__ void win_src(int n0, int& src, int& nvalid) {
    nvalid = 32;
    if (n0 < 1280) src = n0;
    else if (n0 < 1792) src = 1816 + (n0 - 1280);
    else if (n0 < 2048) { src = 1792 + (n0 - 1792); nvalid = (n0 == 1792) ? 24 : 0; if (n0 != 1792) src = 0; }
    else if (n0 < 2560) src = 1280 + (n0 - 2048);
    else if (n0 < 3072) src = 2328 + (n0 - 2560);
    else src = 2840 + (n0 - 3072);
}
__device__ __forceinline__ void p0_prologue(const Frame& F, const Args& A) {
    LAS float* scr = (LAS float*)(F.lds + F.wave * 16384);
    const int gw = F.vcu * NWAVES + F.wave, NGW = F.G * NWAVES, lane = lane_id();
    constexpr int I_WIN = 16 * 160, I_WA = 8 * 32, I_WO = 16 * 32, I_W1 = 32 * 8, I_W2 = 4 * 2, I_LR = 2;
    constexpr int NIT = I_WIN + 2 * I_WA + I_WO + 2 * I_W1 + 2 * I_W2 + 16 * I_LR + 256 + 1;
    for (int it = gw; it < NIT; it += NGW) {
        int r = it;
        if (r < I_WIN) { const int kb = r / 160, nb = r % 160; int src, nv; win_src(32 * nb, src, nv); p0_tr_item(A.in[2], 4888, 64 * kb, src, nv, F.WinT(), 1024, 32 * nb, scr, lane); continue; } r -= I_WIN;
        if (r < I_WA) { p0_tr_item(A.in[17], 1024, 64 * (r / 32), 32 * (r % 32), 32, F.WaT(), 512, 32 * (r % 32), scr, lane); continue; } r -= I_WA;
        if (r < I_WA) { p0_tr_item(A.in[18], 1024, 64 * (r / 32), 32 * (r % 32), 32, F.WbT(), 512, 32 * (r % 32), scr, lane); continue; } r -= I_WA;
        if (r < I_WO) { p0_tr_item(A.in[19], 1024, 64 * (r / 32), 32 * (r % 32), 32, F.WoutT(), 1024, 32 * (r % 32), scr, lane); continue; } r -= I_WO;
        if (r < 2 * I_W1) { const int kv = r / I_W1, q = r % I_W1; p0_tr_item(A.in[6] + (size_t)kv * 2048 * 256, 256, 64 * (q / 8), 32 * (q % 8), 32, F.W1T() + (size_t)kv * 256 * 2048, 2048, 32 * (q % 8), scr, lane); continue; } r -= 2 * I_W1;
        if (r < 2 * I_W2) { const int kv = r / I_W2, q = r % I_W2; p0_tr_item(A.in[8] + (size_t)kv * 256 * 64, 64, 64 * (q / 2), 32 * (q % 2), 32, F.W2T() + (size_t)kv * 64 * 256, 256, 32 * (q % 2), scr, lane); continue; } r -= 2 * I_W2;
        if (r < 16 * I_LR) { const int mtx = r / 2, nb = r % 2; const float* src = (mtx < 8 ? A.in[12] : A.in[14]) + (size_t)(mtx & 7) * 4096; bf16* dst = (mtx < 8 ? F.LWA() : F.LWX()) + (size_t)(mtx & 7) * 4096;
            p0_tr_item(src, 64, 0, 32 * nb, 32, dst, 64, 32 * nb, scr, lane); continue; } r -= 16 * I_LR;
        if (r < 256) {
            const int kc = r >> 3, kv = (r >> 2) & 1, n = (r & 3) * 64 + lane; const float* w1 = A.in[6] + (size_t)kv * 2048 * 256 + (size_t)(64 * kc) * 256 + n; const float* pe = A.in[5] + kv * 2048 + 64 * kc;
            float s0 = 0.f, s1 = 0.f, s2 = 0.f, s3 = 0.f;
#pragma unroll 4
            for (int k = 0; k < 64; k += 4) { s0 += pe[k] * w1[(size_t)k * 256]; s1 += pe[k + 1] * w1[(size_t)(k + 1) * 256]; s2 += pe[k + 2] * w1[(size_t)(k + 2) * 256]; s3 += pe[k + 3] * w1[(size_t)(k + 3) * 256]; }
            F.C1()[(kc * 2 + kv) * 256 + n] = (s0 + s1) + (s2 + s3); continue; } r -= 256;
        {
            for (int e = lane; e < 1024; e += 64) { const int hd = e >> 7, n = e & 127; F.LUT()[e] = A.in[9][t5_bucket(n) * 8 + hd] * LOG2E; }
        }
    }
    const float* gain = A.in[1];
    {
        f32x4 v[4], vn[4];
        if (gw < SEQ) { const f32x4* xr = (const f32x4*)(A.in[0] + (size_t)gw * DM) + lane;
#pragma unroll
            for (int j = 0; j < 4; ++j) v[j] = xr[64 * j]; }
        for (int m = gw; m < SEQ; m += NGW) {
            if (m + NGW < SEQ) { const f32x4* xr = (const f32x4*)(A.in[0] + (size_t)(m + NGW) * DM) + lane;
#pragma unroll
                for (int j = 0; j < 4; ++j) vn[j] = xr[64 * j]; }
            float s = 0.f;
#pragma unroll
            for (int j = 0; j < 4; ++j) s += (v[j].x * v[j].x + v[j].y * v[j].y) + (v[j].z * v[j].z + v[j].w * v[j].w);
            const float rs = 1.0f / sqrtf(wave_sum(s) * (1.f / DM) + RMS_EPS);
            unsigned long long* o8 = (unsigned long long*)(F.XN() + (size_t)m * DM) + lane;
#pragma unroll
            for (int j = 0; j < 4; ++j) { const f32x4 gv = ((const f32x4*)gain)[lane + 64 * j];
                o8[64 * j] = (unsigned long long)pk2(v[j].x * rs * gv.x, v[j].y * rs * gv.y) | ((unsigned long long)pk2(v[j].z * rs * gv.z, v[j].w * rs * gv.w) << 32); }
#pragma unroll
            for (int j = 0; j < 4; ++j) v[j] = vn[j];
        }
    }
}

template <bool FINAL>
__device__ __forceinline__ void lru_tile(const Frame& F, const Args& A, int tt) {
    const int lane = lane_id();
    const int w = F.wave, fr = lane & 15, fq = lane >> 4, ch0 = 64 * w, t0 = 64 * tt;
    LAS float* UC = (LAS float*)(F.lds + w * 16384);
#define UC_IDX(tok, ch) ((tok) * 64 + ((((ch) >> 2) ^ ((tok) & 15)) << 2) + ((ch) & 3))
    float Hc = 0.f;
    if (FINAL) {
        const float* sa = F.SUMA() + ch0 + lane; const float* sb = F.SUMB() + ch0 + lane;
        int i = 0;
        for (; i + 64 <= tt; i += 64) { float ta[64], tb[64];
#pragma unroll
            for (int k = 0; k < 64; ++k) { ta[k] = sa[(size_t)(i + k) * 512]; tb[k] = sb[(size_t)(i + k) * 512]; }
#pragma unroll
            for (int k = 0; k < 64; ++k) Hc = ta[k] * Hc + tb[k]; }
        for (; i + 16 <= tt; i += 16) { float ta[16], tb[16];
#pragma unroll
            for (int k = 0; k < 16; ++k) { ta[k] = sa[(size_t)(i + k) * 512]; tb[k] = sb[(size_t)(i + k) * 512]; }
#pragma unroll
            for (int k = 0; k < 16; ++k) Hc = ta[k] * Hc + tb[k]; }
        for (; i < tt; ++i) Hc = sa[(size_t)i * 512] * Hc + sb[(size_t)i * 512];
        asm volatile("" : "+v"(Hc));
    }
    {
        const int ch = ch0 + lane; const float* cw = A.in[10]; const float cb = A.in[11][ch];
        const float w0 = cw[ch], w1 = cw[512 + ch], w2 = cw[1024 + ch], w3 = cw[1536 + ch];
        const bf16* up = F.U() + (size_t)t0 * 512 + ch;
        float u0 = 0.f, u1 = 0.f, u2 = 0.f;
        if (tt > 0) { u0 = bf2f(up[-3 * 512]); u1 = bf2f(up[-2 * 512]); u2 = bf2f(up[-1 * 512]); }
        unsigned short ur[64];
#pragma unroll
        for (int tok = 0; tok < 64; ++tok) ur[tok] = up[(size_t)tok * 512];
#pragma unroll
        for (int tok = 0; tok < 64; ++tok) { const float u3 = bf2f(ur[tok]);
            UC[UC_IDX(tok, lane)] = cb + ((u0 * w0 + u1 * w1) + (u2 * w2 + u3 * w3)); u0 = u1; u1 = u2; u2 = u3; }
    }
    bf16x8 Ba[4][2], Bx[4][2];
#pragma unroll
    for (int nt = 0; nt < 4; ++nt)
#pragma unroll
        for (int ks = 0; ks < 2; ++ks) { const size_t o = (size_t)w * 4096 + (16 * nt + fr) * 64 + 32 * ks + 8 * fq; Ba[nt][ks] = *(const bf16x8*)(F.LWA() + o); Bx[nt][ks] = *(const bf16x8*)(F.LWX() + o); }
    float ba[4], bx[4], sp8[4], hin[4], acum[4];
#pragma unroll
    for (int nt = 0; nt < 4; ++nt) { const int ch = ch0 + 16 * nt + fr; ba[nt] = A.in[13][ch]; bx[nt] = A.in[15][ch];
        sp8[nt] = 8.0f * log1pf(expf(-A.in[16][ch])); hin[nt] = 0.f; acum[nt] = 1.f; }
    if (FINAL) {
#pragma unroll
        for (int nt = 0; nt < 4; ++nt) hin[nt] = __shfl(Hc, 16 * nt + fr);
    }
    LDS_WAIT();
    unsigned short glv[16], gln[16];
    if (FINAL) {
#pragma unroll
        for (int nt = 0; nt < 4; ++nt)
#pragma unroll
            for (int rg = 0; rg < 4; ++rg) glv[nt * 4 + rg] = F.GL()[(size_t)(t0 + 4 * fq + rg) * 512 + ch0 + 16 * nt + fr];
    }
#pragma unroll 1
    for (int mt = 0; mt < 4; ++mt) {
        if (FINAL && mt < 3) {
#pragma unroll
            for (int nt = 0; nt < 4; ++nt)
#pragma unroll
                for (int rg = 0; rg < 4; ++rg) gln[nt * 4 + rg] = F.GL()[(size_t)(t0 + 16 * (mt + 1) + 4 * fq + rg) * 512 + ch0 + 16 * nt + fr];
        }
        bf16x8 Af[2];
#pragma unroll
        for (int ks = 0; ks < 2; ++ks) { const int tok = 16 * mt + fr, c0 = 8 * ks + 2 * fq;
            const f32x4 x0 = *(const LAS f32x4*)(UC + tok * 64 + ((c0 ^ (tok & 15)) << 2)), x1 = *(const LAS f32x4*)(UC + tok * 64 + (((c0 + 1) ^ (tok & 15)) << 2));
            u32x4 pw; pw.x = cvtpk(x0[0], x0[1]); pw.y = cvtpk(x0[2], x0[3]); pw.z = cvtpk(x1[0], x1[1]); pw.w = cvtpk(x1[2], x1[3]); Af[ks] = __builtin_bit_cast(bf16x8, pw); }
        f32x4 cr[4], ci[4];
#pragma unroll
        for (int nt = 0; nt < 4; ++nt) { cr[nt] = (f32x4){0.f, 0.f, 0.f, 0.f}; ci[nt] = (f32x4){0.f, 0.f, 0.f, 0.f};
#pragma unroll
            for (int ks = 0; ks < 2; ++ks) { cr[nt] = __builtin_amdgcn_mfma_f32_16x16x32_bf16(Af[ks], Ba[nt][ks], cr[nt], 0, 0, 0); ci[nt] = __builtin_amdgcn_mfma_f32_16x16x32_bf16(Af[ks], Bx[nt][ks], ci[nt], 0, 0, 0); } }
#pragma unroll
        for (int nt = 0; nt < 4; ++nt) {
            float P[4], Hh[4];
#pragma unroll
            for (int rg = 0; rg < 4; ++rg) { const int tok = 16 * mt + 4 * fq + rg, e = 16 * nt + fr;
                const float ucv = UC[UC_IDX(tok, e)];
                const float r = fsigmoid(cr[nt][rg] + ba[nt]), ig = fsigmoid(ci[nt][rg] + bx[nt]);
                const float la = -r * sp8[nt]; const float a = __builtin_amdgcn_exp2f(la * LOG2E);
                const float x2 = 2.0f * la;
                const float ser = -x2 * (1.0f + x2 * (0.5f + x2 * (0.16666667f + x2 * (0.041666668f + x2 * 0.008333334f))));
                const float om = (x2 > -0.25f) ? ser : 1.0f - a * a;
                const float b = __builtin_amdgcn_sqrtf(om) * (ig * ucv);
                if (rg == 0) { P[0] = a; Hh[0] = b; } else { P[rg] = P[rg - 1] * a; Hh[rg] = a * Hh[rg - 1] + b; } }
            float At = P[3], Bt = Hh[3];
            { const float Ap = __shfl_up(At, 16), Bp = __shfl_up(Bt, 16); if (fq >= 1) { Bt = At * Bp + Bt; At = Ap * At; } }
            { const float Ap = __shfl_up(At, 32), Bp = __shfl_up(Bt, 32); if (fq >= 2) { Bt = At * Bp + Bt; At = Ap * At; } }
            float Aex = __shfl_up(At, 16), Bex = __shfl_up(Bt, 16); if (fq == 0) { Aex = 1.f; Bex = 0.f; }
            const float hg = Aex * hin[nt] + Bex;
            float hv[4];
#pragma unroll
            for (int rg = 0; rg < 4; ++rg) hv[rg] = P[rg] * hg + Hh[rg];
            hin[nt] = __shfl(hv[3], 48 + fr);
            if (!FINAL) acum[nt] *= __shfl(At, 48 + fr);
            if (FINAL) {
#pragma unroll
                for (int rg = 0; rg < 4; ++rg) { const size_t t = (size_t)(t0 + 16 * mt + 4 * fq + rg); const int ch = ch0 + 16 * nt + fr;
                    F.XN()[t * 1024 + 512 + ch] = (bf16)f2bf(hv[rg] * bf2f(glv[nt * 4 + rg])); }
            }
        }
        if (FINAL) {
#pragma unroll
            for (int x = 0; x < 16; ++x) glv[x] = gln[x];
        }
    }
    if (!FINAL && fq == 0) {
#pragma unroll
        for (int nt = 0; nt < 4; ++nt) { F.SUMA()[(size_t)tt * 512 + ch0 + 16 * nt + fr] = acum[nt]; F.SUMB()[(size_t)tt * 512 + ch0 + 16 * nt + fr] = hin[nt]; }
    }
    LDS_WAIT();
#undef UC_IDX
}

__device__ __forceinline__ void qk_norm_tile(const Frame& F, const Args& A, int tt) {
    const int lane = lane_id(), sub = lane & 7;
#pragma unroll 4
    for (int it = 0; it < 12; ++it) {
        const int idx = it * 64 + F.wave * 8 + (lane >> 3), tok = idx / 12, hr = idx % 12; const size_t t = (size_t)(64 * tt + tok);
        bf16* p; bf16* dst; const float* gain; float sc = 1.f;
        if (hr < 8) { p = F.Q() + t * 512 + hr * 64; dst = F.Q2() + t * 512 + (hr >> 2) * 256 + (sub >> 1) * 64 + (hr & 3) * 16 + (sub & 1) * 8 - sub * 8; gain = A.in[3]; sc = 0.125f * LOG2E; }
        else if (hr < 10) { p = F.KV() + t * 768 + 256 + (hr - 8) * 64; dst = p; gain = A.in[4] + 64; }
        else { p = F.KV() + t * 768 + 512 + (hr - 10) * 64; dst = p; gain = A.in[4] + 128; }
        const u32x4 w = *(const u32x4*)(p + sub * 8);
        float x[8] = {bflo(w.x), bfhi(w.x), bflo(w.y), bfhi(w.y), bflo(w.z), bfhi(w.z), bflo(w.w), bfhi(w.w)};
        float ss = 0.f;
#pragma unroll
        for (int j = 0; j < 8; ++j) ss += x[j] * x[j];
        ss += __shfl_xor(ss, 1); ss += __shfl_xor(ss, 2); ss += __shfl_xor(ss, 4);
        const float rs = sc / sqrtf(ss * (1.f / 64.f) + RMS_EPS);
        const f32x4 g0 = *(const f32x4*)(gain + sub * 8), g1 = *(const f32x4*)(gain + sub * 8 + 4);
        u32x4 o; o.x = pk2(x[0] * rs * g0.x, x[1] * rs * g0.y); o.y = pk2(x[2] * rs * g0.z, x[3] * rs * g0.w); o.z = pk2(x[4] * rs * g1.x, x[5] * rs * g1.y); o.w = pk2(x[6] * rs * g1.z, x[7] * rs * g1.w);
        *(u32x4*)(dst + sub * 8) = o;
        if (hr >= 8 && hr < 10) *(u32x4*)(F.KT() + ((size_t)((hr - 8) * 256 + tt) * 8 + sub) * 512 + tok * 8) = o;
    }
}

__device__ __forceinline__ void vt_tile(const Frame& F, int J) {
    const int tid = F.wave * 64 + lane_id(), d = tid & 63, ks = (tid >> 6) & 1, gp = tid >> 7;
#pragma unroll
    for (int g = 0; g < 2; ++g) {
        const bf16* vp = F.KV() + (size_t)(64 * J) * 768 + 384 + 64 * g + d;
        unsigned short e[8];
#pragma unroll
        for (int j = 0; j < 8; ++j) { const int key = 32 * ks + 4 * gp + (j & 3) + 16 * (j >> 2); e[j] = vp[(size_t)key * 768]; }
        u32x4 w; w.x = e[0] | ((unsigned)e[1] << 16); w.y = e[2] | ((unsigned)e[3] << 16); w.z = e[4] | ((unsigned)e[5] << 16); w.w = e[6] | ((unsigned)e[7] << 16);
        *(u32x4*)(F.VT() + (size_t)(g * 256 + J) * 4096 + ((((d >> 4) * 2 + ks) * 16 + (d & 15)) * 32) + 8 * gp) = w;
    }
}

__device__ __forceinline__ void compress_item(const Frame& F, const Args& A, int kv, int g, int ct) {
    const int lane = lane_id(), w = F.wave, tid = w * 64 + lane, fr = lane & 15, fq = lane >> 4, c0 = 16 * ct, tb = 16 * c0;
    LAS unsigned char* T = F.lds;
    LAS bf16* HID = (LAS bf16*)(F.lds + 34816);
    LAS float* OUTF = (LAS float*)(F.lds + 34816 + 8448);
    LAS float* C1L = (LAS float*)(F.lds + 34816 + 8448 + 4096);
    {
        u32x4 tv[5];
#pragma unroll
        for (int i = 0; i < 5; ++i) { const int idx = tid + 512 * i, tok = idx >> 3, chn = idx & 7, gt = tb + tok; tv[i] = (u32x4){0u, 0u, 0u, 0u};
            if (idx < 272 * 8 && gt < SEQ) tv[i] = *(const u32x4*)(F.KV() + (size_t)gt * 768 + kv * 128 + g * 64 + chn * 8); }
        { const int n = tid & 255, hf = tid >> 8; float pc[16];
#pragma unroll
            for (int k = 0; k < 16; ++k) pc[k] = F.C1()[((hf * 16 + k) * 2 + kv) * 256 + n];
            float s = hf ? 0.f : A.in[7][kv * 256 + n];
#pragma unroll
            for (int k = 0; k < 16; ++k) s += pc[k];
            C1L[hf * 256 + n] = s; }
#pragma unroll
        for (int i = 0; i < 5; ++i) { const int idx = tid + 512 * i, tok = idx >> 3, chn = idx & 7;
            if (idx < 272 * 8) *(LAS u32x4*)(T + tok * 128 + ((chn ^ ((tok >> 4) & 7)) << 4)) = tv[i]; }
    }
    LDS_WAIT(); __syncthreads();
    f32x4 acc[2] = {(f32x4){0.f, 0.f, 0.f, 0.f}, (f32x4){0.f, 0.f, 0.f, 0.f}};
    const bf16* w1t = F.W1T() + (size_t)kv * 256 * 2048 + (size_t)(32 * w + fr) * 2048 + 8 * fq;
#pragma unroll 32
    for (int ks = 0; ks < 64; ++ks) {
        const int tok = 16 * fr + (ks >> 1), chn = 4 * (ks & 1) + fq;
        const bf16x8 a = *(const LAS bf16x8*)(T + tok * 128 + ((chn ^ ((tok >> 4) & 7)) << 4));
        const bf16x8 b0 = *(const bf16x8*)(w1t + 32 * ks), b1 = *(const bf16x8*)(w1t + (size_t)16 * 2048 + 32 * ks);
        acc[0] = __builtin_amdgcn_mfma_f32_16x16x32_bf16(a, b0, acc[0], 0, 0, 0);
        acc[1] = __builtin_amdgcn_mfma_f32_16x16x32_bf16(a, b1, acc[1], 0, 0, 0);
    }
#pragma unroll
    for (int nt = 0; nt < 2; ++nt) { const int n = 32 * w + 16 * nt + fr; const float c1 = C1L[n] + C1L[256 + n];
#pragma unroll
        for (int rg = 0; rg < 4; ++rg) { const float v = acc[nt][rg] + c1; HID[(4 * fq + rg) * 264 + n] = (bf16)f2bf(v * fsigmoid(v)); } }
    LDS_WAIT(); __syncthreads();
    if (w < 4) {
        f32x4 o = (f32x4){0.f, 0.f, 0.f, 0.f};
        const bf16* w2t = F.W2T() + (size_t)kv * 64 * 256 + (size_t)(16 * w + fr) * 256 + 8 * fq;
#pragma unroll
        for (int ks = 0; ks < 8; ++ks) { const bf16x8 a = *(const LAS bf16x8*)(HID + fr * 264 + 32 * ks + 8 * fq); const bf16x8 b = *(const bf16x8*)(w2t + 32 * ks);
            o = __builtin_amdgcn_mfma_f32_16x16x32_bf16(a, b, o, 0, 0, 0); }
#pragma unroll
        for (int rg = 0; rg < 4; ++rg) OUTF[(4 * fq + rg) * 64 + 16 * w + fr] = o[rg];
    }
    LDS_WAIT(); __syncthreads();
    {
        const int row = tid >> 5, e = 2 * (tid & 31), c = c0 + row;
        float v0 = OUTF[row * 64 + e], v1 = OUTF[row * 64 + e + 1];
        if (kv == 0) { float ss = v0 * v0 + v1 * v1;
#pragma unroll
            for (int o = 1; o < 32; o <<= 1) ss += __shfl_xor(ss, o);
            const float rs = 1.0f / sqrtf(ss * (1.f / 64.f) + RMS_EPS); v0 *= rs * A.in[4][e]; v1 *= rs * A.in[4][e + 1]; }
        if (c >= 1023) { v0 = 0.f; v1 = 0.f; }
        bf16* dst = (kv == 0 ? F.KC() : F.VC()) + ((size_t)g * 1024 + c) * 64 + e;
        *(unsigned*)dst = pk2(v0, v1);
    }
    LDS_WAIT(); __syncthreads();
}

namespace att {
constexpr int SLOTB = 8192, NSLOT = 3;
constexpr int L_K = 0, L_V = NSLOT * SLOTB, L_SC = 2 * NSLOT * SLOTB, L_OUT = L_SC + 65536, L_LUT = L_OUT + 32768, L_WSF = L_LUT + 2048, L_BM = L_WSF + 2048, L_REF = L_BM + 2048, L_LACC = L_REF + 1024, L_TL = L_LACC + 1024  , L_END = L_TL + 5120;
static_assert(L_END <= RING_BYTES, "attention LDS map");
constexpr int L_EX = 0  , L_HDR = 34816  , L_LEX = 35072  , L_NT = 36096  ;
constexpr float CLAMP = 100.0f;
constexpr float THR = 8.0f;
#define SBAR() __builtin_amdgcn_sched_barrier(0)
__device__ __forceinline__ int crow(int r, int hi) { return (r & 3) + 8 * (r >> 2) + 4 * hi; }
__device__ __forceinline__ void glds16(const void* gsrc, unsigned lds_dst) { unsigned keep;
    asm volatile("s_mov_b32 %0, m0\n\ts_mov_b32 m0, %2\n\ts_nop 0\n\tglobal_load_lds_dwordx4 %1, off\n\ts_mov_b32 m0, %0" : "=&s"(keep) : "v"(gsrc), "s"(lds_dst) : "memory"); }
__device__ __forceinline__ void qkt(f32x16& p0, f32x16& p1, const LAS unsigned char* Kslot, const bf16x8* qr, int r32, int hi) {
    const LAS unsigned char* kb = Kslot + hi * 1024 + r32 * 16;
    const f32x16 z = {0.f, 0.f, 0.f, 0.f, 0.f, 0.f, 0.f, 0.f, 0.f, 0.f, 0.f, 0.f, 0.f, 0.f, 0.f, 0.f};
#pragma unroll
    for (int d0 = 0; d0 < 4; ++d0) {
        const bf16x8 b0 = *(const LAS bf16x8*)(kb + d0 * 2048);
        const bf16x8 b1 = *(const LAS bf16x8*)(kb + d0 * 2048 + 512);
        if (d0 == 0) { p0 = __builtin_amdgcn_mfma_f32_32x32x16_bf16(b0, qr[0], z, 0, 0, 0); p1 = __builtin_amdgcn_mfma_f32_32x32x16_bf16(b1, qr[0], z, 0, 0, 0); }
        else { p0 = __builtin_amdgcn_mfma_f32_32x32x16_bf16(b0, qr[d0], p0, 0, 0, 0); p1 = __builtin_amdgcn_mfma_f32_32x32x16_bf16(b1, qr[d0], p1, 0, 0, 0); } }
}
__device__ __forceinline__ void pv(f32x16* o, int vb, bf16x8 pa0, bf16x8 pa1, bf16x8 pa2, bf16x8 pa3) {
    s16x4 lo[8], hi[8];
#pragma unroll
    for (int x = 0; x < 8; ++x) {
        asm volatile("ds_read_b64_tr_b16 %0,%1 offset:%c2" : "=&v"(lo[x]) : "v"(vb), "i"((x >> 2) * 4096 + (x & 3) * 1024) : "memory");
        asm volatile("ds_read_b64_tr_b16 %0,%1 offset:%c2" : "=&v"(hi[x]) : "v"(vb), "i"((x >> 2) * 4096 + (x & 3) * 1024 + 512) : "memory"); }
    asm volatile("s_waitcnt lgkmcnt(0)" ::: "memory"); SBAR();
#define PK(k) (bf16x8){lo[k][0], lo[k][1], lo[k][2], lo[k][3], hi[k][0], hi[k][1], hi[k][2], hi[k][3]}
    o[0] = __builtin_amdgcn_mfma_f32_32x32x16_bf16(pa0, PK(0), o[0], 0, 0, 0); o[1] = __builtin_amdgcn_mfma_f32_32x32x16_bf16(pa0, PK(4), o[1], 0, 0, 0);
    o[0] = __builtin_amdgcn_mfma_f32_32x32x16_bf16(pa1, PK(1), o[0], 0, 0, 0); o[1] = __builtin_amdgcn_mfma_f32_32x32x16_bf16(pa1, PK(5), o[1], 0, 0, 0);
    o[0] = __builtin_amdgcn_mfma_f32_32x32x16_bf16(pa2, PK(2), o[0], 0, 0, 0); o[1] = __builtin_amdgcn_mfma_f32_32x32x16_bf16(pa2, PK(6), o[1], 0, 0, 0);
    o[0] = __builtin_amdgcn_mfma_f32_32x32x16_bf16(pa3, PK(3), o[0], 0, 0, 0); o[1] = __builtin_amdgcn_mfma_f32_32x32x16_bf16(pa3, PK(7), o[1], 0, 0, 0);
#undef PK
}
__device__ __forceinline__ float rowmax(const f32x16& p0, const f32x16& p1) {
    float a = fmaxf(fmaxf(p0[0], p0[1]), p1[0]), b = fmaxf(fmaxf(p0[2], p0[3]), p1[1]); a = fmaxf(fmaxf(a, p1[2]), p1[3]);
#pragma unroll
    for (int r = 4; r < 16; r += 4) { a = fmaxf(fmaxf(a, p0[r]), p0[r + 1]); b = fmaxf(fmaxf(b, p0[r + 2]), p0[r + 3]); a = fmaxf(fmaxf(a, p1[r]), p1[r + 1]); b = fmaxf(fmaxf(b, p1[r + 2]), p1[r + 3]); }
    const float m = fmaxf(a, b);
    auto rr = __builtin_amdgcn_permlane32_swap(__float_as_uint(m), __float_as_uint(m), false, false);
    return fmaxf(__uint_as_float(rr[0]), __uint_as_float(rr[1]));
}
__device__ __forceinline__ float halfsum(float v) { auto rr = __builtin_amdgcn_permlane32_swap(__float_as_uint(v), __float_as_uint(v), false, false); return __uint_as_float(rr[0]) + __uint_as_float(rr[1]); }
template <int STEP, unsigned LIMIT>
__device__ __forceinline__ void near_apply(f32x16& p0, f32x16& p1, int dbase, const LAS float* lut) {
    float b0[16], b1[16];
#pragma unroll
    for (int r = 0; r < 16; ++r) { const int koff = (r & 3) + 8 * (r >> 2); const int d0 = dbase - STEP * koff, d1 = d0 - STEP * 32;
        b0[r] = lut[4 * min(max(d0, 0), 127)]; b1[r] = lut[4 * min(max(d1, 0), 127)]; }
#pragma unroll
    for (int r = 0; r < 16; ++r) { asm volatile("" : "+v"(b0[r]), "+v"(b1[r])); }
#pragma unroll
    for (int r = 0; r < 16; ++r) { const int koff = (r & 3) + 8 * (r >> 2); const int d0 = dbase - STEP * koff, d1 = d0 - STEP * 32;
        const float t0 = p0[r] + b0[r], t1 = p1[r] + b1[r];
        p0[r] = ((unsigned)d0 < LIMIT) ? t0 : -INFINITY; p1[r] = ((unsigned)d1 < LIMIT) ? t1 : -INFINITY; }
}
template <bool HASO>
__device__ __forceinline__ void sm_update(f32x16& p0, f32x16& p1, float bias, float& m, float& l, f32x16* o, LAS float* wsf, int r32, int hi) {
    const float rm = rowmax(p0, p1) + bias;
    const bool need = rm > m + THR;
    if (__any(need)) {
        const float mn = need ? rm : m; const float alpha = __builtin_amdgcn_exp2f(m - mn);
        l *= alpha; m = mn;
        if (HASO) { if (hi == 0) wsf[r32] = alpha; LDS_WAIT();
#pragma unroll
            for (int r = 0; r < 16; ++r) { const float f = wsf[crow(r, hi)]; o[0][r] *= f; o[1][r] *= f; } }
    }
    const float mb = m - bias;
#pragma unroll
    for (int r = 0; r < 16; ++r) { p0[r] = __builtin_amdgcn_exp2f(p0[r] - mb); p1[r] = __builtin_amdgcn_exp2f(p1[r] - mb); }
    float t[8];
#pragma unroll
    for (int r = 0; r < 8; ++r) t[r] = (p0[2 * r] + p0[2 * r + 1]) + (p1[2 * r] + p1[2 * r + 1]);
    l += ((t[0] + t[1]) + (t[2] + t[3])) + ((t[4] + t[5]) + (t[6] + t[7]));
}
#define ATT_PACK(P0, P1) \
    const bf16x8 pa0 = __builtin_bit_cast(bf16x8, (u32x4){cvtpk(P0[0], P0[1]), cvtpk(P0[2], P0[3]), cvtpk(P0[4], P0[5]), cvtpk(P0[6], P0[7])}); \
    const bf16x8 pa1 = __builtin_bit_cast(bf16x8, (u32x4){cvtpk(P0[8], P0[9]), cvtpk(P0[10], P0[11]), cvtpk(P0[12], P0[13]), cvtpk(P0[14], P0[15])}); \
    const bf16x8 pa2 = __builtin_bit_cast(bf16x8, (u32x4){cvtpk(P1[0], P1[1]), cvtpk(P1[2], P1[3]), cvtpk(P1[4], P1[5]), cvtpk(P1[6], P1[7])}); \
    const bf16x8 pa3 = __builtin_bit_cast(bf16x8, (u32x4){cvtpk(P1[8], P1[9]), cvtpk(P1[10], P1[11]), cvtpk(P1[12], P1[13]), cvtpk(P1[14], P1[15])});
#define ATT_WAITBAR(N) asm volatile("s_waitcnt vmcnt(" #N ") lgkmcnt(0)\n\ts_barrier" ::: "memory")
#define ATT_FILL(V, x) do { _Pragma("unroll") for (int _r = 0; _r < 16; ++_r) V[_r] = (x); } while (0)

__device__ __forceinline__ unsigned rangemask(int k, int a, int b) {
    const int lo = max(a - 32 * k, 0), hi = min(b - 32 * k, 31);
    return (lo > hi) ? 0u : ((0xFFFFFFFFu >> (31 - hi)) & (0xFFFFFFFFu << lo));
}
__device__ __forceinline__ int wave_max_i32(int x) {
    x = max(x, dpp_i<0xB1>(x)); x = max(x, dpp_i<0x4E>(x)); x = max(x, dpp_i<0x141>(x)); x = max(x, dpp_i<0x140>(x));
    return max(max(__builtin_amdgcn_readlane(x, 0), __builtin_amdgcn_readlane(x, 16)), max(__builtin_amdgcn_readlane(x, 32), __builtin_amdgcn_readlane(x, 48)));
}

__device__ __forceinline__ void lds_add_f32(LAS float* p, float v) { (void)__hip_atomic_fetch_add(p, v, __ATOMIC_RELAXED, __HIP_MEMORY_SCOPE_WORKGROUP); }

__device__ __forceinline__ void attn_item(const Frame& F, int qt, int g) {
    const int lane = lane_id(), wid = F.wave, tid = wid * 64 + lane, r32 = lane & 31, hi = lane >> 5;
    const int ql = r32 >> 2, h = r32 & 3, cur = qt, t = 64 * qt + 8 * wid + ql, head = 4 * g + h;
    LAS unsigned char* shm = F.lds;
    const unsigned lds0 = (unsigned)(uintptr_t)shm;
    LAS float* wsf = (LAS float*)(shm + L_WSF) + wid * 64;
    LAS float* SC = (LAS float*)(shm + L_SC);
    LAS float* OACC = (LAS float*)(shm + L_SC);
    LAS float* lutl = (LAS float*)(shm + L_LUT);
    const LAS float* luth = lutl + h;
    LAS unsigned* BM = (LAS unsigned*)(shm + L_BM);
    LAS float* REF = (LAS float*)(shm + L_REF);
    LAS float* LACC = (LAS float*)(shm + L_LACC);
    lutl[4 * (tid & 127) + (tid >> 7)] = F.LUT()[(4 * g + (tid >> 7)) * 128 + (tid & 127)];
    BM[tid] = 0u;
    LAS bf16* QL = (LAS bf16*)(shm + L_OUT);
#pragma unroll
    for (int i = 0; i < 4; ++i) { const int chn = tid + 512 * i;
        *(LAS u32x4*)(QL + (chn >> 5) * 256 + (chn & 31) * 8) = *(const u32x4*)(F.Q2() + (size_t)(64 * qt + (chn >> 5)) * 512 + g * 256 + (chn & 31) * 8); }
    bf16x8 qr[4];
    { const bf16* qp = F.Q2() + (size_t)t * 512 + g * 256 + h * 16 + hi * 8;
#pragma unroll
        for (int d0 = 0; d0 < 4; ++d0) qr[d0] = *(const bf16x8*)(qp + d0 * 64); }
    const float b31 = F.LUT()[head * 128 + 127];
    const float gate_c = fsigmoid(bf2f(F.BR()[(size_t)t * 256 + head])), gate_s = fsigmoid(bf2f(F.BR()[(size_t)t * 256 + 8 + head])), gate_w = fsigmoid(bf2f(F.BR()[(size_t)t * 256 + 16 + head]));
    f32x16 o[2], p0, p1;
    const unsigned kdst = lds0 + L_K + wid * 1024, vdst = lds0 + L_V + wid * 1024;
    const int vrow = 16 * (wid & 3) + (lane >> 2), vcol = (wid >> 2) * 32 + (lane & 3) * 8;
    const int vb0 = (int)(lds0 + L_V) + ((lane >> 4) & 1) * 32 + (lane & 3) * 8 + (4 * hi + ((lane & 15) >> 2)) * 64;
#define DMA_K(base, pitch, row0, slot) glds16((base) + (size_t)((row0) + lane) * (pitch) + wid * 8, (unsigned)__builtin_amdgcn_readfirstlane(kdst + (slot)))
#define DMA_V(base, pitch, row0, slot) glds16((base) + (size_t)((row0) + vrow) * (pitch) + vcol, (unsigned)__builtin_amdgcn_readfirstlane(vdst + (slot)))
#define ROT() do { sl_cur = sl_next; sl_next = (sl_next == (NSLOT - 1) * SLOTB) ? 0 : sl_next + SLOTB; } while (0)
    VM_WAIT(); LDS_WAIT(); __syncthreads();

    const bf16* KCg = F.KC() + (size_t)g * 1024 * 64; const bf16* VCg = F.VC() + (size_t)g * 1024 * 64;
    const int nkt = (qt >> 4) + 1;
    const int tminw = 64 * qt + 8 * wid;
    float m = -1e30f, l = 0.f;
    {
        int sl_cur = 0, sl_next = SLOTB;
        DMA_K(KCg, 64, 0, 0);
        for (int kt = 0; kt < nkt; ++kt) {
            if (kt + 1 < nkt) { DMA_K(KCg, 64, 64 * (kt + 1), sl_next); ATT_WAITBAR(1); } else { ATT_WAITBAR(0); }
            const bool far = (tminw - 31 - 16 * (64 * kt + 63)) >= 128;
            qkt(p0, p1, shm + L_K + sl_cur, qr, r32, hi);
            if (!far) near_apply<16, 0x80000000u>(p0, p1, t - 31 - 16 * (64 * kt + 4 * hi), luth);
            sm_update<false>(p0, p1, far ? b31 : 0.f, m, l, o, wsf, r32, hi);
            ROT();
        }
        LDS_WAIT(); __builtin_amdgcn_s_barrier();
    }
    {
        const float lt = halfsum(l); const float rl = lt > 0.f ? 1.0f / lt : 0.f;
        ATT_FILL(o[0], 0.f); ATT_FILL(o[1], 0.f);
        float carry = 0.f;
        int sl_cur = 0, sl_next = SLOTB;
        DMA_K(KCg, 64, 0, 0); DMA_V(VCg, 64, 0, 0);
        for (int kt = 0; kt < nkt; ++kt) {
            if (kt + 1 < nkt) { DMA_K(KCg, 64, 64 * (kt + 1), sl_next); DMA_V(VCg, 64, 64 * (kt + 1), sl_next); ATT_WAITBAR(2); } else { ATT_WAITBAR(0); }
            const bool far = (tminw - 31 - 16 * (64 * kt + 63)) >= 128;
            qkt(p0, p1, shm + L_K + sl_cur, qr, r32, hi);
            if (!far) near_apply<16, 0x80000000u>(p0, p1, t - 31 - 16 * (64 * kt + 4 * hi), luth);
            const float mb2 = far ? m - b31 : m;
#pragma unroll
            for (int r = 0; r < 16; ++r) { p0[r] = __builtin_amdgcn_exp2f(p0[r] - mb2) * rl; p1[r] = __builtin_amdgcn_exp2f(p1[r] - mb2) * rl; }
            {
                float q4[8], e[8];
#pragma unroll
                for (int i = 0; i < 4; ++i) { q4[i] = (p0[4 * i] + p0[4 * i + 1]) + (p0[4 * i + 2] + p0[4 * i + 3]); e[i] = p0[4 * i + 3];
                                              q4[4 + i] = (p1[4 * i] + p1[4 * i + 1]) + (p1[4 * i + 2] + p1[4 * i + 3]); e[4 + i] = p1[4 * i + 3]; }
                float newcarry = 0.f;
#pragma unroll
                for (int i = 0; i < 8; ++i) { auto rr = __builtin_amdgcn_permlane32_swap(__float_as_uint(e[i]), __float_as_uint(e[i]), false, false);
                    const float elo = __uint_as_float(rr[0]), ehi = __uint_as_float(rr[1]);
                    if (hi) q4[i] += elo; else if (i < 7) q4[i + 1] += ehi;
                    if (i == 7) newcarry = ehi; }
                if (!hi) q4[0] += carry;
                carry = newcarry;
#pragma unroll
                for (int i = 0; i < 8; ++i) { float v = q4[i]; v += dpp_f<0xB1>(v); v += dpp_f<0x4E>(v); q4[i] = v; }
                if (h == 0) {
#pragma unroll
                    for (int i = 0; i < 8; ++i) SC[(8 * wid + ql) * 256 + 16 * kt + 2 * i + hi] = q4[i]; }
            }
            { ATT_PACK(p0, p1); pv(o, vb0 + sl_cur, pa0, pa1, pa2, pa3); }
            ROT();
        }
        LDS_WAIT(); __builtin_amdgcn_s_barrier();
    }

    if (cur >= 16) {
        const int u4 = lane >> 4, li16 = lane & 15;
#pragma unroll 1
        for (int qb = 0; qb < 8; qb += 4) {
            const int qloc = 8 * wid + qb + u4;
            const LAS float* row = SC + qloc * 256 + li16;
            int v[16];
#pragma unroll
            for (int k = 0; k < 16; ++k) { const int J = li16 + 16 * k; const int x = (__float_as_int(row[16 * k]) & ~255) | (255 - J); v[k] = (J >= 1 && J <= cur - 2) ? x : -1; }
            LAS unsigned* bmq = BM + (qloc >> 5); const unsigned qbit = 1u << (qloc & 31);
#pragma unroll 1
            for (int round = 0; round < 13; ++round) {
                int lm = max(max(max(v[0], v[1]), max(v[2], v[3])), max(max(v[4], v[5]), max(v[6], v[7])));
                lm = max(lm, max(max(max(v[8], v[9]), max(v[10], v[11])), max(max(v[12], v[13]), max(v[14], v[15]))));
                int rm = lm; rm = max(rm, dpp_i<0xB1>(rm)); rm = max(rm, dpp_i<0x4E>(rm)); rm = max(rm, dpp_i<0x141>(rm)); rm = max(rm, dpp_i<0x140>(rm));
                if (lm == rm) {
#pragma unroll
                    for (int k = 0; k < 16; ++k) v[k] = (v[k] == rm) ? -1 : v[k];
                    __hip_atomic_fetch_or(bmq + 2 * (255 - (rm & 255)), qbit, __ATOMIC_RELAXED, __HIP_MEMORY_SCOPE_WORKGROUP);
                }
            }
        }
    }
    LDS_WAIT();
    LAS float* ostg = (LAS float*)(shm + L_SC) + wid * 2048;
    {
        if (hi == 0) wsf[r32] = gate_c; LDS_WAIT();
#pragma unroll
        for (int r = 0; r < 16; ++r) { const float f = wsf[crow(r, hi)]; const int orow = crow(r, hi); ostg[orow * 64 + r32] = o[0][r] * f; ostg[orow * 64 + 32 + r32] = o[1][r] * f; }
    }

    const bf16* Kw = F.KV() + 512 + g * 64; const bf16* Vw = F.KV() + 640 + g * 64;
    {
        m = -1e30f; l = 0.f; ATT_FILL(o[0], 0.f); ATT_FILL(o[1], 0.f);
        const int J0 = max(cur - 8, 0);
        int sl_cur = 0, sl_next = SLOTB;
        DMA_K(Kw, 768, 64 * J0, 0); DMA_V(Vw, 768, 64 * J0, 0);
        for (int J = J0; J <= cur; ++J) {
            if (J + 1 <= cur) { DMA_K(Kw, 768, 64 * (J + 1), sl_next); DMA_V(Vw, 768, 64 * (J + 1), sl_next); ATT_WAITBAR(2); } else { ATT_WAITBAR(0); }
            const bool nearw = (J >= cur - 2 || J == cur - 8);
            qkt(p0, p1, shm + L_K + sl_cur, qr, r32, hi);
            if (nearw) near_apply<1, 512u>(p0, p1, t - 64 * J - 4 * hi, luth);
            sm_update<true>(p0, p1, nearw ? 0.f : b31, m, l, o, wsf, r32, hi);
            { ATT_PACK(p0, p1); pv(o, vb0 + sl_cur, pa0, pa1, pa2, pa3); }
            ROT();
        }
        LDS_WAIT(); __builtin_amdgcn_s_barrier();
        const float lt = halfsum(l); const float fw = lt > 0.f ? gate_w / lt : 0.f;
        if (hi == 0) wsf[r32] = fw; LDS_WAIT();
#pragma unroll
        for (int r = 0; r < 16; ++r) { const float f = wsf[crow(r, hi)]; const int orow = crow(r, hi); ostg[orow * 64 + r32] += o[0][r] * f; ostg[orow * 64 + 32 + r32] += o[1][r] * f; }
        LDS_WAIT();
#pragma unroll
        for (int i = 0; i < 4; ++i) { const int rowl = i * 8 + (lane >> 3), chn = lane & 7;
            const f32x4 a0 = *(const LAS f32x4*)(ostg + rowl * 64 + chn * 8), a1 = *(const LAS f32x4*)(ostg + rowl * 64 + chn * 8 + 4);
            const size_t tt = (size_t)(64 * qt + 8 * wid + (rowl >> 2)); const int col = (4 * g + (rowl & 3)) * 64 + chn * 8;
            *(u32x4*)(F.XN() + tt * 1024 + col) = (u32x4){cvtpk(a0[0], a0[1]), cvtpk(a0[2], a0[3]), cvtpk(a1[0], a1[1]), cvtpk(a1[2], a1[3])}; }
        LDS_WAIT();
    }

    const bf16* Ks = F.KV() + 256 + g * 64; const bf16* Vs = F.KV() + 384 + g * 64;
    {
        m = -1e30f; l = 0.f; ATT_FILL(o[0], 0.f); ATT_FILL(o[1], 0.f);
        const int nA = (cur < 16) ? cur + 1 : 3;
#define JA(i) ((cur < 16) ? (i) : ((i) == 0 ? 0 : cur - 2 + (i)))
        int sl_cur = 0, sl_next = SLOTB;
        DMA_K(Ks, 768, 0, 0); DMA_V(Vs, 768, 0, 0);
        for (int i = 0; i < nA; ++i) {
            const int J = JA(i);
            if (i + 1 < nA) { const int Jn = JA(i + 1); DMA_K(Ks, 768, 64 * Jn, sl_next); DMA_V(Vs, 768, 64 * Jn, sl_next); ATT_WAITBAR(2); } else { ATT_WAITBAR(0); }
            const bool neara = (J >= cur - 2);
            qkt(p0, p1, shm + L_K + sl_cur, qr, r32, hi);
            if (neara) near_apply<1, 0x80000000u>(p0, p1, t - 64 * J - 4 * hi, luth);
            sm_update<true>(p0, p1, neara ? 0.f : b31, m, l, o, wsf, r32, hi);
            { ATT_PACK(p0, p1); pv(o, vb0 + sl_cur, pa0, pa1, pa2, pa3); }
            ROT();
        }
#undef JA
        LDS_WAIT(); __builtin_amdgcn_s_barrier();
        const float lt = halfsum(l);
        if (hi == 0) { REF[32 * wid + r32] = m; LACC[32 * wid + r32] = lt; }
#pragma unroll
        for (int r = 0; r < 16; ++r) { const int orow = 32 * wid + crow(r, hi); OACC[orow * 64 + r32] = o[0][r]; OACC[orow * 64 + 32 + r32] = o[1][r]; }
        LDS_WAIT(); __builtin_amdgcn_s_barrier();
    }

    if (cur >= 16) {
        const int c16 = lane & 15, gq = lane >> 4, qi4 = c16 >> 2;
        const bf16* KTg = F.KT() + (size_t)g * 256 * 4096 + gq * 512 + c16 * 8; const bf16* VTg = F.VT() + (size_t)g * 256 * 4096 + c16 * 32 + 8 * gq;
        const LAS bf16* QLg = QL + (gq >> 1) * 64 + h * 16 + 8 * (gq & 1);
        LAS unsigned* TL = (LAS unsigned*)(shm + L_TL) + wid * 160;
        int ntask = 0;
#pragma unroll 1
        for (int i4 = 0; i4 < 4; ++i4) {
            const int Jl = lane + 64 * i4; int nch = 0;
            unsigned long long mk = 0ull;
            if (Jl >= 1 && Jl <= cur - 2 && (Jl & 7) == wid) { mk = ((unsigned long long)BM[2 * Jl + 1] << 32) | BM[2 * Jl]; nch = (__popcll(mk) + 3) >> 2; }
            int incl = nch;
#pragma unroll
            for (int o = 1; o < 64; o <<= 1) { const int up = __shfl_up(incl, o); if (lane >= o) incl += up; }
            const int base = ntask + incl - nch;
            for (int c = 0; c < nch; ++c) { unsigned e = (unsigned)Jl; int q0 = 0;
#pragma unroll
                for (int k = 0; k < 4; ++k) { int q = q0; if (mk) { q = __builtin_ctzll(mk); mk &= mk - 1; } if (k == 0) q0 = q; e |= (unsigned)q << (8 + 6 * k); }
                if (base + c < 160) TL[base + c] = e; }
            ntask += __shfl(incl, 63);
        }
        ntask = min(ntask, 160);
        LAS bf16* EX = (LAS bf16*)(shm + L_EX); LAS int* HDR = (LAS int*)(shm + L_HDR); LAS float* LEX = (LAS float*)(shm + L_LEX); LAS int* NT = (LAS int*)(shm + L_NT);
        if (lane == 0) NT[wid] = ntask;
        LDS_WAIT(); __builtin_amdgcn_s_barrier();
        int nround = 0;
#pragma unroll
        for (int k = 0; k < 8; ++k) nround = max(nround, __builtin_amdgcn_readfirstlane(NT[k]));
        bf16x8 kfC[8], vfC[8];
#define LOADK(J_, KF) do { const bf16* kp_ = KTg + (size_t)(J_) * 4096; \
            _Pragma("unroll") for (int kt = 0; kt < 4; ++kt) { KF[2 * kt] = *(const bf16x8*)(kp_ + kt * 128); KF[2 * kt + 1] = *(const bf16x8*)(kp_ + 2048 + kt * 128); } } while (0)
#define LOADV(J_, VF) do { const bf16* vp_ = VTg + (size_t)(J_) * 4096; _Pragma("unroll") for (int x = 0; x < 8; ++x) VF[x] = *(const bf16x8*)(vp_ + x * 512); } while (0)
        unsigned e_cur = 0xffu;
        bf16x8 qg0 = {0, 0, 0, 0, 0, 0, 0, 0}, qg1 = {0, 0, 0, 0, 0, 0, 0, 0}; float ref = 0.f;
#define QFETCH(E) do { const int mq_ = ((E) >> (8 + 6 * qi4)) & 63; const LAS bf16* qp_ = QLg + mq_ * 256; qg0 = *(const LAS bf16x8*)(qp_); qg1 = *(const LAS bf16x8*)(qp_ + 128); ref = REF[4 * mq_ + h]; } while (0)
        if (ntask > 0) { e_cur = (unsigned)__builtin_amdgcn_readfirstlane((int)TL[0]); LOADK(e_cur & 255u, kfC); LOADV(e_cur & 255u, vfC); QFETCH(e_cur); }
        float oa[2][16], la2[2];
#pragma unroll
        for (int p = 0; p < 2; ++p) { la2[p] = 0.f;
#pragma unroll
            for (int k = 0; k < 16; ++k) oa[p][k] = 0.f; }
#pragma unroll 1
        for (int n = 0; n < nround; ++n) {
            const int buf = n & 1;
            if (n < ntask) {
                const unsigned e_nxt = (n + 1 < ntask) ? (unsigned)__builtin_amdgcn_readfirstlane((int)TL[n + 1]) : 0xffu;
                const unsigned e_ = e_cur; const int Jb = e_ & 255, Jn = e_nxt & 255; const bool reload = (Jn != Jb) && (Jn != 255);
                const int q0_ = (e_ >> 8) & 63;
                const int myq = (e_ >> (8 + 6 * qi4)) & 63; const bool valid = (qi4 == 0) || (myq != q0_); const int tq = 64 * qt + myq;
                const bool nearJ = (Jb >= cur - 2);
                const float cinit = nearJ ? 0.f : (valid ? b31 - ref : -INFINITY);
                f32x4 s[4];
#pragma unroll
                for (int kt = 0; kt < 4; ++kt) { s[kt] = (f32x4){cinit, cinit, cinit, cinit};
                    s[kt] = __builtin_amdgcn_mfma_f32_16x16x32_bf16(kfC[2 * kt], qg0, s[kt], 0, 0, 0); s[kt] = __builtin_amdgcn_mfma_f32_16x16x32_bf16(kfC[2 * kt + 1], qg1, s[kt], 0, 0, 0); }
                if (reload) LOADK(Jn, kfC);
                const float refc = ref;
                if (n + 1 < ntask) QFETCH(e_nxt);
                if (nearJ) { const float sub = valid ? refc : INFINITY;
                    float bb[16];
#pragma unroll
                    for (int kt = 0; kt < 4; ++kt)
#pragma unroll
                        for (int r = 0; r < 4; ++r) { const int dd = tq - 64 * Jb - (16 * kt + 4 * gq + r); bb[kt * 4 + r] = luth[4 * min(max(dd, 0), 127)]; }
#pragma unroll
                    for (int x = 0; x < 16; ++x) asm volatile("" : "+v"(bb[x]));
#pragma unroll
                    for (int kt = 0; kt < 4; ++kt)
#pragma unroll
                        for (int r = 0; r < 4; ++r) { const int dd = tq - 64 * Jb - (16 * kt + 4 * gq + r); const float tt = s[kt][r] + bb[kt * 4 + r] - sub;
                            s[kt][r] = (dd >= 0) ? tt : -INFINITY; } }
#pragma unroll
                for (int kt = 0; kt < 4; ++kt)
#pragma unroll
                    for (int r = 0; r < 4; ++r) s[kt][r] = __builtin_amdgcn_exp2f(fminf(s[kt][r], CLAMP));
                float ls = (((s[0][0] + s[0][1]) + (s[0][2] + s[0][3])) + ((s[1][0] + s[1][1]) + (s[1][2] + s[1][3]))) + (((s[2][0] + s[2][1]) + (s[2][2] + s[2][3])) + ((s[3][0] + s[3][1]) + (s[3][2] + s[3][3])));
                { auto r16 = __builtin_amdgcn_permlane16_swap(__float_as_uint(ls), __float_as_uint(ls), false, false); ls = __uint_as_float(r16[0]) + __uint_as_float(r16[1]); }
                ls = halfsum(ls);
                bf16x8 pb[2];
#pragma unroll
                for (int ks = 0; ks < 2; ++ks) pb[ks] = __builtin_bit_cast(bf16x8, (u32x4){cvtpk(s[2 * ks][0], s[2 * ks][1]), cvtpk(s[2 * ks][2], s[2 * ks][3]), cvtpk(s[2 * ks + 1][0], s[2 * ks + 1][1]), cvtpk(s[2 * ks + 1][2], s[2 * ks + 1][3])});
                LAS bf16* ex = EX + buf * 8704 + ((wid * 4 + qi4) * 4 + h) * 68 + 4 * gq;
                f32x4 ot[4];
#pragma unroll
                for (int mt = 0; mt < 4; ++mt) { ot[mt] = (f32x4){0.f, 0.f, 0.f, 0.f};
                    ot[mt] = __builtin_amdgcn_mfma_f32_16x16x32_bf16(vfC[2 * mt], pb[0], ot[mt], 0, 0, 0); ot[mt] = __builtin_amdgcn_mfma_f32_16x16x32_bf16(vfC[2 * mt + 1], pb[1], ot[mt], 0, 0, 0); }
                if (reload) LOADV(Jn, vfC);
#pragma unroll
                for (int mt = 0; mt < 4; ++mt) *(LAS u32x2*)(ex + 16 * mt) = (u32x2){cvtpk(ot[mt][0], ot[mt][1]), cvtpk(ot[mt][2], ot[mt][3])};
                if (gq == 0) { LEX[buf * 128 + wid * 16 + c16] = ls; if (h == 0) HDR[buf * 32 + wid * 4 + qi4] = valid ? myq : -1; }
                e_cur = e_nxt;
            } else if (lane < 4) HDR[buf * 32 + wid * 4 + lane] = -1;
            LDS_WAIT(); __builtin_amdgcn_s_barrier();
            {
                const int hv = (lane < 32) ? HDR[buf * 32 + lane] : -1;
                const int li = lane & 15, hsel = li >> 2, dq = (li & 3) * 16;
#pragma unroll
                for (int pass = 0; pass < 2; ++pass) {
                    const unsigned m0 = (unsigned)__ballot(hv == 8 * wid + 4 * pass + 0), m1 = (unsigned)__ballot(hv == 8 * wid + 4 * pass + 1), m2 = (unsigned)__ballot(hv == 8 * wid + 4 * pass + 2), m3 = (unsigned)__ballot(hv == 8 * wid + 4 * pass + 3);
                    if ((m0 | m1 | m2 | m3) == 0u) continue;
                    unsigned mm = gq == 0 ? m0 : gq == 1 ? m1 : gq == 2 ? m2 : m3;
                    while (mm) { const int e = __builtin_ctz(mm); mm &= mm - 1;
                        const LAS bf16* xr = EX + buf * 8704 + (e * 4 + hsel) * 68 + dq;
                        const u32x2 y0 = *(const LAS u32x2*)(xr), y1 = *(const LAS u32x2*)(xr + 4), y2 = *(const LAS u32x2*)(xr + 8), y3 = *(const LAS u32x2*)(xr + 12);
                        const u32x4 x0 = {y0.x, y0.y, y1.x, y1.y}, x1 = {y2.x, y2.y, y3.x, y3.y};
                        oa[pass][0] += bflo(x0.x); oa[pass][1] += bfhi(x0.x); oa[pass][2] += bflo(x0.y); oa[pass][3] += bfhi(x0.y); oa[pass][4] += bflo(x0.z); oa[pass][5] += bfhi(x0.z); oa[pass][6] += bflo(x0.w); oa[pass][7] += bfhi(x0.w);
                        oa[pass][8] += bflo(x1.x); oa[pass][9] += bfhi(x1.x); oa[pass][10] += bflo(x1.y); oa[pass][11] += bfhi(x1.y); oa[pass][12] += bflo(x1.z); oa[pass][13] += bfhi(x1.z); oa[pass][14] += bflo(x1.w); oa[pass][15] += bfhi(x1.w);
                        la2[pass] += LEX[buf * 128 + e * 4 + hsel]; }
                }
            }
        }
        {
            const int li = lane & 15, hsel = li >> 2, dq = (li & 3) * 16;
#pragma unroll
            for (int pass = 0; pass < 2; ++pass) { const int q = 8 * wid + 4 * pass + gq; LAS f32x4* ap = (LAS f32x4*)(OACC + (4 * q + hsel) * 64 + dq);
#pragma unroll
                for (int k = 0; k < 4; ++k) { f32x4 a = ap[k]; a[0] += oa[pass][4 * k]; a[1] += oa[pass][4 * k + 1]; a[2] += oa[pass][4 * k + 2]; a[3] += oa[pass][4 * k + 3]; ap[k] = a; }
                if ((li & 3) == 0) LACC[4 * q + hsel] += la2[pass]; }
        }
#undef LOADK
#undef LOADV
#undef QFETCH
    }
    LDS_WAIT(); __builtin_amdgcn_s_barrier();

    {
        if (hi == 0) { const float lt = LACC[32 * wid + r32]; wsf[r32] = lt > 0.f ? gate_s / lt : 0.f; }
        LDS_WAIT();
#pragma unroll
        for (int i = 0; i < 4; ++i) { const int rowl = i * 8 + (lane >> 3), chn = lane & 7, row = 32 * wid + rowl;
            const float f = wsf[rowl];
            const f32x4 a0 = *(const LAS f32x4*)(OACC + row * 64 + chn * 8), a1 = *(const LAS f32x4*)(OACC + row * 64 + chn * 8 + 4);
            const size_t tt = (size_t)(64 * qt + 8 * wid + (rowl >> 2)); const int col = (4 * g + (rowl & 3)) * 64 + chn * 8;
            const u32x4 ov = *(const u32x4*)(F.XN() + tt * 1024 + col);
            const u32x4 gn = *(const u32x4*)(F.GN() + tt * 512 + col);
            u32x4 w; w.x = pk2((bflo(ov.x) + a0[0] * f) * bflo(gn.x), (bfhi(ov.x) + a0[1] * f) * bfhi(gn.x)); w.y = pk2((bflo(ov.y) + a0[2] * f) * bflo(gn.y), (bfhi(ov.y) + a0[3] * f) * bfhi(gn.y));
            w.z = pk2((bflo(ov.z) + a1[0] * f) * bflo(gn.z), (bfhi(ov.z) + a1[1] * f) * bfhi(gn.z)); w.w = pk2((bflo(ov.w) + a1[2] * f) * bflo(gn.w), (bfhi(ov.w) + a1[3] * f) * bfhi(gn.w));
            *(u32x4*)(F.XN() + tt * 1024 + col) = w; }
        VM_WAIT(); LDS_WAIT(); __syncthreads();
    }
#undef DMA_K
#undef DMA_V
#undef ROT
}
}

__global__ void __launch_bounds__(NWAVES * 64, 2) nsa_lru_fwd(Args args) {
    extern __shared__ __attribute__((aligned(16))) unsigned char lds[];
    Frame F;
    F.lds = (LAS unsigned char*)lds;
    F.MISC = (volatile LAS unsigned*)(F.lds + MISC_OFF);
    F.wave = __builtin_amdgcn_readfirstlane((int)(threadIdx.x >> 6));
    F.G = gridDim.x; { const int bx = blockIdx.x; F.vcu = (F.G % 8 == 0) ? (bx % 8) * (F.G / 8) + bx / 8 : bx; }
    F.ws = args.ws;
    gu32* ctl = (gu32*)(args.ws + WS_CTL);
    for (int u = F.wave * 64 + lane_id(); u < (LDS_BYTES - LDSCTL_OFF) / 4; u += NWAVES * 64) ((LAS unsigned*)(F.lds + LDSCTL_OFF))[u] = 0u;
    __syncthreads();
    const int bli = (N_LAUNCHES == PER_PHASE) ? 0 : args.li;
    XcdBarrier bar; bar.bar = (unsigned*)(ctl + CW_BAR) + bli * XCD_BAR_WORDS; bar.x = 0; bar.st = nullptr;
    if (N_LAUNCHES != PER_PHASE) bar = xcd_barrier_post((unsigned*)(ctl + CW_BAR) + bli * XCD_BAR_WORDS, F.MISC + 8);
#define GRID_BAR() do { if (N_LAUNCHES != PER_PHASE) xcd_barrier(bar); } while (0)
    const int lo = args.ph_lo, hi = args.ph_hi;
#define IN(k) (lo <= (k) && (k) < hi)
#define BOTH(k) (IN(k) && IN((k) + 1))

    if (IN(0)) { p0_prologue(F, args); if (BOTH(0)) GRID_BAR(); }

    if (IN(1)) {
        pg8::Gemm g{F.XN(), F.WinT(), F.XN(), F.WinT(), 1024, 1024, 1024}; pg8::StaticOrder S; S.init(SEQ, NPROJ, F.G, (int)blockIdx.x);
        pg8::EpiProj E{F.Q(), F.KV(), F.U(), F.BR(), F.GN(), F.GL(), F.MG()};
        pg8::gemm_phase<pg8::EpiProj, pg8::StaticOrder, true>(F.lds, g, S, E, F.wave);
        if (BOTH(1)) GRID_BAR();
    }

    if (IN(2)) {
        for (int i = F.vcu; i < 256; i += F.G) {
            lru_tile<false>(F, args, i);
            if (!args.pad) qk_norm_tile(F, args, i);
            vt_tile(F, i);
            __syncthreads();
            compress_item(F, args, i & 1, (i >> 1) & 1, i >> 2);
        }
        if (BOTH(2)) GRID_BAR();
    }

    if (IN(3)) {
        for (int i = F.vcu; i < 256; i += F.G) { lru_tile<true>(F, args, i); }
        __syncthreads();
#pragma unroll 1
        for (int it = 2 * F.vcu; it < 512; it += 2 * F.G) {
#pragma unroll 1
            for (int j = 0; j < 2; ++j) { const int i = it >> 1; att::attn_item(F, j ? i : 255 - i, j ? 0 : 1); }
        }
        if (BOTH(3)) GRID_BAR();
    }

    if (IN(4)) {
        pg8::Gemm g{F.XN(), F.WaT(), F.XN() + 512, F.WbT(), 1024, 512, 512}; pg8::DualOrder S; S.init(SEQ, 1024, F.G, (int)blockIdx.x);
        pg8::EpiMerge E{F.MB(), F.MG()};
        pg8::gemm_phase<pg8::EpiMerge, pg8::DualOrder, true>(F.lds, g, S, E, F.wave);
        if (BOTH(4)) GRID_BAR();
    }

    if (IN(5)) {
        pg8::Gemm g{F.MB(), F.WoutT(), F.MB(), F.WoutT(), 1024, 1024, 1024}; pg8::StaticOrder S; S.init(SEQ, 1024, F.G, (int)blockIdx.x);
        pg8::EpiOut E{args.in[0], args.out};
        pg8::gemm_phase<pg8::EpiOut, pg8::StaticOrder, true>(F.lds, g, S, E, F.wave);
    }
#undef IN
#undef BOTH
}

extern "C" void kernel_launch(void* const* d_in, const int* in_sizes, int n_in, void* d_out, int out_size, void* d_ws, size_t ws_size, hipStream_t stream) {
    static int grid = 0;
    if (grid == 0) {
        if (n_in != 20 || in_sizes[0] != SEQ * DM || out_size != SEQ * DM || ws_size < WS_END) { fprintf(stderr, "kernel_launch: unexpected shapes (n_in %d, in0 %d, out %d, ws %zu)\n", n_in, n_in > 0 ? in_sizes[0] : -1, out_size, ws_size); grid = -1; return; }
        int dev = 0, cus = 0, per_cu = 0;
        if (hipGetDevice(&dev) != hipSuccess || hipDeviceGetAttribute(&cus, hipDeviceAttributeMultiprocessorCount, dev) != hipSuccess) { grid = -1; return; }
        if (hipFuncSetAttribute((const void*)nsa_lru_fwd, hipFuncAttributeMaxDynamicSharedMemorySize, LDS_BYTES) != hipSuccess) { fprintf(stderr, "kernel_launch: hipFuncSetAttribute failed\n"); grid = -1; return; }
        if (hipOccupancyMaxActiveBlocksPerMultiprocessor(&per_cu, (const void*)nsa_lru_fwd, NWAVES * 64, LDS_BYTES) != hipSuccess || per_cu < 1)
            fprintf(stderr, "kernel_launch: occupancy query reports %d workgroups per CU\n", per_cu);
        (void)hipGetLastError();
        grid = cus;
    }
    if (grid < 0) return;
    if (hipMemsetAsync((char*)d_ws + WS_CTL, 0, CTL_ZERO_BYTES, stream) != hipSuccess) { fprintf(stderr, "kernel_launch: hipMemsetAsync failed\n"); return; }
    Args a{};
    for (int i = 0; i < 20; ++i) a.in[i] = (const float*)d_in[i];
    a.out = (float*)d_out; a.ws = (unsigned char*)d_ws;
    const int nl = (PROBE_DUP >= 0) ? 2 : N_LAUNCHES;
    for (int li = 0; li < nl; ++li) {
        if (PROBE_DUP >= 0) { a.ph_lo = li ? PROBE_DUP : 0; a.ph_hi = li ? PER_PHASE : PROBE_DUP + 1; a.li = li; a.pad = (li && PROBE_DUP == 2) ? 1 : 0; }
        else { a.ph_lo = (N_LAUNCHES == PER_PHASE) ? li : 0; a.ph_hi = (N_LAUNCHES == PER_PHASE) ? li + 1 : PER_PHASE; a.li = li; }
        hipLaunchKernelGGL(nsa_lru_fwd, dim3(grid), dim3(NWAVES * 64), LDS_BYTES, stream, a);
        const hipError_t le = hipPeekAtLastError();
        if (le != hipSuccess) { fprintf(stderr, "kernel_launch: launch %d failed: %s\n", li, hipGetErrorName(le)); break; }
    }
}
```

```cpp
#include <hip/hip_runtime.h>
#include <cstdio>
#include <cstdint>

#ifndef PROBE_DUP
#define PROBE_DUP -1
#endif
#ifndef MK_N_LAUNCHES
#define MK_N_LAUNCHES 1
#endif

#define GAS __attribute__((address_space(1)))
#define LAS __attribute__((address_space(3)))
typedef unsigned short bf16;
typedef short bf16x8 __attribute__((ext_vector_type(8)));
typedef short s16x4 __attribute__((ext_vector_type(4)));
typedef float f32x4 __attribute__((ext_vector_type(4)));
typedef float f32x16 __attribute__((ext_vector_type(16)));
typedef unsigned u32x4 __attribute__((ext_vector_type(4)));
typedef unsigned u32x2 __attribute__((ext_vector_type(2)));
typedef GAS unsigned gu32;

constexpr int SEQ = 16384, DM = 1024;
constexpr int NPROJ = 5120;
constexpr float LOG2E = 1.4426950408889634f;
constexpr float RMS_EPS = 1e-6f;

__device__ __forceinline__ unsigned f2bf(float f) { unsigned u = __builtin_bit_cast(unsigned, f); return (u + 0x7fffu + ((u >> 16) & 1u)) >> 16; }
__device__ __forceinline__ unsigned pk2(float lo, float hi) { return f2bf(lo) | (f2bf(hi) << 16); }
__device__ __forceinline__ float bf2f(unsigned h) { return __builtin_bit_cast(float, h << 16); }
__device__ __forceinline__ float bflo(unsigned w) { return __builtin_bit_cast(float, w << 16); }
__device__ __forceinline__ float bfhi(unsigned w) { return __builtin_bit_cast(float, w & 0xffff0000u); }
typedef float f32x2_t __attribute__((ext_vector_type(2))); typedef __bf16 bf16x2_t __attribute__((ext_vector_type(2)));
__device__ __forceinline__ unsigned cvtpk(float lo, float hi) { f32x2_t v = {lo, hi}; bf16x2_t b = __builtin_convertvector(v, bf16x2_t); return __builtin_bit_cast(unsigned, b); }
__device__ __forceinline__ float fsigmoid(float v) { return __builtin_amdgcn_rcpf(1.0f + __builtin_amdgcn_exp2f(-v * LOG2E)); }
template <int CTRL> __device__ __forceinline__ float dpp_f(float v) { return __builtin_bit_cast(float, __builtin_amdgcn_update_dpp(0, __builtin_bit_cast(int, v), CTRL, 0xf, 0xf, true)); }
template <int CTRL> __device__ __forceinline__ int dpp_i(int v) { return __builtin_amdgcn_update_dpp(v, v, CTRL, 0xf, 0xf, false); }
__device__ __forceinline__ int lane_id() { int l = (int)__builtin_amdgcn_mbcnt_hi(~0u, __builtin_amdgcn_mbcnt_lo(~0u, 0u)); asm volatile("" : "+v"(l)); return l; }
__device__ __forceinline__ float wave_sum(float v) {
#pragma unroll
    for (int o = 1; o < 64; o <<= 1) v += __shfl_xor(v, o);
    return v;
}

namespace pg8 {
#define PG8_LAS __attribute__((address_space(3)))
typedef unsigned short bf16_t;
constexpr int BM = 256, BK = 64, HALF = 128, HTB = HALF * BK * 2, STAGE_BYTES = 8 * HTB, NXCD = 8, WGM = 8;
__host__ __device__ __forceinline__ int lds_byte(int r, int c) { const int st = (r >> 4) * 2 + (c >> 5), rr = r & 15, cc = c & 31, ob = rr * 64 + cc * 2; return st * 1024 + (ob ^ (((ob >> 9) & 1) << 5)); }
__host__ __device__ __forceinline__ void stage_rc(int b, int& R, int& C) { const int st = b / 1024, sb = b % 1024, swz = sb ^ (((sb >> 9) & 1) << 5); R = (st >> 1) * 16 + swz / 64; C = (st & 1) * 32 + (swz % 64) / 2; }
__host__ __device__ __forceinline__ int perm32(int rho) { const int n = rho >> 4, i = rho & 15; return 8 * (i >> 2) + 4 * n + (i & 3); }

struct Unit { int pm, pn, part; };
struct Gemm { const bf16_t* A; const bf16_t* Bt; const bf16_t* A2; const bf16_t* Bt2; int lda, ldb, K; };

struct StaticOrder {
    int nM, nN, nwg, G, c;
    __host__ __device__ void init(int M, int N, int G_, int c_) { nM = M / BM; nN = N / BM; nwg = nM * nN; G = G_; c = c_; }
    __host__ __device__ bool tile(long L, Unit& u) const {
        if (L >= nwg) return false;
        int wgid = (int)L; { const int q = nwg / NXCD, r = nwg % NXCD, xcd = wgid % NXCD, off = wgid / NXCD; wgid = (xcd < r ? xcd * (q + 1) : r * (q + 1) + (xcd - r) * q) + off; }
        const int nig = WGM * nN, gid = wgid / nig, fm = gid * WGM, gsz = (nM - fm) < WGM ? (nM - fm) : WGM;
        u.pm = fm + ((wgid % nig) % gsz); u.pn = (wgid % nig) / gsz; u.part = 0; return true;
    }
    __host__ __device__ bool next(int i, Unit& u) const { return tile((long)i * G + c, u); }
};
struct DualOrder : StaticOrder {
    __host__ __device__ bool next(int i, Unit& u) const { if (!tile((long)(i >> 1) * G + c, u)) return false; u.part = i & 1; return true; }
};

__device__ __forceinline__ unsigned cvt_pk_bf16(float lo, float hi) { unsigned r; asm volatile("v_cvt_pk_bf16_f32 %0, %1, %2" : "=v"(r) : "v"(lo), "v"(hi)); return r; }

struct EpiProj {
    static constexpr bool PERM = true, INIT = false;
    bf16_t *Q, *KV, *U, *BR, *GN, *GL, *MG;
    __device__ __forceinline__ void operator()(const f32x4 (&acc)[2][2][4][2], const Unit& u, int wr, int wc, int fr, int fq) const {
        const int pn = u.pn; bf16_t* base; int ldc, colt, act = 0;
        if (pn < 2) { base = Q; ldc = 512; colt = pn * 256; }
        else if (pn < 5) { base = KV; ldc = 768; colt = (pn - 2) * 256; }
        else if (pn < 7) { base = U; ldc = 512; colt = (pn - 5) * 256; }
        else if (pn < 8) { base = BR; ldc = 256; colt = 0; }
        else if (pn < 10) { base = GN; ldc = 512; colt = (pn - 8) * 256; act = 1; }
        else if (pn < 12) { base = GL; ldc = 512; colt = (pn - 10) * 256; act = 1; }
        else { base = MG; ldc = 2048; colt = (pn - 12) * 256; act = 2; }
        const int row0 = u.pm * BM + wr * 64 + fr, col0 = colt + wc * 32 + 8 * fq;
#pragma unroll
        for (int ai = 0; ai < 2; ++ai)
#pragma unroll
            for (int m = 0; m < 4; ++m) { bf16_t* rowp = base + (size_t)(row0 + ai * HALF + m * 16) * ldc + col0;
#pragma unroll
                for (int bj = 0; bj < 2; ++bj) { f32x4 v0 = acc[ai][bj][m][0], v1 = acc[ai][bj][m][1];
                    if (act) {
#pragma unroll
                        for (int e = 0; e < 4; ++e) { const float s0 = fsigmoid(v0[e]), s1 = fsigmoid(v1[e]); v0[e] = (act == 1) ? v0[e] * s0 : s0; v1[e] = (act == 1) ? v1[e] * s1 : s1; } }
                    u32x4 w; w.x = cvt_pk_bf16(v0[0], v0[1]); w.y = cvt_pk_bf16(v0[2], v0[3]); w.z = cvt_pk_bf16(v1[0], v1[1]); w.w = cvt_pk_bf16(v1[2], v1[3]);
                    *(u32x4*)(rowp + bj * HALF) = w; } }
    }
};
struct EpiMerge {
    static constexpr bool PERM = true, INIT = false;
    bf16_t* Mb; const bf16_t* MG;
    __device__ __forceinline__ void operator()(const f32x4 (&acc)[2][2][4][2], const Unit& u, int wr, int wc, int fr, int fq) const {
        const int row0 = u.pm * BM + wr * 64 + fr, col0 = u.pn * BM + wc * 32 + 8 * fq;
#pragma unroll
        for (int ai = 0; ai < 2; ++ai)
#pragma unroll
            for (int m = 0; m < 4; ++m) { const size_t r = (size_t)(row0 + ai * HALF + m * 16);
#pragma unroll
                for (int bj = 0; bj < 2; ++bj) { const f32x4 v0 = acc[ai][bj][m][0], v1 = acc[ai][bj][m][1];
                    const u32x4 gw = *(const u32x4*)(MG + r * 2048 + u.part * 1024 + col0 + bj * HALF);
                    float o[8] = {v0[0] * bflo(gw.x), v0[1] * bfhi(gw.x), v0[2] * bflo(gw.y), v0[3] * bfhi(gw.y), v1[0] * bflo(gw.z), v1[1] * bfhi(gw.z), v1[2] * bflo(gw.w), v1[3] * bfhi(gw.w)};
                    bf16_t* dst = Mb + r * 1024 + col0 + bj * HALF;
                    if (u.part) { const u32x4 pw = *(const u32x4*)dst;
                        o[0] += bflo(pw.x); o[1] += bfhi(pw.x); o[2] += bflo(pw.y); o[3] += bfhi(pw.y); o[4] += bflo(pw.z); o[5] += bfhi(pw.z); o[6] += bflo(pw.w); o[7] += bfhi(pw.w); }
                    u32x4 w; w.x = cvt_pk_bf16(o[0], o[1]); w.y = cvt_pk_bf16(o[2], o[3]); w.z = cvt_pk_bf16(o[4], o[5]); w.w = cvt_pk_bf16(o[6], o[7]);
                    *(u32x4*)dst = w; } }
    }
};
struct EpiOut {
    static constexpr bool PERM = false, INIT = true;
    const float* X; float* O;
    __device__ __forceinline__ void init(f32x4 (&acc)[2][2][4][2], const Unit& u, int wr, int wc, int fr, int fq) const {
        const int row0 = u.pm * BM + wr * 64 + fr, col0 = u.pn * BM + wc * 32 + 4 * fq;
#pragma unroll
        for (int ai = 0; ai < 2; ++ai)
#pragma unroll
            for (int m = 0; m < 4; ++m) { const size_t off = (size_t)(row0 + ai * HALF + m * 16) * 1024 + col0;
#pragma unroll
                for (int bj = 0; bj < 2; ++bj)
#pragma unroll
                    for (int n = 0; n < 2; ++n) acc[ai][bj][m][n] = *(const f32x4*)(X + off + bj * HALF + n * 16); }
    }
    __device__ __forceinline__ void operator()(const f32x4 (&acc)[2][2][4][2], const Unit& u, int wr, int wc, int fr, int fq) const {
        const int row0 = u.pm * BM + wr * 64 + fr, col0 = u.pn * BM + wc * 32 + 4 * fq;
#pragma unroll
        for (int ai = 0; ai < 2; ++ai)
#pragma unroll
            for (int m = 0; m < 4; ++m) { const size_t off = (size_t)(row0 + ai * HALF + m * 16) * 1024 + col0;
#pragma unroll
                for (int bj = 0; bj < 2; ++bj)
#pragma unroll
                    for (int n = 0; n < 2; ++n) *(f32x4*)(O + off + bj * HALF + n * 16) = acc[ai][bj][m][n]; }
    }
};

template <class Epi, class Sched, bool ALIGN_EPI>
__device__ __forceinline__ void gemm_phase(PG8_LAS unsigned char* lds, const Gemm g, const Sched& S, const Epi& E, int wid) {
    const int lane = lane_id(), tid = wid * 64 + lane, wr = wid >> 2, wc = wid & 3, fr = lane & 15, fq = lane >> 4;
    const int K = g.K, nt = K / BK;
    unsigned voffA[2], voffB[2];
#pragma unroll
    for (int i = 0; i < 2; ++i) { int R, C; stage_rc(tid * 16 + i * 8192, R, C); const int Rb = Epi::PERM ? ((R & ~31) + perm32(R & 31)) : R;
        voffA[i] = (unsigned)(R * g.lda + C) * 2u; voffB[i] = (unsigned)(Rb * g.ldb + C) * 2u; }
    const size_t kstep = (size_t)(BK * 2);
    const size_t hstepA = (size_t)HALF * g.lda * 2, hstepB = (size_t)HALF * g.ldb * 2;
    const size_t tstepA = 2 * hstepA, tstepB = 2 * hstepB;
    const unsigned ldsw = (unsigned)wid * 1024u;
    const int aoff = lds_byte(wr * 64 + fr, fq * 8), boff = lds_byte(wc * 32 + fr, fq * 8);
#define PG8_SA(b, h) (((b) * 2 + (h)) * HTB)
#define PG8_SB(b, h) ((4 + (b) * 2 + (h)) * HTB)
#define PG8_STAGE(bufoff, gbase, voff) do { _Pragma("unroll") for (int _i = 0; _i < 2; ++_i) \
        __builtin_amdgcn_global_load_lds((const unsigned*)((const char*)(gbase) + (voff)[_i]), (PG8_LAS unsigned*)(lds + (bufoff) + ldsw + _i * 8192), 16, 0, 0); } while (0)
#define PG8_LDA(dst, b, h) do { _Pragma("unroll") for (int m = 0; m < 4; ++m) _Pragma("unroll") for (int k = 0; k < 2; ++k) dst[m][k] = *(const PG8_LAS bf16x8*)(lds + PG8_SA(b, h) + aoff + m * 2048 + k * 1024); } while (0)
#define PG8_LDB(dst, b, h) do { _Pragma("unroll") for (int n = 0; n < 2; ++n) _Pragma("unroll") for (int k = 0; k < 2; ++k) dst[n][k] = *(const PG8_LAS bf16x8*)(lds + PG8_SB(b, h) + boff + n * 2048 + k * 1024); } while (0)
#define PG8_MMA(ai, bj, At, Bt) do { __builtin_amdgcn_s_setprio(1); _Pragma("unroll") for (int m = 0; m < 4; ++m) _Pragma("unroll") for (int n = 0; n < 2; ++n) _Pragma("unroll") for (int k = 0; k < 2; ++k) \
        acc[ai][bj][m][n] = __builtin_amdgcn_mfma_f32_16x16x32_bf16(Bt[n][k], At[m][k], acc[ai][bj][m][n], 0, 0, 0); __builtin_amdgcn_s_setprio(0); } while (0)
#define PG8_WAIT_V(n) asm volatile("s_waitcnt vmcnt(" #n ")" ::: "memory")
#define PG8_WAIT_L(n) asm volatile("s_waitcnt lgkmcnt(" #n ")" ::: "memory")
#define PG8_BAR __builtin_amdgcn_s_barrier()
#define PG8_SCHED __builtin_amdgcn_sched_barrier(0)
#define PG8_UA(u) ((const char*)((u).part ? g.A2 : g.A) + (size_t)(u).pm * tstepA)
#define PG8_UB(u) ((const char*)((u).part ? g.Bt2 : g.Bt) + (size_t)(u).pn * tstepB)
    Unit cur, nxt; int ui = 0;
    if (!S.next(0, cur)) return;
    f32x4 acc[2][2][4][2];
    if constexpr (Epi::INIT) E.init(acc, cur, wr, wc, fr, fq);
    else {
#pragma unroll
    for (int a = 0; a < 2; ++a)
#pragma unroll
        for (int b = 0; b < 2; ++b)
#pragma unroll
            for (int m = 0; m < 4; ++m)
#pragma unroll
                for (int n = 0; n < 2; ++n) acc[a][b][m][n] = (f32x4){0.f, 0.f, 0.f, 0.f};
    }
    bf16x8 At[4][2], B0[2][2], B1[2][2];
    const char* cA = PG8_UA(cur); const char* cB = PG8_UB(cur);
    PG8_STAGE(PG8_SB(0, 0), cB, voffB); PG8_STAGE(PG8_SB(0, 1), cB + hstepB, voffB); PG8_STAGE(PG8_SA(0, 0), cA, voffA); PG8_STAGE(PG8_SA(0, 1), cA + hstepA, voffA);
    if (wr == 1) PG8_BAR;
    PG8_WAIT_V(2); PG8_BAR;
    PG8_STAGE(PG8_SB(1, 0), cB + kstep, voffB); PG8_STAGE(PG8_SA(1, 0), cA + kstep, voffA); PG8_STAGE(PG8_SB(1, 1), cB + hstepB + kstep, voffB);
    PG8_WAIT_V(6); PG8_BAR;
    for (;;) {
        const bool has_next = S.next(ui + 1, nxt);
        const char* nA = has_next ? PG8_UA(nxt) : cA; const char* nB = has_next ? PG8_UB(nxt) : cB;
        for (int t = 0; t < nt; t += 2) {
            const bool last = (t == nt - 2);
            const char* a1 = cA + (size_t)(t + 1) * kstep;
            const char* a2 = last ? nA : cA + (size_t)(t + 2) * kstep; const char* b2 = last ? nB : cB + (size_t)(t + 2) * kstep;
            const char* a3 = a2 + kstep; const char* b3 = b2 + kstep;
            PG8_LDB(B0, 0, 0); PG8_LDB(B1, 0, 1); PG8_SCHED; PG8_LDA(At, 0, 0); PG8_STAGE(PG8_SA(1, 1), a1 + hstepA, voffA);
            PG8_WAIT_V(8); PG8_WAIT_L(0); PG8_BAR; PG8_MMA(0, 0, At, B0); PG8_MMA(0, 1, At, B1); PG8_BAR; PG8_SCHED;
            PG8_LDA(At, 0, 1); PG8_STAGE(PG8_SB(0, 0), b2, voffB); PG8_STAGE(PG8_SB(0, 1), b2 + hstepB, voffB); PG8_STAGE(PG8_SA(0, 0), a2, voffA);
            PG8_WAIT_V(8); PG8_WAIT_L(0); PG8_BAR; PG8_MMA(1, 0, At, B0); PG8_MMA(1, 1, At, B1); PG8_BAR; PG8_SCHED;
            PG8_LDB(B0, 1, 0); PG8_LDB(B1, 1, 1); PG8_SCHED; PG8_LDA(At, 1, 0); PG8_STAGE(PG8_SA(0, 1), a2 + hstepA, voffA);
            PG8_WAIT_V(8); PG8_WAIT_L(0); PG8_BAR; PG8_MMA(0, 0, At, B0); PG8_MMA(0, 1, At, B1); PG8_BAR; PG8_SCHED;
            PG8_LDA(At, 1, 1); PG8_STAGE(PG8_SB(1, 0), b3, voffB); PG8_STAGE(PG8_SB(1, 1), b3 + hstepB, voffB); PG8_STAGE(PG8_SA(1, 0), a3, voffA);
            PG8_WAIT_V(8); PG8_WAIT_L(0); PG8_BAR; PG8_MMA(1, 0, At, B0); PG8_MMA(1, 1, At, B1); PG8_BAR; PG8_SCHED;
        }
        if constexpr (ALIGN_EPI) { if (wr == 0) PG8_BAR; }
        E(acc, cur, wr, wc, fr, fq);
        if (!has_next) break;
        if constexpr (Epi::INIT) E.init(acc, nxt, wr, wc, fr, fq);
        else {
#pragma unroll
        for (int a = 0; a < 2; ++a)
#pragma unroll
            for (int b = 0; b < 2; ++b)
#pragma unroll
                for (int m = 0; m < 4; ++m)
#pragma unroll
                    for (int n = 0; n < 2; ++n) acc[a][b][m][n] = (f32x4){0.f, 0.f, 0.f, 0.f};
        }
        cur = nxt; cA = nA; cB = nB; ++ui;
        if constexpr (ALIGN_EPI) { if (wr == 1) PG8_BAR; }
    }
    PG8_WAIT_V(0);
    if constexpr (!ALIGN_EPI) { if (wr == 0) PG8_BAR; }
    PG8_BAR;
#undef PG8_SA
#undef PG8_SB
#undef PG8_STAGE
#undef PG8_LDA
#undef PG8_LDB
#undef PG8_MMA
#undef PG8_WAIT_V
#undef PG8_WAIT_L
#undef PG8_BAR
#undef PG8_SCHED
#undef PG8_UA
#undef PG8_UB
}
}

constexpr int NWAVES = 8;
constexpr int N_LAUNCHES = MK_N_LAUNCHES;
constexpr int PER_PHASE = 6;
constexpr size_t MiB = 1u << 20;
constexpr size_t WS_CTL = 0, CTL_ZERO_BYTES = 65536;
constexpr size_t WS_WIN = 1 * MiB;
constexpr size_t WS_WA = 11 * MiB;
constexpr size_t WS_WB = 12 * MiB;
constexpr size_t WS_WOUT = 13 * MiB;
constexpr size_t WS_W1T = 15 * MiB;
constexpr size_t WS_SMALL = 17 * MiB;
constexpr size_t WS_SUM = 18 * MiB;
constexpr size_t WS_KC = 19 * MiB;
constexpr size_t WS_XN = 20 * MiB;
constexpr size_t WS_Q = 52 * MiB;
constexpr size_t WS_KV = 68 * MiB;
constexpr size_t WS_MB = 52 * MiB;
constexpr size_t WS_U = 92 * MiB;
constexpr size_t WS_BR = 108 * MiB;
constexpr size_t WS_GN = 116 * MiB;
constexpr size_t WS_GL = 132 * MiB;
constexpr size_t WS_MG = 148 * MiB;
constexpr size_t WS_VT = 212 * MiB;
constexpr size_t WS_KT = 216 * MiB;
constexpr size_t WS_Q2 = 220 * MiB;
constexpr size_t WS_LB = 236 * MiB;
constexpr size_t WS_END = 252 * MiB;
constexpr size_t SM_W2T = 0;
constexpr size_t SM_LWA = 65536;
constexpr size_t SM_LWX = 131072;
constexpr size_t SM_C1 = 262144;
constexpr size_t SM_LUT = 200704;
constexpr int CW_BAR = 4096;

constexpr int RING_BYTES = 160768;
constexpr int LDSCTL_OFF = RING_BYTES, MISC_OFF = LDSCTL_OFF + 320;
constexpr int LDS_BYTES = 163840;

#define RLX_AGENT __ATOMIC_RELAXED, __HIP_MEMORY_SCOPE_AGENT
#define LDS_WAIT() asm volatile("s_waitcnt lgkmcnt(0)" ::: "memory")
#define VM_WAIT() asm volatile("s_waitcnt vmcnt(0)" ::: "memory")

#define XB_TMO      128
#define XB_XCNT(j)  (256  + 64 * (j))
#define XB_XSUB(j)  (1280 + 64 * (j))
#define XB_XGEN(j)  (2304 + 64 * (j))
#define XB_TOP      3328
#define XB_TOPGEN   3392
#define XCD_BAR_WORDS 3456
#define XB_SPIN_CAP (1u << 18)
__device__ __forceinline__ unsigned xb_ld(unsigned* p)              { return __hip_atomic_load(p, __ATOMIC_RELAXED, __HIP_MEMORY_SCOPE_AGENT); }
__device__ __forceinline__ unsigned xb_add(unsigned* p, unsigned v) { return __hip_atomic_fetch_add(p, v, __ATOMIC_RELAXED, __HIP_MEMORY_SCOPE_AGENT); }
__device__ __forceinline__ unsigned xb_xcc_id() { return (unsigned)__builtin_amdgcn_s_getreg((3 << 11) | 20) & 0xFu; }
#define XB_SPIN(cond, bar) do { unsigned _sp = 0; while (cond) { __builtin_amdgcn_s_sleep(1); \
    if ((++_sp & 255u) == 0u) { if (xb_ld(&(bar)[XB_TMO])) break; if (_sp > XB_SPIN_CAP) { atomicAdd(&(bar)[XB_TMO], 1u); break; } } } } while (0)
struct XcdBarrier { unsigned* bar; unsigned x; volatile LAS unsigned* st; };
__device__ __forceinline__ XcdBarrier xcd_barrier_post(unsigned* bar, volatile LAS unsigned* st) {
    XcdBarrier b; b.bar = bar; b.x = xb_xcc_id(); b.st = st;
    if (threadIdx.x == 0) (void)xb_add(&bar[XB_XCNT(b.x)], 1u);
    return b;
}
__device__ __forceinline__ void xcd_barrier_complete(unsigned* bar, unsigned x, unsigned& nloc, unsigned& nx) {
    const unsigned G = gridDim.x * gridDim.y * gridDim.z;
    unsigned sum, cnt, mine, sp = 0u;
    for (;;) {
        sum = 0u; cnt = 0u; mine = 0u;
#pragma unroll
        for (unsigned j = 0; j < 16; ++j) { const unsigned c = xb_ld(&bar[XB_XCNT(j)]); sum += c; cnt += (c > 0u) ? 1u : 0u; mine = (j == x) ? c : mine; }
        if (sum == G) break;
        __builtin_amdgcn_s_sleep(1);
        if ((++sp & 255u) == 0u) { if (xb_ld(&bar[XB_TMO])) break; if (sp > XB_SPIN_CAP) { atomicAdd(&bar[XB_TMO], 1u); break; } }
    }
    nloc = mine > 0u ? mine : 1u; nx = cnt > 0u ? cnt : 1u;
}
__device__ __forceinline__ void xcd_barrier(const XcdBarrier& b) {
    asm volatile("s_waitcnt vmcnt(0)" ::: "memory");
    __syncthreads();
    if (threadIdx.x == 0) {
        unsigned* bar = b.bar;
        __builtin_amdgcn_s_waitcnt(0);
        unsigned nloc = b.st[0], nx = b.st[1];
        if (nloc == 0u) { xcd_barrier_complete(bar, b.x, nloc, nx); b.st[0] = nloc; b.st[1] = nx; }
        const unsigned old = xb_add(&bar[XB_XSUB(b.x)], 1u);
        const unsigned gen = old / nloc;
        if (old + 1u == (gen + 1u) * nloc) {
            __builtin_amdgcn_fence(__ATOMIC_RELEASE, "agent");
            asm volatile("s_waitcnt vmcnt(0)" ::: "memory");
            const unsigned og = xb_add(&bar[XB_TOP], 1u);
            const unsigned tg = og / nx;
            if (og + 1u == (tg + 1u) * nx) xb_add(&bar[XB_TOPGEN], 1u);
            else XB_SPIN(xb_ld(&bar[XB_TOPGEN]) == tg, bar);
            __builtin_amdgcn_fence(__ATOMIC_ACQUIRE, "agent");
            xb_add(&bar[XB_XGEN(b.x)], 1u);
            asm volatile("s_waitcnt vmcnt(0)" ::: "memory");
        } else {
            XB_SPIN(xb_ld(&bar[XB_XGEN(b.x)]) == gen, bar);
            __builtin_amdgcn_fence(__ATOMIC_ACQUIRE, "agent");
            asm volatile("s_waitcnt vmcnt(0)" ::: "memory");
        }
    }
    __syncthreads();
}

struct Args { const float* in[20]; float* out; unsigned char* ws; int ph_lo, ph_hi, li, pad; };
struct Frame {
    LAS unsigned char* lds;
    volatile LAS unsigned* MISC;
    int wave;
    int vcu, G;
    unsigned char* ws;
#define WSP(name, T, off) __device__ __forceinline__ T* name() const { return (T*)(ws + (off)); }
    WSP(WinT, bf16, WS_WIN) WSP(WaT, bf16, WS_WA) WSP(WbT, bf16, WS_WB) WSP(WoutT, bf16, WS_WOUT) WSP(W1T, bf16, WS_W1T)
    WSP(W2T, bf16, WS_SMALL + SM_W2T) WSP(LWA, bf16, WS_SMALL + SM_LWA) WSP(LWX, bf16, WS_SMALL + SM_LWX)
    WSP(C1, float, WS_SMALL + SM_C1) WSP(LUT, float, WS_SMALL + SM_LUT) WSP(SUMA, float, WS_SUM) WSP(SUMB, float, WS_SUM + 524288)
    WSP(KC, bf16, WS_KC) WSP(VC, bf16, WS_KC + 524288) WSP(XN, bf16, WS_XN) WSP(Q, bf16, WS_Q) WSP(KV, bf16, WS_KV) WSP(MB, bf16, WS_MB)
    WSP(VT, bf16, WS_VT) WSP(KT, bf16, WS_KT) WSP(Q2, bf16, WS_Q2) WSP(LB, bf16, WS_LB) WSP(U, bf16, WS_U) WSP(BR, bf16, WS_BR) WSP(GN, bf16, WS_GN) WSP(GL, bf16, WS_GL) WSP(MG, bf16, WS_MG)
#undef WSP
};

__device__ __forceinline__ int t5_bucket(int n) {
    if (n < 16) return n;
    const int thr[15] = {19, 21, 24, 27, 31, 35, 40, 46, 52, 59, 67, 77, 87, 99, 113};
    int b = 16;
#pragma unroll
    for (int i = 0; i < 15; ++i) b += (n >= thr[i]) ? 1 : 0;
    return b;
}

__device__ __forceinline__ void p0_tr_item(const float* W, int ldw, int k0, int srccol0, int nvalid, bf16* WT, int ldt, int dstrow0, LAS float* scr, int lane) {
    const int c = lane & 31;
    float tv[32];
#pragma unroll
    for (int i = 0; i < 32; ++i) { const int kk = 2 * i + (lane >> 5); tv[i] = (c < nvalid) ? W[(size_t)(k0 + kk) * ldw + srccol0 + c] : 0.f; }
#pragma unroll
    for (int i = 0; i < 32; ++i) { const int kk = 2 * i + (lane >> 5); scr[kk * 33 + c] = tv[i]; }
    LDS_WAIT(); asm volatile("" ::: "memory");
    const int cc = lane & 7;
#pragma unroll
    for (int j = 0; j < 4; ++j) { const int n = (lane >> 3) + 8 * j; const LAS float* s = scr + (8 * cc) * 33 + n;
        u32x4 o; o.x = pk2(s[0 * 33], s[1 * 33]); o.y = pk2(s[2 * 33], s[3 * 33]); o.z = pk2(s[4 * 33], s[5 * 33]); o.w = pk2(s[6 * 33], s[7 * 33]);
        *(u32x4*)(WT + (size_t)(dstrow0 + n) * ldt + k0 + 8 * cc) = o; }
    LDS_WAIT(); asm volatile("" ::: "memory");
}
__device__ __forceinline__ void win_src(int n0, int& src, int& nvalid) {
    nvalid = 32;
    if (n0 < 1280) src = n0;
    else if (n0 < 1792) src = 1816 + (n0 - 1280);
    else if (n0 < 2048) { src = 1792 + (n0 - 1792); nvalid = (n0 == 1792) ? 24 : 0; if (n0 != 1792) src = 0; }
    else if (n0 < 2560) src = 1280 + (n0 - 2048);
    else if (n0 < 3072) src = 2328 + (n0 - 2560);
    else src = 2840 + (n0 - 3072);
}
__device__ __forceinline__ void p0_prologue(const Frame& F, const Args& A) {
    LAS float* scr = (LAS float*)(F.lds + F.wave * 16384);
    const int gw = F.vcu * NWAVES + F.wave, NGW = F.G * NWAVES, lane = lane_id();
    constexpr int I_WIN = 16 * 160, I_WA = 8 * 32, I_WO = 16 * 32, I_W1 = 32 * 8, I_W2 = 4 * 2, I_LR = 2;
    constexpr int NIT = I_WIN + 2 * I_WA + I_WO + 2 * I_W1 + 2 * I_W2 + 16 * I_LR + 256 + 1;
    for (int it = gw; it < NIT; it += NGW) {
        int r = it;
        if (r < I_WIN) { const int kb = r / 160, nb = r % 160; int src, nv; win_src(32 * nb, src, nv); p0_tr_item(A.in[2], 4888, 64 * kb, src, nv, F.WinT(), 1024, 32 * nb, scr, lane); continue; } r -= I_WIN;
        if (r < I_WA) { p0_tr_item(A.in[17], 1024, 64 * (r / 32), 32 * (r % 32), 32, F.WaT(), 512, 32 * (r % 32), scr, lane); continue; } r -= I_WA;
        if (r < I_WA) { p0_tr_item(A.in[18], 1024, 64 * (r / 32), 32 * (r % 32), 32, F.WbT(), 512, 32 * (r % 32), scr, lane); continue; } r -= I_WA;
        if (r < I_WO) { p0_tr_item(A.in[19], 1024, 64 * (r / 32), 32 * (r % 32), 32, F.WoutT(), 1024, 32 * (r % 32), scr, lane); continue; } r -= I_WO;
        if (r < 2 * I_W1) { const int kv = r / I_W1, q = r % I_W1; p0_tr_item(A.in[6] + (size_t)kv * 2048 * 256, 256, 64 * (q / 8), 32 * (q % 8), 32, F.W1T() + (size_t)kv * 256 * 2048, 2048, 32 * (q % 8), scr, lane); continue; } r -= 2 * I_W1;
        if (r < 2 * I_W2) { const int kv = r / I_W2, q = r % I_W2; p0_tr_item(A.in[8] + (size_t)kv * 256 * 64, 64, 64 * (q / 2), 32 * (q % 2), 32, F.W2T() + (size_t)kv * 64 * 256, 256, 32 * (q % 2), scr, lane); continue; } r -= 2 * I_W2;
        if (r < 16 * I_LR) { const int mtx = r / 2, nb = r % 2; const float* src = (mtx < 8 ? A.in[12] : A.in[14]) + (size_t)(mtx & 7) * 4096; bf16* dst = (mtx < 8 ? F.LWA() : F.LWX()) + (size_t)(mtx & 7) * 4096;
            p0_tr_item(src, 64, 0, 32 * nb, 32, dst, 64, 32 * nb, scr, lane); continue; } r -= 16 * I_LR;
        if (r < 256) {
            const int kc = r >> 3, kv = (r >> 2) & 1, n = (r & 3) * 64 + lane; const float* w1 = A.in[6] + (size_t)kv * 2048 * 256 + (size_t)(64 * kc) * 256 + n; const float* pe = A.in[5] + kv * 2048 + 64 * kc;
            float s0 = 0.f, s1 = 0.f, s2 = 0.f, s3 = 0.f;
#pragma unroll 4
            for (int k = 0; k < 64; k += 4) { s0 += pe[k] * w1[(size_t)k * 256]; s1 += pe[k + 1] * w1[(size_t)(k + 1) * 256]; s2 += pe[k + 2] * w1[(size_t)(k + 2) * 256]; s3 += pe[k + 3] * w1[(size_t)(k + 3) * 256]; }
            F.C1()[(kc * 2 + kv) * 256 + n] = (s0 + s1) + (s2 + s3); continue; } r -= 256;
        {
            for (int e = lane; e < 1024; e += 64) { const int hd = e >> 7, n = e & 127; F.LUT()[e] = A.in[9][t5_bucket(n) * 8 + hd] * LOG2E; }
        }
    }
    const float* gain = A.in[1];
    {
        f32x4 v[4], vn[4];
        if (gw < SEQ) { const f32x4* xr = (const f32x4*)(A.in[0] + (size_t)gw * DM) + lane;
#pragma unroll
            for (int j = 0; j < 4; ++j) v[j] = xr[64 * j]; }
        for (int m = gw; m < SEQ; m += NGW) {
            if (m + NGW < SEQ) { const f32x4* xr = (const f32x4*)(A.in[0] + (size_t)(m + NGW) * DM) + lane;
#pragma unroll
                for (int j = 0; j < 4; ++j) vn[j] = xr[64 * j]; }
            float s = 0.f;
#pragma unroll
            for (int j = 0; j < 4; ++j) s += (v[j].x * v[j].x + v[j].y * v[j].y) + (v[j].z * v[j].z + v[j].w * v[j].w);
            const float rs = 1.0f / sqrtf(wave_sum(s) * (1.f / DM) + RMS_EPS);
            unsigned long long* o8 = (unsigned long long*)(F.XN() + (size_t)m * DM) + lane;
#pragma unroll
            for (int j = 0; j < 4; ++j) { const f32x4 gv = ((const f32x4*)gain)[lane + 64 * j];
                o8[64 * j] = (unsigned long long)pk2(v[j].x * rs * gv.x, v[j].y * rs * gv.y) | ((unsigned long long)pk2(v[j].z * rs * gv.z, v[j].w * rs * gv.w) << 32); }
#pragma unroll
            for (int j = 0; j < 4; ++j) v[j] = vn[j];
        }
    }
}

template <bool FINAL>
__device__ __forceinline__ void lru_tile(const Frame& F, const Args& A, int tt) {
    const int lane = lane_id();
    const int w = F.wave, fr = lane & 15, fq = lane >> 4, ch0 = 64 * w, t0 = 64 * tt;
    LAS float* UC = (LAS float*)(F.lds + w * 16384);
#define UC_IDX(tok, ch) ((tok) * 64 + ((((ch) >> 2) ^ ((tok) & 15)) << 2) + ((ch) & 3))
    float Hc = 0.f;
    if (FINAL) {
        const float* sa = F.SUMA() + ch0 + lane; const float* sb = F.SUMB() + ch0 + lane;
        int i = 0;
        for (; i + 64 <= tt; i += 64) { float ta[64], tb[64];
#pragma unroll
            for (int k = 0; k < 64; ++k) { ta[k] = sa[(size_t)(i + k) * 512]; tb[k] = sb[(size_t)(i + k) * 512]; }
#pragma unroll
            for (int k = 0; k < 64; ++k) Hc = ta[k] * Hc + tb[k]; }
        for (; i + 16 <= tt; i += 16) { float ta[16], tb[16];
#pragma unroll
            for (int k = 0; k < 16; ++k) { ta[k] = sa[(size_t)(i + k) * 512]; tb[k] = sb[(size_t)(i + k) * 512]; }
#pragma unroll
            for (int k = 0; k < 16; ++k) Hc = ta[k] * Hc + tb[k]; }
        for (; i < tt; ++i) Hc = sa[(size_t)i * 512] * Hc + sb[(size_t)i * 512];
        asm volatile("" : "+v"(Hc));
    }
    {
        const int ch = ch0 + lane; const float* cw = A.in[10]; const float cb = A.in[11][ch];
        const float w0 = cw[ch], w1 = cw[512 + ch], w2 = cw[1024 + ch], w3 = cw[1536 + ch];
        const bf16* up = F.U() + (size_t)t0 * 512 + ch;
        float u0 = 0.f, u1 = 0.f, u2 = 0.f;
        if (tt > 0) { u0 = bf2f(up[-3 * 512]); u1 = bf2f(up[-2 * 512]); u2 = bf2f(up[-1 * 512]); }
        unsigned short ur[64];
#pragma unroll
        for (int tok = 0; tok < 64; ++tok) ur[tok] = up[(size_t)tok * 512];
#pragma unroll
        for (int tok = 0; tok < 64; ++tok) { const float u3 = bf2f(ur[tok]);
            UC[UC_IDX(tok, lane)] = cb + ((u0 * w0 + u1 * w1) + (u2 * w2 + u3 * w3)); u0 = u1; u1 = u2; u2 = u3; }
    }
    bf16x8 Ba[4][2], Bx[4][2];
#pragma unroll
    for (int nt = 0; nt < 4; ++nt)
#pragma unroll
        for (int ks = 0; ks < 2; ++ks) { const size_t o = (size_t)w * 4096 + (16 * nt + fr) * 64 + 32 * ks + 8 * fq; Ba[nt][ks] = *(const bf16x8*)(F.LWA() + o); Bx[nt][ks] = *(const bf16x8*)(F.LWX() + o); }
    float ba[4], bx[4], sp8[4], hin[4], acum[4];
#pragma unroll
    for (int nt = 0; nt < 4; ++nt) { const int ch = ch0 + 16 * nt + fr; ba[nt] = A.in[13][ch]; bx[nt] = A.in[15][ch];
        sp8[nt] = 8.0f * log1pf(expf(-A.in[16][ch])); hin[nt] = 0.f; acum[nt] = 1.f; }
    if (FINAL) {
#pragma unroll
        for (int nt = 0; nt < 4; ++nt) hin[nt] = __shfl(Hc, 16 * nt + fr);
    }
    LDS_WAIT();
    unsigned short glv[16], gln[16];
    if (FINAL) {
#pragma unroll
        for (int nt = 0; nt < 4; ++nt)
#pragma unroll
            for (int rg = 0; rg < 4; ++rg) glv[nt * 4 + rg] = F.GL()[(size_t)(t0 + 4 * fq + rg) * 512 + ch0 + 16 * nt + fr];
    }
#pragma unroll 1
    for (int mt = 0; mt < 4; ++mt) {
        if (FINAL && mt < 3) {
#pragma unroll
            for (int nt = 0; nt < 4; ++nt)
#pragma unroll
                for (int rg = 0; rg < 4; ++rg) gln[nt * 4 + rg] = F.GL()[(size_t)(t0 + 16 * (mt + 1) + 4 * fq + rg) * 512 + ch0 + 16 * nt + fr];
        }
        bf16x8 Af[2];
#pragma unroll
        for (int ks = 0; ks < 2; ++ks) { const int tok = 16 * mt + fr, c0 = 8 * ks + 2 * fq;
            const f32x4 x0 = *(const LAS f32x4*)(UC + tok * 64 + ((c0 ^ (tok & 15)) << 2)), x1 = *(const LAS f32x4*)(UC + tok * 64 + (((c0 + 1) ^ (tok & 15)) << 2));
            u32x4 pw; pw.x = cvtpk(x0[0], x0[1]); pw.y = cvtpk(x0[2], x0[3]); pw.z = cvtpk(x1[0], x1[1]); pw.w = cvtpk(x1[2], x1[3]); Af[ks] = __builtin_bit_cast(bf16x8, pw); }
        f32x4 cr[4], ci[4];
#pragma unroll
        for (int nt = 0; nt < 4; ++nt) { cr[nt] = (f32x4){0.f, 0.f, 0.f, 0.f}; ci[nt] = (f32x4){0.f, 0.f, 0.f, 0.f};
#pragma unroll
            for (int ks = 0; ks < 2; ++ks) { cr[nt] = __builtin_amdgcn_mfma_f32_16x16x32_bf16(Af[ks], Ba[nt][ks], cr[nt], 0, 0, 0); ci[nt] = __builtin_amdgcn_mfma_f32_16x16x32_bf16(Af[ks], Bx[nt][ks], ci[nt], 0, 0, 0); } }
#pragma unroll
        for (int nt = 0; nt < 4; ++nt) {
            float P[4], Hh[4];
#pragma unroll
            for (int rg = 0; rg < 4; ++rg) { const int tok = 16 * mt + 4 * fq + rg, e = 16 * nt + fr;
                const float ucv = UC[UC_IDX(tok, e)];
                const float r = fsigmoid(cr[nt][rg] + ba[nt]), ig = fsigmoid(ci[nt][rg] + bx[nt]);
                const float la = -r * sp8[nt]; const float a = __builtin_amdgcn_exp2f(la * LOG2E);
                const float x2 = 2.0f * la;
                const float ser = -x2 * (1.0f + x2 * (0.5f + x2 * (0.16666667f + x2 * (0.041666668f + x2 * 0.008333334f))));
                const float om = (x2 > -0.25f) ? ser : 1.0f - a * a;
                const float b = __builtin_amdgcn_sqrtf(om) * (ig * ucv);
                if (!FINAL) {
                    const float so = -la * (1.0f + la * (0.5f + la * (0.16666667f + la * (0.041666668f + la * 0.008333334f))));
                    const float oma = (la > -0.25f) ? so : 1.0f - a; const size_t tg = (size_t)(t0 + tok); const int chg = ch0 + e;
                    F.XN()[tg * 1024 + 512 + chg] = (bf16)f2bf(oma); F.LB()[tg * 512 + chg] = (bf16)f2bf(b); }
                if (rg == 0) { P[0] = a; Hh[0] = b; } else { P[rg] = P[rg - 1] * a; Hh[rg] = a * Hh[rg - 1] + b; } }
            float At = P[3], Bt = Hh[3];
            { const float Ap = __shfl_up(At, 16), Bp = __shfl_up(Bt, 16); if (fq >= 1) { Bt = At * Bp + Bt; At = Ap * At; } }
            { const float Ap = __shfl_up(At, 32), Bp = __shfl_up(Bt, 32); if (fq >= 2) { Bt = At * Bp + Bt; At = Ap * At; } }
            float Aex = __shfl_up(At, 16), Bex = __shfl_up(Bt, 16); if (fq == 0) { Aex = 1.f; Bex = 0.f; }
            const float hg = Aex * hin[nt] + Bex;
            float hv[4];
#pragma unroll
            for (int rg = 0; rg < 4; ++rg) hv[rg] = P[rg] * hg + Hh[rg];
            hin[nt] = __shfl(hv[3], 48 + fr);
            if (!FINAL) acum[nt] *= __shfl(At, 48 + fr);
            if (FINAL) {
#pragma unroll
                for (int rg = 0; rg < 4; ++rg) { const size_t t = (size_t)(t0 + 16 * mt + 4 * fq + rg); const int ch = ch0 + 16 * nt + fr;
                    F.XN()[t * 1024 + 512 + ch] = (bf16)f2bf(hv[rg] * bf2f(glv[nt * 4 + rg])); }
            }
        }
        if (FINAL) {
#pragma unroll
            for (int x = 0; x < 16; ++x) glv[x] = gln[x];
        }
    }
    if (!FINAL && fq == 0) {
#pragma unroll
        for (int nt = 0; nt < 4; ++nt) { F.SUMA()[(size_t)tt * 512 + ch0 + 16 * nt + fr] = acum[nt]; F.SUMB()[(size_t)tt * 512 + ch0 + 16 * nt + fr] = hin[nt]; }
    }
    LDS_WAIT();
#undef UC_IDX
}

__device__ __forceinline__ void lru_apply(const Frame& F, int tt) {
    const int lane = lane_id(), ch = 64 * F.wave + lane, t0 = 64 * tt;
    float H = 0.f;
    { const float* sa = F.SUMA() + ch; const float* sb = F.SUMB() + ch; int i = 0;
        for (; i + 64 <= tt; i += 64) { float ta[64], tb[64];
#pragma unroll
            for (int k = 0; k < 64; ++k) { ta[k] = sa[(size_t)(i + k) * 512]; tb[k] = sb[(size_t)(i + k) * 512]; }
#pragma unroll
            for (int k = 0; k < 64; ++k) H = ta[k] * H + tb[k]; }
        for (; i + 16 <= tt; i += 16) { float ta[16], tb[16];
#pragma unroll
            for (int k = 0; k < 16; ++k) { ta[k] = sa[(size_t)(i + k) * 512]; tb[k] = sb[(size_t)(i + k) * 512]; }
#pragma unroll
            for (int k = 0; k < 16; ++k) H = ta[k] * H + tb[k]; }
        for (; i < tt; ++i) H = sa[(size_t)i * 512] * H + sb[(size_t)i * 512]; }
    bf16* px = F.XN() + (size_t)t0 * 1024 + 512 + ch; const bf16* pb = F.LB() + (size_t)t0 * 512 + ch; const bf16* pg = F.GL() + (size_t)t0 * 512 + ch;
#pragma unroll 1
    for (int c = 0; c < 2; ++c) { unsigned short av[32], bv[32], gv[32];
#pragma unroll
        for (int k = 0; k < 32; ++k) { const size_t tk = (size_t)(32 * c + k); av[k] = px[tk * 1024]; bv[k] = pb[tk * 512]; gv[k] = pg[tk * 512]; }
#pragma unroll
        for (int k = 0; k < 32; ++k) { H = (1.0f - bf2f(av[k])) * H + bf2f(bv[k]); px[(size_t)(32 * c + k) * 1024] = (bf16)f2bf(H * bf2f(gv[k])); } }
}

__device__ __forceinline__ void qk_norm_tile(const Frame& F, const Args& A, int tt) {
    const int lane = lane_id(), sub = lane & 7;
#pragma unroll 4
    for (int it = 0; it < 12; ++it) {
        const int idx = it * 64 + F.wave * 8 + (lane >> 3), tok = idx / 12, hr = idx % 12; const size_t t = (size_t)(64 * tt + tok);
        bf16* p; bf16* dst; const float* gain; float sc = 1.f;
        if (hr < 8) { p = F.Q() + t * 512 + hr * 64; dst = F.Q2() + t * 512 + (hr >> 2) * 256 + (sub >> 1) * 64 + (hr & 3) * 16 + (sub & 1) * 8 - sub * 8; gain = A.in[3]; sc = 0.125f * LOG2E; }
        else if (hr < 10) { p = F.KV() + t * 768 + 256 + (hr - 8) * 64; dst = p; gain = A.in[4] + 64; }
        else { p = F.KV() + t * 768 + 512 + (hr - 10) * 64; dst = p; gain = A.in[4] + 128; }
        const u32x4 w = *(const u32x4*)(p + sub * 8);
        float x[8] = {bflo(w.x), bfhi(w.x), bflo(w.y), bfhi(w.y), bflo(w.z), bfhi(w.z), bflo(w.w), bfhi(w.w)};
        float ss = 0.f;
#pragma unroll
        for (int j = 0; j < 8; ++j) ss += x[j] * x[j];
        ss += __shfl_xor(ss, 1); ss += __shfl_xor(ss, 2); ss += __shfl_xor(ss, 4);
        const float rs = sc / sqrtf(ss * (1.f / 64.f) + RMS_EPS);
        const f32x4 g0 = *(const f32x4*)(gain + sub * 8), g1 = *(const f32x4*)(gain + sub * 8 + 4);
        u32x4 o; o.x = pk2(x[0] * rs * g0.x, x[1] * rs * g0.y); o.y = pk2(x[2] * rs * g0.z, x[3] * rs * g0.w); o.z = pk2(x[4] * rs * g1.x, x[5] * rs * g1.y); o.w = pk2(x[6] * rs * g1.z, x[7] * rs * g1.w);
        *(u32x4*)(dst + sub * 8) = o;
        if (hr >= 8 && hr < 10) *(u32x4*)(F.KT() + ((size_t)((hr - 8) * 256 + tt) * 8 + sub) * 512 + tok * 8) = o;
    }
}

__device__ __forceinline__ void vt_tile(const Frame& F, int J) {
    const int tid = F.wave * 64 + lane_id(), d = tid & 63, ks = (tid >> 6) & 1, gp = tid >> 7;
#pragma unroll
    for (int g = 0; g < 2; ++g) {
        const bf16* vp = F.KV() + (size_t)(64 * J) * 768 + 384 + 64 * g + d;
        unsigned short e[8];
#pragma unroll
        for (int j = 0; j < 8; ++j) { const int key = 32 * ks + 4 * gp + (j & 3) + 16 * (j >> 2); e[j] = vp[(size_t)key * 768]; }
        u32x4 w; w.x = e[0] | ((unsigned)e[1] << 16); w.y = e[2] | ((unsigned)e[3] << 16); w.z = e[4] | ((unsigned)e[5] << 16); w.w = e[6] | ((unsigned)e[7] << 16);
        *(u32x4*)(F.VT() + (size_t)(g * 256 + J) * 4096 + ((((d >> 4) * 2 + ks) * 16 + (d & 15)) * 32) + 8 * gp) = w;
    }
}

__device__ __forceinline__ void compress_item(const Frame& F, const Args& A, int kv, int g, int ct) {
    const int lane = lane_id(), w = F.wave, tid = w * 64 + lane, fr = lane & 15, fq = lane >> 4, c0 = 16 * ct, tb = 16 * c0;
    LAS unsigned char* T = F.lds;
    LAS bf16* HID = (LAS bf16*)(F.lds + 34816);
    LAS float* OUTF = (LAS float*)(F.lds + 34816 + 8448);
    LAS float* C1L = (LAS float*)(F.lds + 34816 + 8448 + 4096);
    {
        u32x4 tv[5];
#pragma unroll
        for (int i = 0; i < 5; ++i) { const int idx = tid + 512 * i, tok = idx >> 3, chn = idx & 7, gt = tb + tok; tv[i] = (u32x4){0u, 0u, 0u, 0u};
            if (idx < 272 * 8 && gt < SEQ) tv[i] = *(const u32x4*)(F.KV() + (size_t)gt * 768 + kv * 128 + g * 64 + chn * 8); }
        { const int n = tid & 255, hf = tid >> 8; float pc[16];
#pragma unroll
            for (int k = 0; k < 16; ++k) pc[k] = F.C1()[((hf * 16 + k) * 2 + kv) * 256 + n];
            float s = hf ? 0.f : A.in[7][kv * 256 + n];
#pragma unroll
            for (int k = 0; k < 16; ++k) s += pc[k];
            C1L[hf * 256 + n] = s; }
#pragma unroll
        for (int i = 0; i < 5; ++i) { const int idx = tid + 512 * i, tok = idx >> 3, chn = idx & 7;
            if (idx < 272 * 8) *(LAS u32x4*)(T + tok * 128 + ((chn ^ ((tok >> 4) & 7)) << 4)) = tv[i]; }
    }
    LDS_WAIT(); __syncthreads();
    f32x4 acc[2] = {(f32x4){0.f, 0.f, 0.f, 0.f}, (f32x4){0.f, 0.f, 0.f, 0.f}};
    const bf16* w1t = F.W1T() + (size_t)kv * 256 * 2048 + (size_t)(32 * w + fr) * 2048 + 8 * fq;
#pragma unroll 32
    for (int ks = 0; ks < 64; ++ks) {
        const int tok = 16 * fr + (ks >> 1), chn = 4 * (ks & 1) + fq;
        const bf16x8 a = *(const LAS bf16x8*)(T + tok * 128 + ((chn ^ ((tok >> 4) & 7)) << 4));
        const bf16x8 b0 = *(const bf16x8*)(w1t + 32 * ks), b1 = *(const bf16x8*)(w1t + (size_t)16 * 2048 + 32 * ks);
        acc[0] = __builtin_amdgcn_mfma_f32_16x16x32_bf16(a, b0, acc[0], 0, 0, 0);
        acc[1] = __builtin_amdgcn_mfma_f32_16x16x32_bf16(a, b1, acc[1], 0, 0, 0);
    }
#pragma unroll
    for (int nt = 0; nt < 2; ++nt) { const int n = 32 * w + 16 * nt + fr; const float c1 = C1L[n] + C1L[256 + n];
#pragma unroll
        for (int rg = 0; rg < 4; ++rg) { const float v = acc[nt][rg] + c1; HID[(4 * fq + rg) * 264 + n] = (bf16)f2bf(v * fsigmoid(v)); } }
    LDS_WAIT(); __syncthreads();
    if (w < 4) {
        f32x4 o = (f32x4){0.f, 0.f, 0.f, 0.f};
        const bf16* w2t = F.W2T() + (size_t)kv * 64 * 256 + (size_t)(16 * w + fr) * 256 + 8 * fq;
#pragma unroll
        for (int ks = 0; ks < 8; ++ks) { const bf16x8 a = *(const LAS bf16x8*)(HID + fr * 264 + 32 * ks + 8 * fq); const bf16x8 b = *(const bf16x8*)(w2t + 32 * ks);
            o = __builtin_amdgcn_mfma_f32_16x16x32_bf16(a, b, o, 0, 0, 0); }
#pragma unroll
        for (int rg = 0; rg < 4; ++rg) OUTF[(4 * fq + rg) * 64 + 16 * w + fr] = o[rg];
    }
    LDS_WAIT(); __syncthreads();
    {
        const int row = tid >> 5, e = 2 * (tid & 31), c = c0 + row;
        float v0 = OUTF[row * 64 + e], v1 = OUTF[row * 64 + e + 1];
        if (kv == 0) { float ss = v0 * v0 + v1 * v1;
#pragma unroll
            for (int o = 1; o < 32; o <<= 1) ss += __shfl_xor(ss, o);
            const float rs = 1.0f / sqrtf(ss * (1.f / 64.f) + RMS_EPS); v0 *= rs * A.in[4][e]; v1 *= rs * A.in[4][e + 1]; }
        if (c >= 1023) { v0 = 0.f; v1 = 0.f; }
        bf16* dst = (kv == 0 ? F.KC() : F.VC()) + ((size_t)g * 1024 + c) * 64 + e;
        *(unsigned*)dst = pk2(v0, v1);
    }
    LDS_WAIT(); __syncthreads();
}

namespace att {
constexpr int SLOTB = 8192, NSLOT = 3;
constexpr int L_K = 0, L_V = NSLOT * SLOTB, L_SC = 2 * NSLOT * SLOTB, L_OUT = L_SC + 65536, L_LUT = L_OUT + 32768, L_WSF = L_LUT + 2048, L_BM = L_WSF + 2048, L_REF = L_BM + 2048, L_LACC = L_REF + 1024, L_TL = L_LACC + 1024  , L_END = L_TL + 5120;
static_assert(L_END <= RING_BYTES, "attention LDS map");
constexpr int L_EX = 0  , L_HDR = 34816  , L_LEX = 35072  , L_NT = 36096  ;
constexpr float CLAMP = 100.0f;
constexpr float THR = 8.0f;
#define SBAR() __builtin_amdgcn_sched_barrier(0)
__device__ __forceinline__ int crow(int r, int hi) { return (r & 3) + 8 * (r >> 2) + 4 * hi; }
__device__ __forceinline__ void glds16(const void* gsrc, unsigned lds_dst) { unsigned keep;
    asm volatile("s_mov_b32 %0, m0\n\ts_mov_b32 m0, %2\n\ts_nop 0\n\tglobal_load_lds_dwordx4 %1, off\n\ts_mov_b32 m0, %0" : "=&s"(keep) : "v"(gsrc), "s"(lds_dst) : "memory"); }
__device__ __forceinline__ void qkt(f32x16& p0, f32x16& p1, const LAS unsigned char* Kslot, const bf16x8* qr, int r32, int hi) {
    const LAS unsigned char* kb = Kslot + hi * 1024 + r32 * 16;
    const f32x16 z = {0.f, 0.f, 0.f, 0.f, 0.f, 0.f, 0.f, 0.f, 0.f, 0.f, 0.f, 0.f, 0.f, 0.f, 0.f, 0.f};
#pragma unroll
    for (int d0 = 0; d0 < 4; ++d0) {
        const bf16x8 b0 = *(const LAS bf16x8*)(kb + d0 * 2048);
        const bf16x8 b1 = *(const LAS bf16x8*)(kb + d0 * 2048 + 512);
        if (d0 == 0) { p0 = __builtin_amdgcn_mfma_f32_32x32x16_bf16(b0, qr[0], z, 0, 0, 0); p1 = __builtin_amdgcn_mfma_f32_32x32x16_bf16(b1, qr[0], z, 0, 0, 0); }
        else { p0 = __builtin_amdgcn_mfma_f32_32x32x16_bf16(b0, qr[d0], p0, 0, 0, 0); p1 = __builtin_amdgcn_mfma_f32_32x32x16_bf16(b1, qr[d0], p1, 0, 0, 0); } }
}
__device__ __forceinline__ void pv(f32x16* o, int vb, bf16x8 pa0, bf16x8 pa1, bf16x8 pa2, bf16x8 pa3) {
    s16x4 lo[8], hi[8];
#pragma unroll
    for (int x = 0; x < 8; ++x) {
        asm volatile("ds_read_b64_tr_b16 %0,%1 offset:%c2" : "=&v"(lo[x]) : "v"(vb), "i"((x >> 2) * 4096 + (x & 3) * 1024) : "memory");
        asm volatile("ds_read_b64_tr_b16 %0,%1 offset:%c2" : "=&v"(hi[x]) : "v"(vb), "i"((x >> 2) * 4096 + (x & 3) * 1024 + 512) : "memory"); }
    asm volatile("s_waitcnt lgkmcnt(0)" ::: "memory"); SBAR();
#define PK(k) (bf16x8){lo[k][0], lo[k][1], lo[k][2], lo[k][3], hi[k][0], hi[k][1], hi[k][2], hi[k][3]}
    o[0] = __builtin_amdgcn_mfma_f32_32x32x16_bf16(pa0, PK(0), o[0], 0, 0, 0); o[1] = __builtin_amdgcn_mfma_f32_32x32x16_bf16(pa0, PK(4), o[1], 0, 0, 0);
    o[0] = __builtin_amdgcn_mfma_f32_32x32x16_bf16(pa1, PK(1), o[0], 0, 0, 0); o[1] = __builtin_amdgcn_mfma_f32_32x32x16_bf16(pa1, PK(5), o[1], 0, 0, 0);
    o[0] = __builtin_amdgcn_mfma_f32_32x32x16_bf16(pa2, PK(2), o[0], 0, 0, 0); o[1] = __builtin_amdgcn_mfma_f32_32x32x16_bf16(pa2, PK(6), o[1], 0, 0, 0);
    o[0] = __builtin_amdgcn_mfma_f32_32x32x16_bf16(pa3, PK(3), o[0], 0, 0, 0); o[1] = __builtin_amdgcn_mfma_f32_32x32x16_bf16(pa3, PK(7), o[1], 0, 0, 0);
#undef PK
}
__device__ __forceinline__ float rowmax(const f32x16& p0, const f32x16& p1) {
    float a = fmaxf(fmaxf(p0[0], p0[1]), p1[0]), b = fmaxf(fmaxf(p0[2], p0[3]), p1[1]); a = fmaxf(fmaxf(a, p1[2]), p1[3]);
#pragma unroll
    for (int r = 4; r < 16; r += 4) { a = fmaxf(fmaxf(a, p0[r]), p0[r + 1]); b = fmaxf(fmaxf(b, p0[r + 2]), p0[r + 3]); a = fmaxf(fmaxf(a, p1[r]), p1[r + 1]); b = fmaxf(fmaxf(b, p1[r + 2]), p1[r + 3]); }
    const float m = fmaxf(a, b);
    auto rr = __builtin_amdgcn_permlane32_swap(__float_as_uint(m), __float_as_uint(m), false, false);
    return fmaxf(__uint_as_float(rr[0]), __uint_as_float(rr[1]));
}
__device__ __forceinline__ float halfsum(float v) { auto rr = __builtin_amdgcn_permlane32_swap(__float_as_uint(v), __float_as_uint(v), false, false); return __uint_as_float(rr[0]) + __uint_as_float(rr[1]); }
template <int STEP, unsigned LIMIT>
__device__ __forceinline__ void near_apply(f32x16& p0, f32x16& p1, int dbase, const LAS float* lut) {
    float b0[16], b1[16];
#pragma unroll
    for (int r = 0; r < 16; ++r) { const int koff = (r & 3) + 8 * (r >> 2); const int d0 = dbase - STEP * koff, d1 = d0 - STEP * 32;
        b0[r] = lut[4 * min(max(d0, 0), 127)]; b1[r] = lut[4 * min(max(d1, 0), 127)]; }
#pragma unroll
    for (int r = 0; r < 16; ++r) { asm volatile("" : "+v"(b0[r]), "+v"(b1[r])); }
#pragma unroll
    for (int r = 0; r < 16; ++r) { const int koff = (r & 3) + 8 * (r >> 2); const int d0 = dbase - STEP * koff, d1 = d0 - STEP * 32;
        const float t0 = p0[r] + b0[r], t1 = p1[r] + b1[r];
        p0[r] = ((unsigned)d0 < LIMIT) ? t0 : -INFINITY; p1[r] = ((unsigned)d1 < LIMIT) ? t1 : -INFINITY; }
}
template <bool HASO>
__device__ __forceinline__ void sm_update(f32x16& p0, f32x16& p1, float bias, float& m, float& l, f32x16* o, LAS float* wsf, int r32, int hi) {
    const float rm = rowmax(p0, p1) + bias;
    const bool need = rm > m + THR;
    if (__any(need)) {
        const float mn = need ? rm : m; const float alpha = __builtin_amdgcn_exp2f(m - mn);
        l *= alpha; m = mn;
        if (HASO) { if (hi == 0) wsf[r32] = alpha; LDS_WAIT();
#pragma unroll
            for (int r = 0; r < 16; ++r) { const float f = wsf[crow(r, hi)]; o[0][r] *= f; o[1][r] *= f; } }
    }
    const float mb = m - bias;
#pragma unroll
    for (int r = 0; r < 16; ++r) { p0[r] = __builtin_amdgcn_exp2f(p0[r] - mb); p1[r] = __builtin_amdgcn_exp2f(p1[r] - mb); }
    float t[8];
#pragma unroll
    for (int r = 0; r < 8; ++r) t[r] = (p0[2 * r] + p0[2 * r + 1]) + (p1[2 * r] + p1[2 * r + 1]);
    l += ((t[0] + t[1]) + (t[2] + t[3])) + ((t[4] + t[5]) + (t[6] + t[7]));
}
#define ATT_PACK(P0, P1) \
    const bf16x8 pa0 = __builtin_bit_cast(bf16x8, (u32x4){cvtpk(P0[0], P0[1]), cvtpk(P0[2], P0[3]), cvtpk(P0[4], P0[5]), cvtpk(P0[6], P0[7])}); \
    const bf16x8 pa1 = __builtin_bit_cast(bf16x8, (u32x4){cvtpk(P0[8], P0[9]), cvtpk(P0[10], P0[11]), cvtpk(P0[12], P0[13]), cvtpk(P0[14], P0[15])}); \
    const bf16x8 pa2 = __builtin_bit_cast(bf16x8, (u32x4){cvtpk(P1[0], P1[1]), cvtpk(P1[2], P1[3]), cvtpk(P1[4], P1[5]), cvtpk(P1[6], P1[7])}); \
    const bf16x8 pa3 = __builtin_bit_cast(bf16x8, (u32x4){cvtpk(P1[8], P1[9]), cvtpk(P1[10], P1[11]), cvtpk(P1[12], P1[13]), cvtpk(P1[14], P1[15])});
#define ATT_WAITBAR(N) asm volatile("s_waitcnt vmcnt(" #N ") lgkmcnt(0)\n\ts_barrier" ::: "memory")
#define ATT_FILL(V, x) do { _Pragma("unroll") for (int _r = 0; _r < 16; ++_r) V[_r] = (x); } while (0)

__device__ __forceinline__ unsigned rangemask(int k, int a, int b) {
    const int lo = max(a - 32 * k, 0), hi = min(b - 32 * k, 31);
    return (lo > hi) ? 0u : ((0xFFFFFFFFu >> (31 - hi)) & (0xFFFFFFFFu << lo));
}
__device__ __forceinline__ int wave_max_i32(int x) {
    x = max(x, dpp_i<0xB1>(x)); x = max(x, dpp_i<0x4E>(x)); x = max(x, dpp_i<0x141>(x)); x = max(x, dpp_i<0x140>(x));
    return max(max(__builtin_amdgcn_readlane(x, 0), __builtin_amdgcn_readlane(x, 16)), max(__builtin_amdgcn_readlane(x, 32), __builtin_amdgcn_readlane(x, 48)));
}

__device__ __forceinline__ void lds_add_f32(LAS float* p, float v) { (void)__hip_atomic_fetch_add(p, v, __ATOMIC_RELAXED, __HIP_MEMORY_SCOPE_WORKGROUP); }

__device__ __forceinline__ void attn_item(const Frame& F, int qt, int g) {
    const int lane = lane_id(), wid = F.wave, tid = wid * 64 + lane, r32 = lane & 31, hi = lane >> 5;
    const int ql = r32 >> 2, h = r32 & 3, cur = qt, t = 64 * qt + 8 * wid + ql, head = 4 * g + h;
    LAS unsigned char* shm = F.lds;
    const unsigned lds0 = (unsigned)(uintptr_t)shm;
    LAS float* wsf = (LAS float*)(shm + L_WSF) + wid * 64;
    LAS float* SC = (LAS float*)(shm + L_SC);
    LAS float* OACC = (LAS float*)(shm + L_SC);
    LAS float* lutl = (LAS float*)(shm + L_LUT);
    const LAS float* luth = lutl + h;
    LAS unsigned* BM = (LAS unsigned*)(shm + L_BM);
    LAS float* REF = (LAS float*)(shm + L_REF);
    LAS float* LACC = (LAS float*)(shm + L_LACC);
    lutl[4 * (tid & 127) + (tid >> 7)] = F.LUT()[(4 * g + (tid >> 7)) * 128 + (tid & 127)];
    BM[tid] = 0u;
    LAS bf16* QL = (LAS bf16*)(shm + L_OUT);
#pragma unroll
    for (int i = 0; i < 4; ++i) { const int chn = tid + 512 * i;
        *(LAS u32x4*)(QL + (chn >> 5) * 256 + (chn & 31) * 8) = *(const u32x4*)(F.Q2() + (size_t)(64 * qt + (chn >> 5)) * 512 + g * 256 + (chn & 31) * 8); }
    bf16x8 qr[4];
    { const bf16* qp = F.Q2() + (size_t)t * 512 + g * 256 + h * 16 + hi * 8;
#pragma unroll
        for (int d0 = 0; d0 < 4; ++d0) qr[d0] = *(const bf16x8*)(qp + d0 * 64); }
    const float b31 = F.LUT()[head * 128 + 127];
    const float gate_c = fsigmoid(bf2f(F.BR()[(size_t)t * 256 + head])), gate_s = fsigmoid(bf2f(F.BR()[(size_t)t * 256 + 8 + head])), gate_w = fsigmoid(bf2f(F.BR()[(size_t)t * 256 + 16 + head]));
    f32x16 o[2], p0, p1;
    const unsigned kdst = lds0 + L_K + wid * 1024, vdst = lds0 + L_V + wid * 1024;
    const int vrow = 16 * (wid & 3) + (lane >> 2), vcol = (wid >> 2) * 32 + (lane & 3) * 8;
    const int vb0 = (int)(lds0 + L_V) + ((lane >> 4) & 1) * 32 + (lane & 3) * 8 + (4 * hi + ((lane & 15) >> 2)) * 64;
#define DMA_K(base, pitch, row0, slot) glds16((base) + (size_t)((row0) + lane) * (pitch) + wid * 8, (unsigned)__builtin_amdgcn_readfirstlane(kdst + (slot)))
#define DMA_V(base, pitch, row0, slot) glds16((base) + (size_t)((row0) + vrow) * (pitch) + vcol, (unsigned)__builtin_amdgcn_readfirstlane(vdst + (slot)))
#define ROT() do { sl_cur = sl_next; sl_next = (sl_next == (NSLOT - 1) * SLOTB) ? 0 : sl_next + SLOTB; } while (0)
    VM_WAIT(); LDS_WAIT(); __syncthreads();

    const bf16* KCg = F.KC() + (size_t)g * 1024 * 64; const bf16* VCg = F.VC() + (size_t)g * 1024 * 64;
    const int nkt = (qt >> 4) + 1;
    const int tminw = 64 * qt + 8 * wid;
    float m = -1e30f, l = 0.f;
    {
        int sl_cur = 0, sl_next = SLOTB;
        DMA_K(KCg, 64, 0, 0);
        for (int kt = 0; kt < nkt; ++kt) {
            if (kt + 1 < nkt) { DMA_K(KCg, 64, 64 * (kt + 1), sl_next); ATT_WAITBAR(1); } else { ATT_WAITBAR(0); }
            const bool far = (tminw - 31 - 16 * (64 * kt + 63)) >= 128;
            qkt(p0, p1, shm + L_K + sl_cur, qr, r32, hi);
            if (!far) near_apply<16, 0x80000000u>(p0, p1, t - 31 - 16 * (64 * kt + 4 * hi), luth);
            sm_update<false>(p0, p1, far ? b31 : 0.f, m, l, o, wsf, r32, hi);
            ROT();
        }
        LDS_WAIT(); __builtin_amdgcn_s_barrier();
    }
    {
        const float lt = halfsum(l); const float rl = lt > 0.f ? 1.0f / lt : 0.f;
        ATT_FILL(o[0], 0.f); ATT_FILL(o[1], 0.f);
        float carry = 0.f;
        int sl_cur = 0, sl_next = SLOTB;
        DMA_K(KCg, 64, 0, 0); DMA_V(VCg, 64, 0, 0);
        for (int kt = 0; kt < nkt; ++kt) {
            if (kt + 1 < nkt) { DMA_K(KCg, 64, 64 * (kt + 1), sl_next); DMA_V(VCg, 64, 64 * (kt + 1), sl_next); ATT_WAITBAR(2); } else { ATT_WAITBAR(0); }
            const bool far = (tminw - 31 - 16 * (64 * kt + 63)) >= 128;
            qkt(p0, p1, shm + L_K + sl_cur, qr, r32, hi);
            if (!far) near_apply<16, 0x80000000u>(p0, p1, t - 31 - 16 * (64 * kt + 4 * hi), luth);
            const float mb2 = far ? m - b31 : m;
#pragma unroll
            for (int r = 0; r < 16; ++r) { p0[r] = __builtin_amdgcn_exp2f(p0[r] - mb2) * rl; p1[r] = __builtin_amdgcn_exp2f(p1[r] - mb2) * rl; }
            {
                float q4[8], e[8];
#pragma unroll
                for (int i = 0; i < 4; ++i) { q4[i] = (p0[4 * i] + p0[4 * i + 1]) + (p0[4 * i + 2] + p0[4 * i + 3]); e[i] = p0[4 * i + 3];
                                              q4[4 + i] = (p1[4 * i] + p1[4 * i + 1]) + (p1[4 * i + 2] + p1[4 * i + 3]); e[4 + i] = p1[4 * i + 3]; }
                float newcarry = 0.f;
#pragma unroll
                for (int i = 0; i < 8; ++i) { auto rr = __builtin_amdgcn_permlane32_swap(__float_as_uint(e[i]), __float_as_uint(e[i]), false, false);
                    const float elo = __uint_as_float(rr[0]), ehi = __uint_as_float(rr[1]);
                    if (hi) q4[i] += elo; else if (i < 7) q4[i + 1] += ehi;
                    if (i == 7) newcarry = ehi; }
                if (!hi) q4[0] += carry;
                carry = newcarry;
#pragma unroll
                for (int i = 0; i < 8; ++i) { float v = q4[i]; v += dpp_f<0xB1>(v); v += dpp_f<0x4E>(v); q4[i] = v; }
                if (h == 0) {
#pragma unroll
                    for (int i = 0; i < 8; ++i) SC[(8 * wid + ql) * 256 + 16 * kt + 2 * i + hi] = q4[i]; }
            }
            { ATT_PACK(p0, p1); pv(o, vb0 + sl_cur, pa0, pa1, pa2, pa3); }
            ROT();
        }
        LDS_WAIT(); __builtin_amdgcn_s_barrier();
    }

    if (cur >= 16) {
        const int u4 = lane >> 4, li16 = lane & 15;
#pragma unroll 1
        for (int qb = 0; qb < 8; qb += 4) {
            const int qloc = 8 * wid + qb + u4;
            const LAS float* row = SC + qloc * 256 + li16;
            int v[16];
#pragma unroll
            for (int k = 0; k < 16; ++k) { const int J = li16 + 16 * k; const int x = (__float_as_int(row[16 * k]) & ~255) | (255 - J); v[k] = (J >= 1 && J <= cur - 2) ? x : -1; }
            LAS unsigned* bmq = BM + (qloc >> 5); const unsigned qbit = 1u << (qloc & 31);
#pragma unroll 1
            for (int round = 0; round < 13; ++round) {
                int lm = max(max(max(v[0], v[1]), max(v[2], v[3])), max(max(v[4], v[5]), max(v[6], v[7])));
                lm = max(lm, max(max(max(v[8], v[9]), max(v[10], v[11])), max(max(v[12], v[13]), max(v[14], v[15]))));
                int rm = lm; rm = max(rm, dpp_i<0xB1>(rm)); rm = max(rm, dpp_i<0x4E>(rm)); rm = max(rm, dpp_i<0x141>(rm)); rm = max(rm, dpp_i<0x140>(rm));
                if (lm == rm) {
#pragma unroll
                    for (int k = 0; k < 16; ++k) v[k] = (v[k] == rm) ? -1 : v[k];
                    __hip_atomic_fetch_or(bmq + 2 * (255 - (rm & 255)), qbit, __ATOMIC_RELAXED, __HIP_MEMORY_SCOPE_WORKGROUP);
                }
            }
        }
    }
    LDS_WAIT();
    LAS float* ostg = (LAS float*)(shm + L_SC) + wid * 2048;
    {
        if (hi == 0) wsf[r32] = gate_c; LDS_WAIT();
#pragma unroll
        for (int r = 0; r < 16; ++r) { const float f = wsf[crow(r, hi)]; const int orow = crow(r, hi); ostg[orow * 64 + r32] = o[0][r] * f; ostg[orow * 64 + 32 + r32] = o[1][r] * f; }
    }

    const bf16* Kw = F.KV() + 512 + g * 64; const bf16* Vw = F.KV() + 640 + g * 64;
    {
        m = -1e30f; l = 0.f; ATT_FILL(o[0], 0.f); ATT_FILL(o[1], 0.f);
        const int J0 = max(cur - 8, 0);
        int sl_cur = 0, sl_next = SLOTB;
        DMA_K(Kw, 768, 64 * J0, 0); DMA_V(Vw, 768, 64 * J0, 0);
        for (int J = J0; J <= cur; ++J) {
            if (J + 1 <= cur) { DMA_K(Kw, 768, 64 * (J + 1), sl_next); DMA_V(Vw, 768, 64 * (J + 1), sl_next); ATT_WAITBAR(2); } else { ATT_WAITBAR(0); }
            const bool nearw = (J >= cur - 2 || J == cur - 8);
            qkt(p0, p1, shm + L_K + sl_cur, qr, r32, hi);
            if (nearw) near_apply<1, 512u>(p0, p1, t - 64 * J - 4 * hi, luth);
            sm_update<true>(p0, p1, nearw ? 0.f : b31, m, l, o, wsf, r32, hi);
            { ATT_PACK(p0, p1); pv(o, vb0 + sl_cur, pa0, pa1, pa2, pa3); }
            ROT();
        }
        LDS_WAIT(); __builtin_amdgcn_s_barrier();
        const float lt = halfsum(l); const float fw = lt > 0.f ? gate_w / lt : 0.f;
        if (hi == 0) wsf[r32] = fw; LDS_WAIT();
#pragma unroll
        for (int r = 0; r < 16; ++r) { const float f = wsf[crow(r, hi)]; const int orow = crow(r, hi); ostg[orow * 64 + r32] += o[0][r] * f; ostg[orow * 64 + 32 + r32] += o[1][r] * f; }
        LDS_WAIT();
#pragma unroll
        for (int i = 0; i < 4; ++i) { const int rowl = i * 8 + (lane >> 3), chn = lane & 7;
            const f32x4 a0 = *(const LAS f32x4*)(ostg + rowl * 64 + chn * 8), a1 = *(const LAS f32x4*)(ostg + rowl * 64 + chn * 8 + 4);
            const size_t tt = (size_t)(64 * qt + 8 * wid + (rowl >> 2)); const int col = (4 * g + (rowl & 3)) * 64 + chn * 8;
            *(u32x4*)(F.XN() + tt * 1024 + col) = (u32x4){cvtpk(a0[0], a0[1]), cvtpk(a0[2], a0[3]), cvtpk(a1[0], a1[1]), cvtpk(a1[2], a1[3])}; }
        LDS_WAIT();
    }

    const bf16* Ks = F.KV() + 256 + g * 64; const bf16* Vs = F.KV() + 384 + g * 64;
    {
        m = -1e30f; l = 0.f; ATT_FILL(o[0], 0.f); ATT_FILL(o[1], 0.f);
        const int nA = (cur < 16) ? cur + 1 : 3;
#define JA(i) ((cur < 16) ? (i) : ((i) == 0 ? 0 : cur - 2 + (i)))
        int sl_cur = 0, sl_next = SLOTB;
        DMA_K(Ks, 768, 0, 0); DMA_V(Vs, 768, 0, 0);
        for (int i = 0; i < nA; ++i) {
            const int J = JA(i);
            if (i + 1 < nA) { const int Jn = JA(i + 1); DMA_K(Ks, 768, 64 * Jn, sl_next); DMA_V(Vs, 768, 64 * Jn, sl_next); ATT_WAITBAR(2); } else { ATT_WAITBAR(0); }
            const bool neara = (J >= cur - 2);
            qkt(p0, p1, shm + L_K + sl_cur, qr, r32, hi);
            if (neara) near_apply<1, 0x80000000u>(p0, p1, t - 64 * J - 4 * hi, luth);
            sm_update<true>(p0, p1, neara ? 0.f : b31, m, l, o, wsf, r32, hi);
            { ATT_PACK(p0, p1); pv(o, vb0 + sl_cur, pa0, pa1, pa2, pa3); }
            ROT();
        }
#undef JA
        LDS_WAIT(); __builtin_amdgcn_s_barrier();
        const float lt = halfsum(l);
        if (hi == 0) { REF[32 * wid + r32] = m; LACC[32 * wid + r32] = lt; }
#pragma unroll
        for (int r = 0; r < 16; ++r) { const int orow = 32 * wid + crow(r, hi); OACC[orow * 64 + r32] = o[0][r]; OACC[orow * 64 + 32 + r32] = o[1][r]; }
        LDS_WAIT(); __builtin_amdgcn_s_barrier();
    }

    if (cur >= 16) {
        const int c16 = lane & 15, gq = lane >> 4, qi4 = c16 >> 2;
        const bf16* KTg = F.KT() + (size_t)g * 256 * 4096 + gq * 512 + c16 * 8; const bf16* VTg = F.VT() + (size_t)g * 256 * 4096 + c16 * 32 + 8 * gq;
        const LAS bf16* QLg = QL + (gq >> 1) * 64 + h * 16 + 8 * (gq & 1);
        LAS unsigned* TL = (LAS unsigned*)(shm + L_TL) + wid * 160;
        int ntask = 0;
#pragma unroll 1
        for (int i4 = 0; i4 < 4; ++i4) {
            const int Jl = lane + 64 * i4; int nch = 0;
            unsigned long long mk = 0ull;
            if (Jl >= 1 && Jl <= cur - 2 && (Jl & 7) == wid) { mk = ((unsigned long long)BM[2 * Jl + 1] << 32) | BM[2 * Jl]; nch = (__popcll(mk) + 3) >> 2; }
            int incl = nch;
#pragma unroll
            for (int o = 1; o < 64; o <<= 1) { const int up = __shfl_up(incl, o); if (lane >= o) incl += up; }
            const int base = ntask + incl - nch;
            for (int c = 0; c < nch; ++c) { unsigned e = (unsigned)Jl; int q0 = 0;
#pragma unroll
                for (int k = 0; k < 4; ++k) { int q = q0; if (mk) { q = __builtin_ctzll(mk); mk &= mk - 1; } if (k == 0) q0 = q; e |= (unsigned)q << (8 + 6 * k); }
                if (base + c < 160) TL[base + c] = e; }
            ntask += __shfl(incl, 63);
        }
        ntask = min(ntask, 160);
        LAS bf16* EX = (LAS bf16*)(shm + L_EX); LAS int* HDR = (LAS int*)(shm + L_HDR); LAS float* LEX = (LAS float*)(shm + L_LEX); LAS int* NT = (LAS int*)(shm + L_NT);
        if (lane == 0) NT[wid] = ntask;
        LDS_WAIT(); __builtin_amdgcn_s_barrier();
        int nround = 0;
#pragma unroll
        for (int k = 0; k < 8; ++k) nround = max(nround, __builtin_amdgcn_readfirstlane(NT[k]));
        bf16x8 kfC[8], vfC[8];
#define LOADK(J_, KF) do { const bf16* kp_ = KTg + (size_t)(J_) * 4096; \
            _Pragma("unroll") for (int kt = 0; kt < 4; ++kt) { KF[2 * kt] = *(const bf16x8*)(kp_ + kt * 128); KF[2 * kt + 1] = *(const bf16x8*)(kp_ + 2048 + kt * 128); } } while (0)
#define LOADV(J_, VF) do { const bf16* vp_ = VTg + (size_t)(J_) * 4096; _Pragma("unroll") for (int x = 0; x < 8; ++x) VF[x] = *(const bf16x8*)(vp_ + x * 512); } while (0)
        unsigned e_cur = 0xffu;
        bf16x8 qg0 = {0, 0, 0, 0, 0, 0, 0, 0}, qg1 = {0, 0, 0, 0, 0, 0, 0, 0}; float ref = 0.f;
#define QFETCH(E) do { const int mq_ = ((E) >> (8 + 6 * qi4)) & 63; const LAS bf16* qp_ = QLg + mq_ * 256; qg0 = *(const LAS bf16x8*)(qp_); qg1 = *(const LAS bf16x8*)(qp_ + 128); ref = REF[4 * mq_ + h]; } while (0)
        if (ntask > 0) { e_cur = (unsigned)__builtin_amdgcn_readfirstlane((int)TL[0]); LOADK(e_cur & 255u, kfC); LOADV(e_cur & 255u, vfC); QFETCH(e_cur); }
        float oa[2][16], la2[2];
#pragma unroll
        for (int p = 0; p < 2; ++p) { la2[p] = 0.f;
#pragma unroll
            for (int k = 0; k < 16; ++k) oa[p][k] = 0.f; }
#pragma unroll 1
        for (int n = 0; n < nround; ++n) {
            const int buf = n & 1;
            if (n < ntask) {
                const unsigned e_nxt = (n + 1 < ntask) ? (unsigned)__builtin_amdgcn_readfirstlane((int)TL[n + 1]) : 0xffu;
                const unsigned e_ = e_cur; const int Jb = e_ & 255, Jn = e_nxt & 255; const bool reload = (Jn != Jb) && (Jn != 255);
                const int q0_ = (e_ >> 8) & 63;
                const int myq = (e_ >> (8 + 6 * qi4)) & 63; const bool valid = (qi4 == 0) || (myq != q0_); const int tq = 64 * qt + myq;
                const bool nearJ = (Jb >= cur - 2);
                const float cinit = nearJ ? 0.f : (valid ? b31 - ref : -INFINITY);
                f32x4 s[4];
#pragma unroll
                for (int kt = 0; kt < 4; ++kt) { s[kt] = (f32x4){0.f, 0.f, 0.f, 0.f};
                    s[kt] = __builtin_amdgcn_mfma_f32_16x16x32_bf16(kfC[2 * kt], qg0, s[kt], 0, 0, 0); s[kt] = __builtin_amdgcn_mfma_f32_16x16x32_bf16(kfC[2 * kt + 1], qg1, s[kt], 0, 0, 0); }
                if (reload) LOADK(Jn, kfC);
                const float refc = ref;
                if (n + 1 < ntask) QFETCH(e_nxt);
                if (nearJ) { const float sub = valid ? refc : INFINITY;
                    float bb[16];
#pragma unroll
                    for (int kt = 0; kt < 4; ++kt)
#pragma unroll
                        for (int r = 0; r < 4; ++r) { const int dd = tq - 64 * Jb - (16 * kt + 4 * gq + r); bb[kt * 4 + r] = luth[4 * min(max(dd, 0), 127)]; }
#pragma unroll
                    for (int x = 0; x < 16; ++x) asm volatile("" : "+v"(bb[x]));
#pragma unroll
                    for (int kt = 0; kt < 4; ++kt)
#pragma unroll
                        for (int r = 0; r < 4; ++r) { const int dd = tq - 64 * Jb - (16 * kt + 4 * gq + r); const float tt = s[kt][r] + bb[kt * 4 + r] - sub;
                            s[kt][r] = (dd >= 0) ? tt : -INFINITY; } }
#pragma unroll
                for (int kt = 0; kt < 4; ++kt)
#pragma unroll
                    for (int r = 0; r < 4; ++r) { const int tb = min(__float_as_int(s[kt][r] + cinit), __float_as_int(CLAMP));
                        s[kt][r] = __builtin_amdgcn_exp2f(__int_as_float(tb)); }
                float ls = (((s[0][0] + s[0][1]) + (s[0][2] + s[0][3])) + ((s[1][0] + s[1][1]) + (s[1][2] + s[1][3]))) + (((s[2][0] + s[2][1]) + (s[2][2] + s[2][3])) + ((s[3][0] + s[3][1]) + (s[3][2] + s[3][3])));
                { auto r16 = __builtin_amdgcn_permlane16_swap(__float_as_uint(ls), __float_as_uint(ls), false, false); ls = __uint_as_float(r16[0]) + __uint_as_float(r16[1]); }
                ls = halfsum(ls);
                bf16x8 pb[2];
#pragma unroll
                for (int ks = 0; ks < 2; ++ks) pb[ks] = __builtin_bit_cast(bf16x8, (u32x4){cvtpk(s[2 * ks][0], s[2 * ks][1]), cvtpk(s[2 * ks][2], s[2 * ks][3]), cvtpk(s[2 * ks + 1][0], s[2 * ks + 1][1]), cvtpk(s[2 * ks + 1][2], s[2 * ks + 1][3])});
                LAS bf16* ex = EX + buf * 8704 + ((wid * 4 + qi4) * 4 + h) * 68 + 4 * gq;
                f32x4 ot[4];
#pragma unroll
                for (int mt = 0; mt < 4; ++mt) { ot[mt] = (f32x4){0.f, 0.f, 0.f, 0.f};
                    ot[mt] = __builtin_amdgcn_mfma_f32_16x16x32_bf16(vfC[2 * mt], pb[0], ot[mt], 0, 0, 0); ot[mt] = __builtin_amdgcn_mfma_f32_16x16x32_bf16(vfC[2 * mt + 1], pb[1], ot[mt], 0, 0, 0); }
                if (reload) LOADV(Jn, vfC);
#pragma unroll
                for (int mt = 0; mt < 4; ++mt) *(LAS u32x2*)(ex + 16 * mt) = (u32x2){cvtpk(ot[mt][0], ot[mt][1]), cvtpk(ot[mt][2], ot[mt][3])};
                if (gq == 0) { LEX[buf * 128 + wid * 16 + c16] = ls; if (h == 0) HDR[buf * 32 + wid * 4 + qi4] = valid ? myq : -1; }
                e_cur = e_nxt;
            } else if (lane < 4) HDR[buf * 32 + wid * 4 + lane] = -1;
            LDS_WAIT(); __builtin_amdgcn_s_barrier();
            {
                const int hv = (lane < 32) ? HDR[buf * 32 + lane] : -1;
                const int li = lane & 15, hsel = li >> 2, dq = (li & 3) * 16;
#pragma unroll
                for (int pass = 0; pass < 2; ++pass) {
                    const unsigned m0 = (unsigned)__ballot(hv == 8 * wid + 4 * pass + 0), m1 = (unsigned)__ballot(hv == 8 * wid + 4 * pass + 1), m2 = (unsigned)__ballot(hv == 8 * wid + 4 * pass + 2), m3 = (unsigned)__ballot(hv == 8 * wid + 4 * pass + 3);
                    if ((m0 | m1 | m2 | m3) == 0u) continue;
                    unsigned mm = gq == 0 ? m0 : gq == 1 ? m1 : gq == 2 ? m2 : m3;
                    while (mm) { const int e = __builtin_ctz(mm); mm &= mm - 1;
                        const LAS bf16* xr = EX + buf * 8704 + (e * 4 + hsel) * 68 + dq;
                        const u32x2 y0 = *(const LAS u32x2*)(xr), y1 = *(const LAS u32x2*)(xr + 4), y2 = *(const LAS u32x2*)(xr + 8), y3 = *(const LAS u32x2*)(xr + 12);
                        const u32x4 x0 = {y0.x, y0.y, y1.x, y1.y}, x1 = {y2.x, y2.y, y3.x, y3.y};
                        oa[pass][0] += bflo(x0.x); oa[pass][1] += bfhi(x0.x); oa[pass][2] += bflo(x0.y); oa[pass][3] += bfhi(x0.y); oa[pass][4] += bflo(x0.z); oa[pass][5] += bfhi(x0.z); oa[pass][6] += bflo(x0.w); oa[pass][7] += bfhi(x0.w);
                        oa[pass][8] += bflo(x1.x); oa[pass][9] += bfhi(x1.x); oa[pass][10] += bflo(x1.y); oa[pass][11] += bfhi(x1.y); oa[pass][12] += bflo(x1.z); oa[pass][13] += bfhi(x1.z); oa[pass][14] += bflo(x1.w); oa[pass][15] += bfhi(x1.w);
                        la2[pass] += LEX[buf * 128 + e * 4 + hsel]; }
                }
            }
        }
        {
            const int li = lane & 15, hsel = li >> 2, dq = (li & 3) * 16;
#pragma unroll
            for (int pass = 0; pass < 2; ++pass) { const int q = 8 * wid + 4 * pass + gq; LAS f32x4* ap = (LAS f32x4*)(OACC + (4 * q + hsel) * 64 + dq);
#pragma unroll
                for (int k = 0; k < 4; ++k) { f32x4 a = ap[k]; a[0] += oa[pass][4 * k]; a[1] += oa[pass][4 * k + 1]; a[2] += oa[pass][4 * k + 2]; a[3] += oa[pass][4 * k + 3]; ap[k] = a; }
                if ((li & 3) == 0) LACC[4 * q + hsel] += la2[pass]; }
        }
#undef LOADK
#undef LOADV
#undef QFETCH
    }
    LDS_WAIT(); __builtin_amdgcn_s_barrier();

    {
        if (hi == 0) { const float lt = LACC[32 * wid + r32]; wsf[r32] = lt > 0.f ? gate_s / lt : 0.f; }
        LDS_WAIT();
#pragma unroll
        for (int i = 0; i < 4; ++i) { const int rowl = i * 8 + (lane >> 3), chn = lane & 7, row = 32 * wid + rowl;
            const float f = wsf[rowl];
            const f32x4 a0 = *(const LAS f32x4*)(OACC + row * 64 + chn * 8), a1 = *(const LAS f32x4*)(OACC + row * 64 + chn * 8 + 4);
            const size_t tt = (size_t)(64 * qt + 8 * wid + (rowl >> 2)); const int col = (4 * g + (rowl & 3)) * 64 + chn * 8;
            const u32x4 ov = *(const u32x4*)(F.XN() + tt * 1024 + col);
            const u32x4 gn = *(const u32x4*)(F.GN() + tt * 512 + col);
            u32x4 w; w.x = pk2((bflo(ov.x) + a0[0] * f) * bflo(gn.x), (bfhi(ov.x) + a0[1] * f) * bfhi(gn.x)); w.y = pk2((bflo(ov.y) + a0[2] * f) * bflo(gn.y), (bfhi(ov.y) + a0[3] * f) * bfhi(gn.y));
            w.z = pk2((bflo(ov.z) + a1[0] * f) * bflo(gn.z), (bfhi(ov.z) + a1[1] * f) * bfhi(gn.z)); w.w = pk2((bflo(ov.w) + a1[2] * f) * bflo(gn.w), (bfhi(ov.w) + a1[3] * f) * bfhi(gn.w));
            *(u32x4*)(F.XN() + tt * 1024 + col) = w; }
        VM_WAIT(); LDS_WAIT(); __syncthreads();
    }
#undef DMA_K
#undef DMA_V
#undef ROT
}
}

__global__ void __launch_bounds__(NWAVES * 64, 2) nsa_lru_fwd(Args args) {
    extern __shared__ __attribute__((aligned(16))) unsigned char lds[];
    Frame F;
    F.lds = (LAS unsigned char*)lds;
    F.MISC = (volatile LAS unsigned*)(F.lds + MISC_OFF);
    F.wave = __builtin_amdgcn_readfirstlane((int)(threadIdx.x >> 6));
    F.G = gridDim.x; { const int bx = blockIdx.x; F.vcu = (F.G % 8 == 0) ? (bx % 8) * (F.G / 8) + bx / 8 : bx; }
    F.ws = args.ws;
    gu32* ctl = (gu32*)(args.ws + WS_CTL);
    for (int u = F.wave * 64 + lane_id(); u < (LDS_BYTES - LDSCTL_OFF) / 4; u += NWAVES * 64) ((LAS unsigned*)(F.lds + LDSCTL_OFF))[u] = 0u;
    __syncthreads();
    const int bli = (N_LAUNCHES == PER_PHASE) ? 0 : args.li;
    XcdBarrier bar; bar.bar = (unsigned*)(ctl + CW_BAR) + bli * XCD_BAR_WORDS; bar.x = 0; bar.st = nullptr;
    if (N_LAUNCHES != PER_PHASE) bar = xcd_barrier_post((unsigned*)(ctl + CW_BAR) + bli * XCD_BAR_WORDS, F.MISC + 8);
#define GRID_BAR() do { if (N_LAUNCHES != PER_PHASE) xcd_barrier(bar); } while (0)
    const int lo = args.ph_lo, hi = args.ph_hi;
#define IN(k) (lo <= (k) && (k) < hi)
#define BOTH(k) (IN(k) && IN((k) + 1))

    if (IN(0)) { p0_prologue(F, args); if (BOTH(0)) GRID_BAR(); }

    if (IN(1)) {
        pg8::Gemm g{F.XN(), F.WinT(), F.XN(), F.WinT(), 1024, 1024, 1024}; pg8::StaticOrder S; S.init(SEQ, NPROJ, F.G, (int)blockIdx.x);
        pg8::EpiProj E{F.Q(), F.KV(), F.U(), F.BR(), F.GN(), F.GL(), F.MG()};
        pg8::gemm_phase<pg8::EpiProj, pg8::StaticOrder, true>(F.lds, g, S, E, F.wave);
        if (BOTH(1)) GRID_BAR();
    }

    if (IN(2)) {
        for (int i = F.vcu; i < 256; i += F.G) {
            lru_tile<false>(F, args, i);
            if (!args.pad) qk_norm_tile(F, args, i);
            vt_tile(F, i);
            __syncthreads();
            compress_item(F, args, i & 1, (i >> 1) & 1, i >> 2);
        }
        if (BOTH(2)) GRID_BAR();
    }

    if (IN(3)) {
        for (int i = F.vcu; i < 256; i += F.G) { lru_apply(F, i); }
        __syncthreads();
#pragma unroll 1
        for (int it = 2 * F.vcu; it < 512; it += 2 * F.G) {
#pragma unroll 1
            for (int j = 0; j < 2; ++j) { const int i = it >> 1; att::attn_item(F, j ? i : 255 - i, j ? 0 : 1); }
        }
        if (BOTH(3)) GRID_BAR();
    }

    if (IN(4)) {
        pg8::Gemm g{F.XN(), F.WaT(), F.XN() + 512, F.WbT(), 1024, 512, 512}; pg8::DualOrder S; S.init(SEQ, 1024, F.G, (int)blockIdx.x);
        pg8::EpiMerge E{F.MB(), F.MG()};
        pg8::gemm_phase<pg8::EpiMerge, pg8::DualOrder, true>(F.lds, g, S, E, F.wave);
        if (BOTH(4)) GRID_BAR();
    }

    if (IN(5)) {
        pg8::Gemm g{F.MB(), F.WoutT(), F.MB(), F.WoutT(), 1024, 1024, 1024}; pg8::StaticOrder S; S.init(SEQ, 1024, F.G, (int)blockIdx.x);
        pg8::EpiOut E{args.in[0], args.out};
        pg8::gemm_phase<pg8::EpiOut, pg8::StaticOrder, true>(F.lds, g, S, E, F.wave);
    }
#undef IN
#undef BOTH
}

extern "C" void kernel_launch(void* const* d_in, const int* in_sizes, int n_in, void* d_out, int out_size, void* d_ws, size_t ws_size, hipStream_t stream) {
    static int grid = 0;
    if (grid == 0) {
        if (n_in != 20 || in_sizes[0] != SEQ * DM || out_size != SEQ * DM || ws_size < WS_END) { fprintf(stderr, "kernel_launch: unexpected shapes (n_in %d, in0 %d, out %d, ws %zu)\n", n_in, n_in > 0 ? in_sizes[0] : -1, out_size, ws_size); grid = -1; return; }
        int dev = 0, cus = 0, per_cu = 0;
        if (hipGetDevice(&dev) != hipSuccess || hipDeviceGetAttribute(&cus, hipDeviceAttributeMultiprocessorCount, dev) != hipSuccess) { grid = -1; return; }
        if (hipFuncSetAttribute((const void*)nsa_lru_fwd, hipFuncAttributeMaxDynamicSharedMemorySize, LDS_BYTES) != hipSuccess) { fprintf(stderr, "kernel_launch: hipFuncSetAttribute failed\n"); grid = -1; return; }
        if (hipOccupancyMaxActiveBlocksPerMultiprocessor(&per_cu, (const void*)nsa_lru_fwd, NWAVES * 64, LDS_BYTES) != hipSuccess || per_cu < 1)
            fprintf(stderr, "kernel_launch: occupancy query reports %d workgroups per CU\n", per_cu);
        (void)hipGetLastError();
        grid = cus;
    }
    if (grid < 0) return;
    if (hipMemsetAsync((char*)d_ws + WS_CTL, 0, CTL_ZERO_BYTES, stream) != hipSuccess) { fprintf(stderr, "kernel_launch: hipMemsetAsync failed\n"); return; }
    Args a{};
    for (int i = 0; i < 20; ++i) a.in[i] = (const float*)d_in[i];
    a.out = (float*)d_out; a.ws = (unsigned char*)d_ws;
    const int nl = (PROBE_DUP >= 0) ? 2 : N_LAUNCHES;
    for (int li = 0; li < nl; ++li) {
        if (PROBE_DUP >= 0) { a.ph_lo = li ? PROBE_DUP : 0; a.ph_hi = li ? PER_PHASE : PROBE_DUP + 1; a.li = li; a.pad = (li && PROBE_DUP == 2) ? 1 : 0; }
        else { a.ph_lo = (N_LAUNCHES == PER_PHASE) ? li : 0; a.ph_hi = (N_LAUNCHES == PER_PHASE) ? li + 1 : PER_PHASE; a.li = li; }
        hipLaunchKernelGGL(nsa_lru_fwd, dim3(grid), dim3(NWAVES * 64), LDS_BYTES, stream, a);
        const hipError_t le = hipPeekAtLastError();
        if (le != hipSuccess) { fprintf(stderr, "kernel_launch: launch %d failed: %s\n", li, hipGetErrorName(le)); break; }
    }
}
```

```cpp
#include <hip/hip_runtime.h>
#include <cstdio>
#include <cstdint>

#ifndef PROBE_DUP
#define PROBE_DUP -1
#endif
#ifndef MK_N_LAUNCHES
#define MK_N_LAUNCHES 1
#endif

#define GAS __attribute__((address_space(1)))
#define LAS __attribute__((address_space(3)))
typedef unsigned short bf16;
typedef short bf16x8 __attribute__((ext_vector_type(8)));
typedef short s16x4 __attribute__((ext_vector_type(4)));
typedef float f32x4 __attribute__((ext_vector_type(4)));
typedef float f32x16 __attribute__((ext_vector_type(16)));
typedef unsigned u32x4 __attribute__((ext_vector_type(4)));
typedef unsigned u32x2 __attribute__((ext_vector_type(2)));
typedef GAS unsigned gu32;

constexpr int SEQ = 16384, DM = 1024;
constexpr int NPROJ = 5120;
constexpr float LOG2E = 1.4426950408889634f;
constexpr float RMS_EPS = 1e-6f;

__device__ __forceinline__ unsigned f2bf(float f) { unsigned u = __builtin_bit_cast(unsigned, f); return (u + 0x7fffu + ((u >> 16) & 1u)) >> 16; }
__device__ __forceinline__ unsigned pk2(float lo, float hi) { return f2bf(lo) | (f2bf(hi) << 16); }
__device__ __forceinline__ float bf2f(unsigned h) { return __builtin_bit_cast(float, h << 16); }
__device__ __forceinline__ float bflo(unsigned w) { return __builtin_bit_cast(float, w << 16); }
__device__ __forceinline__ float bfhi(unsigned w) { return __builtin_bit_cast(float, w & 0xffff0000u); }
typedef float f32x2_t __attribute__((ext_vector_type(2))); typedef __bf16 bf16x2_t __attribute__((ext_vector_type(2)));
__device__ __forceinline__ unsigned cvtpk(float lo, float hi) { f32x2_t v = {lo, hi}; bf16x2_t b = __builtin_convertvector(v, bf16x2_t); return __builtin_bit_cast(unsigned, b); }
__device__ __forceinline__ float fsigmoid(float v) { return __builtin_amdgcn_rcpf(1.0f + __builtin_amdgcn_exp2f(-v * LOG2E)); }
template <int CTRL> __device__ __forceinline__ float dpp_f(float v) { return __builtin_bit_cast(float, __builtin_amdgcn_update_dpp(0, __builtin_bit_cast(int, v), CTRL, 0xf, 0xf, true)); }
template <int CTRL> __device__ __forceinline__ int dpp_i(int v) { return __builtin_amdgcn_update_dpp(v, v, CTRL, 0xf, 0xf, false); }
__device__ __forceinline__ int lane_id() { int l = (int)__builtin_amdgcn_mbcnt_hi(~0u, __builtin_amdgcn_mbcnt_lo(~0u, 0u)); asm volatile("" : "+v"(l)); return l; }
__device__ __forceinline__ float wave_sum(float v) {
#pragma unroll
    for (int o = 1; o < 64; o <<= 1) v += __shfl_xor(v, o);
    return v;
}

namespace pg8 {
#define PG8_LAS __attribute__((address_space(3)))
typedef unsigned short bf16_t;
constexpr int BM = 256, BK = 64, HALF = 128, HTB = HALF * BK * 2, STAGE_BYTES = 8 * HTB, NXCD = 8, WGM = 8;
__host__ __device__ __forceinline__ int lds_byte(int r, int c) { const int st = (r >> 4) * 2 + (c >> 5), rr = r & 15, cc = c & 31, ob = rr * 64 + cc * 2; return st * 1024 + (ob ^ (((ob >> 9) & 1) << 5)); }
__host__ __device__ __forceinline__ void stage_rc(int b, int& R, int& C) { const int st = b / 1024, sb = b % 1024, swz = sb ^ (((sb >> 9) & 1) << 5); R = (st >> 1) * 16 + swz / 64; C = (st & 1) * 32 + (swz % 64) / 2; }
__host__ __device__ __forceinline__ int perm32(int rho) { const int n = rho >> 4, i = rho & 15; return 8 * (i >> 2) + 4 * n + (i & 3); }

struct Unit { int pm, pn, part; };
struct Gemm { const bf16_t* A; const bf16_t* Bt; const bf16_t* A2; const bf16_t* Bt2; int lda, ldb, K; };

struct StaticOrder {
    int nM, nN, nwg, G, c;
    __host__ __device__ void init(int M, int N, int G_, int c_) { nM = M / BM; nN = N / BM; nwg = nM * nN; G = G_; c = c_; }
    __host__ __device__ bool tile(long L, Unit& u) const {
        if (L >= nwg) return false;
        int wgid = (int)L; { const int q = nwg / NXCD, r = nwg % NXCD, xcd = wgid % NXCD, off = wgid / NXCD; wgid = (xcd < r ? xcd * (q + 1) : r * (q + 1) + (xcd - r) * q) + off; }
        const int nig = WGM * nN, gid = wgid / nig, fm = gid * WGM, gsz = (nM - fm) < WGM ? (nM - fm) : WGM;
        u.pm = fm + ((wgid % nig) % gsz); u.pn = (wgid % nig) / gsz; u.part = 0; return true;
    }
    __host__ __device__ bool next(int i, Unit& u) const { return tile((long)i * G + c, u); }
};
struct DualOrder : StaticOrder {
    __host__ __device__ bool next(int i, Unit& u) const { if (!tile((long)(i >> 1) * G + c, u)) return false; u.part = i & 1; return true; }
};

__device__ __forceinline__ unsigned cvt_pk_bf16(float lo, float hi) { unsigned r; asm volatile("v_cvt_pk_bf16_f32 %0, %1, %2" : "=v"(r) : "v"(lo), "v"(hi)); return r; }

struct EpiProj {
    static constexpr bool PERM = true, INIT = false;
    bf16_t *Q, *KV, *U, *BR, *GN, *GL, *MG;
    __device__ __forceinline__ void operator()(const f32x4 (&acc)[2][2][4][2], const Unit& u, int wr, int wc, int fr, int fq) const {
        const int pn = u.pn; bf16_t* base; int ldc, colt, act = 0;
        if (pn < 2) { base = Q; ldc = 512; colt = pn * 256; }
        else if (pn < 5) { base = KV; ldc = 768; colt = (pn - 2) * 256; }
        else if (pn < 7) { base = U; ldc = 512; colt = (pn - 5) * 256; }
        else if (pn < 8) { base = BR; ldc = 256; colt = 0; }
        else if (pn < 10) { base = GN; ldc = 512; colt = (pn - 8) * 256; act = 1; }
        else if (pn < 12) { base = GL; ldc = 512; colt = (pn - 10) * 256; act = 1; }
        else { base = MG; ldc = 2048; colt = (pn - 12) * 256; act = 2; }
        const int row0 = u.pm * BM + wr * 64 + fr, col0 = colt + wc * 32 + 8 * fq;
#pragma unroll
        for (int ai = 0; ai < 2; ++ai)
#pragma unroll
            for (int m = 0; m < 4; ++m) { bf16_t* rowp = base + (size_t)(row0 + ai * HALF + m * 16) * ldc + col0;
#pragma unroll
                for (int bj = 0; bj < 2; ++bj) { f32x4 v0 = acc[ai][bj][m][0], v1 = acc[ai][bj][m][1];
                    if (act) {
#pragma unroll
                        for (int e = 0; e < 4; ++e) { const float s0 = fsigmoid(v0[e]), s1 = fsigmoid(v1[e]); v0[e] = (act == 1) ? v0[e] * s0 : s0; v1[e] = (act == 1) ? v1[e] * s1 : s1; } }
                    u32x4 w; w.x = cvt_pk_bf16(v0[0], v0[1]); w.y = cvt_pk_bf16(v0[2], v0[3]); w.z = cvt_pk_bf16(v1[0], v1[1]); w.w = cvt_pk_bf16(v1[2], v1[3]);
                    *(u32x4*)(rowp + bj * HALF) = w; } }
    }
};
struct EpiMerge {
    static constexpr bool PERM = true, INIT = false;
    bf16_t* Mb; const bf16_t* MG;
    __device__ __forceinline__ void operator()(const f32x4 (&acc)[2][2][4][2], const Unit& u, int wr, int wc, int fr, int fq) const {
        const int row0 = u.pm * BM + wr * 64 + fr, col0 = u.pn * BM + wc * 32 + 8 * fq;
#pragma unroll
        for (int ai = 0; ai < 2; ++ai)
#pragma unroll
            for (int m = 0; m < 4; ++m) { const size_t r = (size_t)(row0 + ai * HALF + m * 16);
#pragma unroll
                for (int bj = 0; bj < 2; ++bj) { const f32x4 v0 = acc[ai][bj][m][0], v1 = acc[ai][bj][m][1];
                    const u32x4 gw = *(const u32x4*)(MG + r * 2048 + u.part * 1024 + col0 + bj * HALF);
                    float o[8] = {v0[0] * bflo(gw.x), v0[1] * bfhi(gw.x), v0[2] * bflo(gw.y), v0[3] * bfhi(gw.y), v1[0] * bflo(gw.z), v1[1] * bfhi(gw.z), v1[2] * bflo(gw.w), v1[3] * bfhi(gw.w)};
                    bf16_t* dst = Mb + r * 1024 + col0 + bj * HALF;
                    if (u.part) { const u32x4 pw = *(const u32x4*)dst;
                        o[0] += bflo(pw.x); o[1] += bfhi(pw.x); o[2] += bflo(pw.y); o[3] += bfhi(pw.y); o[4] += bflo(pw.z); o[5] += bfhi(pw.z); o[6] += bflo(pw.w); o[7] += bfhi(pw.w); }
                    u32x4 w; w.x = cvt_pk_bf16(o[0], o[1]); w.y = cvt_pk_bf16(o[2], o[3]); w.z = cvt_pk_bf16(o[4], o[5]); w.w = cvt_pk_bf16(o[6], o[7]);
                    *(u32x4*)dst = w; } }
    }
};
struct EpiOut {
    static constexpr bool PERM = false, INIT = true;
    const float* X; float* O;
    __device__ __forceinline__ void init(f32x4 (&acc)[2][2][4][2], const Unit& u, int wr, int wc, int fr, int fq) const {
        const int row0 = u.pm * BM + wr * 64 + fr, col0 = u.pn * BM + wc * 32 + 4 * fq;
#pragma unroll
        for (int ai = 0; ai < 2; ++ai)
#pragma unroll
            for (int m = 0; m < 4; ++m) { const size_t off = (size_t)(row0 + ai * HALF + m * 16) * 1024 + col0;
#pragma unroll
                for (int bj = 0; bj < 2; ++bj)
#pragma unroll
                    for (int n = 0; n < 2; ++n) acc[ai][bj][m][n] = *(const f32x4*)(X + off + bj * HALF + n * 16); }
    }
    __device__ __forceinline__ void operator()(const f32x4 (&acc)[2][2][4][2], const Unit& u, int wr, int wc, int fr, int fq) const {
        const int row0 = u.pm * BM + wr * 64 + fr, col0 = u.pn * BM + wc * 32 + 4 * fq;
#pragma unroll
        for (int ai = 0; ai < 2; ++ai)
#pragma unroll
            for (int m = 0; m < 4; ++m) { const size_t off = (size_t)(row0 + ai * HALF + m * 16) * 1024 + col0;
#pragma unroll
                for (int bj = 0; bj < 2; ++bj)
#pragma unroll
                    for (int n = 0; n < 2; ++n) *(f32x4*)(O + off + bj * HALF + n * 16) = acc[ai][bj][m][n]; }
    }
};

template <class Epi, class Sched, bool ALIGN_EPI>
__device__ __forceinline__ void gemm_phase(PG8_LAS unsigned char* lds, const Gemm g, const Sched& S, const Epi& E, int wid) {
    const int lane = lane_id(), tid = wid * 64 + lane, wr = wid >> 2, wc = wid & 3, fr = lane & 15, fq = lane >> 4;
    const int K = g.K, nt = K / BK;
    unsigned voffA[2], voffB[2];
#pragma unroll
    for (int i = 0; i < 2; ++i) { int R, C; stage_rc(tid * 16 + i * 8192, R, C); const int Rb = Epi::PERM ? ((R & ~31) + perm32(R & 31)) : R;
        voffA[i] = (unsigned)(R * g.lda + C) * 2u; voffB[i] = (unsigned)(Rb * g.ldb + C) * 2u; }
    const size_t kstep = (size_t)(BK * 2);
    const size_t hstepA = (size_t)HALF * g.lda * 2, hstepB = (size_t)HALF * g.ldb * 2;
    const size_t tstepA = 2 * hstepA, tstepB = 2 * hstepB;
    const unsigned ldsw = (unsigned)wid * 1024u;
    const int aoff = lds_byte(wr * 64 + fr, fq * 8), boff = lds_byte(wc * 32 + fr, fq * 8);
#define PG8_SA(b, h) (((b) * 2 + (h)) * HTB)
#define PG8_SB(b, h) ((4 + (b) * 2 + (h)) * HTB)
#define PG8_STAGE(bufoff, gbase, voff) do { _Pragma("unroll") for (int _i = 0; _i < 2; ++_i) \
        __builtin_amdgcn_global_load_lds((const unsigned*)((const char*)(gbase) + (voff)[_i]), (PG8_LAS unsigned*)(lds + (bufoff) + ldsw + _i * 8192), 16, 0, 0); } while (0)
#define PG8_LDA(dst, b, h) do { _Pragma("unroll") for (int m = 0; m < 4; ++m) _Pragma("unroll") for (int k = 0; k < 2; ++k) dst[m][k] = *(const PG8_LAS bf16x8*)(lds + PG8_SA(b, h) + aoff + m * 2048 + k * 1024); } while (0)
#define PG8_LDB(dst, b, h) do { _Pragma("unroll") for (int n = 0; n < 2; ++n) _Pragma("unroll") for (int k = 0; k < 2; ++k) dst[n][k] = *(const PG8_LAS bf16x8*)(lds + PG8_SB(b, h) + boff + n * 2048 + k * 1024); } while (0)
#define PG8_MMA(ai, bj, At, Bt) do { __builtin_amdgcn_s_setprio(1); _Pragma("unroll") for (int m = 0; m < 4; ++m) _Pragma("unroll") for (int n = 0; n < 2; ++n) _Pragma("unroll") for (int k = 0; k < 2; ++k) \
        acc[ai][bj][m][n] = __builtin_amdgcn_mfma_f32_16x16x32_bf16(Bt[n][k], At[m][k], acc[ai][bj][m][n], 0, 0, 0); __builtin_amdgcn_s_setprio(0); } while (0)
#define PG8_WAIT_V(n) asm volatile("s_waitcnt vmcnt(" #n ")" ::: "memory")
#define PG8_WAIT_L(n) asm volatile("s_waitcnt lgkmcnt(" #n ")" ::: "memory")
#define PG8_BAR __builtin_amdgcn_s_barrier()
#define PG8_SCHED __builtin_amdgcn_sched_barrier(0)
#define PG8_UA(u) ((const char*)((u).part ? g.A2 : g.A) + (size_t)(u).pm * tstepA)
#define PG8_UB(u) ((const char*)((u).part ? g.Bt2 : g.Bt) + (size_t)(u).pn * tstepB)
    Unit cur, nxt; int ui = 0;
    if (!S.next(0, cur)) return;
    f32x4 acc[2][2][4][2];
    if constexpr (Epi::INIT) E.init(acc, cur, wr, wc, fr, fq);
    else {
#pragma unroll
    for (int a = 0; a < 2; ++a)
#pragma unroll
        for (int b = 0; b < 2; ++b)
#pragma unroll
            for (int m = 0; m < 4; ++m)
#pragma unroll
                for (int n = 0; n < 2; ++n) acc[a][b][m][n] = (f32x4){0.f, 0.f, 0.f, 0.f};
    }
    bf16x8 At[4][2], B0[2][2], B1[2][2];
    const char* cA = PG8_UA(cur); const char* cB = PG8_UB(cur);
    PG8_STAGE(PG8_SB(0, 0), cB, voffB); PG8_STAGE(PG8_SB(0, 1), cB + hstepB, voffB); PG8_STAGE(PG8_SA(0, 0), cA, voffA); PG8_STAGE(PG8_SA(0, 1), cA + hstepA, voffA);
    if (wr == 1) PG8_BAR;
    PG8_WAIT_V(2); PG8_BAR;
    PG8_STAGE(PG8_SB(1, 0), cB + kstep, voffB); PG8_STAGE(PG8_SA(1, 0), cA + kstep, voffA); PG8_STAGE(PG8_SB(1, 1), cB + hstepB + kstep, voffB);
    PG8_WAIT_V(6); PG8_BAR;
    for (;;) {
        const bool has_next = S.next(ui + 1, nxt);
        const char* nA = has_next ? PG8_UA(nxt) : cA; const char* nB = has_next ? PG8_UB(nxt) : cB;
        for (int t = 0; t < nt; t += 2) {
            const bool last = (t == nt - 2);
            const char* a1 = cA + (size_t)(t + 1) * kstep;
            const char* a2 = last ? nA : cA + (size_t)(t + 2) * kstep; const char* b2 = last ? nB : cB + (size_t)(t + 2) * kstep;
            const char* a3 = a2 + kstep; const char* b3 = b2 + kstep;
            PG8_LDB(B0, 0, 0); PG8_LDB(B1, 0, 1); PG8_SCHED; PG8_LDA(At, 0, 0); PG8_STAGE(PG8_SA(1, 1), a1 + hstepA, voffA);
            PG8_WAIT_V(8); PG8_WAIT_L(0); PG8_BAR; PG8_MMA(0, 0, At, B0); PG8_MMA(0, 1, At, B1); PG8_BAR; PG8_SCHED;
            PG8_LDA(At, 0, 1); PG8_STAGE(PG8_SB(0, 0), b2, voffB); PG8_STAGE(PG8_SB(0, 1), b2 + hstepB, voffB); PG8_STAGE(PG8_SA(0, 0), a2, voffA);
            PG8_WAIT_V(8); PG8_WAIT_L(0); PG8_BAR; PG8_MMA(1, 0, At, B0); PG8_MMA(1, 1, At, B1); PG8_BAR; PG8_SCHED;
            PG8_LDB(B0, 1, 0); PG8_LDB(B1, 1, 1); PG8_SCHED; PG8_LDA(At, 1, 0); PG8_STAGE(PG8_SA(0, 1), a2 + hstepA, voffA);
            PG8_WAIT_V(8); PG8_WAIT_L(0); PG8_BAR; PG8_MMA(0, 0, At, B0); PG8_MMA(0, 1, At, B1); PG8_BAR; PG8_SCHED;
            PG8_LDA(At, 1, 1); PG8_STAGE(PG8_SB(1, 0), b3, voffB); PG8_STAGE(PG8_SB(1, 1), b3 + hstepB, voffB); PG8_STAGE(PG8_SA(1, 0), a3, voffA);
            PG8_WAIT_V(8); PG8_WAIT_L(0); PG8_BAR; PG8_MMA(1, 0, At, B0); PG8_MMA(1, 1, At, B1); PG8_BAR; PG8_SCHED;
        }
        if constexpr (ALIGN_EPI) { if (wr == 0) PG8_BAR; }
        E(acc, cur, wr, wc, fr, fq);
        if (!has_next) break;
        if constexpr (Epi::INIT) E.init(acc, nxt, wr, wc, fr, fq);
        else {
#pragma unroll
        for (int a = 0; a < 2; ++a)
#pragma unroll
            for (int b = 0; b < 2; ++b)
#pragma unroll
                for (int m = 0; m < 4; ++m)
#pragma unroll
                    for (int n = 0; n < 2; ++n) acc[a][b][m][n] = (f32x4){0.f, 0.f, 0.f, 0.f};
        }
        cur = nxt; cA = nA; cB = nB; ++ui;
        if constexpr (ALIGN_EPI) { if (wr == 1) PG8_BAR; }
    }
    PG8_WAIT_V(0);
    if constexpr (!ALIGN_EPI) { if (wr == 0) PG8_BAR; }
    PG8_BAR;
#undef PG8_SA
#undef PG8_SB
#undef PG8_STAGE
#undef PG8_LDA
#undef PG8_LDB
#undef PG8_MMA
#undef PG8_WAIT_V
#undef PG8_WAIT_L
#undef PG8_BAR
#undef PG8_SCHED
#undef PG8_UA
#undef PG8_UB
}
}

constexpr int NWAVES = 8;
constexpr int N_LAUNCHES = MK_N_LAUNCHES;
constexpr int PER_PHASE = 6;
constexpr size_t MiB = 1u << 20;
constexpr size_t WS_CTL = 0, CTL_ZERO_BYTES = 65536;
constexpr size_t WS_WIN = 1 * MiB;
constexpr size_t WS_WA = 11 * MiB;
constexpr size_t WS_WB = 12 * MiB;
constexpr size_t WS_WOUT = 13 * MiB;
constexpr size_t WS_W1T = 15 * MiB;
constexpr size_t WS_SMALL = 17 * MiB;
constexpr size_t WS_SUM = 18 * MiB;
constexpr size_t WS_KC = 19 * MiB;
constexpr size_t WS_XN = 20 * MiB;
constexpr size_t WS_Q = 52 * MiB;
constexpr size_t WS_KV = 68 * MiB;
constexpr size_t WS_MB = 52 * MiB;
constexpr size_t WS_U = 92 * MiB;
constexpr size_t WS_BR = 108 * MiB;
constexpr size_t WS_GN = 116 * MiB;
constexpr size_t WS_GL = 132 * MiB;
constexpr size_t WS_MG = 148 * MiB;
constexpr size_t WS_VT = 212 * MiB;
constexpr size_t WS_KT = 216 * MiB;
constexpr size_t WS_Q2 = 220 * MiB;
constexpr size_t WS_LB = 236 * MiB;
constexpr size_t WS_END = 252 * MiB;
constexpr size_t SM_W2T = 0;
constexpr size_t SM_LWA = 65536;
constexpr size_t SM_LWX = 131072;
constexpr size_t SM_C1 = 262144;
constexpr size_t SM_LUT = 200704;
constexpr int CW_BAR = 4096;

constexpr int RING_BYTES = 160768;
constexpr int LDSCTL_OFF = RING_BYTES, MISC_OFF = LDSCTL_OFF + 320;
constexpr int LDS_BYTES = 163840;

#define RLX_AGENT __ATOMIC_RELAXED, __HIP_MEMORY_SCOPE_AGENT
#define LDS_WAIT() asm volatile("s_waitcnt lgkmcnt(0)" ::: "memory")
#define VM_WAIT() asm volatile("s_waitcnt vmcnt(0)" ::: "memory")

#define XB_TMO      128
#define XB_XCNT(j)  (256  + 64 * (j))
#define XB_XSUB(j)  (1280 + 64 * (j))
#define XB_XGEN(j)  (2304 + 64 * (j))
#define XB_TOP      3328
#define XB_TOPGEN   3392
#define XCD_BAR_WORDS 3456
#define XB_SPIN_CAP (1u << 18)
__device__ __forceinline__ unsigned xb_ld(unsigned* p)              { return __hip_atomic_load(p, __ATOMIC_RELAXED, __HIP_MEMORY_SCOPE_AGENT); }
__device__ __forceinline__ unsigned xb_add(unsigned* p, unsigned v) { return __hip_atomic_fetch_add(p, v, __ATOMIC_RELAXED, __HIP_MEMORY_SCOPE_AGENT); }
__device__ __forceinline__ unsigned xb_xcc_id() { return (unsigned)__builtin_amdgcn_s_getreg((3 << 11) | 20) & 0xFu; }
#define XB_SPIN(cond, bar) do { unsigned _sp = 0; while (cond) { __builtin_amdgcn_s_sleep(1); \
    if ((++_sp & 255u) == 0u) { if (xb_ld(&(bar)[XB_TMO])) break; if (_sp > XB_SPIN_CAP) { atomicAdd(&(bar)[XB_TMO], 1u); break; } } } } while (0)
struct XcdBarrier { unsigned* bar; unsigned x; volatile LAS unsigned* st; };
__device__ __forceinline__ XcdBarrier xcd_barrier_post(unsigned* bar, volatile LAS unsigned* st) {
    XcdBarrier b; b.bar = bar; b.x = xb_xcc_id(); b.st = st;
    if (threadIdx.x == 0) (void)xb_add(&bar[XB_XCNT(b.x)], 1u);
    return b;
}
__device__ __forceinline__ void xcd_barrier_complete(unsigned* bar, unsigned x, unsigned& nloc, unsigned& nx) {
    const unsigned G = gridDim.x * gridDim.y * gridDim.z;
    unsigned sum, cnt, mine, sp = 0u;
    for (;;) {
        sum = 0u; cnt = 0u; mine = 0u;
#pragma unroll
        for (unsigned j = 0; j < 16; ++j) { const unsigned c = xb_ld(&bar[XB_XCNT(j)]); sum += c; cnt += (c > 0u) ? 1u : 0u; mine = (j == x) ? c : mine; }
        if (sum == G) break;
        __builtin_amdgcn_s_sleep(1);
        if ((++sp & 255u) == 0u) { if (xb_ld(&bar[XB_TMO])) break; if (sp > XB_SPIN_CAP) { atomicAdd(&bar[XB_TMO], 1u); break; } }
    }
    nloc = mine > 0u ? mine : 1u; nx = cnt > 0u ? cnt : 1u;
}
__device__ __forceinline__ void xcd_barrier(const XcdBarrier& b) {
    asm volatile("s_waitcnt vmcnt(0)" ::: "memory");
    __syncthreads();
    if (threadIdx.x == 0) {
        unsigned* bar = b.bar;
        __builtin_amdgcn_s_waitcnt(0);
        unsigned nloc = b.st[0], nx = b.st[1];
        if (nloc == 0u) { xcd_barrier_complete(bar, b.x, nloc, nx); b.st[0] = nloc; b.st[1] = nx; }
        const unsigned old = xb_add(&bar[XB_XSUB(b.x)], 1u);
        const unsigned gen = old / nloc;
        if (old + 1u == (gen + 1u) * nloc) {
            __builtin_amdgcn_fence(__ATOMIC_RELEASE, "agent");
            asm volatile("s_waitcnt vmcnt(0)" ::: "memory");
            const unsigned og = xb_add(&bar[XB_TOP], 1u);
            const unsigned tg = og / nx;
            if (og + 1u == (tg + 1u) * nx) xb_add(&bar[XB_TOPGEN], 1u);
            else XB_SPIN(xb_ld(&bar[XB_TOPGEN]) == tg, bar);
            __builtin_amdgcn_fence(__ATOMIC_ACQUIRE, "agent");
            xb_add(&bar[XB_XGEN(b.x)], 1u);
            asm volatile("s_waitcnt vmcnt(0)" ::: "memory");
        } else {
            XB_SPIN(xb_ld(&bar[XB_XGEN(b.x)]) == gen, bar);
            __builtin_amdgcn_fence(__ATOMIC_ACQUIRE, "agent");
            asm volatile("s_waitcnt vmcnt(0)" ::: "memory");
        }
    }
    __syncthreads();
}

struct Args { const float* in[20]; float* out; unsigned char* ws; int ph_lo, ph_hi, li, pad; };
struct Frame {
    LAS unsigned char* lds;
    volatile LAS unsigned* MISC;
    int wave;
    int vcu, G;
    unsigned char* ws;
#define WSP(name, T, off) __device__ __forceinline__ T* name() const { return (T*)(ws + (off)); }
    WSP(WinT, bf16, WS_WIN) WSP(WaT, bf16, WS_WA) WSP(WbT, bf16, WS_WB) WSP(WoutT, bf16, WS_WOUT) WSP(W1T, bf16, WS_W1T)
    WSP(W2T, bf16, WS_SMALL + SM_W2T) WSP(LWA, bf16, WS_SMALL + SM_LWA) WSP(LWX, bf16, WS_SMALL + SM_LWX)
    WSP(C1, float, WS_SMALL + SM_C1) WSP(LUT, float, WS_SMALL + SM_LUT) WSP(SUMA, float, WS_SUM) WSP(SUMB, float, WS_SUM + 524288)
    WSP(KC, bf16, WS_KC) WSP(VC, bf16, WS_KC + 524288) WSP(XN, bf16, WS_XN) WSP(Q, bf16, WS_Q) WSP(KV, bf16, WS_KV) WSP(MB, bf16, WS_MB)
    WSP(VT, bf16, WS_VT) WSP(KT, bf16, WS_KT) WSP(Q2, bf16, WS_Q2) WSP(LB, bf16, WS_LB) WSP(U, bf16, WS_U) WSP(BR, bf16, WS_BR) WSP(GN, bf16, WS_GN) WSP(GL, bf16, WS_GL) WSP(MG, bf16, WS_MG)
#undef WSP
};

__device__ __forceinline__ int t5_bucket(int n) {
    if (n < 16) return n;
    const int thr[15] = {19, 21, 24, 27, 31, 35, 40, 46, 52, 59, 67, 77, 87, 99, 113};
    int b = 16;
#pragma unroll
    for (int i = 0; i < 15; ++i) b += (n >= thr[i]) ? 1 : 0;
    return b;
}

__device__ __forceinline__ void p0_tr_item(const float* W, int ldw, int k0, int srccol0, int nvalid, bf16* WT, int ldt, int dstrow0, LAS float* scr, int lane) {
    const int c = lane & 31;
    float tv[32];
#pragma unroll
    for (int i = 0; i < 32; ++i) { const int kk = 2 * i + (lane >> 5); tv[i] = (c < nvalid) ? W[(size_t)(k0 + kk) * ldw + srccol0 + c] : 0.f; }
#pragma unroll
    for (int i = 0; i < 32; ++i) { const int kk = 2 * i + (lane >> 5); scr[kk * 33 + c] = tv[i]; }
    LDS_WAIT(); asm volatile("" ::: "memory");
    const int cc = lane & 7;
#pragma unroll
    for (int j = 0; j < 4; ++j) { const int n = (lane >> 3) + 8 * j; const LAS float* s = scr + (8 * cc) * 33 + n;
        u32x4 o; o.x = pk2(s[0 * 33], s[1 * 33]); o.y = pk2(s[2 * 33], s[3 * 33]); o.z = pk2(s[4 * 33], s[5 * 33]); o.w = pk2(s[6 * 33], s[7 * 33]);
        *(u32x4*)(WT + (size_t)(dstrow0 + n) * ldt + k0 + 8 * cc) = o; }
    LDS_WAIT(); asm volatile("" ::: "memory");
}
__device__ __forceinline__ void win_src(int n0, int& src, int& nvalid) {
    nvalid = 32;
    if (n0 < 1280) src = n0;
    else if (n0 < 1792) src = 1816 + (n0 - 1280);
    else if (n0 < 2048) { src = 1792 + (n0 - 1792); nvalid = (n0 == 1792) ? 24 : 0; if (n0 != 1792) src = 0; }
    else if (n0 < 2560) src = 1280 + (n0 - 2048);
    else if (n0 < 3072) src = 2328 + (n0 - 2560);
    else src = 2840 + (n0 - 3072);
}
__device__ __forceinline__ void p0_prologue(const Frame& F, const Args& A) {
    LAS float* scr = (LAS float*)(F.lds + F.wave * 16384);
    const int gw = F.vcu * NWAVES + F.wave, NGW = F.G * NWAVES, lane = lane_id();
    constexpr int I_WIN = 16 * 160, I_WA = 8 * 32, I_WO = 16 * 32, I_W1 = 32 * 8, I_W2 = 4 * 2, I_LR = 2;
    constexpr int NIT = I_WIN + 2 * I_WA + I_WO + 2 * I_W1 + 2 * I_W2 + 16 * I_LR + 256 + 1;
    for (int it = gw; it < NIT; it += NGW) {
        int r = it;
        if (r < I_WIN) { const int kb = r / 160, nb = r % 160; int src, nv; win_src(32 * nb, src, nv); p0_tr_item(A.in[2], 4888, 64 * kb, src, nv, F.WinT(), 1024, 32 * nb, scr, lane); continue; } r -= I_WIN;
        if (r < I_WA) { p0_tr_item(A.in[17], 1024, 64 * (r / 32), 32 * (r % 32), 32, F.WaT(), 512, 32 * (r % 32), scr, lane); continue; } r -= I_WA;
        if (r < I_WA) { p0_tr_item(A.in[18], 1024, 64 * (r / 32), 32 * (r % 32), 32, F.WbT(), 512, 32 * (r % 32), scr, lane); continue; } r -= I_WA;
        if (r < I_WO) { p0_tr_item(A.in[19], 1024, 64 * (r / 32), 32 * (r % 32), 32, F.WoutT(), 1024, 32 * (r % 32), scr, lane); continue; } r -= I_WO;
        if (r < 2 * I_W1) { const int kv = r / I_W1, q = r % I_W1; p0_tr_item(A.in[6] + (size_t)kv * 2048 * 256, 256, 64 * (q / 8), 32 * (q % 8), 32, F.W1T() + (size_t)kv * 256 * 2048, 2048, 32 * (q % 8), scr, lane); continue; } r -= 2 * I_W1;
        if (r < 2 * I_W2) { const int kv = r / I_W2, q = r % I_W2; p0_tr_item(A.in[8] + (size_t)kv * 256 * 64, 64, 64 * (q / 2), 32 * (q % 2), 32, F.W2T() + (size_t)kv * 64 * 256, 256, 32 * (q % 2), scr, lane); continue; } r -= 2 * I_W2;
        if (r < 16 * I_LR) { const int mtx = r / 2, nb = r % 2; const float* src = (mtx < 8 ? A.in[12] : A.in[14]) + (size_t)(mtx & 7) * 4096; bf16* dst = (mtx < 8 ? F.LWA() : F.LWX()) + (size_t)(mtx & 7) * 4096;
            p0_tr_item(src, 64, 0, 32 * nb, 32, dst, 64, 32 * nb, scr, lane); continue; } r -= 16 * I_LR;
        if (r < 256) {
            const int kc = r >> 3, kv = (r >> 2) & 1, n = (r & 3) * 64 + lane; const float* w1 = A.in[6] + (size_t)kv * 2048 * 256 + (size_t)(64 * kc) * 256 + n; const float* pe = A.in[5] + kv * 2048 + 64 * kc;
            float s0 = 0.f, s1 = 0.f, s2 = 0.f, s3 = 0.f;
#pragma unroll 4
            for (int k = 0; k < 64; k += 4) { s0 += pe[k] * w1[(size_t)k * 256]; s1 += pe[k + 1] * w1[(size_t)(k + 1) * 256]; s2 += pe[k + 2] * w1[(size_t)(k + 2) * 256]; s3 += pe[k + 3] * w1[(size_t)(k + 3) * 256]; }
            F.C1()[(kc * 2 + kv) * 256 + n] = (s0 + s1) + (s2 + s3); continue; } r -= 256;
        {
            for (int e = lane; e < 1024; e += 64) { const int hd = e >> 7, n = e & 127; F.LUT()[e] = A.in[9][t5_bucket(n) * 8 + hd] * LOG2E; }
        }
    }
    const float* gain = A.in[1];
    {
        f32x4 v[4], vn[4];
        if (gw < SEQ) { const f32x4* xr = (const f32x4*)(A.in[0] + (size_t)gw * DM) + lane;
#pragma unroll
            for (int j = 0; j < 4; ++j) v[j] = xr[64 * j]; }
        for (int m = gw; m < SEQ; m += NGW) {
            if (m + NGW < SEQ) { const f32x4* xr = (const f32x4*)(A.in[0] + (size_t)(m + NGW) * DM) + lane;
#pragma unroll
                for (int j = 0; j < 4; ++j) vn[j] = xr[64 * j]; }
            float s = 0.f;
#pragma unroll
            for (int j = 0; j < 4; ++j) s += (v[j].x * v[j].x + v[j].y * v[j].y) + (v[j].z * v[j].z + v[j].w * v[j].w);
            const float rs = 1.0f / sqrtf(wave_sum(s) * (1.f / DM) + RMS_EPS);
            unsigned long long* o8 = (unsigned long long*)(F.XN() + (size_t)m * DM) + lane;
#pragma unroll
            for (int j = 0; j < 4; ++j) { const f32x4 gv = ((const f32x4*)gain)[lane + 64 * j];
                o8[64 * j] = (unsigned long long)pk2(v[j].x * rs * gv.x, v[j].y * rs * gv.y) | ((unsigned long long)pk2(v[j].z * rs * gv.z, v[j].w * rs * gv.w) << 32); }
#pragma unroll
            for (int j = 0; j < 4; ++j) v[j] = vn[j];
        }
    }
}

template <bool FINAL>
__device__ __forceinline__ void lru_tile(const Frame& F, const Args& A, int tt) {
    const int lane = lane_id();
    const int w = F.wave, fr = lane & 15, fq = lane >> 4, ch0 = 64 * w, t0 = 64 * tt;
    LAS float* UC = (LAS float*)(F.lds + w * 16384);
#define UC_IDX(tok, ch) ((tok) * 64 + ((((ch) >> 2) ^ ((tok) & 15)) << 2) + ((ch) & 3))
    float Hc = 0.f;
    if (FINAL) {
        const float* sa = F.SUMA() + ch0 + lane; const float* sb = F.SUMB() + ch0 + lane;
        int i = 0;
        for (; i + 64 <= tt; i += 64) { float ta[64], tb[64];
#pragma unroll
            for (int k = 0; k < 64; ++k) { ta[k] = sa[(size_t)(i + k) * 512]; tb[k] = sb[(size_t)(i + k) * 512]; }
#pragma unroll
            for (int k = 0; k < 64; ++k) Hc = ta[k] * Hc + tb[k]; }
        for (; i + 16 <= tt; i += 16) { float ta[16], tb[16];
#pragma unroll
            for (int k = 0; k < 16; ++k) { ta[k] = sa[(size_t)(i + k) * 512]; tb[k] = sb[(size_t)(i + k) * 512]; }
#pragma unroll
            for (int k = 0; k < 16; ++k) Hc = ta[k] * Hc + tb[k]; }
        for (; i < tt; ++i) Hc = sa[(size_t)i * 512] * Hc + sb[(size_t)i * 512];
        asm volatile("" : "+v"(Hc));
    }
    {
        const int ch = ch0 + lane; const float* cw = A.in[10]; const float cb = A.in[11][ch];
        const float w0 = cw[ch], w1 = cw[512 + ch], w2 = cw[1024 + ch], w3 = cw[1536 + ch];
        const bf16* up = F.U() + (size_t)t0 * 512 + ch;
        float u0 = 0.f, u1 = 0.f, u2 = 0.f;
        if (tt > 0) { u0 = bf2f(up[-3 * 512]); u1 = bf2f(up[-2 * 512]); u2 = bf2f(up[-1 * 512]); }
        unsigned short ur[64];
#pragma unroll
        for (int tok = 0; tok < 64; ++tok) ur[tok] = up[(size_t)tok * 512];
#pragma unroll
        for (int tok = 0; tok < 64; ++tok) { const float u3 = bf2f(ur[tok]);
            UC[UC_IDX(tok, lane)] = cb + ((u0 * w0 + u1 * w1) + (u2 * w2 + u3 * w3)); u0 = u1; u1 = u2; u2 = u3; }
    }
    bf16x8 Ba[4][2], Bx[4][2];
#pragma unroll
    for (int nt = 0; nt < 4; ++nt)
#pragma unroll
        for (int ks = 0; ks < 2; ++ks) { const size_t o = (size_t)w * 4096 + (16 * nt + fr) * 64 + 32 * ks + 8 * fq; Ba[nt][ks] = *(const bf16x8*)(F.LWA() + o); Bx[nt][ks] = *(const bf16x8*)(F.LWX() + o); }
    float ba[4], bx[4], sp8[4], hin[4], acum[4];
#pragma unroll
    for (int nt = 0; nt < 4; ++nt) { const int ch = ch0 + 16 * nt + fr; ba[nt] = A.in[13][ch]; bx[nt] = A.in[15][ch];
        sp8[nt] = 8.0f * log1pf(expf(-A.in[16][ch])); hin[nt] = 0.f; acum[nt] = 1.f; }
    if (FINAL) {
#pragma unroll
        for (int nt = 0; nt < 4; ++nt) hin[nt] = __shfl(Hc, 16 * nt + fr);
    }
    LDS_WAIT();
    unsigned short glv[16], gln[16];
    if (FINAL) {
#pragma unroll
        for (int nt = 0; nt < 4; ++nt)
#pragma unroll
            for (int rg = 0; rg < 4; ++rg) glv[nt * 4 + rg] = F.GL()[(size_t)(t0 + 4 * fq + rg) * 512 + ch0 + 16 * nt + fr];
    }
#pragma unroll 1
    for (int mt = 0; mt < 4; ++mt) {
        if (FINAL && mt < 3) {
#pragma unroll
            for (int nt = 0; nt < 4; ++nt)
#pragma unroll
                for (int rg = 0; rg < 4; ++rg) gln[nt * 4 + rg] = F.GL()[(size_t)(t0 + 16 * (mt + 1) + 4 * fq + rg) * 512 + ch0 + 16 * nt + fr];
        }
        bf16x8 Af[2];
#pragma unroll
        for (int ks = 0; ks < 2; ++ks) { const int tok = 16 * mt + fr, c0 = 8 * ks + 2 * fq;
            const f32x4 x0 = *(const LAS f32x4*)(UC + tok * 64 + ((c0 ^ (tok & 15)) << 2)), x1 = *(const LAS f32x4*)(UC + tok * 64 + (((c0 + 1) ^ (tok & 15)) << 2));
            u32x4 pw; pw.x = cvtpk(x0[0], x0[1]); pw.y = cvtpk(x0[2], x0[3]); pw.z = cvtpk(x1[0], x1[1]); pw.w = cvtpk(x1[2], x1[3]); Af[ks] = __builtin_bit_cast(bf16x8, pw); }
        f32x4 cr[4], ci[4];
#pragma unroll
        for (int nt = 0; nt < 4; ++nt) { cr[nt] = (f32x4){0.f, 0.f, 0.f, 0.f}; ci[nt] = (f32x4){0.f, 0.f, 0.f, 0.f};
#pragma unroll
            for (int ks = 0; ks < 2; ++ks) { cr[nt] = __builtin_amdgcn_mfma_f32_16x16x32_bf16(Af[ks], Ba[nt][ks], cr[nt], 0, 0, 0); ci[nt] = __builtin_amdgcn_mfma_f32_16x16x32_bf16(Af[ks], Bx[nt][ks], ci[nt], 0, 0, 0); } }
#pragma unroll
        for (int nt = 0; nt < 4; ++nt) {
            float P[4], Hh[4];
#pragma unroll
            for (int rg = 0; rg < 4; ++rg) { const int tok = 16 * mt + 4 * fq + rg, e = 16 * nt + fr;
                const float ucv = UC[UC_IDX(tok, e)];
                const float r = fsigmoid(cr[nt][rg] + ba[nt]), ig = fsigmoid(ci[nt][rg] + bx[nt]);
                const float la = -r * sp8[nt]; const float a = __builtin_amdgcn_exp2f(la * LOG2E);
                const float x2 = 2.0f * la;
                const float ser = -x2 * (1.0f + x2 * (0.5f + x2 * (0.16666667f + x2 * (0.041666668f + x2 * 0.008333334f))));
                const float om = (x2 > -0.25f) ? ser : 1.0f - a * a;
                const float b = __builtin_amdgcn_sqrtf(om) * (ig * ucv);
                if (!FINAL) {
                    const float so = -la * (1.0f + la * (0.5f + la * (0.16666667f + la * (0.041666668f + la * 0.008333334f))));
                    const float oma = (la > -0.25f) ? so : 1.0f - a; const size_t tg = (size_t)(t0 + tok); const int chg = ch0 + e;
                    F.XN()[tg * 1024 + 512 + chg] = (bf16)f2bf(oma); F.LB()[tg * 512 + chg] = (bf16)f2bf(b); }
                if (rg == 0) { P[0] = a; Hh[0] = b; } else { P[rg] = P[rg - 1] * a; Hh[rg] = a * Hh[rg - 1] + b; } }
            float At = P[3], Bt = Hh[3];
            { const float Ap = __shfl_up(At, 16), Bp = __shfl_up(Bt, 16); if (fq >= 1) { Bt = At * Bp + Bt; At = Ap * At; } }
            { const float Ap = __shfl_up(At, 32), Bp = __shfl_up(Bt, 32); if (fq >= 2) { Bt = At * Bp + Bt; At = Ap * At; } }
            float Aex = __shfl_up(At, 16), Bex = __shfl_up(Bt, 16); if (fq == 0) { Aex = 1.f; Bex = 0.f; }
            const float hg = Aex * hin[nt] + Bex;
            float hv[4];
#pragma unroll
            for (int rg = 0; rg < 4; ++rg) hv[rg] = P[rg] * hg + Hh[rg];
            hin[nt] = __shfl(hv[3], 48 + fr);
            if (!FINAL) acum[nt] *= __shfl(At, 48 + fr);
            if (FINAL) {
#pragma unroll
                for (int rg = 0; rg < 4; ++rg) { const size_t t = (size_t)(t0 + 16 * mt + 4 * fq + rg); const int ch = ch0 + 16 * nt + fr;
                    F.XN()[t * 1024 + 512 + ch] = (bf16)f2bf(hv[rg] * bf2f(glv[nt * 4 + rg])); }
            }
        }
        if (FINAL) {
#pragma unroll
            for (int x = 0; x < 16; ++x) glv[x] = gln[x];
        }
    }
    if (!FINAL && fq == 0) {
#pragma unroll
        for (int nt = 0; nt < 4; ++nt) { F.SUMA()[(size_t)tt * 512 + ch0 + 16 * nt + fr] = acum[nt]; F.SUMB()[(size_t)tt * 512 + ch0 + 16 * nt + fr] = hin[nt]; }
    }
    LDS_WAIT();
#undef UC_IDX
}

__device__ __forceinline__ void lru_apply(const Frame& F, int tt) {
    const int lane = lane_id(), ch = 64 * F.wave + lane, t0 = 64 * tt;
    float H = 0.f;
    { const float* sa = F.SUMA() + ch; const float* sb = F.SUMB() + ch; int i = 0;
        for (; i + 64 <= tt; i += 64) { float ta[64], tb[64];
#pragma unroll
            for (int k = 0; k < 64; ++k) { ta[k] = sa[(size_t)(i + k) * 512]; tb[k] = sb[(size_t)(i + k) * 512]; }
#pragma unroll
            for (int k = 0; k < 64; ++k) H = ta[k] * H + tb[k]; }
        for (; i + 16 <= tt; i += 16) { float ta[16], tb[16];
#pragma unroll
            for (int k = 0; k < 16; ++k) { ta[k] = sa[(size_t)(i + k) * 512]; tb[k] = sb[(size_t)(i + k) * 512]; }
#pragma unroll
            for (int k = 0; k < 16; ++k) H = ta[k] * H + tb[k]; }
        for (; i < tt; ++i) H = sa[(size_t)i * 512] * H + sb[(size_t)i * 512]; }
    bf16* px = F.XN() + (size_t)t0 * 1024 + 512 + ch; const bf16* pb = F.LB() + (size_t)t0 * 512 + ch; const bf16* pg = F.GL() + (size_t)t0 * 512 + ch;
#pragma unroll 1
    for (int c = 0; c < 2; ++c) { unsigned short av[32], bv[32], gv[32];
#pragma unroll
        for (int k = 0; k < 32; ++k) { const size_t tk = (size_t)(32 * c + k); av[k] = px[tk * 1024]; bv[k] = pb[tk * 512]; gv[k] = pg[tk * 512]; }
#pragma unroll
        for (int k = 0; k < 32; ++k) { H = (1.0f - bf2f(av[k])) * H + bf2f(bv[k]); px[(size_t)(32 * c + k) * 1024] = (bf16)f2bf(H * bf2f(gv[k])); } }
}

__device__ __forceinline__ void qk_norm_tile(const Frame& F, const Args& A, int tt) {
    const int lane = lane_id(), sub = lane & 7;
#pragma unroll 4
    for (int it = 0; it < 12; ++it) {
        const int idx = it * 64 + F.wave * 8 + (lane >> 3), tok = idx / 12, hr = idx % 12; const size_t t = (size_t)(64 * tt + tok);
        bf16* p; bf16* dst; const float* gain; float sc = 1.f;
        if (hr < 8) { p = F.Q() + t * 512 + hr * 64; dst = F.Q2() + t * 512 + (hr >> 2) * 256 + (sub >> 1) * 64 + (hr & 3) * 16 + (sub & 1) * 8 - sub * 8; gain = A.in[3]; sc = 0.125f * LOG2E; }
        else if (hr < 10) { p = F.KV() + t * 768 + 256 + (hr - 8) * 64; dst = p; gain = A.in[4] + 64; }
        else { p = F.KV() + t * 768 + 512 + (hr - 10) * 64; dst = p; gain = A.in[4] + 128; }
        const u32x4 w = *(const u32x4*)(p + sub * 8);
        float x[8] = {bflo(w.x), bfhi(w.x), bflo(w.y), bfhi(w.y), bflo(w.z), bfhi(w.z), bflo(w.w), bfhi(w.w)};
        float ss = 0.f;
#pragma unroll
        for (int j = 0; j < 8; ++j) ss += x[j] * x[j];
        ss += __shfl_xor(ss, 1); ss += __shfl_xor(ss, 2); ss += __shfl_xor(ss, 4);
        const float rs = sc / sqrtf(ss * (1.f / 64.f) + RMS_EPS);
        const f32x4 g0 = *(const f32x4*)(gain + sub * 8), g1 = *(const f32x4*)(gain + sub * 8 + 4);
        u32x4 o; o.x = pk2(x[0] * rs * g0.x, x[1] * rs * g0.y); o.y = pk2(x[2] * rs * g0.z, x[3] * rs * g0.w); o.z = pk2(x[4] * rs * g1.x, x[5] * rs * g1.y); o.w = pk2(x[6] * rs * g1.z, x[7] * rs * g1.w);
        *(u32x4*)(dst + sub * 8) = o;
        if (hr >= 8 && hr < 10) {
            int w0 = __builtin_amdgcn_cvt_pk_fp8_f32(x[0] * rs * g0.x, x[1] * rs * g0.y, 0, false); w0 = __builtin_amdgcn_cvt_pk_fp8_f32(x[2] * rs * g0.z, x[3] * rs * g0.w, w0, true);
            int w1 = __builtin_amdgcn_cvt_pk_fp8_f32(x[4] * rs * g1.x, x[5] * rs * g1.y, 0, false); w1 = __builtin_amdgcn_cvt_pk_fp8_f32(x[6] * rs * g1.z, x[7] * rs * g1.w, w1, true);
            u32x2* kt8 = (u32x2*)F.KT() + (size_t)((hr - 8) * 256 + tt) * 512 + ((((sub >> 2) * 4 + (tok >> 4)) * 4 + (sub & 3)) * 16 + (tok & 15));
            *kt8 = (u32x2){(unsigned)w0, (unsigned)w1}; }
    }
}

__device__ __forceinline__ void vt_tile(const Frame& F, int J) {
    const int tid = F.wave * 64 + lane_id(), d = tid & 63, ks = (tid >> 6) & 1, gp = tid >> 7;
#pragma unroll
    for (int g = 0; g < 2; ++g) {
        const bf16* vp = F.KV() + (size_t)(64 * J) * 768 + 384 + 64 * g + d;
        unsigned short e[8];
#pragma unroll
        for (int j = 0; j < 8; ++j) { const int key = 32 * ks + 4 * gp + (j & 3) + 16 * (j >> 2); e[j] = vp[(size_t)key * 768]; }
        u32x4 w; w.x = e[0] | ((unsigned)e[1] << 16); w.y = e[2] | ((unsigned)e[3] << 16); w.z = e[4] | ((unsigned)e[5] << 16); w.w = e[6] | ((unsigned)e[7] << 16);
        *(u32x4*)(F.VT() + (size_t)(g * 256 + J) * 4096 + ((((d >> 4) * 2 + ks) * 16 + (d & 15)) * 32) + 8 * gp) = w;
    }
}

__device__ __forceinline__ void compress_item(const Frame& F, const Args& A, int kv, int g, int ct) {
    const int lane = lane_id(), w = F.wave, tid = w * 64 + lane, fr = lane & 15, fq = lane >> 4, c0 = 16 * ct, tb = 16 * c0;
    LAS unsigned char* T = F.lds;
    LAS bf16* HID = (LAS bf16*)(F.lds + 34816);
    LAS float* OUTF = (LAS float*)(F.lds + 34816 + 8448);
    LAS float* C1L = (LAS float*)(F.lds + 34816 + 8448 + 4096);
    {
        u32x4 tv[5];
#pragma unroll
        for (int i = 0; i < 5; ++i) { const int idx = tid + 512 * i, tok = idx >> 3, chn = idx & 7, gt = tb + tok; tv[i] = (u32x4){0u, 0u, 0u, 0u};
            if (idx < 272 * 8 && gt < SEQ) tv[i] = *(const u32x4*)(F.KV() + (size_t)gt * 768 + kv * 128 + g * 64 + chn * 8); }
        { const int n = tid & 255, hf = tid >> 8; float pc[16];
#pragma unroll
            for (int k = 0; k < 16; ++k) pc[k] = F.C1()[((hf * 16 + k) * 2 + kv) * 256 + n];
            float s = hf ? 0.f : A.in[7][kv * 256 + n];
#pragma unroll
            for (int k = 0; k < 16; ++k) s += pc[k];
            C1L[hf * 256 + n] = s; }
#pragma unroll
        for (int i = 0; i < 5; ++i) { const int idx = tid + 512 * i, tok = idx >> 3, chn = idx & 7;
            if (idx < 272 * 8) *(LAS u32x4*)(T + tok * 128 + ((chn ^ ((tok >> 4) & 7)) << 4)) = tv[i]; }
    }
    LDS_WAIT(); __syncthreads();
    f32x4 acc[2] = {(f32x4){0.f, 0.f, 0.f, 0.f}, (f32x4){0.f, 0.f, 0.f, 0.f}};
    const bf16* w1t = F.W1T() + (size_t)kv * 256 * 2048 + (size_t)(32 * w + fr) * 2048 + 8 * fq;
#pragma unroll 32
    for (int ks = 0; ks < 64; ++ks) {
        const int tok = 16 * fr + (ks >> 1), chn = 4 * (ks & 1) + fq;
        const bf16x8 a = *(const LAS bf16x8*)(T + tok * 128 + ((chn ^ ((tok >> 4) & 7)) << 4));
        const bf16x8 b0 = *(const bf16x8*)(w1t + 32 * ks), b1 = *(const bf16x8*)(w1t + (size_t)16 * 2048 + 32 * ks);
        acc[0] = __builtin_amdgcn_mfma_f32_16x16x32_bf16(a, b0, acc[0], 0, 0, 0);
        acc[1] = __builtin_amdgcn_mfma_f32_16x16x32_bf16(a, b1, acc[1], 0, 0, 0);
    }
#pragma unroll
    for (int nt = 0; nt < 2; ++nt) { const int n = 32 * w + 16 * nt + fr; const float c1 = C1L[n] + C1L[256 + n];
#pragma unroll
        for (int rg = 0; rg < 4; ++rg) { const float v = acc[nt][rg] + c1; HID[(4 * fq + rg) * 264 + n] = (bf16)f2bf(v * fsigmoid(v)); } }
    LDS_WAIT(); __syncthreads();
    if (w < 4) {
        f32x4 o = (f32x4){0.f, 0.f, 0.f, 0.f};
        const bf16* w2t = F.W2T() + (size_t)kv * 64 * 256 + (size_t)(16 * w + fr) * 256 + 8 * fq;
#pragma unroll
        for (int ks = 0; ks < 8; ++ks) { const bf16x8 a = *(const LAS bf16x8*)(HID + fr * 264 + 32 * ks + 8 * fq); const bf16x8 b = *(const bf16x8*)(w2t + 32 * ks);
            o = __builtin_amdgcn_mfma_f32_16x16x32_bf16(a, b, o, 0, 0, 0); }
#pragma unroll
        for (int rg = 0; rg < 4; ++rg) OUTF[(4 * fq + rg) * 64 + 16 * w + fr] = o[rg];
    }
    LDS_WAIT(); __syncthreads();
    {
        const int row = tid >> 5, e = 2 * (tid & 31), c = c0 + row;
        float v0 = OUTF[row * 64 + e], v1 = OUTF[row * 64 + e + 1];
        if (kv == 0) { float ss = v0 * v0 + v1 * v1;
#pragma unroll
            for (int o = 1; o < 32; o <<= 1) ss += __shfl_xor(ss, o);
            const float rs = 1.0f / sqrtf(ss * (1.f / 64.f) + RMS_EPS); v0 *= rs * A.in[4][e]; v1 *= rs * A.in[4][e + 1]; }
        if (c >= 1023) { v0 = 0.f; v1 = 0.f; }
        bf16* dst = (kv == 0 ? F.KC() : F.VC()) + ((size_t)g * 1024 + c) * 64 + e;
        *(unsigned*)dst = pk2(v0, v1);
    }
    LDS_WAIT(); __syncthreads();
}

namespace att {
constexpr int SLOTB = 8192, NSLOT = 3;
constexpr int L_K = 0, L_V = NSLOT * SLOTB, L_SC = 2 * NSLOT * SLOTB, L_OUT = L_SC + 65536, L_LUT = L_OUT + 32768, L_WSF = L_LUT + 2048, L_BM = L_WSF + 2048, L_REF = L_BM + 2048, L_LACC = L_REF + 1024, L_TL = L_LACC + 1024  , L_END = L_TL + 5120;
static_assert(L_END <= RING_BYTES, "attention LDS map");
constexpr int L_EX = 0  ,
              L_HDR = 69632  , L_LEX = 69888  , L_NT = 70912  ;
static_assert(L_NT + 32 <= L_SC + 65536, "part B exchange area");
constexpr float CLAMP = 100.0f;
constexpr float THR = 8.0f;
#define SBAR() __builtin_amdgcn_sched_barrier(0)
__device__ __forceinline__ int crow(int r, int hi) { return (r & 3) + 8 * (r >> 2) + 4 * hi; }
__device__ __forceinline__ void glds16(const void* gsrc, unsigned lds_dst) { unsigned keep;
    asm volatile("s_mov_b32 %0, m0\n\ts_mov_b32 m0, %2\n\ts_nop 0\n\tglobal_load_lds_dwordx4 %1, off\n\ts_mov_b32 m0, %0" : "=&s"(keep) : "v"(gsrc), "s"(lds_dst) : "memory"); }
__device__ __forceinline__ void qkt(f32x16& p0, f32x16& p1, const LAS unsigned char* Kslot, const bf16x8* qr, int r32, int hi) {
    const LAS unsigned char* kb = Kslot + hi * 1024 + r32 * 16;
    const f32x16 z = {0.f, 0.f, 0.f, 0.f, 0.f, 0.f, 0.f, 0.f, 0.f, 0.f, 0.f, 0.f, 0.f, 0.f, 0.f, 0.f};
#pragma unroll
    for (int d0 = 0; d0 < 4; ++d0) {
        const bf16x8 b0 = *(const LAS bf16x8*)(kb + d0 * 2048);
        const bf16x8 b1 = *(const LAS bf16x8*)(kb + d0 * 2048 + 512);
        if (d0 == 0) { p0 = __builtin_amdgcn_mfma_f32_32x32x16_bf16(b0, qr[0], z, 0, 0, 0); p1 = __builtin_amdgcn_mfma_f32_32x32x16_bf16(b1, qr[0], z, 0, 0, 0); }
        else { p0 = __builtin_amdgcn_mfma_f32_32x32x16_bf16(b0, qr[d0], p0, 0, 0, 0); p1 = __builtin_amdgcn_mfma_f32_32x32x16_bf16(b1, qr[d0], p1, 0, 0, 0); } }
}
__device__ __forceinline__ void pv(f32x16* o, int vb, bf16x8 pa0, bf16x8 pa1, bf16x8 pa2, bf16x8 pa3) {
    s16x4 lo[8], hi[8];
#pragma unroll
    for (int x = 0; x < 8; ++x) {
        asm volatile("ds_read_b64_tr_b16 %0,%1 offset:%c2" : "=&v"(lo[x]) : "v"(vb), "i"((x >> 2) * 4096 + (x & 3) * 1024) : "memory");
        asm volatile("ds_read_b64_tr_b16 %0,%1 offset:%c2" : "=&v"(hi[x]) : "v"(vb), "i"((x >> 2) * 4096 + (x & 3) * 1024 + 512) : "memory"); }
    asm volatile("s_waitcnt lgkmcnt(0)" ::: "memory"); SBAR();
#define PK(k) (bf16x8){lo[k][0], lo[k][1], lo[k][2], lo[k][3], hi[k][0], hi[k][1], hi[k][2], hi[k][3]}
    o[0] = __builtin_amdgcn_mfma_f32_32x32x16_bf16(pa0, PK(0), o[0], 0, 0, 0); o[1] = __builtin_amdgcn_mfma_f32_32x32x16_bf16(pa0, PK(4), o[1], 0, 0, 0);
    o[0] = __builtin_amdgcn_mfma_f32_32x32x16_bf16(pa1, PK(1), o[0], 0, 0, 0); o[1] = __builtin_amdgcn_mfma_f32_32x32x16_bf16(pa1, PK(5), o[1], 0, 0, 0);
    o[0] = __builtin_amdgcn_mfma_f32_32x32x16_bf16(pa2, PK(2), o[0], 0, 0, 0); o[1] = __builtin_amdgcn_mfma_f32_32x32x16_bf16(pa2, PK(6), o[1], 0, 0, 0);
    o[0] = __builtin_amdgcn_mfma_f32_32x32x16_bf16(pa3, PK(3), o[0], 0, 0, 0); o[1] = __builtin_amdgcn_mfma_f32_32x32x16_bf16(pa3, PK(7), o[1], 0, 0, 0);
#undef PK
}
__device__ __forceinline__ float rowmax(const f32x16& p0, const f32x16& p1) {
    float a = fmaxf(fmaxf(p0[0], p0[1]), p1[0]), b = fmaxf(fmaxf(p0[2], p0[3]), p1[1]); a = fmaxf(fmaxf(a, p1[2]), p1[3]);
#pragma unroll
    for (int r = 4; r < 16; r += 4) { a = fmaxf(fmaxf(a, p0[r]), p0[r + 1]); b = fmaxf(fmaxf(b, p0[r + 2]), p0[r + 3]); a = fmaxf(fmaxf(a, p1[r]), p1[r + 1]); b = fmaxf(fmaxf(b, p1[r + 2]), p1[r + 3]); }
    const float m = fmaxf(a, b);
    auto rr = __builtin_amdgcn_permlane32_swap(__float_as_uint(m), __float_as_uint(m), false, false);
    return fmaxf(__uint_as_float(rr[0]), __uint_as_float(rr[1]));
}
__device__ __forceinline__ float halfsum(float v) { auto rr = __builtin_amdgcn_permlane32_swap(__float_as_uint(v), __float_as_uint(v), false, false); return __uint_as_float(rr[0]) + __uint_as_float(rr[1]); }
template <int STEP, unsigned LIMIT>
__device__ __forceinline__ void near_apply(f32x16& p0, f32x16& p1, int dbase, const LAS float* lut) {
    float b0[16], b1[16];
#pragma unroll
    for (int r = 0; r < 16; ++r) { const int koff = (r & 3) + 8 * (r >> 2); const int d0 = dbase - STEP * koff, d1 = d0 - STEP * 32;
        b0[r] = lut[4 * min(max(d0, 0), 127)]; b1[r] = lut[4 * min(max(d1, 0), 127)]; }
#pragma unroll
    for (int r = 0; r < 16; ++r) { asm volatile("" : "+v"(b0[r]), "+v"(b1[r])); }
#pragma unroll
    for (int r = 0; r < 16; ++r) { const int koff = (r & 3) + 8 * (r >> 2); const int d0 = dbase - STEP * koff, d1 = d0 - STEP * 32;
        const float t0 = p0[r] + b0[r], t1 = p1[r] + b1[r];
        p0[r] = ((unsigned)d0 < LIMIT) ? t0 : -INFINITY; p1[r] = ((unsigned)d1 < LIMIT) ? t1 : -INFINITY; }
}
template <bool HASO>
__device__ __forceinline__ void sm_update(f32x16& p0, f32x16& p1, float bias, float& m, float& l, f32x16* o, LAS float* wsf, int r32, int hi) {
    const float rm = rowmax(p0, p1) + bias;
    const bool need = rm > m + THR;
    if (__any(need)) {
        const float mn = need ? rm : m; const float alpha = __builtin_amdgcn_exp2f(m - mn);
        l *= alpha; m = mn;
        if (HASO) { if (hi == 0) wsf[r32] = alpha; LDS_WAIT();
#pragma unroll
            for (int r = 0; r < 16; ++r) { const float f = wsf[crow(r, hi)]; o[0][r] *= f; o[1][r] *= f; } }
    }
    const float mb = m - bias;
#pragma unroll
    for (int r = 0; r < 16; ++r) { p0[r] = __builtin_amdgcn_exp2f(p0[r] - mb); p1[r] = __builtin_amdgcn_exp2f(p1[r] - mb); }
    float t[8];
#pragma unroll
    for (int r = 0; r < 8; ++r) t[r] = (p0[2 * r] + p0[2 * r + 1]) + (p1[2 * r] + p1[2 * r + 1]);
    l += ((t[0] + t[1]) + (t[2] + t[3])) + ((t[4] + t[5]) + (t[6] + t[7]));
}
#define ATT_PACK(P0, P1) \
    const bf16x8 pa0 = __builtin_bit_cast(bf16x8, (u32x4){cvtpk(P0[0], P0[1]), cvtpk(P0[2], P0[3]), cvtpk(P0[4], P0[5]), cvtpk(P0[6], P0[7])}); \
    const bf16x8 pa1 = __builtin_bit_cast(bf16x8, (u32x4){cvtpk(P0[8], P0[9]), cvtpk(P0[10], P0[11]), cvtpk(P0[12], P0[13]), cvtpk(P0[14], P0[15])}); \
    const bf16x8 pa2 = __builtin_bit_cast(bf16x8, (u32x4){cvtpk(P1[0], P1[1]), cvtpk(P1[2], P1[3]), cvtpk(P1[4], P1[5]), cvtpk(P1[6], P1[7])}); \
    const bf16x8 pa3 = __builtin_bit_cast(bf16x8, (u32x4){cvtpk(P1[8], P1[9]), cvtpk(P1[10], P1[11]), cvtpk(P1[12], P1[13]), cvtpk(P1[14], P1[15])});
#define ATT_WAITBAR(N) asm volatile("s_waitcnt vmcnt(" #N ") lgkmcnt(0)\n\ts_barrier" ::: "memory")
#define ATT_FILL(V, x) do { _Pragma("unroll") for (int _r = 0; _r < 16; ++_r) V[_r] = (x); } while (0)

__device__ __forceinline__ unsigned rangemask(int k, int a, int b) {
    const int lo = max(a - 32 * k, 0), hi = min(b - 32 * k, 31);
    return (lo > hi) ? 0u : ((0xFFFFFFFFu >> (31 - hi)) & (0xFFFFFFFFu << lo));
}
__device__ __forceinline__ int wave_max_i32(int x) {
    x = max(x, dpp_i<0xB1>(x)); x = max(x, dpp_i<0x4E>(x)); x = max(x, dpp_i<0x141>(x)); x = max(x, dpp_i<0x140>(x));
    return max(max(__builtin_amdgcn_readlane(x, 0), __builtin_amdgcn_readlane(x, 16)), max(__builtin_amdgcn_readlane(x, 32), __builtin_amdgcn_readlane(x, 48)));
}

__device__ __forceinline__ void lds_add_f32(LAS float* p, float v) { (void)__hip_atomic_fetch_add(p, v, __ATOMIC_RELAXED, __HIP_MEMORY_SCOPE_WORKGROUP); }

__device__ __forceinline__ void attn_item(const Frame& F, int qt, int g) {
    const int lane = lane_id(), wid = F.wave, tid = wid * 64 + lane, r32 = lane & 31, hi = lane >> 5;
    const int ql = r32 >> 2, h = r32 & 3, cur = qt, t = 64 * qt + 8 * wid + ql, head = 4 * g + h;
    LAS unsigned char* shm = F.lds;
    const unsigned lds0 = (unsigned)(uintptr_t)shm;
    LAS float* wsf = (LAS float*)(shm + L_WSF) + wid * 64;
    LAS float* SC = (LAS float*)(shm + L_SC);
    LAS float* OACC = (LAS float*)(shm + L_SC);
    LAS float* lutl = (LAS float*)(shm + L_LUT);
    const LAS float* luth = lutl + h;
    LAS unsigned* BM = (LAS unsigned*)(shm + L_BM);
    LAS float* REF = (LAS float*)(shm + L_REF);
    LAS float* LACC = (LAS float*)(shm + L_LACC);
    lutl[4 * (tid & 127) + (tid >> 7)] = F.LUT()[(4 * g + (tid >> 7)) * 128 + (tid & 127)];
    BM[tid] = 0u;
    LAS u32x2* QL8 = (LAS u32x2*)(shm + L_OUT);
#pragma unroll
    for (int i = 0; i < 4; ++i) { const int slot = tid + 512 * i, q = slot >> 5, ks_ = (slot >> 4) & 1, gq_ = (slot >> 2) & 3, h_ = slot & 3;
        const u32x4 w = *(const u32x4*)(F.Q2() + (size_t)(64 * qt + q) * 512 + g * 256 + (2 * ks_ + (gq_ >> 1)) * 64 + h_ * 16 + 8 * (gq_ & 1));
        int w0 = __builtin_amdgcn_cvt_pk_fp8_f32(8.f * bflo(w.x), 8.f * bfhi(w.x), 0, false); w0 = __builtin_amdgcn_cvt_pk_fp8_f32(8.f * bflo(w.y), 8.f * bfhi(w.y), w0, true);
        int w1 = __builtin_amdgcn_cvt_pk_fp8_f32(8.f * bflo(w.z), 8.f * bfhi(w.z), 0, false); w1 = __builtin_amdgcn_cvt_pk_fp8_f32(8.f * bflo(w.w), 8.f * bfhi(w.w), w1, true);
        QL8[slot] = (u32x2){(unsigned)w0, (unsigned)w1}; }
    bf16x8 qr[4];
    { const bf16* qp = F.Q2() + (size_t)t * 512 + g * 256 + h * 16 + hi * 8;
#pragma unroll
        for (int d0 = 0; d0 < 4; ++d0) qr[d0] = *(const bf16x8*)(qp + d0 * 64); }
    const float b31 = F.LUT()[head * 128 + 127];
    const float gate_c = fsigmoid(bf2f(F.BR()[(size_t)t * 256 + head])), gate_s = fsigmoid(bf2f(F.BR()[(size_t)t * 256 + 8 + head])), gate_w = fsigmoid(bf2f(F.BR()[(size_t)t * 256 + 16 + head]));
    f32x16 o[2], p0, p1;
    const unsigned kdst = lds0 + L_K + wid * 1024, vdst = lds0 + L_V + wid * 1024;
    const int vrow = 16 * (wid & 3) + (lane >> 2), vcol = (wid >> 2) * 32 + (lane & 3) * 8;
    const int vb0 = (int)(lds0 + L_V) + ((lane >> 4) & 1) * 32 + (lane & 3) * 8 + (4 * hi + ((lane & 15) >> 2)) * 64;
#define DMA_K(base, pitch, row0, slot) glds16((base) + (size_t)((row0) + lane) * (pitch) + wid * 8, (unsigned)__builtin_amdgcn_readfirstlane(kdst + (slot)))
#define DMA_V(base, pitch, row0, slot) glds16((base) + (size_t)((row0) + vrow) * (pitch) + vcol, (unsigned)__builtin_amdgcn_readfirstlane(vdst + (slot)))
#define ROT() do { sl_cur = sl_next; sl_next = (sl_next == (NSLOT - 1) * SLOTB) ? 0 : sl_next + SLOTB; } while (0)
    VM_WAIT(); LDS_WAIT(); __syncthreads();

    const bf16* KCg = F.KC() + (size_t)g * 1024 * 64; const bf16* VCg = F.VC() + (size_t)g * 1024 * 64;
    const int nkt = (qt >> 4) + 1;
    const int tminw = 64 * qt + 8 * wid;
    float m = -1e30f, l = 0.f;
    {
        int sl_cur = 0, sl_next = SLOTB;
        DMA_K(KCg, 64, 0, 0);
        for (int kt = 0; kt < nkt; ++kt) {
            if (kt + 1 < nkt) { DMA_K(KCg, 64, 64 * (kt + 1), sl_next); ATT_WAITBAR(1); } else { ATT_WAITBAR(0); }
            const bool far = (tminw - 31 - 16 * (64 * kt + 63)) >= 128;
            qkt(p0, p1, shm + L_K + sl_cur, qr, r32, hi);
            if (!far) near_apply<16, 0x80000000u>(p0, p1, t - 31 - 16 * (64 * kt + 4 * hi), luth);
            sm_update<false>(p0, p1, far ? b31 : 0.f, m, l, o, wsf, r32, hi);
            ROT();
        }
        LDS_WAIT(); __builtin_amdgcn_s_barrier();
    }
    {
        const float lt = halfsum(l); const float rl = lt > 0.f ? 1.0f / lt : 0.f;
        ATT_FILL(o[0], 0.f); ATT_FILL(o[1], 0.f);
        float carry = 0.f;
        int sl_cur = 0, sl_next = SLOTB;
        DMA_K(KCg, 64, 0, 0); DMA_V(VCg, 64, 0, 0);
        for (int kt = 0; kt < nkt; ++kt) {
            if (kt + 1 < nkt) { DMA_K(KCg, 64, 64 * (kt + 1), sl_next); DMA_V(VCg, 64, 64 * (kt + 1), sl_next); ATT_WAITBAR(2); } else { ATT_WAITBAR(0); }
            const bool far = (tminw - 31 - 16 * (64 * kt + 63)) >= 128;
            qkt(p0, p1, shm + L_K + sl_cur, qr, r32, hi);
            if (!far) near_apply<16, 0x80000000u>(p0, p1, t - 31 - 16 * (64 * kt + 4 * hi), luth);
            const float mb2 = far ? m - b31 : m;
#pragma unroll
            for (int r = 0; r < 16; ++r) { p0[r] = __builtin_amdgcn_exp2f(p0[r] - mb2) * rl; p1[r] = __builtin_amdgcn_exp2f(p1[r] - mb2) * rl; }
            {
                float q4[8], e[8];
#pragma unroll
                for (int i = 0; i < 4; ++i) { q4[i] = (p0[4 * i] + p0[4 * i + 1]) + (p0[4 * i + 2] + p0[4 * i + 3]); e[i] = p0[4 * i + 3];
                                              q4[4 + i] = (p1[4 * i] + p1[4 * i + 1]) + (p1[4 * i + 2] + p1[4 * i + 3]); e[4 + i] = p1[4 * i + 3]; }
                float newcarry = 0.f;
#pragma unroll
                for (int i = 0; i < 8; ++i) { auto rr = __builtin_amdgcn_permlane32_swap(__float_as_uint(e[i]), __float_as_uint(e[i]), false, false);
                    const float elo = __uint_as_float(rr[0]), ehi = __uint_as_float(rr[1]);
                    if (hi) q4[i] += elo; else if (i < 7) q4[i + 1] += ehi;
                    if (i == 7) newcarry = ehi; }
                if (!hi) q4[0] += carry;
                carry = newcarry;
#pragma unroll
                for (int i = 0; i < 8; ++i) { float v = q4[i]; v += dpp_f<0xB1>(v); v += dpp_f<0x4E>(v); q4[i] = v; }
                if (h == 0) {
#pragma unroll
                    for (int i = 0; i < 8; ++i) SC[(8 * wid + ql) * 256 + 16 * kt + 2 * i + hi] = q4[i]; }
            }
            { ATT_PACK(p0, p1); pv(o, vb0 + sl_cur, pa0, pa1, pa2, pa3); }
            ROT();
        }
        LDS_WAIT(); __builtin_amdgcn_s_barrier();
    }

    if (cur >= 16) {
        const int u4 = lane >> 4, li16 = lane & 15;
#pragma unroll 1
        for (int qb = 0; qb < 8; qb += 4) {
            const int qloc = 8 * wid + qb + u4;
            const LAS float* row = SC + qloc * 256 + li16;
            int v[16];
#pragma unroll
            for (int k = 0; k < 16; ++k) { const int J = li16 + 16 * k; const int x = (__float_as_int(row[16 * k]) & ~255) | (255 - J); v[k] = (J >= 1 && J <= cur - 2) ? x : -1; }
            LAS unsigned* bmq = BM + (qloc >> 5); const unsigned qbit = 1u << (qloc & 31);
#pragma unroll 1
            for (int round = 0; round < 13; ++round) {
                int lm = max(max(max(v[0], v[1]), max(v[2], v[3])), max(max(v[4], v[5]), max(v[6], v[7])));
                lm = max(lm, max(max(max(v[8], v[9]), max(v[10], v[11])), max(max(v[12], v[13]), max(v[14], v[15]))));
                int rm = lm; rm = max(rm, dpp_i<0xB1>(rm)); rm = max(rm, dpp_i<0x4E>(rm)); rm = max(rm, dpp_i<0x141>(rm)); rm = max(rm, dpp_i<0x140>(rm));
                if (lm == rm) {
#pragma unroll
                    for (int k = 0; k < 16; ++k) v[k] = (v[k] == rm) ? -1 : v[k];
                    __hip_atomic_fetch_or(bmq + 2 * (255 - (rm & 255)), qbit, __ATOMIC_RELAXED, __HIP_MEMORY_SCOPE_WORKGROUP);
                }
            }
        }
    }
    LDS_WAIT();
    LAS float* ostg = (LAS float*)(shm + L_SC) + wid * 2048;
    {
        if (hi == 0) wsf[r32] = gate_c; LDS_WAIT();
#pragma unroll
        for (int r = 0; r < 16; ++r) { const float f = wsf[crow(r, hi)]; const int orow = crow(r, hi); ostg[orow * 64 + r32] = o[0][r] * f; ostg[orow * 64 + 32 + r32] = o[1][r] * f; }
    }

    const bf16* Kw = F.KV() + 512 + g * 64; const bf16* Vw = F.KV() + 640 + g * 64;
    {
        m = -1e30f; l = 0.f; ATT_FILL(o[0], 0.f); ATT_FILL(o[1], 0.f);
        const int J0 = max(cur - 8, 0);
        int sl_cur = 0, sl_next = SLOTB;
        DMA_K(Kw, 768, 64 * J0, 0); DMA_V(Vw, 768, 64 * J0, 0);
        for (int J = J0; J <= cur; ++J) {
            if (J + 1 <= cur) { DMA_K(Kw, 768, 64 * (J + 1), sl_next); DMA_V(Vw, 768, 64 * (J + 1), sl_next); ATT_WAITBAR(2); } else { ATT_WAITBAR(0); }
            const bool nearw = (J >= cur - 2 || J == cur - 8);
            qkt(p0, p1, shm + L_K + sl_cur, qr, r32, hi);
            if (nearw) near_apply<1, 512u>(p0, p1, t - 64 * J - 4 * hi, luth);
            sm_update<true>(p0, p1, nearw ? 0.f : b31, m, l, o, wsf, r32, hi);
            { ATT_PACK(p0, p1); pv(o, vb0 + sl_cur, pa0, pa1, pa2, pa3); }
            ROT();
        }
        LDS_WAIT(); __builtin_amdgcn_s_barrier();
        const float lt = halfsum(l); const float fw = lt > 0.f ? gate_w / lt : 0.f;
        if (hi == 0) wsf[r32] = fw; LDS_WAIT();
#pragma unroll
        for (int r = 0; r < 16; ++r) { const float f = wsf[crow(r, hi)]; const int orow = crow(r, hi); ostg[orow * 64 + r32] += o[0][r] * f; ostg[orow * 64 + 32 + r32] += o[1][r] * f; }
        LDS_WAIT();
#pragma unroll
        for (int i = 0; i < 4; ++i) { const int rowl = i * 8 + (lane >> 3), chn = lane & 7;
            const f32x4 a0 = *(const LAS f32x4*)(ostg + rowl * 64 + chn * 8), a1 = *(const LAS f32x4*)(ostg + rowl * 64 + chn * 8 + 4);
            const size_t tt = (size_t)(64 * qt + 8 * wid + (rowl >> 2)); const int col = (4 * g + (rowl & 3)) * 64 + chn * 8;
            *(u32x4*)(F.XN() + tt * 1024 + col) = (u32x4){cvtpk(a0[0], a0[1]), cvtpk(a0[2], a0[3]), cvtpk(a1[0], a1[1]), cvtpk(a1[2], a1[3])}; }
        LDS_WAIT();
    }

    const bf16* Ks = F.KV() + 256 + g * 64; const bf16* Vs = F.KV() + 384 + g * 64;
    {
        m = -1e30f; l = 0.f; ATT_FILL(o[0], 0.f); ATT_FILL(o[1], 0.f);
        const int nA = (cur < 16) ? cur + 1 : 3;
#define JA(i) ((cur < 16) ? (i) : ((i) == 0 ? 0 : cur - 2 + (i)))
        int sl_cur = 0, sl_next = SLOTB;
        DMA_K(Ks, 768, 0, 0); DMA_V(Vs, 768, 0, 0);
        for (int i = 0; i < nA; ++i) {
            const int J = JA(i);
            if (i + 1 < nA) { const int Jn = JA(i + 1); DMA_K(Ks, 768, 64 * Jn, sl_next); DMA_V(Vs, 768, 64 * Jn, sl_next); ATT_WAITBAR(2); } else { ATT_WAITBAR(0); }
            const bool neara = (J >= cur - 2);
            qkt(p0, p1, shm + L_K + sl_cur, qr, r32, hi);
            if (neara) near_apply<1, 0x80000000u>(p0, p1, t - 64 * J - 4 * hi, luth);
            sm_update<true>(p0, p1, neara ? 0.f : b31, m, l, o, wsf, r32, hi);
            { ATT_PACK(p0, p1); pv(o, vb0 + sl_cur, pa0, pa1, pa2, pa3); }
            ROT();
        }
#undef JA
        LDS_WAIT(); __builtin_amdgcn_s_barrier();
        const float lt = halfsum(l);
        if (hi == 0) { REF[32 * wid + r32] = m; LACC[32 * wid + r32] = lt; }
#pragma unroll
        for (int r = 0; r < 16; ++r) { const int orow = 32 * wid + crow(r, hi); OACC[orow * 64 + r32] = o[0][r]; OACC[orow * 64 + 32 + r32] = o[1][r]; }
        LDS_WAIT(); __builtin_amdgcn_s_barrier();
    }

    if (cur >= 16) {
        const int c16 = lane & 15, gq = lane >> 4, qi4 = c16 >> 2;
        float oa[2][16], la2[2];
        { const int li_ = lane & 15, hsel_ = li_ >> 2, dq_ = (li_ & 3) * 16;
#pragma unroll
            for (int p = 0; p < 2; ++p) { la2[p] = 0.f; const LAS f32x4* ap = (const LAS f32x4*)(OACC + (4 * (8 * wid + 4 * p + gq) + hsel_) * 64 + dq_);
#pragma unroll
                for (int k = 0; k < 4; ++k) { const f32x4 a = ap[k]; oa[p][4 * k] = a[0]; oa[p][4 * k + 1] = a[1]; oa[p][4 * k + 2] = a[2]; oa[p][4 * k + 3] = a[3]; } } }
        LDS_WAIT(); __builtin_amdgcn_s_barrier();
        typedef long i64_t;
        const i64_t* KTg = (const i64_t*)F.KT() + (size_t)g * 256 * 512 + gq * 16 + c16; const bf16* VTg = F.VT() + (size_t)g * 256 * 4096 + c16 * 32 + 8 * gq;
        const LAS i64_t* QLg = (const LAS i64_t*)QL8 + gq * 4 + h;
        LAS unsigned* TL = (LAS unsigned*)(shm + L_TL) + wid * 160;
        int ntask = 0;
#pragma unroll 1
        for (int i4 = 0; i4 < 4; ++i4) {
            const int Jl = lane + 64 * i4; int nch = 0;
            unsigned long long mk = 0ull;
            if (Jl >= 1 && Jl <= cur - 2 && (Jl & 7) == wid) { mk = ((unsigned long long)BM[2 * Jl + 1] << 32) | BM[2 * Jl]; nch = (__popcll(mk) + 3) >> 2; }
            int incl = nch;
#pragma unroll
            for (int o = 1; o < 64; o <<= 1) { const int up = __shfl_up(incl, o); if (lane >= o) incl += up; }
            const int base = ntask + incl - nch;
            for (int c = 0; c < nch; ++c) { unsigned e = (unsigned)Jl; int q0 = 0;
#pragma unroll
                for (int k = 0; k < 4; ++k) { int q = q0; if (mk) { q = __builtin_ctzll(mk); mk &= mk - 1; } if (k == 0) q0 = q; e |= (unsigned)q << (8 + 6 * k); }
                if (base + c < 160) TL[base + c] = e; }
            ntask += __shfl(incl, 63);
        }
        ntask = min(ntask, 160);
        LAS float* EX = (LAS float*)(shm + L_EX); LAS int* HDR = (LAS int*)(shm + L_HDR); LAS float* LEX = (LAS float*)(shm + L_LEX); LAS int* NT = (LAS int*)(shm + L_NT);
        if (lane == 0) NT[wid] = ntask;
        LDS_WAIT(); __builtin_amdgcn_s_barrier();
        int nround = 0;
#pragma unroll
        for (int k = 0; k < 8; ++k) nround = max(nround, __builtin_amdgcn_readfirstlane(NT[k]));
        i64_t kfC[8], kfN[8]; bf16x8 vfC[8]; bool kpend = false;
#define LOADK(J_, KF) do { const i64_t* kp_ = KTg + (size_t)(J_) * 512; \
            _Pragma("unroll") for (int kt = 0; kt < 4; ++kt) { KF[2 * kt] = kp_[kt * 64]; KF[2 * kt + 1] = kp_[256 + kt * 64]; } } while (0)
#define LOADV(J_, VF) do { const bf16* vp_ = VTg + (size_t)(J_) * 4096; _Pragma("unroll") for (int x = 0; x < 8; ++x) VF[x] = *(const bf16x8*)(vp_ + x * 512); } while (0)
        unsigned e_cur = 0xffu;
        i64_t qg0 = 0, qg1 = 0; float ref = 0.f;
#define QFETCH(E) do { const int mq_ = ((E) >> (8 + 6 * qi4)) & 63; const LAS i64_t* qp_ = QLg + mq_ * 32; qg0 = qp_[0]; qg1 = qp_[16]; ref = REF[4 * mq_ + h]; } while (0)
        if (ntask > 0) { e_cur = (unsigned)__builtin_amdgcn_readfirstlane((int)TL[0]); LOADK(e_cur & 255u, kfC); LOADV(e_cur & 255u, vfC); QFETCH(e_cur); }
        unsigned tl1 = (ntask > 1) ? TL[1] : 0xffu;
#define OWNER_PASS(HV, B) do { const int li_ = lane & 15, hsel_ = li_ >> 2, dq_ = (li_ & 3) * 16; \
            _Pragma("unroll") for (int pass = 0; pass < 2; ++pass) { \
                const unsigned m0 = (unsigned)__ballot((HV) == 8 * wid + 4 * pass + 0), m1 = (unsigned)__ballot((HV) == 8 * wid + 4 * pass + 1), m2 = (unsigned)__ballot((HV) == 8 * wid + 4 * pass + 2), m3 = (unsigned)__ballot((HV) == 8 * wid + 4 * pass + 3); \
                if ((m0 | m1 | m2 | m3) == 0u) continue; \
                unsigned mm = gq == 0 ? m0 : gq == 1 ? m1 : gq == 2 ? m2 : m3; \
                while (mm) { const int e = __builtin_ctz(mm); mm &= mm - 1; \
                    const LAS f32x4* xr = (const LAS f32x4*)(EX + (B) * 8704 + (e * 4 + hsel_) * 68 + dq_); \
                    const f32x4 y0 = xr[0], y1 = xr[1], y2 = xr[2], y3 = xr[3]; \
                    oa[pass][0] += y0[0]; oa[pass][1] += y0[1]; oa[pass][2] += y0[2]; oa[pass][3] += y0[3]; oa[pass][4] += y1[0]; oa[pass][5] += y1[1]; oa[pass][6] += y1[2]; oa[pass][7] += y1[3]; \
                    oa[pass][8] += y2[0]; oa[pass][9] += y2[1]; oa[pass][10] += y2[2]; oa[pass][11] += y2[3]; oa[pass][12] += y3[0]; oa[pass][13] += y3[1]; oa[pass][14] += y3[2]; oa[pass][15] += y3[3]; \
                    la2[pass] += LEX[(B) * 128 + e * 4 + hsel_]; } } } while (0)
#pragma unroll 1
        for (int n = 0; n < nround; ++n) {
            const int buf = n & 1;
            const int hvp = (n > 0 && lane < 32) ? HDR[(buf ^ 1) * 32 + lane] : -1;
            if (n < ntask) {
                const unsigned e_nxt = (n + 1 < ntask) ? (unsigned)__builtin_amdgcn_readfirstlane((int)tl1) : 0xffu;
                tl1 = (n + 2 < ntask) ? TL[n + 2] : 0xffu;
                const unsigned e_ = e_cur; const int Jb = e_ & 255, Jn = e_nxt & 255; const bool reload = (Jn != Jb) && (Jn != 255);
                const int q0_ = (e_ >> 8) & 63;
                const int myq = (e_ >> (8 + 6 * qi4)) & 63; const bool valid = (qi4 == 0) || (myq != q0_); const int tq = 64 * qt + myq;
                const bool nearJ = (Jb >= cur - 2);
                const float cinit = nearJ ? 0.f : (valid ? b31 - ref : -INFINITY);
                if (kpend) {
#pragma unroll
                    for (int x = 0; x < 8; ++x) kfC[x] = kfN[x];
                    kpend = false; }
                if (reload) { LOADK(Jn, kfN); kpend = true; }
                f32x4 s[4];
#pragma unroll
                for (int kt = 0; kt < 4; ++kt) { s[kt] = (f32x4){0.f, 0.f, 0.f, 0.f};
                    s[kt] = __builtin_amdgcn_mfma_f32_16x16x32_fp8_fp8(kfC[2 * kt], qg0, s[kt], 0, 0, 0); s[kt] = __builtin_amdgcn_mfma_f32_16x16x32_fp8_fp8(kfC[2 * kt + 1], qg1, s[kt], 0, 0, 0); }
                const float refc = ref;
                if (n + 1 < ntask) QFETCH(e_nxt);
                if (nearJ) { const float sub = valid ? refc : INFINITY;
                    float bb[16];
#pragma unroll
                    for (int kt = 0; kt < 4; ++kt)
#pragma unroll
                        for (int r = 0; r < 4; ++r) { const int dd = tq - 64 * Jb - (16 * kt + 4 * gq + r); bb[kt * 4 + r] = luth[4 * min(max(dd, 0), 127)]; }
#pragma unroll
                    for (int x = 0; x < 16; ++x) asm volatile("" : "+v"(bb[x]));
#pragma unroll
                    for (int kt = 0; kt < 4; ++kt)
#pragma unroll
                        for (int r = 0; r < 4; ++r) { const int dd = tq - 64 * Jb - (16 * kt + 4 * gq + r); const float tt = s[kt][r] * 0.125f + bb[kt * 4 + r] - sub;
                            s[kt][r] = (dd >= 0) ? tt * 8.0f : -INFINITY; } }
#pragma unroll
                for (int kt = 0; kt < 4; ++kt)
#pragma unroll
                    for (int r = 0; r < 4; ++r) { const int tb = min(__float_as_int(s[kt][r] * 0.125f + cinit), __float_as_int(CLAMP));
                        s[kt][r] = __builtin_amdgcn_exp2f(__int_as_float(tb)); }
                float ls = (((s[0][0] + s[0][1]) + (s[0][2] + s[0][3])) + ((s[1][0] + s[1][1]) + (s[1][2] + s[1][3]))) + (((s[2][0] + s[2][1]) + (s[2][2] + s[2][3])) + ((s[3][0] + s[3][1]) + (s[3][2] + s[3][3])));
                { auto r16 = __builtin_amdgcn_permlane16_swap(__float_as_uint(ls), __float_as_uint(ls), false, false); ls = __uint_as_float(r16[0]) + __uint_as_float(r16[1]); }
                ls = halfsum(ls);
                bf16x8 pb[2];
#pragma unroll
                for (int ks = 0; ks < 2; ++ks) pb[ks] = __builtin_bit_cast(bf16x8, (u32x4){cvtpk(s[2 * ks][0], s[2 * ks][1]), cvtpk(s[2 * ks][2], s[2 * ks][3]), cvtpk(s[2 * ks + 1][0], s[2 * ks + 1][1]), cvtpk(s[2 * ks + 1][2], s[2 * ks + 1][3])});
                LAS float* ex = EX + buf * 8704 + ((wid * 4 + qi4) * 4 + h) * 68 + 4 * gq;
                f32x4 ot[4];
#pragma unroll
                for (int mt = 0; mt < 4; ++mt) { ot[mt] = (f32x4){0.f, 0.f, 0.f, 0.f};
                    ot[mt] = __builtin_amdgcn_mfma_f32_16x16x32_bf16(vfC[2 * mt], pb[0], ot[mt], 0, 0, 0); ot[mt] = __builtin_amdgcn_mfma_f32_16x16x32_bf16(vfC[2 * mt + 1], pb[1], ot[mt], 0, 0, 0); }
                if (reload) LOADV(Jn, vfC);
#pragma unroll
                for (int mt = 0; mt < 4; ++mt) *(LAS f32x4*)(ex + 16 * mt) = ot[mt];
                if (gq == 0) { LEX[buf * 128 + wid * 16 + c16] = ls; if (h == 0) HDR[buf * 32 + wid * 4 + qi4] = valid ? myq : -1; }
                e_cur = e_nxt;
            } else if (lane < 4) HDR[buf * 32 + wid * 4 + lane] = -1;
            OWNER_PASS(hvp, buf ^ 1);
            LDS_WAIT(); __builtin_amdgcn_s_barrier();
        }
        if (nround > 0) { const int lb = (nround - 1) & 1; const int hvl = (lane < 32) ? HDR[lb * 32 + lane] : -1; OWNER_PASS(hvl, lb); }
#undef OWNER_PASS
        LDS_WAIT(); __builtin_amdgcn_s_barrier();
        {
            const int li = lane & 15, hsel = li >> 2, dq = (li & 3) * 16;
#pragma unroll
            for (int pass = 0; pass < 2; ++pass) { const int q = 8 * wid + 4 * pass + gq; LAS f32x4* ap = (LAS f32x4*)(OACC + (4 * q + hsel) * 64 + dq);
#pragma unroll
                for (int k = 0; k < 4; ++k) ap[k] = (f32x4){oa[pass][4 * k], oa[pass][4 * k + 1], oa[pass][4 * k + 2], oa[pass][4 * k + 3]};
                if ((li & 3) == 0) LACC[4 * q + hsel] += la2[pass]; }
        }
#undef LOADK
#undef LOADV
#undef QFETCH
    }
    LDS_WAIT(); __builtin_amdgcn_s_barrier();

    {
        if (hi == 0) { const float lt = LACC[32 * wid + r32]; wsf[r32] = lt > 0.f ? gate_s / lt : 0.f; }
        LDS_WAIT();
#pragma unroll
        for (int i = 0; i < 4; ++i) { const int rowl = i * 8 + (lane >> 3), chn = lane & 7, row = 32 * wid + rowl;
            const float f = wsf[rowl];
            const f32x4 a0 = *(const LAS f32x4*)(OACC + row * 64 + chn * 8), a1 = *(const LAS f32x4*)(OACC + row * 64 + chn * 8 + 4);
            const size_t tt = (size_t)(64 * qt + 8 * wid + (rowl >> 2)); const int col = (4 * g + (rowl & 3)) * 64 + chn * 8;
            const u32x4 ov = *(const u32x4*)(F.XN() + tt * 1024 + col);
            const u32x4 gn = *(const u32x4*)(F.GN() + tt * 512 + col);
            u32x4 w; w.x = pk2((bflo(ov.x) + a0[0] * f) * bflo(gn.x), (bfhi(ov.x) + a0[1] * f) * bfhi(gn.x)); w.y = pk2((bflo(ov.y) + a0[2] * f) * bflo(gn.y), (bfhi(ov.y) + a0[3] * f) * bfhi(gn.y));
            w.z = pk2((bflo(ov.z) + a1[0] * f) * bflo(gn.z), (bfhi(ov.z) + a1[1] * f) * bfhi(gn.z)); w.w = pk2((bflo(ov.w) + a1[2] * f) * bflo(gn.w), (bfhi(ov.w) + a1[3] * f) * bfhi(gn.w));
            *(u32x4*)(F.XN() + tt * 1024 + col) = w; }
        VM_WAIT(); LDS_WAIT(); __syncthreads();
    }
#undef DMA_K
#undef DMA_V
#undef ROT
}
}

__global__ void __launch_bounds__(NWAVES * 64, 2) nsa_lru_fwd(Args args) {
    extern __shared__ __attribute__((aligned(16))) unsigned char lds[];
    Frame F;
    F.lds = (LAS unsigned char*)lds;
    F.MISC = (volatile LAS unsigned*)(F.lds + MISC_OFF);
    F.wave = __builtin_amdgcn_readfirstlane((int)(threadIdx.x >> 6));
    F.G = gridDim.x; { const int bx = blockIdx.x; F.vcu = (F.G % 8 == 0) ? (bx % 8) * (F.G / 8) + bx / 8 : bx; }
    F.ws = args.ws;
    gu32* ctl = (gu32*)(args.ws + WS_CTL);
    for (int u = F.wave * 64 + lane_id(); u < (LDS_BYTES - LDSCTL_OFF) / 4; u += NWAVES * 64) ((LAS unsigned*)(F.lds + LDSCTL_OFF))[u] = 0u;
    __syncthreads();
    const int bli = (N_LAUNCHES == PER_PHASE) ? 0 : args.li;
    XcdBarrier bar; bar.bar = (unsigned*)(ctl + CW_BAR) + bli * XCD_BAR_WORDS; bar.x = 0; bar.st = nullptr;
    if (N_LAUNCHES != PER_PHASE) bar = xcd_barrier_post((unsigned*)(ctl + CW_BAR) + bli * XCD_BAR_WORDS, F.MISC + 8);
#define GRID_BAR() do { if (N_LAUNCHES != PER_PHASE) xcd_barrier(bar); } while (0)
    const int lo = args.ph_lo, hi = args.ph_hi;
#define IN(k) (lo <= (k) && (k) < hi)
#define BOTH(k) (IN(k) && IN((k) + 1))

    if (IN(0)) { p0_prologue(F, args); if (BOTH(0)) GRID_BAR(); }

    if (IN(1)) {
        pg8::Gemm g{F.XN(), F.WinT(), F.XN(), F.WinT(), 1024, 1024, 1024}; pg8::StaticOrder S; S.init(SEQ, NPROJ, F.G, (int)blockIdx.x);
        pg8::EpiProj E{F.Q(), F.KV(), F.U(), F.BR(), F.GN(), F.GL(), F.MG()};
        pg8::gemm_phase<pg8::EpiProj, pg8::StaticOrder, true>(F.lds, g, S, E, F.wave);
        if (BOTH(1)) GRID_BAR();
    }

    if (IN(2)) {
        for (int i = F.vcu; i < 256; i += F.G) {
            lru_tile<false>(F, args, i);
            if (!args.pad) qk_norm_tile(F, args, i);
            vt_tile(F, i);
            __syncthreads();
            compress_item(F, args, i & 1, (i >> 1) & 1, i >> 2);
        }
        if (BOTH(2)) GRID_BAR();
    }

    if (IN(3)) {
        for (int i = F.vcu; i < 256; i += F.G) { lru_apply(F, i); }
        __syncthreads();
#pragma unroll 1
        for (int it = 2 * F.vcu; it < 512; it += 2 * F.G) {
#pragma unroll 1
            for (int j = 0; j < 2; ++j) { const int i = it >> 1; att::attn_item(F, j ? i : 255 - i, j ? 0 : 1); }
        }
        if (BOTH(3)) GRID_BAR();
    }

    if (IN(4)) {
        pg8::Gemm g{F.XN(), F.WaT(), F.XN() + 512, F.WbT(), 1024, 512, 512}; pg8::DualOrder S; S.init(SEQ, 1024, F.G, (int)blockIdx.x);
        pg8::EpiMerge E{F.MB(), F.MG()};
        pg8::gemm_phase<pg8::EpiMerge, pg8::DualOrder, true>(F.lds, g, S, E, F.wave);
        if (BOTH(4)) GRID_BAR();
    }

    if (IN(5)) {
        pg8::Gemm g{F.MB(), F.WoutT(), F.MB(), F.WoutT(), 1024, 1024, 1024}; pg8::StaticOrder S; S.init(SEQ, 1024, F.G, (int)blockIdx.x);
        pg8::EpiOut E{args.in[0], args.out};
        pg8::gemm_phase<pg8::EpiOut, pg8::StaticOrder, true>(F.lds, g, S, E, F.wave);
    }
#undef IN
#undef BOTH
}

extern "C" void kernel_launch(void* const* d_in, const int* in_sizes, int n_in, void* d_out, int out_size, void* d_ws, size_t ws_size, hipStream_t stream) {
    static int grid = 0;
    if (grid == 0) {
        if (n_in != 20 || in_sizes[0] != SEQ * DM || out_size != SEQ * DM || ws_size < WS_END) { fprintf(stderr, "kernel_launch: unexpected shapes (n_in %d, in0 %d, out %d, ws %zu)\n", n_in, n_in > 0 ? in_sizes[0] : -1, out_size, ws_size); grid = -1; return; }
        int dev = 0, cus = 0, per_cu = 0;
        if (hipGetDevice(&dev) != hipSuccess || hipDeviceGetAttribute(&cus, hipDeviceAttributeMultiprocessorCount, dev) != hipSuccess) { grid = -1; return; }
        if (hipFuncSetAttribute((const void*)nsa_lru_fwd, hipFuncAttributeMaxDynamicSharedMemorySize, LDS_BYTES) != hipSuccess) { fprintf(stderr, "kernel_launch: hipFuncSetAttribute failed\n"); grid = -1; return; }
        if (hipOccupancyMaxActiveBlocksPerMultiprocessor(&per_cu, (const void*)nsa_lru_fwd, NWAVES * 64, LDS_BYTES) != hipSuccess || per_cu < 1)
            fprintf(stderr, "kernel_launch: occupancy query reports %d workgroups per CU\n", per_cu);
        (void)hipGetLastError();
        grid = cus;
    }
    if (grid < 0) return;
    if (hipMemsetAsync((char*)d_ws + WS_CTL, 0, CTL_ZERO_BYTES, stream) != hipSuccess) { fprintf(stderr, "kernel_launch: hipMemsetAsync failed\n"); return; }
    Args a{};
    for (int i = 0; i < 20; ++i) a.in[i] = (const float*)d_in[i];
    a.out = (float*)d_out; a.ws = (unsigned char*)d_ws;
    const int nl = (PROBE_DUP >= 0) ? 2 : N_LAUNCHES;
    for (int li = 0; li < nl; ++li) {
        if (PROBE_DUP >= 0) { a.ph_lo = li ? PROBE_DUP : 0; a.ph_hi = li ? PER_PHASE : PROBE_DUP + 1; a.li = li; a.pad = (li && PROBE_DUP == 2) ? 1 : 0; }
        else { a.ph_lo = (N_LAUNCHES == PER_PHASE) ? li : 0; a.ph_hi = (N_LAUNCHES == PER_PHASE) ? li + 1 : PER_PHASE; a.li = li; }
        hipLaunchKernelGGL(nsa_lru_fwd, dim3(grid), dim3(NWAVES * 64), LDS_BYTES, stream, a);
        const hipError_t le = hipPeekAtLastError();
        if (le != hipSuccess) { fprintf(stderr, "kernel_launch: launch %d failed: %s\n", li, hipGetErrorName(le)); break; }
    }
}
```

```cpp
#include <hip/hip_runtime.h>
#include <cstdio>
#include <cstdint>

#ifndef PROBE_DUP
#define PROBE_DUP -1
#endif
#ifndef MK_N_LAUNCHES
#define MK_N_LAUNCHES 1
#endif

#define GAS __attribute__((address_space(1)))
#define LAS __attribute__((address_space(3)))
typedef unsigned short bf16;
typedef short bf16x8 __attribute__((ext_vector_type(8)));
typedef short s16x4 __attribute__((ext_vector_type(4)));
typedef float f32x4 __attribute__((ext_vector_type(4)));
typedef float f32x16 __attribute__((ext_vector_type(16)));
typedef unsigned u32x4 __attribute__((ext_vector_type(4)));
typedef unsigned u32x2 __attribute__((ext_vector_type(2)));
typedef GAS unsigned gu32;

constexpr int SEQ = 16384, DM = 1024;
constexpr int NPROJ = 5120;
constexpr float LOG2E = 1.4426950408889634f;
constexpr float RMS_EPS = 1e-6f;

__device__ __forceinline__ unsigned f2bf(float f) { unsigned u = __builtin_bit_cast(unsigned, f); return (u + 0x7fffu + ((u >> 16) & 1u)) >> 16; }
__device__ __forceinline__ unsigned pk2(float lo, float hi) { return f2bf(lo) | (f2bf(hi) << 16); }
__device__ __forceinline__ float bf2f(unsigned h) { return __builtin_bit_cast(float, h << 16); }
__device__ __forceinline__ float bflo(unsigned w) { return __builtin_bit_cast(float, w << 16); }
__device__ __forceinline__ float bfhi(unsigned w) { return __builtin_bit_cast(float, w & 0xffff0000u); }
typedef float f32x2_t __attribute__((ext_vector_type(2))); typedef __bf16 bf16x2_t __attribute__((ext_vector_type(2)));
__device__ __forceinline__ unsigned cvtpk(float lo, float hi) { f32x2_t v = {lo, hi}; bf16x2_t b = __builtin_convertvector(v, bf16x2_t); return __builtin_bit_cast(unsigned, b); }
__device__ __forceinline__ float fsigmoid(float v) { return __builtin_amdgcn_rcpf(1.0f + __builtin_amdgcn_exp2f(-v * LOG2E)); }
template <int CTRL> __device__ __forceinline__ float dpp_f(float v) { return __builtin_bit_cast(float, __builtin_amdgcn_update_dpp(0, __builtin_bit_cast(int, v), CTRL, 0xf, 0xf, true)); }
template <int CTRL> __device__ __forceinline__ int dpp_i(int v) { return __builtin_amdgcn_update_dpp(v, v, CTRL, 0xf, 0xf, false); }
__device__ __forceinline__ int lane_id() { int l = (int)__builtin_amdgcn_mbcnt_hi(~0u, __builtin_amdgcn_mbcnt_lo(~0u, 0u)); asm volatile("" : "+v"(l)); return l; }
__device__ __forceinline__ float wave_sum(float v) {
#pragma unroll
    for (int o = 1; o < 64; o <<= 1) v += __shfl_xor(v, o);
    return v;
}

namespace pg8 {
#define PG8_LAS __attribute__((address_space(3)))
typedef unsigned short bf16_t;
constexpr int BM = 256, BK = 64, HALF = 128, HTB = HALF * BK * 2, STAGE_BYTES = 8 * HTB, NXCD = 8, WGM = 8;
__host__ __device__ __forceinline__ int lds_byte(int r, int c) { const int st = (r >> 4) * 2 + (c >> 5), rr = r & 15, cc = c & 31, ob = rr * 64 + cc * 2; return st * 1024 + (ob ^ (((ob >> 9) & 1) << 5)); }
__host__ __device__ __forceinline__ void stage_rc(int b, int& R, int& C) { const int st = b / 1024, sb = b % 1024, swz = sb ^ (((sb >> 9) & 1) << 5); R = (st >> 1) * 16 + swz / 64; C = (st & 1) * 32 + (swz % 64) / 2; }
__host__ __device__ __forceinline__ int perm32(int rho) { const int n = rho >> 4, i = rho & 15; return 8 * (i >> 2) + 4 * n + (i & 3); }

struct Unit { int pm, pn, part; };
struct Gemm { const bf16_t* A; const bf16_t* Bt; const bf16_t* A2; const bf16_t* Bt2; int lda, ldb, K; };

struct StaticOrder {
    int nM, nN, nwg, G, c;
    __host__ __device__ void init(int M, int N, int G_, int c_) { nM = M / BM; nN = N / BM; nwg = nM * nN; G = G_; c = c_; }
    __host__ __device__ bool tile(long L, Unit& u) const {
        if (L >= nwg) return false;
        int wgid = (int)L; { const int q = nwg / NXCD, r = nwg % NXCD, xcd = wgid % NXCD, off = wgid / NXCD; wgid = (xcd < r ? xcd * (q + 1) : r * (q + 1) + (xcd - r) * q) + off; }
        const int nig = WGM * nN, gid = wgid / nig, fm = gid * WGM, gsz = (nM - fm) < WGM ? (nM - fm) : WGM;
        u.pm = fm + ((wgid % nig) % gsz); u.pn = (wgid % nig) / gsz; u.part = 0; return true;
    }
    __host__ __device__ bool next(int i, Unit& u) const { return tile((long)i * G + c, u); }
};
struct DualOrder : StaticOrder {
    __host__ __device__ bool next(int i, Unit& u) const { if (!tile((long)(i >> 1) * G + c, u)) return false; u.part = i & 1; return true; }
};

__device__ __forceinline__ unsigned cvt_pk_bf16(float lo, float hi) { unsigned r; asm volatile("v_cvt_pk_bf16_f32 %0, %1, %2" : "=v"(r) : "v"(lo), "v"(hi)); return r; }

struct EpiProj {
    static constexpr bool PERM = true, INIT = false;
    bf16_t *Q, *KV, *U, *BR, *GN, *GL, *MG;
    __device__ __forceinline__ void operator()(const f32x4 (&acc)[2][2][4][2], const Unit& u, int wr, int wc, int fr, int fq) const {
        const int pn = u.pn; bf16_t* base; int ldc, colt, act = 0;
        if (pn < 2) { base = Q; ldc = 512; colt = pn * 256; }
        else if (pn < 5) { base = KV; ldc = 768; colt = (pn - 2) * 256; }
        else if (pn < 7) { base = U; ldc = 512; colt = (pn - 5) * 256; }
        else if (pn < 8) { base = BR; ldc = 256; colt = 0; }
        else if (pn < 10) { base = GN; ldc = 512; colt = (pn - 8) * 256; act = 1; }
        else if (pn < 12) { base = GL; ldc = 512; colt = (pn - 10) * 256; act = 1; }
        else { base = MG; ldc = 2048; colt = (pn - 12) * 256; act = 2; }
        const int row0 = u.pm * BM + wr * 64 + fr, col0 = colt + wc * 32 + 8 * fq;
#pragma unroll
        for (int ai = 0; ai < 2; ++ai)
#pragma unroll
            for (int m = 0; m < 4; ++m) { bf16_t* rowp = base + (size_t)(row0 + ai * HALF + m * 16) * ldc + col0;
#pragma unroll
                for (int bj = 0; bj < 2; ++bj) { f32x4 v0 = acc[ai][bj][m][0], v1 = acc[ai][bj][m][1];
                    if (act) {
#pragma unroll
                        for (int e = 0; e < 4; ++e) { const float s0 = fsigmoid(v0[e]), s1 = fsigmoid(v1[e]); v0[e] = (act == 1) ? v0[e] * s0 : s0; v1[e] = (act == 1) ? v1[e] * s1 : s1; } }
                    u32x4 w; w.x = cvt_pk_bf16(v0[0], v0[1]); w.y = cvt_pk_bf16(v0[2], v0[3]); w.z = cvt_pk_bf16(v1[0], v1[1]); w.w = cvt_pk_bf16(v1[2], v1[3]);
                    *(u32x4*)(rowp + bj * HALF) = w; } }
    }
};
struct EpiMerge {
    static constexpr bool PERM = true, INIT = false;
    bf16_t* Mb; const bf16_t* MG;
    __device__ __forceinline__ void operator()(const f32x4 (&acc)[2][2][4][2], const Unit& u, int wr, int wc, int fr, int fq) const {
        const int row0 = u.pm * BM + wr * 64 + fr, col0 = u.pn * BM + wc * 32 + 8 * fq;
#pragma unroll
        for (int ai = 0; ai < 2; ++ai)
#pragma unroll
            for (int m = 0; m < 4; ++m) { const size_t r = (size_t)(row0 + ai * HALF + m * 16);
#pragma unroll
                for (int bj = 0; bj < 2; ++bj) { const f32x4 v0 = acc[ai][bj][m][0], v1 = acc[ai][bj][m][1];
                    const u32x4 gw = *(const u32x4*)(MG + r * 2048 + u.part * 1024 + col0 + bj * HALF);
                    float o[8] = {v0[0] * bflo(gw.x), v0[1] * bfhi(gw.x), v0[2] * bflo(gw.y), v0[3] * bfhi(gw.y), v1[0] * bflo(gw.z), v1[1] * bfhi(gw.z), v1[2] * bflo(gw.w), v1[3] * bfhi(gw.w)};
                    bf16_t* dst = Mb + r * 1024 + col0 + bj * HALF;
                    if (u.part) { const u32x4 pw = *(const u32x4*)dst;
                        o[0] += bflo(pw.x); o[1] += bfhi(pw.x); o[2] += bflo(pw.y); o[3] += bfhi(pw.y); o[4] += bflo(pw.z); o[5] += bfhi(pw.z); o[6] += bflo(pw.w); o[7] += bfhi(pw.w); }
                    u32x4 w; w.x = cvt_pk_bf16(o[0], o[1]); w.y = cvt_pk_bf16(o[2], o[3]); w.z = cvt_pk_bf16(o[4], o[5]); w.w = cvt_pk_bf16(o[6], o[7]);
                    *(u32x4*)dst = w; } }
    }
};
struct EpiOut {
    static constexpr bool PERM = false, INIT = true;
    const float* X; float* O;
    __device__ __forceinline__ void init(f32x4 (&acc)[2][2][4][2], const Unit& u, int wr, int wc, int fr, int fq) const {
        const int row0 = u.pm * BM + wr * 64 + fr, col0 = u.pn * BM + wc * 32 + 4 * fq;
#pragma unroll
        for (int ai = 0; ai < 2; ++ai)
#pragma unroll
            for (int m = 0; m < 4; ++m) { const size_t off = (size_t)(row0 + ai * HALF + m * 16) * 1024 + col0;
#pragma unroll
                for (int bj = 0; bj < 2; ++bj)
#pragma unroll
                    for (int n = 0; n < 2; ++n) acc[ai][bj][m][n] = *(const f32x4*)(X + off + bj * HALF + n * 16); }
    }
    __device__ __forceinline__ void operator()(const f32x4 (&acc)[2][2][4][2], const Unit& u, int wr, int wc, int fr, int fq) const {
        const int row0 = u.pm * BM + wr * 64 + fr, col0 = u.pn * BM + wc * 32 + 4 * fq;
#pragma unroll
        for (int ai = 0; ai < 2; ++ai)
#pragma unroll
            for (int m = 0; m < 4; ++m) { const size_t off = (size_t)(row0 + ai * HALF + m * 16) * 1024 + col0;
#pragma unroll
                for (int bj = 0; bj < 2; ++bj)
#pragma unroll
                    for (int n = 0; n < 2; ++n) *(f32x4*)(O + off + bj * HALF + n * 16) = acc[ai][bj][m][n]; }
    }
};

template <class Epi, class Sched, bool ALIGN_EPI>
__device__ __forceinline__ void gemm_phase(PG8_LAS unsigned char* lds, const Gemm g, const Sched& S, const Epi& E, int wid) {
    const int lane = lane_id(), tid = wid * 64 + lane, wr = wid >> 2, wc = wid & 3, fr = lane & 15, fq = lane >> 4;
    const int K = g.K, nt = K / BK;
    unsigned voffA[2], voffB[2];
#pragma unroll
    for (int i = 0; i < 2; ++i) { int R, C; stage_rc(tid * 16 + i * 8192, R, C); const int Rb = Epi::PERM ? ((R & ~31) + perm32(R & 31)) : R;
        voffA[i] = (unsigned)(R * g.lda + C) * 2u; voffB[i] = (unsigned)(Rb * g.ldb + C) * 2u; }
    const size_t kstep = (size_t)(BK * 2);
    const size_t hstepA = (size_t)HALF * g.lda * 2, hstepB = (size_t)HALF * g.ldb * 2;
    const size_t tstepA = 2 * hstepA, tstepB = 2 * hstepB;
    const unsigned ldsw = (unsigned)wid * 1024u;
    const int aoff = lds_byte(wr * 64 + fr, fq * 8), boff = lds_byte(wc * 32 + fr, fq * 8);
#define PG8_SA(b, h) (((b) * 2 + (h)) * HTB)
#define PG8_SB(b, h) ((4 + (b) * 2 + (h)) * HTB)
#define PG8_STAGE(bufoff, gbase, voff) do { _Pragma("unroll") for (int _i = 0; _i < 2; ++_i) \
        __builtin_amdgcn_global_load_lds((const unsigned*)((const char*)(gbase) + (voff)[_i]), (PG8_LAS unsigned*)(lds + (bufoff) + ldsw + _i * 8192), 16, 0, 0); } while (0)
#define PG8_LDA(dst, b, h) do { _Pragma("unroll") for (int m = 0; m < 4; ++m) _Pragma("unroll") for (int k = 0; k < 2; ++k) dst[m][k] = *(const PG8_LAS bf16x8*)(lds + PG8_SA(b, h) + aoff + m * 2048 + k * 1024); } while (0)
#define PG8_LDB(dst, b, h) do { _Pragma("unroll") for (int n = 0; n < 2; ++n) _Pragma("unroll") for (int k = 0; k < 2; ++k) dst[n][k] = *(const PG8_LAS bf16x8*)(lds + PG8_SB(b, h) + boff + n * 2048 + k * 1024); } while (0)
#define PG8_MMA(ai, bj, At, Bt) do { __builtin_amdgcn_s_setprio(1); _Pragma("unroll") for (int m = 0; m < 4; ++m) _Pragma("unroll") for (int n = 0; n < 2; ++n) _Pragma("unroll") for (int k = 0; k < 2; ++k) \
        acc[ai][bj][m][n] = __builtin_amdgcn_mfma_f32_16x16x32_bf16(Bt[n][k], At[m][k], acc[ai][bj][m][n], 0, 0, 0); __builtin_amdgcn_s_setprio(0); } while (0)
#define PG8_WAIT_V(n) asm volatile("s_waitcnt vmcnt(" #n ")" ::: "memory")
#define PG8_WAIT_L(n) asm volatile("s_waitcnt lgkmcnt(" #n ")" ::: "memory")
#define PG8_BAR __builtin_amdgcn_s_barrier()
#define PG8_SCHED __builtin_amdgcn_sched_barrier(0)
#define PG8_UA(u) ((const char*)((u).part ? g.A2 : g.A) + (size_t)(u).pm * tstepA)
#define PG8_UB(u) ((const char*)((u).part ? g.Bt2 : g.Bt) + (size_t)(u).pn * tstepB)
    Unit cur, nxt; int ui = 0;
    if (!S.next(0, cur)) return;
    f32x4 acc[2][2][4][2];
    if constexpr (Epi::INIT) E.init(acc, cur, wr, wc, fr, fq);
    else {
#pragma unroll
    for (int a = 0; a < 2; ++a)
#pragma unroll
        for (int b = 0; b < 2; ++b)
#pragma unroll
            for (int m = 0; m < 4; ++m)
#pragma unroll
                for (int n = 0; n < 2; ++n) acc[a][b][m][n] = (f32x4){0.f, 0.f, 0.f, 0.f};
    }
    bf16x8 At[4][2], B0[2][2], B1[2][2];
    const char* cA = PG8_UA(cur); const char* cB = PG8_UB(cur);
    PG8_STAGE(PG8_SB(0, 0), cB, voffB); PG8_STAGE(PG8_SB(0, 1), cB + hstepB, voffB); PG8_STAGE(PG8_SA(0, 0), cA, voffA); PG8_STAGE(PG8_SA(0, 1), cA + hstepA, voffA);
    if (wr == 1) PG8_BAR;
    PG8_WAIT_V(2); PG8_BAR;
    PG8_STAGE(PG8_SB(1, 0), cB + kstep, voffB); PG8_STAGE(PG8_SA(1, 0), cA + kstep, voffA); PG8_STAGE(PG8_SB(1, 1), cB + hstepB + kstep, voffB);
    PG8_WAIT_V(6); PG8_BAR;
    for (;;) {
        const bool has_next = S.next(ui + 1, nxt);
        const char* nA = has_next ? PG8_UA(nxt) : cA; const char* nB = has_next ? PG8_UB(nxt) : cB;
        for (int t = 0; t < nt; t += 2) {
            const bool last = (t == nt - 2);
            const char* a1 = cA + (size_t)(t + 1) * kstep;
            const char* a2 = last ? nA : cA + (size_t)(t + 2) * kstep; const char* b2 = last ? nB : cB + (size_t)(t + 2) * kstep;
            const char* a3 = a2 + kstep; const char* b3 = b2 + kstep;
            PG8_LDB(B0, 0, 0); PG8_LDB(B1, 0, 1); PG8_SCHED; PG8_LDA(At, 0, 0); PG8_STAGE(PG8_SA(1, 1), a1 + hstepA, voffA);
            PG8_WAIT_V(8); PG8_WAIT_L(0); PG8_BAR; PG8_MMA(0, 0, At, B0); PG8_MMA(0, 1, At, B1); PG8_BAR; PG8_SCHED;
            PG8_LDA(At, 0, 1); PG8_STAGE(PG8_SB(0, 0), b2, voffB); PG8_STAGE(PG8_SB(0, 1), b2 + hstepB, voffB); PG8_STAGE(PG8_SA(0, 0), a2, voffA);
            PG8_WAIT_V(8); PG8_WAIT_L(0); PG8_BAR; PG8_MMA(1, 0, At, B0); PG8_MMA(1, 1, At, B1); PG8_BAR; PG8_SCHED;
            PG8_LDB(B0, 1, 0); PG8_LDB(B1, 1, 1); PG8_SCHED; PG8_LDA(At, 1, 0); PG8_STAGE(PG8_SA(0, 1), a2 + hstepA, voffA);
            PG8_WAIT_V(8); PG8_WAIT_L(0); PG8_BAR; PG8_MMA(0, 0, At, B0); PG8_MMA(0, 1, At, B1); PG8_BAR; PG8_SCHED;
            PG8_LDA(At, 1, 1); PG8_STAGE(PG8_SB(1, 0), b3, voffB); PG8_STAGE(PG8_SB(1, 1), b3 + hstepB, voffB); PG8_STAGE(PG8_SA(1, 0), a3, voffA);
            PG8_WAIT_V(8); PG8_WAIT_L(0); PG8_BAR; PG8_MMA(1, 0, At, B0); PG8_MMA(1, 1, At, B1); PG8_BAR; PG8_SCHED;
        }
        if constexpr (ALIGN_EPI) { if (wr == 0) PG8_BAR; }
        E(acc, cur, wr, wc, fr, fq);
        if (!has_next) break;
        if constexpr (Epi::INIT) E.init(acc, nxt, wr, wc, fr, fq);
        else {
#pragma unroll
        for (int a = 0; a < 2; ++a)
#pragma unroll
            for (int b = 0; b < 2; ++b)
#pragma unroll
                for (int m = 0; m < 4; ++m)
#pragma unroll
                    for (int n = 0; n < 2; ++n) acc[a][b][m][n] = (f32x4){0.f, 0.f, 0.f, 0.f};
        }
        cur = nxt; cA = nA; cB = nB; ++ui;
        if constexpr (ALIGN_EPI) { if (wr == 1) PG8_BAR; }
    }
    PG8_WAIT_V(0);
    if constexpr (!ALIGN_EPI) { if (wr == 0) PG8_BAR; }
    PG8_BAR;
#undef PG8_SA
#undef PG8_SB
#undef PG8_STAGE
#undef PG8_LDA
#undef PG8_LDB
#undef PG8_MMA
#undef PG8_WAIT_V
#undef PG8_WAIT_L
#undef PG8_BAR
#undef PG8_SCHED
#undef PG8_UA
#undef PG8_UB
}
}

constexpr int NWAVES = 8;
constexpr int N_LAUNCHES = MK_N_LAUNCHES;
constexpr int PER_PHASE = 6;
constexpr size_t MiB = 1u << 20;
constexpr size_t WS_CTL = 0, CTL_ZERO_BYTES = 65536;
constexpr size_t WS_WIN = 1 * MiB;
constexpr size_t WS_WA = 11 * MiB;
constexpr size_t WS_WB = 12 * MiB;
constexpr size_t WS_WOUT = 13 * MiB;
constexpr size_t WS_W1T = 15 * MiB;
constexpr size_t WS_SMALL = 17 * MiB;
constexpr size_t WS_SUM = 18 * MiB;
constexpr size_t WS_KC = 19 * MiB;
constexpr size_t WS_XN = 20 * MiB;
constexpr size_t WS_Q = 52 * MiB;
constexpr size_t WS_KV = 68 * MiB;
constexpr size_t WS_MB = 52 * MiB;
constexpr size_t WS_U = 92 * MiB;
constexpr size_t WS_BR = 108 * MiB;
constexpr size_t WS_GN = 116 * MiB;
constexpr size_t WS_GL = 132 * MiB;
constexpr size_t WS_MG = 148 * MiB;
constexpr size_t WS_VT = 212 * MiB;
constexpr size_t WS_KT = 216 * MiB;
constexpr size_t WS_Q2 = 220 * MiB;
constexpr size_t WS_LB = 236 * MiB;
constexpr size_t WS_END = 252 * MiB;
constexpr size_t SM_W2T = 0;
constexpr size_t SM_LWA = 65536;
constexpr size_t SM_LWX = 131072;
constexpr size_t SM_C1 = 262144;
constexpr size_t SM_LUT = 200704;
constexpr int CW_BAR = 4096;

constexpr int RING_BYTES = 160768;
constexpr int LDSCTL_OFF = RING_BYTES, MISC_OFF = LDSCTL_OFF + 320;
constexpr int LDS_BYTES = 163840;

#define RLX_AGENT __ATOMIC_RELAXED, __HIP_MEMORY_SCOPE_AGENT
#define LDS_WAIT() asm volatile("s_waitcnt lgkmcnt(0)" ::: "memory")
#define VM_WAIT() asm volatile("s_waitcnt vmcnt(0)" ::: "memory")

#define XB_TMO      128
#define XB_XCNT(j)  (256  + 64 * (j))
#define XB_XSUB(j)  (1280 + 64 * (j))
#define XB_XGEN(j)  (2304 + 64 * (j))
#define XB_TOP      3328
#define XB_TOPGEN   3392
#define XCD_BAR_WORDS 3456
#define XB_SPIN_CAP (1u << 18)
__device__ __forceinline__ unsigned xb_ld(unsigned* p)              { return __hip_atomic_load(p, __ATOMIC_RELAXED, __HIP_MEMORY_SCOPE_AGENT); }
__device__ __forceinline__ unsigned xb_add(unsigned* p, unsigned v) { return __hip_atomic_fetch_add(p, v, __ATOMIC_RELAXED, __HIP_MEMORY_SCOPE_AGENT); }
__device__ __forceinline__ unsigned xb_xcc_id() { return (unsigned)__builtin_amdgcn_s_getreg((3 << 11) | 20) & 0xFu; }
#define XB_SPIN(cond, bar) do { unsigned _sp = 0; while (cond) { __builtin_amdgcn_s_sleep(1); \
    if ((++_sp & 255u) == 0u) { if (xb_ld(&(bar)[XB_TMO])) break; if (_sp > XB_SPIN_CAP) { atomicAdd(&(bar)[XB_TMO], 1u); break; } } } } while (0)
struct XcdBarrier { unsigned* bar; unsigned x; volatile LAS unsigned* st; };
__device__ __forceinline__ XcdBarrier xcd_barrier_post(unsigned* bar, volatile LAS unsigned* st) {
    XcdBarrier b; b.bar = bar; b.x = xb_xcc_id(); b.st = st;
    if (threadIdx.x == 0) (void)xb_add(&bar[XB_XCNT(b.x)], 1u);
    return b;
}
__device__ __forceinline__ void xcd_barrier_complete(unsigned* bar, unsigned x, unsigned& nloc, unsigned& nx) {
    const unsigned G = gridDim.x * gridDim.y * gridDim.z;
    unsigned sum, cnt, mine, sp = 0u;
    for (;;) {
        sum = 0u; cnt = 0u; mine = 0u;
#pragma unroll
        for (unsigned j = 0; j < 16; ++j) { const unsigned c = xb_ld(&bar[XB_XCNT(j)]); sum += c; cnt += (c > 0u) ? 1u : 0u; mine = (j == x) ? c : mine; }
        if (sum == G) break;
        __builtin_amdgcn_s_sleep(1);
        if ((++sp & 255u) == 0u) { if (xb_ld(&bar[XB_TMO])) break; if (sp > XB_SPIN_CAP) { atomicAdd(&bar[XB_TMO], 1u); break; } }
    }
    nloc = mine > 0u ? mine : 1u; nx = cnt > 0u ? cnt : 1u;
}
__device__ __forceinline__ void xcd_barrier(const XcdBarrier& b) {
    asm volatile("s_waitcnt vmcnt(0)" ::: "memory");
    __syncthreads();
    if (threadIdx.x == 0) {
        unsigned* bar = b.bar;
        __builtin_amdgcn_s_waitcnt(0);
        unsigned nloc = b.st[0], nx = b.st[1];
        if (nloc == 0u) { xcd_barrier_complete(bar, b.x, nloc, nx); b.st[0] = nloc; b.st[1] = nx; }
        const unsigned old = xb_add(&bar[XB_XSUB(b.x)], 1u);
        const unsigned gen = old / nloc;
        if (old + 1u == (gen + 1u) * nloc) {
            __builtin_amdgcn_fence(__ATOMIC_RELEASE, "agent");
            asm volatile("s_waitcnt vmcnt(0)" ::: "memory");
            const unsigned og = xb_add(&bar[XB_TOP], 1u);
            const unsigned tg = og / nx;
            if (og + 1u == (tg + 1u) * nx) xb_add(&bar[XB_TOPGEN], 1u);
            else XB_SPIN(xb_ld(&bar[XB_TOPGEN]) == tg, bar);
            __builtin_amdgcn_fence(__ATOMIC_ACQUIRE, "agent");
            xb_add(&bar[XB_XGEN(b.x)], 1u);
            asm volatile("s_waitcnt vmcnt(0)" ::: "memory");
        } else {
            XB_SPIN(xb_ld(&bar[XB_XGEN(b.x)]) == gen, bar);
            __builtin_amdgcn_fence(__ATOMIC_ACQUIRE, "agent");
            asm volatile("s_waitcnt vmcnt(0)" ::: "memory");
        }
    }
    __syncthreads();
}

struct Args { const float* in[20]; float* out; unsigned char* ws; int ph_lo, ph_hi, li, pad; };
struct Frame {
    LAS unsigned char* lds;
    volatile LAS unsigned* MISC;
    int wave;
    int vcu, G;
    unsigned char* ws;
#define WSP(name, T, off) __device__ __forceinline__ T* name() const { return (T*)(ws + (off)); }
    WSP(WinT, bf16, WS_WIN) WSP(WaT, bf16, WS_WA) WSP(WbT, bf16, WS_WB) WSP(WoutT, bf16, WS_WOUT) WSP(W1T, bf16, WS_W1T)
    WSP(W2T, bf16, WS_SMALL + SM_W2T) WSP(LWA, bf16, WS_SMALL + SM_LWA) WSP(LWX, bf16, WS_SMALL + SM_LWX)
    WSP(C1, float, WS_SMALL + SM_C1) WSP(LUT, float, WS_SMALL + SM_LUT) WSP(SUMA, float, WS_SUM) WSP(SUMB, float, WS_SUM + 524288)
    WSP(KC, bf16, WS_KC) WSP(VC, bf16, WS_KC + 524288) WSP(XN, bf16, WS_XN) WSP(Q, bf16, WS_Q) WSP(KV, bf16, WS_KV) WSP(MB, bf16, WS_MB)
    WSP(VT, bf16, WS_VT) WSP(KT, bf16, WS_KT) WSP(Q2, bf16, WS_Q2) WSP(LB, bf16, WS_LB) WSP(U, bf16, WS_U) WSP(BR, bf16, WS_BR) WSP(GN, bf16, WS_GN) WSP(GL, bf16, WS_GL) WSP(MG, bf16, WS_MG)
#undef WSP
};

__device__ __forceinline__ int t5_bucket(int n) {
    if (n < 16) return n;
    const int thr[15] = {19, 21, 24, 27, 31, 35, 40, 46, 52, 59, 67, 77, 87, 99, 113};
    int b = 16;
#pragma unroll
    for (int i = 0; i < 15; ++i) b += (n >= thr[i]) ? 1 : 0;
    return b;
}

__device__ __forceinline__ void p0_tr_item(const float* W, int ldw, int k0, int srccol0, int nvalid, bf16* WT, int ldt, int dstrow0, LAS float* scr, int lane) {
    const int c = lane & 31;
    float tv[32];
#pragma unroll
    for (int i = 0; i < 32; ++i) { const int kk = 2 * i + (lane >> 5); tv[i] = (c < nvalid) ? W[(size_t)(k0 + kk) * ldw + srccol0 + c] : 0.f; }
#pragma unroll
    for (int i = 0; i < 32; ++i) { const int kk = 2 * i + (lane >> 5); scr[kk * 33 + c] = tv[i]; }
    LDS_WAIT(); asm volatile("" ::: "memory");
    const int cc = lane & 7;
#pragma unroll
    for (int j = 0; j < 4; ++j) { const int n = (lane >> 3) + 8 * j; const LAS float* s = scr + (8 * cc) * 33 + n;
        u32x4 o; o.x = pk2(s[0 * 33], s[1 * 33]); o.y = pk2(s[2 * 33], s[3 * 33]); o.z = pk2(s[4 * 33], s[5 * 33]); o.w = pk2(s[6 * 33], s[7 * 33]);
        *(u32x4*)(WT + (size_t)(dstrow0 + n) * ldt + k0 + 8 * cc) = o; }
    LDS_WAIT(); asm volatile("" ::: "memory");
}
__device__ __forceinline__ void win_src(int n0, int& src, int& nvalid) {
    nvalid = 32;
    if (n0 < 1280) src = n0;
    else if (n0 < 1792) src = 1816 + (n0 - 1280);
    else if (n0 < 2048) { src = 1792 + (n0 - 1792); nvalid = (n0 == 1792) ? 24 : 0; if (n0 != 1792) src = 0; }
    else if (n0 < 2560) src = 1280 + (n0 - 2048);
    else if (n0 < 3072) src = 2328 + (n0 - 2560);
    else src = 2840 + (n0 - 3072);
}
__device__ __forceinline__ void p0_prologue(const Frame& F, const Args& A) {
    LAS float* scr = (LAS float*)(F.lds + F.wave * 16384);
    const int gw = F.vcu * NWAVES + F.wave, NGW = F.G * NWAVES, lane = lane_id();
    constexpr int I_WIN = 16 * 160, I_WA = 8 * 32, I_WO = 16 * 32, I_W1 = 32 * 8, I_W2 = 4 * 2, I_LR = 2;
    constexpr int NIT = I_WIN + 2 * I_WA + I_WO + 2 * I_W1 + 2 * I_W2 + 16 * I_LR + 256 + 1;
    for (int it = gw; it < NIT; it += NGW) {
        int r = it;
        if (r < I_WIN) { const int kb = r / 160, nb = r % 160; int src, nv; win_src(32 * nb, src, nv); p0_tr_item(A.in[2], 4888, 64 * kb, src, nv, F.WinT(), 1024, 32 * nb, scr, lane); continue; } r -= I_WIN;
        if (r < I_WA) { p0_tr_item(A.in[17], 1024, 64 * (r / 32), 32 * (r % 32), 32, F.WaT(), 512, 32 * (r % 32), scr, lane); continue; } r -= I_WA;
        if (r < I_WA) { p0_tr_item(A.in[18], 1024, 64 * (r / 32), 32 * (r % 32), 32, F.WbT(), 512, 32 * (r % 32), scr, lane); continue; } r -= I_WA;
        if (r < I_WO) { p0_tr_item(A.in[19], 1024, 64 * (r / 32), 32 * (r % 32), 32, F.WoutT(), 1024, 32 * (r % 32), scr, lane); continue; } r -= I_WO;
        if (r < 2 * I_W1) { const int kv = r / I_W1, q = r % I_W1; p0_tr_item(A.in[6] + (size_t)kv * 2048 * 256, 256, 64 * (q / 8), 32 * (q % 8), 32, F.W1T() + (size_t)kv * 256 * 2048, 2048, 32 * (q % 8), scr, lane); continue; } r -= 2 * I_W1;
        if (r < 2 * I_W2) { const int kv = r / I_W2, q = r % I_W2; p0_tr_item(A.in[8] + (size_t)kv * 256 * 64, 64, 64 * (q / 2), 32 * (q % 2), 32, F.W2T() + (size_t)kv * 64 * 256, 256, 32 * (q % 2), scr, lane); continue; } r -= 2 * I_W2;
        if (r < 16 * I_LR) { const int mtx = r / 2, nb = r % 2; const float* src = (mtx < 8 ? A.in[12] : A.in[14]) + (size_t)(mtx & 7) * 4096; bf16* dst = (mtx < 8 ? F.LWA() : F.LWX()) + (size_t)(mtx & 7) * 4096;
            p0_tr_item(src, 64, 0, 32 * nb, 32, dst, 64, 32 * nb, scr, lane); continue; } r -= 16 * I_LR;
        if (r < 256) {
            const int kc = r >> 3, kv = (r >> 2) & 1, n = (r & 3) * 64 + lane; const float* w1 = A.in[6] + (size_t)kv * 2048 * 256 + (size_t)(64 * kc) * 256 + n; const float* pe = A.in[5] + kv * 2048 + 64 * kc;
            float s0 = 0.f, s1 = 0.f, s2 = 0.f, s3 = 0.f;
#pragma unroll 4
            for (int k = 0; k < 64; k += 4) { s0 += pe[k] * w1[(size_t)k * 256]; s1 += pe[k + 1] * w1[(size_t)(k + 1) * 256]; s2 += pe[k + 2] * w1[(size_t)(k + 2) * 256]; s3 += pe[k + 3] * w1[(size_t)(k + 3) * 256]; }
            F.C1()[(kc * 2 + kv) * 256 + n] = (s0 + s1) + (s2 + s3); continue; } r -= 256;
        {
            for (int e = lane; e < 1024; e += 64) { const int hd = e >> 7, n = e & 127; F.LUT()[e] = A.in[9][t5_bucket(n) * 8 + hd] * LOG2E; }
        }
    }
    const float* gain = A.in[1];
    {
        f32x4 v[4], vn[4];
        if (gw < SEQ) { const f32x4* xr = (const f32x4*)(A.in[0] + (size_t)gw * DM) + lane;
#pragma unroll
            for (int j = 0; j < 4; ++j) v[j] = xr[64 * j]; }
        for (int m = gw; m < SEQ; m += NGW) {
            if (m + NGW < SEQ) { const f32x4* xr = (const f32x4*)(A.in[0] + (size_t)(m + NGW) * DM) + lane;
#pragma unroll
                for (int j = 0; j < 4; ++j) vn[j] = xr[64 * j]; }
            float s = 0.f;
#pragma unroll
            for (int j = 0; j < 4; ++j) s += (v[j].x * v[j].x + v[j].y * v[j].y) + (v[j].z * v[j].z + v[j].w * v[j].w);
            const float rs = 1.0f / sqrtf(wave_sum(s) * (1.f / DM) + RMS_EPS);
            unsigned long long* o8 = (unsigned long long*)(F.XN() + (size_t)m * DM) + lane;
#pragma unroll
            for (int j = 0; j < 4; ++j) { const f32x4 gv = ((const f32x4*)gain)[lane + 64 * j];
                o8[64 * j] = (unsigned long long)pk2(v[j].x * rs * gv.x, v[j].y * rs * gv.y) | ((unsigned long long)pk2(v[j].z * rs * gv.z, v[j].w * rs * gv.w) << 32); }
#pragma unroll
            for (int j = 0; j < 4; ++j) v[j] = vn[j];
        }
    }
}

template <bool FINAL>
__device__ __forceinline__ void lru_tile(const Frame& F, const Args& A, int tt) {
    const int lane = lane_id();
    const int w = F.wave, fr = lane & 15, fq = lane >> 4, ch0 = 64 * w, t0 = 64 * tt;
    LAS float* UC = (LAS float*)(F.lds + w * 16384);
#define UC_IDX(tok, ch) ((tok) * 64 + ((((ch) >> 2) ^ ((tok) & 15)) << 2) + ((ch) & 3))
    float Hc = 0.f;
    if (FINAL) {
        const float* sa = F.SUMA() + ch0 + lane; const float* sb = F.SUMB() + ch0 + lane;
        int i = 0;
        for (; i + 64 <= tt; i += 64) { float ta[64], tb[64];
#pragma unroll
            for (int k = 0; k < 64; ++k) { ta[k] = sa[(size_t)(i + k) * 512]; tb[k] = sb[(size_t)(i + k) * 512]; }
#pragma unroll
            for (int k = 0; k < 64; ++k) Hc = ta[k] * Hc + tb[k]; }
        for (; i + 16 <= tt; i += 16) { float ta[16], tb[16];
#pragma unroll
            for (int k = 0; k < 16; ++k) { ta[k] = sa[(size_t)(i + k) * 512]; tb[k] = sb[(size_t)(i + k) * 512]; }
#pragma unroll
            for (int k = 0; k < 16; ++k) Hc = ta[k] * Hc + tb[k]; }
        for (; i < tt; ++i) Hc = sa[(size_t)i * 512] * Hc + sb[(size_t)i * 512];
        asm volatile("" : "+v"(Hc));
    }
    {
        const int ch = ch0 + lane; const float* cw = A.in[10]; const float cb = A.in[11][ch];
        const float w0 = cw[ch], w1 = cw[512 + ch], w2 = cw[1024 + ch], w3 = cw[1536 + ch];
        const bf16* up = F.U() + (size_t)t0 * 512 + ch;
        float u0 = 0.f, u1 = 0.f, u2 = 0.f;
        if (tt > 0) { u0 = bf2f(up[-3 * 512]); u1 = bf2f(up[-2 * 512]); u2 = bf2f(up[-1 * 512]); }
        unsigned short ur[64];
#pragma unroll
        for (int tok = 0; tok < 64; ++tok) ur[tok] = up[(size_t)tok * 512];
#pragma unroll
        for (int tok = 0; tok < 64; ++tok) { const float u3 = bf2f(ur[tok]);
            UC[UC_IDX(tok, lane)] = cb + ((u0 * w0 + u1 * w1) + (u2 * w2 + u3 * w3)); u0 = u1; u1 = u2; u2 = u3; }
    }
    bf16x8 Ba[4][2], Bx[4][2];
#pragma unroll
    for (int nt = 0; nt < 4; ++nt)
#pragma unroll
        for (int ks = 0; ks < 2; ++ks) { const size_t o = (size_t)w * 4096 + (16 * nt + fr) * 64 + 32 * ks + 8 * fq; Ba[nt][ks] = *(const bf16x8*)(F.LWA() + o); Bx[nt][ks] = *(const bf16x8*)(F.LWX() + o); }
    float ba[4], bx[4], sp8[4], hin[4], acum[4];
#pragma unroll
    for (int nt = 0; nt < 4; ++nt) { const int ch = ch0 + 16 * nt + fr; ba[nt] = A.in[13][ch]; bx[nt] = A.in[15][ch];
        sp8[nt] = 8.0f * log1pf(expf(-A.in[16][ch])); hin[nt] = 0.f; acum[nt] = 1.f; }
    if (FINAL) {
#pragma unroll
        for (int nt = 0; nt < 4; ++nt) hin[nt] = __shfl(Hc, 16 * nt + fr);
    }
    LDS_WAIT();
    unsigned short glv[16], gln[16];
    if (FINAL) {
#pragma unroll
        for (int nt = 0; nt < 4; ++nt)
#pragma unroll
            for (int rg = 0; rg < 4; ++rg) glv[nt * 4 + rg] = F.GL()[(size_t)(t0 + 4 * fq + rg) * 512 + ch0 + 16 * nt + fr];
    }
#pragma unroll 1
    for (int mt = 0; mt < 4; ++mt) {
        if (FINAL && mt < 3) {
#pragma unroll
            for (int nt = 0; nt < 4; ++nt)
#pragma unroll
                for (int rg = 0; rg < 4; ++rg) gln[nt * 4 + rg] = F.GL()[(size_t)(t0 + 16 * (mt + 1) + 4 * fq + rg) * 512 + ch0 + 16 * nt + fr];
        }
        bf16x8 Af[2];
#pragma unroll
        for (int ks = 0; ks < 2; ++ks) { const int tok = 16 * mt + fr, c0 = 8 * ks + 2 * fq;
            const f32x4 x0 = *(const LAS f32x4*)(UC + tok * 64 + ((c0 ^ (tok & 15)) << 2)), x1 = *(const LAS f32x4*)(UC + tok * 64 + (((c0 + 1) ^ (tok & 15)) << 2));
            u32x4 pw; pw.x = cvtpk(x0[0], x0[1]); pw.y = cvtpk(x0[2], x0[3]); pw.z = cvtpk(x1[0], x1[1]); pw.w = cvtpk(x1[2], x1[3]); Af[ks] = __builtin_bit_cast(bf16x8, pw); }
        f32x4 cr[4], ci[4];
#pragma unroll
        for (int nt = 0; nt < 4; ++nt) { cr[nt] = (f32x4){0.f, 0.f, 0.f, 0.f}; ci[nt] = (f32x4){0.f, 0.f, 0.f, 0.f};
#pragma unroll
            for (int ks = 0; ks < 2; ++ks) { cr[nt] = __builtin_amdgcn_mfma_f32_16x16x32_bf16(Af[ks], Ba[nt][ks], cr[nt], 0, 0, 0); ci[nt] = __builtin_amdgcn_mfma_f32_16x16x32_bf16(Af[ks], Bx[nt][ks], ci[nt], 0, 0, 0); } }
#pragma unroll
        for (int nt = 0; nt < 4; ++nt) {
            float P[4], Hh[4];
#pragma unroll
            for (int rg = 0; rg < 4; ++rg) { const int tok = 16 * mt + 4 * fq + rg, e = 16 * nt + fr;
                const float ucv = UC[UC_IDX(tok, e)];
                const float r = fsigmoid(cr[nt][rg] + ba[nt]), ig = fsigmoid(ci[nt][rg] + bx[nt]);
                const float la = -r * sp8[nt]; const float a = __builtin_amdgcn_exp2f(la * LOG2E);
                const float x2 = 2.0f * la;
                const float ser = -x2 * (1.0f + x2 * (0.5f + x2 * (0.16666667f + x2 * (0.041666668f + x2 * 0.008333334f))));
                const float om = (x2 > -0.25f) ? ser : 1.0f - a * a;
                const float b = __builtin_amdgcn_sqrtf(om) * (ig * ucv);
                if (!FINAL) {
                    const float so = -la * (1.0f + la * (0.5f + la * (0.16666667f + la * (0.041666668f + la * 0.008333334f))));
                    const float oma = (la > -0.25f) ? so : 1.0f - a; const size_t tg = (size_t)(t0 + tok); const int chg = ch0 + e;
                    F.XN()[tg * 1024 + 512 + chg] = (bf16)f2bf(oma); F.LB()[tg * 512 + chg] = (bf16)f2bf(b); }
                if (rg == 0) { P[0] = a; Hh[0] = b; } else { P[rg] = P[rg - 1] * a; Hh[rg] = a * Hh[rg - 1] + b; } }
            float At = P[3], Bt = Hh[3];
            { const float Ap = __shfl_up(At, 16), Bp = __shfl_up(Bt, 16); if (fq >= 1) { Bt = At * Bp + Bt; At = Ap * At; } }
            { const float Ap = __shfl_up(At, 32), Bp = __shfl_up(Bt, 32); if (fq >= 2) { Bt = At * Bp + Bt; At = Ap * At; } }
            float Aex = __shfl_up(At, 16), Bex = __shfl_up(Bt, 16); if (fq == 0) { Aex = 1.f; Bex = 0.f; }
            const float hg = Aex * hin[nt] + Bex;
            float hv[4];
#pragma unroll
            for (int rg = 0; rg < 4; ++rg) hv[rg] = P[rg] * hg + Hh[rg];
            hin[nt] = __shfl(hv[3], 48 + fr);
            if (!FINAL) acum[nt] *= __shfl(At, 48 + fr);
            if (FINAL) {
#pragma unroll
                for (int rg = 0; rg < 4; ++rg) { const size_t t = (size_t)(t0 + 16 * mt + 4 * fq + rg); const int ch = ch0 + 16 * nt + fr;
                    F.XN()[t * 1024 + 512 + ch] = (bf16)f2bf(hv[rg] * bf2f(glv[nt * 4 + rg])); }
            }
        }
        if (FINAL) {
#pragma unroll
            for (int x = 0; x < 16; ++x) glv[x] = gln[x];
        }
    }
    if (!FINAL && fq == 0) {
#pragma unroll
        for (int nt = 0; nt < 4; ++nt) { F.SUMA()[(size_t)tt * 512 + ch0 + 16 * nt + fr] = acum[nt]; F.SUMB()[(size_t)tt * 512 + ch0 + 16 * nt + fr] = hin[nt]; }
    }
    LDS_WAIT();
#undef UC_IDX
}

__device__ __forceinline__ void lru_apply(const Frame& F, int tt) {
    const int lane = lane_id(), ch = 64 * F.wave + lane, t0 = 64 * tt;
    float H = 0.f;
    { const float* sa = F.SUMA() + ch; const float* sb = F.SUMB() + ch; int i = 0;
        for (; i + 64 <= tt; i += 64) { float ta[64], tb[64];
#pragma unroll
            for (int k = 0; k < 64; ++k) { ta[k] = sa[(size_t)(i + k) * 512]; tb[k] = sb[(size_t)(i + k) * 512]; }
#pragma unroll
            for (int k = 0; k < 64; ++k) H = ta[k] * H + tb[k]; }
        for (; i + 16 <= tt; i += 16) { float ta[16], tb[16];
#pragma unroll
            for (int k = 0; k < 16; ++k) { ta[k] = sa[(size_t)(i + k) * 512]; tb[k] = sb[(size_t)(i + k) * 512]; }
#pragma unroll
            for (int k = 0; k < 16; ++k) H = ta[k] * H + tb[k]; }
        for (; i < tt; ++i) H = sa[(size_t)i * 512] * H + sb[(size_t)i * 512]; }
    bf16* px = F.XN() + (size_t)t0 * 1024 + 512 + ch; const bf16* pb = F.LB() + (size_t)t0 * 512 + ch; const bf16* pg = F.GL() + (size_t)t0 * 512 + ch;
#pragma unroll 1
    for (int c = 0; c < 2; ++c) { unsigned short av[32], bv[32], gv[32];
#pragma unroll
        for (int k = 0; k < 32; ++k) { const size_t tk = (size_t)(32 * c + k); av[k] = px[tk * 1024]; bv[k] = pb[tk * 512]; gv[k] = pg[tk * 512]; }
#pragma unroll
        for (int k = 0; k < 32; ++k) { H = (1.0f - bf2f(av[k])) * H + bf2f(bv[k]); px[(size_t)(32 * c + k) * 1024] = (bf16)f2bf(H * bf2f(gv[k])); } }
}

__device__ __forceinline__ void qk_norm_tile(const Frame& F, const Args& A, int tt) {
    const int lane = lane_id(), sub = lane & 7;
#pragma unroll 4
    for (int it = 0; it < 12; ++it) {
        const int idx = it * 64 + F.wave * 8 + (lane >> 3), tok = idx / 12, hr = idx % 12; const size_t t = (size_t)(64 * tt + tok);
        bf16* p; bf16* dst; const float* gain; float sc = 1.f;
        if (hr < 8) { p = F.Q() + t * 512 + hr * 64; dst = F.Q2() + t * 512 + (hr >> 2) * 256 + (sub >> 1) * 64 + (hr & 3) * 16 + (sub & 1) * 8 - sub * 8; gain = A.in[3]; sc = 0.125f * LOG2E; }
        else if (hr < 10) { p = F.KV() + t * 768 + 256 + (hr - 8) * 64; dst = p; gain = A.in[4] + 64; }
        else { p = F.KV() + t * 768 + 512 + (hr - 10) * 64; dst = p; gain = A.in[4] + 128; }
        const u32x4 w = *(const u32x4*)(p + sub * 8);
        float x[8] = {bflo(w.x), bfhi(w.x), bflo(w.y), bfhi(w.y), bflo(w.z), bfhi(w.z), bflo(w.w), bfhi(w.w)};
        float ss = 0.f;
#pragma unroll
        for (int j = 0; j < 8; ++j) ss += x[j] * x[j];
        ss += __shfl_xor(ss, 1); ss += __shfl_xor(ss, 2); ss += __shfl_xor(ss, 4);
        const float rs = sc / sqrtf(ss * (1.f / 64.f) + RMS_EPS);
        const f32x4 g0 = *(const f32x4*)(gain + sub * 8), g1 = *(const f32x4*)(gain + sub * 8 + 4);
        u32x4 o; o.x = pk2(x[0] * rs * g0.x, x[1] * rs * g0.y); o.y = pk2(x[2] * rs * g0.z, x[3] * rs * g0.w); o.z = pk2(x[4] * rs * g1.x, x[5] * rs * g1.y); o.w = pk2(x[6] * rs * g1.z, x[7] * rs * g1.w);
        *(u32x4*)(dst + sub * 8) = o;
        if (hr >= 8 && hr < 10) {
            int w0 = __builtin_amdgcn_cvt_pk_fp8_f32(x[0] * rs * g0.x, x[1] * rs * g0.y, 0, false); w0 = __builtin_amdgcn_cvt_pk_fp8_f32(x[2] * rs * g0.z, x[3] * rs * g0.w, w0, true);
            int w1 = __builtin_amdgcn_cvt_pk_fp8_f32(x[4] * rs * g1.x, x[5] * rs * g1.y, 0, false); w1 = __builtin_amdgcn_cvt_pk_fp8_f32(x[6] * rs * g1.z, x[7] * rs * g1.w, w1, true);
            u32x2* kt8 = (u32x2*)F.KT() + (size_t)((hr - 8) * 256 + tt) * 512 + ((((sub >> 2) * 4 + (tok >> 4)) * 4 + (sub & 3)) * 16 + (tok & 15));
            *kt8 = (u32x2){(unsigned)w0, (unsigned)w1}; }
    }
}

__device__ __forceinline__ void vt_tile(const Frame& F, int J) {
    const int tid = F.wave * 64 + lane_id(), d = tid & 63, ks = (tid >> 6) & 1, gp = tid >> 7;
#pragma unroll
    for (int g = 0; g < 2; ++g) {
        const bf16* vp = F.KV() + (size_t)(64 * J) * 768 + 384 + 64 * g + d;
        unsigned short e[8];
#pragma unroll
        for (int j = 0; j < 8; ++j) { const int key = 32 * ks + 4 * gp + (j & 3) + 16 * (j >> 2); e[j] = vp[(size_t)key * 768]; }
        u32x4 w; w.x = e[0] | ((unsigned)e[1] << 16); w.y = e[2] | ((unsigned)e[3] << 16); w.z = e[4] | ((unsigned)e[5] << 16); w.w = e[6] | ((unsigned)e[7] << 16);
        *(u32x4*)(F.VT() + (size_t)(g * 256 + J) * 4096 + ((((d >> 4) * 2 + ks) * 16 + (d & 15)) * 32) + 8 * gp) = w;
    }
}

__device__ __forceinline__ void compress_item(const Frame& F, const Args& A, int kv, int g, int ct) {
    const int lane = lane_id(), w = F.wave, tid = w * 64 + lane, fr = lane & 15, fq = lane >> 4, c0 = 16 * ct, tb = 16 * c0;
    LAS unsigned char* T = F.lds;
    LAS bf16* HID = (LAS bf16*)(F.lds + 34816);
    LAS float* OUTF = (LAS float*)(F.lds + 34816 + 8448);
    LAS float* C1L = (LAS float*)(F.lds + 34816 + 8448 + 4096);
    {
        u32x4 tv[5];
#pragma unroll
        for (int i = 0; i < 5; ++i) { const int idx = tid + 512 * i, tok = idx >> 3, chn = idx & 7, gt = tb + tok; tv[i] = (u32x4){0u, 0u, 0u, 0u};
            if (idx < 272 * 8 && gt < SEQ) tv[i] = *(const u32x4*)(F.KV() + (size_t)gt * 768 + kv * 128 + g * 64 + chn * 8); }
        { const int n = tid & 255, hf = tid >> 8; float pc[16];
#pragma unroll
            for (int k = 0; k < 16; ++k) pc[k] = F.C1()[((hf * 16 + k) * 2 + kv) * 256 + n];
            float s = hf ? 0.f : A.in[7][kv * 256 + n];
#pragma unroll
            for (int k = 0; k < 16; ++k) s += pc[k];
            C1L[hf * 256 + n] = s; }
#pragma unroll
        for (int i = 0; i < 5; ++i) { const int idx = tid + 512 * i, tok = idx >> 3, chn = idx & 7;
            if (idx < 272 * 8) *(LAS u32x4*)(T + tok * 128 + ((chn ^ ((tok >> 4) & 7)) << 4)) = tv[i]; }
    }
    LDS_WAIT(); __syncthreads();
    f32x4 acc[2] = {(f32x4){0.f, 0.f, 0.f, 0.f}, (f32x4){0.f, 0.f, 0.f, 0.f}};
    const bf16* w1t = F.W1T() + (size_t)kv * 256 * 2048 + (size_t)(32 * w + fr) * 2048 + 8 * fq;
#pragma unroll 32
    for (int ks = 0; ks < 64; ++ks) {
        const int tok = 16 * fr + (ks >> 1), chn = 4 * (ks & 1) + fq;
        const bf16x8 a = *(const LAS bf16x8*)(T + tok * 128 + ((chn ^ ((tok >> 4) & 7)) << 4));
        const bf16x8 b0 = *(const bf16x8*)(w1t + 32 * ks), b1 = *(const bf16x8*)(w1t + (size_t)16 * 2048 + 32 * ks);
        acc[0] = __builtin_amdgcn_mfma_f32_16x16x32_bf16(a, b0, acc[0], 0, 0, 0);
        acc[1] = __builtin_amdgcn_mfma_f32_16x16x32_bf16(a, b1, acc[1], 0, 0, 0);
    }
#pragma unroll
    for (int nt = 0; nt < 2; ++nt) { const int n = 32 * w + 16 * nt + fr; const float c1 = C1L[n] + C1L[256 + n];
#pragma unroll
        for (int rg = 0; rg < 4; ++rg) { const float v = acc[nt][rg] + c1; HID[(4 * fq + rg) * 264 + n] = (bf16)f2bf(v * fsigmoid(v)); } }
    LDS_WAIT(); __syncthreads();
    if (w < 4) {
        f32x4 o = (f32x4){0.f, 0.f, 0.f, 0.f};
        const bf16* w2t = F.W2T() + (size_t)kv * 64 * 256 + (size_t)(16 * w + fr) * 256 + 8 * fq;
#pragma unroll
        for (int ks = 0; ks < 8; ++ks) { const bf16x8 a = *(const LAS bf16x8*)(HID + fr * 264 + 32 * ks + 8 * fq); const bf16x8 b = *(const bf16x8*)(w2t + 32 * ks);
            o = __builtin_amdgcn_mfma_f32_16x16x32_bf16(a, b, o, 0, 0, 0); }
#pragma unroll
        for (int rg = 0; rg < 4; ++rg) OUTF[(4 * fq + rg) * 64 + 16 * w + fr] = o[rg];
    }
    LDS_WAIT(); __syncthreads();
    {
        const int row = tid >> 5, e = 2 * (tid & 31), c = c0 + row;
        float v0 = OUTF[row * 64 + e], v1 = OUTF[row * 64 + e + 1];
        if (kv == 0) { float ss = v0 * v0 + v1 * v1;
#pragma unroll
            for (int o = 1; o < 32; o <<= 1) ss += __shfl_xor(ss, o);
            const float rs = 1.0f / sqrtf(ss * (1.f / 64.f) + RMS_EPS); v0 *= rs * A.in[4][e]; v1 *= rs * A.in[4][e + 1]; }
        if (c >= 1023) { v0 = 0.f; v1 = 0.f; }
        bf16* dst = (kv == 0 ? F.KC() : F.VC()) + ((size_t)g * 1024 + c) * 64 + e;
        *(unsigned*)dst = pk2(v0, v1);
    }
    LDS_WAIT(); __syncthreads();
}

namespace att {
constexpr int SLOTB = 8192, NSLOT = 3;
constexpr int L_K = 0, L_V = NSLOT * SLOTB, L_SC = 2 * NSLOT * SLOTB, L_OUT = L_SC + 65536, L_LUT = L_OUT + 32768, L_WSF = L_LUT + 2048, L_BM = L_WSF + 2048, L_REF = L_BM + 2048, L_LACC = L_REF + 1024, L_TL = L_LACC + 1024  , L_END = L_TL + 5120;
static_assert(L_END <= RING_BYTES, "attention LDS map");
constexpr int L_EX = 0  ,
              L_HDR = 69632  , L_LEX = 70144  , L_NT = 71168  ;
static_assert(L_NT + 32 <= L_SC + 65536, "part B exchange area");
constexpr float CLAMP = 100.0f;
constexpr float THR = 8.0f;
#define SBAR() __builtin_amdgcn_sched_barrier(0)
__device__ __forceinline__ int crow(int r, int hi) { return (r & 3) + 8 * (r >> 2) + 4 * hi; }
__device__ __forceinline__ void glds16(const void* gsrc, unsigned lds_dst) { unsigned keep;
    asm volatile("s_mov_b32 %0, m0\n\ts_mov_b32 m0, %2\n\ts_nop 0\n\tglobal_load_lds_dwordx4 %1, off\n\ts_mov_b32 m0, %0" : "=&s"(keep) : "v"(gsrc), "s"(lds_dst) : "memory"); }
__device__ __forceinline__ void qkt(f32x16& p0, f32x16& p1, const LAS unsigned char* Kslot, const bf16x8* qr, int r32, int hi) {
    const LAS unsigned char* kb = Kslot + hi * 1024 + r32 * 16;
    const f32x16 z = {0.f, 0.f, 0.f, 0.f, 0.f, 0.f, 0.f, 0.f, 0.f, 0.f, 0.f, 0.f, 0.f, 0.f, 0.f, 0.f};
#pragma unroll
    for (int d0 = 0; d0 < 4; ++d0) {
        const bf16x8 b0 = *(const LAS bf16x8*)(kb + d0 * 2048);
        const bf16x8 b1 = *(const LAS bf16x8*)(kb + d0 * 2048 + 512);
        if (d0 == 0) { p0 = __builtin_amdgcn_mfma_f32_32x32x16_bf16(b0, qr[0], z, 0, 0, 0); p1 = __builtin_amdgcn_mfma_f32_32x32x16_bf16(b1, qr[0], z, 0, 0, 0); }
        else { p0 = __builtin_amdgcn_mfma_f32_32x32x16_bf16(b0, qr[d0], p0, 0, 0, 0); p1 = __builtin_amdgcn_mfma_f32_32x32x16_bf16(b1, qr[d0], p1, 0, 0, 0); } }
}
__device__ __forceinline__ void pv(f32x16* o, int vb, bf16x8 pa0, bf16x8 pa1, bf16x8 pa2, bf16x8 pa3) {
    s16x4 lo[8], hi[8];
#pragma unroll
    for (int x = 0; x < 8; ++x) {
        asm volatile("ds_read_b64_tr_b16 %0,%1 offset:%c2" : "=&v"(lo[x]) : "v"(vb), "i"((x >> 2) * 4096 + (x & 3) * 1024) : "memory");
        asm volatile("ds_read_b64_tr_b16 %0,%1 offset:%c2" : "=&v"(hi[x]) : "v"(vb), "i"((x >> 2) * 4096 + (x & 3) * 1024 + 512) : "memory"); }
    asm volatile("s_waitcnt lgkmcnt(0)" ::: "memory"); SBAR();
#define PK(k) (bf16x8){lo[k][0], lo[k][1], lo[k][2], lo[k][3], hi[k][0], hi[k][1], hi[k][2], hi[k][3]}
    o[0] = __builtin_amdgcn_mfma_f32_32x32x16_bf16(pa0, PK(0), o[0], 0, 0, 0); o[1] = __builtin_amdgcn_mfma_f32_32x32x16_bf16(pa0, PK(4), o[1], 0, 0, 0);
    o[0] = __builtin_amdgcn_mfma_f32_32x32x16_bf16(pa1, PK(1), o[0], 0, 0, 0); o[1] = __builtin_amdgcn_mfma_f32_32x32x16_bf16(pa1, PK(5), o[1], 0, 0, 0);
    o[0] = __builtin_amdgcn_mfma_f32_32x32x16_bf16(pa2, PK(2), o[0], 0, 0, 0); o[1] = __builtin_amdgcn_mfma_f32_32x32x16_bf16(pa2, PK(6), o[1], 0, 0, 0);
    o[0] = __builtin_amdgcn_mfma_f32_32x32x16_bf16(pa3, PK(3), o[0], 0, 0, 0); o[1] = __builtin_amdgcn_mfma_f32_32x32x16_bf16(pa3, PK(7), o[1], 0, 0, 0);
#undef PK
}
__device__ __forceinline__ float rowmax(const f32x16& p0, const f32x16& p1) {
    float a = fmaxf(fmaxf(p0[0], p0[1]), p1[0]), b = fmaxf(fmaxf(p0[2], p0[3]), p1[1]); a = fmaxf(fmaxf(a, p1[2]), p1[3]);
#pragma unroll
    for (int r = 4; r < 16; r += 4) { a = fmaxf(fmaxf(a, p0[r]), p0[r + 1]); b = fmaxf(fmaxf(b, p0[r + 2]), p0[r + 3]); a = fmaxf(fmaxf(a, p1[r]), p1[r + 1]); b = fmaxf(fmaxf(b, p1[r + 2]), p1[r + 3]); }
    const float m = fmaxf(a, b);
    auto rr = __builtin_amdgcn_permlane32_swap(__float_as_uint(m), __float_as_uint(m), false, false);
    return fmaxf(__uint_as_float(rr[0]), __uint_as_float(rr[1]));
}
__device__ __forceinline__ float halfsum(float v) { auto rr = __builtin_amdgcn_permlane32_swap(__float_as_uint(v), __float_as_uint(v), false, false); return __uint_as_float(rr[0]) + __uint_as_float(rr[1]); }
template <int STEP, unsigned LIMIT>
__device__ __forceinline__ void near_apply(f32x16& p0, f32x16& p1, int dbase, const LAS float* lut) {
    float b0[16], b1[16];
#pragma unroll
    for (int r = 0; r < 16; ++r) { const int koff = (r & 3) + 8 * (r >> 2); const int d0 = dbase - STEP * koff, d1 = d0 - STEP * 32;
        b0[r] = lut[4 * min(max(d0, 0), 127)]; b1[r] = lut[4 * min(max(d1, 0), 127)]; }
#pragma unroll
    for (int r = 0; r < 16; ++r) { asm volatile("" : "+v"(b0[r]), "+v"(b1[r])); }
#pragma unroll
    for (int r = 0; r < 16; ++r) { const int koff = (r & 3) + 8 * (r >> 2); const int d0 = dbase - STEP * koff, d1 = d0 - STEP * 32;
        const float t0 = p0[r] + b0[r], t1 = p1[r] + b1[r];
        p0[r] = ((unsigned)d0 < LIMIT) ? t0 : -INFINITY; p1[r] = ((unsigned)d1 < LIMIT) ? t1 : -INFINITY; }
}
template <bool HASO>
__device__ __forceinline__ void sm_update(f32x16& p0, f32x16& p1, float bias, float& m, float& l, f32x16* o, LAS float* wsf, int r32, int hi) {
    const float rm = rowmax(p0, p1) + bias;
    const bool need = rm > m + THR;
    if (__any(need)) {
        const float mn = need ? rm : m; const float alpha = __builtin_amdgcn_exp2f(m - mn);
        l *= alpha; m = mn;
        if (HASO) { if (hi == 0) wsf[r32] = alpha; LDS_WAIT();
#pragma unroll
            for (int r = 0; r < 16; ++r) { const float f = wsf[crow(r, hi)]; o[0][r] *= f; o[1][r] *= f; } }
    }
    const float mb = m - bias;
#pragma unroll
    for (int r = 0; r < 16; ++r) { p0[r] = __builtin_amdgcn_exp2f(p0[r] - mb); p1[r] = __builtin_amdgcn_exp2f(p1[r] - mb); }
    float t[8];
#pragma unroll
    for (int r = 0; r < 8; ++r) t[r] = (p0[2 * r] + p0[2 * r + 1]) + (p1[2 * r] + p1[2 * r + 1]);
    l += ((t[0] + t[1]) + (t[2] + t[3])) + ((t[4] + t[5]) + (t[6] + t[7]));
}
#define ATT_PACK(P0, P1) \
    const bf16x8 pa0 = __builtin_bit_cast(bf16x8, (u32x4){cvtpk(P0[0], P0[1]), cvtpk(P0[2], P0[3]), cvtpk(P0[4], P0[5]), cvtpk(P0[6], P0[7])}); \
    const bf16x8 pa1 = __builtin_bit_cast(bf16x8, (u32x4){cvtpk(P0[8], P0[9]), cvtpk(P0[10], P0[11]), cvtpk(P0[12], P0[13]), cvtpk(P0[14], P0[15])}); \
    const bf16x8 pa2 = __builtin_bit_cast(bf16x8, (u32x4){cvtpk(P1[0], P1[1]), cvtpk(P1[2], P1[3]), cvtpk(P1[4], P1[5]), cvtpk(P1[6], P1[7])}); \
    const bf16x8 pa3 = __builtin_bit_cast(bf16x8, (u32x4){cvtpk(P1[8], P1[9]), cvtpk(P1[10], P1[11]), cvtpk(P1[12], P1[13]), cvtpk(P1[14], P1[15])});
#define ATT_WAITBAR(N) asm volatile("s_waitcnt vmcnt(" #N ") lgkmcnt(0)\n\ts_barrier" ::: "memory")
#define ATT_FILL(V, x) do { _Pragma("unroll") for (int _r = 0; _r < 16; ++_r) V[_r] = (x); } while (0)

__device__ __forceinline__ unsigned rangemask(int k, int a, int b) {
    const int lo = max(a - 32 * k, 0), hi = min(b - 32 * k, 31);
    return (lo > hi) ? 0u : ((0xFFFFFFFFu >> (31 - hi)) & (0xFFFFFFFFu << lo));
}
__device__ __forceinline__ int wave_max_i32(int x) {
    x = max(x, dpp_i<0xB1>(x)); x = max(x, dpp_i<0x4E>(x)); x = max(x, dpp_i<0x141>(x)); x = max(x, dpp_i<0x140>(x));
    return max(max(__builtin_amdgcn_readlane(x, 0), __builtin_amdgcn_readlane(x, 16)), max(__builtin_amdgcn_readlane(x, 32), __builtin_amdgcn_readlane(x, 48)));
}

__device__ __forceinline__ void lds_add_f32(LAS float* p, float v) { (void)__hip_atomic_fetch_add(p, v, __ATOMIC_RELAXED, __HIP_MEMORY_SCOPE_WORKGROUP); }

__device__ __forceinline__ void attn_item(const Frame& F, int qt, int g) {
    const int lane = lane_id(), wid = F.wave, tid = wid * 64 + lane, r32 = lane & 31, hi = lane >> 5;
    const int ql = r32 >> 2, h = r32 & 3, cur = qt, t = 64 * qt + 8 * wid + ql, head = 4 * g + h;
    LAS unsigned char* shm = F.lds;
    const unsigned lds0 = (unsigned)(uintptr_t)shm;
    LAS float* wsf = (LAS float*)(shm + L_WSF) + wid * 64;
    LAS float* SC = (LAS float*)(shm + L_SC);
    LAS float* OACC = (LAS float*)(shm + L_SC);
    LAS float* lutl = (LAS float*)(shm + L_LUT);
    const LAS float* luth = lutl + h;
    LAS unsigned* BM = (LAS unsigned*)(shm + L_BM);
    LAS float* REF = (LAS float*)(shm + L_REF);
    LAS float* LACC = (LAS float*)(shm + L_LACC);
    lutl[4 * (tid & 127) + (tid >> 7)] = F.LUT()[(4 * g + (tid >> 7)) * 128 + (tid & 127)];
    BM[tid] = 0u;
    LAS u32x2* QL8 = (LAS u32x2*)(shm + L_OUT);
#pragma unroll
    for (int i = 0; i < 4; ++i) { const int slot = tid + 512 * i, q = slot >> 5, ks_ = (slot >> 4) & 1, gq_ = (slot >> 2) & 3, h_ = slot & 3;
        const u32x4 w = *(const u32x4*)(F.Q2() + (size_t)(64 * qt + q) * 512 + g * 256 + (2 * ks_ + (gq_ >> 1)) * 64 + h_ * 16 + 8 * (gq_ & 1));
        int w0 = __builtin_amdgcn_cvt_pk_fp8_f32(8.f * bflo(w.x), 8.f * bfhi(w.x), 0, false); w0 = __builtin_amdgcn_cvt_pk_fp8_f32(8.f * bflo(w.y), 8.f * bfhi(w.y), w0, true);
        int w1 = __builtin_amdgcn_cvt_pk_fp8_f32(8.f * bflo(w.z), 8.f * bfhi(w.z), 0, false); w1 = __builtin_amdgcn_cvt_pk_fp8_f32(8.f * bflo(w.w), 8.f * bfhi(w.w), w1, true);
        QL8[slot] = (u32x2){(unsigned)w0, (unsigned)w1}; }
    bf16x8 qr[4];
    { const bf16* qp = F.Q2() + (size_t)t * 512 + g * 256 + h * 16 + hi * 8;
#pragma unroll
        for (int d0 = 0; d0 < 4; ++d0) qr[d0] = *(const bf16x8*)(qp + d0 * 64); }
    const float b31 = F.LUT()[head * 128 + 127];
    const float gate_c = fsigmoid(bf2f(F.BR()[(size_t)t * 256 + head])), gate_s = fsigmoid(bf2f(F.BR()[(size_t)t * 256 + 8 + head])), gate_w = fsigmoid(bf2f(F.BR()[(size_t)t * 256 + 16 + head]));
    f32x16 o[2], p0, p1;
    const unsigned kdst = lds0 + L_K + wid * 1024, vdst = lds0 + L_V + wid * 1024;
    const int vrow = 16 * (wid & 3) + (lane >> 2), vcol = (wid >> 2) * 32 + (lane & 3) * 8;
    const int vb0 = (int)(lds0 + L_V) + ((lane >> 4) & 1) * 32 + (lane & 3) * 8 + (4 * hi + ((lane & 15) >> 2)) * 64;
#define DMA_K(base, pitch, row0, slot) glds16((base) + (size_t)((row0) + lane) * (pitch) + wid * 8, (unsigned)__builtin_amdgcn_readfirstlane(kdst + (slot)))
#define DMA_V(base, pitch, row0, slot) glds16((base) + (size_t)((row0) + vrow) * (pitch) + vcol, (unsigned)__builtin_amdgcn_readfirstlane(vdst + (slot)))
#define ROT() do { sl_cur = sl_next; sl_next = (sl_next == (NSLOT - 1) * SLOTB) ? 0 : sl_next + SLOTB; } while (0)
    VM_WAIT(); LDS_WAIT(); __syncthreads();

    const bf16* KCg = F.KC() + (size_t)g * 1024 * 64; const bf16* VCg = F.VC() + (size_t)g * 1024 * 64;
    const int nkt = (qt >> 4) + 1;
    const int tminw = 64 * qt + 8 * wid;
    float m = -1e30f, l = 0.f;
    {
        int sl_cur = 0, sl_next = SLOTB;
        DMA_K(KCg, 64, 0, 0);
        for (int kt = 0; kt < nkt; ++kt) {
            if (kt + 1 < nkt) { DMA_K(KCg, 64, 64 * (kt + 1), sl_next); ATT_WAITBAR(1); } else { ATT_WAITBAR(0); }
            const bool far = (tminw - 31 - 16 * (64 * kt + 63)) >= 128;
            qkt(p0, p1, shm + L_K + sl_cur, qr, r32, hi);
            if (!far) near_apply<16, 0x80000000u>(p0, p1, t - 31 - 16 * (64 * kt + 4 * hi), luth);
            sm_update<false>(p0, p1, far ? b31 : 0.f, m, l, o, wsf, r32, hi);
            ROT();
        }
        LDS_WAIT(); __builtin_amdgcn_s_barrier();
    }
    {
        const float lt = halfsum(l); const float rl = lt > 0.f ? 1.0f / lt : 0.f;
        ATT_FILL(o[0], 0.f); ATT_FILL(o[1], 0.f);
        float carry = 0.f;
        int sl_cur = 0, sl_next = SLOTB;
        DMA_K(KCg, 64, 0, 0); DMA_V(VCg, 64, 0, 0);
        for (int kt = 0; kt < nkt; ++kt) {
            if (kt + 1 < nkt) { DMA_K(KCg, 64, 64 * (kt + 1), sl_next); DMA_V(VCg, 64, 64 * (kt + 1), sl_next); ATT_WAITBAR(2); } else { ATT_WAITBAR(0); }
            const bool far = (tminw - 31 - 16 * (64 * kt + 63)) >= 128;
            qkt(p0, p1, shm + L_K + sl_cur, qr, r32, hi);
            if (!far) near_apply<16, 0x80000000u>(p0, p1, t - 31 - 16 * (64 * kt + 4 * hi), luth);
            const float mb2 = far ? m - b31 : m;
#pragma unroll
            for (int r = 0; r < 16; ++r) { p0[r] = __builtin_amdgcn_exp2f(p0[r] - mb2) * rl; p1[r] = __builtin_amdgcn_exp2f(p1[r] - mb2) * rl; }
            {
                float q4[8], e[8];
#pragma unroll
                for (int i = 0; i < 4; ++i) { q4[i] = (p0[4 * i] + p0[4 * i + 1]) + (p0[4 * i + 2] + p0[4 * i + 3]); e[i] = p0[4 * i + 3];
                                              q4[4 + i] = (p1[4 * i] + p1[4 * i + 1]) + (p1[4 * i + 2] + p1[4 * i + 3]); e[4 + i] = p1[4 * i + 3]; }
                float newcarry = 0.f;
#pragma unroll
                for (int i = 0; i < 8; ++i) { auto rr = __builtin_amdgcn_permlane32_swap(__float_as_uint(e[i]), __float_as_uint(e[i]), false, false);
                    const float elo = __uint_as_float(rr[0]), ehi = __uint_as_float(rr[1]);
                    if (hi) q4[i] += elo; else if (i < 7) q4[i + 1] += ehi;
                    if (i == 7) newcarry = ehi; }
                if (!hi) q4[0] += carry;
                carry = newcarry;
#pragma unroll
                for (int i = 0; i < 8; ++i) { float v = q4[i]; v += dpp_f<0xB1>(v); v += dpp_f<0x4E>(v); q4[i] = v; }
                if (h == 0) {
#pragma unroll
                    for (int i = 0; i < 8; ++i) SC[(8 * wid + ql) * 256 + 16 * kt + 2 * i + hi] = q4[i]; }
            }
            { ATT_PACK(p0, p1); pv(o, vb0 + sl_cur, pa0, pa1, pa2, pa3); }
            ROT();
        }
        LDS_WAIT(); __builtin_amdgcn_s_barrier();
    }

    if (cur >= 16) {
        const int u4 = lane >> 4, li16 = lane & 15;
#pragma unroll 1
        for (int qb = 0; qb < 8; qb += 4) {
            const int qloc = 8 * wid + qb + u4;
            const LAS float* row = SC + qloc * 256 + li16;
            int v[16];
#pragma unroll
            for (int k = 0; k < 16; ++k) { const int J = li16 + 16 * k; const int x = (__float_as_int(row[16 * k]) & ~255) | (255 - J); v[k] = (J >= 1 && J <= cur - 2) ? x : -1; }
            LAS unsigned* bmq = BM + (qloc >> 5); const unsigned qbit = 1u << (qloc & 31);
#pragma unroll 1
            for (int round = 0; round < 13; ++round) {
                int lm = max(max(max(v[0], v[1]), max(v[2], v[3])), max(max(v[4], v[5]), max(v[6], v[7])));
                lm = max(lm, max(max(max(v[8], v[9]), max(v[10], v[11])), max(max(v[12], v[13]), max(v[14], v[15]))));
                int rm = lm; rm = max(rm, dpp_i<0xB1>(rm)); rm = max(rm, dpp_i<0x4E>(rm)); rm = max(rm, dpp_i<0x141>(rm)); rm = max(rm, dpp_i<0x140>(rm));
                if (lm == rm) {
#pragma unroll
                    for (int k = 0; k < 16; ++k) v[k] = (v[k] == rm) ? -1 : v[k];
                    __hip_atomic_fetch_or(bmq + 2 * (255 - (rm & 255)), qbit, __ATOMIC_RELAXED, __HIP_MEMORY_SCOPE_WORKGROUP);
                }
            }
        }
    }
    LDS_WAIT();
    LAS float* ostg = (LAS float*)(shm + L_SC) + wid * 2048;
    {
        if (hi == 0) wsf[r32] = gate_c; LDS_WAIT();
#pragma unroll
        for (int r = 0; r < 16; ++r) { const float f = wsf[crow(r, hi)]; const int orow = crow(r, hi); ostg[orow * 64 + r32] = o[0][r] * f; ostg[orow * 64 + 32 + r32] = o[1][r] * f; }
    }

    const bf16* Kw = F.KV() + 512 + g * 64; const bf16* Vw = F.KV() + 640 + g * 64;
    {
        m = -1e30f; l = 0.f; ATT_FILL(o[0], 0.f); ATT_FILL(o[1], 0.f);
        const int J0 = max(cur - 8, 0);
        int sl_cur = 0, sl_next = SLOTB;
        DMA_K(Kw, 768, 64 * J0, 0); DMA_V(Vw, 768, 64 * J0, 0);
        for (int J = J0; J <= cur; ++J) {
            if (J + 1 <= cur) { DMA_K(Kw, 768, 64 * (J + 1), sl_next); DMA_V(Vw, 768, 64 * (J + 1), sl_next); ATT_WAITBAR(2); } else { ATT_WAITBAR(0); }
            const bool nearw = (J >= cur - 2 || J == cur - 8);
            qkt(p0, p1, shm + L_K + sl_cur, qr, r32, hi);
            if (nearw) near_apply<1, 512u>(p0, p1, t - 64 * J - 4 * hi, luth);
            sm_update<true>(p0, p1, nearw ? 0.f : b31, m, l, o, wsf, r32, hi);
            { ATT_PACK(p0, p1); pv(o, vb0 + sl_cur, pa0, pa1, pa2, pa3); }
            ROT();
        }
        LDS_WAIT(); __builtin_amdgcn_s_barrier();
        const float lt = halfsum(l); const float fw = lt > 0.f ? gate_w / lt : 0.f;
        if (hi == 0) wsf[r32] = fw; LDS_WAIT();
#pragma unroll
        for (int r = 0; r < 16; ++r) { const float f = wsf[crow(r, hi)]; const int orow = crow(r, hi); ostg[orow * 64 + r32] += o[0][r] * f; ostg[orow * 64 + 32 + r32] += o[1][r] * f; }
        LDS_WAIT();
#pragma unroll
        for (int i = 0; i < 4; ++i) { const int rowl = i * 8 + (lane >> 3), chn = lane & 7;
            const f32x4 a0 = *(const LAS f32x4*)(ostg + rowl * 64 + chn * 8), a1 = *(const LAS f32x4*)(ostg + rowl * 64 + chn * 8 + 4);
            const size_t tt = (size_t)(64 * qt + 8 * wid + (rowl >> 2)); const int col = (4 * g + (rowl & 3)) * 64 + chn * 8;
            *(u32x4*)(F.XN() + tt * 1024 + col) = (u32x4){cvtpk(a0[0], a0[1]), cvtpk(a0[2], a0[3]), cvtpk(a1[0], a1[1]), cvtpk(a1[2], a1[3])}; }
        LDS_WAIT();
    }

    const bf16* Ks = F.KV() + 256 + g * 64; const bf16* Vs = F.KV() + 384 + g * 64;
    {
        m = -1e30f; l = 0.f; ATT_FILL(o[0], 0.f); ATT_FILL(o[1], 0.f);
        const int nA = (cur < 16) ? cur + 1 : 3;
#define JA(i) ((cur < 16) ? (i) : ((i) == 0 ? 0 : cur - 2 + (i)))
        int sl_cur = 0, sl_next = SLOTB;
        DMA_K(Ks, 768, 0, 0); DMA_V(Vs, 768, 0, 0);
        for (int i = 0; i < nA; ++i) {
            const int J = JA(i);
            if (i + 1 < nA) { const int Jn = JA(i + 1); DMA_K(Ks, 768, 64 * Jn, sl_next); DMA_V(Vs, 768, 64 * Jn, sl_next); ATT_WAITBAR(2); } else { ATT_WAITBAR(0); }
            const bool neara = (J >= cur - 2);
            qkt(p0, p1, shm + L_K + sl_cur, qr, r32, hi);
            if (neara) near_apply<1, 0x80000000u>(p0, p1, t - 64 * J - 4 * hi, luth);
            sm_update<true>(p0, p1, neara ? 0.f : b31, m, l, o, wsf, r32, hi);
            { ATT_PACK(p0, p1); pv(o, vb0 + sl_cur, pa0, pa1, pa2, pa3); }
            ROT();
        }
#undef JA
        LDS_WAIT(); __builtin_amdgcn_s_barrier();
        const float lt = halfsum(l);
        if (hi == 0) { REF[32 * wid + r32] = m; LACC[32 * wid + r32] = lt; }
#pragma unroll
        for (int r = 0; r < 16; ++r) { const int orow = 32 * wid + crow(r, hi); OACC[orow * 64 + r32] = o[0][r]; OACC[orow * 64 + 32 + r32] = o[1][r]; }
        LDS_WAIT(); __builtin_amdgcn_s_barrier();
    }

    if (cur >= 16) {
        const int c16 = lane & 15, gq = lane >> 4, qi4 = c16 >> 2;
        float oa[2][16], la2[2];
        { const int li_ = lane & 15, hsel_ = li_ >> 2, dq_ = (li_ & 3) * 16;
#pragma unroll
            for (int p = 0; p < 2; ++p) { la2[p] = 0.f; const LAS f32x4* ap = (const LAS f32x4*)(OACC + (4 * (8 * wid + 4 * p + gq) + hsel_) * 64 + dq_);
#pragma unroll
                for (int k = 0; k < 4; ++k) { const f32x4 a = ap[k]; oa[p][4 * k] = a[0]; oa[p][4 * k + 1] = a[1]; oa[p][4 * k + 2] = a[2]; oa[p][4 * k + 3] = a[3]; } } }
        LDS_WAIT(); __builtin_amdgcn_s_barrier();
        if (tid < 128) ((LAS unsigned*)(shm + L_HDR))[tid] = 0u;
        typedef long i64_t;
        const i64_t* KTg = (const i64_t*)F.KT() + (size_t)g * 256 * 512 + gq * 16 + c16; const bf16* VTg = F.VT() + (size_t)g * 256 * 4096 + c16 * 32 + 8 * gq;
        const LAS i64_t* QLg = (const LAS i64_t*)QL8 + gq * 4 + h;
        LAS unsigned* TL = (LAS unsigned*)(shm + L_TL) + wid * 160;
        int ntask = 0;
#pragma unroll 1
        for (int i4 = 0; i4 < 4; ++i4) {
            const int Jl = lane + 64 * i4; int nch = 0;
            unsigned long long mk = 0ull;
            if (Jl >= 1 && Jl <= cur - 2 && (Jl & 7) == wid) { mk = ((unsigned long long)BM[2 * Jl + 1] << 32) | BM[2 * Jl]; nch = (__popcll(mk) + 3) >> 2; }
            int incl = nch;
#pragma unroll
            for (int o = 1; o < 64; o <<= 1) { const int up = __shfl_up(incl, o); if (lane >= o) incl += up; }
            const int base = ntask + incl - nch;
            for (int c = 0; c < nch; ++c) { unsigned e = (unsigned)Jl; int q0 = 0;
#pragma unroll
                for (int k = 0; k < 4; ++k) { int q = q0; if (mk) { q = __builtin_ctzll(mk); mk &= mk - 1; } if (k == 0) q0 = q; e |= (unsigned)q << (8 + 6 * k); }
                if (base + c < 160) TL[base + c] = e; }
            ntask += __shfl(incl, 63);
        }
        ntask = min(ntask, 160);
        LAS float* EX = (LAS float*)(shm + L_EX); LAS unsigned* QM = (LAS unsigned*)(shm + L_HDR); LAS float* LEX = (LAS float*)(shm + L_LEX); LAS int* NT = (LAS int*)(shm + L_NT);
        if (lane == 0) NT[wid] = ntask;
        LDS_WAIT(); __builtin_amdgcn_s_barrier();
        int nround = 0;
#pragma unroll
        for (int k = 0; k < 8; ++k) nround = max(nround, __builtin_amdgcn_readfirstlane(NT[k]));
        i64_t kfC[8], kfN[8]; bf16x8 vfC[8]; bool kpend = false;
#define LOADK(J_, KF) do { const i64_t* kp_ = KTg + (size_t)(J_) * 512; \
            _Pragma("unroll") for (int kt = 0; kt < 4; ++kt) { KF[2 * kt] = kp_[kt * 64]; KF[2 * kt + 1] = kp_[256 + kt * 64]; } } while (0)
#define LOADV(J_, VF) do { const bf16* vp_ = VTg + (size_t)(J_) * 4096; _Pragma("unroll") for (int x = 0; x < 8; ++x) VF[x] = *(const bf16x8*)(vp_ + x * 512); } while (0)
        unsigned e_cur = 0xffu;
        i64_t qg0 = 0, qg1 = 0; float ref = 0.f;
#define QFETCH(E) do { const int mq_ = ((E) >> (8 + 6 * qi4)) & 63; const LAS i64_t* qp_ = QLg + mq_ * 32; qg0 = qp_[0]; qg1 = qp_[16]; ref = REF[4 * mq_ + h]; } while (0)
        if (ntask > 0) { e_cur = (unsigned)__builtin_amdgcn_readfirstlane((int)TL[0]); LOADK(e_cur & 255u, kfC); LOADV(e_cur & 255u, vfC); QFETCH(e_cur); }
        unsigned tl1 = (ntask > 1) ? TL[1] : 0xffu;
#define OWNER_PASS(M0, M1, B) do { const int li_ = lane & 15, hsel_ = li_ >> 2, dq_ = (li_ & 3) * 16; \
            _Pragma("unroll") for (int pass = 0; pass < 2; ++pass) { \
                unsigned mm = pass ? (M1) : (M0); \
                while (mm) { const int e = __builtin_ctz(mm); mm &= mm - 1; \
                    const LAS f32x4* xr = (const LAS f32x4*)(EX + (B) * 8704 + (e * 4 + hsel_) * 68 + dq_); \
                    const f32x4 y0 = xr[0], y1 = xr[1], y2 = xr[2], y3 = xr[3]; \
                    oa[pass][0] += y0[0]; oa[pass][1] += y0[1]; oa[pass][2] += y0[2]; oa[pass][3] += y0[3]; oa[pass][4] += y1[0]; oa[pass][5] += y1[1]; oa[pass][6] += y1[2]; oa[pass][7] += y1[3]; \
                    oa[pass][8] += y2[0]; oa[pass][9] += y2[1]; oa[pass][10] += y2[2]; oa[pass][11] += y2[3]; oa[pass][12] += y3[0]; oa[pass][13] += y3[1]; oa[pass][14] += y3[2]; oa[pass][15] += y3[3]; \
                    la2[pass] += LEX[(B) * 128 + e * 4 + hsel_]; } } } while (0)
#pragma unroll 1
        for (int n = 0; n < nround; ++n) {
            const int buf = n & 1;
            unsigned qm0 = 0u, qm1 = 0u;
            if (n > 0) { qm0 = QM[(buf ^ 1) * 64 + 8 * wid + gq]; qm1 = QM[(buf ^ 1) * 64 + 8 * wid + 4 + gq]; }
            if (n < ntask) {
                const unsigned e_nxt = (n + 1 < ntask) ? (unsigned)__builtin_amdgcn_readfirstlane((int)tl1) : 0xffu;
                tl1 = (n + 2 < ntask) ? TL[n + 2] : 0xffu;
                const unsigned e_ = e_cur; const int Jb = e_ & 255, Jn = e_nxt & 255; const bool reload = (Jn != Jb) && (Jn != 255);
                const int q0_ = (e_ >> 8) & 63;
                const int myq = (e_ >> (8 + 6 * qi4)) & 63; const bool valid = (qi4 == 0) || (myq != q0_); const int tq = 64 * qt + myq;
                const bool nearJ = (Jb >= cur - 2);
                const float cinit = nearJ ? 0.f : (valid ? b31 - ref : -INFINITY);
                if (kpend) {
#pragma unroll
                    for (int x = 0; x < 8; ++x) kfC[x] = kfN[x];
                    kpend = false; }
                if (reload) { LOADK(Jn, kfN); kpend = true; }
                f32x4 s[4];
#pragma unroll
                for (int kt = 0; kt < 4; ++kt) { s[kt] = (f32x4){0.f, 0.f, 0.f, 0.f};
                    s[kt] = __builtin_amdgcn_mfma_f32_16x16x32_fp8_fp8(kfC[2 * kt], qg0, s[kt], 0, 0, 0); s[kt] = __builtin_amdgcn_mfma_f32_16x16x32_fp8_fp8(kfC[2 * kt + 1], qg1, s[kt], 0, 0, 0); }
                const float refc = ref;
                if (n + 1 < ntask) QFETCH(e_nxt);
                if (nearJ) { const float sub = valid ? refc : INFINITY;
                    float bb[16];
#pragma unroll
                    for (int kt = 0; kt < 4; ++kt)
#pragma unroll
                        for (int r = 0; r < 4; ++r) { const int dd = tq - 64 * Jb - (16 * kt + 4 * gq + r); bb[kt * 4 + r] = luth[4 * min(max(dd, 0), 127)]; }
#pragma unroll
                    for (int x = 0; x < 16; ++x) asm volatile("" : "+v"(bb[x]));
#pragma unroll
                    for (int kt = 0; kt < 4; ++kt)
#pragma unroll
                        for (int r = 0; r < 4; ++r) { const int dd = tq - 64 * Jb - (16 * kt + 4 * gq + r); const float tt = s[kt][r] * 0.125f + bb[kt * 4 + r] - sub;
                            s[kt][r] = (dd >= 0) ? tt * 8.0f : -INFINITY; } }
#pragma unroll
                for (int kt = 0; kt < 4; ++kt)
#pragma unroll
                    for (int r = 0; r < 4; ++r) { const int tb = min(__float_as_int(s[kt][r] * 0.125f + cinit), __float_as_int(CLAMP));
                        s[kt][r] = __builtin_amdgcn_exp2f(__int_as_float(tb)); }
                float ls = (((s[0][0] + s[0][1]) + (s[0][2] + s[0][3])) + ((s[1][0] + s[1][1]) + (s[1][2] + s[1][3]))) + (((s[2][0] + s[2][1]) + (s[2][2] + s[2][3])) + ((s[3][0] + s[3][1]) + (s[3][2] + s[3][3])));
                { auto r16 = __builtin_amdgcn_permlane16_swap(__float_as_uint(ls), __float_as_uint(ls), false, false); ls = __uint_as_float(r16[0]) + __uint_as_float(r16[1]); }
                ls = halfsum(ls);
                bf16x8 pb[2];
#pragma unroll
                for (int ks = 0; ks < 2; ++ks) pb[ks] = __builtin_bit_cast(bf16x8, (u32x4){cvtpk(s[2 * ks][0], s[2 * ks][1]), cvtpk(s[2 * ks][2], s[2 * ks][3]), cvtpk(s[2 * ks + 1][0], s[2 * ks + 1][1]), cvtpk(s[2 * ks + 1][2], s[2 * ks + 1][3])});
                LAS float* ex = EX + buf * 8704 + ((wid * 4 + qi4) * 4 + h) * 68 + 4 * gq;
                f32x4 ot[4];
#pragma unroll
                for (int mt = 0; mt < 4; ++mt) { ot[mt] = (f32x4){0.f, 0.f, 0.f, 0.f};
                    ot[mt] = __builtin_amdgcn_mfma_f32_16x16x32_bf16(vfC[2 * mt], pb[0], ot[mt], 0, 0, 0); ot[mt] = __builtin_amdgcn_mfma_f32_16x16x32_bf16(vfC[2 * mt + 1], pb[1], ot[mt], 0, 0, 0); }
                if (reload) LOADV(Jn, vfC);
#pragma unroll
                for (int mt = 0; mt < 4; ++mt) *(LAS f32x4*)(ex + 16 * mt) = ot[mt];
                if (gq == 0) { LEX[buf * 128 + wid * 16 + c16] = ls; if (h == 0 && valid) __hip_atomic_fetch_or(QM + buf * 64 + myq, 1u << (wid * 4 + qi4), __ATOMIC_RELAXED, __HIP_MEMORY_SCOPE_WORKGROUP); }
                e_cur = e_nxt;
            }
            OWNER_PASS(qm0, qm1, buf ^ 1);
            if (n > 0 && (lane & 15) == 0) { QM[(buf ^ 1) * 64 + 8 * wid + gq] = 0u; QM[(buf ^ 1) * 64 + 8 * wid + 4 + gq] = 0u; }
            LDS_WAIT(); __builtin_amdgcn_s_barrier();
        }
        if (nround > 0) { const int lb = (nround - 1) & 1; const unsigned l0 = QM[lb * 64 + 8 * wid + gq], l1 = QM[lb * 64 + 8 * wid + 4 + gq]; OWNER_PASS(l0, l1, lb); }
#undef OWNER_PASS
        LDS_WAIT(); __builtin_amdgcn_s_barrier();
        {
            const int li = lane & 15, hsel = li >> 2, dq = (li & 3) * 16;
#pragma unroll
            for (int pass = 0; pass < 2; ++pass) { const int q = 8 * wid + 4 * pass + gq; LAS f32x4* ap = (LAS f32x4*)(OACC + (4 * q + hsel) * 64 + dq);
#pragma unroll
                for (int k = 0; k < 4; ++k) ap[k] = (f32x4){oa[pass][4 * k], oa[pass][4 * k + 1], oa[pass][4 * k + 2], oa[pass][4 * k + 3]};
                if ((li & 3) == 0) LACC[4 * q + hsel] += la2[pass]; }
        }
#undef LOADK
#undef LOADV
#undef QFETCH
    }
    LDS_WAIT(); __builtin_amdgcn_s_barrier();

    {
        if (hi == 0) { const float lt = LACC[32 * wid + r32]; wsf[r32] = lt > 0.f ? gate_s / lt : 0.f; }
        LDS_WAIT();
#pragma unroll
        for (int i = 0; i < 4; ++i) { const int rowl = i * 8 + (lane >> 3), chn = lane & 7, row = 32 * wid + rowl;
            const float f = wsf[rowl];
            const f32x4 a0 = *(const LAS f32x4*)(OACC + row * 64 + chn * 8), a1 = *(const LAS f32x4*)(OACC + row * 64 + chn * 8 + 4);
            const size_t tt = (size_t)(64 * qt + 8 * wid + (rowl >> 2)); const int col = (4 * g + (rowl & 3)) * 64 + chn * 8;
            const u32x4 ov = *(const u32x4*)(F.XN() + tt * 1024 + col);
            const u32x4 gn = *(const u32x4*)(F.GN() + tt * 512 + col);
            u32x4 w; w.x = pk2((bflo(ov.x) + a0[0] * f) * bflo(gn.x), (bfhi(ov.x) + a0[1] * f) * bfhi(gn.x)); w.y = pk2((bflo(ov.y) + a0[2] * f) * bflo(gn.y), (bfhi(ov.y) + a0[3] * f) * bfhi(gn.y));
            w.z = pk2((bflo(ov.z) + a1[0] * f) * bflo(gn.z), (bfhi(ov.z) + a1[1] * f) * bfhi(gn.z)); w.w = pk2((bflo(ov.w) + a1[2] * f) * bflo(gn.w), (bfhi(ov.w) + a1[3] * f) * bfhi(gn.w));
            *(u32x4*)(F.XN() + tt * 1024 + col) = w; }
        VM_WAIT(); LDS_WAIT(); __syncthreads();
    }
#undef DMA_K
#undef DMA_V
#undef ROT
}
}

__global__ void __launch_bounds__(NWAVES * 64, 2) nsa_lru_fwd(Args args) {
    extern __shared__ __attribute__((aligned(16))) unsigned char lds[];
    Frame F;
    F.lds = (LAS unsigned char*)lds;
    F.MISC = (volatile LAS unsigned*)(F.lds + MISC_OFF);
    F.wave = __builtin_amdgcn_readfirstlane((int)(threadIdx.x >> 6));
    F.G = gridDim.x; { const int bx = blockIdx.x; F.vcu = (F.G % 8 == 0) ? (bx % 8) * (F.G / 8) + bx / 8 : bx; }
    F.ws = args.ws;
    gu32* ctl = (gu32*)(args.ws + WS_CTL);
    for (int u = F.wave * 64 + lane_id(); u < (LDS_BYTES - LDSCTL_OFF) / 4; u += NWAVES * 64) ((LAS unsigned*)(F.lds + LDSCTL_OFF))[u] = 0u;
    __syncthreads();
    const int bli = (N_LAUNCHES == PER_PHASE) ? 0 : args.li;
    XcdBarrier bar; bar.bar = (unsigned*)(ctl + CW_BAR) + bli * XCD_BAR_WORDS; bar.x = 0; bar.st = nullptr;
    if (N_LAUNCHES != PER_PHASE) bar = xcd_barrier_post((unsigned*)(ctl + CW_BAR) + bli * XCD_BAR_WORDS, F.MISC + 8);
#define GRID_BAR() do { if (N_LAUNCHES != PER_PHASE) xcd_barrier(bar); } while (0)
    const int lo = args.ph_lo, hi = args.ph_hi;
#define IN(k) (lo <= (k) && (k) < hi)
#define BOTH(k) (IN(k) && IN((k) + 1))

    if (IN(0)) { p0_prologue(F, args); if (BOTH(0)) GRID_BAR(); }

    if (IN(1)) {
        pg8::Gemm g{F.XN(), F.WinT(), F.XN(), F.WinT(), 1024, 1024, 1024}; pg8::StaticOrder S; S.init(SEQ, NPROJ, F.G, (int)blockIdx.x);
        pg8::EpiProj E{F.Q(), F.KV(), F.U(), F.BR(), F.GN(), F.GL(), F.MG()};
        pg8::gemm_phase<pg8::EpiProj, pg8::StaticOrder, true>(F.lds, g, S, E, F.wave);
        if (BOTH(1)) GRID_BAR();
    }

    if (IN(2)) {
        for (int i = F.vcu; i < 256; i += F.G) {
            lru_tile<false>(F, args, i);
            if (!args.pad) qk_norm_tile(F, args, i);
            vt_tile(F, i);
            __syncthreads();
            compress_item(F, args, i & 1, (i >> 1) & 1, i >> 2);
        }
        if (BOTH(2)) GRID_BAR();
    }

    if (IN(3)) {
        for (int i = F.vcu; i < 256; i += F.G) { lru_apply(F, i); }
        __syncthreads();
#pragma unroll 1
        for (int it = 2 * F.vcu; it < 512; it += 2 * F.G) {
#pragma unroll 1
            for (int j = 0; j < 2; ++j) { const int i = it >> 1; att::attn_item(F, j ? i : 255 - i, j ? 0 : 1); }
        }
        if (BOTH(3)) GRID_BAR();
    }

    if (IN(4)) {
        pg8::Gemm g{F.XN(), F.WaT(), F.XN() + 512, F.WbT(), 1024, 512, 512}; pg8::DualOrder S; S.init(SEQ, 1024, F.G, (int)blockIdx.x);
        pg8::EpiMerge E{F.MB(), F.MG()};
        pg8::gemm_phase<pg8::EpiMerge, pg8::DualOrder, true>(F.lds, g, S, E, F.wave);
        if (BOTH(4)) GRID_BAR();
    }

    if (IN(5)) {
        pg8::Gemm g{F.MB(), F.WoutT(), F.MB(), F.WoutT(), 1024, 1024, 1024}; pg8::StaticOrder S; S.init(SEQ, 1024, F.G, (int)blockIdx.x);
        pg8::EpiOut E{args.in[0], args.out};
        pg8::gemm_phase<pg8::EpiOut, pg8::StaticOrder, true>(F.lds, g, S, E, F.wave);
    }
#undef IN
#undef BOTH
}

extern "C" void kernel_launch(void* const* d_in, const int* in_sizes, int n_in, void* d_out, int out_size, void* d_ws, size_t ws_size, hipStream_t stream) {
    static int grid = 0;
    if (grid == 0) {
        if (n_in != 20 || in_sizes[0] != SEQ * DM || out_size != SEQ * DM || ws_size < WS_END) { fprintf(stderr, "kernel_launch: unexpected shapes (n_in %d, in0 %d, out %d, ws %zu)\n", n_in, n_in > 0 ? in_sizes[0] : -1, out_size, ws_size); grid = -1; return; }
        int dev = 0, cus = 0, per_cu = 0;
        if (hipGetDevice(&dev) != hipSuccess || hipDeviceGetAttribute(&cus, hipDeviceAttributeMultiprocessorCount, dev) != hipSuccess) { grid = -1; return; }
        if (hipFuncSetAttribute((const void*)nsa_lru_fwd, hipFuncAttributeMaxDynamicSharedMemorySize, LDS_BYTES) != hipSuccess) { fprintf(stderr, "kernel_launch: hipFuncSetAttribute failed\n"); grid = -1; return; }
        if (hipOccupancyMaxActiveBlocksPerMultiprocessor(&per_cu, (const void*)nsa_lru_fwd, NWAVES * 64, LDS_BYTES) != hipSuccess || per_cu < 1)
            fprintf(stderr, "kernel_launch: occupancy query reports %d workgroups per CU\n", per_cu);
        (void)hipGetLastError();
        grid = cus;
    }
    if (grid < 0) return;
    if (hipMemsetAsync((char*)d_ws + WS_CTL, 0, CTL_ZERO_BYTES, stream) != hipSuccess) { fprintf(stderr, "kernel_launch: hipMemsetAsync failed\n"); return; }
    Args a{};
    for (int i = 0; i < 20; ++i) a.in[i] = (const float*)d_in[i];
    a.out = (float*)d_out; a.ws = (unsigned char*)d_ws;
    const int nl = (PROBE_DUP >= 0) ? 2 : N_LAUNCHES;
    for (int li = 0; li < nl; ++li) {
        if (PROBE_DUP >= 0) { a.ph_lo = li ? PROBE_DUP : 0; a.ph_hi = li ? PER_PHASE : PROBE_DUP + 1; a.li = li; a.pad = (li && PROBE_DUP == 2) ? 1 : 0; }
        else { a.ph_lo = (N_LAUNCHES == PER_PHASE) ? li : 0; a.ph_hi = (N_LAUNCHES == PER_PHASE) ? li + 1 : PER_PHASE; a.li = li; }
        hipLaunchKernelGGL(nsa_lru_fwd, dim3(grid), dim3(NWAVES * 64), LDS_BYTES, stream, a);
        const hipError_t le = hipPeekAtLastError();
        if (le != hipSuccess) { fprintf(stderr, "kernel_launch: launch %d failed: %s\n", li, hipGetErrorName(le)); break; }
    }
}
```

```cpp
#include <hip/hip_runtime.h>
#include <cstdio>
#include <cstdint>

#ifndef PROBE_DUP
#define PROBE_DUP -1
#endif
#ifndef MK_N_LAUNCHES
#define MK_N_LAUNCHES 1
#endif

#define GAS __attribute__((address_space(1)))
#define LAS __attribute__((address_space(3)))
typedef unsigned short bf16;
typedef short bf16x8 __attribute__((ext_vector_type(8)));
typedef short s16x4 __attribute__((ext_vector_type(4)));
typedef float f32x4 __attribute__((ext_vector_type(4)));
typedef float f32x16 __attribute__((ext_vector_type(16)));
typedef unsigned u32x4 __attribute__((ext_vector_type(4)));
typedef unsigned u32x2 __attribute__((ext_vector_type(2)));
typedef GAS unsigned gu32;

constexpr int SEQ = 16384, DM = 1024;
constexpr int NPROJ = 5120;
constexpr float LOG2E = 1.4426950408889634f;
constexpr float RMS_EPS = 1e-6f;

__device__ __forceinline__ unsigned f2bf(float f) { unsigned u = __builtin_bit_cast(unsigned, f); return (u + 0x7fffu + ((u >> 16) & 1u)) >> 16; }
__device__ __forceinline__ unsigned pk2(float lo, float hi) { return f2bf(lo) | (f2bf(hi) << 16); }
__device__ __forceinline__ float bf2f(unsigned h) { return __builtin_bit_cast(float, h << 16); }
__device__ __forceinline__ float bflo(unsigned w) { return __builtin_bit_cast(float, w << 16); }
__device__ __forceinline__ float bfhi(unsigned w) { return __builtin_bit_cast(float, w & 0xffff0000u); }
typedef float f32x2_t __attribute__((ext_vector_type(2))); typedef __bf16 bf16x2_t __attribute__((ext_vector_type(2)));
__device__ __forceinline__ unsigned cvtpk(float lo, float hi) { f32x2_t v = {lo, hi}; bf16x2_t b = __builtin_convertvector(v, bf16x2_t); return __builtin_bit_cast(unsigned, b); }
__device__ __forceinline__ float fsigmoid(float v) { return __builtin_amdgcn_rcpf(1.0f + __builtin_amdgcn_exp2f(-v * LOG2E)); }
template <int CTRL> __device__ __forceinline__ float dpp_f(float v) { return __builtin_bit_cast(float, __builtin_amdgcn_update_dpp(0, __builtin_bit_cast(int, v), CTRL, 0xf, 0xf, true)); }
template <int CTRL> __device__ __forceinline__ int dpp_i(int v) { return __builtin_amdgcn_update_dpp(v, v, CTRL, 0xf, 0xf, false); }
__device__ __forceinline__ int lane_id() { int l = (int)__builtin_amdgcn_mbcnt_hi(~0u, __builtin_amdgcn_mbcnt_lo(~0u, 0u)); asm volatile("" : "+v"(l)); return l; }
__device__ __forceinline__ float wave_sum(float v) {
#pragma unroll
    for (int o = 1; o < 64; o <<= 1) v += __shfl_xor(v, o);
    return v;
}

namespace pg8 {
#define PG8_LAS __attribute__((address_space(3)))
typedef unsigned short bf16_t;
constexpr int BM = 256, BK = 64, HALF = 128, HTB = HALF * BK * 2, STAGE_BYTES = 8 * HTB, NXCD = 8, WGM = 8;
__host__ __device__ __forceinline__ int lds_byte(int r, int c) { const int st = (r >> 4) * 2 + (c >> 5), rr = r & 15, cc = c & 31, ob = rr * 64 + cc * 2; return st * 1024 + (ob ^ (((ob >> 9) & 1) << 5)); }
__host__ __device__ __forceinline__ void stage_rc(int b, int& R, int& C) { const int st = b / 1024, sb = b % 1024, swz = sb ^ (((sb >> 9) & 1) << 5); R = (st >> 1) * 16 + swz / 64; C = (st & 1) * 32 + (swz % 64) / 2; }
__host__ __device__ __forceinline__ int perm32(int rho) { const int n = rho >> 4, i = rho & 15; return 8 * (i >> 2) + 4 * n + (i & 3); }

struct Unit { int pm, pn, part; };
struct Gemm { const bf16_t* A; const bf16_t* Bt; const bf16_t* A2; const bf16_t* Bt2; int lda, ldb, K; };

struct StaticOrder {
    int nM, nN, nwg, G, c;
    __host__ __device__ void init(int M, int N, int G_, int c_) { nM = M / BM; nN = N / BM; nwg = nM * nN; G = G_; c = c_; }
    __host__ __device__ bool tile(long L, Unit& u) const {
        if (L >= nwg) return false;
        int wgid = (int)L; { const int q = nwg / NXCD, r = nwg % NXCD, xcd = wgid % NXCD, off = wgid / NXCD; wgid = (xcd < r ? xcd * (q + 1) : r * (q + 1) + (xcd - r) * q) + off; }
        const int nig = WGM * nN, gid = wgid / nig, fm = gid * WGM, gsz = (nM - fm) < WGM ? (nM - fm) : WGM;
        u.pm = fm + ((wgid % nig) % gsz); u.pn = (wgid % nig) / gsz; u.part = 0; return true;
    }
    __host__ __device__ bool next(int i, Unit& u) const { return tile((long)i * G + c, u); }
};
struct DualOrder : StaticOrder {
    __host__ __device__ bool next(int i, Unit& u) const { if (!tile((long)(i >> 1) * G + c, u)) return false; u.part = i & 1; return true; }
};

__device__ __forceinline__ unsigned cvt_pk_bf16(float lo, float hi) { unsigned r; asm volatile("v_cvt_pk_bf16_f32 %0, %1, %2" : "=v"(r) : "v"(lo), "v"(hi)); return r; }

struct EpiProj {
    static constexpr bool PERM = true, INIT = false;
    bf16_t *Q, *KV, *U, *BR, *GN, *GL, *MG;
    __device__ __forceinline__ void operator()(const f32x4 (&acc)[2][2][4][2], const Unit& u, int wr, int wc, int fr, int fq) const {
        const int pn = u.pn; bf16_t* base; int ldc, colt, act = 0;
        if (pn < 2) { base = Q; ldc = 512; colt = pn * 256; }
        else if (pn < 5) { base = KV; ldc = 768; colt = (pn - 2) * 256; }
        else if (pn < 7) { base = U; ldc = 512; colt = (pn - 5) * 256; }
        else if (pn < 8) { base = BR; ldc = 256; colt = 0; }
        else if (pn < 10) { base = GN; ldc = 512; colt = (pn - 8) * 256; act = 1; }
        else if (pn < 12) { base = GL; ldc = 512; colt = (pn - 10) * 256; act = 1; }
        else { base = MG; ldc = 2048; colt = (pn - 12) * 256; act = 2; }
        const int row0 = u.pm * BM + wr * 64 + fr, col0 = colt + wc * 32 + 8 * fq;
#pragma unroll
        for (int ai = 0; ai < 2; ++ai)
#pragma unroll
            for (int m = 0; m < 4; ++m) { bf16_t* rowp = base + (size_t)(row0 + ai * HALF + m * 16) * ldc + col0;
#pragma unroll
                for (int bj = 0; bj < 2; ++bj) { f32x4 v0 = acc[ai][bj][m][0], v1 = acc[ai][bj][m][1];
                    if (act) {
#pragma unroll
                        for (int e = 0; e < 4; ++e) { const float s0 = fsigmoid(v0[e]), s1 = fsigmoid(v1[e]); v0[e] = (act == 1) ? v0[e] * s0 : s0; v1[e] = (act == 1) ? v1[e] * s1 : s1; } }
                    u32x4 w; w.x = cvt_pk_bf16(v0[0], v0[1]); w.y = cvt_pk_bf16(v0[2], v0[3]); w.z = cvt_pk_bf16(v1[0], v1[1]); w.w = cvt_pk_bf16(v1[2], v1[3]);
                    *(u32x4*)(rowp + bj * HALF) = w; } }
    }
};
struct EpiMerge {
    static constexpr bool PERM = true, INIT = false;
    bf16_t* Mb; const bf16_t* MG;
    __device__ __forceinline__ void operator()(const f32x4 (&acc)[2][2][4][2], const Unit& u, int wr, int wc, int fr, int fq) const {
        const int row0 = u.pm * BM + wr * 64 + fr, col0 = u.pn * BM + wc * 32 + 8 * fq;
#pragma unroll
        for (int ai = 0; ai < 2; ++ai)
#pragma unroll
            for (int m = 0; m < 4; ++m) { const size_t r = (size_t)(row0 + ai * HALF + m * 16);
#pragma unroll
                for (int bj = 0; bj < 2; ++bj) { const f32x4 v0 = acc[ai][bj][m][0], v1 = acc[ai][bj][m][1];
                    const u32x4 gw = *(const u32x4*)(MG + r * 2048 + u.part * 1024 + col0 + bj * HALF);
                    float o[8] = {v0[0] * bflo(gw.x), v0[1] * bfhi(gw.x), v0[2] * bflo(gw.y), v0[3] * bfhi(gw.y), v1[0] * bflo(gw.z), v1[1] * bfhi(gw.z), v1[2] * bflo(gw.w), v1[3] * bfhi(gw.w)};
                    bf16_t* dst = Mb + r * 1024 + col0 + bj * HALF;
                    if (u.part) { const u32x4 pw = *(const u32x4*)dst;
                        o[0] += bflo(pw.x); o[1] += bfhi(pw.x); o[2] += bflo(pw.y); o[3] += bfhi(pw.y); o[4] += bflo(pw.z); o[5] += bfhi(pw.z); o[6] += bflo(pw.w); o[7] += bfhi(pw.w); }
                    u32x4 w; w.x = cvt_pk_bf16(o[0], o[1]); w.y = cvt_pk_bf16(o[2], o[3]); w.z = cvt_pk_bf16(o[4], o[5]); w.w = cvt_pk_bf16(o[6], o[7]);
                    *(u32x4*)dst = w; } }
    }
};
struct EpiOut {
    static constexpr bool PERM = false, INIT = true;
    const float* X; float* O;
    __device__ __forceinline__ void init(f32x4 (&acc)[2][2][4][2], const Unit& u, int wr, int wc, int fr, int fq) const {
        const int row0 = u.pm * BM + wr * 64 + fr, col0 = u.pn * BM + wc * 32 + 4 * fq;
#pragma unroll
        for (int ai = 0; ai < 2; ++ai)
#pragma unroll
            for (int m = 0; m < 4; ++m) { const size_t off = (size_t)(row0 + ai * HALF + m * 16) * 1024 + col0;
#pragma unroll
                for (int bj = 0; bj < 2; ++bj)
#pragma unroll
                    for (int n = 0; n < 2; ++n) acc[ai][bj][m][n] = *(const f32x4*)(X + off + bj * HALF + n * 16); }
    }
    __device__ __forceinline__ void operator()(const f32x4 (&acc)[2][2][4][2], const Unit& u, int wr, int wc, int fr, int fq) const {
        const int row0 = u.pm * BM + wr * 64 + fr, col0 = u.pn * BM + wc * 32 + 4 * fq;
#pragma unroll
        for (int ai = 0; ai < 2; ++ai)
#pragma unroll
            for (int m = 0; m < 4; ++m) { const size_t off = (size_t)(row0 + ai * HALF + m * 16) * 1024 + col0;
#pragma unroll
                for (int bj = 0; bj < 2; ++bj)
#pragma unroll
                    for (int n = 0; n < 2; ++n) *(f32x4*)(O + off + bj * HALF + n * 16) = acc[ai][bj][m][n]; }
    }
};

template <class Epi, class Sched, bool ALIGN_EPI>
__device__ __forceinline__ void gemm_phase(PG8_LAS unsigned char* lds, const Gemm g, const Sched& S, const Epi& E, int wid) {
    const int lane = lane_id(), tid = wid * 64 + lane, wr = wid >> 2, wc = wid & 3, fr = lane & 15, fq = lane >> 4;
    const int K = g.K, nt = K / BK;
    unsigned voffA[2], voffB[2];
#pragma unroll
    for (int i = 0; i < 2; ++i) { int R, C; stage_rc(tid * 16 + i * 8192, R, C); const int Rb = Epi::PERM ? ((R & ~31) + perm32(R & 31)) : R;
        voffA[i] = (unsigned)(R * g.lda + C) * 2u; voffB[i] = (unsigned)(Rb * g.ldb + C) * 2u; }
    const size_t kstep = (size_t)(BK * 2);
    const size_t hstepA = (size_t)HALF * g.lda * 2, hstepB = (size_t)HALF * g.ldb * 2;
    const size_t tstepA = 2 * hstepA, tstepB = 2 * hstepB;
    const unsigned ldsw = (unsigned)wid * 1024u;
    const int aoff = lds_byte(wr * 64 + fr, fq * 8), boff = lds_byte(wc * 32 + fr, fq * 8);
#define PG8_SA(b, h) (((b) * 2 + (h)) * HTB)
#define PG8_SB(b, h) ((4 + (b) * 2 + (h)) * HTB)
#define PG8_STAGE(bufoff, gbase, voff) do { _Pragma("unroll") for (int _i = 0; _i < 2; ++_i) \
        __builtin_amdgcn_global_load_lds((const unsigned*)((const char*)(gbase) + (voff)[_i]), (PG8_LAS unsigned*)(lds + (bufoff) + ldsw + _i * 8192), 16, 0, 0); } while (0)
#define PG8_LDA(dst, b, h) do { _Pragma("unroll") for (int m = 0; m < 4; ++m) _Pragma("unroll") for (int k = 0; k < 2; ++k) dst[m][k] = *(const PG8_LAS bf16x8*)(lds + PG8_SA(b, h) + aoff + m * 2048 + k * 1024); } while (0)
#define PG8_LDB(dst, b, h) do { _Pragma("unroll") for (int n = 0; n < 2; ++n) _Pragma("unroll") for (int k = 0; k < 2; ++k) dst[n][k] = *(const PG8_LAS bf16x8*)(lds + PG8_SB(b, h) + boff + n * 2048 + k * 1024); } while (0)
#define PG8_MMA(ai, bj, At, Bt) do { __builtin_amdgcn_s_setprio(1); _Pragma("unroll") for (int m = 0; m < 4; ++m) _Pragma("unroll") for (int n = 0; n < 2; ++n) _Pragma("unroll") for (int k = 0; k < 2; ++k) \
        acc[ai][bj][m][n] = __builtin_amdgcn_mfma_f32_16x16x32_bf16(Bt[n][k], At[m][k], acc[ai][bj][m][n], 0, 0, 0); __builtin_amdgcn_s_setprio(0); } while (0)
#define PG8_WAIT_V(n) asm volatile("s_waitcnt vmcnt(" #n ")" ::: "memory")
#define PG8_WAIT_L(n) asm volatile("s_waitcnt lgkmcnt(" #n ")" ::: "memory")
#define PG8_BAR __builtin_amdgcn_s_barrier()
#define PG8_SCHED __builtin_amdgcn_sched_barrier(0)
#define PG8_UA(u) ((const char*)((u).part ? g.A2 : g.A) + (size_t)(u).pm * tstepA)
#define PG8_UB(u) ((const char*)((u).part ? g.Bt2 : g.Bt) + (size_t)(u).pn * tstepB)
    Unit cur, nxt; int ui = 0;
    if (!S.next(0, cur)) return;
    f32x4 acc[2][2][4][2];
    if constexpr (Epi::INIT) E.init(acc, cur, wr, wc, fr, fq);
    else {
#pragma unroll
    for (int a = 0; a < 2; ++a)
#pragma unroll
        for (int b = 0; b < 2; ++b)
#pragma unroll
            for (int m = 0; m < 4; ++m)
#pragma unroll
                for (int n = 0; n < 2; ++n) acc[a][b][m][n] = (f32x4){0.f, 0.f, 0.f, 0.f};
    }
    bf16x8 At[4][2], B0[2][2], B1[2][2];
    const char* cA = PG8_UA(cur); const char* cB = PG8_UB(cur);
    PG8_STAGE(PG8_SB(0, 0), cB, voffB); PG8_STAGE(PG8_SB(0, 1), cB + hstepB, voffB); PG8_STAGE(PG8_SA(0, 0), cA, voffA); PG8_STAGE(PG8_SA(0, 1), cA + hstepA, voffA);
    if (wr == 1) PG8_BAR;
    PG8_WAIT_V(2); PG8_BAR;
    PG8_STAGE(PG8_SB(1, 0), cB + kstep, voffB); PG8_STAGE(PG8_SA(1, 0), cA + kstep, voffA); PG8_STAGE(PG8_SB(1, 1), cB + hstepB + kstep, voffB);
    PG8_WAIT_V(6); PG8_BAR;
    for (;;) {
        const bool has_next = S.next(ui + 1, nxt);
        const char* nA = has_next ? PG8_UA(nxt) : cA; const char* nB = has_next ? PG8_UB(nxt) : cB;
        for (int t = 0; t < nt; t += 2) {
            const bool last = (t == nt - 2);
            const char* a1 = cA + (size_t)(t + 1) * kstep;
            const char* a2 = last ? nA : cA + (size_t)(t + 2) * kstep; const char* b2 = last ? nB : cB + (size_t)(t + 2) * kstep;
            const char* a3 = a2 + kstep; const char* b3 = b2 + kstep;
            PG8_LDB(B0, 0, 0); PG8_LDB(B1, 0, 1); PG8_SCHED; PG8_LDA(At, 0, 0); PG8_STAGE(PG8_SA(1, 1), a1 + hstepA, voffA);
            PG8_WAIT_V(8); PG8_WAIT_L(0); PG8_BAR; PG8_MMA(0, 0, At, B0); PG8_MMA(0, 1, At, B1); PG8_BAR; PG8_SCHED;
            PG8_LDA(At, 0, 1); PG8_STAGE(PG8_SB(0, 0), b2, voffB); PG8_STAGE(PG8_SB(0, 1), b2 + hstepB, voffB); PG8_STAGE(PG8_SA(0, 0), a2, voffA);
            PG8_WAIT_V(8); PG8_WAIT_L(0); PG8_BAR; PG8_MMA(1, 0, At, B0); PG8_MMA(1, 1, At, B1); PG8_BAR; PG8_SCHED;
            PG8_LDB(B0, 1, 0); PG8_LDB(B1, 1, 1); PG8_SCHED; PG8_LDA(At, 1, 0); PG8_STAGE(PG8_SA(0, 1), a2 + hstepA, voffA);
            PG8_WAIT_V(8); PG8_WAIT_L(0); PG8_BAR; PG8_MMA(0, 0, At, B0); PG8_MMA(0, 1, At, B1); PG8_BAR; PG8_SCHED;
            PG8_LDA(At, 1, 1); PG8_STAGE(PG8_SB(1, 0), b3, voffB); PG8_STAGE(PG8_SB(1, 1), b3 + hstepB, voffB); PG8_STAGE(PG8_SA(1, 0), a3, voffA);
            PG8_WAIT_V(8); PG8_WAIT_L(0); PG8_BAR; PG8_MMA(1, 0, At, B0); PG8_MMA(1, 1, At, B1); PG8_BAR; PG8_SCHED;
        }
        if constexpr (ALIGN_EPI) { if (wr == 0) PG8_BAR; }
        E(acc, cur, wr, wc, fr, fq);
        if (!has_next) break;
        if constexpr (Epi::INIT) E.init(acc, nxt, wr, wc, fr, fq);
        else {
#pragma unroll
        for (int a = 0; a < 2; ++a)
#pragma unroll
            for (int b = 0; b < 2; ++b)
#pragma unroll
                for (int m = 0; m < 4; ++m)
#pragma unroll
                    for (int n = 0; n < 2; ++n) acc[a][b][m][n] = (f32x4){0.f, 0.f, 0.f, 0.f};
        }
        cur = nxt; cA = nA; cB = nB; ++ui;
        if constexpr (ALIGN_EPI) { if (wr == 1) PG8_BAR; }
    }
    PG8_WAIT_V(0);
    if constexpr (!ALIGN_EPI) { if (wr == 0) PG8_BAR; }
    PG8_BAR;
#undef PG8_SA
#undef PG8_SB
#undef PG8_STAGE
#undef PG8_LDA
#undef PG8_LDB
#undef PG8_MMA
#undef PG8_WAIT_V
#undef PG8_WAIT_L
#undef PG8_BAR
#undef PG8_SCHED
#undef PG8_UA
#undef PG8_UB
}
}

constexpr int NWAVES = 8;
constexpr int N_LAUNCHES = MK_N_LAUNCHES;
constexpr int PER_PHASE = 6;
constexpr size_t MiB = 1u << 20;
constexpr size_t WS_CTL = 0, CTL_ZERO_BYTES = 65536;
constexpr size_t WS_WIN = 1 * MiB;
constexpr size_t WS_WA = 11 * MiB;
constexpr size_t WS_WB = 12 * MiB;
constexpr size_t WS_WOUT = 13 * MiB;
constexpr size_t WS_W1T = 15 * MiB;
constexpr size_t WS_SMALL = 17 * MiB;
constexpr size_t WS_SUM = 18 * MiB;
constexpr size_t WS_KC = 19 * MiB;
constexpr size_t WS_XN = 20 * MiB;
constexpr size_t WS_Q = 52 * MiB;
constexpr size_t WS_KV = 68 * MiB;
constexpr size_t WS_MB = 52 * MiB;
constexpr size_t WS_U = 92 * MiB;
constexpr size_t WS_BR = 108 * MiB;
constexpr size_t WS_GN = 116 * MiB;
constexpr size_t WS_GL = 132 * MiB;
constexpr size_t WS_MG = 148 * MiB;
constexpr size_t WS_VT = 212 * MiB;
constexpr size_t WS_KT = 216 * MiB;
constexpr size_t WS_Q2 = 220 * MiB;
constexpr size_t WS_LB = 236 * MiB;
constexpr size_t WS_END = 252 * MiB;
constexpr size_t SM_W2T = 0;
constexpr size_t SM_LWA = 65536;
constexpr size_t SM_LWX = 131072;
constexpr size_t SM_C1 = 262144;
constexpr size_t SM_LUT = 200704;
constexpr int CW_BAR = 4096;

constexpr int RING_BYTES = 160768;
constexpr int LDSCTL_OFF = RING_BYTES, MISC_OFF = LDSCTL_OFF + 320;
constexpr int LDS_BYTES = 163840;

#define RLX_AGENT __ATOMIC_RELAXED, __HIP_MEMORY_SCOPE_AGENT
#define LDS_WAIT() asm volatile("s_waitcnt lgkmcnt(0)" ::: "memory")
#define VM_WAIT() asm volatile("s_waitcnt vmcnt(0)" ::: "memory")

#define XB_TMO      128
#define XB_XCNT(j)  (256  + 64 * (j))
#define XB_XSUB(j)  (1280 + 64 * (j))
#define XB_XGEN(j)  (2304 + 64 * (j))
#define XB_TOP      3328
#define XB_TOPGEN   3392
#define XCD_BAR_WORDS 3456
#define XB_SPIN_CAP (1u << 18)
__device__ __forceinline__ unsigned xb_ld(unsigned* p)              { return __hip_atomic_load(p, __ATOMIC_RELAXED, __HIP_MEMORY_SCOPE_AGENT); }
__device__ __forceinline__ unsigned xb_add(unsigned* p, unsigned v) { return __hip_atomic_fetch_add(p, v, __ATOMIC_RELAXED, __HIP_MEMORY_SCOPE_AGENT); }
__device__ __forceinline__ unsigned xb_xcc_id() { return (unsigned)__builtin_amdgcn_s_getreg((3 << 11) | 20) & 0xFu; }
#define XB_SPIN(cond, bar) do { unsigned _sp = 0; while (cond) { __builtin_amdgcn_s_sleep(1); \
    if ((++_sp & 255u) == 0u) { if (xb_ld(&(bar)[XB_TMO])) break; if (_sp > XB_SPIN_CAP) { atomicAdd(&(bar)[XB_TMO], 1u); break; } } } } while (0)
struct XcdBarrier { unsigned* bar; unsigned x; volatile LAS unsigned* st; };
__device__ __forceinline__ XcdBarrier xcd_barrier_post(unsigned* bar, volatile LAS unsigned* st) {
    XcdBarrier b; b.bar = bar; b.x = xb_xcc_id(); b.st = st;
    if (threadIdx.x == 0) (void)xb_add(&bar[XB_XCNT(b.x)], 1u);
    return b;
}
__device__ __forceinline__ void xcd_barrier_complete(unsigned* bar, unsigned x, unsigned& nloc, unsigned& nx) {
    const unsigned G = gridDim.x * gridDim.y * gridDim.z;
    unsigned sum, cnt, mine, sp = 0u;
    for (;;) {
        sum = 0u; cnt = 0u; mine = 0u;
#pragma unroll
        for (unsigned j = 0; j < 16; ++j) { const unsigned c = xb_ld(&bar[XB_XCNT(j)]); sum += c; cnt += (c > 0u) ? 1u : 0u; mine = (j == x) ? c : mine; }
        if (sum == G) break;
        __builtin_amdgcn_s_sleep(1);
        if ((++sp & 255u) == 0u) { if (xb_ld(&bar[XB_TMO])) break; if (sp > XB_SPIN_CAP) { atomicAdd(&bar[XB_TMO], 1u); break; } }
    }
    nloc = mine > 0u ? mine : 1u; nx = cnt > 0u ? cnt : 1u;
}
__device__ __forceinline__ void xcd_barrier(const XcdBarrier& b) {
    asm volatile("s_waitcnt vmcnt(0)" ::: "memory");
    __syncthreads();
    if (threadIdx.x == 0) {
        unsigned* bar = b.bar;
        __builtin_amdgcn_s_waitcnt(0);
        unsigned nloc = b.st[0], nx = b.st[1];
        if (nloc == 0u) { xcd_barrier_complete(bar, b.x, nloc, nx); b.st[0] = nloc; b.st[1] = nx; }
        const unsigned old = xb_add(&bar[XB_XSUB(b.x)], 1u);
        const unsigned gen = old / nloc;
        if (old + 1u == (gen + 1u) * nloc) {
            __builtin_amdgcn_fence(__ATOMIC_RELEASE, "agent");
            asm volatile("s_waitcnt vmcnt(0)" ::: "memory");
            const unsigned og = xb_add(&bar[XB_TOP], 1u);
            const unsigned tg = og / nx;
            if (og + 1u == (tg + 1u) * nx) xb_add(&bar[XB_TOPGEN], 1u);
            else XB_SPIN(xb_ld(&bar[XB_TOPGEN]) == tg, bar);
            __builtin_amdgcn_fence(__ATOMIC_ACQUIRE, "agent");
            xb_add(&bar[XB_XGEN(b.x)], 1u);
            asm volatile("s_waitcnt vmcnt(0)" ::: "memory");
        } else {
            XB_SPIN(xb_ld(&bar[XB_XGEN(b.x)]) == gen, bar);
            __builtin_amdgcn_fence(__ATOMIC_ACQUIRE, "agent");
            asm volatile("s_waitcnt vmcnt(0)" ::: "memory");
        }
    }
    __syncthreads();
}

struct Args { const float* in[20]; float* out; unsigned char* ws; int ph_lo, ph_hi, li, pad; };
struct Frame {
    LAS unsigned char* lds;
    volatile LAS unsigned* MISC;
    int wave;
    int vcu, G;
    unsigned char* ws;
#define WSP(name, T, off) __device__ __forceinline__ T* name() const { return (T*)(ws + (off)); }
    WSP(WinT, bf16, WS_WIN) WSP(WaT, bf16, WS_WA) WSP(WbT, bf16, WS_WB) WSP(WoutT, bf16, WS_WOUT) WSP(W1T, bf16, WS_W1T)
    WSP(W2T, bf16, WS_SMALL + SM_W2T) WSP(LWA, bf16, WS_SMALL + SM_LWA) WSP(LWX, bf16, WS_SMALL + SM_LWX)
    WSP(C1, float, WS_SMALL + SM_C1) WSP(LUT, float, WS_SMALL + SM_LUT) WSP(SUMA, float, WS_SUM) WSP(SUMB, float, WS_SUM + 524288)
    WSP(KC, bf16, WS_KC) WSP(VC, bf16, WS_KC + 524288) WSP(XN, bf16, WS_XN) WSP(Q, bf16, WS_Q) WSP(KV, bf16, WS_KV) WSP(MB, bf16, WS_MB)
    WSP(VT, bf16, WS_VT) WSP(KT, bf16, WS_KT) WSP(Q2, bf16, WS_Q2) WSP(LB, bf16, WS_LB) WSP(U, bf16, WS_U) WSP(BR, bf16, WS_BR) WSP(GN, bf16, WS_GN) WSP(GL, bf16, WS_GL) WSP(MG, bf16, WS_MG)
#undef WSP
};

__device__ __forceinline__ int t5_bucket(int n) {
    if (n < 16) return n;
    const int thr[15] = {19, 21, 24, 27, 31, 35, 40, 46, 52, 59, 67, 77, 87, 99, 113};
    int b = 16;
#pragma unroll
    for (int i = 0; i < 15; ++i) b += (n >= thr[i]) ? 1 : 0;
    return b;
}

__device__ __forceinline__ void p0_tr_item(const float* W, int ldw, int k0, int srccol0, int nvalid, bf16* WT, int ldt, int dstrow0, LAS float* scr, int lane) {
    const int c = lane & 31;
    float tv[32];
#pragma unroll
    for (int i = 0; i < 32; ++i) { const int kk = 2 * i + (lane >> 5); tv[i] = (c < nvalid) ? W[(size_t)(k0 + kk) * ldw + srccol0 + c] : 0.f; }
#pragma unroll
    for (int i = 0; i < 32; ++i) { const int kk = 2 * i + (lane >> 5); scr[kk * 33 + c] = tv[i]; }
    LDS_WAIT(); asm volatile("" ::: "memory");
    const int cc = lane & 7;
#pragma unroll
    for (int j = 0; j < 4; ++j) { const int n = (lane >> 3) + 8 * j; const LAS float* s = scr + (8 * cc) * 33 + n;
        u32x4 o; o.x = pk2(s[0 * 33], s[1 * 33]); o.y = pk2(s[2 * 33], s[3 * 33]); o.z = pk2(s[4 * 33], s[5 * 33]); o.w = pk2(s[6 * 33], s[7 * 33]);
        *(u32x4*)(WT + (size_t)(dstrow0 + n) * ldt + k0 + 8 * cc) = o; }
    LDS_WAIT(); asm volatile("" ::: "memory");
}
__device__ __forceinline__ void win_src(int n0, int& src, int& nvalid) {
    nvalid = 32;
    if (n0 < 1280) src = n0;
    else if (n0 < 1792) src = 1816 + (n0 - 1280);
    else if (n0 < 2048) { src = 1792 + (n0 - 1792); nvalid = (n0 == 1792) ? 24 : 0; if (n0 != 1792) src = 0; }
    else if (n0 < 2560) src = 1280 + (n0 - 2048);
    else if (n0 < 3072) src = 2328 + (n0 - 2560);
    else src = 2840 + (n0 - 3072);
}
__device__ __forceinline__ void p0_prologue(const Frame& F, const Args& A) {
    LAS float* scr = (LAS float*)(F.lds + F.wave * 16384);
    const int gw = F.vcu * NWAVES + F.wave, NGW = F.G * NWAVES, lane = lane_id();
    constexpr int I_WIN = 16 * 160, I_WA = 8 * 32, I_WO = 16 * 32, I_W1 = 32 * 8, I_W2 = 4 * 2, I_LR = 2;
    constexpr int NIT = I_WIN + 2 * I_WA + I_WO + 2 * I_W1 + 2 * I_W2 + 16 * I_LR + 256 + 1;
    for (int it = gw; it < NIT; it += NGW) {
        int r = it;
        if (r < I_WIN) { const int kb = r / 160, nb = r % 160; int src, nv; win_src(32 * nb, src, nv); p0_tr_item(A.in[2], 4888, 64 * kb, src, nv, F.WinT(), 1024, 32 * nb, scr, lane); continue; } r -= I_WIN;
        if (r < I_WA) { p0_tr_item(A.in[17], 1024, 64 * (r / 32), 32 * (r % 32), 32, F.WaT(), 512, 32 * (r % 32), scr, lane); continue; } r -= I_WA;
        if (r < I_WA) { p0_tr_item(A.in[18], 1024, 64 * (r / 32), 32 * (r % 32), 32, F.WbT(), 512, 32 * (r % 32), scr, lane); continue; } r -= I_WA;
        if (r < I_WO) { p0_tr_item(A.in[19], 1024, 64 * (r / 32), 32 * (r % 32), 32, F.WoutT(), 1024, 32 * (r % 32), scr, lane); continue; } r -= I_WO;
        if (r < 2 * I_W1) { const int kv = r / I_W1, q = r % I_W1; p0_tr_item(A.in[6] + (size_t)kv * 2048 * 256, 256, 64 * (q / 8), 32 * (q % 8), 32, F.W1T() + (size_t)kv * 256 * 2048, 2048, 32 * (q % 8), scr, lane); continue; } r -= 2 * I_W1;
        if (r < 2 * I_W2) { const int kv = r / I_W2, q = r % I_W2; p0_tr_item(A.in[8] + (size_t)kv * 256 * 64, 64, 64 * (q / 2), 32 * (q % 2), 32, F.W2T() + (size_t)kv * 64 * 256, 256, 32 * (q % 2), scr, lane); continue; } r -= 2 * I_W2;
        if (r < 16 * I_LR) { const int mtx = r / 2, nb = r % 2; const float* src = (mtx < 8 ? A.in[12] : A.in[14]) + (size_t)(mtx & 7) * 4096; bf16* dst = (mtx < 8 ? F.LWA() : F.LWX()) + (size_t)(mtx & 7) * 4096;
            p0_tr_item(src, 64, 0, 32 * nb, 32, dst, 64, 32 * nb, scr, lane); continue; } r -= 16 * I_LR;
        if (r < 256) {
            const int kc = r >> 3, kv = (r >> 2) & 1, n = (r & 3) * 64 + lane; const float* w1 = A.in[6] + (size_t)kv * 2048 * 256 + (size_t)(64 * kc) * 256 + n; const float* pe = A.in[5] + kv * 2048 + 64 * kc;
            float s0 = 0.f, s1 = 0.f, s2 = 0.f, s3 = 0.f;
#pragma unroll 4
            for (int k = 0; k < 64; k += 4) { s0 += pe[k] * w1[(size_t)k * 256]; s1 += pe[k + 1] * w1[(size_t)(k + 1) * 256]; s2 += pe[k + 2] * w1[(size_t)(k + 2) * 256]; s3 += pe[k + 3] * w1[(size_t)(k + 3) * 256]; }
            F.C1()[(kc * 2 + kv) * 256 + n] = (s0 + s1) + (s2 + s3); continue; } r -= 256;
        {
            for (int e = lane; e < 1024; e += 64) { const int hd = e >> 7, n = e & 127; F.LUT()[e] = A.in[9][t5_bucket(n) * 8 + hd] * LOG2E; }
        }
    }
    const float* gain = A.in[1];
    {
        f32x4 v[4], vn[4];
        if (gw < SEQ) { const f32x4* xr = (const f32x4*)(A.in[0] + (size_t)gw * DM) + lane;
#pragma unroll
            for (int j = 0; j < 4; ++j) v[j] = xr[64 * j]; }
        for (int m = gw; m < SEQ; m += NGW) {
            if (m + NGW < SEQ) { const f32x4* xr = (const f32x4*)(A.in[0] + (size_t)(m + NGW) * DM) + lane;
#pragma unroll
                for (int j = 0; j < 4; ++j) vn[j] = xr[64 * j]; }
            float s = 0.f;
#pragma unroll
            for (int j = 0; j < 4; ++j) s += (v[j].x * v[j].x + v[j].y * v[j].y) + (v[j].z * v[j].z + v[j].w * v[j].w);
            const float rs = 1.0f / sqrtf(wave_sum(s) * (1.f / DM) + RMS_EPS);
            unsigned long long* o8 = (unsigned long long*)(F.XN() + (size_t)m * DM) + lane;
#pragma unroll
            for (int j = 0; j < 4; ++j) { const f32x4 gv = ((const f32x4*)gain)[lane + 64 * j];
                o8[64 * j] = (unsigned long long)pk2(v[j].x * rs * gv.x, v[j].y * rs * gv.y) | ((unsigned long long)pk2(v[j].z * rs * gv.z, v[j].w * rs * gv.w) << 32); }
#pragma unroll
            for (int j = 0; j < 4; ++j) v[j] = vn[j];
        }
    }
}

template <bool FINAL>
__device__ __forceinline__ void lru_tile(const Frame& F, const Args& A, int tt) {
    const int lane = lane_id();
    const int w = F.wave, fr = lane & 15, fq = lane >> 4, ch0 = 64 * w, t0 = 64 * tt;
    LAS float* UC = (LAS float*)(F.lds + w * 16384);
#define UC_IDX(tok, ch) ((tok) * 64 + ((((ch) >> 2) ^ ((tok) & 15)) << 2) + ((ch) & 3))
    float Hc = 0.f;
    if (FINAL) {
        const float* sa = F.SUMA() + ch0 + lane; const float* sb = F.SUMB() + ch0 + lane;
        int i = 0;
        for (; i + 64 <= tt; i += 64) { float ta[64], tb[64];
#pragma unroll
            for (int k = 0; k < 64; ++k) { ta[k] = sa[(size_t)(i + k) * 512]; tb[k] = sb[(size_t)(i + k) * 512]; }
#pragma unroll
            for (int k = 0; k < 64; ++k) Hc = ta[k] * Hc + tb[k]; }
        for (; i + 16 <= tt; i += 16) { float ta[16], tb[16];
#pragma unroll
            for (int k = 0; k < 16; ++k) { ta[k] = sa[(size_t)(i + k) * 512]; tb[k] = sb[(size_t)(i + k) * 512]; }
#pragma unroll
            for (int k = 0; k < 16; ++k) Hc = ta[k] * Hc + tb[k]; }
        for (; i < tt; ++i) Hc = sa[(size_t)i * 512] * Hc + sb[(size_t)i * 512];
        asm volatile("" : "+v"(Hc));
    }
    {
        const int ch = ch0 + lane; const float* cw = A.in[10]; const float cb = A.in[11][ch];
        const float w0 = cw[ch], w1 = cw[512 + ch], w2 = cw[1024 + ch], w3 = cw[1536 + ch];
        const bf16* up = F.U() + (size_t)t0 * 512 + ch;
        float u0 = 0.f, u1 = 0.f, u2 = 0.f;
        if (tt > 0) { u0 = bf2f(up[-3 * 512]); u1 = bf2f(up[-2 * 512]); u2 = bf2f(up[-1 * 512]); }
        unsigned short ur[64];
#pragma unroll
        for (int tok = 0; tok < 64; ++tok) ur[tok] = up[(size_t)tok * 512];
#pragma unroll
        for (int tok = 0; tok < 64; ++tok) { const float u3 = bf2f(ur[tok]);
            UC[UC_IDX(tok, lane)] = cb + ((u0 * w0 + u1 * w1) + (u2 * w2 + u3 * w3)); u0 = u1; u1 = u2; u2 = u3; }
    }
    bf16x8 Ba[4][2], Bx[4][2];
#pragma unroll
    for (int nt = 0; nt < 4; ++nt)
#pragma unroll
        for (int ks = 0; ks < 2; ++ks) { const size_t o = (size_t)w * 4096 + (16 * nt + fr) * 64 + 32 * ks + 8 * fq; Ba[nt][ks] = *(const bf16x8*)(F.LWA() + o); Bx[nt][ks] = *(const bf16x8*)(F.LWX() + o); }
    float ba[4], bx[4], sp8[4], hin[4], acum[4];
#pragma unroll
    for (int nt = 0; nt < 4; ++nt) { const int ch = ch0 + 16 * nt + fr; ba[nt] = A.in[13][ch]; bx[nt] = A.in[15][ch];
        sp8[nt] = 8.0f * log1pf(expf(-A.in[16][ch])); hin[nt] = 0.f; acum[nt] = 1.f; }
    if (FINAL) {
#pragma unroll
        for (int nt = 0; nt < 4; ++nt) hin[nt] = __shfl(Hc, 16 * nt + fr);
    }
    LDS_WAIT();
    unsigned short glv[16], gln[16];
    if (FINAL) {
#pragma unroll
        for (int nt = 0; nt < 4; ++nt)
#pragma unroll
            for (int rg = 0; rg < 4; ++rg) glv[nt * 4 + rg] = F.GL()[(size_t)(t0 + 4 * fq + rg) * 512 + ch0 + 16 * nt + fr];
    }
#pragma unroll 1
    for (int mt = 0; mt < 4; ++mt) {
        if (FINAL && mt < 3) {
#pragma unroll
            for (int nt = 0; nt < 4; ++nt)
#pragma unroll
                for (int rg = 0; rg < 4; ++rg) gln[nt * 4 + rg] = F.GL()[(size_t)(t0 + 16 * (mt + 1) + 4 * fq + rg) * 512 + ch0 + 16 * nt + fr];
        }
        bf16x8 Af[2];
#pragma unroll
        for (int ks = 0; ks < 2; ++ks) { const int tok = 16 * mt + fr, c0 = 8 * ks + 2 * fq;
            const f32x4 x0 = *(const LAS f32x4*)(UC + tok * 64 + ((c0 ^ (tok & 15)) << 2)), x1 = *(const LAS f32x4*)(UC + tok * 64 + (((c0 + 1) ^ (tok & 15)) << 2));
            u32x4 pw; pw.x = cvtpk(x0[0], x0[1]); pw.y = cvtpk(x0[2], x0[3]); pw.z = cvtpk(x1[0], x1[1]); pw.w = cvtpk(x1[2], x1[3]); Af[ks] = __builtin_bit_cast(bf16x8, pw); }
        f32x4 cr[4], ci[4];
#pragma unroll
        for (int nt = 0; nt < 4; ++nt) { cr[nt] = (f32x4){0.f, 0.f, 0.f, 0.f}; ci[nt] = (f32x4){0.f, 0.f, 0.f, 0.f};
#pragma unroll
            for (int ks = 0; ks < 2; ++ks) { cr[nt] = __builtin_amdgcn_mfma_f32_16x16x32_bf16(Af[ks], Ba[nt][ks], cr[nt], 0, 0, 0); ci[nt] = __builtin_amdgcn_mfma_f32_16x16x32_bf16(Af[ks], Bx[nt][ks], ci[nt], 0, 0, 0); } }
#pragma unroll
        for (int nt = 0; nt < 4; ++nt) {
            float P[4], Hh[4];
#pragma unroll
            for (int rg = 0; rg < 4; ++rg) { const int tok = 16 * mt + 4 * fq + rg, e = 16 * nt + fr;
                const float ucv = UC[UC_IDX(tok, e)];
                const float r = fsigmoid(cr[nt][rg] + ba[nt]), ig = fsigmoid(ci[nt][rg] + bx[nt]);
                const float la = -r * sp8[nt]; const float a = __builtin_amdgcn_exp2f(la * LOG2E);
                const float x2 = 2.0f * la;
                const float ser = -x2 * (1.0f + x2 * (0.5f + x2 * (0.16666667f + x2 * (0.041666668f + x2 * 0.008333334f))));
                const float om = (x2 > -0.25f) ? ser : 1.0f - a * a;
                const float b = __builtin_amdgcn_sqrtf(om) * (ig * ucv);
                if (!FINAL) {
                    const float so = -la * (1.0f + la * (0.5f + la * (0.16666667f + la * (0.041666668f + la * 0.008333334f))));
                    const float oma = (la > -0.25f) ? so : 1.0f - a; const size_t tg = (size_t)(t0 + tok); const int chg = ch0 + e;
                    F.XN()[tg * 1024 + 512 + chg] = (bf16)f2bf(oma); F.LB()[tg * 512 + chg] = (bf16)f2bf(b); }
                if (rg == 0) { P[0] = a; Hh[0] = b; } else { P[rg] = P[rg - 1] * a; Hh[rg] = a * Hh[rg - 1] + b; } }
            float At = P[3], Bt = Hh[3];
            { const float Ap = __shfl_up(At, 16), Bp = __shfl_up(Bt, 16); if (fq >= 1) { Bt = At * Bp + Bt; At = Ap * At; } }
            { const float Ap = __shfl_up(At, 32), Bp = __shfl_up(Bt, 32); if (fq >= 2) { Bt = At * Bp + Bt; At = Ap * At; } }
            float Aex = __shfl_up(At, 16), Bex = __shfl_up(Bt, 16); if (fq == 0) { Aex = 1.f; Bex = 0.f; }
            const float hg = Aex * hin[nt] + Bex;
            float hv[4];
#pragma unroll
            for (int rg = 0; rg < 4; ++rg) hv[rg] = P[rg] * hg + Hh[rg];
            hin[nt] = __shfl(hv[3], 48 + fr);
            if (!FINAL) acum[nt] *= __shfl(At, 48 + fr);
            if (FINAL) {
#pragma unroll
                for (int rg = 0; rg < 4; ++rg) { const size_t t = (size_t)(t0 + 16 * mt + 4 * fq + rg); const int ch = ch0 + 16 * nt + fr;
                    F.XN()[t * 1024 + 512 + ch] = (bf16)f2bf(hv[rg] * bf2f(glv[nt * 4 + rg])); }
            }
        }
        if (FINAL) {
#pragma unroll
            for (int x = 0; x < 16; ++x) glv[x] = gln[x];
        }
    }
    if (!FINAL && fq == 0) {
#pragma unroll
        for (int nt = 0; nt < 4; ++nt) { F.SUMA()[(size_t)tt * 512 + ch0 + 16 * nt + fr] = acum[nt]; F.SUMB()[(size_t)tt * 512 + ch0 + 16 * nt + fr] = hin[nt]; }
    }
    LDS_WAIT();
#undef UC_IDX
}

__device__ __forceinline__ void lru_apply(const Frame& F, int tt) {
    const int lane = lane_id(), ch = 64 * F.wave + lane, t0 = 64 * tt;
    float H = 0.f;
    { const float* sa = F.SUMA() + ch; const float* sb = F.SUMB() + ch; int i = 0;
        for (; i + 64 <= tt; i += 64) { float ta[64], tb[64];
#pragma unroll
            for (int k = 0; k < 64; ++k) { ta[k] = sa[(size_t)(i + k) * 512]; tb[k] = sb[(size_t)(i + k) * 512]; }
#pragma unroll
            for (int k = 0; k < 64; ++k) H = ta[k] * H + tb[k]; }
        for (; i + 16 <= tt; i += 16) { float ta[16], tb[16];
#pragma unroll
            for (int k = 0; k < 16; ++k) { ta[k] = sa[(size_t)(i + k) * 512]; tb[k] = sb[(size_t)(i + k) * 512]; }
#pragma unroll
            for (int k = 0; k < 16; ++k) H = ta[k] * H + tb[k]; }
        for (; i < tt; ++i) H = sa[(size_t)i * 512] * H + sb[(size_t)i * 512]; }
    bf16* px = F.XN() + (size_t)t0 * 1024 + 512 + ch; const bf16* pb = F.LB() + (size_t)t0 * 512 + ch; const bf16* pg = F.GL() + (size_t)t0 * 512 + ch;
#pragma unroll 1
    for (int c = 0; c < 2; ++c) { unsigned short av[32], bv[32], gv[32];
#pragma unroll
        for (int k = 0; k < 32; ++k) { const size_t tk = (size_t)(32 * c + k); av[k] = px[tk * 1024]; bv[k] = pb[tk * 512]; gv[k] = pg[tk * 512]; }
#pragma unroll
        for (int k = 0; k < 32; ++k) { H = (1.0f - bf2f(av[k])) * H + bf2f(bv[k]); px[(size_t)(32 * c + k) * 1024] = (bf16)f2bf(H * bf2f(gv[k])); } }
}

__device__ __forceinline__ void qk_norm_tile(const Frame& F, const Args& A, int tt) {
    const int lane = lane_id(), sub = lane & 7;
#pragma unroll 4
    for (int it = 0; it < 12; ++it) {
        const int idx = it * 64 + F.wave * 8 + (lane >> 3), tok = idx / 12, hr = idx % 12; const size_t t = (size_t)(64 * tt + tok);
        bf16* p; bf16* dst; const float* gain; float sc = 1.f;
        if (hr < 8) { p = F.Q() + t * 512 + hr * 64; dst = F.Q2() + t * 512 + (hr >> 2) * 256 + (sub >> 1) * 64 + (hr & 3) * 16 + (sub & 1) * 8 - sub * 8; gain = A.in[3]; sc = 0.125f * LOG2E; }
        else if (hr < 10) { p = F.KV() + t * 768 + 256 + (hr - 8) * 64; dst = p; gain = A.in[4] + 64; }
        else { p = F.KV() + t * 768 + 512 + (hr - 10) * 64; dst = p; gain = A.in[4] + 128; }
        const u32x4 w = *(const u32x4*)(p + sub * 8);
        float x[8] = {bflo(w.x), bfhi(w.x), bflo(w.y), bfhi(w.y), bflo(w.z), bfhi(w.z), bflo(w.w), bfhi(w.w)};
        float ss = 0.f;
#pragma unroll
        for (int j = 0; j < 8; ++j) ss += x[j] * x[j];
        ss += __shfl_xor(ss, 1); ss += __shfl_xor(ss, 2); ss += __shfl_xor(ss, 4);
        const float rs = sc / sqrtf(ss * (1.f / 64.f) + RMS_EPS);
        const f32x4 g0 = *(const f32x4*)(gain + sub * 8), g1 = *(const f32x4*)(gain + sub * 8 + 4);
        u32x4 o; o.x = pk2(x[0] * rs * g0.x, x[1] * rs * g0.y); o.y = pk2(x[2] * rs * g0.z, x[3] * rs * g0.w); o.z = pk2(x[4] * rs * g1.x, x[5] * rs * g1.y); o.w = pk2(x[6] * rs * g1.z, x[7] * rs * g1.w);
        *(u32x4*)(dst + sub * 8) = o;
        if (hr >= 8 && hr < 10) {
            int w0 = __builtin_amdgcn_cvt_pk_fp8_f32(x[0] * rs * g0.x, x[1] * rs * g0.y, 0, false); w0 = __builtin_amdgcn_cvt_pk_fp8_f32(x[2] * rs * g0.z, x[3] * rs * g0.w, w0, true);
            int w1 = __builtin_amdgcn_cvt_pk_fp8_f32(x[4] * rs * g1.x, x[5] * rs * g1.y, 0, false); w1 = __builtin_amdgcn_cvt_pk_fp8_f32(x[6] * rs * g1.z, x[7] * rs * g1.w, w1, true);
            u32x2* kt8 = (u32x2*)F.KT() + (size_t)((hr - 8) * 256 + tt) * 512 + ((((sub >> 2) * 4 + (tok >> 4)) * 4 + (sub & 3)) * 16 + (tok & 15));
            *kt8 = (u32x2){(unsigned)w0, (unsigned)w1}; }
    }
}

__device__ __forceinline__ void vt_tile(const Frame& F, int J) {
    const int tid = F.wave * 64 + lane_id(), d = tid & 63, ks = (tid >> 6) & 1, gp = tid >> 7;
#pragma unroll
    for (int g = 0; g < 2; ++g) {
        const bf16* vp = F.KV() + (size_t)(64 * J) * 768 + 384 + 64 * g + d;
        unsigned short e[8];
#pragma unroll
        for (int j = 0; j < 8; ++j) { const int key = 32 * ks + 4 * gp + (j & 3) + 16 * (j >> 2); e[j] = vp[(size_t)key * 768]; }
        u32x4 w; w.x = e[0] | ((unsigned)e[1] << 16); w.y = e[2] | ((unsigned)e[3] << 16); w.z = e[4] | ((unsigned)e[5] << 16); w.w = e[6] | ((unsigned)e[7] << 16);
        *(u32x4*)(F.VT() + (size_t)(g * 256 + J) * 4096 + ((((d >> 4) * 2 + ks) * 16 + (d & 15)) * 32) + 8 * gp) = w;
    }
}

__device__ __forceinline__ void compress_item(const Frame& F, const Args& A, int kv, int g, int ct) {
    const int lane = lane_id(), w = F.wave, tid = w * 64 + lane, fr = lane & 15, fq = lane >> 4, c0 = 16 * ct, tb = 16 * c0;
    LAS unsigned char* T = F.lds;
    LAS bf16* HID = (LAS bf16*)(F.lds + 34816);
    LAS float* OUTF = (LAS float*)(F.lds + 34816 + 8448);
    LAS float* C1L = (LAS float*)(F.lds + 34816 + 8448 + 4096);
    {
        u32x4 tv[5];
#pragma unroll
        for (int i = 0; i < 5; ++i) { const int idx = tid + 512 * i, tok = idx >> 3, chn = idx & 7, gt = tb + tok; tv[i] = (u32x4){0u, 0u, 0u, 0u};
            if (idx < 272 * 8 && gt < SEQ) tv[i] = *(const u32x4*)(F.KV() + (size_t)gt * 768 + kv * 128 + g * 64 + chn * 8); }
        { const int n = tid & 255, hf = tid >> 8; float pc[16];
#pragma unroll
            for (int k = 0; k < 16; ++k) pc[k] = F.C1()[((hf * 16 + k) * 2 + kv) * 256 + n];
            float s = hf ? 0.f : A.in[7][kv * 256 + n];
#pragma unroll
            for (int k = 0; k < 16; ++k) s += pc[k];
            C1L[hf * 256 + n] = s; }
#pragma unroll
        for (int i = 0; i < 5; ++i) { const int idx = tid + 512 * i, tok = idx >> 3, chn = idx & 7;
            if (idx < 272 * 8) *(LAS u32x4*)(T + tok * 128 + ((chn ^ ((tok >> 4) & 7)) << 4)) = tv[i]; }
    }
    LDS_WAIT(); __syncthreads();
    f32x4 acc[2] = {(f32x4){0.f, 0.f, 0.f, 0.f}, (f32x4){0.f, 0.f, 0.f, 0.f}};
    const bf16* w1t = F.W1T() + (size_t)kv * 256 * 2048 + (size_t)(32 * w + fr) * 2048 + 8 * fq;
#pragma unroll 32
    for (int ks = 0; ks < 64; ++ks) {
        const int tok = 16 * fr + (ks >> 1), chn = 4 * (ks & 1) + fq;
        const bf16x8 a = *(const LAS bf16x8*)(T + tok * 128 + ((chn ^ ((tok >> 4) & 7)) << 4));
        const bf16x8 b0 = *(const bf16x8*)(w1t + 32 * ks), b1 = *(const bf16x8*)(w1t + (size_t)16 * 2048 + 32 * ks);
        acc[0] = __builtin_amdgcn_mfma_f32_16x16x32_bf16(a, b0, acc[0], 0, 0, 0);
        acc[1] = __builtin_amdgcn_mfma_f32_16x16x32_bf16(a, b1, acc[1], 0, 0, 0);
    }
#pragma unroll
    for (int nt = 0; nt < 2; ++nt) { const int n = 32 * w + 16 * nt + fr; const float c1 = C1L[n] + C1L[256 + n];
#pragma unroll
        for (int rg = 0; rg < 4; ++rg) { const float v = acc[nt][rg] + c1; HID[(4 * fq + rg) * 264 + n] = (bf16)f2bf(v * fsigmoid(v)); } }
    LDS_WAIT(); __syncthreads();
    if (w < 4) {
        f32x4 o = (f32x4){0.f, 0.f, 0.f, 0.f};
        const bf16* w2t = F.W2T() + (size_t)kv * 64 * 256 + (size_t)(16 * w + fr) * 256 + 8 * fq;
#pragma unroll
        for (int ks = 0; ks < 8; ++ks) { const bf16x8 a = *(const LAS bf16x8*)(HID + fr * 264 + 32 * ks + 8 * fq); const bf16x8 b = *(const bf16x8*)(w2t + 32 * ks);
            o = __builtin_amdgcn_mfma_f32_16x16x32_bf16(a, b, o, 0, 0, 0); }
#pragma unroll
        for (int rg = 0; rg < 4; ++rg) OUTF[(4 * fq + rg) * 64 + 16 * w + fr] = o[rg];
    }
    LDS_WAIT(); __syncthreads();
    {
        const int row = tid >> 5, e = 2 * (tid & 31), c = c0 + row;
        float v0 = OUTF[row * 64 + e], v1 = OUTF[row * 64 + e + 1];
        if (kv == 0) { float ss = v0 * v0 + v1 * v1;
#pragma unroll
            for (int o = 1; o < 32; o <<= 1) ss += __shfl_xor(ss, o);
            const float rs = 1.0f / sqrtf(ss * (1.f / 64.f) + RMS_EPS); v0 *= rs * A.in[4][e]; v1 *= rs * A.in[4][e + 1]; }
        if (c >= 1023) { v0 = 0.f; v1 = 0.f; }
        bf16* dst = (kv == 0 ? F.KC() : F.VC()) + ((size_t)g * 1024 + c) * 64 + e;
        *(unsigned*)dst = pk2(v0, v1);
    }
    LDS_WAIT(); __syncthreads();
}

namespace att {
constexpr int SLOTB = 8192, NSLOT = 3;
constexpr int L_K = 0, L_V = NSLOT * SLOTB, L_SC = 2 * NSLOT * SLOTB, L_OUT = L_SC + 65536, L_LUT = L_OUT + 32768, L_WSF = L_LUT + 2048, L_BM = L_WSF + 2048, L_REF = L_BM + 2048, L_LACC = L_REF + 1024, L_TL = L_LACC + 1024  , L_END = L_TL + 5120;
static_assert(L_END <= RING_BYTES, "attention LDS map");
constexpr int L_EX = 0  ,
              L_HDR = 69632  , L_LEX = 70144  , L_NT = 71168  ;
static_assert(L_NT + 32 <= L_SC + 65536, "part B exchange area");
constexpr float CLAMP = 100.0f;
constexpr float THR = 8.0f;
#define SBAR() __builtin_amdgcn_sched_barrier(0)
__device__ __forceinline__ int crow(int r, int hi) { return (r & 3) + 8 * (r >> 2) + 4 * hi; }
__device__ __forceinline__ void glds16(const void* gsrc, unsigned lds_dst) { unsigned keep;
    asm volatile("s_mov_b32 %0, m0\n\ts_mov_b32 m0, %2\n\ts_nop 0\n\tglobal_load_lds_dwordx4 %1, off\n\ts_mov_b32 m0, %0" : "=&s"(keep) : "v"(gsrc), "s"(lds_dst) : "memory"); }
__device__ __forceinline__ void qkt(f32x16& p0, f32x16& p1, const LAS unsigned char* Kslot, const bf16x8* qr, int r32, int hi) {
    const LAS unsigned char* kb = Kslot + hi * 1024 + r32 * 16;
    const f32x16 z = {0.f, 0.f, 0.f, 0.f, 0.f, 0.f, 0.f, 0.f, 0.f, 0.f, 0.f, 0.f, 0.f, 0.f, 0.f, 0.f};
#pragma unroll
    for (int d0 = 0; d0 < 4; ++d0) {
        const bf16x8 b0 = *(const LAS bf16x8*)(kb + d0 * 2048);
        const bf16x8 b1 = *(const LAS bf16x8*)(kb + d0 * 2048 + 512);
        if (d0 == 0) { p0 = __builtin_amdgcn_mfma_f32_32x32x16_bf16(b0, qr[0], z, 0, 0, 0); p1 = __builtin_amdgcn_mfma_f32_32x32x16_bf16(b1, qr[0], z, 0, 0, 0); }
        else { p0 = __builtin_amdgcn_mfma_f32_32x32x16_bf16(b0, qr[d0], p0, 0, 0, 0); p1 = __builtin_amdgcn_mfma_f32_32x32x16_bf16(b1, qr[d0], p1, 0, 0, 0); } }
}
__device__ __forceinline__ void pv(f32x16* o, int vb, bf16x8 pa0, bf16x8 pa1, bf16x8 pa2, bf16x8 pa3) {
    s16x4 lo[8], hi[8];
#pragma unroll
    for (int x = 0; x < 8; ++x) {
        asm volatile("ds_read_b64_tr_b16 %0,%1 offset:%c2" : "=&v"(lo[x]) : "v"(vb), "i"((x >> 2) * 4096 + (x & 3) * 1024) : "memory");
        asm volatile("ds_read_b64_tr_b16 %0,%1 offset:%c2" : "=&v"(hi[x]) : "v"(vb), "i"((x >> 2) * 4096 + (x & 3) * 1024 + 512) : "memory"); }
    asm volatile("s_waitcnt lgkmcnt(0)" ::: "memory"); SBAR();
#define PK(k) (bf16x8){lo[k][0], lo[k][1], lo[k][2], lo[k][3], hi[k][0], hi[k][1], hi[k][2], hi[k][3]}
    o[0] = __builtin_amdgcn_mfma_f32_32x32x16_bf16(pa0, PK(0), o[0], 0, 0, 0); o[1] = __builtin_amdgcn_mfma_f32_32x32x16_bf16(pa0, PK(4), o[1], 0, 0, 0);
    o[0] = __builtin_amdgcn_mfma_f32_32x32x16_bf16(pa1, PK(1), o[0], 0, 0, 0); o[1] = __builtin_amdgcn_mfma_f32_32x32x16_bf16(pa1, PK(5), o[1], 0, 0, 0);
    o[0] = __builtin_amdgcn_mfma_f32_32x32x16_bf16(pa2, PK(2), o[0], 0, 0, 0); o[1] = __builtin_amdgcn_mfma_f32_32x32x16_bf16(pa2, PK(6), o[1], 0, 0, 0);
    o[0] = __builtin_amdgcn_mfma_f32_32x32x16_bf16(pa3, PK(3), o[0], 0, 0, 0); o[1] = __builtin_amdgcn_mfma_f32_32x32x16_bf16(pa3, PK(7), o[1], 0, 0, 0);
#undef PK
}
__device__ __forceinline__ float rowmax(const f32x16& p0, const f32x16& p1) {
    float a = fmaxf(fmaxf(p0[0], p0[1]), p1[0]), b = fmaxf(fmaxf(p0[2], p0[3]), p1[1]); a = fmaxf(fmaxf(a, p1[2]), p1[3]);
#pragma unroll
    for (int r = 4; r < 16; r += 4) { a = fmaxf(fmaxf(a, p0[r]), p0[r + 1]); b = fmaxf(fmaxf(b, p0[r + 2]), p0[r + 3]); a = fmaxf(fmaxf(a, p1[r]), p1[r + 1]); b = fmaxf(fmaxf(b, p1[r + 2]), p1[r + 3]); }
    const float m = fmaxf(a, b);
    auto rr = __builtin_amdgcn_permlane32_swap(__float_as_uint(m), __float_as_uint(m), false, false);
    return fmaxf(__uint_as_float(rr[0]), __uint_as_float(rr[1]));
}
__device__ __forceinline__ float halfsum(float v) { auto rr = __builtin_amdgcn_permlane32_swap(__float_as_uint(v), __float_as_uint(v), false, false); return __uint_as_float(rr[0]) + __uint_as_float(rr[1]); }
template <int STEP, unsigned LIMIT>
__device__ __forceinline__ void near_apply(f32x16& p0, f32x16& p1, int dbase, const LAS float* lut) {
    float b0[16], b1[16];
#pragma unroll
    for (int r = 0; r < 16; ++r) { const int koff = (r & 3) + 8 * (r >> 2); const int d0 = dbase - STEP * koff, d1 = d0 - STEP * 32;
        b0[r] = lut[4 * min(max(d0, 0), 127)]; b1[r] = lut[4 * min(max(d1, 0), 127)]; }
#pragma unroll
    for (int r = 0; r < 16; ++r) { asm volatile("" : "+v"(b0[r]), "+v"(b1[r])); }
#pragma unroll
    for (int r = 0; r < 16; ++r) { const int koff = (r & 3) + 8 * (r >> 2); const int d0 = dbase - STEP * koff, d1 = d0 - STEP * 32;
        const float t0 = p0[r] + b0[r], t1 = p1[r] + b1[r];
        p0[r] = ((unsigned)d0 < LIMIT) ? t0 : -INFINITY; p1[r] = ((unsigned)d1 < LIMIT) ? t1 : -INFINITY; }
}
template <bool HASO>
__device__ __forceinline__ void sm_update(f32x16& p0, f32x16& p1, float bias, float& m, float& l, f32x16* o, LAS float* wsf, int r32, int hi) {
    const float rm = rowmax(p0, p1) + bias;
    const bool need = rm > m + THR;
    if (__any(need)) {
        const float mn = need ? rm : m; const float alpha = __builtin_amdgcn_exp2f(m - mn);
        l *= alpha; m = mn;
        if (HASO) { if (hi == 0) wsf[r32] = alpha; LDS_WAIT();
#pragma unroll
            for (int r = 0; r < 16; ++r) { const float f = wsf[crow(r, hi)]; o[0][r] *= f; o[1][r] *= f; } }
    }
    const float mb = m - bias;
#pragma unroll
    for (int r = 0; r < 16; ++r) { p0[r] = __builtin_amdgcn_exp2f(p0[r] - mb); p1[r] = __builtin_amdgcn_exp2f(p1[r] - mb); }
    float t[8];
#pragma unroll
    for (int r = 0; r < 8; ++r) t[r] = (p0[2 * r] + p0[2 * r + 1]) + (p1[2 * r] + p1[2 * r + 1]);
    l += ((t[0] + t[1]) + (t[2] + t[3])) + ((t[4] + t[5]) + (t[6] + t[7]));
}
#define ATT_PACK(P0, P1) \
    const bf16x8 pa0 = __builtin_bit_cast(bf16x8, (u32x4){cvtpk(P0[0], P0[1]), cvtpk(P0[2], P0[3]), cvtpk(P0[4], P0[5]), cvtpk(P0[6], P0[7])}); \
    const bf16x8 pa1 = __builtin_bit_cast(bf16x8, (u32x4){cvtpk(P0[8], P0[9]), cvtpk(P0[10], P0[11]), cvtpk(P0[12], P0[13]), cvtpk(P0[14], P0[15])}); \
    const bf16x8 pa2 = __builtin_bit_cast(bf16x8, (u32x4){cvtpk(P1[0], P1[1]), cvtpk(P1[2], P1[3]), cvtpk(P1[4], P1[5]), cvtpk(P1[6], P1[7])}); \
    const bf16x8 pa3 = __builtin_bit_cast(bf16x8, (u32x4){cvtpk(P1[8], P1[9]), cvtpk(P1[10], P1[11]), cvtpk(P1[12], P1[13]), cvtpk(P1[14], P1[15])});
#define ATT_WAITBAR(N) asm volatile("s_waitcnt vmcnt(" #N ") lgkmcnt(0)\n\ts_barrier" ::: "memory")
#define ATT_FILL(V, x) do { _Pragma("unroll") for (int _r = 0; _r < 16; ++_r) V[_r] = (x); } while (0)

__device__ __forceinline__ unsigned rangemask(int k, int a, int b) {
    const int lo = max(a - 32 * k, 0), hi = min(b - 32 * k, 31);
    return (lo > hi) ? 0u : ((0xFFFFFFFFu >> (31 - hi)) & (0xFFFFFFFFu << lo));
}
__device__ __forceinline__ int wave_max_i32(int x) {
    x = max(x, dpp_i<0xB1>(x)); x = max(x, dpp_i<0x4E>(x)); x = max(x, dpp_i<0x141>(x)); x = max(x, dpp_i<0x140>(x));
    return max(max(__builtin_amdgcn_readlane(x, 0), __builtin_amdgcn_readlane(x, 16)), max(__builtin_amdgcn_readlane(x, 32), __builtin_amdgcn_readlane(x, 48)));
}

__device__ __forceinline__ void lds_add_f32(LAS float* p, float v) { (void)__hip_atomic_fetch_add(p, v, __ATOMIC_RELAXED, __HIP_MEMORY_SCOPE_WORKGROUP); }

__device__ __forceinline__ void attn_item(const Frame& F, int qt, int g) {
    const int lane = lane_id(), wid = F.wave, tid = wid * 64 + lane, r32 = lane & 31, hi = lane >> 5;
    const int ql = r32 >> 2, h = r32 & 3, cur = qt, t = 64 * qt + 8 * wid + ql, head = 4 * g + h;
    LAS unsigned char* shm = F.lds;
    const unsigned lds0 = (unsigned)(uintptr_t)shm;
    LAS float* wsf = (LAS float*)(shm + L_WSF) + wid * 64;
    LAS float* SC = (LAS float*)(shm + L_SC);
    LAS float* OACC = (LAS float*)(shm + L_SC);
    LAS float* lutl = (LAS float*)(shm + L_LUT);
    const LAS float* luth = lutl + h;
    LAS unsigned* BM = (LAS unsigned*)(shm + L_BM);
    LAS float* REF = (LAS float*)(shm + L_REF);
    LAS float* LACC = (LAS float*)(shm + L_LACC);
    lutl[4 * (tid & 127) + (tid >> 7)] = F.LUT()[(4 * g + (tid >> 7)) * 128 + (tid & 127)];
    BM[tid] = 0u;
    LAS u32x2* QL8 = (LAS u32x2*)(shm + L_OUT);
#pragma unroll
    for (int i = 0; i < 4; ++i) { const int slot = tid + 512 * i, q = slot >> 5, ks_ = (slot >> 4) & 1, gq_ = (slot >> 2) & 3, h_ = slot & 3;
        const u32x4 w = *(const u32x4*)(F.Q2() + (size_t)(64 * qt + q) * 512 + g * 256 + (2 * ks_ + (gq_ >> 1)) * 64 + h_ * 16 + 8 * (gq_ & 1));
        int w0 = __builtin_amdgcn_cvt_pk_fp8_f32(8.f * bflo(w.x), 8.f * bfhi(w.x), 0, false); w0 = __builtin_amdgcn_cvt_pk_fp8_f32(8.f * bflo(w.y), 8.f * bfhi(w.y), w0, true);
        int w1 = __builtin_amdgcn_cvt_pk_fp8_f32(8.f * bflo(w.z), 8.f * bfhi(w.z), 0, false); w1 = __builtin_amdgcn_cvt_pk_fp8_f32(8.f * bflo(w.w), 8.f * bfhi(w.w), w1, true);
        QL8[slot] = (u32x2){(unsigned)w0, (unsigned)w1}; }
    bf16x8 qr[4];
    { const bf16* qp = F.Q2() + (size_t)t * 512 + g * 256 + h * 16 + hi * 8;
#pragma unroll
        for (int d0 = 0; d0 < 4; ++d0) qr[d0] = *(const bf16x8*)(qp + d0 * 64); }
    const float b31 = F.LUT()[head * 128 + 127];
    const float gate_c = fsigmoid(bf2f(F.BR()[(size_t)t * 256 + head])), gate_s = fsigmoid(bf2f(F.BR()[(size_t)t * 256 + 8 + head])), gate_w = fsigmoid(bf2f(F.BR()[(size_t)t * 256 + 16 + head]));
    f32x16 o[2], p0, p1;
    const unsigned kdst = lds0 + L_K + wid * 1024, vdst = lds0 + L_V + wid * 1024;
    const int vrow = 16 * (wid & 3) + (lane >> 2), vcol = (wid >> 2) * 32 + (lane & 3) * 8;
    const int vb0 = (int)(lds0 + L_V) + ((lane >> 4) & 1) * 32 + (lane & 3) * 8 + (4 * hi + ((lane & 15) >> 2)) * 64;
#define DMA_K(base, pitch, row0, slot) glds16((base) + (size_t)((row0) + lane) * (pitch) + wid * 8, (unsigned)__builtin_amdgcn_readfirstlane(kdst + (slot)))
#define DMA_V(base, pitch, row0, slot) glds16((base) + (size_t)((row0) + vrow) * (pitch) + vcol, (unsigned)__builtin_amdgcn_readfirstlane(vdst + (slot)))
#define ROT() do { sl_cur = sl_next; sl_next = (sl_next == (NSLOT - 1) * SLOTB) ? 0 : sl_next + SLOTB; } while (0)
    VM_WAIT(); LDS_WAIT(); __syncthreads();

    const bf16* KCg = F.KC() + (size_t)g * 1024 * 64; const bf16* VCg = F.VC() + (size_t)g * 1024 * 64;
    const int nkt = (qt >> 4) + 1;
    const int tminw = 64 * qt + 8 * wid;
    float m = -1e30f, l = 0.f;
    {
        int sl_cur = 0, sl_next = SLOTB;
        DMA_K(KCg, 64, 0, 0);
        for (int kt = 0; kt < nkt; ++kt) {
            if (kt + 1 < nkt) { DMA_K(KCg, 64, 64 * (kt + 1), sl_next); ATT_WAITBAR(1); } else { ATT_WAITBAR(0); }
            const bool far = (tminw - 31 - 16 * (64 * kt + 63)) >= 128;
            qkt(p0, p1, shm + L_K + sl_cur, qr, r32, hi);
            if (!far) near_apply<16, 0x80000000u>(p0, p1, t - 31 - 16 * (64 * kt + 4 * hi), luth);
            sm_update<false>(p0, p1, far ? b31 : 0.f, m, l, o, wsf, r32, hi);
            ROT();
        }
        LDS_WAIT(); __builtin_amdgcn_s_barrier();
    }
    {
        const float lt = halfsum(l); const float rl = lt > 0.f ? 1.0f / lt : 0.f;
        ATT_FILL(o[0], 0.f); ATT_FILL(o[1], 0.f);
        float carry = 0.f;
        int sl_cur = 0, sl_next = SLOTB;
        DMA_K(KCg, 64, 0, 0); DMA_V(VCg, 64, 0, 0);
        for (int kt = 0; kt < nkt; ++kt) {
            if (kt + 1 < nkt) { DMA_K(KCg, 64, 64 * (kt + 1), sl_next); DMA_V(VCg, 64, 64 * (kt + 1), sl_next); ATT_WAITBAR(2); } else { ATT_WAITBAR(0); }
            const bool far = (tminw - 31 - 16 * (64 * kt + 63)) >= 128;
            qkt(p0, p1, shm + L_K + sl_cur, qr, r32, hi);
            if (!far) near_apply<16, 0x80000000u>(p0, p1, t - 31 - 16 * (64 * kt + 4 * hi), luth);
            const float mb2 = far ? m - b31 : m;
#pragma unroll
            for (int r = 0; r < 16; ++r) { p0[r] = __builtin_amdgcn_exp2f(p0[r] - mb2) * rl; p1[r] = __builtin_amdgcn_exp2f(p1[r] - mb2) * rl; }
            {
                float q4[8], e[8];
#pragma unroll
                for (int i = 0; i < 4; ++i) { q4[i] = (p0[4 * i] + p0[4 * i + 1]) + (p0[4 * i + 2] + p0[4 * i + 3]); e[i] = p0[4 * i + 3];
                                              q4[4 + i] = (p1[4 * i] + p1[4 * i + 1]) + (p1[4 * i + 2] + p1[4 * i + 3]); e[4 + i] = p1[4 * i + 3]; }
                float newcarry = 0.f;
#pragma unroll
                for (int i = 0; i < 8; ++i) { auto rr = __builtin_amdgcn_permlane32_swap(__float_as_uint(e[i]), __float_as_uint(e[i]), false, false);
                    const float elo = __uint_as_float(rr[0]), ehi = __uint_as_float(rr[1]);
                    if (hi) q4[i] += elo; else if (i < 7) q4[i + 1] += ehi;
                    if (i == 7) newcarry = ehi; }
                if (!hi) q4[0] += carry;
                carry = newcarry;
#pragma unroll
                for (int i = 0; i < 8; ++i) { float v = q4[i]; v += dpp_f<0xB1>(v); v += dpp_f<0x4E>(v); q4[i] = v; }
                if (h == 0) {
#pragma unroll
                    for (int i = 0; i < 8; ++i) SC[(8 * wid + ql) * 256 + 16 * kt + 2 * i + hi] = q4[i]; }
            }
            { ATT_PACK(p0, p1); pv(o, vb0 + sl_cur, pa0, pa1, pa2, pa3); }
            ROT();
        }
        LDS_WAIT(); __builtin_amdgcn_s_barrier();
    }

    if (cur >= 16) {
        const int u4 = lane >> 4, li16 = lane & 15;
#pragma unroll 1
        for (int qb = 0; qb < 8; qb += 4) {
            const int qloc = 8 * wid + qb + u4;
            const LAS float* row = SC + qloc * 256 + li16;
            int v[16];
#pragma unroll
            for (int k = 0; k < 16; ++k) { const int J = li16 + 16 * k; const int x = (__float_as_int(row[16 * k]) & ~255) | (255 - J); v[k] = (J >= 1 && J <= cur - 2) ? x : -1; }
            LAS unsigned* bmq = BM + (qloc >> 5); const unsigned qbit = 1u << (qloc & 31);
#pragma unroll 1
            for (int round = 0; round < 13; ++round) {
                int lm = max(max(max(v[0], v[1]), max(v[2], v[3])), max(max(v[4], v[5]), max(v[6], v[7])));
                lm = max(lm, max(max(max(v[8], v[9]), max(v[10], v[11])), max(max(v[12], v[13]), max(v[14], v[15]))));
                int rm = lm; rm = max(rm, dpp_i<0xB1>(rm)); rm = max(rm, dpp_i<0x4E>(rm)); rm = max(rm, dpp_i<0x141>(rm)); rm = max(rm, dpp_i<0x140>(rm));
                if (lm == rm) {
#pragma unroll
                    for (int k = 0; k < 16; ++k) v[k] = (v[k] == rm) ? -1 : v[k];
                    __hip_atomic_fetch_or(bmq + 2 * (255 - (rm & 255)), qbit, __ATOMIC_RELAXED, __HIP_MEMORY_SCOPE_WORKGROUP);
                }
            }
        }
    }
    LDS_WAIT();
    LAS float* ostg = (LAS float*)(shm + L_SC) + wid * 2048;
    {
        if (hi == 0) wsf[r32] = gate_c; LDS_WAIT();
#pragma unroll
        for (int r = 0; r < 16; ++r) { const float f = wsf[crow(r, hi)]; const int orow = crow(r, hi); ostg[orow * 64 + r32] = o[0][r] * f; ostg[orow * 64 + 32 + r32] = o[1][r] * f; }
    }

    const bf16* Kw = F.KV() + 512 + g * 64; const bf16* Vw = F.KV() + 640 + g * 64;
    {
        m = -1e30f; l = 0.f; ATT_FILL(o[0], 0.f); ATT_FILL(o[1], 0.f);
        const int J0 = max(cur - 8, 0);
        int sl_cur = 0, sl_next = SLOTB;
        DMA_K(Kw, 768, 64 * J0, 0); DMA_V(Vw, 768, 64 * J0, 0);
        for (int J = J0; J <= cur; ++J) {
            if (J + 1 <= cur) { DMA_K(Kw, 768, 64 * (J + 1), sl_next); DMA_V(Vw, 768, 64 * (J + 1), sl_next); ATT_WAITBAR(2); } else { ATT_WAITBAR(0); }
            const bool nearw = (J >= cur - 2 || J == cur - 8);
            qkt(p0, p1, shm + L_K + sl_cur, qr, r32, hi);
            if (nearw) near_apply<1, 512u>(p0, p1, t - 64 * J - 4 * hi, luth);
            sm_update<true>(p0, p1, nearw ? 0.f : b31, m, l, o, wsf, r32, hi);
            { ATT_PACK(p0, p1); pv(o, vb0 + sl_cur, pa0, pa1, pa2, pa3); }
            ROT();
        }
        LDS_WAIT(); __builtin_amdgcn_s_barrier();
        const float lt = halfsum(l); const float fw = lt > 0.f ? gate_w / lt : 0.f;
        if (hi == 0) wsf[r32] = fw; LDS_WAIT();
#pragma unroll
        for (int r = 0; r < 16; ++r) { const float f = wsf[crow(r, hi)]; const int orow = crow(r, hi); ostg[orow * 64 + r32] += o[0][r] * f; ostg[orow * 64 + 32 + r32] += o[1][r] * f; }
        LDS_WAIT();
#pragma unroll
        for (int i = 0; i < 4; ++i) { const int rowl = i * 8 + (lane >> 3), chn = lane & 7;
            const f32x4 a0 = *(const LAS f32x4*)(ostg + rowl * 64 + chn * 8), a1 = *(const LAS f32x4*)(ostg + rowl * 64 + chn * 8 + 4);
            const size_t tt = (size_t)(64 * qt + 8 * wid + (rowl >> 2)); const int col = (4 * g + (rowl & 3)) * 64 + chn * 8;
            *(u32x4*)(F.XN() + tt * 1024 + col) = (u32x4){cvtpk(a0[0], a0[1]), cvtpk(a0[2], a0[3]), cvtpk(a1[0], a1[1]), cvtpk(a1[2], a1[3])}; }
        LDS_WAIT();
    }

    const bf16* Ks = F.KV() + 256 + g * 64; const bf16* Vs = F.KV() + 384 + g * 64;
    {
        m = -1e30f; l = 0.f; ATT_FILL(o[0], 0.f); ATT_FILL(o[1], 0.f);
        const int nA = (cur < 16) ? cur + 1 : 3;
#define JA(i) ((cur < 16) ? (i) : ((i) == 0 ? 0 : cur - 2 + (i)))
        int sl_cur = 0, sl_next = SLOTB;
        DMA_K(Ks, 768, 0, 0); DMA_V(Vs, 768, 0, 0);
        for (int i = 0; i < nA; ++i) {
            const int J = JA(i);
            if (i + 1 < nA) { const int Jn = JA(i + 1); DMA_K(Ks, 768, 64 * Jn, sl_next); DMA_V(Vs, 768, 64 * Jn, sl_next); ATT_WAITBAR(2); } else { ATT_WAITBAR(0); }
            const bool neara = (J >= cur - 2);
            qkt(p0, p1, shm + L_K + sl_cur, qr, r32, hi);
            if (neara) near_apply<1, 0x80000000u>(p0, p1, t - 64 * J - 4 * hi, luth);
            sm_update<true>(p0, p1, neara ? 0.f : b31, m, l, o, wsf, r32, hi);
            { ATT_PACK(p0, p1); pv(o, vb0 + sl_cur, pa0, pa1, pa2, pa3); }
            ROT();
        }
#undef JA
        LDS_WAIT(); __builtin_amdgcn_s_barrier();
        const float lt = halfsum(l);
        if (hi == 0) { REF[32 * wid + r32] = m; LACC[32 * wid + r32] = lt; }
#pragma unroll
        for (int r = 0; r < 16; ++r) { const int orow = 32 * wid + crow(r, hi); OACC[orow * 64 + r32] = o[0][r]; OACC[orow * 64 + 32 + r32] = o[1][r]; }
        LDS_WAIT(); __builtin_amdgcn_s_barrier();
    }

    if (cur >= 16) {
        const int c16 = lane & 15, gq = lane >> 4, qi4 = c16 >> 2;
        float oa[2][16], la2[2];
        { const int li_ = lane & 15, hsel_ = li_ >> 2, dq_ = (li_ & 3) * 16;
#pragma unroll
            for (int p = 0; p < 2; ++p) { la2[p] = 0.f; const LAS f32x4* ap = (const LAS f32x4*)(OACC + (4 * (8 * wid + 4 * p + gq) + hsel_) * 64 + dq_);
#pragma unroll
                for (int k = 0; k < 4; ++k) { const f32x4 a = ap[k]; oa[p][4 * k] = a[0]; oa[p][4 * k + 1] = a[1]; oa[p][4 * k + 2] = a[2]; oa[p][4 * k + 3] = a[3]; } } }
        LDS_WAIT(); __builtin_amdgcn_s_barrier();
        if (tid < 128) ((LAS unsigned*)(shm + L_HDR))[tid] = 0u;
        typedef long i64_t;
        const i64_t* KTg = (const i64_t*)F.KT() + (size_t)g * 256 * 512 + gq * 16 + c16; const bf16* VTg = F.VT() + (size_t)g * 256 * 4096 + c16 * 32 + 8 * gq;
        const LAS i64_t* QLg = (const LAS i64_t*)QL8 + gq * 4 + h;
        LAS unsigned* TL = (LAS unsigned*)(shm + L_TL) + wid * 160;
        int ntask = 0;
#pragma unroll 1
        for (int i4 = 0; i4 < 4; ++i4) {
            const int Jl = lane + 64 * i4; int nch = 0;
            unsigned long long mk = 0ull;
            if (Jl >= 1 && Jl <= cur - 2 && (Jl & 7) == wid) { mk = ((unsigned long long)BM[2 * Jl + 1] << 32) | BM[2 * Jl]; nch = (__popcll(mk) + 3) >> 2; }
            int incl = nch;
#pragma unroll
            for (int o = 1; o < 64; o <<= 1) { const int up = __shfl_up(incl, o); if (lane >= o) incl += up; }
            const int base = ntask + incl - nch;
            for (int c = 0; c < nch; ++c) { unsigned e = (unsigned)Jl; int q0 = 0;
#pragma unroll
                for (int k = 0; k < 4; ++k) { int q = q0; if (mk) { q = __builtin_ctzll(mk); mk &= mk - 1; } if (k == 0) q0 = q; e |= (unsigned)q << (8 + 6 * k); }
                if (base + c < 160) TL[base + c] = e; }
            ntask += __builtin_amdgcn_readlane(incl, 63);
        }
        ntask = __builtin_amdgcn_readfirstlane(min(ntask, 160));
        LAS float* EX = (LAS float*)(shm + L_EX); LAS unsigned* QM = (LAS unsigned*)(shm + L_HDR); LAS float* LEX = (LAS float*)(shm + L_LEX); LAS int* NT = (LAS int*)(shm + L_NT);
        if (lane == 0) NT[wid] = ntask;
        LDS_WAIT(); __builtin_amdgcn_s_barrier();
        int nround = 0;
#pragma unroll
        for (int k = 0; k < 8; ++k) nround = max(nround, __builtin_amdgcn_readfirstlane(NT[k]));
        i64_t kfC[8], kfN[8]; bf16x8 vfC[8]; bool kpend = false;
#define LOADK(J_, KF) do { const i64_t* kp_ = KTg + (size_t)(J_) * 512; \
            _Pragma("unroll") for (int kt = 0; kt < 4; ++kt) { KF[2 * kt] = kp_[kt * 64]; KF[2 * kt + 1] = kp_[256 + kt * 64]; } } while (0)
#define LOADV(J_, VF) do { const bf16* vp_ = VTg + (size_t)(J_) * 4096; _Pragma("unroll") for (int x = 0; x < 8; ++x) VF[x] = *(const bf16x8*)(vp_ + x * 512); } while (0)
        unsigned e_cur = 0xffu;
        i64_t qg0 = 0, qg1 = 0; float ref = 0.f;
#define QFETCH(E) do { const int mq_ = ((E) >> (8 + 6 * qi4)) & 63; const LAS i64_t* qp_ = QLg + mq_ * 32; qg0 = qp_[0]; qg1 = qp_[16]; ref = REF[4 * mq_ + h]; } while (0)
        if (ntask > 0) { e_cur = (unsigned)__builtin_amdgcn_readfirstlane((int)TL[0]); LOADK(e_cur & 255u, kfC); LOADV(e_cur & 255u, vfC); QFETCH(e_cur); }
        unsigned tl1 = (ntask > 1) ? TL[1] : 0xffu;
#define OWNER_PASS(M0, M1, B) do { const int li_ = lane & 15, hsel_ = li_ >> 2, dq_ = (li_ & 3) * 16; \
            _Pragma("unroll") for (int pass = 0; pass < 2; ++pass) { \
                unsigned mm = pass ? (M1) : (M0); \
                while (mm) { const int e = __builtin_ctz(mm); mm &= mm - 1; \
                    const LAS f32x4* xr = (const LAS f32x4*)(EX + (B) * 8704 + (e * 4 + hsel_) * 68 + dq_); \
                    const f32x4 y0 = xr[0], y1 = xr[1], y2 = xr[2], y3 = xr[3]; \
                    oa[pass][0] += y0[0]; oa[pass][1] += y0[1]; oa[pass][2] += y0[2]; oa[pass][3] += y0[3]; oa[pass][4] += y1[0]; oa[pass][5] += y1[1]; oa[pass][6] += y1[2]; oa[pass][7] += y1[3]; \
                    oa[pass][8] += y2[0]; oa[pass][9] += y2[1]; oa[pass][10] += y2[2]; oa[pass][11] += y2[3]; oa[pass][12] += y3[0]; oa[pass][13] += y3[1]; oa[pass][14] += y3[2]; oa[pass][15] += y3[3]; \
                    la2[pass] += LEX[(B) * 128 + e * 4 + hsel_]; } } } while (0)
#pragma unroll 1
        for (int n = 0; n < nround; ++n) {
            const int buf = n & 1;
            unsigned qm0 = 0u, qm1 = 0u;
            if (n > 0) { qm0 = QM[(buf ^ 1) * 64 + 8 * wid + gq]; qm1 = QM[(buf ^ 1) * 64 + 8 * wid + 4 + gq]; }
            if (n < ntask) {
                const unsigned e_nxt = (n + 1 < ntask) ? (unsigned)__builtin_amdgcn_readfirstlane((int)tl1) : 0xffu;
                tl1 = (n + 2 < ntask) ? TL[n + 2] : 0xffu;
                const unsigned e_ = e_cur; const int Jb = e_ & 255, Jn = e_nxt & 255; const bool reload = (Jn != Jb) && (Jn != 255);
                const int q0_ = (e_ >> 8) & 63;
                const int myq = (e_ >> (8 + 6 * qi4)) & 63; const bool valid = (qi4 == 0) || (myq != q0_); const int tq = 64 * qt + myq;
                const bool nearJ = (Jb >= cur - 2);
                const float cinit = nearJ ? 0.f : (valid ? b31 - ref : -INFINITY);
                if (kpend) {
#pragma unroll
                    for (int x = 0; x < 8; ++x) kfC[x] = kfN[x];
                    kpend = false; }
                if (reload) { LOADK(Jn, kfN); kpend = true; }
                f32x4 s[4];
#pragma unroll
                for (int kt = 0; kt < 4; ++kt) { s[kt] = (f32x4){0.f, 0.f, 0.f, 0.f};
                    s[kt] = __builtin_amdgcn_mfma_f32_16x16x32_fp8_fp8(kfC[2 * kt], qg0, s[kt], 0, 0, 0); s[kt] = __builtin_amdgcn_mfma_f32_16x16x32_fp8_fp8(kfC[2 * kt + 1], qg1, s[kt], 0, 0, 0); }
                const float refc = ref;
                if (n + 1 < ntask) QFETCH(e_nxt);
                if (nearJ) { const float sub = valid ? refc : INFINITY;
                    float bb[16];
#pragma unroll
                    for (int kt = 0; kt < 4; ++kt)
#pragma unroll
                        for (int r = 0; r < 4; ++r) { const int dd = tq - 64 * Jb - (16 * kt + 4 * gq + r); bb[kt * 4 + r] = luth[4 * min(max(dd, 0), 127)]; }
#pragma unroll
                    for (int x = 0; x < 16; ++x) asm volatile("" : "+v"(bb[x]));
#pragma unroll
                    for (int kt = 0; kt < 4; ++kt)
#pragma unroll
                        for (int r = 0; r < 4; ++r) { const int dd = tq - 64 * Jb - (16 * kt + 4 * gq + r); const float tt = s[kt][r] * 0.125f + bb[kt * 4 + r] - sub;
                            s[kt][r] = (dd >= 0) ? tt * 8.0f : -INFINITY; } }
#pragma unroll
                for (int kt = 0; kt < 4; ++kt)
#pragma unroll
                    for (int r = 0; r < 4; ++r) { const int tb = min(__float_as_int(s[kt][r] * 0.125f + cinit), __float_as_int(CLAMP));
                        s[kt][r] = __builtin_amdgcn_exp2f(__int_as_float(tb)); }
                float ls = (((s[0][0] + s[0][1]) + (s[0][2] + s[0][3])) + ((s[1][0] + s[1][1]) + (s[1][2] + s[1][3]))) + (((s[2][0] + s[2][1]) + (s[2][2] + s[2][3])) + ((s[3][0] + s[3][1]) + (s[3][2] + s[3][3])));
                { auto r16 = __builtin_amdgcn_permlane16_swap(__float_as_uint(ls), __float_as_uint(ls), false, false); ls = __uint_as_float(r16[0]) + __uint_as_float(r16[1]); }
                ls = halfsum(ls);
                bf16x8 pb[2];
#pragma unroll
                for (int ks = 0; ks < 2; ++ks) pb[ks] = __builtin_bit_cast(bf16x8, (u32x4){cvtpk(s[2 * ks][0], s[2 * ks][1]), cvtpk(s[2 * ks][2], s[2 * ks][3]), cvtpk(s[2 * ks + 1][0], s[2 * ks + 1][1]), cvtpk(s[2 * ks + 1][2], s[2 * ks + 1][3])});
                LAS float* ex = EX + buf * 8704 + ((wid * 4 + qi4) * 4 + h) * 68 + 4 * gq;
                f32x4 ot[4];
#pragma unroll
                for (int mt = 0; mt < 4; ++mt) { ot[mt] = (f32x4){0.f, 0.f, 0.f, 0.f};
                    ot[mt] = __builtin_amdgcn_mfma_f32_16x16x32_bf16(vfC[2 * mt], pb[0], ot[mt], 0, 0, 0); ot[mt] = __builtin_amdgcn_mfma_f32_16x16x32_bf16(vfC[2 * mt + 1], pb[1], ot[mt], 0, 0, 0); }
                if (reload) LOADV(Jn, vfC);
#pragma unroll
                for (int mt = 0; mt < 4; ++mt) *(LAS f32x4*)(ex + 16 * mt) = ot[mt];
                if (gq == 0) { LEX[buf * 128 + wid * 16 + c16] = ls; if (h == 0 && valid) __hip_atomic_fetch_or(QM + buf * 64 + myq, 1u << (wid * 4 + qi4), __ATOMIC_RELAXED, __HIP_MEMORY_SCOPE_WORKGROUP); }
                e_cur = e_nxt;
            }
            OWNER_PASS(qm0, qm1, buf ^ 1);
            if (n > 0 && (lane & 15) == 0) { QM[(buf ^ 1) * 64 + 8 * wid + gq] = 0u; QM[(buf ^ 1) * 64 + 8 * wid + 4 + gq] = 0u; }
            LDS_WAIT(); __builtin_amdgcn_s_barrier();
        }
        if (nround > 0) { const int lb = (nround - 1) & 1; const unsigned l0 = QM[lb * 64 + 8 * wid + gq], l1 = QM[lb * 64 + 8 * wid + 4 + gq]; OWNER_PASS(l0, l1, lb); }
#undef OWNER_PASS
        LDS_WAIT(); __builtin_amdgcn_s_barrier();
        {
            const int li = lane & 15, hsel = li >> 2, dq = (li & 3) * 16;
#pragma unroll
            for (int pass = 0; pass < 2; ++pass) { const int q = 8 * wid + 4 * pass + gq; LAS f32x4* ap = (LAS f32x4*)(OACC + (4 * q + hsel) * 64 + dq);
#pragma unroll
                for (int k = 0; k < 4; ++k) ap[k] = (f32x4){oa[pass][4 * k], oa[pass][4 * k + 1], oa[pass][4 * k + 2], oa[pass][4 * k + 3]};
                if ((li & 3) == 0) LACC[4 * q + hsel] += la2[pass]; }
        }
#undef LOADK
#undef LOADV
#undef QFETCH
    }
    LDS_WAIT(); __builtin_amdgcn_s_barrier();

    {
        if (hi == 0) { const float lt = LACC[32 * wid + r32]; wsf[r32] = lt > 0.f ? gate_s / lt : 0.f; }
        LDS_WAIT();
#pragma unroll
        for (int i = 0; i < 4; ++i) { const int rowl = i * 8 + (lane >> 3), chn = lane & 7, row = 32 * wid + rowl;
            const float f = wsf[rowl];
            const f32x4 a0 = *(const LAS f32x4*)(OACC + row * 64 + chn * 8), a1 = *(const LAS f32x4*)(OACC + row * 64 + chn * 8 + 4);
            const size_t tt = (size_t)(64 * qt + 8 * wid + (rowl >> 2)); const int col = (4 * g + (rowl & 3)) * 64 + chn * 8;
            const u32x4 ov = *(const u32x4*)(F.XN() + tt * 1024 + col);
            const u32x4 gn = *(const u32x4*)(F.GN() + tt * 512 + col);
            u32x4 w; w.x = pk2((bflo(ov.x) + a0[0] * f) * bflo(gn.x), (bfhi(ov.x) + a0[1] * f) * bfhi(gn.x)); w.y = pk2((bflo(ov.y) + a0[2] * f) * bflo(gn.y), (bfhi(ov.y) + a0[3] * f) * bfhi(gn.y));
            w.z = pk2((bflo(ov.z) + a1[0] * f) * bflo(gn.z), (bfhi(ov.z) + a1[1] * f) * bfhi(gn.z)); w.w = pk2((bflo(ov.w) + a1[2] * f) * bflo(gn.w), (bfhi(ov.w) + a1[3] * f) * bfhi(gn.w));
            *(u32x4*)(F.XN() + tt * 1024 + col) = w; }
        VM_WAIT(); LDS_WAIT(); __syncthreads();
    }
#undef DMA_K
#undef DMA_V
#undef ROT
}
}

__global__ void __launch_bounds__(NWAVES * 64, 2) nsa_lru_fwd(Args args) {
    extern __shared__ __attribute__((aligned(16))) unsigned char lds[];
    Frame F;
    F.lds = (LAS unsigned char*)lds;
    F.MISC = (volatile LAS unsigned*)(F.lds + MISC_OFF);
    F.wave = __builtin_amdgcn_readfirstlane((int)(threadIdx.x >> 6));
    F.G = gridDim.x; { const int bx = blockIdx.x; F.vcu = (F.G % 8 == 0) ? (bx % 8) * (F.G / 8) + bx / 8 : bx; }
    F.ws = args.ws;
    gu32* ctl = (gu32*)(args.ws + WS_CTL);
    for (int u = F.wave * 64 + lane_id(); u < (LDS_BYTES - LDSCTL_OFF) / 4; u += NWAVES * 64) ((LAS unsigned*)(F.lds + LDSCTL_OFF))[u] = 0u;
    __syncthreads();
    const int bli = (N_LAUNCHES == PER_PHASE) ? 0 : args.li;
    XcdBarrier bar; bar.bar = (unsigned*)(ctl + CW_BAR) + bli * XCD_BAR_WORDS; bar.x = 0; bar.st = nullptr;
    if (N_LAUNCHES != PER_PHASE) bar = xcd_barrier_post((unsigned*)(ctl + CW_BAR) + bli * XCD_BAR_WORDS, F.MISC + 8);
#define GRID_BAR() do { if (N_LAUNCHES != PER_PHASE) xcd_barrier(bar); } while (0)
    const int lo = args.ph_lo, hi = args.ph_hi;
#define IN(k) (lo <= (k) && (k) < hi)
#define BOTH(k) (IN(k) && IN((k) + 1))

    if (IN(0)) { p0_prologue(F, args); if (BOTH(0)) GRID_BAR(); }

    if (IN(1)) {
        pg8::Gemm g{F.XN(), F.WinT(), F.XN(), F.WinT(), 1024, 1024, 1024}; pg8::StaticOrder S; S.init(SEQ, NPROJ, F.G, (int)blockIdx.x);
        pg8::EpiProj E{F.Q(), F.KV(), F.U(), F.BR(), F.GN(), F.GL(), F.MG()};
        pg8::gemm_phase<pg8::EpiProj, pg8::StaticOrder, true>(F.lds, g, S, E, F.wave);
        if (BOTH(1)) GRID_BAR();
    }

    if (IN(2)) {
        for (int i = F.vcu; i < 256; i += F.G) {
            lru_tile<false>(F, args, i);
            if (!args.pad) qk_norm_tile(F, args, i);
            vt_tile(F, i);
            __syncthreads();
            compress_item(F, args, i & 1, (i >> 1) & 1, i >> 2);
        }
        if (BOTH(2)) GRID_BAR();
    }

    if (IN(3)) {
        for (int i = F.vcu; i < 256; i += F.G) { lru_apply(F, i); }
        __syncthreads();
#pragma unroll 1
        for (int it = 2 * F.vcu; it < 512; it += 2 * F.G) {
#pragma unroll 1
            for (int j = 0; j < 2; ++j) { const int i = it >> 1; att::attn_item(F, j ? i : 255 - i, j ? 0 : 1); }
        }
        if (BOTH(3)) GRID_BAR();
    }

    if (IN(4)) {
        pg8::Gemm g{F.XN(), F.WaT(), F.XN() + 512, F.WbT(), 1024, 512, 512}; pg8::DualOrder S; S.init(SEQ, 1024, F.G, (int)blockIdx.x);
        pg8::EpiMerge E{F.MB(), F.MG()};
        pg8::gemm_phase<pg8::EpiMerge, pg8::DualOrder, true>(F.lds, g, S, E, F.wave);
        if (BOTH(4)) GRID_BAR();
    }

    if (IN(5)) {
        pg8::Gemm g{F.MB(), F.WoutT(), F.MB(), F.WoutT(), 1024, 1024, 1024}; pg8::StaticOrder S; S.init(SEQ, 1024, F.G, (int)blockIdx.x);
        pg8::EpiOut E{args.in[0], args.out};
        pg8::gemm_phase<pg8::EpiOut, pg8::StaticOrder, true>(F.lds, g, S, E, F.wave);
    }
#undef IN
#undef BOTH
}

extern "C" void kernel_launch(void* const* d_in, const int* in_sizes, int n_in, void* d_out, int out_size, void* d_ws, size_t ws_size, hipStream_t stream) {
    static int grid = 0;
    if (grid == 0) {
        if (n_in != 20 || in_sizes[0] != SEQ * DM || out_size != SEQ * DM || ws_size < WS_END) { fprintf(stderr, "kernel_launch: unexpected shapes (n_in %d, in0 %d, out %d, ws %zu)\n", n_in, n_in > 0 ? in_sizes[0] : -1, out_size, ws_size); grid = -1; return; }
        int dev = 0, cus = 0, per_cu = 0;
        if (hipGetDevice(&dev) != hipSuccess || hipDeviceGetAttribute(&cus, hipDeviceAttributeMultiprocessorCount, dev) != hipSuccess) { grid = -1; return; }
        if (hipFuncSetAttribute((const void*)nsa_lru_fwd, hipFuncAttributeMaxDynamicSharedMemorySize, LDS_BYTES) != hipSuccess) { fprintf(stderr, "kernel_launch: hipFuncSetAttribute failed\n"); grid = -1; return; }
        if (hipOccupancyMaxActiveBlocksPerMultiprocessor(&per_cu, (const void*)nsa_lru_fwd, NWAVES * 64, LDS_BYTES) != hipSuccess || per_cu < 1)
            fprintf(stderr, "kernel_launch: occupancy query reports %d workgroups per CU\n", per_cu);
        (void)hipGetLastError();
        grid = cus;
    }
    if (grid < 0) return;
    if (hipMemsetAsync((char*)d_ws + WS_CTL, 0, CTL_ZERO_BYTES, stream) != hipSuccess) { fprintf(stderr, "kernel_launch: hipMemsetAsync failed\n"); return; }
    Args a{};
    for (int i = 0; i < 20; ++i) a.in[i] = (const float*)d_in[i];
    a.out = (float*)d_out; a.ws = (unsigned char*)d_ws;
    const int nl = (PROBE_DUP >= 0) ? 2 : N_LAUNCHES;
    for (int li = 0; li < nl; ++li) {
        if (PROBE_DUP >= 0) { a.ph_lo = li ? PROBE_DUP : 0; a.ph_hi = li ? PER_PHASE : PROBE_DUP + 1; a.li = li; a.pad = (li && PROBE_DUP == 2) ? 1 : 0; }
        else { a.ph_lo = (N_LAUNCHES == PER_PHASE) ? li : 0; a.ph_hi = (N_LAUNCHES == PER_PHASE) ? li + 1 : PER_PHASE; a.li = li; }
        hipLaunchKernelGGL(nsa_lru_fwd, dim3(grid), dim3(NWAVES * 64), LDS_BYTES, stream, a);
        const hipError_t le = hipPeekAtLastError();
        if (le != hipSuccess) { fprintf(stderr, "kernel_launch: launch %d failed: %s\n", li, hipGetErrorName(le)); break; }
    }
}
```

```cpp
#include <hip/hip_runtime.h>
#include <cstdio>
#include <cstdint>

#ifndef PROBE_DUP
#define PROBE_DUP -1
#endif
#ifndef MK_N_LAUNCHES
#define MK_N_LAUNCHES 1
#endif

#define GAS __attribute__((address_space(1)))
#define LAS __attribute__((address_space(3)))
typedef unsigned short bf16;
typedef short bf16x8 __attribute__((ext_vector_type(8)));
typedef short s16x4 __attribute__((ext_vector_type(4)));
typedef float f32x4 __attribute__((ext_vector_type(4)));
typedef float f32x16 __attribute__((ext_vector_type(16)));
typedef unsigned u32x4 __attribute__((ext_vector_type(4)));
typedef unsigned u32x2 __attribute__((ext_vector_type(2)));
typedef GAS unsigned gu32;

constexpr int SEQ = 16384, DM = 1024;
constexpr int NPROJ = 5120;
constexpr float LOG2E = 1.4426950408889634f;
constexpr float RMS_EPS = 1e-6f;

__device__ __forceinline__ unsigned f2bf(float f) { unsigned u = __builtin_bit_cast(unsigned, f); return (u + 0x7fffu + ((u >> 16) & 1u)) >> 16; }
__device__ __forceinline__ unsigned pk2(float lo, float hi) { return f2bf(lo) | (f2bf(hi) << 16); }
__device__ __forceinline__ float bf2f(unsigned h) { return __builtin_bit_cast(float, h << 16); }
__device__ __forceinline__ float bflo(unsigned w) { return __builtin_bit_cast(float, w << 16); }
__device__ __forceinline__ float bfhi(unsigned w) { return __builtin_bit_cast(float, w & 0xffff0000u); }
typedef float f32x2_t __attribute__((ext_vector_type(2))); typedef __bf16 bf16x2_t __attribute__((ext_vector_type(2)));
__device__ __forceinline__ unsigned cvtpk(float lo, float hi) { f32x2_t v = {lo, hi}; bf16x2_t b = __builtin_convertvector(v, bf16x2_t); return __builtin_bit_cast(unsigned, b); }
__device__ __forceinline__ float fsigmoid(float v) { return __builtin_amdgcn_rcpf(1.0f + __builtin_amdgcn_exp2f(-v * LOG2E)); }
template <int CTRL> __device__ __forceinline__ float dpp_f(float v) { return __builtin_bit_cast(float, __builtin_amdgcn_update_dpp(0, __builtin_bit_cast(int, v), CTRL, 0xf, 0xf, true)); }
template <int CTRL> __device__ __forceinline__ int dpp_i(int v) { return __builtin_amdgcn_update_dpp(v, v, CTRL, 0xf, 0xf, false); }
__device__ __forceinline__ int lane_id() { int l = (int)__builtin_amdgcn_mbcnt_hi(~0u, __builtin_amdgcn_mbcnt_lo(~0u, 0u)); asm volatile("" : "+v"(l)); return l; }
__device__ __forceinline__ float wave_sum(float v) {
#pragma unroll
    for (int o = 1; o < 64; o <<= 1) v += __shfl_xor(v, o);
    return v;
}

namespace pg8 {
#define PG8_LAS __attribute__((address_space(3)))
typedef unsigned short bf16_t;
constexpr int BM = 256, BK = 64, HALF = 128, HTB = HALF * BK * 2, STAGE_BYTES = 8 * HTB, NXCD = 8, WGM = 8;
__host__ __device__ __forceinline__ int lds_byte(int r, int c) { const int st = (r >> 4) * 2 + (c >> 5), rr = r & 15, cc = c & 31, ob = rr * 64 + cc * 2; return st * 1024 + (ob ^ (((ob >> 9) & 1) << 5)); }
__host__ __device__ __forceinline__ void stage_rc(int b, int& R, int& C) { const int st = b / 1024, sb = b % 1024, swz = sb ^ (((sb >> 9) & 1) << 5); R = (st >> 1) * 16 + swz / 64; C = (st & 1) * 32 + (swz % 64) / 2; }
__host__ __device__ __forceinline__ int perm32(int rho) { const int n = rho >> 4, i = rho & 15; return 8 * (i >> 2) + 4 * n + (i & 3); }

struct Unit { int pm, pn, part; };
struct Gemm { const bf16_t* A; const bf16_t* Bt; const bf16_t* A2; const bf16_t* Bt2; int lda, ldb, K; };

struct StaticOrder {
    int nM, nN, nwg, G, c;
    __host__ __device__ void init(int M, int N, int G_, int c_) { nM = M / BM; nN = N / BM; nwg = nM * nN; G = G_; c = c_; }
    __host__ __device__ bool tile(long L, Unit& u) const {
        if (L >= nwg) return false;
        int wgid = (int)L; { const int q = nwg / NXCD, r = nwg % NXCD, xcd = wgid % NXCD, off = wgid / NXCD; wgid = (xcd < r ? xcd * (q + 1) : r * (q + 1) + (xcd - r) * q) + off; }
        const int nig = WGM * nN, gid = wgid / nig, fm = gid * WGM, gsz = (nM - fm) < WGM ? (nM - fm) : WGM;
        u.pm = fm + ((wgid % nig) % gsz); u.pn = (wgid % nig) / gsz; u.part = 0; return true;
    }
    __host__ __device__ bool next(int i, Unit& u) const { return tile((long)i * G + c, u); }
};
struct DualOrder : StaticOrder {
    __host__ __device__ bool next(int i, Unit& u) const { if (!tile((long)(i >> 1) * G + c, u)) return false; u.part = i & 1; return true; }
};

__device__ __forceinline__ unsigned cvt_pk_bf16(float lo, float hi) { unsigned r; asm volatile("v_cvt_pk_bf16_f32 %0, %1, %2" : "=v"(r) : "v"(lo), "v"(hi)); return r; }

struct EpiProj {
    static constexpr bool PERM = true, INIT = false;
    bf16_t *Q, *KV, *U, *BR, *GN, *GL, *MG;
    __device__ __forceinline__ void operator()(const f32x4 (&acc)[2][2][4][2], const Unit& u, int wr, int wc, int fr, int fq) const {
        const int pn = u.pn; bf16_t* base; int ldc, colt, act = 0;
        if (pn < 2) { base = Q; ldc = 512; colt = pn * 256; }
        else if (pn < 5) { base = KV; ldc = 768; colt = (pn - 2) * 256; }
        else if (pn < 7) { base = U; ldc = 512; colt = (pn - 5) * 256; }
        else if (pn < 8) { base = BR; ldc = 256; colt = 0; }
        else if (pn < 10) { base = GN; ldc = 512; colt = (pn - 8) * 256; act = 1; }
        else if (pn < 12) { base = GL; ldc = 512; colt = (pn - 10) * 256; act = 1; }
        else { base = MG; ldc = 2048; colt = (pn - 12) * 256; act = 2; }
        const int row0 = u.pm * BM + wr * 64 + fr, col0 = colt + wc * 32 + 8 * fq;
#pragma unroll
        for (int ai = 0; ai < 2; ++ai)
#pragma unroll
            for (int m = 0; m < 4; ++m) { bf16_t* rowp = base + (size_t)(row0 + ai * HALF + m * 16) * ldc + col0;
#pragma unroll
                for (int bj = 0; bj < 2; ++bj) { f32x4 v0 = acc[ai][bj][m][0], v1 = acc[ai][bj][m][1];
                    if (act) {
#pragma unroll
                        for (int e = 0; e < 4; ++e) { const float s0 = fsigmoid(v0[e]), s1 = fsigmoid(v1[e]); v0[e] = (act == 1) ? v0[e] * s0 : s0; v1[e] = (act == 1) ? v1[e] * s1 : s1; } }
                    u32x4 w; w.x = cvt_pk_bf16(v0[0], v0[1]); w.y = cvt_pk_bf16(v0[2], v0[3]); w.z = cvt_pk_bf16(v1[0], v1[1]); w.w = cvt_pk_bf16(v1[2], v1[3]);
                    *(u32x4*)(rowp + bj * HALF) = w; } }
    }
};
struct EpiMerge {
    static constexpr bool PERM = true, INIT = false;
    bf16_t* Mb; const bf16_t* MG;
    __device__ __forceinline__ void operator()(const f32x4 (&acc)[2][2][4][2], const Unit& u, int wr, int wc, int fr, int fq) const {
        const int row0 = u.pm * BM + wr * 64 + fr, col0 = u.pn * BM + wc * 32 + 8 * fq;
#pragma unroll
        for (int ai = 0; ai < 2; ++ai)
#pragma unroll
            for (int m = 0; m < 4; ++m) { const size_t r = (size_t)(row0 + ai * HALF + m * 16);
#pragma unroll
                for (int bj = 0; bj < 2; ++bj) { const f32x4 v0 = acc[ai][bj][m][0], v1 = acc[ai][bj][m][1];
                    const u32x4 gw = *(const u32x4*)(MG + r * 2048 + u.part * 1024 + col0 + bj * HALF);
                    float o[8] = {v0[0] * bflo(gw.x), v0[1] * bfhi(gw.x), v0[2] * bflo(gw.y), v0[3] * bfhi(gw.y), v1[0] * bflo(gw.z), v1[1] * bfhi(gw.z), v1[2] * bflo(gw.w), v1[3] * bfhi(gw.w)};
                    bf16_t* dst = Mb + r * 1024 + col0 + bj * HALF;
                    if (u.part) { const u32x4 pw = *(const u32x4*)dst;
                        o[0] += bflo(pw.x); o[1] += bfhi(pw.x); o[2] += bflo(pw.y); o[3] += bfhi(pw.y); o[4] += bflo(pw.z); o[5] += bfhi(pw.z); o[6] += bflo(pw.w); o[7] += bfhi(pw.w); }
                    u32x4 w; w.x = cvt_pk_bf16(o[0], o[1]); w.y = cvt_pk_bf16(o[2], o[3]); w.z = cvt_pk_bf16(o[4], o[5]); w.w = cvt_pk_bf16(o[6], o[7]);
                    *(u32x4*)dst = w; } }
    }
};
struct EpiOut {
    static constexpr bool PERM = false, INIT = true;
    const float* X; float* O;
    __device__ __forceinline__ void init(f32x4 (&acc)[2][2][4][2], const Unit& u, int wr, int wc, int fr, int fq) const {
        const int row0 = u.pm * BM + wr * 64 + fr, col0 = u.pn * BM + wc * 32 + 4 * fq;
#pragma unroll
        for (int ai = 0; ai < 2; ++ai)
#pragma unroll
            for (int m = 0; m < 4; ++m) { const size_t off = (size_t)(row0 + ai * HALF + m * 16) * 1024 + col0;
#pragma unroll
                for (int bj = 0; bj < 2; ++bj)
#pragma unroll
                    for (int n = 0; n < 2; ++n) acc[ai][bj][m][n] = *(const f32x4*)(X + off + bj * HALF + n * 16); }
    }
    __device__ __forceinline__ void operator()(const f32x4 (&acc)[2][2][4][2], const Unit& u, int wr, int wc, int fr, int fq) const {
        const int row0 = u.pm * BM + wr * 64 + fr, col0 = u.pn * BM + wc * 32 + 4 * fq;
#pragma unroll
        for (int ai = 0; ai < 2; ++ai)
#pragma unroll
            for (int m = 0; m < 4; ++m) { const size_t off = (size_t)(row0 + ai * HALF + m * 16) * 1024 + col0;
#pragma unroll
                for (int bj = 0; bj < 2; ++bj)
#pragma unroll
                    for (int n = 0; n < 2; ++n) *(f32x4*)(O + off + bj * HALF + n * 16) = acc[ai][bj][m][n]; }
    }
};

template <class Epi, class Sched, bool ALIGN_EPI>
__device__ __forceinline__ void gemm_phase(PG8_LAS unsigned char* lds, const Gemm g, const Sched& S, const Epi& E, int wid) {
    const int lane = lane_id(), tid = wid * 64 + lane, wr = wid >> 2, wc = wid & 3, fr = lane & 15, fq = lane >> 4;
    const int K = g.K, nt = K / BK;
    unsigned voffA[2], voffB[2];
#pragma unroll
    for (int i = 0; i < 2; ++i) { int R, C; stage_rc(tid * 16 + i * 8192, R, C); const int Rb = Epi::PERM ? ((R & ~31) + perm32(R & 31)) : R;
        voffA[i] = (unsigned)(R * g.lda + C) * 2u; voffB[i] = (unsigned)(Rb * g.ldb + C) * 2u; }
    const size_t kstep = (size_t)(BK * 2);
    const size_t hstepA = (size_t)HALF * g.lda * 2, hstepB = (size_t)HALF * g.ldb * 2;
    const size_t tstepA = 2 * hstepA, tstepB = 2 * hstepB;
    const unsigned ldsw = (unsigned)wid * 1024u;
    const int aoff = lds_byte(wr * 64 + fr, fq * 8), boff = lds_byte(wc * 32 + fr, fq * 8);
#define PG8_SA(b, h) (((b) * 2 + (h)) * HTB)
#define PG8_SB(b, h) ((4 + (b) * 2 + (h)) * HTB)
#define PG8_STAGE(bufoff, gbase, voff) do { _Pragma("unroll") for (int _i = 0; _i < 2; ++_i) \
        __builtin_amdgcn_global_load_lds((const unsigned*)((const char*)(gbase) + (voff)[_i]), (PG8_LAS unsigned*)(lds + (bufoff) + ldsw + _i * 8192), 16, 0, 0); } while (0)
#define PG8_LDA(dst, b, h) do { _Pragma("unroll") for (int m = 0; m < 4; ++m) _Pragma("unroll") for (int k = 0; k < 2; ++k) dst[m][k] = *(const PG8_LAS bf16x8*)(lds + PG8_SA(b, h) + aoff + m * 2048 + k * 1024); } while (0)
#define PG8_LDB(dst, b, h) do { _Pragma("unroll") for (int n = 0; n < 2; ++n) _Pragma("unroll") for (int k = 0; k < 2; ++k) dst[n][k] = *(const PG8_LAS bf16x8*)(lds + PG8_SB(b, h) + boff + n * 2048 + k * 1024); } while (0)
#define PG8_MMA(ai, bj, At, Bt) do { __builtin_amdgcn_s_setprio(1); _Pragma("unroll") for (int m = 0; m < 4; ++m) _Pragma("unroll") for (int n = 0; n < 2; ++n) _Pragma("unroll") for (int k = 0; k < 2; ++k) \
        acc[ai][bj][m][n] = __builtin_amdgcn_mfma_f32_16x16x32_bf16(Bt[n][k], At[m][k], acc[ai][bj][m][n], 0, 0, 0); __builtin_amdgcn_s_setprio(0); } while (0)
#define PG8_WAIT_V(n) asm volatile("s_waitcnt vmcnt(" #n ")" ::: "memory")
#define PG8_WAIT_L(n) asm volatile("s_waitcnt lgkmcnt(" #n ")" ::: "memory")
#define PG8_BAR __builtin_amdgcn_s_barrier()
#define PG8_SCHED __builtin_amdgcn_sched_barrier(0)
#define PG8_UA(u) ((const char*)((u).part ? g.A2 : g.A) + (size_t)(u).pm * tstepA)
#define PG8_UB(u) ((const char*)((u).part ? g.Bt2 : g.Bt) + (size_t)(u).pn * tstepB)
    Unit cur, nxt; int ui = 0;
    if (!S.next(0, cur)) return;
    f32x4 acc[2][2][4][2];
    if constexpr (Epi::INIT) E.init(acc, cur, wr, wc, fr, fq);
    else {
#pragma unroll
    for (int a = 0; a < 2; ++a)
#pragma unroll
        for (int b = 0; b < 2; ++b)
#pragma unroll
            for (int m = 0; m < 4; ++m)
#pragma unroll
                for (int n = 0; n < 2; ++n) acc[a][b][m][n] = (f32x4){0.f, 0.f, 0.f, 0.f};
    }
    bf16x8 At[4][2], B0[2][2], B1[2][2];
    const char* cA = PG8_UA(cur); const char* cB = PG8_UB(cur);
    PG8_STAGE(PG8_SB(0, 0), cB, voffB); PG8_STAGE(PG8_SB(0, 1), cB + hstepB, voffB); PG8_STAGE(PG8_SA(0, 0), cA, voffA); PG8_STAGE(PG8_SA(0, 1), cA + hstepA, voffA);
    if (wr == 1) PG8_BAR;
    PG8_WAIT_V(2); PG8_BAR;
    PG8_STAGE(PG8_SB(1, 0), cB + kstep, voffB); PG8_STAGE(PG8_SA(1, 0), cA + kstep, voffA); PG8_STAGE(PG8_SB(1, 1), cB + hstepB + kstep, voffB);
    PG8_WAIT_V(6); PG8_BAR;
    for (;;) {
        const bool has_next = S.next(ui + 1, nxt);
        const char* nA = has_next ? PG8_UA(nxt) : cA; const char* nB = has_next ? PG8_UB(nxt) : cB;
        for (int t = 0; t < nt; t += 2) {
            const bool last = (t == nt - 2);
            const char* a1 = cA + (size_t)(t + 1) * kstep;
            const char* a2 = last ? nA : cA + (size_t)(t + 2) * kstep; const char* b2 = last ? nB : cB + (size_t)(t + 2) * kstep;
            const char* a3 = a2 + kstep; const char* b3 = b2 + kstep;
            PG8_LDB(B0, 0, 0); PG8_LDB(B1, 0, 1); PG8_SCHED; PG8_LDA(At, 0, 0); PG8_STAGE(PG8_SA(1, 1), a1 + hstepA, voffA);
            PG8_WAIT_V(8); PG8_WAIT_L(0); PG8_BAR; PG8_MMA(0, 0, At, B0); PG8_MMA(0, 1, At, B1); PG8_BAR; PG8_SCHED;
            PG8_LDA(At, 0, 1); PG8_STAGE(PG8_SB(0, 0), b2, voffB); PG8_STAGE(PG8_SB(0, 1), b2 + hstepB, voffB); PG8_STAGE(PG8_SA(0, 0), a2, voffA);
            PG8_WAIT_V(8); PG8_WAIT_L(0); PG8_BAR; PG8_MMA(1, 0, At, B0); PG8_MMA(1, 1, At, B1); PG8_BAR; PG8_SCHED;
            PG8_LDB(B0, 1, 0); PG8_LDB(B1, 1, 1); PG8_SCHED; PG8_LDA(At, 1, 0); PG8_STAGE(PG8_SA(0, 1), a2 + hstepA, voffA);
            PG8_WAIT_V(8); PG8_WAIT_L(0); PG8_BAR; PG8_MMA(0, 0, At, B0); PG8_MMA(0, 1, At, B1); PG8_BAR; PG8_SCHED;
            PG8_LDA(At, 1, 1); PG8_STAGE(PG8_SB(1, 0), b3, voffB); PG8_STAGE(PG8_SB(1, 1), b3 + hstepB, voffB); PG8_STAGE(PG8_SA(1, 0), a3, voffA);
            PG8_WAIT_V(8); PG8_WAIT_L(0); PG8_BAR; PG8_MMA(1, 0, At, B0); PG8_MMA(1, 1, At, B1); PG8_BAR; PG8_SCHED;
        }
        if constexpr (ALIGN_EPI) { if (wr == 0) PG8_BAR; }
        E(acc, cur, wr, wc, fr, fq);
        if (!has_next) break;
        if constexpr (Epi::INIT) E.init(acc, nxt, wr, wc, fr, fq);
        else {
#pragma unroll
        for (int a = 0; a < 2; ++a)
#pragma unroll
            for (int b = 0; b < 2; ++b)
#pragma unroll
                for (int m = 0; m < 4; ++m)
#pragma unroll
                    for (int n = 0; n < 2; ++n) acc[a][b][m][n] = (f32x4){0.f, 0.f, 0.f, 0.f};
        }
        cur = nxt; cA = nA; cB = nB; ++ui;
        if constexpr (ALIGN_EPI) { if (wr == 1) PG8_BAR; }
    }
    PG8_WAIT_V(0);
    if constexpr (!ALIGN_EPI) { if (wr == 0) PG8_BAR; }
    PG8_BAR;
#undef PG8_SA
#undef PG8_SB
#undef PG8_STAGE
#undef PG8_LDA
#undef PG8_LDB
#undef PG8_MMA
#undef PG8_WAIT_V
#undef PG8_WAIT_L
#undef PG8_BAR
#undef PG8_SCHED
#undef PG8_UA
#undef PG8_UB
}
}

constexpr int NWAVES = 8;
constexpr int N_LAUNCHES = MK_N_LAUNCHES;
constexpr int PER_PHASE = 6;
constexpr size_t MiB = 1u << 20;
constexpr size_t WS_CTL = 0, CTL_ZERO_BYTES = 65536;
constexpr size_t WS_WIN = 1 * MiB;
constexpr size_t WS_WA = 11 * MiB;
constexpr size_t WS_WB = 12 * MiB;
constexpr size_t WS_WOUT = 13 * MiB;
constexpr size_t WS_W1T = 15 * MiB;
constexpr size_t WS_SMALL = 17 * MiB;
constexpr size_t WS_SUM = 18 * MiB;
constexpr size_t WS_KC = 19 * MiB;
constexpr size_t WS_XN = 20 * MiB;
constexpr size_t WS_Q = 52 * MiB;
constexpr size_t WS_KV = 68 * MiB;
constexpr size_t WS_MB = 52 * MiB;
constexpr size_t WS_U = 92 * MiB;
constexpr size_t WS_BR = 108 * MiB;
constexpr size_t WS_GN = 116 * MiB;
constexpr size_t WS_GL = 132 * MiB;
constexpr size_t WS_MG = 148 * MiB;
constexpr size_t WS_VT = 212 * MiB;
constexpr size_t WS_KT = 216 * MiB;
constexpr size_t WS_Q2 = 220 * MiB;
constexpr size_t WS_LB = 236 * MiB;
constexpr size_t WS_END = 252 * MiB;
constexpr size_t SM_W2T = 0;
constexpr size_t SM_LWA = 65536;
constexpr size_t SM_LWX = 131072;
constexpr size_t SM_C1 = 262144;
constexpr size_t SM_LUT = 200704;
constexpr int CW_BAR = 4096;

constexpr int RING_BYTES = 160768;
constexpr int LDSCTL_OFF = RING_BYTES, MISC_OFF = LDSCTL_OFF + 320;
constexpr int LDS_BYTES = 163840;

#define RLX_AGENT __ATOMIC_RELAXED, __HIP_MEMORY_SCOPE_AGENT
#define LDS_WAIT() asm volatile("s_waitcnt lgkmcnt(0)" ::: "memory")
#define VM_WAIT() asm volatile("s_waitcnt vmcnt(0)" ::: "memory")

#define XB_TMO      128
#define XB_XCNT(j)  (256  + 64 * (j))
#define XB_XSUB(j)  (1280 + 64 * (j))
#define XB_XGEN(j)  (2304 + 64 * (j))
#define XB_TOP      3328
#define XB_TOPGEN   3392
#define XCD_BAR_WORDS 3456
#define XB_SPIN_CAP (1u << 18)
__device__ __forceinline__ unsigned xb_ld(unsigned* p)              { return __hip_atomic_load(p, __ATOMIC_RELAXED, __HIP_MEMORY_SCOPE_AGENT); }
__device__ __forceinline__ unsigned xb_add(unsigned* p, unsigned v) { return __hip_atomic_fetch_add(p, v, __ATOMIC_RELAXED, __HIP_MEMORY_SCOPE_AGENT); }
__device__ __forceinline__ unsigned xb_xcc_id() { return (unsigned)__builtin_amdgcn_s_getreg((3 << 11) | 20) & 0xFu; }
#define XB_SPIN(cond, bar) do { unsigned _sp = 0; while (cond) { __builtin_amdgcn_s_sleep(1); \
    if ((++_sp & 255u) == 0u) { if (xb_ld(&(bar)[XB_TMO])) break; if (_sp > XB_SPIN_CAP) { atomicAdd(&(bar)[XB_TMO], 1u); break; } } } } while (0)
struct XcdBarrier { unsigned* bar; unsigned x; volatile LAS unsigned* st; };
__device__ __forceinline__ XcdBarrier xcd_barrier_post(unsigned* bar, volatile LAS unsigned* st) {
    XcdBarrier b; b.bar = bar; b.x = xb_xcc_id(); b.st = st;
    if (threadIdx.x == 0) (void)xb_add(&bar[XB_XCNT(b.x)], 1u);
    return b;
}
__device__ __forceinline__ void xcd_barrier_complete(unsigned* bar, unsigned x, unsigned& nloc, unsigned& nx) {
    const unsigned G = gridDim.x * gridDim.y * gridDim.z;
    unsigned sum, cnt, mine, sp = 0u;
    for (;;) {
        sum = 0u; cnt = 0u; mine = 0u;
#pragma unroll
        for (unsigned j = 0; j < 16; ++j) { const unsigned c = xb_ld(&bar[XB_XCNT(j)]); sum += c; cnt += (c > 0u) ? 1u : 0u; mine = (j == x) ? c : mine; }
        if (sum == G) break;
        __builtin_amdgcn_s_sleep(1);
        if ((++sp & 255u) == 0u) { if (xb_ld(&bar[XB_TMO])) break; if (sp > XB_SPIN_CAP) { atomicAdd(&bar[XB_TMO], 1u); break; } }
    }
    nloc = mine > 0u ? mine : 1u; nx = cnt > 0u ? cnt : 1u;
}
__device__ __forceinline__ void xcd_barrier(const XcdBarrier& b) {
    asm volatile("s_waitcnt vmcnt(0)" ::: "memory");
    __syncthreads();
    if (threadIdx.x == 0) {
        unsigned* bar = b.bar;
        __builtin_amdgcn_s_waitcnt(0);
        unsigned nloc = b.st[0], nx = b.st[1];
        if (nloc == 0u) { xcd_barrier_complete(bar, b.x, nloc, nx); b.st[0] = nloc; b.st[1] = nx; }
        const unsigned old = xb_add(&bar[XB_XSUB(b.x)], 1u);
        const unsigned gen = old / nloc;
        if (old + 1u == (gen + 1u) * nloc) {
            __builtin_amdgcn_fence(__ATOMIC_RELEASE, "agent");
            asm volatile("s_waitcnt vmcnt(0)" ::: "memory");
            const unsigned og = xb_add(&bar[XB_TOP], 1u);
            const unsigned tg = og / nx;
            if (og + 1u == (tg + 1u) * nx) xb_add(&bar[XB_TOPGEN], 1u);
            else XB_SPIN(xb_ld(&bar[XB_TOPGEN]) == tg, bar);
            __builtin_amdgcn_fence(__ATOMIC_ACQUIRE, "agent");
            xb_add(&bar[XB_XGEN(b.x)], 1u);
            asm volatile("s_waitcnt vmcnt(0)" ::: "memory");
        } else {
            XB_SPIN(xb_ld(&bar[XB_XGEN(b.x)]) == gen, bar);
            __builtin_amdgcn_fence(__ATOMIC_ACQUIRE, "agent");
            asm volatile("s_waitcnt vmcnt(0)" ::: "memory");
        }
    }
    __syncthreads();
}

struct Args { const float* in[20]; float* out; unsigned char* ws; int ph_lo, ph_hi, li, pad; };
struct Frame {
    LAS unsigned char* lds;
    volatile LAS unsigned* MISC;
    int wave;
    int vcu, G;
    unsigned char* ws;
#define WSP(name, T, off) __device__ __forceinline__ T* name() const { return (T*)(ws + (off)); }
    WSP(WinT, bf16, WS_WIN) WSP(WaT, bf16, WS_WA) WSP(WbT, bf16, WS_WB) WSP(WoutT, bf16, WS_WOUT) WSP(W1T, bf16, WS_W1T)
    WSP(W2T, bf16, WS_SMALL + SM_W2T) WSP(LWA, bf16, WS_SMALL + SM_LWA) WSP(LWX, bf16, WS_SMALL + SM_LWX)
    WSP(C1, float, WS_SMALL + SM_C1) WSP(LUT, float, WS_SMALL + SM_LUT) WSP(SUMA, float, WS_SUM) WSP(SUMB, float, WS_SUM + 524288)
    WSP(KC, bf16, WS_KC) WSP(VC, bf16, WS_KC + 524288) WSP(XN, bf16, WS_XN) WSP(Q, bf16, WS_Q) WSP(KV, bf16, WS_KV) WSP(MB, bf16, WS_MB)
    WSP(VT, bf16, WS_VT) WSP(KT, bf16, WS_KT) WSP(Q2, bf16, WS_Q2) WSP(LB, bf16, WS_LB) WSP(U, bf16, WS_U) WSP(BR, bf16, WS_BR) WSP(GN, bf16, WS_GN) WSP(GL, bf16, WS_GL) WSP(MG, bf16, WS_MG)
#undef WSP
};

__device__ __forceinline__ int t5_bucket(int n) {
    if (n < 16) return n;
    const int thr[15] = {19, 21, 24, 27, 31, 35, 40, 46, 52, 59, 67, 77, 87, 99, 113};
    int b = 16;
#pragma unroll
    for (int i = 0; i < 15; ++i) b += (n >= thr[i]) ? 1 : 0;
    return b;
}

__device__ __forceinline__ void p0_tr_item(const float* W, int ldw, int k0, int srccol0, int nvalid, bf16* WT, int ldt, int dstrow0, LAS float* scr, int lane) {
    const int c = lane & 31;
    float tv[32];
#pragma unroll
    for (int i = 0; i < 32; ++i) { const int kk = 2 * i + (lane >> 5); tv[i] = (c < nvalid) ? W[(size_t)(k0 + kk) * ldw + srccol0 + c] : 0.f; }
#pragma unroll
    for (int i = 0; i < 32; ++i) { const int kk = 2 * i + (lane >> 5); scr[kk * 33 + c] = tv[i]; }
    LDS_WAIT(); asm volatile("" ::: "memory");
    const int cc = lane & 7;
#pragma unroll
    for (int j = 0; j < 4; ++j) { const int n = (lane >> 3) + 8 * j; const LAS float* s = scr + (8 * cc) * 33 + n;
        u32x4 o; o.x = pk2(s[0 * 33], s[1 * 33]); o.y = pk2(s[2 * 33], s[3 * 33]); o.z = pk2(s[4 * 33], s[5 * 33]); o.w = pk2(s[6 * 33], s[7 * 33]);
        *(u32x4*)(WT + (size_t)(dstrow0 + n) * ldt + k0 + 8 * cc) = o; }
    LDS_WAIT(); asm volatile("" ::: "memory");
}
__device__ __forceinline__ void win_src(int n0, int& src, int& nvalid) {
    nvalid = 32;
    if (n0 < 1280) src = n0;
    else if (n0 < 1792) src = 1816 + (n0 - 1280);
    else if (n0 < 2048) { src = 1792 + (n0 - 1792); nvalid = (n0 == 1792) ? 24 : 0; if (n0 != 1792) src = 0; }
    else if (n0 < 2560) src = 1280 + (n0 - 2048);
    else if (n0 < 3072) src = 2328 + (n0 - 2560);
    else src = 2840 + (n0 - 3072);
}
__device__ __forceinline__ void p0_prologue(const Frame& F, const Args& A) {
    LAS float* scr = (LAS float*)(F.lds + F.wave * 16384);
    const int gw = F.vcu * NWAVES + F.wave, NGW = F.G * NWAVES, lane = lane_id();
    constexpr int I_WIN = 16 * 160, I_WA = 8 * 32, I_WO = 16 * 32, I_W1 = 32 * 8, I_W2 = 4 * 2, I_LR = 2;
    constexpr int NIT = I_WIN + 2 * I_WA + I_WO + 2 * I_W1 + 2 * I_W2 + 16 * I_LR + 256 + 1;
    for (int it = gw; it < NIT; it += NGW) {
        int r = it;
        if (r < I_WIN) { const int kb = r / 160, nb = r % 160; int src, nv; win_src(32 * nb, src, nv); p0_tr_item(A.in[2], 4888, 64 * kb, src, nv, F.WinT(), 1024, 32 * nb, scr, lane); continue; } r -= I_WIN;
        if (r < I_WA) { p0_tr_item(A.in[17], 1024, 64 * (r / 32), 32 * (r % 32), 32, F.WaT(), 512, 32 * (r % 32), scr, lane); continue; } r -= I_WA;
        if (r < I_WA) { p0_tr_item(A.in[18], 1024, 64 * (r / 32), 32 * (r % 32), 32, F.WbT(), 512, 32 * (r % 32), scr, lane); continue; } r -= I_WA;
        if (r < I_WO) { p0_tr_item(A.in[19], 1024, 64 * (r / 32), 32 * (r % 32), 32, F.WoutT(), 1024, 32 * (r % 32), scr, lane); continue; } r -= I_WO;
        if (r < 2 * I_W1) { const int kv = r / I_W1, q = r % I_W1; p0_tr_item(A.in[6] + (size_t)kv * 2048 * 256, 256, 64 * (q / 8), 32 * (q % 8), 32, F.W1T() + (size_t)kv * 256 * 2048, 2048, 32 * (q % 8), scr, lane); continue; } r -= 2 * I_W1;
        if (r < 2 * I_W2) { const int kv = r / I_W2, q = r % I_W2; p0_tr_item(A.in[8] + (size_t)kv * 256 * 64, 64, 64 * (q / 2), 32 * (q % 2), 32, F.W2T() + (size_t)kv * 64 * 256, 256, 32 * (q % 2), scr, lane); continue; } r -= 2 * I_W2;
        if (r < 16 * I_LR) { const int mtx = r / 2, nb = r % 2; const float* src = (mtx < 8 ? A.in[12] : A.in[14]) + (size_t)(mtx & 7) * 4096; bf16* dst = (mtx < 8 ? F.LWA() : F.LWX()) + (size_t)(mtx & 7) * 4096;
            p0_tr_item(src, 64, 0, 32 * nb, 32, dst, 64, 32 * nb, scr, lane); continue; } r -= 16 * I_LR;
        if (r < 256) {
            const int kc = r >> 3, kv = (r >> 2) & 1, n = (r & 3) * 64 + lane; const float* w1 = A.in[6] + (size_t)kv * 2048 * 256 + (size_t)(64 * kc) * 256 + n; const float* pe = A.in[5] + kv * 2048 + 64 * kc;
            float s0 = 0.f, s1 = 0.f, s2 = 0.f, s3 = 0.f;
#pragma unroll 4
            for (int k = 0; k < 64; k += 4) { s0 += pe[k] * w1[(size_t)k * 256]; s1 += pe[k + 1] * w1[(size_t)(k + 1) * 256]; s2 += pe[k + 2] * w1[(size_t)(k + 2) * 256]; s3 += pe[k + 3] * w1[(size_t)(k + 3) * 256]; }
            F.C1()[(kc * 2 + kv) * 256 + n] = (s0 + s1) + (s2 + s3); continue; } r -= 256;
        {
            for (int e = lane; e < 1024; e += 64) { const int hd = e >> 7, n = e & 127; F.LUT()[e] = A.in[9][t5_bucket(n) * 8 + hd] * LOG2E; }
        }
    }
    const float* gain = A.in[1];
    {
        f32x4 v[4], vn[4];
        if (gw < SEQ) { const f32x4* xr = (const f32x4*)(A.in[0] + (size_t)gw * DM) + lane;
#pragma unroll
            for (int j = 0; j < 4; ++j) v[j] = xr[64 * j]; }
        for (int m = gw; m < SEQ; m += NGW) {
            if (m + NGW < SEQ) { const f32x4* xr = (const f32x4*)(A.in[0] + (size_t)(m + NGW) * DM) + lane;
#pragma unroll
                for (int j = 0; j < 4; ++j) vn[j] = xr[64 * j]; }
            float s = 0.f;
#pragma unroll
            for (int j = 0; j < 4; ++j) s += (v[j].x * v[j].x + v[j].y * v[j].y) + (v[j].z * v[j].z + v[j].w * v[j].w);
            const float rs = 1.0f / sqrtf(wave_sum(s) * (1.f / DM) + RMS_EPS);
            unsigned long long* o8 = (unsigned long long*)(F.XN() + (size_t)m * DM) + lane;
#pragma unroll
            for (int j = 0; j < 4; ++j) { const f32x4 gv = ((const f32x4*)gain)[lane + 64 * j];
                o8[64 * j] = (unsigned long long)pk2(v[j].x * rs * gv.x, v[j].y * rs * gv.y) | ((unsigned long long)pk2(v[j].z * rs * gv.z, v[j].w * rs * gv.w) << 32); }
#pragma unroll
            for (int j = 0; j < 4; ++j) v[j] = vn[j];
        }
    }
}

template <bool FINAL>
__device__ __forceinline__ void lru_tile(const Frame& F, const Args& A, int tt) {
    const int lane = lane_id();
    const int w = F.wave, fr = lane & 15, fq = lane >> 4, ch0 = 64 * w, t0 = 64 * tt;
    LAS float* UC = (LAS float*)(F.lds + w * 16384);
#define UC_IDX(tok, ch) ((tok) * 64 + ((((ch) >> 2) ^ ((tok) & 15)) << 2) + ((ch) & 3))
    float Hc = 0.f;
    if (FINAL) {
        const float* sa = F.SUMA() + ch0 + lane; const float* sb = F.SUMB() + ch0 + lane;
        int i = 0;
        for (; i + 64 <= tt; i += 64) { float ta[64], tb[64];
#pragma unroll
            for (int k = 0; k < 64; ++k) { ta[k] = sa[(size_t)(i + k) * 512]; tb[k] = sb[(size_t)(i + k) * 512]; }
#pragma unroll
            for (int k = 0; k < 64; ++k) Hc = ta[k] * Hc + tb[k]; }
        for (; i + 16 <= tt; i += 16) { float ta[16], tb[16];
#pragma unroll
            for (int k = 0; k < 16; ++k) { ta[k] = sa[(size_t)(i + k) * 512]; tb[k] = sb[(size_t)(i + k) * 512]; }
#pragma unroll
            for (int k = 0; k < 16; ++k) Hc = ta[k] * Hc + tb[k]; }
        for (; i < tt; ++i) Hc = sa[(size_t)i * 512] * Hc + sb[(size_t)i * 512];
        asm volatile("" : "+v"(Hc));
    }
    {
        const int ch = ch0 + lane; const float* cw = A.in[10]; const float cb = A.in[11][ch];
        const float w0 = cw[ch], w1 = cw[512 + ch], w2 = cw[1024 + ch], w3 = cw[1536 + ch];
        const bf16* up = F.U() + (size_t)t0 * 512 + ch;
        float u0 = 0.f, u1 = 0.f, u2 = 0.f;
        if (tt > 0) { u0 = bf2f(up[-3 * 512]); u1 = bf2f(up[-2 * 512]); u2 = bf2f(up[-1 * 512]); }
        unsigned short ur[64];
#pragma unroll
        for (int tok = 0; tok < 64; ++tok) ur[tok] = up[(size_t)tok * 512];
#pragma unroll
        for (int tok = 0; tok < 64; ++tok) { const float u3 = bf2f(ur[tok]);
            UC[UC_IDX(tok, lane)] = cb + ((u0 * w0 + u1 * w1) + (u2 * w2 + u3 * w3)); u0 = u1; u1 = u2; u2 = u3; }
    }
    bf16x8 Ba[4][2], Bx[4][2];
#pragma unroll
    for (int nt = 0; nt < 4; ++nt)
#pragma unroll
        for (int ks = 0; ks < 2; ++ks) { const size_t o = (size_t)w * 4096 + (16 * nt + fr) * 64 + 32 * ks + 8 * fq; Ba[nt][ks] = *(const bf16x8*)(F.LWA() + o); Bx[nt][ks] = *(const bf16x8*)(F.LWX() + o); }
    float ba[4], bx[4], sp8[4], hin[4], acum[4];
#pragma unroll
    for (int nt = 0; nt < 4; ++nt) { const int ch = ch0 + 16 * nt + fr; ba[nt] = A.in[13][ch]; bx[nt] = A.in[15][ch];
        sp8[nt] = 8.0f * log1pf(expf(-A.in[16][ch])); hin[nt] = 0.f; acum[nt] = 1.f; }
    if (FINAL) {
#pragma unroll
        for (int nt = 0; nt < 4; ++nt) hin[nt] = __shfl(Hc, 16 * nt + fr);
    }
    LDS_WAIT();
    unsigned short glv[16], gln[16];
    if (FINAL) {
#pragma unroll
        for (int nt = 0; nt < 4; ++nt)
#pragma unroll
            for (int rg = 0; rg < 4; ++rg) glv[nt * 4 + rg] = F.GL()[(size_t)(t0 + 4 * fq + rg) * 512 + ch0 + 16 * nt + fr];
    }
#pragma unroll 1
    for (int mt = 0; mt < 4; ++mt) {
        if (FINAL && mt < 3) {
#pragma unroll
            for (int nt = 0; nt < 4; ++nt)
#pragma unroll
                for (int rg = 0; rg < 4; ++rg) gln[nt * 4 + rg] = F.GL()[(size_t)(t0 + 16 * (mt + 1) + 4 * fq + rg) * 512 + ch0 + 16 * nt + fr];
        }
        bf16x8 Af[2];
#pragma unroll
        for (int ks = 0; ks < 2; ++ks) { const int tok = 16 * mt + fr, c0 = 8 * ks + 2 * fq;
            const f32x4 x0 = *(const LAS f32x4*)(UC + tok * 64 + ((c0 ^ (tok & 15)) << 2)), x1 = *(const LAS f32x4*)(UC + tok * 64 + (((c0 + 1) ^ (tok & 15)) << 2));
            u32x4 pw; pw.x = cvtpk(x0[0], x0[1]); pw.y = cvtpk(x0[2], x0[3]); pw.z = cvtpk(x1[0], x1[1]); pw.w = cvtpk(x1[2], x1[3]); Af[ks] = __builtin_bit_cast(bf16x8, pw); }
        f32x4 cr[4], ci[4];
#pragma unroll
        for (int nt = 0; nt < 4; ++nt) { cr[nt] = (f32x4){0.f, 0.f, 0.f, 0.f}; ci[nt] = (f32x4){0.f, 0.f, 0.f, 0.f};
#pragma unroll
            for (int ks = 0; ks < 2; ++ks) { cr[nt] = __builtin_amdgcn_mfma_f32_16x16x32_bf16(Af[ks], Ba[nt][ks], cr[nt], 0, 0, 0); ci[nt] = __builtin_amdgcn_mfma_f32_16x16x32_bf16(Af[ks], Bx[nt][ks], ci[nt], 0, 0, 0); } }
#pragma unroll
        for (int nt = 0; nt < 4; ++nt) {
            float P[4], Hh[4];
#pragma unroll
            for (int rg = 0; rg < 4; ++rg) { const int tok = 16 * mt + 4 * fq + rg, e = 16 * nt + fr;
                const float ucv = UC[UC_IDX(tok, e)];
                const float r = fsigmoid(cr[nt][rg] + ba[nt]), ig = fsigmoid(ci[nt][rg] + bx[nt]);
                const float la = -r * sp8[nt]; const float a = __builtin_amdgcn_exp2f(la * LOG2E);
                const float x2 = 2.0f * la;
                const float ser = -x2 * (1.0f + x2 * (0.5f + x2 * (0.16666667f + x2 * (0.041666668f + x2 * 0.008333334f))));
                const float om = (x2 > -0.25f) ? ser : 1.0f - a * a;
                const float b = __builtin_amdgcn_sqrtf(om) * (ig * ucv);
                if (!FINAL) {
                    const float so = -la * (1.0f + la * (0.5f + la * (0.16666667f + la * (0.041666668f + la * 0.008333334f))));
                    const float oma = (la > -0.25f) ? so : 1.0f - a; const size_t tg = (size_t)(t0 + tok); const int chg = ch0 + e;
                    F.XN()[tg * 1024 + 512 + chg] = (bf16)f2bf(oma); F.LB()[tg * 512 + chg] = (bf16)f2bf(b); }
                if (rg == 0) { P[0] = a; Hh[0] = b; } else { P[rg] = P[rg - 1] * a; Hh[rg] = a * Hh[rg - 1] + b; } }
            float At = P[3], Bt = Hh[3];
            { const float Ap = __shfl_up(At, 16), Bp = __shfl_up(Bt, 16); if (fq >= 1) { Bt = At * Bp + Bt; At = Ap * At; } }
            { const float Ap = __shfl_up(At, 32), Bp = __shfl_up(Bt, 32); if (fq >= 2) { Bt = At * Bp + Bt; At = Ap * At; } }
            float Aex = __shfl_up(At, 16), Bex = __shfl_up(Bt, 16); if (fq == 0) { Aex = 1.f; Bex = 0.f; }
            const float hg = Aex * hin[nt] + Bex;
            float hv[4];
#pragma unroll
            for (int rg = 0; rg < 4; ++rg) hv[rg] = P[rg] * hg + Hh[rg];
            hin[nt] = __shfl(hv[3], 48 + fr);
            if (!FINAL) acum[nt] *= __shfl(At, 48 + fr);
            if (FINAL) {
#pragma unroll
                for (int rg = 0; rg < 4; ++rg) { const size_t t = (size_t)(t0 + 16 * mt + 4 * fq + rg); const int ch = ch0 + 16 * nt + fr;
                    F.XN()[t * 1024 + 512 + ch] = (bf16)f2bf(hv[rg] * bf2f(glv[nt * 4 + rg])); }
            }
        }
        if (FINAL) {
#pragma unroll
            for (int x = 0; x < 16; ++x) glv[x] = gln[x];
        }
    }
    if (!FINAL && fq == 0) {
#pragma unroll
        for (int nt = 0; nt < 4; ++nt) { F.SUMA()[(size_t)tt * 512 + ch0 + 16 * nt + fr] = acum[nt]; F.SUMB()[(size_t)tt * 512 + ch0 + 16 * nt + fr] = hin[nt]; }
    }
    LDS_WAIT();
#undef UC_IDX
}

__device__ __forceinline__ void lru_apply(const Frame& F, int tt) {
    const int lane = lane_id(), ch = 64 * F.wave + lane, t0 = 64 * tt;
    float H = 0.f;
    { const float* sa = F.SUMA() + ch; const float* sb = F.SUMB() + ch; int i = 0;
        for (; i + 64 <= tt; i += 64) { float ta[64], tb[64];
#pragma unroll
            for (int k = 0; k < 64; ++k) { ta[k] = sa[(size_t)(i + k) * 512]; tb[k] = sb[(size_t)(i + k) * 512]; }
#pragma unroll
            for (int k = 0; k < 64; ++k) H = ta[k] * H + tb[k]; }
        for (; i + 16 <= tt; i += 16) { float ta[16], tb[16];
#pragma unroll
            for (int k = 0; k < 16; ++k) { ta[k] = sa[(size_t)(i + k) * 512]; tb[k] = sb[(size_t)(i + k) * 512]; }
#pragma unroll
            for (int k = 0; k < 16; ++k) H = ta[k] * H + tb[k]; }
        for (; i < tt; ++i) H = sa[(size_t)i * 512] * H + sb[(size_t)i * 512]; }
    bf16* px = F.XN() + (size_t)t0 * 1024 + 512 + ch; const bf16* pb = F.LB() + (size_t)t0 * 512 + ch; const bf16* pg = F.GL() + (size_t)t0 * 512 + ch;
#pragma unroll 1
    for (int c = 0; c < 2; ++c) { unsigned short av[32], bv[32], gv[32];
#pragma unroll
        for (int k = 0; k < 32; ++k) { const size_t tk = (size_t)(32 * c + k); av[k] = px[tk * 1024]; bv[k] = pb[tk * 512]; gv[k] = pg[tk * 512]; }
#pragma unroll
        for (int k = 0; k < 32; ++k) { H = (1.0f - bf2f(av[k])) * H + bf2f(bv[k]); px[(size_t)(32 * c + k) * 1024] = (bf16)f2bf(H * bf2f(gv[k])); } }
}

__device__ __forceinline__ void qk_norm_tile(const Frame& F, const Args& A, int tt) {
    const int lane = lane_id(), sub = lane & 7;
#pragma unroll 4
    for (int it = 0; it < 12; ++it) {
        const int idx = it * 64 + F.wave * 8 + (lane >> 3), tok = idx / 12, hr = idx % 12; const size_t t = (size_t)(64 * tt + tok);
        bf16* p; bf16* dst; const float* gain; float sc = 1.f;
        if (hr < 8) { p = F.Q() + t * 512 + hr * 64; dst = F.Q2() + t * 512 + (hr >> 2) * 256 + (sub >> 1) * 64 + (hr & 3) * 16 + (sub & 1) * 8 - sub * 8; gain = A.in[3]; sc = 0.125f * LOG2E; }
        else if (hr < 10) { p = F.KV() + t * 768 + 256 + (hr - 8) * 64; dst = p; gain = A.in[4] + 64; }
        else { p = F.KV() + t * 768 + 512 + (hr - 10) * 64; dst = p; gain = A.in[4] + 128; }
        const u32x4 w = *(const u32x4*)(p + sub * 8);
        float x[8] = {bflo(w.x), bfhi(w.x), bflo(w.y), bfhi(w.y), bflo(w.z), bfhi(w.z), bflo(w.w), bfhi(w.w)};
        float ss = 0.f;
#pragma unroll
        for (int j = 0; j < 8; ++j) ss += x[j] * x[j];
        ss += __shfl_xor(ss, 1); ss += __shfl_xor(ss, 2); ss += __shfl_xor(ss, 4);
        const float rs = sc / sqrtf(ss * (1.f / 64.f) + RMS_EPS);
        const f32x4 g0 = *(const f32x4*)(gain + sub * 8), g1 = *(const f32x4*)(gain + sub * 8 + 4);
        u32x4 o; o.x = pk2(x[0] * rs * g0.x, x[1] * rs * g0.y); o.y = pk2(x[2] * rs * g0.z, x[3] * rs * g0.w); o.z = pk2(x[4] * rs * g1.x, x[5] * rs * g1.y); o.w = pk2(x[6] * rs * g1.z, x[7] * rs * g1.w);
        *(u32x4*)(dst + sub * 8) = o;
        if (hr >= 8 && hr < 10) {
            int w0 = __builtin_amdgcn_cvt_pk_fp8_f32(x[0] * rs * g0.x, x[1] * rs * g0.y, 0, false); w0 = __builtin_amdgcn_cvt_pk_fp8_f32(x[2] * rs * g0.z, x[3] * rs * g0.w, w0, true);
            int w1 = __builtin_amdgcn_cvt_pk_fp8_f32(x[4] * rs * g1.x, x[5] * rs * g1.y, 0, false); w1 = __builtin_amdgcn_cvt_pk_fp8_f32(x[6] * rs * g1.z, x[7] * rs * g1.w, w1, true);
            u32x2* kt8 = (u32x2*)F.KT() + (size_t)((hr - 8) * 256 + tt) * 512 + ((((sub >> 2) * 4 + (tok >> 4)) * 4 + (sub & 3)) * 16 + (tok & 15));
            *kt8 = (u32x2){(unsigned)w0, (unsigned)w1}; }
    }
}

__device__ __forceinline__ void vt_tile(const Frame& F, int J) {
    const int tid = F.wave * 64 + lane_id(), d = tid & 63, ks = (tid >> 6) & 1, gp = tid >> 7;
#pragma unroll
    for (int g = 0; g < 2; ++g) {
        const bf16* vp = F.KV() + (size_t)(64 * J) * 768 + 384 + 64 * g + d;
        unsigned short e[8];
#pragma unroll
        for (int j = 0; j < 8; ++j) { const int key = 32 * ks + 4 * gp + (j & 3) + 16 * (j >> 2); e[j] = vp[(size_t)key * 768]; }
        u32x4 w; w.x = e[0] | ((unsigned)e[1] << 16); w.y = e[2] | ((unsigned)e[3] << 16); w.z = e[4] | ((unsigned)e[5] << 16); w.w = e[6] | ((unsigned)e[7] << 16);
        *(u32x4*)(F.VT() + (size_t)(g * 256 + J) * 4096 + ((((d >> 4) * 2 + ks) * 16 + (d & 15)) * 32) + 8 * gp) = w;
    }
}

__device__ __forceinline__ void compress_item(const Frame& F, const Args& A, int kv, int g, int ct) {
    const int lane = lane_id(), w = F.wave, tid = w * 64 + lane, fr = lane & 15, fq = lane >> 4, c0 = 16 * ct, tb = 16 * c0;
    LAS unsigned char* T = F.lds;
    LAS bf16* HID = (LAS bf16*)(F.lds + 34816);
    LAS float* OUTF = (LAS float*)(F.lds + 34816 + 8448);
    LAS float* C1L = (LAS float*)(F.lds + 34816 + 8448 + 4096);
    {
        u32x4 tv[5];
#pragma unroll
        for (int i = 0; i < 5; ++i) { const int idx = tid + 512 * i, tok = idx >> 3, chn = idx & 7, gt = tb + tok; tv[i] = (u32x4){0u, 0u, 0u, 0u};
            if (idx < 272 * 8 && gt < SEQ) tv[i] = *(const u32x4*)(F.KV() + (size_t)gt * 768 + kv * 128 + g * 64 + chn * 8); }
        { const int n = tid & 255, hf = tid >> 8; float pc[16];
#pragma unroll
            for (int k = 0; k < 16; ++k) pc[k] = F.C1()[((hf * 16 + k) * 2 + kv) * 256 + n];
            float s = hf ? 0.f : A.in[7][kv * 256 + n];
#pragma unroll
            for (int k = 0; k < 16; ++k) s += pc[k];
            C1L[hf * 256 + n] = s; }
#pragma unroll
        for (int i = 0; i < 5; ++i) { const int idx = tid + 512 * i, tok = idx >> 3, chn = idx & 7;
            if (idx < 272 * 8) *(LAS u32x4*)(T + tok * 128 + ((chn ^ ((tok >> 4) & 7)) << 4)) = tv[i]; }
    }
    LDS_WAIT(); __syncthreads();
    f32x4 acc[2] = {(f32x4){0.f, 0.f, 0.f, 0.f}, (f32x4){0.f, 0.f, 0.f, 0.f}};
    const bf16* w1t = F.W1T() + (size_t)kv * 256 * 2048 + (size_t)(32 * w + fr) * 2048 + 8 * fq;
#pragma unroll 32
    for (int ks = 0; ks < 64; ++ks) {
        const int tok = 16 * fr + (ks >> 1), chn = 4 * (ks & 1) + fq;
        const bf16x8 a = *(const LAS bf16x8*)(T + tok * 128 + ((chn ^ ((tok >> 4) & 7)) << 4));
        const bf16x8 b0 = *(const bf16x8*)(w1t + 32 * ks), b1 = *(const bf16x8*)(w1t + (size_t)16 * 2048 + 32 * ks);
        acc[0] = __builtin_amdgcn_mfma_f32_16x16x32_bf16(a, b0, acc[0], 0, 0, 0);
        acc[1] = __builtin_amdgcn_mfma_f32_16x16x32_bf16(a, b1, acc[1], 0, 0, 0);
    }
#pragma unroll
    for (int nt = 0; nt < 2; ++nt) { const int n = 32 * w + 16 * nt + fr; const float c1 = C1L[n] + C1L[256 + n];
#pragma unroll
        for (int rg = 0; rg < 4; ++rg) { const float v = acc[nt][rg] + c1; HID[(4 * fq + rg) * 264 + n] = (bf16)f2bf(v * fsigmoid(v)); } }
    LDS_WAIT(); __syncthreads();
    if (w < 4) {
        f32x4 o = (f32x4){0.f, 0.f, 0.f, 0.f};
        const bf16* w2t = F.W2T() + (size_t)kv * 64 * 256 + (size_t)(16 * w + fr) * 256 + 8 * fq;
#pragma unroll
        for (int ks = 0; ks < 8; ++ks) { const bf16x8 a = *(const LAS bf16x8*)(HID + fr * 264 + 32 * ks + 8 * fq); const bf16x8 b = *(const bf16x8*)(w2t + 32 * ks);
            o = __builtin_amdgcn_mfma_f32_16x16x32_bf16(a, b, o, 0, 0, 0); }
#pragma unroll
        for (int rg = 0; rg < 4; ++rg) OUTF[(4 * fq + rg) * 64 + 16 * w + fr] = o[rg];
    }
    LDS_WAIT(); __syncthreads();
    {
        const int row = tid >> 5, e = 2 * (tid & 31), c = c0 + row;
        float v0 = OUTF[row * 64 + e], v1 = OUTF[row * 64 + e + 1];
        if (kv == 0) { float ss = v0 * v0 + v1 * v1;
#pragma unroll
            for (int o = 1; o < 32; o <<= 1) ss += __shfl_xor(ss, o);
            const float rs = 1.0f / sqrtf(ss * (1.f / 64.f) + RMS_EPS); v0 *= rs * A.in[4][e]; v1 *= rs * A.in[4][e + 1]; }
        if (c >= 1023) { v0 = 0.f; v1 = 0.f; }
        bf16* dst = (kv == 0 ? F.KC() : F.VC()) + ((size_t)g * 1024 + c) * 64 + e;
        *(unsigned*)dst = pk2(v0, v1);
    }
    LDS_WAIT(); __syncthreads();
}

namespace att {
constexpr int SLOTB = 8192, NSLOT = 3;
constexpr int L_K = 0, L_V = NSLOT * SLOTB, L_SC = 2 * NSLOT * SLOTB, L_OUT = L_SC + 65536, L_LUT = L_OUT + 32768, L_WSF = L_LUT + 2048, L_BM = L_WSF + 2048, L_REF = L_BM + 2048, L_LACC = L_REF + 1024, L_TL = L_LACC + 1024  , L_END = L_TL + 5120;
static_assert(L_END <= RING_BYTES, "attention LDS map");
constexpr int L_EX = 0  ,
              L_HDR = 69632  , L_LEX = 70144  , L_NT = 71168  ;
static_assert(L_NT + 32 <= L_SC + 65536, "part B exchange area");
constexpr float CLAMP = 100.0f;
constexpr float THR = 8.0f;
#define SBAR() __builtin_amdgcn_sched_barrier(0)
__device__ __forceinline__ int crow(int r, int hi) { return (r & 3) + 8 * (r >> 2) + 4 * hi; }
__device__ __forceinline__ void glds16(const void* gsrc, unsigned lds_dst) { unsigned keep;
    asm volatile("s_mov_b32 %0, m0\n\ts_mov_b32 m0, %2\n\ts_nop 0\n\tglobal_load_lds_dwordx4 %1, off\n\ts_mov_b32 m0, %0" : "=&s"(keep) : "v"(gsrc), "s"(lds_dst) : "memory"); }
__device__ __forceinline__ void qkt(f32x16& p0, f32x16& p1, const LAS unsigned char* Kslot, const bf16x8* qr, int r32, int hi) {
    const LAS unsigned char* kb = Kslot + hi * 1024 + r32 * 16;
    const f32x16 z = {0.f, 0.f, 0.f, 0.f, 0.f, 0.f, 0.f, 0.f, 0.f, 0.f, 0.f, 0.f, 0.f, 0.f, 0.f, 0.f};
#pragma unroll
    for (int d0 = 0; d0 < 4; ++d0) {
        const bf16x8 b0 = *(const LAS bf16x8*)(kb + d0 * 2048);
        const bf16x8 b1 = *(const LAS bf16x8*)(kb + d0 * 2048 + 512);
        if (d0 == 0) { p0 = __builtin_amdgcn_mfma_f32_32x32x16_bf16(b0, qr[0], z, 0, 0, 0); p1 = __builtin_amdgcn_mfma_f32_32x32x16_bf16(b1, qr[0], z, 0, 0, 0); }
        else { p0 = __builtin_amdgcn_mfma_f32_32x32x16_bf16(b0, qr[d0], p0, 0, 0, 0); p1 = __builtin_amdgcn_mfma_f32_32x32x16_bf16(b1, qr[d0], p1, 0, 0, 0); } }
}
__device__ __forceinline__ void pv(f32x16* o, int vb, bf16x8 pa0, bf16x8 pa1, bf16x8 pa2, bf16x8 pa3) {
    s16x4 lo[8], hi[8];
#pragma unroll
    for (int x = 0; x < 8; ++x) {
        asm volatile("ds_read_b64_tr_b16 %0,%1 offset:%c2" : "=&v"(lo[x]) : "v"(vb), "i"((x >> 2) * 4096 + (x & 3) * 1024) : "memory");
        asm volatile("ds_read_b64_tr_b16 %0,%1 offset:%c2" : "=&v"(hi[x]) : "v"(vb), "i"((x >> 2) * 4096 + (x & 3) * 1024 + 512) : "memory"); }
    asm volatile("s_waitcnt lgkmcnt(0)" ::: "memory"); SBAR();
#define PK(k) (bf16x8){lo[k][0], lo[k][1], lo[k][2], lo[k][3], hi[k][0], hi[k][1], hi[k][2], hi[k][3]}
    o[0] = __builtin_amdgcn_mfma_f32_32x32x16_bf16(pa0, PK(0), o[0], 0, 0, 0); o[1] = __builtin_amdgcn_mfma_f32_32x32x16_bf16(pa0, PK(4), o[1], 0, 0, 0);
    o[0] = __builtin_amdgcn_mfma_f32_32x32x16_bf16(pa1, PK(1), o[0], 0, 0, 0); o[1] = __builtin_amdgcn_mfma_f32_32x32x16_bf16(pa1, PK(5), o[1], 0, 0, 0);
    o[0] = __builtin_amdgcn_mfma_f32_32x32x16_bf16(pa2, PK(2), o[0], 0, 0, 0); o[1] = __builtin_amdgcn_mfma_f32_32x32x16_bf16(pa2, PK(6), o[1], 0, 0, 0);
    o[0] = __builtin_amdgcn_mfma_f32_32x32x16_bf16(pa3, PK(3), o[0], 0, 0, 0); o[1] = __builtin_amdgcn_mfma_f32_32x32x16_bf16(pa3, PK(7), o[1], 0, 0, 0);
#undef PK
}
__device__ __forceinline__ float rowmax(const f32x16& p0, const f32x16& p1) {
    float a = fmaxf(fmaxf(p0[0], p0[1]), p1[0]), b = fmaxf(fmaxf(p0[2], p0[3]), p1[1]); a = fmaxf(fmaxf(a, p1[2]), p1[3]);
#pragma unroll
    for (int r = 4; r < 16; r += 4) { a = fmaxf(fmaxf(a, p0[r]), p0[r + 1]); b = fmaxf(fmaxf(b, p0[r + 2]), p0[r + 3]); a = fmaxf(fmaxf(a, p1[r]), p1[r + 1]); b = fmaxf(fmaxf(b, p1[r + 2]), p1[r + 3]); }
    const float m = fmaxf(a, b);
    auto rr = __builtin_amdgcn_permlane32_swap(__float_as_uint(m), __float_as_uint(m), false, false);
    return fmaxf(__uint_as_float(rr[0]), __uint_as_float(rr[1]));
}
__device__ __forceinline__ float halfsum(float v) { auto rr = __builtin_amdgcn_permlane32_swap(__float_as_uint(v), __float_as_uint(v), false, false); return __uint_as_float(rr[0]) + __uint_as_float(rr[1]); }
template <int STEP, unsigned LIMIT>
__device__ __forceinline__ void near_apply(f32x16& p0, f32x16& p1, int dbase, const LAS float* lut) {
    float b0[16], b1[16];
#pragma unroll
    for (int r = 0; r < 16; ++r) { const int koff = (r & 3) + 8 * (r >> 2); const int d0 = dbase - STEP * koff, d1 = d0 - STEP * 32;
        b0[r] = lut[4 * min(max(d0, 0), 127)]; b1[r] = lut[4 * min(max(d1, 0), 127)]; }
#pragma unroll
    for (int r = 0; r < 16; ++r) { asm volatile("" : "+v"(b0[r]), "+v"(b1[r])); }
#pragma unroll
    for (int r = 0; r < 16; ++r) { const int koff = (r & 3) + 8 * (r >> 2); const int d0 = dbase - STEP * koff, d1 = d0 - STEP * 32;
        const float t0 = p0[r] + b0[r], t1 = p1[r] + b1[r];
        p0[r] = ((unsigned)d0 < LIMIT) ? t0 : -INFINITY; p1[r] = ((unsigned)d1 < LIMIT) ? t1 : -INFINITY; }
}
template <bool HASO>
__device__ __forceinline__ void sm_update(f32x16& p0, f32x16& p1, float bias, float& m, float& l, f32x16* o, LAS float* wsf, int r32, int hi) {
    const float rm = rowmax(p0, p1) + bias;
    const bool need = rm > m + THR;
    if (__any(need)) {
        const float mn = need ? rm : m; const float alpha = __builtin_amdgcn_exp2f(m - mn);
        l *= alpha; m = mn;
        if (HASO) { if (hi == 0) wsf[r32] = alpha; LDS_WAIT();
#pragma unroll
            for (int r = 0; r < 16; ++r) { const float f = wsf[crow(r, hi)]; o[0][r] *= f; o[1][r] *= f; } }
    }
    const float mb = m - bias;
#pragma unroll
    for (int r = 0; r < 16; ++r) { p0[r] = __builtin_amdgcn_exp2f(p0[r] - mb); p1[r] = __builtin_amdgcn_exp2f(p1[r] - mb); }
    float t[8];
#pragma unroll
    for (int r = 0; r < 8; ++r) t[r] = (p0[2 * r] + p0[2 * r + 1]) + (p1[2 * r] + p1[2 * r + 1]);
    l += ((t[0] + t[1]) + (t[2] + t[3])) + ((t[4] + t[5]) + (t[6] + t[7]));
}
#define ATT_PACK(P0, P1) \
    const bf16x8 pa0 = __builtin_bit_cast(bf16x8, (u32x4){cvtpk(P0[0], P0[1]), cvtpk(P0[2], P0[3]), cvtpk(P0[4], P0[5]), cvtpk(P0[6], P0[7])}); \
    const bf16x8 pa1 = __builtin_bit_cast(bf16x8, (u32x4){cvtpk(P0[8], P0[9]), cvtpk(P0[10], P0[11]), cvtpk(P0[12], P0[13]), cvtpk(P0[14], P0[15])}); \
    const bf16x8 pa2 = __builtin_bit_cast(bf16x8, (u32x4){cvtpk(P1[0], P1[1]), cvtpk(P1[2], P1[3]), cvtpk(P1[4], P1[5]), cvtpk(P1[6], P1[7])}); \
    const bf16x8 pa3 = __builtin_bit_cast(bf16x8, (u32x4){cvtpk(P1[8], P1[9]), cvtpk(P1[10], P1[11]), cvtpk(P1[12], P1[13]), cvtpk(P1[14], P1[15])});
#define ATT_WAITBAR(N) asm volatile("s_waitcnt vmcnt(" #N ") lgkmcnt(0)\n\ts_barrier" ::: "memory")
#define ATT_FILL(V, x) do { _Pragma("unroll") for (int _r = 0; _r < 16; ++_r) V[_r] = (x); } while (0)

__device__ __forceinline__ unsigned rangemask(int k, int a, int b) {
    const int lo = max(a - 32 * k, 0), hi = min(b - 32 * k, 31);
    return (lo > hi) ? 0u : ((0xFFFFFFFFu >> (31 - hi)) & (0xFFFFFFFFu << lo));
}
__device__ __forceinline__ int wave_max_i32(int x) {
    x = max(x, dpp_i<0xB1>(x)); x = max(x, dpp_i<0x4E>(x)); x = max(x, dpp_i<0x141>(x)); x = max(x, dpp_i<0x140>(x));
    return max(max(__builtin_amdgcn_readlane(x, 0), __builtin_amdgcn_readlane(x, 16)), max(__builtin_amdgcn_readlane(x, 32), __builtin_amdgcn_readlane(x, 48)));
}

__device__ __forceinline__ void lds_add_f32(LAS float* p, float v) { (void)__hip_atomic_fetch_add(p, v, __ATOMIC_RELAXED, __HIP_MEMORY_SCOPE_WORKGROUP); }

__device__ __forceinline__ void attn_item(const Frame& F, int qt, int g) {
    const int lane = lane_id(), wid = F.wave, tid = wid * 64 + lane, r32 = lane & 31, hi = lane >> 5;
    const int ql = r32 >> 2, h = r32 & 3, cur = qt, t = 64 * qt + 8 * wid + ql, head = 4 * g + h;
    LAS unsigned char* shm = F.lds;
    const unsigned lds0 = (unsigned)(uintptr_t)shm;
    LAS float* wsf = (LAS float*)(shm + L_WSF) + wid * 64;
    LAS float* SC = (LAS float*)(shm + L_SC);
    LAS float* OACC = (LAS float*)(shm + L_SC);
    LAS float* lutl = (LAS float*)(shm + L_LUT);
    const LAS float* luth = lutl + h;
    LAS unsigned* BM = (LAS unsigned*)(shm + L_BM);
    LAS float* REF = (LAS float*)(shm + L_REF);
    LAS float* LACC = (LAS float*)(shm + L_LACC);
    lutl[4 * (tid & 127) + (tid >> 7)] = F.LUT()[(4 * g + (tid >> 7)) * 128 + (tid & 127)];
    BM[tid] = 0u;
    LAS u32x2* QL8 = (LAS u32x2*)(shm + L_OUT);
#pragma unroll
    for (int i = 0; i < 4; ++i) { const int slot = tid + 512 * i, q = slot >> 5, ks_ = (slot >> 4) & 1, gq_ = (slot >> 2) & 3, h_ = slot & 3;
        const u32x4 w = *(const u32x4*)(F.Q2() + (size_t)(64 * qt + q) * 512 + g * 256 + (2 * ks_ + (gq_ >> 1)) * 64 + h_ * 16 + 8 * (gq_ & 1));
        int w0 = __builtin_amdgcn_cvt_pk_fp8_f32(8.f * bflo(w.x), 8.f * bfhi(w.x), 0, false); w0 = __builtin_amdgcn_cvt_pk_fp8_f32(8.f * bflo(w.y), 8.f * bfhi(w.y), w0, true);
        int w1 = __builtin_amdgcn_cvt_pk_fp8_f32(8.f * bflo(w.z), 8.f * bfhi(w.z), 0, false); w1 = __builtin_amdgcn_cvt_pk_fp8_f32(8.f * bflo(w.w), 8.f * bfhi(w.w), w1, true);
        QL8[slot] = (u32x2){(unsigned)w0, (unsigned)w1}; }
    bf16x8 qr[4];
    { const bf16* qp = F.Q2() + (size_t)t * 512 + g * 256 + h * 16 + hi * 8;
#pragma unroll
        for (int d0 = 0; d0 < 4; ++d0) qr[d0] = *(const bf16x8*)(qp + d0 * 64); }
    const float b31 = F.LUT()[head * 128 + 127];
    const float gate_c = fsigmoid(bf2f(F.BR()[(size_t)t * 256 + head])), gate_s = fsigmoid(bf2f(F.BR()[(size_t)t * 256 + 8 + head])), gate_w = fsigmoid(bf2f(F.BR()[(size_t)t * 256 + 16 + head]));
    f32x16 o[2], p0, p1;
    const unsigned kdst = lds0 + L_K + wid * 1024, vdst = lds0 + L_V + wid * 1024;
    const int vrow = 16 * (wid & 3) + (lane >> 2), vcol = (wid >> 2) * 32 + (lane & 3) * 8;
    const int vb0 = (int)(lds0 + L_V) + ((lane >> 4) & 1) * 32 + (lane & 3) * 8 + (4 * hi + ((lane & 15) >> 2)) * 64;
#define DMA_K(base, pitch, row0, slot) glds16((base) + (size_t)((row0) + lane) * (pitch) + wid * 8, (unsigned)__builtin_amdgcn_readfirstlane(kdst + (slot)))
#define DMA_V(base, pitch, row0, slot) glds16((base) + (size_t)((row0) + vrow) * (pitch) + vcol, (unsigned)__builtin_amdgcn_readfirstlane(vdst + (slot)))
#define ROT() do { sl_cur = sl_next; sl_next = (sl_next == (NSLOT - 1) * SLOTB) ? 0 : sl_next + SLOTB; } while (0)
    VM_WAIT(); LDS_WAIT(); __syncthreads();

    const bf16* KCg = F.KC() + (size_t)g * 1024 * 64; const bf16* VCg = F.VC() + (size_t)g * 1024 * 64;
    const int nkt = (qt >> 4) + 1;
    const int tminw = 64 * qt + 8 * wid;
    float m = -1e30f, l = 0.f;
    {
        int sl_cur = 0, sl_next = SLOTB;
        DMA_K(KCg, 64, 0, 0);
        for (int kt = 0; kt < nkt; ++kt) {
            if (kt + 1 < nkt) { DMA_K(KCg, 64, 64 * (kt + 1), sl_next); ATT_WAITBAR(1); } else { ATT_WAITBAR(0); }
            const bool far = (tminw - 31 - 16 * (64 * kt + 63)) >= 128;
            qkt(p0, p1, shm + L_K + sl_cur, qr, r32, hi);
            if (!far) near_apply<16, 0x80000000u>(p0, p1, t - 31 - 16 * (64 * kt + 4 * hi), luth);
            sm_update<false>(p0, p1, far ? b31 : 0.f, m, l, o, wsf, r32, hi);
            ROT();
        }
        LDS_WAIT(); __builtin_amdgcn_s_barrier();
    }
    {
        const float lt = halfsum(l); const float rl = lt > 0.f ? 1.0f / lt : 0.f;
        ATT_FILL(o[0], 0.f); ATT_FILL(o[1], 0.f);
        float carry = 0.f;
        int sl_cur = 0, sl_next = SLOTB;
        DMA_K(KCg, 64, 0, 0); DMA_V(VCg, 64, 0, 0);
        for (int kt = 0; kt < nkt; ++kt) {
            if (kt + 1 < nkt) { DMA_K(KCg, 64, 64 * (kt + 1), sl_next); DMA_V(VCg, 64, 64 * (kt + 1), sl_next); ATT_WAITBAR(2); } else { ATT_WAITBAR(0); }
            const bool far = (tminw - 31 - 16 * (64 * kt + 63)) >= 128;
            qkt(p0, p1, shm + L_K + sl_cur, qr, r32, hi);
            if (!far) near_apply<16, 0x80000000u>(p0, p1, t - 31 - 16 * (64 * kt + 4 * hi), luth);
            const float mb2 = far ? m - b31 : m;
#pragma unroll
            for (int r = 0; r < 16; ++r) { p0[r] = __builtin_amdgcn_exp2f(p0[r] - mb2) * rl; p1[r] = __builtin_amdgcn_exp2f(p1[r] - mb2) * rl; }
            {
                float q4[8], e[8];
#pragma unroll
                for (int i = 0; i < 4; ++i) { q4[i] = (p0[4 * i] + p0[4 * i + 1]) + (p0[4 * i + 2] + p0[4 * i + 3]); e[i] = p0[4 * i + 3];
                                              q4[4 + i] = (p1[4 * i] + p1[4 * i + 1]) + (p1[4 * i + 2] + p1[4 * i + 3]); e[4 + i] = p1[4 * i + 3]; }
                float newcarry = 0.f;
#pragma unroll
                for (int i = 0; i < 8; ++i) { auto rr = __builtin_amdgcn_permlane32_swap(__float_as_uint(e[i]), __float_as_uint(e[i]), false, false);
                    const float elo = __uint_as_float(rr[0]), ehi = __uint_as_float(rr[1]);
                    if (hi) q4[i] += elo; else if (i < 7) q4[i + 1] += ehi;
                    if (i == 7) newcarry = ehi; }
                if (!hi) q4[0] += carry;
                carry = newcarry;
#pragma unroll
                for (int i = 0; i < 8; ++i) { float v = q4[i]; v += dpp_f<0xB1>(v); v += dpp_f<0x4E>(v); q4[i] = v; }
                if (h == 0) {
#pragma unroll
                    for (int i = 0; i < 8; ++i) SC[(8 * wid + ql) * 256 + 16 * kt + 2 * i + hi] = q4[i]; }
            }
            { ATT_PACK(p0, p1); pv(o, vb0 + sl_cur, pa0, pa1, pa2, pa3); }
            ROT();
        }
        LDS_WAIT(); __builtin_amdgcn_s_barrier();
    }

    if (cur >= 16) {
        const int u4 = lane >> 4, li16 = lane & 15;
#pragma unroll 1
        for (int qb = 0; qb < 8; qb += 4) {
            const int qloc = 8 * wid + qb + u4;
            const LAS float* row = SC + qloc * 256 + li16;
            int v[16];
#pragma unroll
            for (int k = 0; k < 16; ++k) { const int J = li16 + 16 * k; const int x = (__float_as_int(row[16 * k]) & ~255) | (255 - J); v[k] = (J >= 1 && J <= cur - 2) ? x : -1; }
            LAS unsigned* bmq = BM + (qloc >> 5); const unsigned qbit = 1u << (qloc & 31);
#pragma unroll 1
            for (int round = 0; round < 13; ++round) {
                int lm = max(max(max(v[0], v[1]), max(v[2], v[3])), max(max(v[4], v[5]), max(v[6], v[7])));
                lm = max(lm, max(max(max(v[8], v[9]), max(v[10], v[11])), max(max(v[12], v[13]), max(v[14], v[15]))));
                int rm = lm; rm = max(rm, dpp_i<0xB1>(rm)); rm = max(rm, dpp_i<0x4E>(rm)); rm = max(rm, dpp_i<0x141>(rm)); rm = max(rm, dpp_i<0x140>(rm));
                if (lm == rm) {
#pragma unroll
                    for (int k = 0; k < 16; ++k) v[k] = (v[k] == rm) ? -1 : v[k];
                    __hip_atomic_fetch_or(bmq + 2 * (255 - (rm & 255)), qbit, __ATOMIC_RELAXED, __HIP_MEMORY_SCOPE_WORKGROUP);
                }
            }
        }
    }
    LDS_WAIT();
    LAS float* ostg = (LAS float*)(shm + L_SC) + wid * 2048;
    {
        if (hi == 0) wsf[r32] = gate_c; LDS_WAIT();
#pragma unroll
        for (int r = 0; r < 16; ++r) { const float f = wsf[crow(r, hi)]; const int orow = crow(r, hi); ostg[orow * 64 + r32] = o[0][r] * f; ostg[orow * 64 + 32 + r32] = o[1][r] * f; }
    }

    const bf16* Kw = F.KV() + 512 + g * 64; const bf16* Vw = F.KV() + 640 + g * 64;
    {
        m = -1e30f; l = 0.f; ATT_FILL(o[0], 0.f); ATT_FILL(o[1], 0.f);
        const int J0 = max(cur - 8, 0);
        int sl_cur = 0, sl_next = SLOTB;
        DMA_K(Kw, 768, 64 * J0, 0); DMA_V(Vw, 768, 64 * J0, 0);
        for (int J = J0; J <= cur; ++J) {
            if (J + 1 <= cur) { DMA_K(Kw, 768, 64 * (J + 1), sl_next); DMA_V(Vw, 768, 64 * (J + 1), sl_next); ATT_WAITBAR(2); } else { ATT_WAITBAR(0); }
            const bool nearw = (J >= cur - 2 || J == cur - 8);
            qkt(p0, p1, shm + L_K + sl_cur, qr, r32, hi);
            if (nearw) near_apply<1, 512u>(p0, p1, t - 64 * J - 4 * hi, luth);
            sm_update<true>(p0, p1, nearw ? 0.f : b31, m, l, o, wsf, r32, hi);
            { ATT_PACK(p0, p1); pv(o, vb0 + sl_cur, pa0, pa1, pa2, pa3); }
            ROT();
        }
        LDS_WAIT(); __builtin_amdgcn_s_barrier();
        const float lt = halfsum(l); const float fw = lt > 0.f ? gate_w / lt : 0.f;
        if (hi == 0) wsf[r32] = fw; LDS_WAIT();
#pragma unroll
        for (int r = 0; r < 16; ++r) { const float f = wsf[crow(r, hi)]; const int orow = crow(r, hi); ostg[orow * 64 + r32] += o[0][r] * f; ostg[orow * 64 + 32 + r32] += o[1][r] * f; }
        LDS_WAIT();
#pragma unroll
        for (int i = 0; i < 4; ++i) { const int rowl = i * 8 + (lane >> 3), chn = lane & 7;
            const f32x4 a0 = *(const LAS f32x4*)(ostg + rowl * 64 + chn * 8), a1 = *(const LAS f32x4*)(ostg + rowl * 64 + chn * 8 + 4);
            const size_t tt = (size_t)(64 * qt + 8 * wid + (rowl >> 2)); const int col = (4 * g + (rowl & 3)) * 64 + chn * 8;
            *(u32x4*)(F.XN() + tt * 1024 + col) = (u32x4){cvtpk(a0[0], a0[1]), cvtpk(a0[2], a0[3]), cvtpk(a1[0], a1[1]), cvtpk(a1[2], a1[3])}; }
        LDS_WAIT();
    }

    const bf16* Ks = F.KV() + 256 + g * 64; const bf16* Vs = F.KV() + 384 + g * 64;
    {
        m = -1e30f; l = 0.f; ATT_FILL(o[0], 0.f); ATT_FILL(o[1], 0.f);
        const int nA = (cur < 16) ? cur + 1 : 3;
#define JA(i) ((cur < 16) ? (i) : ((i) == 0 ? 0 : cur - 2 + (i)))
        int sl_cur = 0, sl_next = SLOTB;
        DMA_K(Ks, 768, 0, 0); DMA_V(Vs, 768, 0, 0);
        for (int i = 0; i < nA; ++i) {
            const int J = JA(i);
            if (i + 1 < nA) { const int Jn = JA(i + 1); DMA_K(Ks, 768, 64 * Jn, sl_next); DMA_V(Vs, 768, 64 * Jn, sl_next); ATT_WAITBAR(2); } else { ATT_WAITBAR(0); }
            const bool neara = (J >= cur - 2);
            qkt(p0, p1, shm + L_K + sl_cur, qr, r32, hi);
            if (neara) near_apply<1, 0x80000000u>(p0, p1, t - 64 * J - 4 * hi, luth);
            sm_update<true>(p0, p1, neara ? 0.f : b31, m, l, o, wsf, r32, hi);
            { ATT_PACK(p0, p1); pv(o, vb0 + sl_cur, pa0, pa1, pa2, pa3); }
            ROT();
        }
#undef JA
        LDS_WAIT(); __builtin_amdgcn_s_barrier();
        const float lt = halfsum(l);
        if (hi == 0) { REF[32 * wid + r32] = m; LACC[32 * wid + r32] = lt; }
#pragma unroll
        for (int r = 0; r < 16; ++r) { const int orow = 32 * wid + crow(r, hi); OACC[orow * 64 + r32] = o[0][r]; OACC[orow * 64 + 32 + r32] = o[1][r]; }
        LDS_WAIT(); __builtin_amdgcn_s_barrier();
    }

    if (cur >= 16) {
        const int c16 = lane & 15, gq = lane >> 4, qi4 = c16 >> 2;
        float oa[2][16], la2[2];
        { const int li_ = lane & 15, hsel_ = li_ >> 2, dq_ = (li_ & 3) * 16;
#pragma unroll
            for (int p = 0; p < 2; ++p) { la2[p] = 0.f; const LAS f32x4* ap = (const LAS f32x4*)(OACC + (4 * (8 * wid + 4 * p + gq) + hsel_) * 64 + dq_);
#pragma unroll
                for (int k = 0; k < 4; ++k) { const f32x4 a = ap[k]; oa[p][4 * k] = a[0]; oa[p][4 * k + 1] = a[1]; oa[p][4 * k + 2] = a[2]; oa[p][4 * k + 3] = a[3]; } } }
        LDS_WAIT(); __builtin_amdgcn_s_barrier();
        if (tid < 128) ((LAS unsigned*)(shm + L_HDR))[tid] = 0u;
        typedef long i64_t;
        const i64_t* KTg = (const i64_t*)F.KT() + (size_t)g * 256 * 512 + gq * 16 + c16; const bf16* VTg = F.VT() + (size_t)g * 256 * 4096 + c16 * 32 + 8 * gq;
        const LAS i64_t* QLg = (const LAS i64_t*)QL8 + gq * 4 + h;
        LAS unsigned* TL = (LAS unsigned*)(shm + L_TL) + wid * 160;
        int tot_ = 0;
#pragma unroll
        for (int i4 = 0; i4 < 4; ++i4) { const int Jl = lane + 64 * i4; if (Jl >= 1 && Jl <= cur - 2) tot_ += (__popc(BM[2 * Jl]) + __popc(BM[2 * Jl + 1]) + 3) >> 2; }
        const int T_ = __builtin_amdgcn_readfirstlane((int)(wave_sum((float)tot_) + 0.5f));
        const int nround = (T_ + 7) >> 3; const int tlo = wid * nround; const int ntask = max(0, min(T_ - tlo, nround));
        int run_ = 0;
#pragma unroll 1
        for (int i4 = 0; i4 < 4; ++i4) {
            const int Jl = lane + 64 * i4; int nch = 0;
            unsigned long long mk = 0ull;
            if (Jl >= 1 && Jl <= cur - 2) { mk = ((unsigned long long)BM[2 * Jl + 1] << 32) | BM[2 * Jl]; nch = (__popcll(mk) + 3) >> 2; }
            int incl = nch;
#pragma unroll
            for (int o = 1; o < 64; o <<= 1) { const int up = __shfl_up(incl, o); if (lane >= o) incl += up; }
            const int base = run_ + incl - nch - tlo;
            for (int c = 0; c < nch; ++c) { unsigned e = (unsigned)Jl; int q0 = 0;
#pragma unroll
                for (int k = 0; k < 4; ++k) { int q = q0; if (mk) { q = __builtin_ctzll(mk); mk &= mk - 1; } if (k == 0) q0 = q; e |= (unsigned)q << (8 + 6 * k); }
                if ((unsigned)(base + c) < (unsigned)ntask) TL[base + c] = e; }
            run_ += __builtin_amdgcn_readlane(incl, 63);
        }
        LAS float* EX = (LAS float*)(shm + L_EX); LAS unsigned* QM = (LAS unsigned*)(shm + L_HDR); LAS float* LEX = (LAS float*)(shm + L_LEX);
        LDS_WAIT(); __builtin_amdgcn_s_barrier();
        i64_t kfC[8], kfN[8]; bf16x8 vfC[8]; bool kpend = false;
#define LOADK(J_, KF) do { const i64_t* kp_ = KTg + (size_t)(J_) * 512; \
            _Pragma("unroll") for (int kt = 0; kt < 4; ++kt) { KF[2 * kt] = kp_[kt * 64]; KF[2 * kt + 1] = kp_[256 + kt * 64]; } } while (0)
#define LOADV(J_, VF) do { const bf16* vp_ = VTg + (size_t)(J_) * 4096; _Pragma("unroll") for (int x = 0; x < 8; ++x) VF[x] = *(const bf16x8*)(vp_ + x * 512); } while (0)
        unsigned e_cur = 0xffu;
        i64_t qg0 = 0, qg1 = 0; float ref = 0.f;
#define QFETCH(E) do { const int mq_ = ((E) >> (8 + 6 * qi4)) & 63; const LAS i64_t* qp_ = QLg + mq_ * 32; qg0 = qp_[0]; qg1 = qp_[16]; ref = REF[4 * mq_ + h]; } while (0)
        if (ntask > 0) { e_cur = (unsigned)__builtin_amdgcn_readfirstlane((int)TL[0]); LOADK(e_cur & 255u, kfC); LOADV(e_cur & 255u, vfC); QFETCH(e_cur); }
        unsigned tl1 = (ntask > 1) ? TL[1] : 0xffu;
#define OWNER_PASS(M0, M1, B) do { const int li_ = lane & 15, hsel_ = li_ >> 2, dq_ = (li_ & 3) * 16; \
            _Pragma("unroll") for (int pass = 0; pass < 2; ++pass) { \
                unsigned mm = pass ? (M1) : (M0); \
                while (mm) { const int e = __builtin_ctz(mm); mm &= mm - 1; \
                    const LAS f32x4* xr = (const LAS f32x4*)(EX + (B) * 8704 + (e * 4 + hsel_) * 68 + dq_); \
                    const f32x4 y0 = xr[0], y1 = xr[1], y2 = xr[2], y3 = xr[3]; \
                    oa[pass][0] += y0[0]; oa[pass][1] += y0[1]; oa[pass][2] += y0[2]; oa[pass][3] += y0[3]; oa[pass][4] += y1[0]; oa[pass][5] += y1[1]; oa[pass][6] += y1[2]; oa[pass][7] += y1[3]; \
                    oa[pass][8] += y2[0]; oa[pass][9] += y2[1]; oa[pass][10] += y2[2]; oa[pass][11] += y2[3]; oa[pass][12] += y3[0]; oa[pass][13] += y3[1]; oa[pass][14] += y3[2]; oa[pass][15] += y3[3]; \
                    la2[pass] += LEX[(B) * 128 + e * 4 + hsel_]; } } } while (0)
#pragma unroll 1
        for (int n = 0; n < nround; ++n) {
            const int buf = n & 1;
            unsigned qm0 = 0u, qm1 = 0u;
            if (n > 0) { qm0 = QM[(buf ^ 1) * 64 + 8 * wid + gq]; qm1 = QM[(buf ^ 1) * 64 + 8 * wid + 4 + gq]; }
            if (n < ntask) {
                const unsigned e_nxt = (n + 1 < ntask) ? (unsigned)__builtin_amdgcn_readfirstlane((int)tl1) : 0xffu;
                tl1 = (n + 2 < ntask) ? TL[n + 2] : 0xffu;
                const unsigned e_ = e_cur; const int Jb = e_ & 255, Jn = e_nxt & 255; const bool reload = (Jn != Jb) && (Jn != 255);
                const int q0_ = (e_ >> 8) & 63;
                const int myq = (e_ >> (8 + 6 * qi4)) & 63; const bool valid = (qi4 == 0) || (myq != q0_); const int tq = 64 * qt + myq;
                const bool nearJ = (Jb >= cur - 2);
                const float cinit = nearJ ? 0.f : (valid ? b31 - ref : -INFINITY);
                if (kpend) {
#pragma unroll
                    for (int x = 0; x < 8; ++x) kfC[x] = kfN[x];
                    kpend = false; }
                if (reload) { LOADK(Jn, kfN); kpend = true; }
                f32x4 s[4];
#pragma unroll
                for (int kt = 0; kt < 4; ++kt) { s[kt] = (f32x4){0.f, 0.f, 0.f, 0.f};
                    s[kt] = __builtin_amdgcn_mfma_f32_16x16x32_fp8_fp8(kfC[2 * kt], qg0, s[kt], 0, 0, 0); s[kt] = __builtin_amdgcn_mfma_f32_16x16x32_fp8_fp8(kfC[2 * kt + 1], qg1, s[kt], 0, 0, 0); }
                const float refc = ref;
                if (n + 1 < ntask) QFETCH(e_nxt);
                if (nearJ) { const float sub = valid ? refc : INFINITY;
                    float bb[16];
#pragma unroll
                    for (int kt = 0; kt < 4; ++kt)
#pragma unroll
                        for (int r = 0; r < 4; ++r) { const int dd = tq - 64 * Jb - (16 * kt + 4 * gq + r); bb[kt * 4 + r] = luth[4 * min(max(dd, 0), 127)]; }
#pragma unroll
                    for (int x = 0; x < 16; ++x) asm volatile("" : "+v"(bb[x]));
#pragma unroll
                    for (int kt = 0; kt < 4; ++kt)
#pragma unroll
                        for (int r = 0; r < 4; ++r) { const int dd = tq - 64 * Jb - (16 * kt + 4 * gq + r); const float tt = s[kt][r] * 0.125f + bb[kt * 4 + r] - sub;
                            s[kt][r] = (dd >= 0) ? tt * 8.0f : -INFINITY; } }
#pragma unroll
                for (int kt = 0; kt < 4; ++kt)
#pragma unroll
                    for (int r = 0; r < 4; ++r) { const int tb = min(__float_as_int(s[kt][r] * 0.125f + cinit), __float_as_int(CLAMP));
                        s[kt][r] = __builtin_amdgcn_exp2f(__int_as_float(tb)); }
                float ls = (((s[0][0] + s[0][1]) + (s[0][2] + s[0][3])) + ((s[1][0] + s[1][1]) + (s[1][2] + s[1][3]))) + (((s[2][0] + s[2][1]) + (s[2][2] + s[2][3])) + ((s[3][0] + s[3][1]) + (s[3][2] + s[3][3])));
                { auto r16 = __builtin_amdgcn_permlane16_swap(__float_as_uint(ls), __float_as_uint(ls), false, false); ls = __uint_as_float(r16[0]) + __uint_as_float(r16[1]); }
                ls = halfsum(ls);
                bf16x8 pb[2];
#pragma unroll
                for (int ks = 0; ks < 2; ++ks) pb[ks] = __builtin_bit_cast(bf16x8, (u32x4){cvtpk(s[2 * ks][0], s[2 * ks][1]), cvtpk(s[2 * ks][2], s[2 * ks][3]), cvtpk(s[2 * ks + 1][0], s[2 * ks + 1][1]), cvtpk(s[2 * ks + 1][2], s[2 * ks + 1][3])});
                LAS float* ex = EX + buf * 8704 + ((wid * 4 + qi4) * 4 + h) * 68 + 4 * gq;
                f32x4 ot[4];
#pragma unroll
                for (int mt = 0; mt < 4; ++mt) { ot[mt] = (f32x4){0.f, 0.f, 0.f, 0.f};
                    ot[mt] = __builtin_amdgcn_mfma_f32_16x16x32_bf16(vfC[2 * mt], pb[0], ot[mt], 0, 0, 0); ot[mt] = __builtin_amdgcn_mfma_f32_16x16x32_bf16(vfC[2 * mt + 1], pb[1], ot[mt], 0, 0, 0); }
                if (reload) LOADV(Jn, vfC);
#pragma unroll
                for (int mt = 0; mt < 4; ++mt) *(LAS f32x4*)(ex + 16 * mt) = ot[mt];
                if (gq == 0) { LEX[buf * 128 + wid * 16 + c16] = ls; if (h == 0 && valid) __hip_atomic_fetch_or(QM + buf * 64 + myq, 1u << (wid * 4 + qi4), __ATOMIC_RELAXED, __HIP_MEMORY_SCOPE_WORKGROUP); }
                e_cur = e_nxt;
            }
            OWNER_PASS(qm0, qm1, buf ^ 1);
            if (n > 0 && (lane & 15) == 0) { QM[(buf ^ 1) * 64 + 8 * wid + gq] = 0u; QM[(buf ^ 1) * 64 + 8 * wid + 4 + gq] = 0u; }
            LDS_WAIT(); __builtin_amdgcn_s_barrier();
        }
        if (nround > 0) { const int lb = (nround - 1) & 1; const unsigned l0 = QM[lb * 64 + 8 * wid + gq], l1 = QM[lb * 64 + 8 * wid + 4 + gq]; OWNER_PASS(l0, l1, lb); }
#undef OWNER_PASS
        LDS_WAIT(); __builtin_amdgcn_s_barrier();
        {
            const int li = lane & 15, hsel = li >> 2, dq = (li & 3) * 16;
#pragma unroll
            for (int pass = 0; pass < 2; ++pass) { const int q = 8 * wid + 4 * pass + gq; LAS f32x4* ap = (LAS f32x4*)(OACC + (4 * q + hsel) * 64 + dq);
#pragma unroll
                for (int k = 0; k < 4; ++k) ap[k] = (f32x4){oa[pass][4 * k], oa[pass][4 * k + 1], oa[pass][4 * k + 2], oa[pass][4 * k + 3]};
                if ((li & 3) == 0) LACC[4 * q + hsel] += la2[pass]; }
        }
#undef LOADK
#undef LOADV
#undef QFETCH
    }
    LDS_WAIT(); __builtin_amdgcn_s_barrier();

    {
        if (hi == 0) { const float lt = LACC[32 * wid + r32]; wsf[r32] = lt > 0.f ? gate_s / lt : 0.f; }
        LDS_WAIT();
#pragma unroll
        for (int i = 0; i < 4; ++i) { const int rowl = i * 8 + (lane >> 3), chn = lane & 7, row = 32 * wid + rowl;
            const float f = wsf[rowl];
            const f32x4 a0 = *(const LAS f32x4*)(OACC + row * 64 + chn * 8), a1 = *(const LAS f32x4*)(OACC + row * 64 + chn * 8 + 4);
            const size_t tt = (size_t)(64 * qt + 8 * wid + (rowl >> 2)); const int col = (4 * g + (rowl & 3)) * 64 + chn * 8;
            const u32x4 ov = *(const u32x4*)(F.XN() + tt * 1024 + col);
            const u32x4 gn = *(const u32x4*)(F.GN() + tt * 512 + col);
            u32x4 w; w.x = pk2((bflo(ov.x) + a0[0] * f) * bflo(gn.x), (bfhi(ov.x) + a0[1] * f) * bfhi(gn.x)); w.y = pk2((bflo(ov.y) + a0[2] * f) * bflo(gn.y), (bfhi(ov.y) + a0[3] * f) * bfhi(gn.y));
            w.z = pk2((bflo(ov.z) + a1[0] * f) * bflo(gn.z), (bfhi(ov.z) + a1[1] * f) * bfhi(gn.z)); w.w = pk2((bflo(ov.w) + a1[2] * f) * bflo(gn.w), (bfhi(ov.w) + a1[3] * f) * bfhi(gn.w));
            *(u32x4*)(F.XN() + tt * 1024 + col) = w; }
        VM_WAIT(); LDS_WAIT(); __syncthreads();
    }
#undef DMA_K
#undef DMA_V
#undef ROT
}
}

__global__ void __launch_bounds__(NWAVES * 64, 2) nsa_lru_fwd(Args args) {
    extern __shared__ __attribute__((aligned(16))) unsigned char lds[];
    Frame F;
    F.lds = (LAS unsigned char*)lds;
    F.MISC = (volatile LAS unsigned*)(F.lds + MISC_OFF);
    F.wave = __builtin_amdgcn_readfirstlane((int)(threadIdx.x >> 6));
    F.G = gridDim.x; { const int bx = blockIdx.x; F.vcu = (F.G % 8 == 0) ? (bx % 8) * (F.G / 8) + bx / 8 : bx; }
    F.ws = args.ws;
    gu32* ctl = (gu32*)(args.ws + WS_CTL);
    for (int u = F.wave * 64 + lane_id(); u < (LDS_BYTES - LDSCTL_OFF) / 4; u += NWAVES * 64) ((LAS unsigned*)(F.lds + LDSCTL_OFF))[u] = 0u;
    __syncthreads();
    const int bli = (N_LAUNCHES == PER_PHASE) ? 0 : args.li;
    XcdBarrier bar; bar.bar = (unsigned*)(ctl + CW_BAR) + bli * XCD_BAR_WORDS; bar.x = 0; bar.st = nullptr;
    if (N_LAUNCHES != PER_PHASE) bar = xcd_barrier_post((unsigned*)(ctl + CW_BAR) + bli * XCD_BAR_WORDS, F.MISC + 8);
#define GRID_BAR() do { if (N_LAUNCHES != PER_PHASE) xcd_barrier(bar); } while (0)
    const int lo = args.ph_lo, hi = args.ph_hi;
#define IN(k) (lo <= (k) && (k) < hi)
#define BOTH(k) (IN(k) && IN((k) + 1))

    if (IN(0)) { p0_prologue(F, args); if (BOTH(0)) GRID_BAR(); }

    if (IN(1)) {
        pg8::Gemm g{F.XN(), F.WinT(), F.XN(), F.WinT(), 1024, 1024, 1024}; pg8::StaticOrder S; S.init(SEQ, NPROJ, F.G, (int)blockIdx.x);
        pg8::EpiProj E{F.Q(), F.KV(), F.U(), F.BR(), F.GN(), F.GL(), F.MG()};
        pg8::gemm_phase<pg8::EpiProj, pg8::StaticOrder, true>(F.lds, g, S, E, F.wave);
        if (BOTH(1)) GRID_BAR();
    }

    if (IN(2)) {
        for (int i = F.vcu; i < 256; i += F.G) {
            lru_tile<false>(F, args, i);
            if (!args.pad) qk_norm_tile(F, args, i);
            vt_tile(F, i);
            __syncthreads();
            compress_item(F, args, i & 1, (i >> 1) & 1, i >> 2);
        }
        if (BOTH(2)) GRID_BAR();
    }

    if (IN(3)) {
        for (int i = F.vcu; i < 256; i += F.G) { lru_apply(F, i); }
        __syncthreads();
#pragma unroll 1
        for (int it = 2 * F.vcu; it < 512; it += 2 * F.G) {
#pragma unroll 1
            for (int j = 0; j < 2; ++j) { const int i = it >> 1; att::attn_item(F, j ? i : 255 - i, j ? 0 : 1); }
        }
        if (BOTH(3)) GRID_BAR();
    }

    if (IN(4)) {
        pg8::Gemm g{F.XN(), F.WaT(), F.XN() + 512, F.WbT(), 1024, 512, 512}; pg8::DualOrder S; S.init(SEQ, 1024, F.G, (int)blockIdx.x);
        pg8::EpiMerge E{F.MB(), F.MG()};
        pg8::gemm_phase<pg8::EpiMerge, pg8::DualOrder, true>(F.lds, g, S, E, F.wave);
        if (BOTH(4)) GRID_BAR();
    }

    if (IN(5)) {
        pg8::Gemm g{F.MB(), F.WoutT(), F.MB(), F.WoutT(), 1024, 1024, 1024}; pg8::StaticOrder S; S.init(SEQ, 1024, F.G, (int)blockIdx.x);
        pg8::EpiOut E{args.in[0], args.out};
        pg8::gemm_phase<pg8::EpiOut, pg8::StaticOrder, true>(F.lds, g, S, E, F.wave);
    }
#undef IN
#undef BOTH
}

extern "C" void kernel_launch(void* const* d_in, const int* in_sizes, int n_in, void* d_out, int out_size, void* d_ws, size_t ws_size, hipStream_t stream) {
    static int grid = 0;
    if (grid == 0) {
        if (n_in != 20 || in_sizes[0] != SEQ * DM || out_size != SEQ * DM || ws_size < WS_END) { fprintf(stderr, "kernel_launch: unexpected shapes (n_in %d, in0 %d, out %d, ws %zu)\n", n_in, n_in > 0 ? in_sizes[0] : -1, out_size, ws_size); grid = -1; return; }
        int dev = 0, cus = 0, per_cu = 0;
        if (hipGetDevice(&dev) != hipSuccess || hipDeviceGetAttribute(&cus, hipDeviceAttributeMultiprocessorCount, dev) != hipSuccess) { grid = -1; return; }
        if (hipFuncSetAttribute((const void*)nsa_lru_fwd, hipFuncAttributeMaxDynamicSharedMemorySize, LDS_BYTES) != hipSuccess) { fprintf(stderr, "kernel_launch: hipFuncSetAttribute failed\n"); grid = -1; return; }
        if (hipOccupancyMaxActiveBlocksPerMultiprocessor(&per_cu, (const void*)nsa_lru_fwd, NWAVES * 64, LDS_BYTES) != hipSuccess || per_cu < 1)
            fprintf(stderr, "kernel_launch: occupancy query reports %d workgroups per CU\n", per_cu);
        (void)hipGetLastError();
        grid = cus;
    }
    if (grid < 0) return;
    if (hipMemsetAsync((char*)d_ws + WS_CTL, 0, CTL_ZERO_BYTES, stream) != hipSuccess) { fprintf(stderr, "kernel_launch: hipMemsetAsync failed\n"); return; }
    Args a{};
    for (int i = 0; i < 20; ++i) a.in[i] = (const float*)d_in[i];
    a.out = (float*)d_out; a.ws = (unsigned char*)d_ws;
    const int nl = (PROBE_DUP >= 0) ? 2 : N_LAUNCHES;
    for (int li = 0; li < nl; ++li) {
        if (PROBE_DUP >= 0) { a.ph_lo = li ? PROBE_DUP : 0; a.ph_hi = li ? PER_PHASE : PROBE_DUP + 1; a.li = li; a.pad = (li && PROBE_DUP == 2) ? 1 : 0; }
        else { a.ph_lo = (N_LAUNCHES == PER_PHASE) ? li : 0; a.ph_hi = (N_LAUNCHES == PER_PHASE) ? li + 1 : PER_PHASE; a.li = li; }
        hipLaunchKernelGGL(nsa_lru_fwd, dim3(grid), dim3(NWAVES * 64), LDS_BYTES, stream, a);
        const hipError_t le = hipPeekAtLastError();
        if (le != hipSuccess) { fprintf(stderr, "kernel_launch: launch %d failed: %s\n", li, hipGetErrorName(le)); break; }
    }
}
```

```cpp
#include <hip/hip_runtime.h>
#include <cstdio>
#include <cstdint>

#ifndef PROBE_IDLE
#define PROBE_IDLE -1
#endif
#ifndef PROBE_DUP
#define PROBE_DUP -1
#endif
#ifndef MK_N_LAUNCHES
#define MK_N_LAUNCHES 1
#endif

#define GAS __attribute__((address_space(1)))
#define LAS __attribute__((address_space(3)))
typedef unsigned short bf16;
typedef short bf16x8 __attribute__((ext_vector_type(8)));
typedef short s16x4 __attribute__((ext_vector_type(4)));
typedef float f32x4 __attribute__((ext_vector_type(4)));
typedef float f32x16 __attribute__((ext_vector_type(16)));
typedef unsigned u32x4 __attribute__((ext_vector_type(4)));
typedef unsigned u32x2 __attribute__((ext_vector_type(2)));
typedef GAS unsigned gu32;

constexpr int SEQ = 16384, DM = 1024;
constexpr int NPROJ = 5120;
constexpr float LOG2E = 1.4426950408889634f;
constexpr float RMS_EPS = 1e-6f;

__device__ __forceinline__ unsigned f2bf(float f) { unsigned u = __builtin_bit_cast(unsigned, f); return (u + 0x7fffu + ((u >> 16) & 1u)) >> 16; }
__device__ __forceinline__ unsigned pk2(float lo, float hi) { return f2bf(lo) | (f2bf(hi) << 16); }
__device__ __forceinline__ float bf2f(unsigned h) { return __builtin_bit_cast(float, h << 16); }
__device__ __forceinline__ float bflo(unsigned w) { return __builtin_bit_cast(float, w << 16); }
__device__ __forceinline__ float bfhi(unsigned w) { return __builtin_bit_cast(float, w & 0xffff0000u); }
typedef float f32x2_t __attribute__((ext_vector_type(2))); typedef __bf16 bf16x2_t __attribute__((ext_vector_type(2)));
__device__ __forceinline__ unsigned cvtpk(float lo, float hi) { f32x2_t v = {lo, hi}; bf16x2_t b = __builtin_convertvector(v, bf16x2_t); return __builtin_bit_cast(unsigned, b); }
__device__ __forceinline__ float fsigmoid(float v) { return __builtin_amdgcn_rcpf(1.0f + __builtin_amdgcn_exp2f(-v * LOG2E)); }
template <int CTRL> __device__ __forceinline__ float dpp_f(float v) { return __builtin_bit_cast(float, __builtin_amdgcn_update_dpp(0, __builtin_bit_cast(int, v), CTRL, 0xf, 0xf, true)); }
template <int CTRL> __device__ __forceinline__ int dpp_i(int v) { return __builtin_amdgcn_update_dpp(v, v, CTRL, 0xf, 0xf, false); }
__device__ __forceinline__ int lane_id() { int l = (int)__builtin_amdgcn_mbcnt_hi(~0u, __builtin_amdgcn_mbcnt_lo(~0u, 0u)); asm volatile("" : "+v"(l)); return l; }
__device__ __forceinline__ float wave_sum(float v) {
#pragma unroll
    for (int o = 1; o < 64; o <<= 1) v += __shfl_xor(v, o);
    return v;
}

namespace pg8 {
#define PG8_LAS __attribute__((address_space(3)))
typedef unsigned short bf16_t;
constexpr int BM = 256, BK = 64, HALF = 128, HTB = HALF * BK * 2, STAGE_BYTES = 8 * HTB, NXCD = 8, WGM = 8;
__host__ __device__ __forceinline__ int lds_byte(int r, int c) { const int st = (r >> 4) * 2 + (c >> 5), rr = r & 15, cc = c & 31, ob = rr * 64 + cc * 2; return st * 1024 + (ob ^ (((ob >> 9) & 1) << 5)); }
__host__ __device__ __forceinline__ void stage_rc(int b, int& R, int& C) { const int st = b / 1024, sb = b % 1024, swz = sb ^ (((sb >> 9) & 1) << 5); R = (st >> 1) * 16 + swz / 64; C = (st & 1) * 32 + (swz % 64) / 2; }
__host__ __device__ __forceinline__ int perm32(int rho) { const int n = rho >> 4, i = rho & 15; return 8 * (i >> 2) + 4 * n + (i & 3); }

struct Unit { int pm, pn, part; };
struct Gemm { const bf16_t* A; const bf16_t* Bt; const bf16_t* A2; const bf16_t* Bt2; int lda, ldb, K; };

struct StaticOrder {
    int nM, nN, nwg, G, c;
    __host__ __device__ void init(int M, int N, int G_, int c_) { nM = M / BM; nN = N / BM; nwg = nM * nN; G = G_; c = c_; }
    __host__ __device__ bool tile(long L, Unit& u) const {
        if (L >= nwg) return false;
        int wgid = (int)L; { const int q = nwg / NXCD, r = nwg % NXCD, xcd = wgid % NXCD, off = wgid / NXCD; wgid = (xcd < r ? xcd * (q + 1) : r * (q + 1) + (xcd - r) * q) + off; }
        const int nig = WGM * nN, gid = wgid / nig, fm = gid * WGM, gsz = (nM - fm) < WGM ? (nM - fm) : WGM;
        u.pm = fm + ((wgid % nig) % gsz); u.pn = (wgid % nig) / gsz; u.part = 0; return true;
    }
    __host__ __device__ bool next(int i, Unit& u) const { return tile((long)i * G + c, u); }
};
struct DualOrder : StaticOrder {
    __host__ __device__ bool next(int i, Unit& u) const { if (!tile((long)(i >> 1) * G + c, u)) return false; u.part = i & 1; return true; }
};
struct XOrder {
    int G, c;
    __host__ __device__ void init(int G_, int c_) { G = G_; c = c_; }
    __host__ __device__ bool tile(long L, Unit& u) const {
        if (L >= 256) return false;
        const int v = ((int)L % 8) * 32 + (int)L / 8, k = v >> 5, j = v & 31, r = j & 7;
        u.pm = (r < 4) ? 4 * k + r : 63 - 4 * k - (r - 4); u.pn = j >> 3; u.part = 0; return true;
    }
    __host__ __device__ bool next(int i, Unit& u) const { return tile((long)i * G + c, u); }
};
struct XDualOrder : XOrder {
    __host__ __device__ bool next(int i, Unit& u) const { if (!tile((long)(i >> 1) * G + c, u)) return false; u.part = i & 1; return true; }
};

__device__ __forceinline__ unsigned cvt_pk_bf16(float lo, float hi) { unsigned r; asm volatile("v_cvt_pk_bf16_f32 %0, %1, %2" : "=v"(r) : "v"(lo), "v"(hi)); return r; }

struct EpiProj {
    static constexpr bool PERM = true, INIT = false;
    bf16_t *Q, *KV, *U, *BR, *GN, *GL, *MG;
    __device__ __forceinline__ void operator()(const f32x4 (&acc)[2][2][4][2], const Unit& u, int wr, int wc, int fr, int fq) const {
        const int pn = u.pn; bf16_t* base; int ldc, colt, act = 0;
        if (pn < 2) { base = Q; ldc = 512; colt = pn * 256; }
        else if (pn < 5) { base = KV; ldc = 768; colt = (pn - 2) * 256; }
        else if (pn < 7) { base = U; ldc = 512; colt = (pn - 5) * 256; }
        else if (pn < 8) { base = BR; ldc = 256; colt = 0; }
        else if (pn < 10) { base = GN; ldc = 512; colt = (pn - 8) * 256; act = 1; }
        else if (pn < 12) { base = GL; ldc = 512; colt = (pn - 10) * 256; act = 1; }
        else { base = MG; ldc = 2048; colt = (pn - 12) * 256; act = 2; }
        const int row0 = u.pm * BM + wr * 64 + fr, col0 = colt + wc * 32 + 8 * fq;
#pragma unroll
        for (int ai = 0; ai < 2; ++ai)
#pragma unroll
            for (int m = 0; m < 4; ++m) { bf16_t* rowp = base + (size_t)(row0 + ai * HALF + m * 16) * ldc + col0;
#pragma unroll
                for (int bj = 0; bj < 2; ++bj) { f32x4 v0 = acc[ai][bj][m][0], v1 = acc[ai][bj][m][1];
                    if (act) {
#pragma unroll
                        for (int e = 0; e < 4; ++e) { const float s0 = fsigmoid(v0[e]), s1 = fsigmoid(v1[e]); v0[e] = (act == 1) ? v0[e] * s0 : s0; v1[e] = (act == 1) ? v1[e] * s1 : s1; } }
                    u32x4 w; w.x = cvt_pk_bf16(v0[0], v0[1]); w.y = cvt_pk_bf16(v0[2], v0[3]); w.z = cvt_pk_bf16(v1[0], v1[1]); w.w = cvt_pk_bf16(v1[2], v1[3]);
                    *(u32x4*)(rowp + bj * HALF) = w; } }
    }
};
struct EpiMerge {
    static constexpr bool PERM = true, INIT = false;
    bf16_t* Mb; const bf16_t* MG;
    __device__ __forceinline__ void operator()(const f32x4 (&acc)[2][2][4][2], const Unit& u, int wr, int wc, int fr, int fq) const {
        const int row0 = u.pm * BM + wr * 64 + fr, col0 = u.pn * BM + wc * 32 + 8 * fq;
#pragma unroll
        for (int ai = 0; ai < 2; ++ai)
#pragma unroll
            for (int m = 0; m < 4; ++m) { const size_t r = (size_t)(row0 + ai * HALF + m * 16);
#pragma unroll
                for (int bj = 0; bj < 2; ++bj) { const f32x4 v0 = acc[ai][bj][m][0], v1 = acc[ai][bj][m][1];
                    const u32x4 gw = *(const u32x4*)(MG + r * 2048 + u.part * 1024 + col0 + bj * HALF);
                    float o[8] = {v0[0] * bflo(gw.x), v0[1] * bfhi(gw.x), v0[2] * bflo(gw.y), v0[3] * bfhi(gw.y), v1[0] * bflo(gw.z), v1[1] * bfhi(gw.z), v1[2] * bflo(gw.w), v1[3] * bfhi(gw.w)};
                    bf16_t* dst = Mb + r * 1024 + col0 + bj * HALF;
                    if (u.part) { const u32x4 pw = *(const u32x4*)dst;
                        o[0] += bflo(pw.x); o[1] += bfhi(pw.x); o[2] += bflo(pw.y); o[3] += bfhi(pw.y); o[4] += bflo(pw.z); o[5] += bfhi(pw.z); o[6] += bflo(pw.w); o[7] += bfhi(pw.w); }
                    u32x4 w; w.x = cvt_pk_bf16(o[0], o[1]); w.y = cvt_pk_bf16(o[2], o[3]); w.z = cvt_pk_bf16(o[4], o[5]); w.w = cvt_pk_bf16(o[6], o[7]);
                    *(u32x4*)dst = w; } }
    }
};
struct EpiOut {
    static constexpr bool PERM = false, INIT = true;
    const float* X; float* O;
    __device__ __forceinline__ void init(f32x4 (&acc)[2][2][4][2], const Unit& u, int wr, int wc, int fr, int fq) const {
        const int row0 = u.pm * BM + wr * 64 + fr, col0 = u.pn * BM + wc * 32 + 4 * fq;
#pragma unroll
        for (int ai = 0; ai < 2; ++ai)
#pragma unroll
            for (int m = 0; m < 4; ++m) { const size_t off = (size_t)(row0 + ai * HALF + m * 16) * 1024 + col0;
#pragma unroll
                for (int bj = 0; bj < 2; ++bj)
#pragma unroll
                    for (int n = 0; n < 2; ++n) acc[ai][bj][m][n] = *(const f32x4*)(X + off + bj * HALF + n * 16); }
    }
    __device__ __forceinline__ void operator()(const f32x4 (&acc)[2][2][4][2], const Unit& u, int wr, int wc, int fr, int fq) const {
        const int row0 = u.pm * BM + wr * 64 + fr, col0 = u.pn * BM + wc * 32 + 4 * fq;
#pragma unroll
        for (int ai = 0; ai < 2; ++ai)
#pragma unroll
            for (int m = 0; m < 4; ++m) { const size_t off = (size_t)(row0 + ai * HALF + m * 16) * 1024 + col0;
#pragma unroll
                for (int bj = 0; bj < 2; ++bj)
#pragma unroll
                    for (int n = 0; n < 2; ++n) *(f32x4*)(O + off + bj * HALF + n * 16) = acc[ai][bj][m][n]; }
    }
};

struct NoGate { __device__ __forceinline__ void operator()() const {} };
template <class Epi, class Sched, bool ALIGN_EPI, class Gate = NoGate>
__device__ __forceinline__ void gemm_phase(PG8_LAS unsigned char* lds, const Gemm g, const Sched& S, const Epi& E, int wid, const Gate& gate = Gate()) {
    const int lane = lane_id(), tid = wid * 64 + lane, wr = wid >> 2, wc = wid & 3, fr = lane & 15, fq = lane >> 4;
    const int K = g.K, nt = K / BK;
    unsigned voffA[2], voffB[2];
#pragma unroll
    for (int i = 0; i < 2; ++i) { int R, C; stage_rc(tid * 16 + i * 8192, R, C); const int Rb = Epi::PERM ? ((R & ~31) + perm32(R & 31)) : R;
        voffA[i] = (unsigned)(R * g.lda + C) * 2u; voffB[i] = (unsigned)(Rb * g.ldb + C) * 2u; }
    const size_t kstep = (size_t)(BK * 2);
    const size_t hstepA = (size_t)HALF * g.lda * 2, hstepB = (size_t)HALF * g.ldb * 2;
    const size_t tstepA = 2 * hstepA, tstepB = 2 * hstepB;
    const unsigned ldsw = (unsigned)wid * 1024u;
    const int aoff = lds_byte(wr * 64 + fr, fq * 8), boff = lds_byte(wc * 32 + fr, fq * 8);
#define PG8_SA(b, h) (((b) * 2 + (h)) * HTB)
#define PG8_SB(b, h) ((4 + (b) * 2 + (h)) * HTB)
#define PG8_STAGE(bufoff, gbase, voff) do { _Pragma("unroll") for (int _i = 0; _i < 2; ++_i) \
        __builtin_amdgcn_global_load_lds((const unsigned*)((const char*)(gbase) + (voff)[_i]), (PG8_LAS unsigned*)(lds + (bufoff) + ldsw + _i * 8192), 16, 0, 0); } while (0)
#define PG8_LDA(dst, b, h) do { _Pragma("unroll") for (int m = 0; m < 4; ++m) _Pragma("unroll") for (int k = 0; k < 2; ++k) dst[m][k] = *(const PG8_LAS bf16x8*)(lds + PG8_SA(b, h) + aoff + m * 2048 + k * 1024); } while (0)
#define PG8_LDB(dst, b, h) do { _Pragma("unroll") for (int n = 0; n < 2; ++n) _Pragma("unroll") for (int k = 0; k < 2; ++k) dst[n][k] = *(const PG8_LAS bf16x8*)(lds + PG8_SB(b, h) + boff + n * 2048 + k * 1024); } while (0)
#define PG8_MMA(ai, bj, At, Bt) do { __builtin_amdgcn_s_setprio(1); _Pragma("unroll") for (int m = 0; m < 4; ++m) _Pragma("unroll") for (int n = 0; n < 2; ++n) _Pragma("unroll") for (int k = 0; k < 2; ++k) \
        acc[ai][bj][m][n] = __builtin_amdgcn_mfma_f32_16x16x32_bf16(Bt[n][k], At[m][k], acc[ai][bj][m][n], 0, 0, 0); __builtin_amdgcn_s_setprio(0); } while (0)
#define PG8_WAIT_V(n) asm volatile("s_waitcnt vmcnt(" #n ")" ::: "memory")
#define PG8_WAIT_L(n) asm volatile("s_waitcnt lgkmcnt(" #n ")" ::: "memory")
#define PG8_BAR __builtin_amdgcn_s_barrier()
#define PG8_SCHED __builtin_amdgcn_sched_barrier(0)
#define PG8_UA(u) ((const char*)((u).part ? g.A2 : g.A) + (size_t)(u).pm * tstepA)
#define PG8_UB(u) ((const char*)((u).part ? g.Bt2 : g.Bt) + (size_t)(u).pn * tstepB)
    Unit cur, nxt; int ui = 0;
    if (!S.next(0, cur)) return;
    f32x4 acc[2][2][4][2];
    if constexpr (Epi::INIT) E.init(acc, cur, wr, wc, fr, fq);
    else {
#pragma unroll
    for (int a = 0; a < 2; ++a)
#pragma unroll
        for (int b = 0; b < 2; ++b)
#pragma unroll
            for (int m = 0; m < 4; ++m)
#pragma unroll
                for (int n = 0; n < 2; ++n) acc[a][b][m][n] = (f32x4){0.f, 0.f, 0.f, 0.f};
    }
    gate();
    bf16x8 At[4][2], B0[2][2], B1[2][2];
    const char* cA = PG8_UA(cur); const char* cB = PG8_UB(cur);
    PG8_STAGE(PG8_SB(0, 0), cB, voffB); PG8_STAGE(PG8_SB(0, 1), cB + hstepB, voffB); PG8_STAGE(PG8_SA(0, 0), cA, voffA); PG8_STAGE(PG8_SA(0, 1), cA + hstepA, voffA);
    if (wr == 1) PG8_BAR;
    PG8_WAIT_V(2); PG8_BAR;
    PG8_STAGE(PG8_SB(1, 0), cB + kstep, voffB); PG8_STAGE(PG8_SA(1, 0), cA + kstep, voffA); PG8_STAGE(PG8_SB(1, 1), cB + hstepB + kstep, voffB);
    PG8_WAIT_V(6); PG8_BAR;
    for (;;) {
        const bool has_next = S.next(ui + 1, nxt);
        const char* nA = has_next ? PG8_UA(nxt) : cA; const char* nB = has_next ? PG8_UB(nxt) : cB;
        for (int t = 0; t < nt; t += 2) {
            const bool last = (t == nt - 2);
            const char* a1 = cA + (size_t)(t + 1) * kstep;
            const char* a2 = last ? nA : cA + (size_t)(t + 2) * kstep; const char* b2 = last ? nB : cB + (size_t)(t + 2) * kstep;
            const char* a3 = a2 + kstep; const char* b3 = b2 + kstep;
            PG8_LDB(B0, 0, 0); PG8_LDB(B1, 0, 1); PG8_SCHED; PG8_LDA(At, 0, 0); PG8_STAGE(PG8_SA(1, 1), a1 + hstepA, voffA);
            PG8_WAIT_V(8); PG8_WAIT_L(0); PG8_BAR; PG8_MMA(0, 0, At, B0); PG8_MMA(0, 1, At, B1); PG8_BAR; PG8_SCHED;
            PG8_LDA(At, 0, 1); PG8_STAGE(PG8_SB(0, 0), b2, voffB); PG8_STAGE(PG8_SB(0, 1), b2 + hstepB, voffB); PG8_STAGE(PG8_SA(0, 0), a2, voffA);
            PG8_WAIT_V(8); PG8_WAIT_L(0); PG8_BAR; PG8_MMA(1, 0, At, B0); PG8_MMA(1, 1, At, B1); PG8_BAR; PG8_SCHED;
            PG8_LDB(B0, 1, 0); PG8_LDB(B1, 1, 1); PG8_SCHED; PG8_LDA(At, 1, 0); PG8_STAGE(PG8_SA(0, 1), a2 + hstepA, voffA);
            PG8_WAIT_V(8); PG8_WAIT_L(0); PG8_BAR; PG8_MMA(0, 0, At, B0); PG8_MMA(0, 1, At, B1); PG8_BAR; PG8_SCHED;
            PG8_LDA(At, 1, 1); PG8_STAGE(PG8_SB(1, 0), b3, voffB); PG8_STAGE(PG8_SB(1, 1), b3 + hstepB, voffB); PG8_STAGE(PG8_SA(1, 0), a3, voffA);
            PG8_WAIT_V(8); PG8_WAIT_L(0); PG8_BAR; PG8_MMA(1, 0, At, B0); PG8_MMA(1, 1, At, B1); PG8_BAR; PG8_SCHED;
        }
        if constexpr (ALIGN_EPI) { if (wr == 0) PG8_BAR; }
        E(acc, cur, wr, wc, fr, fq);
        if (!has_next) break;
        if constexpr (Epi::INIT) E.init(acc, nxt, wr, wc, fr, fq);
        else {
#pragma unroll
        for (int a = 0; a < 2; ++a)
#pragma unroll
            for (int b = 0; b < 2; ++b)
#pragma unroll
                for (int m = 0; m < 4; ++m)
#pragma unroll
                    for (int n = 0; n < 2; ++n) acc[a][b][m][n] = (f32x4){0.f, 0.f, 0.f, 0.f};
        }
        cur = nxt; cA = nA; cB = nB; ++ui;
        if constexpr (ALIGN_EPI) { if (wr == 1) PG8_BAR; }
    }
    PG8_WAIT_V(0);
    if constexpr (!ALIGN_EPI) { if (wr == 0) PG8_BAR; }
    PG8_BAR;
#undef PG8_SA
#undef PG8_SB
#undef PG8_STAGE
#undef PG8_LDA
#undef PG8_LDB
#undef PG8_MMA
#undef PG8_WAIT_V
#undef PG8_WAIT_L
#undef PG8_BAR
#undef PG8_SCHED
#undef PG8_UA
#undef PG8_UB
}
}

constexpr int NWAVES = 8;
constexpr int N_LAUNCHES = MK_N_LAUNCHES;
constexpr int PER_PHASE = 6;
constexpr size_t MiB = 1u << 20;
constexpr size_t WS_CTL = 0, CTL_ZERO_BYTES = 65536;
constexpr size_t WS_WIN = 1 * MiB;
constexpr size_t WS_WA = 11 * MiB;
constexpr size_t WS_WB = 12 * MiB;
constexpr size_t WS_WOUT = 13 * MiB;
constexpr size_t WS_W1T = 15 * MiB;
constexpr size_t WS_SMALL = 17 * MiB;
constexpr size_t WS_SUM = 18 * MiB;
constexpr size_t WS_KC = 19 * MiB;
constexpr size_t WS_XN = 20 * MiB;
constexpr size_t WS_Q = 52 * MiB;
constexpr size_t WS_KV = 84 * MiB;
constexpr size_t WS_MB = 52 * MiB;
constexpr size_t WS_U = 68 * MiB;
constexpr size_t WS_BR = 108 * MiB;
constexpr size_t WS_GN = 116 * MiB;
constexpr size_t WS_GL = 132 * MiB;
constexpr size_t WS_MG = 148 * MiB;
constexpr size_t WS_VT = 212 * MiB;
constexpr size_t WS_KT = 216 * MiB;
constexpr size_t WS_Q2 = 220 * MiB;
constexpr size_t WS_LB = 236 * MiB;
constexpr size_t WS_END = 252 * MiB;
constexpr size_t SM_W2T = 0;
constexpr size_t SM_LWA = 65536;
constexpr size_t SM_LWX = 131072;
constexpr size_t SM_C1 = 262144;
constexpr size_t SM_LUT = 200704;
constexpr int CW_BAR = 4096;

constexpr int RING_BYTES = 160768;
constexpr int LDSCTL_OFF = RING_BYTES, MISC_OFF = LDSCTL_OFF + 320;
constexpr int LDS_BYTES = 163840;

#define RLX_AGENT __ATOMIC_RELAXED, __HIP_MEMORY_SCOPE_AGENT
#define LDS_WAIT() asm volatile("s_waitcnt lgkmcnt(0)" ::: "memory")
#define VM_WAIT() asm volatile("s_waitcnt vmcnt(0)" ::: "memory")

#define XB_TMO      128
#define XB_XCNT(j)  (256  + 64 * (j))
#define XB_XSUB(j)  (1280 + 64 * (j))
#define XB_XGEN(j)  (2304 + 64 * (j))
#define XB_TOP      3328
#define XB_TOPGEN   3392
#define XCD_BAR_WORDS 3456
#define XB_SPIN_CAP (1u << 18)
__device__ __forceinline__ unsigned xb_ld(unsigned* p)              { return __hip_atomic_load(p, __ATOMIC_RELAXED, __HIP_MEMORY_SCOPE_AGENT); }
__device__ __forceinline__ unsigned xb_add(unsigned* p, unsigned v) { return __hip_atomic_fetch_add(p, v, __ATOMIC_RELAXED, __HIP_MEMORY_SCOPE_AGENT); }
__device__ __forceinline__ unsigned xb_xcc_id() { return (unsigned)__builtin_amdgcn_s_getreg((3 << 11) | 20) & 0xFu; }
#define XB_SPIN(cond, bar) do { unsigned _sp = 0; while (cond) { __builtin_amdgcn_s_sleep(1); \
    if ((++_sp & 255u) == 0u) { if (xb_ld(&(bar)[XB_TMO])) break; if (_sp > XB_SPIN_CAP) { atomicAdd(&(bar)[XB_TMO], 1u); break; } } } } while (0)
struct XcdBarrier { unsigned* bar; unsigned x; volatile LAS unsigned* st; };
constexpr int CW_XCC = 13056, CW_FLAGA = 13312, CW_FLAGB = 13440, CW_FLAGP = 13568;
__device__ __forceinline__ void flag_signal(unsigned* f) {
    asm volatile("s_waitcnt vmcnt(0)" ::: "memory");
    __syncthreads();
    if (threadIdx.x == 0) (void)xb_add(f, 1u);
}
__device__ __forceinline__ void flag_wait(unsigned* f, unsigned target) {
    if (threadIdx.x == 0) { unsigned sp = 0u; while (xb_ld(f) < target) { __builtin_amdgcn_s_sleep(2); if (++sp > (1u << 22)) break; } }
    __syncthreads();
}
__device__ __forceinline__ XcdBarrier xcd_barrier_post(unsigned* bar, volatile LAS unsigned* st) {
    XcdBarrier b; b.bar = bar; b.x = xb_xcc_id(); b.st = st;
    if (threadIdx.x == 0) (void)xb_add(&bar[XB_XCNT(b.x)], 1u);
    return b;
}
__device__ __forceinline__ void xcd_barrier_complete(unsigned* bar, unsigned x, unsigned& nloc, unsigned& nx) {
    const unsigned G = gridDim.x * gridDim.y * gridDim.z;
    unsigned sum, cnt, mine, sp = 0u;
    for (;;) {
        sum = 0u; cnt = 0u; mine = 0u;
#pragma unroll
        for (unsigned j = 0; j < 16; ++j) { const unsigned c = xb_ld(&bar[XB_XCNT(j)]); sum += c; cnt += (c > 0u) ? 1u : 0u; mine = (j == x) ? c : mine; }
        if (sum == G) break;
        __builtin_amdgcn_s_sleep(1);
        if ((++sp & 255u) == 0u) { if (xb_ld(&bar[XB_TMO])) break; if (sp > XB_SPIN_CAP) { atomicAdd(&bar[XB_TMO], 1u); break; } }
    }
    nloc = mine > 0u ? mine : 1u; nx = cnt > 0u ? cnt : 1u;
}
__device__ __forceinline__ void xcd_barrier(const XcdBarrier& b) {
    asm volatile("s_waitcnt vmcnt(0)" ::: "memory");
    __syncthreads();
    if (threadIdx.x == 0) {
        unsigned* bar = b.bar;
        __builtin_amdgcn_s_waitcnt(0);
        unsigned nloc = b.st[0], nx = b.st[1];
        if (nloc == 0u) { xcd_barrier_complete(bar, b.x, nloc, nx); b.st[0] = nloc; b.st[1] = nx; }
        const unsigned old = xb_add(&bar[XB_XSUB(b.x)], 1u);
        const unsigned gen = old / nloc;
        if (old + 1u == (gen + 1u) * nloc) {
            __builtin_amdgcn_fence(__ATOMIC_RELEASE, "agent");
            asm volatile("s_waitcnt vmcnt(0)" ::: "memory");
            const unsigned og = xb_add(&bar[XB_TOP], 1u);
            const unsigned tg = og / nx;
            if (og + 1u == (tg + 1u) * nx) xb_add(&bar[XB_TOPGEN], 1u);
            else XB_SPIN(xb_ld(&bar[XB_TOPGEN]) == tg, bar);
            __builtin_amdgcn_fence(__ATOMIC_ACQUIRE, "agent");
            xb_add(&bar[XB_XGEN(b.x)], 1u);
            asm volatile("s_waitcnt vmcnt(0)" ::: "memory");
        } else {
            XB_SPIN(xb_ld(&bar[XB_XGEN(b.x)]) == gen, bar);
            __builtin_amdgcn_fence(__ATOMIC_ACQUIRE, "agent");
            asm volatile("s_waitcnt vmcnt(0)" ::: "memory");
        }
    }
    __syncthreads();
}

struct Args { const float* in[20]; float* out; unsigned char* ws; int ph_lo, ph_hi, li, pad; };
struct Frame {
    LAS unsigned char* lds;
    volatile LAS unsigned* MISC;
    int wave;
    int vcu, G;
    unsigned char* ws;
#define WSP(name, T, off) __device__ __forceinline__ T* name() const { return (T*)(ws + (off)); }
    WSP(WinT, bf16, WS_WIN) WSP(WaT, bf16, WS_WA) WSP(WbT, bf16, WS_WB) WSP(WoutT, bf16, WS_WOUT) WSP(W1T, bf16, WS_W1T)
    WSP(W2T, bf16, WS_SMALL + SM_W2T) WSP(LWA, bf16, WS_SMALL + SM_LWA) WSP(LWX, bf16, WS_SMALL + SM_LWX)
    WSP(C1, float, WS_SMALL + SM_C1) WSP(LUT, float, WS_SMALL + SM_LUT) WSP(SUMA, float, WS_SUM) WSP(SUMB, float, WS_SUM + 524288)
    WSP(KC, bf16, WS_KC) WSP(VC, bf16, WS_KC + 524288) WSP(XN, bf16, WS_XN) WSP(Q, bf16, WS_Q) WSP(KV, bf16, WS_KV) WSP(MB, bf16, WS_MB)
    WSP(VT, bf16, WS_VT) WSP(KT, bf16, WS_KT) WSP(Q2, bf16, WS_Q2) WSP(LB, bf16, WS_LB) WSP(U, bf16, WS_U) WSP(BR, bf16, WS_BR) WSP(GN, bf16, WS_GN) WSP(GL, bf16, WS_GL) WSP(MG, bf16, WS_MG)
#undef WSP
};

__device__ __forceinline__ int t5_bucket(int n) {
    if (n < 16) return n;
    const int thr[15] = {19, 21, 24, 27, 31, 35, 40, 46, 52, 59, 67, 77, 87, 99, 113};
    int b = 16;
#pragma unroll
    for (int i = 0; i < 15; ++i) b += (n >= thr[i]) ? 1 : 0;
    return b;
}

__device__ __forceinline__ void p0_tr_item(const float* W, int ldw, int k0, int srccol0, int nvalid, bf16* WT, int ldt, int dstrow0, LAS float* scr, int lane) {
    const int c = lane & 31;
    float tv[32];
#pragma unroll
    for (int i = 0; i < 32; ++i) { const int kk = 2 * i + (lane >> 5); tv[i] = (c < nvalid) ? W[(size_t)(k0 + kk) * ldw + srccol0 + c] : 0.f; }
#pragma unroll
    for (int i = 0; i < 32; ++i) { const int kk = 2 * i + (lane >> 5); scr[kk * 33 + c] = tv[i]; }
    LDS_WAIT(); asm volatile("" ::: "memory");
    const int cc = lane & 7;
#pragma unroll
    for (int j = 0; j < 4; ++j) { const int n = (lane >> 3) + 8 * j; const LAS float* s = scr + (8 * cc) * 33 + n;
        u32x4 o; o.x = pk2(s[0 * 33], s[1 * 33]); o.y = pk2(s[2 * 33], s[3 * 33]); o.z = pk2(s[4 * 33], s[5 * 33]); o.w = pk2(s[6 * 33], s[7 * 33]);
        *(u32x4*)(WT + (size_t)(dstrow0 + n) * ldt + k0 + 8 * cc) = o; }
    LDS_WAIT(); asm volatile("" ::: "memory");
}
__device__ __forceinline__ void win_src(int n0, int& src, int& nvalid) {
    nvalid = 32;
    if (n0 < 1280) src = n0;
    else if (n0 < 1792) src = 1816 + (n0 - 1280);
    else if (n0 < 2048) { src = 1792 + (n0 - 1792); nvalid = (n0 == 1792) ? 24 : 0; if (n0 != 1792) src = 0; }
    else if (n0 < 2560) src = 1280 + (n0 - 2048);
    else if (n0 < 3072) src = 2328 + (n0 - 2560);
    else src = 2840 + (n0 - 3072);
}
__device__ __forceinline__ void p0_prologue(const Frame& F, const Args& A) {
    LAS float* scr = (LAS float*)(F.lds + F.wave * 16384);
    const int gw = F.vcu * NWAVES + F.wave, NGW = F.G * NWAVES, lane = lane_id();
    constexpr int I_WIN = 16 * 160, I_WA = 8 * 32, I_WO = 16 * 32, I_W1 = 32 * 8, I_W2 = 4 * 2, I_LR = 2;
    constexpr int NIT = I_WIN + 2 * I_WA + I_WO + 2 * I_W1 + 2 * I_W2 + 16 * I_LR + 256 + 1;
    for (int it = gw; it < NIT; it += NGW) {
        int r = it;
        if (r < I_WIN) { const int kb = r / 160, nb = r % 160; int src, nv; win_src(32 * nb, src, nv); p0_tr_item(A.in[2], 4888, 64 * kb, src, nv, F.WinT(), 1024, 32 * nb, scr, lane); continue; } r -= I_WIN;
        if (r < I_WA) { p0_tr_item(A.in[17], 1024, 64 * (r / 32), 32 * (r % 32), 32, F.WaT(), 512, 32 * (r % 32), scr, lane); continue; } r -= I_WA;
        if (r < I_WA) { p0_tr_item(A.in[18], 1024, 64 * (r / 32), 32 * (r % 32), 32, F.WbT(), 512, 32 * (r % 32), scr, lane); continue; } r -= I_WA;
        if (r < I_WO) { p0_tr_item(A.in[19], 1024, 64 * (r / 32), 32 * (r % 32), 32, F.WoutT(), 1024, 32 * (r % 32), scr, lane); continue; } r -= I_WO;
        if (r < 2 * I_W1) { const int kv = r / I_W1, q = r % I_W1; p0_tr_item(A.in[6] + (size_t)kv * 2048 * 256, 256, 64 * (q / 8), 32 * (q % 8), 32, F.W1T() + (size_t)kv * 256 * 2048, 2048, 32 * (q % 8), scr, lane); continue; } r -= 2 * I_W1;
        if (r < 2 * I_W2) { const int kv = r / I_W2, q = r % I_W2; p0_tr_item(A.in[8] + (size_t)kv * 256 * 64, 64, 64 * (q / 2), 32 * (q % 2), 32, F.W2T() + (size_t)kv * 64 * 256, 256, 32 * (q % 2), scr, lane); continue; } r -= 2 * I_W2;
        if (r < 16 * I_LR) { const int mtx = r / 2, nb = r % 2; const float* src = (mtx < 8 ? A.in[12] : A.in[14]) + (size_t)(mtx & 7) * 4096; bf16* dst = (mtx < 8 ? F.LWA() : F.LWX()) + (size_t)(mtx & 7) * 4096;
            p0_tr_item(src, 64, 0, 32 * nb, 32, dst, 64, 32 * nb, scr, lane); continue; } r -= 16 * I_LR;
        if (r < 256) {
            const int kc = r >> 3, kv = (r >> 2) & 1, n = (r & 3) * 64 + lane; const float* w1 = A.in[6] + (size_t)kv * 2048 * 256 + (size_t)(64 * kc) * 256 + n; const float* pe = A.in[5] + kv * 2048 + 64 * kc;
            float s0 = 0.f, s1 = 0.f, s2 = 0.f, s3 = 0.f;
#pragma unroll 4
            for (int k = 0; k < 64; k += 4) { s0 += pe[k] * w1[(size_t)k * 256]; s1 += pe[k + 1] * w1[(size_t)(k + 1) * 256]; s2 += pe[k + 2] * w1[(size_t)(k + 2) * 256]; s3 += pe[k + 3] * w1[(size_t)(k + 3) * 256]; }
            F.C1()[(kc * 2 + kv) * 256 + n] = (s0 + s1) + (s2 + s3); continue; } r -= 256;
        {
            for (int e = lane; e < 1024; e += 64) { const int hd = e >> 7, n = e & 127; F.LUT()[e] = A.in[9][t5_bucket(n) * 8 + hd] * LOG2E; }
        }
    }
    const float* gain = A.in[1];
    {
        f32x4 v[4], vn[4];
        if (gw < SEQ) { const f32x4* xr = (const f32x4*)(A.in[0] + (size_t)gw * DM) + lane;
#pragma unroll
            for (int j = 0; j < 4; ++j) v[j] = xr[64 * j]; }
        for (int m = gw; m < SEQ; m += NGW) {
            if (m + NGW < SEQ) { const f32x4* xr = (const f32x4*)(A.in[0] + (size_t)(m + NGW) * DM) + lane;
#pragma unroll
                for (int j = 0; j < 4; ++j) vn[j] = xr[64 * j]; }
            float s = 0.f;
#pragma unroll
            for (int j = 0; j < 4; ++j) s += (v[j].x * v[j].x + v[j].y * v[j].y) + (v[j].z * v[j].z + v[j].w * v[j].w);
            const float rs = 1.0f / sqrtf(wave_sum(s) * (1.f / DM) + RMS_EPS);
            unsigned long long* o8 = (unsigned long long*)(F.XN() + (size_t)m * DM) + lane;
#pragma unroll
            for (int j = 0; j < 4; ++j) { const f32x4 gv = ((const f32x4*)gain)[lane + 64 * j];
                o8[64 * j] = (unsigned long long)pk2(v[j].x * rs * gv.x, v[j].y * rs * gv.y) | ((unsigned long long)pk2(v[j].z * rs * gv.z, v[j].w * rs * gv.w) << 32); }
#pragma unroll
            for (int j = 0; j < 4; ++j) v[j] = vn[j];
        }
    }
}

template <bool FINAL>
__device__ __forceinline__ void lru_tile(const Frame& F, const Args& A, int tt) {
    const int lane = lane_id();
    const int w = F.wave, fr = lane & 15, fq = lane >> 4, ch0 = 64 * w, t0 = 64 * tt;
    LAS float* UC = (LAS float*)(F.lds + w * 16384);
#define UC_IDX(tok, ch) ((tok) * 64 + ((((ch) >> 2) ^ ((tok) & 15)) << 2) + ((ch) & 3))
    float Hc = 0.f;
    if (FINAL) {
        const float* sa = F.SUMA() + ch0 + lane; const float* sb = F.SUMB() + ch0 + lane;
        int i = 0;
        for (; i + 64 <= tt; i += 64) { float ta[64], tb[64];
#pragma unroll
            for (int k = 0; k < 64; ++k) { ta[k] = sa[(size_t)(i + k) * 512]; tb[k] = sb[(size_t)(i + k) * 512]; }
#pragma unroll
            for (int k = 0; k < 64; ++k) Hc = ta[k] * Hc + tb[k]; }
        for (; i + 16 <= tt; i += 16) { float ta[16], tb[16];
#pragma unroll
            for (int k = 0; k < 16; ++k) { ta[k] = sa[(size_t)(i + k) * 512]; tb[k] = sb[(size_t)(i + k) * 512]; }
#pragma unroll
            for (int k = 0; k < 16; ++k) Hc = ta[k] * Hc + tb[k]; }
        for (; i < tt; ++i) Hc = sa[(size_t)i * 512] * Hc + sb[(size_t)i * 512];
        asm volatile("" : "+v"(Hc));
    }
    {
        const int ch = ch0 + lane; const float* cw = A.in[10]; const float cb = A.in[11][ch];
        const float w0 = cw[ch], w1 = cw[512 + ch], w2 = cw[1024 + ch], w3 = cw[1536 + ch];
        const bf16* up = F.U() + (size_t)t0 * 512 + ch;
        float u0 = 0.f, u1 = 0.f, u2 = 0.f;
        if (tt > 0) { u0 = bf2f(up[-3 * 512]); u1 = bf2f(up[-2 * 512]); u2 = bf2f(up[-1 * 512]); }
        unsigned short ur[64];
#pragma unroll
        for (int tok = 0; tok < 64; ++tok) ur[tok] = up[(size_t)tok * 512];
#pragma unroll
        for (int tok = 0; tok < 64; ++tok) { const float u3 = bf2f(ur[tok]);
            UC[UC_IDX(tok, lane)] = cb + ((u0 * w0 + u1 * w1) + (u2 * w2 + u3 * w3)); u0 = u1; u1 = u2; u2 = u3; }
    }
    bf16x8 Ba[4][2], Bx[4][2];
#pragma unroll
    for (int nt = 0; nt < 4; ++nt)
#pragma unroll
        for (int ks = 0; ks < 2; ++ks) { const size_t o = (size_t)w * 4096 + (16 * nt + fr) * 64 + 32 * ks + 8 * fq; Ba[nt][ks] = *(const bf16x8*)(F.LWA() + o); Bx[nt][ks] = *(const bf16x8*)(F.LWX() + o); }
    float ba[4], bx[4], sp8[4], hin[4], acum[4];
#pragma unroll
    for (int nt = 0; nt < 4; ++nt) { const int ch = ch0 + 16 * nt + fr; ba[nt] = A.in[13][ch]; bx[nt] = A.in[15][ch];
        sp8[nt] = 8.0f * log1pf(expf(-A.in[16][ch])); hin[nt] = 0.f; acum[nt] = 1.f; }
    if (FINAL) {
#pragma unroll
        for (int nt = 0; nt < 4; ++nt) hin[nt] = __shfl(Hc, 16 * nt + fr);
    }
    LDS_WAIT();
    unsigned short glv[16], gln[16];
    if (FINAL) {
#pragma unroll
        for (int nt = 0; nt < 4; ++nt)
#pragma unroll
            for (int rg = 0; rg < 4; ++rg) glv[nt * 4 + rg] = F.GL()[(size_t)(t0 + 4 * fq + rg) * 512 + ch0 + 16 * nt + fr];
    }
#pragma unroll 1
    for (int mt = 0; mt < 4; ++mt) {
        if (FINAL && mt < 3) {
#pragma unroll
            for (int nt = 0; nt < 4; ++nt)
#pragma unroll
                for (int rg = 0; rg < 4; ++rg) gln[nt * 4 + rg] = F.GL()[(size_t)(t0 + 16 * (mt + 1) + 4 * fq + rg) * 512 + ch0 + 16 * nt + fr];
        }
        bf16x8 Af[2];
#pragma unroll
        for (int ks = 0; ks < 2; ++ks) { const int tok = 16 * mt + fr, c0 = 8 * ks + 2 * fq;
            const f32x4 x0 = *(const LAS f32x4*)(UC + tok * 64 + ((c0 ^ (tok & 15)) << 2)), x1 = *(const LAS f32x4*)(UC + tok * 64 + (((c0 + 1) ^ (tok & 15)) << 2));
            u32x4 pw; pw.x = cvtpk(x0[0], x0[1]); pw.y = cvtpk(x0[2], x0[3]); pw.z = cvtpk(x1[0], x1[1]); pw.w = cvtpk(x1[2], x1[3]); Af[ks] = __builtin_bit_cast(bf16x8, pw); }
        f32x4 cr[4], ci[4];
#pragma unroll
        for (int nt = 0; nt < 4; ++nt) { cr[nt] = (f32x4){0.f, 0.f, 0.f, 0.f}; ci[nt] = (f32x4){0.f, 0.f, 0.f, 0.f};
#pragma unroll
            for (int ks = 0; ks < 2; ++ks) { cr[nt] = __builtin_amdgcn_mfma_f32_16x16x32_bf16(Af[ks], Ba[nt][ks], cr[nt], 0, 0, 0); ci[nt] = __builtin_amdgcn_mfma_f32_16x16x32_bf16(Af[ks], Bx[nt][ks], ci[nt], 0, 0, 0); } }
#pragma unroll
        for (int nt = 0; nt < 4; ++nt) {
            float P[4], Hh[4];
#pragma unroll
            for (int rg = 0; rg < 4; ++rg) { const int tok = 16 * mt + 4 * fq + rg, e = 16 * nt + fr;
                const float ucv = UC[UC_IDX(tok, e)];
                const float r = fsigmoid(cr[nt][rg] + ba[nt]), ig = fsigmoid(ci[nt][rg] + bx[nt]);
                const float la = -r * sp8[nt]; const float a = __builtin_amdgcn_exp2f(la * LOG2E);
                const float x2 = 2.0f * la;
                const float ser = -x2 * (1.0f + x2 * (0.5f + x2 * (0.16666667f + x2 * (0.041666668f + x2 * 0.008333334f))));
                const float om = (x2 > -0.25f) ? ser : 1.0f - a * a;
                const float b = __builtin_amdgcn_sqrtf(om) * (ig * ucv);
                if (!FINAL) {
                    const float so = -la * (1.0f + la * (0.5f + la * (0.16666667f + la * (0.041666668f + la * 0.008333334f))));
                    const float oma = (la > -0.25f) ? so : 1.0f - a; const size_t tg = (size_t)(t0 + tok); const int chg = ch0 + e;
                    F.XN()[tg * 1024 + 512 + chg] = (bf16)f2bf(oma); F.LB()[tg * 512 + chg] = (bf16)f2bf(b); }
                if (rg == 0) { P[0] = a; Hh[0] = b; } else { P[rg] = P[rg - 1] * a; Hh[rg] = a * Hh[rg - 1] + b; } }
            float At = P[3], Bt = Hh[3];
            { const float Ap = __shfl_up(At, 16), Bp = __shfl_up(Bt, 16); if (fq >= 1) { Bt = At * Bp + Bt; At = Ap * At; } }
            { const float Ap = __shfl_up(At, 32), Bp = __shfl_up(Bt, 32); if (fq >= 2) { Bt = At * Bp + Bt; At = Ap * At; } }
            float Aex = __shfl_up(At, 16), Bex = __shfl_up(Bt, 16); if (fq == 0) { Aex = 1.f; Bex = 0.f; }
            const float hg = Aex * hin[nt] + Bex;
            float hv[4];
#pragma unroll
            for (int rg = 0; rg < 4; ++rg) hv[rg] = P[rg] * hg + Hh[rg];
            hin[nt] = __shfl(hv[3], 48 + fr);
            if (!FINAL) acum[nt] *= __shfl(At, 48 + fr);
            if (FINAL) {
#pragma unroll
                for (int rg = 0; rg < 4; ++rg) { const size_t t = (size_t)(t0 + 16 * mt + 4 * fq + rg); const int ch = ch0 + 16 * nt + fr;
                    F.XN()[t * 1024 + 512 + ch] = (bf16)f2bf(hv[rg] * bf2f(glv[nt * 4 + rg])); }
            }
        }
        if (FINAL) {
#pragma unroll
            for (int x = 0; x < 16; ++x) glv[x] = gln[x];
        }
    }
    if (!FINAL && fq == 0) {
#pragma unroll
        for (int nt = 0; nt < 4; ++nt) { F.SUMA()[(size_t)tt * 512 + ch0 + 16 * nt + fr] = acum[nt]; F.SUMB()[(size_t)tt * 512 + ch0 + 16 * nt + fr] = hin[nt]; }
    }
    LDS_WAIT();
#undef UC_IDX
}

__device__ __forceinline__ void lru_apply(const Frame& F, int tt) {
    const int lane = lane_id(), ch = 64 * F.wave + lane, t0 = 64 * tt;
    float H = 0.f;
    { const float* sa = F.SUMA() + ch; const float* sb = F.SUMB() + ch; int i = 0;
        for (; i + 64 <= tt; i += 64) { float ta[64], tb[64];
#pragma unroll
            for (int k = 0; k < 64; ++k) { ta[k] = sa[(size_t)(i + k) * 512]; tb[k] = sb[(size_t)(i + k) * 512]; }
#pragma unroll
            for (int k = 0; k < 64; ++k) H = ta[k] * H + tb[k]; }
        for (; i + 16 <= tt; i += 16) { float ta[16], tb[16];
#pragma unroll
            for (int k = 0; k < 16; ++k) { ta[k] = sa[(size_t)(i + k) * 512]; tb[k] = sb[(size_t)(i + k) * 512]; }
#pragma unroll
            for (int k = 0; k < 16; ++k) H = ta[k] * H + tb[k]; }
        for (; i < tt; ++i) H = sa[(size_t)i * 512] * H + sb[(size_t)i * 512]; }
    bf16* px = F.XN() + (size_t)t0 * 1024 + 512 + ch; const bf16* pb = F.LB() + (size_t)t0 * 512 + ch; const bf16* pg = F.GL() + (size_t)t0 * 512 + ch;
#pragma unroll 1
    for (int c = 0; c < 2; ++c) { unsigned short av[32], bv[32], gv[32];
#pragma unroll
        for (int k = 0; k < 32; ++k) { const size_t tk = (size_t)(32 * c + k); av[k] = px[tk * 1024]; bv[k] = pb[tk * 512]; gv[k] = pg[tk * 512]; }
#pragma unroll
        for (int k = 0; k < 32; ++k) { H = (1.0f - bf2f(av[k])) * H + bf2f(bv[k]); px[(size_t)(32 * c + k) * 1024] = (bf16)f2bf(H * bf2f(gv[k])); } }
}

__device__ __forceinline__ void qk_norm_tile(const Frame& F, const Args& A, int tt) {
    const int lane = lane_id(), sub = lane & 7;
#pragma unroll 4
    for (int it = 0; it < 12; ++it) {
        const int idx = it * 64 + F.wave * 8 + (lane >> 3), tok = idx / 12, hr = idx % 12; const size_t t = (size_t)(64 * tt + tok);
        bf16* p; bf16* dst; const float* gain; float sc = 1.f;
        if (hr < 8) { p = F.Q() + t * 512 + hr * 64; dst = F.Q2() + t * 512 + (hr >> 2) * 256 + (sub >> 1) * 64 + (hr & 3) * 16 + (sub & 1) * 8 - sub * 8; gain = A.in[3]; sc = 0.125f * LOG2E; }
        else if (hr < 10) { p = F.KV() + t * 768 + 256 + (hr - 8) * 64; dst = p; gain = A.in[4] + 64; }
        else { p = F.KV() + t * 768 + 512 + (hr - 10) * 64; dst = p; gain = A.in[4] + 128; }
        const u32x4 w = *(const u32x4*)(p + sub * 8);
        float x[8] = {bflo(w.x), bfhi(w.x), bflo(w.y), bfhi(w.y), bflo(w.z), bfhi(w.z), bflo(w.w), bfhi(w.w)};
        float ss = 0.f;
#pragma unroll
        for (int j = 0; j < 8; ++j) ss += x[j] * x[j];
        ss += __shfl_xor(ss, 1); ss += __shfl_xor(ss, 2); ss += __shfl_xor(ss, 4);
        const float rs = sc / sqrtf(ss * (1.f / 64.f) + RMS_EPS);
        const f32x4 g0 = *(const f32x4*)(gain + sub * 8), g1 = *(const f32x4*)(gain + sub * 8 + 4);
        u32x4 o; o.x = pk2(x[0] * rs * g0.x, x[1] * rs * g0.y); o.y = pk2(x[2] * rs * g0.z, x[3] * rs * g0.w); o.z = pk2(x[4] * rs * g1.x, x[5] * rs * g1.y); o.w = pk2(x[6] * rs * g1.z, x[7] * rs * g1.w);
        *(u32x4*)(dst + sub * 8) = o;
        if (hr >= 8 && hr < 10) {
            int w0 = __builtin_amdgcn_cvt_pk_fp8_f32(x[0] * rs * g0.x, x[1] * rs * g0.y, 0, false); w0 = __builtin_amdgcn_cvt_pk_fp8_f32(x[2] * rs * g0.z, x[3] * rs * g0.w, w0, true);
            int w1 = __builtin_amdgcn_cvt_pk_fp8_f32(x[4] * rs * g1.x, x[5] * rs * g1.y, 0, false); w1 = __builtin_amdgcn_cvt_pk_fp8_f32(x[6] * rs * g1.z, x[7] * rs * g1.w, w1, true);
            u32x2* kt8 = (u32x2*)F.KT() + (size_t)((hr - 8) * 256 + tt) * 512 + ((((sub >> 2) * 4 + (tok >> 4)) * 4 + (sub & 3)) * 16 + (tok & 15));
            *kt8 = (u32x2){(unsigned)w0, (unsigned)w1}; }
    }
}

__device__ __forceinline__ void vt_tile(const Frame& F, int J) {
    const int tid = F.wave * 64 + lane_id(), d = tid & 63, ks = (tid >> 6) & 1, gp = tid >> 7;
#pragma unroll
    for (int g = 0; g < 2; ++g) {
        const bf16* vp = F.KV() + (size_t)(64 * J) * 768 + 384 + 64 * g + d;
        unsigned short e[8];
#pragma unroll
        for (int j = 0; j < 8; ++j) { const int key = 32 * ks + 4 * gp + (j & 3) + 16 * (j >> 2); e[j] = vp[(size_t)key * 768]; }
        u32x4 w; w.x = e[0] | ((unsigned)e[1] << 16); w.y = e[2] | ((unsigned)e[3] << 16); w.z = e[4] | ((unsigned)e[5] << 16); w.w = e[6] | ((unsigned)e[7] << 16);
        *(u32x4*)(F.VT() + (size_t)(g * 256 + J) * 4096 + ((((d >> 4) * 2 + ks) * 16 + (d & 15)) * 32) + 8 * gp) = w;
    }
}

__device__ __forceinline__ void compress_item(const Frame& F, const Args& A, int kv, int g, int ct) {
    const int lane = lane_id(), w = F.wave, tid = w * 64 + lane, fr = lane & 15, fq = lane >> 4, c0 = 16 * ct, tb = 16 * c0;
    LAS unsigned char* T = F.lds;
    LAS bf16* HID = (LAS bf16*)(F.lds + 34816);
    LAS float* OUTF = (LAS float*)(F.lds + 34816 + 8448);
    LAS float* C1L = (LAS float*)(F.lds + 34816 + 8448 + 4096);
    {
        u32x4 tv[5];
#pragma unroll
        for (int i = 0; i < 5; ++i) { const int idx = tid + 512 * i, tok = idx >> 3, chn = idx & 7, gt = tb + tok; tv[i] = (u32x4){0u, 0u, 0u, 0u};
            if (idx < 272 * 8 && gt < SEQ) tv[i] = *(const u32x4*)(F.KV() + (size_t)gt * 768 + kv * 128 + g * 64 + chn * 8); }
        { const int n = tid & 255, hf = tid >> 8; float pc[16];
#pragma unroll
            for (int k = 0; k < 16; ++k) pc[k] = F.C1()[((hf * 16 + k) * 2 + kv) * 256 + n];
            float s = hf ? 0.f : A.in[7][kv * 256 + n];
#pragma unroll
            for (int k = 0; k < 16; ++k) s += pc[k];
            C1L[hf * 256 + n] = s; }
#pragma unroll
        for (int i = 0; i < 5; ++i) { const int idx = tid + 512 * i, tok = idx >> 3, chn = idx & 7;
            if (idx < 272 * 8) *(LAS u32x4*)(T + tok * 128 + ((chn ^ ((tok >> 4) & 7)) << 4)) = tv[i]; }
    }
    LDS_WAIT(); __syncthreads();
    f32x4 acc[2] = {(f32x4){0.f, 0.f, 0.f, 0.f}, (f32x4){0.f, 0.f, 0.f, 0.f}};
    const bf16* w1t = F.W1T() + (size_t)kv * 256 * 2048 + (size_t)(32 * w + fr) * 2048 + 8 * fq;
#pragma unroll 32
    for (int ks = 0; ks < 64; ++ks) {
        const int tok = 16 * fr + (ks >> 1), chn = 4 * (ks & 1) + fq;
        const bf16x8 a = *(const LAS bf16x8*)(T + tok * 128 + ((chn ^ ((tok >> 4) & 7)) << 4));
        const bf16x8 b0 = *(const bf16x8*)(w1t + 32 * ks), b1 = *(const bf16x8*)(w1t + (size_t)16 * 2048 + 32 * ks);
        acc[0] = __builtin_amdgcn_mfma_f32_16x16x32_bf16(a, b0, acc[0], 0, 0, 0);
        acc[1] = __builtin_amdgcn_mfma_f32_16x16x32_bf16(a, b1, acc[1], 0, 0, 0);
    }
#pragma unroll
    for (int nt = 0; nt < 2; ++nt) { const int n = 32 * w + 16 * nt + fr; const float c1 = C1L[n] + C1L[256 + n];
#pragma unroll
        for (int rg = 0; rg < 4; ++rg) { const float v = acc[nt][rg] + c1; HID[(4 * fq + rg) * 264 + n] = (bf16)f2bf(v * fsigmoid(v)); } }
    LDS_WAIT(); __syncthreads();
    if (w < 4) {
        f32x4 o = (f32x4){0.f, 0.f, 0.f, 0.f};
        const bf16* w2t = F.W2T() + (size_t)kv * 64 * 256 + (size_t)(16 * w + fr) * 256 + 8 * fq;
#pragma unroll
        for (int ks = 0; ks < 8; ++ks) { const bf16x8 a = *(const LAS bf16x8*)(HID + fr * 264 + 32 * ks + 8 * fq); const bf16x8 b = *(const bf16x8*)(w2t + 32 * ks);
            o = __builtin_amdgcn_mfma_f32_16x16x32_bf16(a, b, o, 0, 0, 0); }
#pragma unroll
        for (int rg = 0; rg < 4; ++rg) OUTF[(4 * fq + rg) * 64 + 16 * w + fr] = o[rg];
    }
    LDS_WAIT(); __syncthreads();
    {
        const int row = tid >> 5, e = 2 * (tid & 31), c = c0 + row;
        float v0 = OUTF[row * 64 + e], v1 = OUTF[row * 64 + e + 1];
        if (kv == 0) { float ss = v0 * v0 + v1 * v1;
#pragma unroll
            for (int o = 1; o < 32; o <<= 1) ss += __shfl_xor(ss, o);
            const float rs = 1.0f / sqrtf(ss * (1.f / 64.f) + RMS_EPS); v0 *= rs * A.in[4][e]; v1 *= rs * A.in[4][e + 1]; }
        if (c >= 1023) { v0 = 0.f; v1 = 0.f; }
        bf16* dst = (kv == 0 ? F.KC() : F.VC()) + ((size_t)g * 1024 + c) * 64 + e;
        *(unsigned*)dst = pk2(v0, v1);
    }
    LDS_WAIT(); __syncthreads();
}

namespace att {
constexpr int SLOTB = 8192, NSLOT = 3;
constexpr int L_K = 0, L_V = NSLOT * SLOTB, L_SC = 2 * NSLOT * SLOTB, L_OUT = L_SC + 65536, L_LUT = L_OUT + 32768, L_WSF = L_LUT + 2048, L_BM = L_WSF + 2048, L_REF = L_BM + 2048, L_LACC = L_REF + 1024, L_TL = L_LACC + 1024  , L_END = L_TL + 5120;
static_assert(L_END <= RING_BYTES, "attention LDS map");
constexpr int L_EX = 0  ,
              L_HDR = 69632  , L_LEX = 70144  , L_NT = 71168  ;
static_assert(L_NT + 32 <= L_SC + 65536, "part B exchange area");
constexpr float CLAMP = 100.0f;
constexpr float THR = 8.0f;
#define SBAR() __builtin_amdgcn_sched_barrier(0)
__device__ __forceinline__ int crow(int r, int hi) { return (r & 3) + 8 * (r >> 2) + 4 * hi; }
__device__ __forceinline__ void glds16(const void* gsrc, unsigned lds_dst) { unsigned keep;
    asm volatile("s_mov_b32 %0, m0\n\ts_mov_b32 m0, %2\n\ts_nop 0\n\tglobal_load_lds_dwordx4 %1, off\n\ts_mov_b32 m0, %0" : "=&s"(keep) : "v"(gsrc), "s"(lds_dst) : "memory"); }
__device__ __forceinline__ void qkt(f32x16& p0, f32x16& p1, const LAS unsigned char* Kslot, const bf16x8* qr, int r32, int hi) {
    const LAS unsigned char* kb = Kslot + hi * 1024 + r32 * 16;
    const f32x16 z = {0.f, 0.f, 0.f, 0.f, 0.f, 0.f, 0.f, 0.f, 0.f, 0.f, 0.f, 0.f, 0.f, 0.f, 0.f, 0.f};
#pragma unroll
    for (int d0 = 0; d0 < 4; ++d0) {
        const bf16x8 b0 = *(const LAS bf16x8*)(kb + d0 * 2048);
        const bf16x8 b1 = *(const LAS bf16x8*)(kb + d0 * 2048 + 512);
        if (d0 == 0) { p0 = __builtin_amdgcn_mfma_f32_32x32x16_bf16(b0, qr[0], z, 0, 0, 0); p1 = __builtin_amdgcn_mfma_f32_32x32x16_bf16(b1, qr[0], z, 0, 0, 0); }
        else { p0 = __builtin_amdgcn_mfma_f32_32x32x16_bf16(b0, qr[d0], p0, 0, 0, 0); p1 = __builtin_amdgcn_mfma_f32_32x32x16_bf16(b1, qr[d0], p1, 0, 0, 0); } }
}
__device__ __forceinline__ void pv(f32x16* o, int vb, bf16x8 pa0, bf16x8 pa1, bf16x8 pa2, bf16x8 pa3) {
    s16x4 lo[8], hi[8];
#pragma unroll
    for (int x = 0; x < 8; ++x) {
        asm volatile("ds_read_b64_tr_b16 %0,%1 offset:%c2" : "=&v"(lo[x]) : "v"(vb), "i"((x >> 2) * 4096 + (x & 3) * 1024) : "memory");
        asm volatile("ds_read_b64_tr_b16 %0,%1 offset:%c2" : "=&v"(hi[x]) : "v"(vb), "i"((x >> 2) * 4096 + (x & 3) * 1024 + 512) : "memory"); }
    asm volatile("s_waitcnt lgkmcnt(0)" ::: "memory"); SBAR();
#define PK(k) (bf16x8){lo[k][0], lo[k][1], lo[k][2], lo[k][3], hi[k][0], hi[k][1], hi[k][2], hi[k][3]}
    o[0] = __builtin_amdgcn_mfma_f32_32x32x16_bf16(pa0, PK(0), o[0], 0, 0, 0); o[1] = __builtin_amdgcn_mfma_f32_32x32x16_bf16(pa0, PK(4), o[1], 0, 0, 0);
    o[0] = __builtin_amdgcn_mfma_f32_32x32x16_bf16(pa1, PK(1), o[0], 0, 0, 0); o[1] = __builtin_amdgcn_mfma_f32_32x32x16_bf16(pa1, PK(5), o[1], 0, 0, 0);
    o[0] = __builtin_amdgcn_mfma_f32_32x32x16_bf16(pa2, PK(2), o[0], 0, 0, 0); o[1] = __builtin_amdgcn_mfma_f32_32x32x16_bf16(pa2, PK(6), o[1], 0, 0, 0);
    o[0] = __builtin_amdgcn_mfma_f32_32x32x16_bf16(pa3, PK(3), o[0], 0, 0, 0); o[1] = __builtin_amdgcn_mfma_f32_32x32x16_bf16(pa3, PK(7), o[1], 0, 0, 0);
#undef PK
}
__device__ __forceinline__ float rowmax(const f32x16& p0, const f32x16& p1) {
    float a = fmaxf(fmaxf(p0[0], p0[1]), p1[0]), b = fmaxf(fmaxf(p0[2], p0[3]), p1[1]); a = fmaxf(fmaxf(a, p1[2]), p1[3]);
#pragma unroll
    for (int r = 4; r < 16; r += 4) { a = fmaxf(fmaxf(a, p0[r]), p0[r + 1]); b = fmaxf(fmaxf(b, p0[r + 2]), p0[r + 3]); a = fmaxf(fmaxf(a, p1[r]), p1[r + 1]); b = fmaxf(fmaxf(b, p1[r + 2]), p1[r + 3]); }
    const float m = fmaxf(a, b);
    auto rr = __builtin_amdgcn_permlane32_swap(__float_as_uint(m), __float_as_uint(m), false, false);
    return fmaxf(__uint_as_float(rr[0]), __uint_as_float(rr[1]));
}
__device__ __forceinline__ float halfsum(float v) { auto rr = __builtin_amdgcn_permlane32_swap(__float_as_uint(v), __float_as_uint(v), false, false); return __uint_as_float(rr[0]) + __uint_as_float(rr[1]); }
template <int STEP, unsigned LIMIT>
__device__ __forceinline__ void near_apply(f32x16& p0, f32x16& p1, int dbase, const LAS float* lut) {
    float b0[16], b1[16];
#pragma unroll
    for (int r = 0; r < 16; ++r) { const int koff = (r & 3) + 8 * (r >> 2); const int d0 = dbase - STEP * koff, d1 = d0 - STEP * 32;
        b0[r] = lut[4 * min(max(d0, 0), 127)]; b1[r] = lut[4 * min(max(d1, 0), 127)]; }
#pragma unroll
    for (int r = 0; r < 16; ++r) { asm volatile("" : "+v"(b0[r]), "+v"(b1[r])); }
#pragma unroll
    for (int r = 0; r < 16; ++r) { const int koff = (r & 3) + 8 * (r >> 2); const int d0 = dbase - STEP * koff, d1 = d0 - STEP * 32;
        const float t0 = p0[r] + b0[r], t1 = p1[r] + b1[r];
        p0[r] = ((unsigned)d0 < LIMIT) ? t0 : -INFINITY; p1[r] = ((unsigned)d1 < LIMIT) ? t1 : -INFINITY; }
}
template <bool HASO>
__device__ __forceinline__ void sm_update(f32x16& p0, f32x16& p1, float bias, float& m, float& l, f32x16* o, LAS float* wsf, int r32, int hi) {
    const float rm = rowmax(p0, p1) + bias;
    const bool need = rm > m + THR;
    if (__any(need)) {
        const float mn = need ? rm : m; const float alpha = __builtin_amdgcn_exp2f(m - mn);
        l *= alpha; m = mn;
        if (HASO) { if (hi == 0) wsf[r32] = alpha; LDS_WAIT();
#pragma unroll
            for (int r = 0; r < 16; ++r) { const float f = wsf[crow(r, hi)]; o[0][r] *= f; o[1][r] *= f; } }
    }
    const float mb = m - bias;
#pragma unroll
    for (int r = 0; r < 16; ++r) { p0[r] = __builtin_amdgcn_exp2f(p0[r] - mb); p1[r] = __builtin_amdgcn_exp2f(p1[r] - mb); }
    float t[8];
#pragma unroll
    for (int r = 0; r < 8; ++r) t[r] = (p0[2 * r] + p0[2 * r + 1]) + (p1[2 * r] + p1[2 * r + 1]);
    l += ((t[0] + t[1]) + (t[2] + t[3])) + ((t[4] + t[5]) + (t[6] + t[7]));
}
#define ATT_PACK(P0, P1) \
    const bf16x8 pa0 = __builtin_bit_cast(bf16x8, (u32x4){cvtpk(P0[0], P0[1]), cvtpk(P0[2], P0[3]), cvtpk(P0[4], P0[5]), cvtpk(P0[6], P0[7])}); \
    const bf16x8 pa1 = __builtin_bit_cast(bf16x8, (u32x4){cvtpk(P0[8], P0[9]), cvtpk(P0[10], P0[11]), cvtpk(P0[12], P0[13]), cvtpk(P0[14], P0[15])}); \
    const bf16x8 pa2 = __builtin_bit_cast(bf16x8, (u32x4){cvtpk(P1[0], P1[1]), cvtpk(P1[2], P1[3]), cvtpk(P1[4], P1[5]), cvtpk(P1[6], P1[7])}); \
    const bf16x8 pa3 = __builtin_bit_cast(bf16x8, (u32x4){cvtpk(P1[8], P1[9]), cvtpk(P1[10], P1[11]), cvtpk(P1[12], P1[13]), cvtpk(P1[14], P1[15])});
#define ATT_WAITBAR(N) asm volatile("s_waitcnt vmcnt(" #N ") lgkmcnt(0)\n\ts_barrier" ::: "memory")
#define ATT_FILL(V, x) do { _Pragma("unroll") for (int _r = 0; _r < 16; ++_r) V[_r] = (x); } while (0)

__device__ __forceinline__ unsigned rangemask(int k, int a, int b) {
    const int lo = max(a - 32 * k, 0), hi = min(b - 32 * k, 31);
    return (lo > hi) ? 0u : ((0xFFFFFFFFu >> (31 - hi)) & (0xFFFFFFFFu << lo));
}
__device__ __forceinline__ int wave_max_i32(int x) {
    x = max(x, dpp_i<0xB1>(x)); x = max(x, dpp_i<0x4E>(x)); x = max(x, dpp_i<0x141>(x)); x = max(x, dpp_i<0x140>(x));
    return max(max(__builtin_amdgcn_readlane(x, 0), __builtin_amdgcn_readlane(x, 16)), max(__builtin_amdgcn_readlane(x, 32), __builtin_amdgcn_readlane(x, 48)));
}

__device__ __forceinline__ void lds_add_f32(LAS float* p, float v) { (void)__hip_atomic_fetch_add(p, v, __ATOMIC_RELAXED, __HIP_MEMORY_SCOPE_WORKGROUP); }

__device__ __forceinline__ void attn_item(const Frame& F, int qt, int g) {
    const int lane = lane_id(), wid = F.wave, tid = wid * 64 + lane, r32 = lane & 31, hi = lane >> 5;
    const int ql = r32 >> 2, h = r32 & 3, cur = qt, t = 64 * qt + 8 * wid + ql, head = 4 * g + h;
    LAS unsigned char* shm = F.lds;
    const unsigned lds0 = (unsigned)(uintptr_t)shm;
    LAS float* wsf = (LAS float*)(shm + L_WSF) + wid * 64;
    LAS float* SC = (LAS float*)(shm + L_SC);
    LAS float* OACC = (LAS float*)(shm + L_SC);
    LAS float* lutl = (LAS float*)(shm + L_LUT);
    const LAS float* luth = lutl + h;
    LAS unsigned* BM = (LAS unsigned*)(shm + L_BM);
    LAS float* REF = (LAS float*)(shm + L_REF);
    LAS float* LACC = (LAS float*)(shm + L_LACC);
    lutl[4 * (tid & 127) + (tid >> 7)] = F.LUT()[(4 * g + (tid >> 7)) * 128 + (tid & 127)];
    BM[tid] = 0u;
    LAS u32x2* QL8 = (LAS u32x2*)(shm + L_OUT);
#pragma unroll
    for (int i = 0; i < 4; ++i) { const int slot = tid + 512 * i, q = slot >> 5, ks_ = (slot >> 4) & 1, gq_ = (slot >> 2) & 3, h_ = slot & 3;
        const u32x4 w = *(const u32x4*)(F.Q2() + (size_t)(64 * qt + q) * 512 + g * 256 + (2 * ks_ + (gq_ >> 1)) * 64 + h_ * 16 + 8 * (gq_ & 1));
        int w0 = __builtin_amdgcn_cvt_pk_fp8_f32(8.f * bflo(w.x), 8.f * bfhi(w.x), 0, false); w0 = __builtin_amdgcn_cvt_pk_fp8_f32(8.f * bflo(w.y), 8.f * bfhi(w.y), w0, true);
        int w1 = __builtin_amdgcn_cvt_pk_fp8_f32(8.f * bflo(w.z), 8.f * bfhi(w.z), 0, false); w1 = __builtin_amdgcn_cvt_pk_fp8_f32(8.f * bflo(w.w), 8.f * bfhi(w.w), w1, true);
        QL8[slot] = (u32x2){(unsigned)w0, (unsigned)w1}; }
    bf16x8 qr[4];
    { const bf16* qp = F.Q2() + (size_t)t * 512 + g * 256 + h * 16 + hi * 8;
#pragma unroll
        for (int d0 = 0; d0 < 4; ++d0) qr[d0] = *(const bf16x8*)(qp + d0 * 64); }
    const float b31 = F.LUT()[head * 128 + 127];
    const float gate_c = fsigmoid(bf2f(F.BR()[(size_t)t * 256 + head])), gate_s = fsigmoid(bf2f(F.BR()[(size_t)t * 256 + 8 + head])), gate_w = fsigmoid(bf2f(F.BR()[(size_t)t * 256 + 16 + head]));
    f32x16 o[2], p0, p1;
    const unsigned kdst = lds0 + L_K + wid * 1024, vdst = lds0 + L_V + wid * 1024;
    const int vrow = 16 * (wid & 3) + (lane >> 2), vcol = (wid >> 2) * 32 + (lane & 3) * 8;
    const int vb0 = (int)(lds0 + L_V) + ((lane >> 4) & 1) * 32 + (lane & 3) * 8 + (4 * hi + ((lane & 15) >> 2)) * 64;
#define DMA_K(base, pitch, row0, slot) glds16((base) + (size_t)((row0) + lane) * (pitch) + wid * 8, (unsigned)__builtin_amdgcn_readfirstlane(kdst + (slot)))
#define DMA_V(base, pitch, row0, slot) glds16((base) + (size_t)((row0) + vrow) * (pitch) + vcol, (unsigned)__builtin_amdgcn_readfirstlane(vdst + (slot)))
#define ROT() do { sl_cur = sl_next; sl_next = (sl_next == (NSLOT - 1) * SLOTB) ? 0 : sl_next + SLOTB; } while (0)
    VM_WAIT(); LDS_WAIT(); __syncthreads();

    const bf16* KCg = F.KC() + (size_t)g * 1024 * 64; const bf16* VCg = F.VC() + (size_t)g * 1024 * 64;
    const int nkt = (qt >> 4) + 1;
    const int tminw = 64 * qt + 8 * wid;
    float m = -1e30f, l = 0.f;
    {
        int sl_cur = 0, sl_next = SLOTB;
        DMA_K(KCg, 64, 0, 0);
        for (int kt = 0; kt < nkt; ++kt) {
            if (kt + 1 < nkt) { DMA_K(KCg, 64, 64 * (kt + 1), sl_next); ATT_WAITBAR(1); } else { ATT_WAITBAR(0); }
            const bool far = (tminw - 31 - 16 * (64 * kt + 63)) >= 128;
            qkt(p0, p1, shm + L_K + sl_cur, qr, r32, hi);
            if (!far) near_apply<16, 0x80000000u>(p0, p1, t - 31 - 16 * (64 * kt + 4 * hi), luth);
            sm_update<false>(p0, p1, far ? b31 : 0.f, m, l, o, wsf, r32, hi);
            ROT();
        }
        LDS_WAIT(); __builtin_amdgcn_s_barrier();
    }
    {
        const float lt = halfsum(l); const float rl = lt > 0.f ? 1.0f / lt : 0.f;
        ATT_FILL(o[0], 0.f); ATT_FILL(o[1], 0.f);
        float carry = 0.f;
        int sl_cur = 0, sl_next = SLOTB;
        DMA_K(KCg, 64, 0, 0); DMA_V(VCg, 64, 0, 0);
        for (int kt = 0; kt < nkt; ++kt) {
            if (kt + 1 < nkt) { DMA_K(KCg, 64, 64 * (kt + 1), sl_next); DMA_V(VCg, 64, 64 * (kt + 1), sl_next); ATT_WAITBAR(2); } else { ATT_WAITBAR(0); }
            const bool far = (tminw - 31 - 16 * (64 * kt + 63)) >= 128;
            qkt(p0, p1, shm + L_K + sl_cur, qr, r32, hi);
            if (!far) near_apply<16, 0x80000000u>(p0, p1, t - 31 - 16 * (64 * kt + 4 * hi), luth);
            const float mb2 = far ? m - b31 : m;
#pragma unroll
            for (int r = 0; r < 16; ++r) { p0[r] = __builtin_amdgcn_exp2f(p0[r] - mb2) * rl; p1[r] = __builtin_amdgcn_exp2f(p1[r] - mb2) * rl; }
            {
                float q4[8], e[8];
#pragma unroll
                for (int i = 0; i < 4; ++i) { q4[i] = (p0[4 * i] + p0[4 * i + 1]) + (p0[4 * i + 2] + p0[4 * i + 3]); e[i] = p0[4 * i + 3];
                                              q4[4 + i] = (p1[4 * i] + p1[4 * i + 1]) + (p1[4 * i + 2] + p1[4 * i + 3]); e[4 + i] = p1[4 * i + 3]; }
                float newcarry = 0.f;
#pragma unroll
                for (int i = 0; i < 8; ++i) { auto rr = __builtin_amdgcn_permlane32_swap(__float_as_uint(e[i]), __float_as_uint(e[i]), false, false);
                    const float elo = __uint_as_float(rr[0]), ehi = __uint_as_float(rr[1]);
                    if (hi) q4[i] += elo; else if (i < 7) q4[i + 1] += ehi;
                    if (i == 7) newcarry = ehi; }
                if (!hi) q4[0] += carry;
                carry = newcarry;
#pragma unroll
                for (int i = 0; i < 8; ++i) { float v = q4[i]; v += dpp_f<0xB1>(v); v += dpp_f<0x4E>(v); q4[i] = v; }
                if (h == 0) {
#pragma unroll
                    for (int i = 0; i < 8; ++i) SC[(8 * wid + ql) * 256 + 16 * kt + 2 * i + hi] = q4[i]; }
            }
            { ATT_PACK(p0, p1); pv(o, vb0 + sl_cur, pa0, pa1, pa2, pa3); }
            ROT();
        }
        LDS_WAIT(); __builtin_amdgcn_s_barrier();
    }

    if (cur >= 16) {
        const int u4 = lane >> 4, li16 = lane & 15;
#pragma unroll 1
        for (int qb = 0; qb < 8; qb += 4) {
            const int qloc = 8 * wid + qb + u4;
            const LAS float* row = SC + qloc * 256 + li16;
            int v[16];
#pragma unroll
            for (int k = 0; k < 16; ++k) { const int J = li16 + 16 * k; const int x = (__float_as_int(row[16 * k]) & ~255) | (255 - J); v[k] = (J >= 1 && J <= cur - 2) ? x : -1; }
            LAS unsigned* bmq = BM + (qloc >> 5); const unsigned qbit = 1u << (qloc & 31);
#pragma unroll 1
            for (int round = 0; round < 13; ++round) {
                int lm = max(max(max(v[0], v[1]), max(v[2], v[3])), max(max(v[4], v[5]), max(v[6], v[7])));
                lm = max(lm, max(max(max(v[8], v[9]), max(v[10], v[11])), max(max(v[12], v[13]), max(v[14], v[15]))));
                int rm = lm; rm = max(rm, dpp_i<0xB1>(rm)); rm = max(rm, dpp_i<0x4E>(rm)); rm = max(rm, dpp_i<0x141>(rm)); rm = max(rm, dpp_i<0x140>(rm));
                if (lm == rm) {
#pragma unroll
                    for (int k = 0; k < 16; ++k) v[k] = (v[k] == rm) ? -1 : v[k];
                    __hip_atomic_fetch_or(bmq + 2 * (255 - (rm & 255)), qbit, __ATOMIC_RELAXED, __HIP_MEMORY_SCOPE_WORKGROUP);
                }
            }
        }
    }
    LDS_WAIT();
    LAS float* ostg = (LAS float*)(shm + L_SC) + wid * 2048;
    {
        if (hi == 0) wsf[r32] = gate_c; LDS_WAIT();
#pragma unroll
        for (int r = 0; r < 16; ++r) { const float f = wsf[crow(r, hi)]; const int orow = crow(r, hi); ostg[orow * 64 + r32] = o[0][r] * f; ostg[orow * 64 + 32 + r32] = o[1][r] * f; }
    }

    const bf16* Kw = F.KV() + 512 + g * 64; const bf16* Vw = F.KV() + 640 + g * 64;
    {
        m = -1e30f; l = 0.f; ATT_FILL(o[0], 0.f); ATT_FILL(o[1], 0.f);
        const int J0 = max(cur - 8, 0);
        int sl_cur = 0, sl_next = SLOTB;
        DMA_K(Kw, 768, 64 * J0, 0); DMA_V(Vw, 768, 64 * J0, 0);
        for (int J = J0; J <= cur; ++J) {
            if (J + 1 <= cur) { DMA_K(Kw, 768, 64 * (J + 1), sl_next); DMA_V(Vw, 768, 64 * (J + 1), sl_next); ATT_WAITBAR(2); } else { ATT_WAITBAR(0); }
            const bool nearw = (J >= cur - 2 || J == cur - 8);
            qkt(p0, p1, shm + L_K + sl_cur, qr, r32, hi);
            if (nearw) near_apply<1, 512u>(p0, p1, t - 64 * J - 4 * hi, luth);
            sm_update<true>(p0, p1, nearw ? 0.f : b31, m, l, o, wsf, r32, hi);
            { ATT_PACK(p0, p1); pv(o, vb0 + sl_cur, pa0, pa1, pa2, pa3); }
            ROT();
        }
        LDS_WAIT(); __builtin_amdgcn_s_barrier();
        const float lt = halfsum(l); const float fw = lt > 0.f ? gate_w / lt : 0.f;
        if (hi == 0) wsf[r32] = fw; LDS_WAIT();
#pragma unroll
        for (int r = 0; r < 16; ++r) { const float f = wsf[crow(r, hi)]; const int orow = crow(r, hi); ostg[orow * 64 + r32] += o[0][r] * f; ostg[orow * 64 + 32 + r32] += o[1][r] * f; }
        LDS_WAIT();
#pragma unroll
        for (int i = 0; i < 4; ++i) { const int rowl = i * 8 + (lane >> 3), chn = lane & 7;
            const f32x4 a0 = *(const LAS f32x4*)(ostg + rowl * 64 + chn * 8), a1 = *(const LAS f32x4*)(ostg + rowl * 64 + chn * 8 + 4);
            const size_t tt = (size_t)(64 * qt + 8 * wid + (rowl >> 2)); const int col = (4 * g + (rowl & 3)) * 64 + chn * 8;
            *(u32x4*)(F.XN() + tt * 1024 + col) = (u32x4){cvtpk(a0[0], a0[1]), cvtpk(a0[2], a0[3]), cvtpk(a1[0], a1[1]), cvtpk(a1[2], a1[3])}; }
        LDS_WAIT();
    }

    const bf16* Ks = F.KV() + 256 + g * 64; const bf16* Vs = F.KV() + 384 + g * 64;
    {
        m = -1e30f; l = 0.f; ATT_FILL(o[0], 0.f); ATT_FILL(o[1], 0.f);
        const int nA = (cur < 16) ? cur + 1 : 3;
#define JA(i) ((cur < 16) ? (i) : ((i) == 0 ? 0 : cur - 2 + (i)))
        int sl_cur = 0, sl_next = SLOTB;
        DMA_K(Ks, 768, 0, 0); DMA_V(Vs, 768, 0, 0);
        for (int i = 0; i < nA; ++i) {
            const int J = JA(i);
            if (i + 1 < nA) { const int Jn = JA(i + 1); DMA_K(Ks, 768, 64 * Jn, sl_next); DMA_V(Vs, 768, 64 * Jn, sl_next); ATT_WAITBAR(2); } else { ATT_WAITBAR(0); }
            const bool neara = (J >= cur - 2);
            qkt(p0, p1, shm + L_K + sl_cur, qr, r32, hi);
            if (neara) near_apply<1, 0x80000000u>(p0, p1, t - 64 * J - 4 * hi, luth);
            sm_update<true>(p0, p1, neara ? 0.f : b31, m, l, o, wsf, r32, hi);
            { ATT_PACK(p0, p1); pv(o, vb0 + sl_cur, pa0, pa1, pa2, pa3); }
            ROT();
        }
#undef JA
        LDS_WAIT(); __builtin_amdgcn_s_barrier();
        const float lt = halfsum(l);
        if (hi == 0) { REF[32 * wid + r32] = m; LACC[32 * wid + r32] = lt; }
#pragma unroll
        for (int r = 0; r < 16; ++r) { const int orow = 32 * wid + crow(r, hi); OACC[orow * 64 + r32] = o[0][r]; OACC[orow * 64 + 32 + r32] = o[1][r]; }
        LDS_WAIT(); __builtin_amdgcn_s_barrier();
    }

    if (cur >= 16) {
        const int c16 = lane & 15, gq = lane >> 4, qi4 = c16 >> 2;
        float oa[2][16], la2[2];
        { const int li_ = lane & 15, hsel_ = li_ >> 2, dq_ = (li_ & 3) * 16;
#pragma unroll
            for (int p = 0; p < 2; ++p) { la2[p] = 0.f; const LAS f32x4* ap = (const LAS f32x4*)(OACC + (4 * (8 * wid + 4 * p + gq) + hsel_) * 64 + dq_);
#pragma unroll
                for (int k = 0; k < 4; ++k) { const f32x4 a = ap[k]; oa[p][4 * k] = a[0]; oa[p][4 * k + 1] = a[1]; oa[p][4 * k + 2] = a[2]; oa[p][4 * k + 3] = a[3]; } } }
        LDS_WAIT(); __builtin_amdgcn_s_barrier();
        if (tid < 128) ((LAS unsigned*)(shm + L_HDR))[tid] = 0u;
        typedef long i64_t;
        const i64_t* KTg = (const i64_t*)F.KT() + (size_t)g * 256 * 512 + gq * 16 + c16; const bf16* VTg = F.VT() + (size_t)g * 256 * 4096 + c16 * 32 + 8 * gq;
        const LAS i64_t* QLg = (const LAS i64_t*)QL8 + gq * 4 + h;
        LAS unsigned* TL = (LAS unsigned*)(shm + L_TL) + wid * 160;
        int tot_ = 0;
#pragma unroll
        for (int i4 = 0; i4 < 4; ++i4) { const int Jl = lane + 64 * i4; if (Jl >= 1 && Jl <= cur - 2) tot_ += (__popc(BM[2 * Jl]) + __popc(BM[2 * Jl + 1]) + 3) >> 2; }
        const int T_ = __builtin_amdgcn_readfirstlane((int)(wave_sum((float)tot_) + 0.5f));
        const int nround = (T_ + 7) >> 3; const int tlo = wid * nround; const int ntask = max(0, min(T_ - tlo, nround));
        int run_ = 0;
#pragma unroll 1
        for (int i4 = 0; i4 < 4; ++i4) {
            const int Jl = lane + 64 * i4; int nch = 0;
            unsigned long long mk = 0ull;
            if (Jl >= 1 && Jl <= cur - 2) { mk = ((unsigned long long)BM[2 * Jl + 1] << 32) | BM[2 * Jl]; nch = (__popcll(mk) + 3) >> 2; }
            int incl = nch;
#pragma unroll
            for (int o = 1; o < 64; o <<= 1) { const int up = __shfl_up(incl, o); if (lane >= o) incl += up; }
            const int base = run_ + incl - nch - tlo;
            for (int c = 0; c < nch; ++c) { unsigned e = (unsigned)Jl; int q0 = 0;
#pragma unroll
                for (int k = 0; k < 4; ++k) { int q = q0; if (mk) { q = __builtin_ctzll(mk); mk &= mk - 1; } if (k == 0) q0 = q; e |= (unsigned)q << (8 + 6 * k); }
                if ((unsigned)(base + c) < (unsigned)ntask) TL[base + c] = e; }
            run_ += __builtin_amdgcn_readlane(incl, 63);
        }
        LAS float* EX = (LAS float*)(shm + L_EX); LAS unsigned* QM = (LAS unsigned*)(shm + L_HDR); LAS float* LEX = (LAS float*)(shm + L_LEX);
        LDS_WAIT(); __builtin_amdgcn_s_barrier();
        i64_t kfC[8], kfN[8]; bf16x8 vfC[8]; bool kpend = false;
#define LOADK(J_, KF) do { const i64_t* kp_ = KTg + (size_t)(J_) * 512; \
            _Pragma("unroll") for (int kt = 0; kt < 4; ++kt) { KF[2 * kt] = kp_[kt * 64]; KF[2 * kt + 1] = kp_[256 + kt * 64]; } } while (0)
#define LOADV(J_, VF) do { const bf16* vp_ = VTg + (size_t)(J_) * 4096; _Pragma("unroll") for (int x = 0; x < 8; ++x) VF[x] = *(const bf16x8*)(vp_ + x * 512); } while (0)
        unsigned e_cur = 0xffu;
        i64_t qg0 = 0, qg1 = 0; float ref = 0.f;
#define QFETCH(E) do { const int mq_ = ((E) >> (8 + 6 * qi4)) & 63; const LAS i64_t* qp_ = QLg + mq_ * 32; qg0 = qp_[0]; qg1 = qp_[16]; ref = REF[4 * mq_ + h]; } while (0)
        if (ntask > 0) { e_cur = (unsigned)__builtin_amdgcn_readfirstlane((int)TL[0]); LOADK(e_cur & 255u, kfC); LOADV(e_cur & 255u, vfC); QFETCH(e_cur); }
        unsigned tl1 = (ntask > 1) ? TL[1] : 0xffu;
#define OWNER_PASS(M0, M1, B) do { const int li_ = lane & 15, hsel_ = li_ >> 2, dq_ = (li_ & 3) * 16; \
            _Pragma("unroll") for (int pass = 0; pass < 2; ++pass) { \
                unsigned mm = pass ? (M1) : (M0); \
                while (mm) { const int e = __builtin_ctz(mm); mm &= mm - 1; \
                    const LAS f32x4* xr = (const LAS f32x4*)(EX + (B) * 8704 + (e * 4 + hsel_) * 68 + dq_); \
                    const f32x4 y0 = xr[0], y1 = xr[1], y2 = xr[2], y3 = xr[3]; \
                    oa[pass][0] += y0[0]; oa[pass][1] += y0[1]; oa[pass][2] += y0[2]; oa[pass][3] += y0[3]; oa[pass][4] += y1[0]; oa[pass][5] += y1[1]; oa[pass][6] += y1[2]; oa[pass][7] += y1[3]; \
                    oa[pass][8] += y2[0]; oa[pass][9] += y2[1]; oa[pass][10] += y2[2]; oa[pass][11] += y2[3]; oa[pass][12] += y3[0]; oa[pass][13] += y3[1]; oa[pass][14] += y3[2]; oa[pass][15] += y3[3]; \
                    la2[pass] += LEX[(B) * 128 + e * 4 + hsel_]; } } } while (0)
#pragma unroll 1
        for (int n = 0; n < nround; ++n) {
            const int buf = n & 1;
            unsigned qm0 = 0u, qm1 = 0u;
            if (n > 0) { qm0 = QM[(buf ^ 1) * 64 + 8 * wid + gq]; qm1 = QM[(buf ^ 1) * 64 + 8 * wid + 4 + gq]; }
            if (n < ntask) {
                const unsigned e_nxt = (n + 1 < ntask) ? (unsigned)__builtin_amdgcn_readfirstlane((int)tl1) : 0xffu;
                tl1 = (n + 2 < ntask) ? TL[n + 2] : 0xffu;
                const unsigned e_ = e_cur; const int Jb = e_ & 255, Jn = e_nxt & 255; const bool reload = (Jn != Jb) && (Jn != 255);
                const int q0_ = (e_ >> 8) & 63;
                const int myq = (e_ >> (8 + 6 * qi4)) & 63; const bool valid = (qi4 == 0) || (myq != q0_); const int tq = 64 * qt + myq;
                const bool nearJ = (Jb >= cur - 2);
                const float cinit = nearJ ? 0.f : (valid ? b31 - ref : -INFINITY);
                if (kpend) {
#pragma unroll
                    for (int x = 0; x < 8; ++x) kfC[x] = kfN[x];
                    kpend = false; }
                if (reload) { LOADK(Jn, kfN); kpend = true; }
                f32x4 s[4];
#pragma unroll
                for (int kt = 0; kt < 4; ++kt) { s[kt] = (f32x4){0.f, 0.f, 0.f, 0.f};
                    s[kt] = __builtin_amdgcn_mfma_f32_16x16x32_fp8_fp8(kfC[2 * kt], qg0, s[kt], 0, 0, 0); s[kt] = __builtin_amdgcn_mfma_f32_16x16x32_fp8_fp8(kfC[2 * kt + 1], qg1, s[kt], 0, 0, 0); }
                const float refc = ref;
                if (n + 1 < ntask) QFETCH(e_nxt);
                if (nearJ) { const float sub = valid ? refc : INFINITY;
                    float bb[16];
#pragma unroll
                    for (int kt = 0; kt < 4; ++kt)
#pragma unroll
                        for (int r = 0; r < 4; ++r) { const int dd = tq - 64 * Jb - (16 * kt + 4 * gq + r); bb[kt * 4 + r] = luth[4 * min(max(dd, 0), 127)]; }
#pragma unroll
                    for (int x = 0; x < 16; ++x) asm volatile("" : "+v"(bb[x]));
#pragma unroll
                    for (int kt = 0; kt < 4; ++kt)
#pragma unroll
                        for (int r = 0; r < 4; ++r) { const int dd = tq - 64 * Jb - (16 * kt + 4 * gq + r); const float tt = s[kt][r] * 0.125f + bb[kt * 4 + r] - sub;
                            s[kt][r] = (dd >= 0) ? tt * 8.0f : -INFINITY; } }
#pragma unroll
                for (int kt = 0; kt < 4; ++kt)
#pragma unroll
                    for (int r = 0; r < 4; ++r) { const int tb = min(__float_as_int(s[kt][r] * 0.125f + cinit), __float_as_int(CLAMP));
                        s[kt][r] = __builtin_amdgcn_exp2f(__int_as_float(tb)); }
                float ls = (((s[0][0] + s[0][1]) + (s[0][2] + s[0][3])) + ((s[1][0] + s[1][1]) + (s[1][2] + s[1][3]))) + (((s[2][0] + s[2][1]) + (s[2][2] + s[2][3])) + ((s[3][0] + s[3][1]) + (s[3][2] + s[3][3])));
                { auto r16 = __builtin_amdgcn_permlane16_swap(__float_as_uint(ls), __float_as_uint(ls), false, false); ls = __uint_as_float(r16[0]) + __uint_as_float(r16[1]); }
                ls = halfsum(ls);
                bf16x8 pb[2];
#pragma unroll
                for (int ks = 0; ks < 2; ++ks) pb[ks] = __builtin_bit_cast(bf16x8, (u32x4){cvtpk(s[2 * ks][0], s[2 * ks][1]), cvtpk(s[2 * ks][2], s[2 * ks][3]), cvtpk(s[2 * ks + 1][0], s[2 * ks + 1][1]), cvtpk(s[2 * ks + 1][2], s[2 * ks + 1][3])});
                LAS float* ex = EX + buf * 8704 + ((wid * 4 + qi4) * 4 + h) * 68 + 4 * gq;
                f32x4 ot[4];
#pragma unroll
                for (int mt = 0; mt < 4; ++mt) { ot[mt] = (f32x4){0.f, 0.f, 0.f, 0.f};
                    ot[mt] = __builtin_amdgcn_mfma_f32_16x16x32_bf16(vfC[2 * mt], pb[0], ot[mt], 0, 0, 0); ot[mt] = __builtin_amdgcn_mfma_f32_16x16x32_bf16(vfC[2 * mt + 1], pb[1], ot[mt], 0, 0, 0); }
                if (reload) LOADV(Jn, vfC);
#pragma unroll
                for (int mt = 0; mt < 4; ++mt) *(LAS f32x4*)(ex + 16 * mt) = ot[mt];
                if (gq == 0) { LEX[buf * 128 + wid * 16 + c16] = ls; if (h == 0 && valid) __hip_atomic_fetch_or(QM + buf * 64 + myq, 1u << (wid * 4 + qi4), __ATOMIC_RELAXED, __HIP_MEMORY_SCOPE_WORKGROUP); }
                e_cur = e_nxt;
            }
            OWNER_PASS(qm0, qm1, buf ^ 1);
            if (n > 0 && (lane & 15) == 0) { QM[(buf ^ 1) * 64 + 8 * wid + gq] = 0u; QM[(buf ^ 1) * 64 + 8 * wid + 4 + gq] = 0u; }
            LDS_WAIT(); __builtin_amdgcn_s_barrier();
        }
        if (nround > 0) { const int lb = (nround - 1) & 1; const unsigned l0 = QM[lb * 64 + 8 * wid + gq], l1 = QM[lb * 64 + 8 * wid + 4 + gq]; OWNER_PASS(l0, l1, lb); }
#undef OWNER_PASS
        LDS_WAIT(); __builtin_amdgcn_s_barrier();
        {
            const int li = lane & 15, hsel = li >> 2, dq = (li & 3) * 16;
#pragma unroll
            for (int pass = 0; pass < 2; ++pass) { const int q = 8 * wid + 4 * pass + gq; LAS f32x4* ap = (LAS f32x4*)(OACC + (4 * q + hsel) * 64 + dq);
#pragma unroll
                for (int k = 0; k < 4; ++k) ap[k] = (f32x4){oa[pass][4 * k], oa[pass][4 * k + 1], oa[pass][4 * k + 2], oa[pass][4 * k + 3]};
                if ((li & 3) == 0) LACC[4 * q + hsel] += la2[pass]; }
        }
#undef LOADK
#undef LOADV
#undef QFETCH
    }
    LDS_WAIT(); __builtin_amdgcn_s_barrier();

    {
        if (hi == 0) { const float lt = LACC[32 * wid + r32]; wsf[r32] = lt > 0.f ? gate_s / lt : 0.f; }
        LDS_WAIT();
#pragma unroll
        for (int i = 0; i < 4; ++i) { const int rowl = i * 8 + (lane >> 3), chn = lane & 7, row = 32 * wid + rowl;
            const float f = wsf[rowl];
            const f32x4 a0 = *(const LAS f32x4*)(OACC + row * 64 + chn * 8), a1 = *(const LAS f32x4*)(OACC + row * 64 + chn * 8 + 4);
            const size_t tt = (size_t)(64 * qt + 8 * wid + (rowl >> 2)); const int col = (4 * g + (rowl & 3)) * 64 + chn * 8;
            const u32x4 ov = *(const u32x4*)(F.XN() + tt * 1024 + col);
            const u32x4 gn = *(const u32x4*)(F.GN() + tt * 512 + col);
            u32x4 w; w.x = pk2((bflo(ov.x) + a0[0] * f) * bflo(gn.x), (bfhi(ov.x) + a0[1] * f) * bfhi(gn.x)); w.y = pk2((bflo(ov.y) + a0[2] * f) * bflo(gn.y), (bfhi(ov.y) + a0[3] * f) * bfhi(gn.y));
            w.z = pk2((bflo(ov.z) + a1[0] * f) * bflo(gn.z), (bfhi(ov.z) + a1[1] * f) * bfhi(gn.z)); w.w = pk2((bflo(ov.w) + a1[2] * f) * bflo(gn.w), (bfhi(ov.w) + a1[3] * f) * bfhi(gn.w));
            *(u32x4*)(F.XN() + tt * 1024 + col) = w; }
        VM_WAIT(); LDS_WAIT(); __syncthreads();
    }
#undef DMA_K
#undef DMA_V
#undef ROT
}
}

__global__ void __launch_bounds__(NWAVES * 64, 2) nsa_lru_fwd(Args args) {
    extern __shared__ __attribute__((aligned(16))) unsigned char lds[];
    Frame F;
    F.lds = (LAS unsigned char*)lds;
    F.MISC = (volatile LAS unsigned*)(F.lds + MISC_OFF);
    F.wave = __builtin_amdgcn_readfirstlane((int)(threadIdx.x >> 6));
    F.G = gridDim.x; { const int bx = blockIdx.x; F.vcu = (F.G % 8 == 0) ? (bx % 8) * (F.G / 8) + bx / 8 : bx; }
    F.ws = args.ws;
    gu32* ctl = (gu32*)(args.ws + WS_CTL);
    for (int u = F.wave * 64 + lane_id(); u < (LDS_BYTES - LDSCTL_OFF) / 4; u += NWAVES * 64) ((LAS unsigned*)(F.lds + LDSCTL_OFF))[u] = 0u;
    __syncthreads();
    const int bli = (N_LAUNCHES == PER_PHASE) ? 0 : args.li;
    XcdBarrier bar; bar.bar = (unsigned*)(ctl + CW_BAR) + bli * XCD_BAR_WORDS; bar.x = 0; bar.st = nullptr;
    if (N_LAUNCHES != PER_PHASE) bar = xcd_barrier_post((unsigned*)(ctl + CW_BAR) + bli * XCD_BAR_WORDS, F.MISC + 8);
    if (threadIdx.x == 0) __hip_atomic_store((unsigned*)(ctl + CW_XCC) + F.vcu, xb_xcc_id() + 1u, RLX_AGENT);
#define GRID_BAR() do { if (N_LAUNCHES != PER_PHASE) xcd_barrier(bar); } while (0)
    const int lo = args.ph_lo, hi = args.ph_hi;
    bool df = false;
#define IN(k) (lo <= (k) && (k) < hi)
#define BOTH(k) (IN(k) && IN((k) + 1))

    unsigned long long pt0 = 0ull;
#define PH_T0(k) do { if (PROBE_IDLE == (k)) pt0 = wall_clock64(); } while (0)
#define PH_T1(k) do { if (PROBE_IDLE == (k)) { __syncthreads(); if (threadIdx.x == 0) __hip_atomic_store((unsigned*)(ctl + 12288) + F.vcu, (unsigned)(wall_clock64() - pt0), __ATOMIC_RELAXED, __HIP_MEMORY_SCOPE_AGENT); } } while (0)
    if (IN(0)) { PH_T0(0); p0_prologue(F, args); PH_T1(0); if (BOTH(0)) GRID_BAR(); }

    if (IN(1)) {
        PH_T0(1);
        pg8::Gemm g{F.XN(), F.WinT(), F.XN(), F.WinT(), 1024, 1024, 1024}; pg8::StaticOrder S; S.init(SEQ, NPROJ, F.G, (int)blockIdx.x);
        pg8::EpiProj E{F.Q(), F.KV(), F.U(), F.BR(), F.GN(), F.GL(), F.MG()};
        pg8::gemm_phase<pg8::EpiProj, pg8::StaticOrder, true>(F.lds, g, S, E, F.wave);
        PH_T1(1);
        if (BOTH(1)) GRID_BAR();
    }

    if (IN(2)) {
        PH_T0(2);
        for (int i = F.vcu; i < 256; i += F.G) {
            lru_tile<false>(F, args, i);
            if (!args.pad) qk_norm_tile(F, args, i);
            vt_tile(F, i);
            __syncthreads();
            compress_item(F, args, i & 1, (i >> 1) & 1, i >> 2);
        }
        PH_T1(2);
        if (BOTH(2)) GRID_BAR();
    }

    if (IN(3)) {
        PH_T0(3);
        if (N_LAUNCHES != PER_PHASE && PROBE_DUP < 0) {
            bool ok = (F.G == 256);
            if (ok) {
#pragma unroll
                for (int q = 0; q < 4; ++q) { const int v = 4 * lane_id() + q; const unsigned a = xb_ld((unsigned*)(ctl + CW_XCC) + v), b = xb_ld((unsigned*)(ctl + CW_XCC) + (v & ~31)); ok = ok && (a == b) && (a != 0u); }
            }
            df = (__builtin_amdgcn_ballot_w64(ok) == ~0ull);
        }
        unsigned* flagA = (unsigned*)(ctl + CW_FLAGA);
#pragma unroll 1
        for (int it = F.vcu; it < 256; it += F.G) {
            const int k = it >> 5, sel = (it >> 4) & 1, qlo = 16 * k + (it & 15), qhi = 255 - qlo;
            { const int tt = sel ? qhi : qlo; lru_apply(F, tt); flag_signal(flagA + (tt >> 2)); }
#pragma unroll 1
            for (int j = 0; j < 2; ++j) { const int qt = j ? qlo : qhi; att::attn_item(F, qt, (j ^ sel) ? 0 : 1); flag_signal(flagA + (qt >> 2)); }
        }
        PH_T1(3);
        if (BOTH(3) && !df) GRID_BAR();
    }

    if (IN(4)) {
        PH_T0(4);
        pg8::Gemm g{F.XN(), F.WaT(), F.XN() + 512, F.WbT(), 1024, 512, 512}; pg8::XDualOrder S; S.init(F.G, (int)blockIdx.x);
        pg8::EpiMerge E{F.MB(), F.MG()};
        unsigned* flagA = (unsigned*)(ctl + CW_FLAGA); unsigned* flagB = (unsigned*)(ctl + CW_FLAGB);
        if (df) { pg8::Unit u; for (int i = 0; S.tile((long)i * F.G + (int)blockIdx.x, u); ++i) flag_wait(flagA + u.pm, 12u); }
        pg8::gemm_phase<pg8::EpiMerge, pg8::XDualOrder, true>(F.lds, g, S, E, F.wave);
        { pg8::Unit u; for (int i = 0; S.tile((long)i * F.G + (int)blockIdx.x, u); ++i) flag_signal(flagB + u.pm); }
        PH_T1(4);
        if (BOTH(4) && !df) GRID_BAR();
    }

    if (IN(5)) {
        PH_T0(5);
        pg8::Gemm g{F.MB(), F.WoutT(), F.MB(), F.WoutT(), 1024, 1024, 1024}; pg8::XOrder S; S.init(F.G, (int)blockIdx.x);
        pg8::EpiOut E{args.in[0], args.out};
        auto gate = [&]() { if (df) { unsigned* flagB = (unsigned*)(ctl + CW_FLAGB); pg8::Unit u; for (int i = 0; S.tile((long)i * F.G + (int)blockIdx.x, u); ++i) flag_wait(flagB + u.pm, 4u); } };
        pg8::gemm_phase<pg8::EpiOut, pg8::XOrder, true>(F.lds, g, S, E, F.wave, gate);
        PH_T1(5);
    }
    if (PROBE_IDLE >= 0) {
        GRID_BAR();
        if (blockIdx.x == 0 && threadIdx.x == 0) {
            unsigned mx = 0u; unsigned long long sum = 0ull;
            for (int i = 0; i < F.G; ++i) { const unsigned v = __hip_atomic_load((unsigned*)(ctl + 12288) + i, __ATOMIC_RELAXED, __HIP_MEMORY_SCOPE_AGENT); mx = max(mx, v); sum += v; }
            const unsigned long long spin = 64ull * ((unsigned long long)mx - sum / (unsigned)F.G);
            const unsigned long long s0 = wall_clock64();
            while (wall_clock64() - s0 < spin) __builtin_amdgcn_s_sleep(8);
        }
    }
#undef IN
#undef BOTH
}

extern "C" void kernel_launch(void* const* d_in, const int* in_sizes, int n_in, void* d_out, int out_size, void* d_ws, size_t ws_size, hipStream_t stream) {
    static int grid = 0;
    if (grid == 0) {
        if (n_in != 20 || in_sizes[0] != SEQ * DM || out_size != SEQ * DM || ws_size < WS_END) { fprintf(stderr, "kernel_launch: unexpected shapes (n_in %d, in0 %d, out %d, ws %zu)\n", n_in, n_in > 0 ? in_sizes[0] : -1, out_size, ws_size); grid = -1; return; }
        int dev = 0, cus = 0, per_cu = 0;
        if (hipGetDevice(&dev) != hipSuccess || hipDeviceGetAttribute(&cus, hipDeviceAttributeMultiprocessorCount, dev) != hipSuccess) { grid = -1; return; }
        if (hipFuncSetAttribute((const void*)nsa_lru_fwd, hipFuncAttributeMaxDynamicSharedMemorySize, LDS_BYTES) != hipSuccess) { fprintf(stderr, "kernel_launch: hipFuncSetAttribute failed\n"); grid = -1; return; }
        if (hipOccupancyMaxActiveBlocksPerMultiprocessor(&per_cu, (const void*)nsa_lru_fwd, NWAVES * 64, LDS_BYTES) != hipSuccess || per_cu < 1)
            fprintf(stderr, "kernel_launch: occupancy query reports %d workgroups per CU\n", per_cu);
        (void)hipGetLastError();
        grid = cus;
    }
    if (grid < 0) return;
    if (hipMemsetAsync((char*)d_ws + WS_CTL, 0, CTL_ZERO_BYTES, stream) != hipSuccess) { fprintf(stderr, "kernel_launch: hipMemsetAsync failed\n"); return; }
    Args a{};
    for (int i = 0; i < 20; ++i) a.in[i] = (const float*)d_in[i];
    a.out = (float*)d_out; a.ws = (unsigned char*)d_ws;
    const int nl = (PROBE_DUP >= 0) ? 2 : N_LAUNCHES;
    for (int li = 0; li < nl; ++li) {
        if (PROBE_DUP >= 0) { a.ph_lo = li ? PROBE_DUP : 0; a.ph_hi = li ? PER_PHASE : PROBE_DUP + 1; a.li = li; a.pad = (li && PROBE_DUP == 2) ? 1 : 0; }
        else { a.ph_lo = (N_LAUNCHES == PER_PHASE) ? li : 0; a.ph_hi = (N_LAUNCHES == PER_PHASE) ? li + 1 : PER_PHASE; a.li = li; }
        hipLaunchKernelGGL(nsa_lru_fwd, dim3(grid), dim3(NWAVES * 64), LDS_BYTES, stream, a);
        const hipError_t le = hipPeekAtLastError();
        if (le != hipSuccess) { fprintf(stderr, "kernel_launch: launch %d failed: %s\n", li, hipGetErrorName(le)); break; }
    }
}
```

```cpp
#include <hip/hip_runtime.h>
#include <cstdio>
#include <cstdint>

#ifndef PROBE_STAGE
#define PROBE_STAGE 0
#endif
#define REG_T0(id) do { if (PROBE_STAGE == (id) && threadIdx.x == 0) F.MISC[16] = (unsigned)wall_clock64(); } while (0)
#define REG_T1(id) do { if (PROBE_STAGE == (id) && threadIdx.x == 0) F.MISC[17] += (unsigned)wall_clock64() - F.MISC[16]; } while (0)
#ifndef PROBE_IDLE
#define PROBE_IDLE -1
#endif
#ifndef PROBE_DUP
#define PROBE_DUP -1
#endif
#ifndef MK_N_LAUNCHES
#define MK_N_LAUNCHES 1
#endif

#define GAS __attribute__((address_space(1)))
#define LAS __attribute__((address_space(3)))
typedef unsigned short bf16;
typedef short bf16x8 __attribute__((ext_vector_type(8)));
typedef short s16x4 __attribute__((ext_vector_type(4)));
typedef float f32x4 __attribute__((ext_vector_type(4)));
typedef float f32x16 __attribute__((ext_vector_type(16)));
typedef unsigned u32x4 __attribute__((ext_vector_type(4)));
typedef unsigned u32x2 __attribute__((ext_vector_type(2)));
typedef GAS unsigned gu32;

constexpr int SEQ = 16384, DM = 1024;
constexpr int NPROJ = 5120;
constexpr float LOG2E = 1.4426950408889634f;
constexpr float RMS_EPS = 1e-6f;

__device__ __forceinline__ unsigned f2bf(float f) { unsigned u = __builtin_bit_cast(unsigned, f); return (u + 0x7fffu + ((u >> 16) & 1u)) >> 16; }
__device__ __forceinline__ unsigned pk2(float lo, float hi) { return f2bf(lo) | (f2bf(hi) << 16); }
__device__ __forceinline__ float bf2f(unsigned h) { return __builtin_bit_cast(float, h << 16); }
__device__ __forceinline__ float bflo(unsigned w) { return __builtin_bit_cast(float, w << 16); }
__device__ __forceinline__ float bfhi(unsigned w) { return __builtin_bit_cast(float, w & 0xffff0000u); }
typedef float f32x2_t __attribute__((ext_vector_type(2))); typedef __bf16 bf16x2_t __attribute__((ext_vector_type(2)));
__device__ __forceinline__ unsigned cvtpk(float lo, float hi) { f32x2_t v = {lo, hi}; bf16x2_t b = __builtin_convertvector(v, bf16x2_t); return __builtin_bit_cast(unsigned, b); }
__device__ __forceinline__ float fsigmoid(float v) { return __builtin_amdgcn_rcpf(1.0f + __builtin_amdgcn_exp2f(-v * LOG2E)); }
template <int CTRL> __device__ __forceinline__ float dpp_f(float v) { return __builtin_bit_cast(float, __builtin_amdgcn_update_dpp(0, __builtin_bit_cast(int, v), CTRL, 0xf, 0xf, true)); }
template <int CTRL> __device__ __forceinline__ int dpp_i(int v) { return __builtin_amdgcn_update_dpp(v, v, CTRL, 0xf, 0xf, false); }
template <int CTRL> __device__ __forceinline__ int dpp_m(int v) { return __builtin_amdgcn_mov_dpp(v, CTRL, 0xf, 0xf, true); }
__device__ __forceinline__ int lane_id() { int l = (int)__builtin_amdgcn_mbcnt_hi(~0u, __builtin_amdgcn_mbcnt_lo(~0u, 0u)); asm volatile("" : "+v"(l)); return l; }
__device__ __forceinline__ float wave_sum(float v) {
#pragma unroll
    for (int o = 1; o < 64; o <<= 1) v += __shfl_xor(v, o);
    return v;
}

namespace pg8 {
#define PG8_LAS __attribute__((address_space(3)))
typedef unsigned short bf16_t;
constexpr int BM = 256, BK = 64, HALF = 128, HTB = HALF * BK * 2, STAGE_BYTES = 8 * HTB, NXCD = 8, WGM = 8;
__host__ __device__ __forceinline__ int lds_byte(int r, int c) { const int st = (r >> 4) * 2 + (c >> 5), rr = r & 15, cc = c & 31, ob = rr * 64 + cc * 2; return st * 1024 + (ob ^ (((ob >> 9) & 1) << 5)); }
__host__ __device__ __forceinline__ void stage_rc(int b, int& R, int& C) { const int st = b / 1024, sb = b % 1024, swz = sb ^ (((sb >> 9) & 1) << 5); R = (st >> 1) * 16 + swz / 64; C = (st & 1) * 32 + (swz % 64) / 2; }
__host__ __device__ __forceinline__ int perm32(int rho) { const int n = rho >> 4, i = rho & 15; return 8 * (i >> 2) + 4 * n + (i & 3); }

struct Unit { int pm, pn, part; };
struct Gemm { const bf16_t* A; const bf16_t* Bt; const bf16_t* A2; const bf16_t* Bt2; int lda, ldb, K; };

struct StaticOrder {
    int nM, nN, nwg, G, c;
    __host__ __device__ void init(int M, int N, int G_, int c_) { nM = M / BM; nN = N / BM; nwg = nM * nN; G = G_; c = c_; }
    __host__ __device__ bool tile(long L, Unit& u) const {
        if (L >= nwg) return false;
        int wgid = (int)L; { const int q = nwg / NXCD, r = nwg % NXCD, xcd = wgid % NXCD, off = wgid / NXCD; wgid = (xcd < r ? xcd * (q + 1) : r * (q + 1) + (xcd - r) * q) + off; }
        const int nig = WGM * nN, gid = wgid / nig, fm = gid * WGM, gsz = (nM - fm) < WGM ? (nM - fm) : WGM;
        u.pm = fm + ((wgid % nig) % gsz); u.pn = (wgid % nig) / gsz; u.part = 0; return true;
    }
    __host__ __device__ bool next(int i, Unit& u) const { return tile((long)i * G + c, u); }
};
struct DualOrder : StaticOrder {
    __host__ __device__ bool next(int i, Unit& u) const { if (!tile((long)(i >> 1) * G + c, u)) return false; u.part = i & 1; return true; }
};
struct XOrder {
    int G, c;
    __host__ __device__ void init(int G_, int c_) { G = G_; c = c_; }
    __host__ __device__ bool tile(long L, Unit& u) const {
        if (L >= 256) return false;
        const int v = ((int)L % 8) * 32 + (int)L / 8, k = v >> 5, j = v & 31, r = j & 7;
        u.pm = (r < 4) ? 4 * k + r : 63 - 4 * k - (r - 4); u.pn = j >> 3; u.part = 0; return true;
    }
    __host__ __device__ bool next(int i, Unit& u) const { return tile((long)i * G + c, u); }
};
struct XPartOrder : XOrder {
    int part;
    __host__ __device__ bool next(int i, Unit& u) const { if (!tile((long)i * G + c, u)) return false; u.part = part; return true; }
};
struct XDualOrder : XOrder {
    __host__ __device__ bool next(int i, Unit& u) const { if (!tile((long)(i >> 1) * G + c, u)) return false; u.part = i & 1; return true; }
};

__device__ __forceinline__ unsigned cvt_pk_bf16(float lo, float hi) { unsigned r; asm volatile("v_cvt_pk_bf16_f32 %0, %1, %2" : "=v"(r) : "v"(lo), "v"(hi)); return r; }

struct EpiProj {
    static constexpr bool PERM = true, INIT = false;
    bf16_t *Q, *KV, *U, *BR, *GN, *GL, *MG;
    __device__ __forceinline__ void operator()(const f32x4 (&acc)[2][2][4][2], const Unit& u, int wr, int wc, int fr, int fq) const {
        const int pn = u.pn; bf16_t* base; int ldc, colt, act = 0;
        if (pn < 2) { base = Q; ldc = 512; colt = pn * 256; }
        else if (pn < 5) { base = KV; ldc = 768; colt = (pn - 2) * 256; }
        else if (pn < 7) { base = U; ldc = 512; colt = (pn - 5) * 256; }
        else if (pn < 8) { base = BR; ldc = 256; colt = 0; }
        else if (pn < 10) { base = GN; ldc = 512; colt = (pn - 8) * 256; act = 1; }
        else if (pn < 12) { base = GL; ldc = 512; colt = (pn - 10) * 256; act = 1; }
        else { base = MG; ldc = 2048; colt = (pn - 12) * 256; act = 2; }
        const int row0 = u.pm * BM + wr * 64 + fr, col0 = colt + wc * 32 + 8 * fq;
#pragma unroll
        for (int ai = 0; ai < 2; ++ai)
#pragma unroll
            for (int m = 0; m < 4; ++m) { bf16_t* rowp = base + (size_t)(row0 + ai * HALF + m * 16) * ldc + col0;
#pragma unroll
                for (int bj = 0; bj < 2; ++bj) { f32x4 v0 = acc[ai][bj][m][0], v1 = acc[ai][bj][m][1];
                    if (act) {
#pragma unroll
                        for (int e = 0; e < 4; ++e) { const float s0 = fsigmoid(v0[e]), s1 = fsigmoid(v1[e]); v0[e] = (act == 1) ? v0[e] * s0 : s0; v1[e] = (act == 1) ? v1[e] * s1 : s1; } }
                    u32x4 w; w.x = cvt_pk_bf16(v0[0], v0[1]); w.y = cvt_pk_bf16(v0[2], v0[3]); w.z = cvt_pk_bf16(v1[0], v1[1]); w.w = cvt_pk_bf16(v1[2], v1[3]);
                    if (act) __builtin_nontemporal_store(w, (u32x4*)(rowp + bj * HALF)); else *(u32x4*)(rowp + bj * HALF) = w; } }
    }
};
struct EpiMerge {
    static constexpr bool PERM = true, INIT = false;
    bf16_t* Mb; const bf16_t* MG; int first;
    __device__ __forceinline__ void operator()(const f32x4 (&acc)[2][2][4][2], const Unit& u, int wr, int wc, int fr, int fq) const {
        const int row0 = u.pm * BM + wr * 64 + fr, col0 = u.pn * BM + wc * 32 + 8 * fq;
#pragma unroll
        for (int ai = 0; ai < 2; ++ai)
#pragma unroll
            for (int m = 0; m < 4; ++m) { const size_t r = (size_t)(row0 + ai * HALF + m * 16);
#pragma unroll
                for (int bj = 0; bj < 2; ++bj) { const f32x4 v0 = acc[ai][bj][m][0], v1 = acc[ai][bj][m][1];
                    const u32x4 gw = __builtin_nontemporal_load((const u32x4*)(MG + r * 2048 + u.part * 1024 + col0 + bj * HALF));
                    float o[8] = {v0[0] * bflo(gw.x), v0[1] * bfhi(gw.x), v0[2] * bflo(gw.y), v0[3] * bfhi(gw.y), v1[0] * bflo(gw.z), v1[1] * bfhi(gw.z), v1[2] * bflo(gw.w), v1[3] * bfhi(gw.w)};
                    bf16_t* dst = Mb + r * 1024 + col0 + bj * HALF;
                    if (u.part != first) { const u32x4 pw = *(const u32x4*)dst;
                        o[0] += bflo(pw.x); o[1] += bfhi(pw.x); o[2] += bflo(pw.y); o[3] += bfhi(pw.y); o[4] += bflo(pw.z); o[5] += bfhi(pw.z); o[6] += bflo(pw.w); o[7] += bfhi(pw.w); }
                    u32x4 w; w.x = cvt_pk_bf16(o[0], o[1]); w.y = cvt_pk_bf16(o[2], o[3]); w.z = cvt_pk_bf16(o[4], o[5]); w.w = cvt_pk_bf16(o[6], o[7]);
                    *(u32x4*)dst = w; } }
    }
};
typedef unsigned u32x4_t __attribute__((ext_vector_type(4)));
constexpr int SEQ_ = 16384;
struct EpiOut {
    static constexpr bool PERM = false, INIT = true;
    const float* X; float* O;
    __device__ __forceinline__ void init(f32x4 (&acc)[2][2][4][2], const Unit& u, int wr, int wc, int fr, int fq) const {
        const int row0 = u.pm * BM + wr * 64 + fr, col0 = u.pn * BM + wc * 32 + 4 * fq;
#pragma unroll
        for (int ai = 0; ai < 2; ++ai)
#pragma unroll
            for (int m = 0; m < 4; ++m) { const size_t off = (size_t)(row0 + ai * HALF + m * 16) * 1024 + col0;
#pragma unroll
                for (int bj = 0; bj < 2; ++bj)
#pragma unroll
                    for (int n = 0; n < 2; ++n) acc[ai][bj][m][n] = __builtin_nontemporal_load((const f32x4*)(X + off + bj * HALF + n * 16)); }
    }
    __device__ __forceinline__ void operator()(const f32x4 (&acc)[2][2][4][2], const Unit& u, int wr, int wc, int fr, int fq) const {
        const int row0 = u.pm * BM + wr * 64 + fr, col0 = u.pn * BM + wc * 32 + 4 * fq;
        const __amdgpu_buffer_rsrc_t orsrc = __builtin_amdgcn_make_buffer_rsrc(O, 0, SEQ_ * 1024 * 4, 0x00020000);
#pragma unroll
        for (int ai = 0; ai < 2; ++ai)
#pragma unroll
            for (int m = 0; m < 4; ++m) { const unsigned off = (unsigned)((row0 + ai * HALF + m * 16) * 1024 + col0);
#pragma unroll
                for (int bj = 0; bj < 2; ++bj)
#pragma unroll
                    for (int n = 0; n < 2; ++n) __builtin_amdgcn_raw_buffer_store_b128(__builtin_bit_cast(u32x4_t, acc[ai][bj][m][n]), orsrc, (off + bj * HALF + n * 16) * 4u, 0, 16); }
    }
};

struct NoGate { __device__ __forceinline__ void operator()() const {} };
template <class Epi, class Sched, bool ALIGN_EPI, class Gate = NoGate>
__device__ __forceinline__ void gemm_phase(PG8_LAS unsigned char* lds, const Gemm g, const Sched& S, const Epi& E, int wid, const Gate& gate = Gate()) {
    const int lane = lane_id(), tid = wid * 64 + lane, wr = wid >> 2, wc = wid & 3, fr = lane & 15, fq = lane >> 4;
    const int K = g.K, nt = K / BK;
    unsigned voffA[2], voffB[2];
#pragma unroll
    for (int i = 0; i < 2; ++i) { int R, C; stage_rc(tid * 16 + i * 8192, R, C); const int Rb = Epi::PERM ? ((R & ~31) + perm32(R & 31)) : R;
        voffA[i] = (unsigned)(R * g.lda + C) * 2u; voffB[i] = (unsigned)(Rb * g.ldb + C) * 2u; }
    const size_t kstep = (size_t)(BK * 2);
    const size_t hstepA = (size_t)HALF * g.lda * 2, hstepB = (size_t)HALF * g.ldb * 2;
    const size_t tstepA = 2 * hstepA, tstepB = 2 * hstepB;
    const unsigned ldsw = (unsigned)wid * 1024u;
    const int aoff = lds_byte(wr * 64 + fr, fq * 8), boff = lds_byte(wc * 32 + fr, fq * 8);
#define PG8_SA(b, h) (((b) * 2 + (h)) * HTB)
#define PG8_SB(b, h) ((4 + (b) * 2 + (h)) * HTB)
#define PG8_STAGE(bufoff, gbase, voff) do { _Pragma("unroll") for (int _i = 0; _i < 2; ++_i) \
        __builtin_amdgcn_global_load_lds((const unsigned*)((const char*)(gbase) + (voff)[_i]), (PG8_LAS unsigned*)(lds + (bufoff) + ldsw + _i * 8192), 16, 0, 0); } while (0)
#define PG8_LDA(dst, b, h) do { _Pragma("unroll") for (int m = 0; m < 4; ++m) _Pragma("unroll") for (int k = 0; k < 2; ++k) dst[m][k] = *(const PG8_LAS bf16x8*)(lds + PG8_SA(b, h) + aoff + m * 2048 + k * 1024); } while (0)
#define PG8_LDB(dst, b, h) do { _Pragma("unroll") for (int n = 0; n < 2; ++n) _Pragma("unroll") for (int k = 0; k < 2; ++k) dst[n][k] = *(const PG8_LAS bf16x8*)(lds + PG8_SB(b, h) + boff + n * 2048 + k * 1024); } while (0)
#define PG8_MMA(ai, bj, At, Bt) do { __builtin_amdgcn_s_setprio(1); _Pragma("unroll") for (int m = 0; m < 4; ++m) _Pragma("unroll") for (int n = 0; n < 2; ++n) _Pragma("unroll") for (int k = 0; k < 2; ++k) \
        acc[ai][bj][m][n] = __builtin_amdgcn_mfma_f32_16x16x32_bf16(Bt[n][k], At[m][k], acc[ai][bj][m][n], 0, 0, 0); __builtin_amdgcn_s_setprio(0); } while (0)
#define PG8_WAIT_V(n) asm volatile("s_waitcnt vmcnt(" #n ")" ::: "memory")
#define PG8_WAIT_L(n) asm volatile("s_waitcnt lgkmcnt(" #n ")" ::: "memory")
#define PG8_BAR __builtin_amdgcn_s_barrier()
#define PG8_SCHED __builtin_amdgcn_sched_barrier(0)
#define PG8_UA(u) ((const char*)((u).part ? g.A2 : g.A) + (size_t)(u).pm * tstepA)
#define PG8_UB(u) ((const char*)((u).part ? g.Bt2 : g.Bt) + (size_t)(u).pn * tstepB)
    Unit cur, nxt; int ui = 0;
    if (!S.next(0, cur)) return;
    f32x4 acc[2][2][4][2];
    if constexpr (Epi::INIT) E.init(acc, cur, wr, wc, fr, fq);
    else {
#pragma unroll
    for (int a = 0; a < 2; ++a)
#pragma unroll
        for (int b = 0; b < 2; ++b)
#pragma unroll
            for (int m = 0; m < 4; ++m)
#pragma unroll
                for (int n = 0; n < 2; ++n) acc[a][b][m][n] = (f32x4){0.f, 0.f, 0.f, 0.f};
    }
    gate();
    bf16x8 At[4][2], B0[2][2], B1[2][2];
    const char* cA = PG8_UA(cur); const char* cB = PG8_UB(cur);
    PG8_STAGE(PG8_SB(0, 0), cB, voffB); PG8_STAGE(PG8_SB(0, 1), cB + hstepB, voffB); PG8_STAGE(PG8_SA(0, 0), cA, voffA); PG8_STAGE(PG8_SA(0, 1), cA + hstepA, voffA);
    if (wr == 1) PG8_BAR;
    PG8_WAIT_V(2); PG8_BAR;
    PG8_STAGE(PG8_SB(1, 0), cB + kstep, voffB); PG8_STAGE(PG8_SA(1, 0), cA + kstep, voffA); PG8_STAGE(PG8_SB(1, 1), cB + hstepB + kstep, voffB);
    PG8_WAIT_V(6); PG8_BAR;
    for (;;) {
        const bool has_next = S.next(ui + 1, nxt);
        const char* nA = has_next ? PG8_UA(nxt) : cA; const char* nB = has_next ? PG8_UB(nxt) : cB;
        for (int t = 0; t < nt; t += 2) {
            const bool last = (t == nt - 2);
            const char* a1 = cA + (size_t)(t + 1) * kstep;
            const char* a2 = last ? nA : cA + (size_t)(t + 2) * kstep; const char* b2 = last ? nB : cB + (size_t)(t + 2) * kstep;
            const char* a3 = a2 + kstep; const char* b3 = b2 + kstep;
            PG8_LDB(B0, 0, 0); PG8_LDB(B1, 0, 1); PG8_SCHED; PG8_LDA(At, 0, 0); PG8_STAGE(PG8_SA(1, 1), a1 + hstepA, voffA);
            PG8_WAIT_V(8); PG8_WAIT_L(0); PG8_BAR; PG8_MMA(0, 0, At, B0); PG8_MMA(0, 1, At, B1); PG8_BAR; PG8_SCHED;
            PG8_LDA(At, 0, 1); PG8_STAGE(PG8_SB(0, 0), b2, voffB); PG8_STAGE(PG8_SB(0, 1), b2 + hstepB, voffB); PG8_STAGE(PG8_SA(0, 0), a2, voffA);
            PG8_WAIT_V(8); PG8_WAIT_L(0); PG8_BAR; PG8_MMA(1, 0, At, B0); PG8_MMA(1, 1, At, B1); PG8_BAR; PG8_SCHED;
            PG8_LDB(B0, 1, 0); PG8_LDB(B1, 1, 1); PG8_SCHED; PG8_LDA(At, 1, 0); PG8_STAGE(PG8_SA(0, 1), a2 + hstepA, voffA);
            PG8_WAIT_V(8); PG8_WAIT_L(0); PG8_BAR; PG8_MMA(0, 0, At, B0); PG8_MMA(0, 1, At, B1); PG8_BAR; PG8_SCHED;
            PG8_LDA(At, 1, 1); PG8_STAGE(PG8_SB(1, 0), b3, voffB); PG8_STAGE(PG8_SB(1, 1), b3 + hstepB, voffB); PG8_STAGE(PG8_SA(1, 0), a3, voffA);
            PG8_WAIT_V(8); PG8_WAIT_L(0); PG8_BAR; PG8_MMA(1, 0, At, B0); PG8_MMA(1, 1, At, B1); PG8_BAR; PG8_SCHED;
        }
        if constexpr (ALIGN_EPI) { if (wr == 0) PG8_BAR; }
        E(acc, cur, wr, wc, fr, fq);
        if (!has_next) break;
        if constexpr (Epi::INIT) E.init(acc, nxt, wr, wc, fr, fq);
        else {
#pragma unroll
        for (int a = 0; a < 2; ++a)
#pragma unroll
            for (int b = 0; b < 2; ++b)
#pragma unroll
                for (int m = 0; m < 4; ++m)
#pragma unroll
                    for (int n = 0; n < 2; ++n) acc[a][b][m][n] = (f32x4){0.f, 0.f, 0.f, 0.f};
        }
        cur = nxt; cA = nA; cB = nB; ++ui;
        if constexpr (ALIGN_EPI) { if (wr == 1) PG8_BAR; }
    }
    PG8_WAIT_V(0);
    if constexpr (!ALIGN_EPI) { if (wr == 0) PG8_BAR; }
    PG8_BAR;
#undef PG8_SA
#undef PG8_SB
#undef PG8_STAGE
#undef PG8_LDA
#undef PG8_LDB
#undef PG8_MMA
#undef PG8_WAIT_V
#undef PG8_WAIT_L
#undef PG8_BAR
#undef PG8_SCHED
#undef PG8_UA
#undef PG8_UB
}
}

constexpr int NWAVES = 8;
constexpr int N_LAUNCHES = MK_N_LAUNCHES;
constexpr int PER_PHASE = 6;
constexpr size_t MiB = 1u << 20;
constexpr size_t WS_CTL = 0, CTL_ZERO_BYTES = 65536;
constexpr size_t WS_WIN = 1 * MiB;
constexpr size_t WS_WA = 11 * MiB;
constexpr size_t WS_WB = 12 * MiB;
constexpr size_t WS_WOUT = 13 * MiB;
constexpr size_t WS_W1T = 15 * MiB;
constexpr size_t WS_SMALL = 17 * MiB;
constexpr size_t WS_SUM = 18 * MiB;
constexpr size_t WS_KC = 19 * MiB;
constexpr size_t WS_XN = 20 * MiB;
constexpr size_t WS_Q = 52 * MiB;
constexpr size_t WS_KV = 84 * MiB;
constexpr size_t WS_MB = 52 * MiB;
constexpr size_t WS_U = 68 * MiB;
constexpr size_t WS_BR = 108 * MiB;
constexpr size_t WS_GN = 116 * MiB;
constexpr size_t WS_GL = 132 * MiB;
constexpr size_t WS_MG = 148 * MiB;
constexpr size_t WS_VT = 212 * MiB;
constexpr size_t WS_KT = 216 * MiB;
constexpr size_t WS_Q2 = 220 * MiB;
constexpr size_t WS_LB = 236 * MiB;
constexpr size_t WS_END = 252 * MiB;
constexpr size_t SM_W2T = 0;
constexpr size_t SM_LWA = 65536;
constexpr size_t SM_LWX = 131072;
constexpr size_t SM_C1 = 262144;
constexpr size_t SM_LUT = 200704;
constexpr int CW_BAR = 4096;

constexpr int RING_BYTES = 160768;
constexpr int LDSCTL_OFF = RING_BYTES, MISC_OFF = LDSCTL_OFF + 320;
constexpr int LDS_BYTES = 163840;

#define RLX_AGENT __ATOMIC_RELAXED, __HIP_MEMORY_SCOPE_AGENT
#define LDS_WAIT() asm volatile("s_waitcnt lgkmcnt(0)" ::: "memory")
#define VM_WAIT() asm volatile("s_waitcnt vmcnt(0)" ::: "memory")

#define XB_TMO      128
#define XB_XCNT(j)  (256  + 64 * (j))
#define XB_XSUB(j)  (1280 + 64 * (j))
#define XB_XGEN(j)  (2304 + 64 * (j))
#define XB_TOP      3328
#define XB_TOPGEN   3392
#define XCD_BAR_WORDS 3456
#define XB_SPIN_CAP (1u << 18)
__device__ __forceinline__ unsigned xb_ld(unsigned* p)              { return __hip_atomic_load(p, __ATOMIC_RELAXED, __HIP_MEMORY_SCOPE_AGENT); }
__device__ __forceinline__ unsigned xb_add(unsigned* p, unsigned v) { return __hip_atomic_fetch_add(p, v, __ATOMIC_RELAXED, __HIP_MEMORY_SCOPE_AGENT); }
__device__ __forceinline__ unsigned xb_xcc_id() { return (unsigned)__builtin_amdgcn_s_getreg((3 << 11) | 20) & 0xFu; }
#define XB_SPIN(cond, bar) do { unsigned _sp = 0; while (cond) { __builtin_amdgcn_s_sleep(1); \
    if ((++_sp & 255u) == 0u) { if (xb_ld(&(bar)[XB_TMO])) break; if (_sp > XB_SPIN_CAP) { atomicAdd(&(bar)[XB_TMO], 1u); break; } } } } while (0)
struct XcdBarrier { unsigned* bar; unsigned x; volatile LAS unsigned* st; };
constexpr int CW_XCC = 13056, CW_FLAGA = 13312, CW_FLAGB = 13440, CW_FLAGP = 13568, CW_FLAGL = 13824;
__device__ __forceinline__ void flag_signal(unsigned* f) {
    asm volatile("s_waitcnt vmcnt(0)" ::: "memory");
    __syncthreads();
    if (threadIdx.x == 0) (void)xb_add(f, 1u);
}
__device__ __forceinline__ void flag_wait(unsigned* f, unsigned target) {
    if (threadIdx.x == 0) { unsigned sp = 0u; while (xb_ld(f) < target) { __builtin_amdgcn_s_sleep(2); if (++sp > (1u << 22)) break; } }
    __syncthreads();
}
__device__ __forceinline__ XcdBarrier xcd_barrier_post(unsigned* bar, volatile LAS unsigned* st) {
    XcdBarrier b; b.bar = bar; b.x = xb_xcc_id(); b.st = st;
    if (threadIdx.x == 0) (void)xb_add(&bar[XB_XCNT(b.x)], 1u);
    return b;
}
__device__ __forceinline__ void xcd_barrier_complete(unsigned* bar, unsigned x, unsigned& nloc, unsigned& nx) {
    const unsigned G = gridDim.x * gridDim.y * gridDim.z;
    unsigned sum, cnt, mine, sp = 0u;
    for (;;) {
        sum = 0u; cnt = 0u; mine = 0u;
#pragma unroll
        for (unsigned j = 0; j < 16; ++j) { const unsigned c = xb_ld(&bar[XB_XCNT(j)]); sum += c; cnt += (c > 0u) ? 1u : 0u; mine = (j == x) ? c : mine; }
        if (sum == G) break;
        __builtin_amdgcn_s_sleep(1);
        if ((++sp & 255u) == 0u) { if (xb_ld(&bar[XB_TMO])) break; if (sp > XB_SPIN_CAP) { atomicAdd(&bar[XB_TMO], 1u); break; } }
    }
    nloc = mine > 0u ? mine : 1u; nx = cnt > 0u ? cnt : 1u;
}
__device__ __forceinline__ void xcd_barrier(const XcdBarrier& b) {
    asm volatile("s_waitcnt vmcnt(0)" ::: "memory");
    __syncthreads();
    if (threadIdx.x == 0) {
        unsigned* bar = b.bar;
        __builtin_amdgcn_s_waitcnt(0);
        unsigned nloc = b.st[0], nx = b.st[1];
        if (nloc == 0u) { xcd_barrier_complete(bar, b.x, nloc, nx); b.st[0] = nloc; b.st[1] = nx; }
        const unsigned old = xb_add(&bar[XB_XSUB(b.x)], 1u);
        const unsigned gen = old / nloc;
        if (old + 1u == (gen + 1u) * nloc) {
            __builtin_amdgcn_fence(__ATOMIC_RELEASE, "agent");
            asm volatile("s_waitcnt vmcnt(0)" ::: "memory");
            const unsigned og = xb_add(&bar[XB_TOP], 1u);
            const unsigned tg = og / nx;
            if (og + 1u == (tg + 1u) * nx) xb_add(&bar[XB_TOPGEN], 1u);
            else XB_SPIN(xb_ld(&bar[XB_TOPGEN]) == tg, bar);
            __builtin_amdgcn_fence(__ATOMIC_ACQUIRE, "agent");
            xb_add(&bar[XB_XGEN(b.x)], 1u);
            asm volatile("s_waitcnt vmcnt(0)" ::: "memory");
        } else {
            XB_SPIN(xb_ld(&bar[XB_XGEN(b.x)]) == gen, bar);
            __builtin_amdgcn_fence(__ATOMIC_ACQUIRE, "agent");
            asm volatile("s_waitcnt vmcnt(0)" ::: "memory");
        }
    }
    __syncthreads();
}

struct Args { const float* in[20]; float* out; unsigned char* ws; int ph_lo, ph_hi, li, pad; };
struct Frame {
    LAS unsigned char* lds;
    volatile LAS unsigned* MISC;
    int wave;
    int vcu, G;
    unsigned char* ws;
#define WSP(name, T, off) __device__ __forceinline__ T* name() const { return (T*)(ws + (off)); }
    WSP(WinT, bf16, WS_WIN) WSP(WaT, bf16, WS_WA) WSP(WbT, bf16, WS_WB) WSP(WoutT, bf16, WS_WOUT) WSP(W1T, bf16, WS_W1T)
    WSP(W2T, bf16, WS_SMALL + SM_W2T) WSP(LWA, bf16, WS_SMALL + SM_LWA) WSP(LWX, bf16, WS_SMALL + SM_LWX)
    WSP(C1, float, WS_SMALL + SM_C1) WSP(LUT, float, WS_SMALL + SM_LUT) WSP(SUMA, float, WS_SUM) WSP(SUMB, float, WS_SUM + 524288)
    WSP(KC, bf16, WS_KC) WSP(VC, bf16, WS_KC + 524288) WSP(XN, bf16, WS_XN) WSP(Q, bf16, WS_Q) WSP(KV, bf16, WS_KV) WSP(MB, bf16, WS_MB)
    WSP(VT, bf16, WS_VT) WSP(KT, bf16, WS_KT) WSP(Q2, bf16, WS_Q2) WSP(LB, bf16, WS_LB) WSP(U, bf16, WS_U) WSP(BR, bf16, WS_BR) WSP(GN, bf16, WS_GN) WSP(GL, bf16, WS_GL) WSP(MG, bf16, WS_MG)
#undef WSP
};

__device__ __forceinline__ int t5_bucket(int n) {
    if (n < 16) return n;
    const int thr[15] = {19, 21, 24, 27, 31, 35, 40, 46, 52, 59, 67, 77, 87, 99, 113};
    int b = 16;
#pragma unroll
    for (int i = 0; i < 15; ++i) b += (n >= thr[i]) ? 1 : 0;
    return b;
}

__device__ __forceinline__ void p0_tr_item(const float* W, int ldw, int k0, int srccol0, int nvalid, bf16* WT, int ldt, int dstrow0, LAS float* scr, int lane) {
    const int c = lane & 31;
    float tv[32];
#pragma unroll
    for (int i = 0; i < 32; ++i) { const int kk = 2 * i + (lane >> 5); tv[i] = (c < nvalid) ? __builtin_nontemporal_load(W + (size_t)(k0 + kk) * ldw + srccol0 + c) : 0.f; }
#pragma unroll
    for (int i = 0; i < 32; ++i) { const int kk = 2 * i + (lane >> 5); scr[kk * 33 + c] = tv[i]; }
    LDS_WAIT(); asm volatile("" ::: "memory");
    const int cc = lane & 7;
#pragma unroll
    for (int j = 0; j < 4; ++j) { const int n = (lane >> 3) + 8 * j; const LAS float* s = scr + (8 * cc) * 33 + n;
        u32x4 o; o.x = pk2(s[0 * 33], s[1 * 33]); o.y = pk2(s[2 * 33], s[3 * 33]); o.z = pk2(s[4 * 33], s[5 * 33]); o.w = pk2(s[6 * 33], s[7 * 33]);
        *(u32x4*)(WT + (size_t)(dstrow0 + n) * ldt + k0 + 8 * cc) = o; }
    LDS_WAIT(); asm volatile("" ::: "memory");
}
__device__ __forceinline__ void p0_w1f_item(const float* W, int k0, int n0, bf16* WF, LAS float* scr, int lane, const float* pe, float* c1out) {
    const int c = lane & 31;
    float tv[32];
#pragma unroll
    for (int i = 0; i < 32; ++i) { const int kk = 2 * i + (lane >> 5); tv[i] = W[(size_t)(k0 + kk) * 256 + n0 + c]; }
    {
        float pv_[32];
#pragma unroll
        for (int i = 0; i < 32; ++i) pv_[i] = pe[k0 + 2 * i + (lane >> 5)];
        float s0 = 0.f, s1 = 0.f, s2 = 0.f, s3 = 0.f;
#pragma unroll
        for (int i = 0; i < 32; i += 4) { s0 += pv_[i] * tv[i]; s1 += pv_[i + 1] * tv[i + 1]; s2 += pv_[i + 2] * tv[i + 2]; s3 += pv_[i + 3] * tv[i + 3]; }
        float sm = (s0 + s1) + (s2 + s3); sm += __shfl_xor(sm, 32);
        if (lane < 32) c1out[n0 + c] = sm; }
#pragma unroll
    for (int i = 0; i < 32; ++i) { const int kk = 2 * i + (lane >> 5); scr[kk * 33 + c] = tv[i]; }
    LDS_WAIT(); asm volatile("" ::: "memory");
    const int fr = lane & 15, fq = lane >> 4;
#pragma unroll
    for (int j = 0; j < 4; ++j) { const int ksl = j >> 1, nt = j & 1; const LAS float* sp = scr + (32 * ksl + 8 * fq) * 33 + 16 * nt + fr;
        u32x4 o; o.x = pk2(sp[0 * 33], sp[1 * 33]); o.y = pk2(sp[2 * 33], sp[3 * 33]); o.z = pk2(sp[4 * 33], sp[5 * 33]); o.w = pk2(sp[6 * 33], sp[7 * 33]);
        *(u32x4*)(WF + ((size_t)(((n0 >> 5) * 64 + (k0 >> 5) + ksl) * 2 + nt) * 64 + lane) * 8) = o; }
    LDS_WAIT(); asm volatile("" ::: "memory");
}
__device__ __forceinline__ void win_src(int n0, int& src, int& nvalid) {
    nvalid = 32;
    if (n0 < 1280) src = n0;
    else if (n0 < 1792) src = 1816 + (n0 - 1280);
    else if (n0 < 2048) { src = 1792 + (n0 - 1792); nvalid = (n0 == 1792) ? 24 : 0; if (n0 != 1792) src = 0; }
    else if (n0 < 2560) src = 1280 + (n0 - 2048);
    else if (n0 < 3072) src = 2328 + (n0 - 2560);
    else src = 2840 + (n0 - 3072);
}
__device__ __forceinline__ void p0_prologue(const Frame& F, const Args& A) {
    LAS float* scr = (LAS float*)(F.lds + F.wave * 16384);
    const int gw = F.vcu * NWAVES + F.wave, NGW = F.G * NWAVES, lane = lane_id();
    constexpr int I_WIN = 16 * 160, I_WA = 8 * 32, I_WO = 16 * 32, I_W1 = 32 * 8, I_W2 = 4 * 2, I_LR = 2;
    constexpr int NIT = I_WIN + 2 * I_WA + I_WO + 2 * I_W1 + 2 * I_W2 + 16 * I_LR + 1;
    f32x4 rb[4][4];
#pragma unroll
    for (int sl = 0; sl < 4; ++sl) { const int m = gw + sl * NGW;
        if (m < SEQ) { const f32x4* xr = (const f32x4*)(A.in[0] + (size_t)m * DM) + lane;
#pragma unroll
            for (int j = 0; j < 4; ++j) rb[sl][j] = __builtin_nontemporal_load(xr + 64 * j); } }
    REG_T0(14);
    auto do_item = [&](int it) {
        int r = it;
        if (r < I_WIN) { const int kb = r / 160, nb = r % 160; int src, nv; win_src(32 * nb, src, nv); p0_tr_item(A.in[2], 4888, 64 * kb, src, nv, F.WinT(), 1024, 32 * nb, scr, lane); return; } r -= I_WIN;
        if (r < I_WA) { p0_tr_item(A.in[17], 1024, 64 * (r / 32), 32 * (r % 32), 32, F.WaT(), 512, 32 * (r % 32), scr, lane); return; } r -= I_WA;
        if (r < I_WA) { p0_tr_item(A.in[18], 1024, 64 * (r / 32), 32 * (r % 32), 32, F.WbT(), 512, 32 * (r % 32), scr, lane); return; } r -= I_WA;
        if (r < I_WO) { p0_tr_item(A.in[19], 1024, 64 * (r / 32), 32 * (r % 32), 32, F.WoutT(), 1024, 32 * (r % 32), scr, lane); return; } r -= I_WO;
        if (r < 2 * I_W1) { const int kv = r / I_W1, q = r % I_W1; p0_w1f_item(A.in[6] + (size_t)kv * 2048 * 256, 64 * (q / 8), 32 * (q % 8), F.W1T() + (size_t)kv * 256 * 2048, scr, lane, A.in[5] + kv * 2048, F.C1() + ((q / 8) * 2 + kv) * 256); return; } r -= 2 * I_W1;
        if (r < 2 * I_W2) { const int kv = r / I_W2, q = r % I_W2; p0_tr_item(A.in[8] + (size_t)kv * 256 * 64, 64, 64 * (q / 2), 32 * (q % 2), 32, F.W2T() + (size_t)kv * 64 * 256, 256, 32 * (q % 2), scr, lane); return; } r -= 2 * I_W2;
        if (r < 16 * I_LR) { const int mtx = r / 2, nb = r % 2; const float* src = (mtx < 8 ? A.in[12] : A.in[14]) + (size_t)(mtx & 7) * 4096; bf16* dst = (mtx < 8 ? F.LWA() : F.LWX()) + (size_t)(mtx & 7) * 4096;
            p0_tr_item(src, 64, 0, 32 * nb, 32, dst, 64, 32 * nb, scr, lane); return; } r -= 16 * I_LR;
        {
            for (int e = lane; e < 1024; e += 64) { const int hd = e >> 7, n = e & 127; F.LUT()[e] = (A.in[9][t5_bucket(n) * 8 + hd] - A.in[9][31 * 8 + hd]) * LOG2E; }
            { float gq = fabsf(A.in[3][lane]), gk = fmaxf(fmaxf(fabsf(A.in[4][lane]), fabsf(A.in[4][64 + lane])), fabsf(A.in[4][128 + lane]));
              float bm = fmaxf(fmaxf(fabsf(A.in[9][lane]), fabsf(A.in[9][64 + lane])), fmaxf(fabsf(A.in[9][128 + lane]), fabsf(A.in[9][192 + lane])));
#pragma unroll
              for (int o = 1; o < 64; o <<= 1) { gq = fmaxf(gq, __shfl_xor(gq, o)); gk = fmaxf(gk, __shfl_xor(gk, o)); bm = fmaxf(bm, __shfl_xor(bm, o)); }
              const float bound = 11.55f * gq * gk + 2.0f * LOG2E * bm;
              if (lane == 0) F.LUT()[1024] = (bound < 40.0f) ? 1.0f : 0.0f; }
        }
    };
    const float* gain = A.in[1];
    int it = gw;
    int m = gw;
#pragma unroll 1
    while (m < SEQ || it < NIT) {
        if (it < NIT) { do_item(it); it += NGW; }
#pragma unroll 1
        for (int rep_ = 0; rep_ < 2 && m < SEQ; ++rep_, m += NGW) {
            float s = 0.f;
#pragma unroll
            for (int j = 0; j < 4; ++j) s += (rb[0][j].x * rb[0][j].x + rb[0][j].y * rb[0][j].y) + (rb[0][j].z * rb[0][j].z + rb[0][j].w * rb[0][j].w);
            const float rs = 1.0f / sqrtf(wave_sum(s) * (1.f / DM) + RMS_EPS);
            unsigned long long* o8 = (unsigned long long*)(F.XN() + (size_t)m * DM) + lane;
#pragma unroll
            for (int j = 0; j < 4; ++j) { const f32x4 gv = ((const f32x4*)gain)[lane + 64 * j]; const f32x4 vv = rb[0][j];
                o8[64 * j] = (unsigned long long)pk2(vv.x * rs * gv.x, vv.y * rs * gv.y) | ((unsigned long long)pk2(vv.z * rs * gv.z, vv.w * rs * gv.w) << 32); }
#pragma unroll
            for (int sl = 0; sl < 3; ++sl)
#pragma unroll
                for (int j = 0; j < 4; ++j) rb[sl][j] = rb[sl + 1][j];
            if (m + 4 * NGW < SEQ) { const f32x4* xr = (const f32x4*)(A.in[0] + (size_t)(m + 4 * NGW) * DM) + lane;
#pragma unroll
                for (int j = 0; j < 4; ++j) rb[3][j] = __builtin_nontemporal_load(xr + 64 * j); }
        }
    }
    REG_T1(14);
}

template <bool FINAL>
__device__ __forceinline__ void lru_tile(const Frame& F, const Args& A, int tt) {
    const int lane = lane_id();
    const int w = F.wave, fr = lane & 15, fq = lane >> 4, ch0 = 64 * w, t0 = 64 * tt;
    LAS float* UC = (LAS float*)(F.lds + w * 16384);
#define UC_IDX(tok, ch) ((tok) * 64 + ((((ch) >> 2) ^ ((tok) & 15)) << 2) + ((ch) & 3))
    float Hc = 0.f;
    if (FINAL) {
        const float* sa = F.SUMA() + ch0 + lane; const float* sb = F.SUMB() + ch0 + lane;
        int i = 0;
        for (; i + 64 <= tt; i += 64) { float ta[64], tb[64];
#pragma unroll
            for (int k = 0; k < 64; ++k) { ta[k] = sa[(size_t)(i + k) * 512]; tb[k] = sb[(size_t)(i + k) * 512]; }
#pragma unroll
            for (int k = 0; k < 64; ++k) Hc = ta[k] * Hc + tb[k]; }
        for (; i + 16 <= tt; i += 16) { float ta[16], tb[16];
#pragma unroll
            for (int k = 0; k < 16; ++k) { ta[k] = sa[(size_t)(i + k) * 512]; tb[k] = sb[(size_t)(i + k) * 512]; }
#pragma unroll
            for (int k = 0; k < 16; ++k) Hc = ta[k] * Hc + tb[k]; }
        for (; i < tt; ++i) Hc = sa[(size_t)i * 512] * Hc + sb[(size_t)i * 512];
        asm volatile("" : "+v"(Hc));
    }
    {
        const int ch = ch0 + lane; const float* cw = A.in[10]; const float cb = A.in[11][ch];
        const float w0 = cw[ch], w1 = cw[512 + ch], w2 = cw[1024 + ch], w3 = cw[1536 + ch];
        const bf16* up = F.U() + (size_t)t0 * 512 + ch;
        float u0 = 0.f, u1 = 0.f, u2 = 0.f;
        if (tt > 0) { u0 = bf2f(up[-3 * 512]); u1 = bf2f(up[-2 * 512]); u2 = bf2f(up[-1 * 512]); }
        unsigned short ur[64];
#pragma unroll
        for (int tok = 0; tok < 64; ++tok) ur[tok] = __builtin_nontemporal_load(up + (size_t)tok * 512);
#pragma unroll
        for (int tok = 0; tok < 64; ++tok) { const float u3 = bf2f(ur[tok]);
            UC[UC_IDX(tok, lane)] = cb + ((u0 * w0 + u1 * w1) + (u2 * w2 + u3 * w3)); u0 = u1; u1 = u2; u2 = u3; }
    }
    bf16x8 Ba[4][2], Bx[4][2];
#pragma unroll
    for (int nt = 0; nt < 4; ++nt)
#pragma unroll
        for (int ks = 0; ks < 2; ++ks) { const size_t o = (size_t)w * 4096 + (16 * nt + fr) * 64 + 32 * ks + 8 * fq; Ba[nt][ks] = *(const bf16x8*)(F.LWA() + o); Bx[nt][ks] = *(const bf16x8*)(F.LWX() + o); }
    float ba[4], bx[4], sp8[4], hin[4], acum[4];
#pragma unroll
    for (int nt = 0; nt < 4; ++nt) { const int ch = ch0 + 16 * nt + fr; ba[nt] = A.in[13][ch]; bx[nt] = A.in[15][ch];
        sp8[nt] = 8.0f * log1pf(expf(-A.in[16][ch])); hin[nt] = 0.f; acum[nt] = 1.f; }
    if (FINAL) {
#pragma unroll
        for (int nt = 0; nt < 4; ++nt) hin[nt] = __shfl(Hc, 16 * nt + fr);
    }
    LDS_WAIT();
    unsigned short glv[16], gln[16];
    if (FINAL) {
#pragma unroll
        for (int nt = 0; nt < 4; ++nt)
#pragma unroll
            for (int rg = 0; rg < 4; ++rg) glv[nt * 4 + rg] = F.GL()[(size_t)(t0 + 4 * fq + rg) * 512 + ch0 + 16 * nt + fr];
    }
#pragma unroll 1
    for (int mt = 0; mt < 4; ++mt) {
        if (FINAL && mt < 3) {
#pragma unroll
            for (int nt = 0; nt < 4; ++nt)
#pragma unroll
                for (int rg = 0; rg < 4; ++rg) gln[nt * 4 + rg] = F.GL()[(size_t)(t0 + 16 * (mt + 1) + 4 * fq + rg) * 512 + ch0 + 16 * nt + fr];
        }
        bf16x8 Af[2];
#pragma unroll
        for (int ks = 0; ks < 2; ++ks) { const int tok = 16 * mt + fr, c0 = 8 * ks + 2 * fq;
            const f32x4 x0 = *(const LAS f32x4*)(UC + tok * 64 + ((c0 ^ (tok & 15)) << 2)), x1 = *(const LAS f32x4*)(UC + tok * 64 + (((c0 + 1) ^ (tok & 15)) << 2));
            u32x4 pw; pw.x = cvtpk(x0[0], x0[1]); pw.y = cvtpk(x0[2], x0[3]); pw.z = cvtpk(x1[0], x1[1]); pw.w = cvtpk(x1[2], x1[3]); Af[ks] = __builtin_bit_cast(bf16x8, pw); }
        f32x4 cr[4], ci[4];
#pragma unroll
        for (int nt = 0; nt < 4; ++nt) { cr[nt] = (f32x4){0.f, 0.f, 0.f, 0.f}; ci[nt] = (f32x4){0.f, 0.f, 0.f, 0.f};
#pragma unroll
            for (int ks = 0; ks < 2; ++ks) { cr[nt] = __builtin_amdgcn_mfma_f32_16x16x32_bf16(Af[ks], Ba[nt][ks], cr[nt], 0, 0, 0); ci[nt] = __builtin_amdgcn_mfma_f32_16x16x32_bf16(Af[ks], Bx[nt][ks], ci[nt], 0, 0, 0); } }
#pragma unroll
        for (int nt = 0; nt < 4; ++nt) {
            float P[4], Hh[4];
#pragma unroll
            for (int rg = 0; rg < 4; ++rg) { const int tok = 16 * mt + 4 * fq + rg, e = 16 * nt + fr;
                const float ucv = UC[UC_IDX(tok, e)];
                const float r = fsigmoid(cr[nt][rg] + ba[nt]), ig = fsigmoid(ci[nt][rg] + bx[nt]);
                const float la = -r * sp8[nt]; const float a = __builtin_amdgcn_exp2f(la * LOG2E);
                const float so = -la * (1.0f + la * (0.5f + la * (0.16666667f + la * (0.041666668f + la * 0.008333334f))));
                const float oma = (la > -0.25f) ? so : 1.0f - a;
                const float om = oma * (1.0f + a);
                const float b = __builtin_amdgcn_sqrtf(om) * (ig * ucv);
                if (!FINAL) {
                    const size_t tg = (size_t)(t0 + tok); const int chg = ch0 + e; const unsigned pk = cvtpk(oma, b);
                    F.XN()[tg * 1024 + 512 + chg] = (bf16)(pk & 0xffffu); F.LB()[tg * 512 + chg] = (bf16)(pk >> 16); }
                if (rg == 0) { P[0] = a; Hh[0] = b; } else { P[rg] = P[rg - 1] * a; Hh[rg] = a * Hh[rg - 1] + b; } }
            float At = P[3], Bt = Hh[3];
            { const float Ap = __shfl_up(At, 16), Bp = __shfl_up(Bt, 16); if (fq >= 1) { Bt = At * Bp + Bt; At = Ap * At; } }
            { const float Ap = __shfl_up(At, 32), Bp = __shfl_up(Bt, 32); if (fq >= 2) { Bt = At * Bp + Bt; At = Ap * At; } }
            float Aex = __shfl_up(At, 16), Bex = __shfl_up(Bt, 16); if (fq == 0) { Aex = 1.f; Bex = 0.f; }
            const float hg = Aex * hin[nt] + Bex;
            float hv[4];
#pragma unroll
            for (int rg = 0; rg < 4; ++rg) hv[rg] = P[rg] * hg + Hh[rg];
            hin[nt] = __shfl(hv[3], 48 + fr);
            if (!FINAL) acum[nt] *= __shfl(At, 48 + fr);
            if (FINAL) {
#pragma unroll
                for (int rg = 0; rg < 4; ++rg) { const size_t t = (size_t)(t0 + 16 * mt + 4 * fq + rg); const int ch = ch0 + 16 * nt + fr;
                    F.XN()[t * 1024 + 512 + ch] = (bf16)f2bf(hv[rg] * bf2f(glv[nt * 4 + rg])); }
            }
        }
        if (FINAL) {
#pragma unroll
            for (int x = 0; x < 16; ++x) glv[x] = gln[x];
        }
    }
    if (!FINAL && fq == 0) {
#pragma unroll
        for (int nt = 0; nt < 4; ++nt) { F.SUMA()[(size_t)tt * 512 + ch0 + 16 * nt + fr] = acum[nt]; F.SUMB()[(size_t)tt * 512 + ch0 + 16 * nt + fr] = hin[nt]; }
    }
    LDS_WAIT();
#undef UC_IDX
}

__device__ __forceinline__ void lru_apply(const Frame& F, int tt) {
    const int lane = lane_id(), ch = 64 * F.wave + lane, t0 = 64 * tt;
    float H = 0.f;
    bf16* px = F.XN() + (size_t)t0 * 1024 + 512 + ch; const bf16* pb = F.LB() + (size_t)t0 * 512 + ch; const bf16* pg = F.GL() + (size_t)t0 * 512 + ch;
    unsigned short a0[16], b0[16], g0[16];
#pragma unroll
    for (int k = 0; k < 16; ++k) { a0[k] = __builtin_nontemporal_load(px + (size_t)k * 1024); b0[k] = __builtin_nontemporal_load(pb + (size_t)k * 512); g0[k] = __builtin_nontemporal_load(pg + (size_t)k * 512); }
    { const float* sa = F.SUMA() + ch; const float* sb = F.SUMB() + ch; int i = 0;
        for (; i + 64 <= tt; i += 64) { float ta[64], tb[64];
#pragma unroll
            for (int k = 0; k < 64; ++k) { ta[k] = sa[(size_t)(i + k) * 512]; tb[k] = sb[(size_t)(i + k) * 512]; }
#pragma unroll
            for (int k = 0; k < 64; ++k) H = ta[k] * H + tb[k]; }
        for (; i + 16 <= tt; i += 16) { float ta[16], tb[16];
#pragma unroll
            for (int k = 0; k < 16; ++k) { ta[k] = sa[(size_t)(i + k) * 512]; tb[k] = sb[(size_t)(i + k) * 512]; }
#pragma unroll
            for (int k = 0; k < 16; ++k) H = ta[k] * H + tb[k]; }
        if (i < tt) { float ta[16], tb[16];
#pragma unroll
            for (int k = 0; k < 16; ++k) { const bool ok = (i + k < tt); const size_t o = (size_t)(ok ? i + k : 0) * 512; const float a_ = sa[o], b_ = sb[o]; ta[k] = ok ? a_ : 1.f; tb[k] = ok ? b_ : 0.f; }
#pragma unroll
            for (int k = 0; k < 16; ++k) H = ta[k] * H + tb[k]; } }
#pragma unroll
    for (int k = 0; k < 16; ++k) { H = (1.0f - bf2f(a0[k])) * H + bf2f(b0[k]); px[(size_t)k * 1024] = (bf16)f2bf(H * bf2f(g0[k])); }
    { unsigned short av[48], bv[48], gv[48];
#pragma unroll
        for (int k = 0; k < 48; ++k) { const size_t tk = (size_t)(16 + k); av[k] = __builtin_nontemporal_load(px + tk * 1024); bv[k] = __builtin_nontemporal_load(pb + tk * 512); gv[k] = __builtin_nontemporal_load(pg + tk * 512); }
#pragma unroll
        for (int k = 0; k < 48; ++k) { H = (1.0f - bf2f(av[k])) * H + bf2f(bv[k]); px[(size_t)(16 + k) * 1024] = (bf16)f2bf(H * bf2f(gv[k])); } }
}

__device__ __forceinline__ void qk_norm_tile(const Frame& F, const Args& A, int tt) {
    const int lane = lane_id(), sub = lane & 7;
#pragma unroll 4
    for (int it = 0; it < 12; ++it) {
        const int idx = it * 64 + F.wave * 8 + (lane >> 3), tok = idx / 12, hr = idx % 12; const size_t t = (size_t)(64 * tt + tok);
        bf16* p; bf16* dst; const float* gain; float sc = 1.f;
        if (hr < 8) { p = F.Q() + t * 512 + hr * 64; dst = F.Q2() + t * 512 + (hr >> 2) * 256 + (sub >> 1) * 64 + (hr & 3) * 16 + (sub & 1) * 8 - sub * 8; gain = A.in[3]; sc = 0.125f * LOG2E; }
        else if (hr < 10) { p = F.KV() + t * 768 + 256 + (hr - 8) * 64; dst = p; gain = A.in[4] + 64; }
        else { p = F.KV() + t * 768 + 512 + (hr - 10) * 64; dst = p; gain = A.in[4] + 128; }
        const u32x4 w = __builtin_nontemporal_load((const u32x4*)(p + sub * 8));
        float x[8] = {bflo(w.x), bfhi(w.x), bflo(w.y), bfhi(w.y), bflo(w.z), bfhi(w.z), bflo(w.w), bfhi(w.w)};
        float ss = 0.f;
#pragma unroll
        for (int j = 0; j < 8; ++j) ss += x[j] * x[j];
        ss += __shfl_xor(ss, 1); ss += __shfl_xor(ss, 2); ss += __shfl_xor(ss, 4);
        const float rs = sc / sqrtf(ss * (1.f / 64.f) + RMS_EPS);
        const f32x4 g0 = *(const f32x4*)(gain + sub * 8), g1 = *(const f32x4*)(gain + sub * 8 + 4);
        u32x4 o; o.x = pk2(x[0] * rs * g0.x, x[1] * rs * g0.y); o.y = pk2(x[2] * rs * g0.z, x[3] * rs * g0.w); o.z = pk2(x[4] * rs * g1.x, x[5] * rs * g1.y); o.w = pk2(x[6] * rs * g1.z, x[7] * rs * g1.w);
        *(u32x4*)(dst + sub * 8) = o;
        if (hr >= 8 && hr < 10) {
            int w0 = __builtin_amdgcn_cvt_pk_fp8_f32(x[0] * rs * g0.x, x[1] * rs * g0.y, 0, false); w0 = __builtin_amdgcn_cvt_pk_fp8_f32(x[2] * rs * g0.z, x[3] * rs * g0.w, w0, true);
            int w1 = __builtin_amdgcn_cvt_pk_fp8_f32(x[4] * rs * g1.x, x[5] * rs * g1.y, 0, false); w1 = __builtin_amdgcn_cvt_pk_fp8_f32(x[6] * rs * g1.z, x[7] * rs * g1.w, w1, true);
            u32x2* kt8 = (u32x2*)F.KT() + (size_t)((hr - 8) * 256 + tt) * 512 + ((((sub >> 2) * 4 + (tok >> 4)) * 4 + (sub & 3)) * 16 + (tok & 15));
            *kt8 = (u32x2){(unsigned)w0, (unsigned)w1}; }
    }
}

__device__ __forceinline__ void vt_tile(const Frame& F, int J) {
    const int tid = F.wave * 64 + lane_id(), d = tid & 63, ks = (tid >> 6) & 1, gp = tid >> 7;
#pragma unroll
    for (int g = 0; g < 2; ++g) {
        const bf16* vp = F.KV() + (size_t)(64 * J) * 768 + 384 + 64 * g + d;
        unsigned short e[8];
#pragma unroll
        for (int j = 0; j < 8; ++j) { const int key = 32 * ks + 4 * gp + (j & 3) + 16 * (j >> 2); e[j] = vp[(size_t)key * 768]; }
        u32x4 w; w.x = e[0] | ((unsigned)e[1] << 16); w.y = e[2] | ((unsigned)e[3] << 16); w.z = e[4] | ((unsigned)e[5] << 16); w.w = e[6] | ((unsigned)e[7] << 16);
        *(u32x4*)(F.VT() + (size_t)(g * 256 + J) * 4096 + ((((d >> 4) * 2 + ks) * 16 + (d & 15)) * 32) + 8 * gp) = w;
    }
}

__device__ __forceinline__ void compress_item(const Frame& F, const Args& A, int kv, int g, int ct) {
    const int lane = lane_id(), w = F.wave, tid = w * 64 + lane, fr = lane & 15, fq = lane >> 4, c0 = 16 * ct, tb = 16 * c0;
    LAS unsigned char* T = F.lds;
    LAS bf16* HID = (LAS bf16*)(F.lds + 34816);
    LAS float* OUTF = (LAS float*)(F.lds + 34816 + 8448);
    LAS float* C1L = (LAS float*)(F.lds + 34816 + 8448 + 4096);
    {
        u32x4 tv[5];
#pragma unroll
        for (int i = 0; i < 5; ++i) { const int idx = tid + 512 * i, tok = idx >> 3, chn = idx & 7, gt = tb + tok; tv[i] = (u32x4){0u, 0u, 0u, 0u};
            if (idx < 272 * 8 && gt < SEQ) tv[i] = *(const u32x4*)(F.KV() + (size_t)gt * 768 + kv * 128 + g * 64 + chn * 8); }
        { const int n = tid & 255, hf = tid >> 8; float pc[16];
#pragma unroll
            for (int k = 0; k < 16; ++k) pc[k] = F.C1()[((hf * 16 + k) * 2 + kv) * 256 + n];
            float s = hf ? 0.f : A.in[7][kv * 256 + n];
#pragma unroll
            for (int k = 0; k < 16; ++k) s += pc[k];
            C1L[hf * 256 + n] = s; }
#pragma unroll
        for (int i = 0; i < 5; ++i) { const int idx = tid + 512 * i, tok = idx >> 3, chn = idx & 7;
            if (idx < 272 * 8) *(LAS u32x4*)(T + tok * 128 + ((chn ^ ((tok >> 4) & 7)) << 4)) = tv[i]; }
    }
    LDS_WAIT(); __syncthreads();
    f32x4 acc[2] = {(f32x4){0.f, 0.f, 0.f, 0.f}, (f32x4){0.f, 0.f, 0.f, 0.f}};
    const bf16x8* wf = (const bf16x8*)(F.W1T() + (size_t)kv * 256 * 2048) + (size_t)w * (64 * 2 * 64) + lane;
    bf16x8 wb[2][16];
#pragma unroll
    for (int x = 0; x < 16; ++x) wb[0][x] = wf[(size_t)x * 64];
#pragma unroll
    for (int blk = 0; blk < 8; ++blk) {
        if (blk + 1 < 8) {
#pragma unroll
            for (int x = 0; x < 16; ++x) wb[(blk + 1) & 1][x] = wf[(size_t)((blk + 1) * 16 + x) * 64]; }
#pragma unroll
        for (int k8 = 0; k8 < 8; ++k8) { const int ks = 8 * blk + k8;
            const int tok = 16 * fr + (ks >> 1), chn = 4 * (ks & 1) + fq;
            const bf16x8 a = *(const LAS bf16x8*)(T + tok * 128 + ((chn ^ ((tok >> 4) & 7)) << 4));
            acc[0] = __builtin_amdgcn_mfma_f32_16x16x32_bf16(a, wb[blk & 1][2 * k8], acc[0], 0, 0, 0);
            acc[1] = __builtin_amdgcn_mfma_f32_16x16x32_bf16(a, wb[blk & 1][2 * k8 + 1], acc[1], 0, 0, 0); }
    }
#pragma unroll
    for (int nt = 0; nt < 2; ++nt) { const int n = 32 * w + 16 * nt + fr; const float c1 = C1L[n] + C1L[256 + n];
#pragma unroll
        for (int rg = 0; rg < 4; ++rg) { const float v = acc[nt][rg] + c1; HID[(4 * fq + rg) * 264 + n] = (bf16)f2bf(v * fsigmoid(v)); } }
    LDS_WAIT(); __syncthreads();
    if (w < 4) {
        f32x4 o = (f32x4){0.f, 0.f, 0.f, 0.f};
        const bf16* w2t = F.W2T() + (size_t)kv * 64 * 256 + (size_t)(16 * w + fr) * 256 + 8 * fq;
#pragma unroll
        for (int ks = 0; ks < 8; ++ks) { const bf16x8 a = *(const LAS bf16x8*)(HID + fr * 264 + 32 * ks + 8 * fq); const bf16x8 b = *(const bf16x8*)(w2t + 32 * ks);
            o = __builtin_amdgcn_mfma_f32_16x16x32_bf16(a, b, o, 0, 0, 0); }
#pragma unroll
        for (int rg = 0; rg < 4; ++rg) OUTF[(4 * fq + rg) * 64 + 16 * w + fr] = o[rg];
    }
    LDS_WAIT(); __syncthreads();
    {
        const int row = tid >> 5, e = 2 * (tid & 31), c = c0 + row;
        float v0 = OUTF[row * 64 + e], v1 = OUTF[row * 64 + e + 1];
        if (kv == 0) { float ss = v0 * v0 + v1 * v1;
#pragma unroll
            for (int o = 1; o < 32; o <<= 1) ss += __shfl_xor(ss, o);
            const float rs = 1.0f / sqrtf(ss * (1.f / 64.f) + RMS_EPS); v0 *= rs * A.in[4][e]; v1 *= rs * A.in[4][e + 1]; }
        if (c >= 1023) { v0 = 0.f; v1 = 0.f; }
        bf16* dst = (kv == 0 ? F.KC() : F.VC()) + ((size_t)g * 1024 + c) * 64 + e;
        *(unsigned*)dst = pk2(v0, v1);
    }
    LDS_WAIT(); __syncthreads();
}

template <int N> struct IntC { static constexpr int value = N; };
namespace att {
constexpr int SLOTB = 8192, NSLOT = 3;
constexpr int L_K = 0, L_V = NSLOT * SLOTB, L_SC = 2 * NSLOT * SLOTB, L_OUT = L_SC + 65536, L_LUT = L_OUT + 32768  , L_WSF = L_LUT + 4096, L_BM = L_WSF + 2048, L_REF = L_BM + 2048, L_LACC = L_REF + 1024, L_TL = L_LACC + 1024  , L_END = L_TL + 3072;
static_assert(L_END <= RING_BYTES, "attention LDS map");
constexpr int L_EX = 0  ,
              L_HDR = 69632  , L_LEX = 70144  , L_NT = 71168  ;
static_assert(L_NT + 32 <= L_SC + 65536, "part B exchange area");
constexpr float CLAMP = 100.0f;
constexpr float THR = 8.0f;
#define SBAR() __builtin_amdgcn_sched_barrier(0)
__device__ __forceinline__ int crow(int r, int hi) { return (r & 3) + 8 * (r >> 2) + 4 * hi; }
__device__ __forceinline__ void glds16(const void* gsrc, unsigned lds_dst) { unsigned keep;
    asm volatile("s_mov_b32 %0, m0\n\ts_mov_b32 m0, %2\n\ts_nop 0\n\tglobal_load_lds_dwordx4 %1, off\n\ts_mov_b32 m0, %0" : "=&s"(keep) : "v"(gsrc), "s"(lds_dst) : "memory"); }
__device__ __forceinline__ void qkt(f32x16& p0, f32x16& p1, const LAS unsigned char* Kslot, const bf16x8* qr, int r32, int hi) {
    const LAS unsigned char* kb = Kslot + hi * 1024 + r32 * 16;
    const f32x16 z = {0.f, 0.f, 0.f, 0.f, 0.f, 0.f, 0.f, 0.f, 0.f, 0.f, 0.f, 0.f, 0.f, 0.f, 0.f, 0.f};
#pragma unroll
    for (int d0 = 0; d0 < 4; ++d0) {
        const bf16x8 b0 = *(const LAS bf16x8*)(kb + d0 * 2048);
        const bf16x8 b1 = *(const LAS bf16x8*)(kb + d0 * 2048 + 512);
        if (d0 == 0) { p0 = __builtin_amdgcn_mfma_f32_32x32x16_bf16(b0, qr[0], z, 0, 0, 0); p1 = __builtin_amdgcn_mfma_f32_32x32x16_bf16(b1, qr[0], z, 0, 0, 0); }
        else { p0 = __builtin_amdgcn_mfma_f32_32x32x16_bf16(b0, qr[d0], p0, 0, 0, 0); p1 = __builtin_amdgcn_mfma_f32_32x32x16_bf16(b1, qr[d0], p1, 0, 0, 0); } }
}
__device__ __forceinline__ void pv(f32x16* o, int vb, bf16x8 pa0, bf16x8 pa1, bf16x8 pa2, bf16x8 pa3) {
    s16x4 lo[8], hi[8];
#pragma unroll
    for (int x = 0; x < 8; ++x) {
        asm volatile("ds_read_b64_tr_b16 %0,%1 offset:%c2" : "=&v"(lo[x]) : "v"(vb), "i"((x >> 2) * 4096 + (x & 3) * 1024) : "memory");
        asm volatile("ds_read_b64_tr_b16 %0,%1 offset:%c2" : "=&v"(hi[x]) : "v"(vb), "i"((x >> 2) * 4096 + (x & 3) * 1024 + 512) : "memory"); }
    asm volatile("s_waitcnt lgkmcnt(0)" ::: "memory"); SBAR();
#define PK(k) (bf16x8){lo[k][0], lo[k][1], lo[k][2], lo[k][3], hi[k][0], hi[k][1], hi[k][2], hi[k][3]}
    o[0] = __builtin_amdgcn_mfma_f32_32x32x16_bf16(pa0, PK(0), o[0], 0, 0, 0); o[1] = __builtin_amdgcn_mfma_f32_32x32x16_bf16(pa0, PK(4), o[1], 0, 0, 0);
    o[0] = __builtin_amdgcn_mfma_f32_32x32x16_bf16(pa1, PK(1), o[0], 0, 0, 0); o[1] = __builtin_amdgcn_mfma_f32_32x32x16_bf16(pa1, PK(5), o[1], 0, 0, 0);
    o[0] = __builtin_amdgcn_mfma_f32_32x32x16_bf16(pa2, PK(2), o[0], 0, 0, 0); o[1] = __builtin_amdgcn_mfma_f32_32x32x16_bf16(pa2, PK(6), o[1], 0, 0, 0);
    o[0] = __builtin_amdgcn_mfma_f32_32x32x16_bf16(pa3, PK(3), o[0], 0, 0, 0); o[1] = __builtin_amdgcn_mfma_f32_32x32x16_bf16(pa3, PK(7), o[1], 0, 0, 0);
#undef PK
}
__device__ __forceinline__ float rowmax(const f32x16& p0, const f32x16& p1) {
    float a = fmaxf(fmaxf(p0[0], p0[1]), p1[0]), b = fmaxf(fmaxf(p0[2], p0[3]), p1[1]); a = fmaxf(fmaxf(a, p1[2]), p1[3]);
#pragma unroll
    for (int r = 4; r < 16; r += 4) { a = fmaxf(fmaxf(a, p0[r]), p0[r + 1]); b = fmaxf(fmaxf(b, p0[r + 2]), p0[r + 3]); a = fmaxf(fmaxf(a, p1[r]), p1[r + 1]); b = fmaxf(fmaxf(b, p1[r + 2]), p1[r + 3]); }
    const float m = fmaxf(a, b);
    auto rr = __builtin_amdgcn_permlane32_swap(__float_as_uint(m), __float_as_uint(m), false, false);
    return fmaxf(__uint_as_float(rr[0]), __uint_as_float(rr[1]));
}
__device__ __forceinline__ float halfsum(float v) { auto rr = __builtin_amdgcn_permlane32_swap(__float_as_uint(v), __float_as_uint(v), false, false); return __uint_as_float(rr[0]) + __uint_as_float(rr[1]); }
template <int STEP, unsigned LIMIT>
__device__ __forceinline__ void near_apply(f32x16& p0, f32x16& p1, int dbase, const LAS float* lut) {
    float b0[16], b1[16];
#pragma unroll
    for (int r = 0; r < 16; ++r) { const int koff = (r & 3) + 8 * (r >> 2); const int d0 = dbase - STEP * koff, d1 = d0 - STEP * 32;
        b0[r] = lut[4 * min(max(d0, 0), 127)]; b1[r] = lut[4 * min(max(d1, 0), 127)]; }
#pragma unroll
    for (int r = 0; r < 16; ++r) { asm volatile("" : "+v"(b0[r]), "+v"(b1[r])); }
#pragma unroll
    for (int r = 0; r < 16; ++r) { const int koff = (r & 3) + 8 * (r >> 2); const int d0 = dbase - STEP * koff, d1 = d0 - STEP * 32;
        const float t0 = p0[r] + b0[r], t1 = p1[r] + b1[r];
        p0[r] = ((unsigned)d0 < LIMIT) ? t0 : -INFINITY; p1[r] = ((unsigned)d1 < LIMIT) ? t1 : -INFINITY; }
}
__device__ __forceinline__ void near_s1(f32x16& p0, f32x16& p1, int dbase, const LAS float* lutx  ) {
    const LAS float* bp = lutx + 4 * (dbase + 64 - 59);
    float b0[16], b1[16];
#pragma unroll
    for (int r = 0; r < 16; ++r) { const int koff = (r & 3) + 8 * (r >> 2); b0[r] = bp[4 * (59 - koff)]; b1[r] = bp[4 * (59 - koff - 32)]; }
#pragma unroll
    for (int r = 0; r < 16; ++r) { asm volatile("" : "+v"(b0[r]), "+v"(b1[r])); }
#pragma unroll
    for (int r = 0; r < 16; ++r) { p0[r] += b0[r]; p1[r] += b1[r]; }
}
__device__ __forceinline__ void edge_mask(f32x16& p0, f32x16& p1, int dbase) {
#pragma unroll
    for (int r = 0; r < 16; ++r) { const int koff = (r & 3) + 8 * (r >> 2); p0[r] = (dbase < 512 + koff) ? p0[r] : -INFINITY; p1[r] = (dbase < 512 + koff + 32) ? p1[r] : -INFINITY; }
}
template <bool HASO>
__device__ __forceinline__ void sm_update(f32x16& p0, f32x16& p1, float bias, float& m, float& l, f32x16* o, LAS float* wsf, int r32, int hi, bool nomax) {
    if (!nomax) {
    const float rm = rowmax(p0, p1) + bias;
    const bool need = rm > m + THR;
    if (__any(need)) {
        const float mn = need ? rm : m; const float alpha = __builtin_amdgcn_exp2f(m - mn);
        l *= alpha; m = mn;
        if (HASO) { if (hi == 0) wsf[r32] = alpha; LDS_WAIT();
#pragma unroll
            for (int r = 0; r < 16; ++r) { const float f = wsf[crow(r, hi)]; o[0][r] *= f; o[1][r] *= f; } }
    }
    }
    if (nomax) {
#pragma unroll
        for (int r = 0; r < 16; ++r) { p0[r] = __builtin_amdgcn_exp2f(p0[r]); p1[r] = __builtin_amdgcn_exp2f(p1[r]); }
    } else {
        const float mb = m - bias;
#pragma unroll
        for (int r = 0; r < 16; ++r) { p0[r] = __builtin_amdgcn_exp2f(p0[r] - mb); p1[r] = __builtin_amdgcn_exp2f(p1[r] - mb); }
    }
    float t[8];
#pragma unroll
    for (int r = 0; r < 8; ++r) t[r] = (p0[2 * r] + p0[2 * r + 1]) + (p1[2 * r] + p1[2 * r + 1]);
    l += ((t[0] + t[1]) + (t[2] + t[3])) + ((t[4] + t[5]) + (t[6] + t[7]));
}
#define SGB(mask, n) __builtin_amdgcn_sched_group_barrier(mask, n, 0)
template <int KIND, bool WITH_L = true>
__device__ __forceinline__ void tile_pipe(f32x16* o, float& l, const LAS unsigned char* Kslot, int vb, const bf16x8* qr, int r32, int hi, int dbase = 0, const LAS float* lutx = nullptr, f32x16* pout = nullptr) {
    const LAS unsigned char* kb = Kslot + hi * 1024 + r32 * 16;
    const LAS unsigned char* vp = (const LAS unsigned char*)(uintptr_t)(unsigned)vb;
    const f32x16 z = {0.f, 0.f, 0.f, 0.f, 0.f, 0.f, 0.f, 0.f, 0.f, 0.f, 0.f, 0.f, 0.f, 0.f, 0.f, 0.f};
    bf16x8 b0[4], b1[4];
#pragma unroll
    for (int d0 = 0; d0 < 4; ++d0) { b0[d0] = *(const LAS bf16x8*)(kb + d0 * 2048); b1[d0] = *(const LAS bf16x8*)(kb + d0 * 2048 + 512); }
    s16x4 lo[8], hv[8];
#pragma unroll
    for (int x = 0; x < 8; ++x) { lo[x] = __builtin_amdgcn_ds_read_tr16_b64_v4i16((LAS s16x4*)(vp + (x >> 2) * 4096 + (x & 3) * 1024)); hv[x] = __builtin_amdgcn_ds_read_tr16_b64_v4i16((LAS s16x4*)(vp + (x >> 2) * 4096 + (x & 3) * 1024 + 512)); }
    float bb0[16], bb1[16];
    if (KIND == 1) { const LAS float* bp = lutx + 4 * (dbase + 64 - 59);
#pragma unroll
        for (int r = 0; r < 16; ++r) { const int koff = (r & 3) + 8 * (r >> 2); bb0[r] = bp[4 * (59 - koff)]; bb1[r] = bp[4 * (59 - koff - 32)]; } }
#define SB() __builtin_amdgcn_sched_barrier(0)
#define PK(k) __builtin_bit_cast(bf16x8, __builtin_shufflevector(lo[k], hv[k], 0, 1, 2, 3, 4, 5, 6, 7))
    f32x16 p0 = __builtin_amdgcn_mfma_f32_32x32x16_bf16(b0[0], qr[0], z, 0, 0, 0);
#pragma unroll
    for (int d0 = 1; d0 < 4; ++d0) p0 = __builtin_amdgcn_mfma_f32_32x32x16_bf16(b0[d0], qr[d0], p0, 0, 0, 0);
    f32x16 p1 = __builtin_amdgcn_mfma_f32_32x32x16_bf16(b1[0], qr[0], z, 0, 0, 0);
    if (KIND == 1) {
#pragma unroll
        for (int r = 0; r < 16; ++r) p0[r] += bb0[r]; }
    if (KIND == 2) {
#pragma unroll
        for (int r = 0; r < 16; ++r) { const int koff = (r & 3) + 8 * (r >> 2); p0[r] = (dbase < 512 + koff) ? p0[r] : -INFINITY; } }
    SB();
#pragma unroll
    for (int d0 = 1; d0 < 4; ++d0) {
#pragma unroll
        for (int r = 0; r < 5; ++r) { const int rr = 5 * (d0 - 1) + r; p0[rr] = __builtin_amdgcn_exp2f(p0[rr]); }
        p1 = __builtin_amdgcn_mfma_f32_32x32x16_bf16(b1[d0], qr[d0], p1, 0, 0, 0); SB(); }
    p0[15] = __builtin_amdgcn_exp2f(p0[15]);
    if (KIND == 1) {
#pragma unroll
        for (int r = 0; r < 16; ++r) p1[r] += bb1[r]; }
    if (KIND == 2) {
#pragma unroll
        for (int r = 0; r < 16; ++r) { const int koff = (r & 3) + 8 * (r >> 2); p1[r] = (dbase < 512 + koff + 32) ? p1[r] : -INFINITY; } }
    const bf16x8 pa0 = __builtin_bit_cast(bf16x8, (u32x4){cvtpk(p0[0], p0[1]), cvtpk(p0[2], p0[3]), cvtpk(p0[4], p0[5]), cvtpk(p0[6], p0[7])});
    const bf16x8 pa1 = __builtin_bit_cast(bf16x8, (u32x4){cvtpk(p0[8], p0[9]), cvtpk(p0[10], p0[11]), cvtpk(p0[12], p0[13]), cvtpk(p0[14], p0[15])});
    SB();
    o[0] = __builtin_amdgcn_mfma_f32_32x32x16_bf16(pa0, PK(0), o[0], 0, 0, 0);
#pragma unroll
    for (int r = 0; r < 4; ++r) p1[r] = __builtin_amdgcn_exp2f(p1[r]);
    SB();
    o[1] = __builtin_amdgcn_mfma_f32_32x32x16_bf16(pa0, PK(4), o[1], 0, 0, 0);
#pragma unroll
    for (int r = 4; r < 8; ++r) p1[r] = __builtin_amdgcn_exp2f(p1[r]);
    SB();
    o[0] = __builtin_amdgcn_mfma_f32_32x32x16_bf16(pa1, PK(1), o[0], 0, 0, 0);
#pragma unroll
    for (int r = 8; r < 12; ++r) p1[r] = __builtin_amdgcn_exp2f(p1[r]);
    SB();
    o[1] = __builtin_amdgcn_mfma_f32_32x32x16_bf16(pa1, PK(5), o[1], 0, 0, 0);
#pragma unroll
    for (int r = 12; r < 16; ++r) p1[r] = __builtin_amdgcn_exp2f(p1[r]);
    SB();
    const bf16x8 pa2 = __builtin_bit_cast(bf16x8, (u32x4){cvtpk(p1[0], p1[1]), cvtpk(p1[2], p1[3]), cvtpk(p1[4], p1[5]), cvtpk(p1[6], p1[7])});
    const bf16x8 pa3 = __builtin_bit_cast(bf16x8, (u32x4){cvtpk(p1[8], p1[9]), cvtpk(p1[10], p1[11]), cvtpk(p1[12], p1[13]), cvtpk(p1[14], p1[15])});
    float t[8];
    o[0] = __builtin_amdgcn_mfma_f32_32x32x16_bf16(pa2, PK(2), o[0], 0, 0, 0);
    if (WITH_L) {
#pragma unroll
        for (int r = 0; r < 4; ++r) t[r] = (p0[2 * r] + p0[2 * r + 1]) + (p1[2 * r] + p1[2 * r + 1]); }
    SB();
    o[1] = __builtin_amdgcn_mfma_f32_32x32x16_bf16(pa2, PK(6), o[1], 0, 0, 0);
    if (WITH_L) {
#pragma unroll
        for (int r = 4; r < 8; ++r) t[r] = (p0[2 * r] + p0[2 * r + 1]) + (p1[2 * r] + p1[2 * r + 1]); }
    SB();
    o[0] = __builtin_amdgcn_mfma_f32_32x32x16_bf16(pa3, PK(3), o[0], 0, 0, 0);
    if (WITH_L) l += ((t[0] + t[1]) + (t[2] + t[3])) + ((t[4] + t[5]) + (t[6] + t[7]));
    if (pout) { pout[0] = p0; pout[1] = p1; }
    SB();
    o[1] = __builtin_amdgcn_mfma_f32_32x32x16_bf16(pa3, PK(7), o[1], 0, 0, 0);
#undef PK
#undef SB
}
#define ATT_PACK(P0, P1) \
    const bf16x8 pa0 = __builtin_bit_cast(bf16x8, (u32x4){cvtpk(P0[0], P0[1]), cvtpk(P0[2], P0[3]), cvtpk(P0[4], P0[5]), cvtpk(P0[6], P0[7])}); \
    const bf16x8 pa1 = __builtin_bit_cast(bf16x8, (u32x4){cvtpk(P0[8], P0[9]), cvtpk(P0[10], P0[11]), cvtpk(P0[12], P0[13]), cvtpk(P0[14], P0[15])}); \
    const bf16x8 pa2 = __builtin_bit_cast(bf16x8, (u32x4){cvtpk(P1[0], P1[1]), cvtpk(P1[2], P1[3]), cvtpk(P1[4], P1[5]), cvtpk(P1[6], P1[7])}); \
    const bf16x8 pa3 = __builtin_bit_cast(bf16x8, (u32x4){cvtpk(P1[8], P1[9]), cvtpk(P1[10], P1[11]), cvtpk(P1[12], P1[13]), cvtpk(P1[14], P1[15])});
#define ATT_WAITBAR(N) asm volatile("s_waitcnt vmcnt(" #N ") lgkmcnt(0)\n\ts_barrier" ::: "memory")
#define ATT_FILL(V, x) do { _Pragma("unroll") for (int _r = 0; _r < 16; ++_r) V[_r] = (x); } while (0)

__device__ __forceinline__ unsigned rangemask(int k, int a, int b) {
    const int lo = max(a - 32 * k, 0), hi = min(b - 32 * k, 31);
    return (lo > hi) ? 0u : ((0xFFFFFFFFu >> (31 - hi)) & (0xFFFFFFFFu << lo));
}
__device__ __forceinline__ int wave_max_i32(int x) {
    x = max(x, dpp_i<0xB1>(x)); x = max(x, dpp_i<0x4E>(x)); x = max(x, dpp_i<0x141>(x)); x = max(x, dpp_i<0x140>(x));
    return max(max(__builtin_amdgcn_readlane(x, 0), __builtin_amdgcn_readlane(x, 16)), max(__builtin_amdgcn_readlane(x, 32), __builtin_amdgcn_readlane(x, 48)));
}

__device__ __forceinline__ void lds_add_f32(LAS float* p, float v) { (void)__hip_atomic_fetch_add(p, v, __ATOMIC_RELAXED, __HIP_MEMORY_SCOPE_WORKGROUP); }

__device__ __forceinline__ void attn_item(const Frame& F, int qt, int g) {
    const int lane = lane_id(), wid = F.wave, tid = wid * 64 + lane, r32 = lane & 31, hi = lane >> 5;
    const int ql = r32 >> 2, h = r32 & 3, cur = qt, t = 64 * qt + 8 * wid + ql, head = 4 * g + h;
    LAS unsigned char* shm = F.lds;
    const unsigned lds0 = (unsigned)(uintptr_t)shm;
    LAS float* wsf = (LAS float*)(shm + L_WSF) + wid * 64;
    LAS float* SC = (LAS float*)(shm + L_SC);
    LAS float* OACC = (LAS float*)(shm + L_SC);
    LAS float* lutl = (LAS float*)(shm + L_LUT);
    const LAS float* luth = lutl + 256 + h;
    LAS unsigned* BM = (LAS unsigned*)(shm + L_BM);
    LAS float* REF = (LAS float*)(shm + L_REF);
    LAS float* LACC = (LAS float*)(shm + L_LACC);
    REG_T0(6);
    { const int h_ = tid >> 7, i_ = tid & 127;
      lutl[4 * i_ + h_] = (i_ < 64) ? -INFINITY : F.LUT()[(4 * g + h_) * 128 + i_ - 64];
      lutl[4 * (i_ + 128) + h_] = (i_ < 64) ? F.LUT()[(4 * g + h_) * 128 + i_ + 64] : 0.f; }
    BM[tid] = 0u;
    LAS u32x2* QL8 = (LAS u32x2*)(shm + L_OUT);
#pragma unroll
    for (int i = 0; i < 4; ++i) { const int slot = tid + 512 * i, q = slot >> 5, ks_ = (slot >> 4) & 1, gq_ = (slot >> 2) & 3, h_ = slot & 3;
        const u32x4 w = *(const u32x4*)(F.Q2() + (size_t)(64 * qt + q) * 512 + g * 256 + (2 * ks_ + (gq_ >> 1)) * 64 + h_ * 16 + 8 * (gq_ & 1));
        int w0 = __builtin_amdgcn_cvt_pk_fp8_f32(bflo(w.x), bfhi(w.x), 0, false); w0 = __builtin_amdgcn_cvt_pk_fp8_f32(bflo(w.y), bfhi(w.y), w0, true);
        int w1 = __builtin_amdgcn_cvt_pk_fp8_f32(bflo(w.z), bfhi(w.z), 0, false); w1 = __builtin_amdgcn_cvt_pk_fp8_f32(bflo(w.w), bfhi(w.w), w1, true);
        QL8[slot] = (u32x2){(unsigned)w0, (unsigned)w1}; }
    bf16x8 qr[4];
    { const bf16* qp = F.Q2() + (size_t)t * 512 + g * 256 + h * 16 + hi * 8;
#pragma unroll
        for (int d0 = 0; d0 < 4; ++d0) qr[d0] = *(const bf16x8*)(qp + d0 * 64); }
    constexpr float b31 = 0.f;
    const float gate_c = fsigmoid(bf2f(F.BR()[(size_t)t * 256 + head])), gate_s = fsigmoid(bf2f(F.BR()[(size_t)t * 256 + 8 + head])), gate_w = fsigmoid(bf2f(F.BR()[(size_t)t * 256 + 16 + head]));
    f32x16 o[2], p0, p1;
    float gate_cn = gate_c;
    const unsigned kdst = lds0 + L_K + wid * 1024, vdst = lds0 + L_V + wid * 1024;
    const int vrow = 16 * (wid & 3) + (lane >> 2), vcol = (wid >> 2) * 32 + (lane & 3) * 8;
    const int vb0 = (int)(lds0 + L_V) + ((lane >> 4) & 1) * 32 + (lane & 3) * 8 + (4 * hi + ((lane & 15) >> 2)) * 64;
#define DMA_K(base, pitch, row0, slot) glds16((base) + (size_t)((row0) + lane) * (pitch) + wid * 8, (unsigned)__builtin_amdgcn_readfirstlane(kdst + (slot)))
#define DMA_V(base, pitch, row0, slot) glds16((base) + (size_t)((row0) + vrow) * (pitch) + vcol, (unsigned)__builtin_amdgcn_readfirstlane(vdst + (slot)))
#define ROT() do { sl_cur = sl_next; sl_next = (sl_next == (NSLOT - 1) * SLOTB) ? 0 : sl_next + SLOTB; } while (0)
    VM_WAIT(); LDS_WAIT(); __syncthreads();

    REG_T1(6);
    const bf16* KCg = F.KC() + (size_t)g * 1024 * 64; const bf16* VCg = F.VC() + (size_t)g * 1024 * 64;
    const int nkt = (qt >> 4) + 1;
    const int tminw = 64 * qt + 8 * wid;
    const bool nomax = __builtin_amdgcn_readfirstlane(__float_as_int(F.LUT()[1024])) != 0;
    float m = nomax ? 0.f : -1e30f, l = 0.f;
    REG_T0(7);
    {
        int sl_cur = 0, sl_next = SLOTB;
        DMA_K(KCg, 64, 0, 0);
        for (int kt = 0; kt < nkt; ++kt) {
            if (kt + 1 < nkt) { DMA_K(KCg, 64, 64 * (kt + 1), sl_next); ATT_WAITBAR(1); } else { ATT_WAITBAR(0); }
            const bool far = (tminw - 31 - 16 * (64 * kt + 63)) >= 128;
            qkt(p0, p1, shm + L_K + sl_cur, qr, r32, hi);
            if (!far) near_apply<16, 0x80000000u>(p0, p1, t - 31 - 16 * (64 * kt + 4 * hi), luth);
            sm_update<false>(p0, p1, far ? b31 : 0.f, m, l, o, wsf, r32, hi, nomax);
            ROT();
        }
        LDS_WAIT(); __builtin_amdgcn_s_barrier();
    }
    REG_T1(7); REG_T0(8);
    {
        const float lt = halfsum(l); const float rl = lt > 0.f ? 1.0f / lt : 0.f;
        ATT_FILL(o[0], 0.f); ATT_FILL(o[1], 0.f);
        float carry = 0.f;
        int sl_cur = 0, sl_next = SLOTB;
        DMA_K(KCg, 64, 0, 0); DMA_V(VCg, 64, 0, 0);
        for (int kt = 0; kt < nkt; ++kt) {
            if (kt + 1 < nkt) { DMA_K(KCg, 64, 64 * (kt + 1), sl_next); DMA_V(VCg, 64, 64 * (kt + 1), sl_next); ATT_WAITBAR(2); } else { ATT_WAITBAR(0); }
            const bool far = (tminw - 31 - 16 * (64 * kt + 63)) >= 128;
            const bool piped = nomax && far;
            if (piped) { f32x16 pp[2]; float dl_ = 0.f; tile_pipe<0, false>(o, dl_, shm + L_K + sl_cur, vb0 + sl_cur, qr, r32, hi, 0, nullptr, pp); p0 = pp[0]; p1 = pp[1]; }
            else {
            qkt(p0, p1, shm + L_K + sl_cur, qr, r32, hi);
            if (!far) near_apply<16, 0x80000000u>(p0, p1, t - 31 - 16 * (64 * kt + 4 * hi), luth);
            if (nomax) {
#pragma unroll
                for (int r = 0; r < 16; ++r) { p0[r] = __builtin_amdgcn_exp2f(p0[r]); p1[r] = __builtin_amdgcn_exp2f(p1[r]); }
            } else {
#pragma unroll
                for (int r = 0; r < 16; ++r) { p0[r] = __builtin_amdgcn_exp2f(p0[r] - m) * rl; p1[r] = __builtin_amdgcn_exp2f(p1[r] - m) * rl; } }
            }
            {
                float q4[8], e[8];
#pragma unroll
                for (int i = 0; i < 4; ++i) { q4[i] = (p0[4 * i] + p0[4 * i + 1]) + (p0[4 * i + 2] + p0[4 * i + 3]); e[i] = p0[4 * i + 3];
                                              q4[4 + i] = (p1[4 * i] + p1[4 * i + 1]) + (p1[4 * i + 2] + p1[4 * i + 3]); e[4 + i] = p1[4 * i + 3]; }
                float newcarry = 0.f;
#pragma unroll
                for (int i = 0; i < 8; ++i) { auto rr = __builtin_amdgcn_permlane32_swap(__float_as_uint(e[i]), __float_as_uint(e[i]), false, false);
                    const float elo = __uint_as_float(rr[0]), ehi = __uint_as_float(rr[1]);
                    if (hi) q4[i] += elo; else if (i < 7) q4[i + 1] += ehi;
                    if (i == 7) newcarry = ehi; }
                if (!hi) q4[0] += carry;
                carry = newcarry;
                if (nomax) {
#pragma unroll
                    for (int i = 0; i < 8; ++i) q4[i] *= rl; }
#pragma unroll
                for (int i = 0; i < 8; ++i) { float v = q4[i]; v += dpp_f<0xB1>(v); v += dpp_f<0x4E>(v); q4[i] = v; }
                if (h == 0) {
#pragma unroll
                    for (int i = 0; i < 8; ++i) SC[(8 * wid + ql) * 256 + 16 * kt + 2 * i + hi] = q4[i]; }
            }
            if (!piped) { ATT_PACK(p0, p1); pv(o, vb0 + sl_cur, pa0, pa1, pa2, pa3); }
            ROT();
        }
        LDS_WAIT(); __builtin_amdgcn_s_barrier();
        if (nomax) gate_cn = gate_c * rl;
    }

    REG_T1(8); REG_T0(9);
    if (cur >= 16) {
        const int u4 = lane >> 4, li16 = lane & 15;
        auto topk = [&](auto nr_) {
            constexpr int NREG = decltype(nr_)::value;
#pragma unroll 1
            for (int qb = 0; qb < 8; qb += 4) {
                const int qloc = 8 * wid + qb + u4;
                const LAS float* row = SC + qloc * 256 + li16;
                constexpr int NS = NREG <= 4 ? 4 : (NREG <= 8 ? 8 : 16), KEEP = NS < 13 ? NS : 13;
                int v[NS];
#pragma unroll
                for (int k = 0; k < NS; ++k) { if (k < NREG) { const int J = li16 + 16 * k; const int x = (__float_as_int(row[16 * k]) & ~255) | (255 - J); v[k] = (J >= 1 && J <= cur - 2) ? x : -1; } else v[k] = -1; }
#pragma unroll
                for (int k = 2; k <= NS; k <<= 1) {
#pragma unroll
                    for (int j = k >> 1; j > 0; j >>= 1) {
#pragma unroll
                        for (int i = 0; i < NS; ++i) { const int l2 = i ^ j;
                            if (l2 > i) { const int a = v[i], b = v[l2]; const int mx = max(a, b), mn = min(a, b); const bool desc = ((i & k) == 0); v[i] = desc ? mx : mn; v[l2] = desc ? mn : mx; } }
                    }
                }
                LAS unsigned* bmq = BM + (qloc >> 5); const unsigned qbit = 1u << (qloc & 31);
#pragma unroll 1
                for (int round = 0; round < 13; ++round) {
                    int rm = v[0]; rm = max(rm, dpp_m<0xB1>(rm)); rm = max(rm, dpp_m<0x4E>(rm)); rm = max(rm, dpp_m<0x141>(rm)); rm = max(rm, dpp_m<0x140>(rm));
                    if (v[0] == rm) {
                        __hip_atomic_fetch_or(bmq + 2 * (255 - (rm & 255)), qbit, __ATOMIC_RELAXED, __HIP_MEMORY_SCOPE_WORKGROUP);
#pragma unroll
                        for (int k = 0; k + 1 < KEEP; ++k) { v[k] = v[k + 1]; asm volatile("" : "+v"(v[k])); }
                        v[KEEP - 1] = -1;
                    }
                }
            }
        };
        if (cur - 2 < 64) topk(IntC<4>{}); else if (cur - 2 < 128) topk(IntC<8>{}); else if (cur - 2 < 192) topk(IntC<12>{}); else topk(IntC<16>{});
    }
    LDS_WAIT();
    LAS float* ostg = (LAS float*)(shm + L_SC) + wid * 2048;
    {
        if (hi == 0) wsf[r32] = gate_cn; LDS_WAIT();
#pragma unroll
        for (int r = 0; r < 16; ++r) { const float f = wsf[crow(r, hi)]; const int orow = crow(r, hi); ostg[orow * 64 + r32] = o[0][r] * f; ostg[orow * 64 + 32 + r32] = o[1][r] * f; }
    }

    REG_T1(9); REG_T0(10);
    const bf16* Kw = F.KV() + 512 + g * 64; const bf16* Vw = F.KV() + 640 + g * 64;
    {
        m = nomax ? 0.f : -1e30f; l = 0.f; ATT_FILL(o[0], 0.f); ATT_FILL(o[1], 0.f);
        const int J0 = max(cur - 8, 0);
        int sl_cur = 0, sl_next = SLOTB;
        DMA_K(Kw, 768, 64 * J0, 0); DMA_V(Vw, 768, 64 * J0, 0);
        for (int J = J0; J <= cur; ++J) {
            if (J + 1 <= cur) { DMA_K(Kw, 768, 64 * (J + 1), sl_next); DMA_V(Vw, 768, 64 * (J + 1), sl_next); ATT_WAITBAR(2); } else { ATT_WAITBAR(0); }
            const bool nearw = (J >= cur - 2 || J == cur - 8);
            if (nomax && !nearw) tile_pipe<0>(o, l, shm + L_K + sl_cur, vb0 + sl_cur, qr, r32, hi);
            else if (nomax && J >= cur - 2) tile_pipe<1>(o, l, shm + L_K + sl_cur, vb0 + sl_cur, qr, r32, hi, t - 64 * J - 4 * hi, lutl + h);
            else if (nomax) tile_pipe<2>(o, l, shm + L_K + sl_cur, vb0 + sl_cur, qr, r32, hi, t - 64 * J - 4 * hi);
            else {
            qkt(p0, p1, shm + L_K + sl_cur, qr, r32, hi);
            if (J >= cur - 2) near_s1(p0, p1, t - 64 * J - 4 * hi, lutl + h); else if (nearw) edge_mask(p0, p1, t - 64 * J - 4 * hi);
            sm_update<true>(p0, p1, nearw ? 0.f : b31, m, l, o, wsf, r32, hi, nomax);
            { ATT_PACK(p0, p1); pv(o, vb0 + sl_cur, pa0, pa1, pa2, pa3); }
            }
            ROT();
        }
        LDS_WAIT(); __builtin_amdgcn_s_barrier();
        const float lt = halfsum(l); const float fw = lt > 0.f ? gate_w / lt : 0.f;
        if (hi == 0) wsf[r32] = fw; LDS_WAIT();
#pragma unroll
        for (int r = 0; r < 16; ++r) { const float f = wsf[crow(r, hi)]; const int orow = crow(r, hi); ostg[orow * 64 + r32] += o[0][r] * f; ostg[orow * 64 + 32 + r32] += o[1][r] * f; }
        LDS_WAIT();
#pragma unroll
        for (int i = 0; i < 4; ++i) { const int rowl = i * 8 + (lane >> 3), chn = lane & 7;
            const f32x4 a0 = *(const LAS f32x4*)(ostg + rowl * 64 + chn * 8), a1 = *(const LAS f32x4*)(ostg + rowl * 64 + chn * 8 + 4);
            const size_t tt = (size_t)(64 * qt + 8 * wid + (rowl >> 2)); const int col = (4 * g + (rowl & 3)) * 64 + chn * 8;
            *(u32x4*)(F.XN() + tt * 1024 + col) = (u32x4){cvtpk(a0[0], a0[1]), cvtpk(a0[2], a0[3]), cvtpk(a1[0], a1[1]), cvtpk(a1[2], a1[3])}; }
        LDS_WAIT();
    }

    REG_T1(10); REG_T0(11);
    const bf16* Ks = F.KV() + 256 + g * 64; const bf16* Vs = F.KV() + 384 + g * 64;
    {
        m = nomax ? 0.f : -1e30f; l = 0.f; ATT_FILL(o[0], 0.f); ATT_FILL(o[1], 0.f);
        const int nA = (cur < 16) ? cur + 1 : 3;
#define JA(i) ((cur < 16) ? (i) : ((i) == 0 ? 0 : cur - 2 + (i)))
        int sl_cur = 0, sl_next = SLOTB;
        DMA_K(Ks, 768, 0, 0); DMA_V(Vs, 768, 0, 0);
        for (int i = 0; i < nA; ++i) {
            const int J = JA(i);
            if (i + 1 < nA) { const int Jn = JA(i + 1); DMA_K(Ks, 768, 64 * Jn, sl_next); DMA_V(Vs, 768, 64 * Jn, sl_next); ATT_WAITBAR(2); } else { ATT_WAITBAR(0); }
            const bool neara = (J >= cur - 2);
            if (nomax && !neara) tile_pipe<0>(o, l, shm + L_K + sl_cur, vb0 + sl_cur, qr, r32, hi);
            else if (nomax) tile_pipe<1>(o, l, shm + L_K + sl_cur, vb0 + sl_cur, qr, r32, hi, t - 64 * J - 4 * hi, lutl + h);
            else {
            qkt(p0, p1, shm + L_K + sl_cur, qr, r32, hi);
            if (neara) near_s1(p0, p1, t - 64 * J - 4 * hi, lutl + h);
            sm_update<true>(p0, p1, neara ? 0.f : b31, m, l, o, wsf, r32, hi, nomax);
            { ATT_PACK(p0, p1); pv(o, vb0 + sl_cur, pa0, pa1, pa2, pa3); }
            }
            ROT();
        }
#undef JA
        LDS_WAIT(); __builtin_amdgcn_s_barrier();
        const float lt = halfsum(l);
        if (hi == 0) { REF[32 * wid + r32] = m; LACC[32 * wid + r32] = lt; }
#pragma unroll
        for (int r = 0; r < 16; ++r) { const int orow = 32 * wid + crow(r, hi); OACC[orow * 64 + r32] = o[0][r]; OACC[orow * 64 + 32 + r32] = o[1][r]; }
        LDS_WAIT(); __builtin_amdgcn_s_barrier();
    }

    REG_T1(11); REG_T0(12);
    if (cur >= 16) {
        const int c16 = lane & 15, gq = lane >> 4, qi4 = c16 >> 2;
        float oa[2][16], la2[2];
        { const int li_ = lane & 15, hsel_ = li_ >> 2, dq_ = (li_ & 3) * 16;
#pragma unroll
            for (int p = 0; p < 2; ++p) { la2[p] = 0.f; const LAS f32x4* ap = (const LAS f32x4*)(OACC + (4 * (8 * wid + 4 * p + gq) + hsel_) * 64 + dq_);
#pragma unroll
                for (int k = 0; k < 4; ++k) { const f32x4 a = ap[k]; oa[p][4 * k] = a[0]; oa[p][4 * k + 1] = a[1]; oa[p][4 * k + 2] = a[2]; oa[p][4 * k + 3] = a[3]; } } }
        LDS_WAIT(); __builtin_amdgcn_s_barrier();
        if (tid < 128) ((LAS unsigned*)(shm + L_HDR))[tid] = 0u;
        typedef long i64_t;
        const i64_t* KTg = (const i64_t*)F.KT() + (size_t)g * 256 * 512 + gq * 16 + c16; const bf16* VTg = F.VT() + (size_t)g * 256 * 4096 + c16 * 32 + 8 * gq;
        const LAS i64_t* QLg = (const LAS i64_t*)QL8 + gq * 4 + h;
        LAS unsigned* TL = (LAS unsigned*)(shm + L_TL) + wid * 96;
        int tot_ = 0;
#pragma unroll
        for (int i4 = 0; i4 < 4; ++i4) { const int Jl = lane + 64 * i4; if (Jl >= 1 && Jl <= cur - 2) tot_ += (__popc(BM[2 * Jl]) + __popc(BM[2 * Jl + 1]) + 3) >> 2; }
        const int T_ = __builtin_amdgcn_readfirstlane((int)(wave_sum((float)tot_) + 0.5f));
        const int nround = (T_ + 7) >> 3; const int tlo = wid * nround; const int ntask = max(0, min(T_ - tlo, nround));
        int run_ = 0;
#pragma unroll 1
        for (int i4 = 0; i4 < 4 && 64 * i4 <= cur - 2; ++i4) {
            const int Jl = lane + 64 * i4; int nch = 0;
            unsigned long long mk = 0ull;
            if (Jl >= 1 && Jl <= cur - 2) { mk = ((unsigned long long)BM[2 * Jl + 1] << 32) | BM[2 * Jl]; nch = (__popcll(mk) + 3) >> 2; }
            int incl = nch;
#pragma unroll
            for (int o = 1; o < 64; o <<= 1) { const int up = __shfl_up(incl, o); if (lane >= o) incl += up; }
            const int base = run_ + incl - nch - tlo;
            for (int c = 0; c < nch; ++c) { unsigned e = (unsigned)Jl; int q0 = 0;
#pragma unroll
                for (int k = 0; k < 4; ++k) { int q = q0; if (mk) { q = __builtin_ctzll(mk); mk &= mk - 1; } if (k == 0) q0 = q; e |= (unsigned)q << (8 + 6 * k); }
                if ((unsigned)(base + c) < (unsigned)ntask) TL[base + c] = e; }
            run_ += __builtin_amdgcn_readlane(incl, 63);
        }
        LAS float* EX = (LAS float*)(shm + L_EX); LAS unsigned* QM = (LAS unsigned*)(shm + L_HDR); LAS float* LEX = (LAS float*)(shm + L_LEX);
        LDS_WAIT(); __builtin_amdgcn_s_barrier();
        i64_t kfC[8], kfN[8]; bf16x8 vfC[8]; bool kpend = false;
#define LOADK(J_, KF) do { const i64_t* kp_ = KTg + (size_t)(J_) * 512; \
            _Pragma("unroll") for (int kt = 0; kt < 4; ++kt) { KF[2 * kt] = kp_[kt * 64]; KF[2 * kt + 1] = kp_[256 + kt * 64]; } } while (0)
#define LOADV(J_, VF) do { const bf16* vp_ = VTg + (size_t)(J_) * 4096; _Pragma("unroll") for (int x = 0; x < 8; ++x) VF[x] = *(const bf16x8*)(vp_ + x * 512); } while (0)
        unsigned e_cur = 0xffu;
        i64_t qg0 = 0, qg1 = 0; float ref = 0.f;
#define QFETCH(E) do { const int mq_ = ((E) >> (8 + 6 * qi4)) & 63; const LAS i64_t* qp_ = QLg + mq_ * 32; qg0 = qp_[0]; qg1 = qp_[16]; ref = REF[4 * mq_ + h]; } while (0)
        if (ntask > 0) { e_cur = (unsigned)__builtin_amdgcn_readfirstlane((int)TL[0]); LOADK(e_cur & 255u, kfC); LOADV(e_cur & 255u, vfC); QFETCH(e_cur); }
        unsigned tl1 = (ntask > 1) ? TL[1] : 0xffu;
#define OWNER_PASS(M0, M1, B) do { const int li_ = lane & 15, hsel_ = li_ >> 2, dq_ = (li_ & 3) * 16; \
            _Pragma("unroll") for (int pass = 0; pass < 2; ++pass) { \
                unsigned mm = pass ? (M1) : (M0); \
                while (mm) { const int e = __builtin_ctz(mm); mm &= mm - 1; \
                    const LAS f32x4* xr = (const LAS f32x4*)(EX + (B) * 8704 + (e * 4 + hsel_) * 68 + dq_); \
                    const f32x4 y0 = xr[0], y1 = xr[1], y2 = xr[2], y3 = xr[3]; \
                    oa[pass][0] += y0[0]; oa[pass][1] += y0[1]; oa[pass][2] += y0[2]; oa[pass][3] += y0[3]; oa[pass][4] += y1[0]; oa[pass][5] += y1[1]; oa[pass][6] += y1[2]; oa[pass][7] += y1[3]; \
                    oa[pass][8] += y2[0]; oa[pass][9] += y2[1]; oa[pass][10] += y2[2]; oa[pass][11] += y2[3]; oa[pass][12] += y3[0]; oa[pass][13] += y3[1]; oa[pass][14] += y3[2]; oa[pass][15] += y3[3]; \
                    la2[pass] += LEX[(B) * 128 + e * 4 + hsel_]; } } } while (0)
#pragma unroll 1
        for (int n = 0; n < nround; ++n) {
            const int buf = n & 1;
            unsigned qm0 = 0u, qm1 = 0u;
            if (n > 0) { qm0 = QM[(buf ^ 1) * 64 + 8 * wid + gq]; qm1 = QM[(buf ^ 1) * 64 + 8 * wid + 4 + gq]; }
            if (n < ntask) {
                const unsigned e_nxt = (n + 1 < ntask) ? (unsigned)__builtin_amdgcn_readfirstlane((int)tl1) : 0xffu;
                tl1 = (n + 2 < ntask) ? TL[n + 2] : 0xffu;
                const unsigned e_ = e_cur; const int Jb = e_ & 255, Jn = e_nxt & 255; const bool reload = (Jn != Jb) && (Jn != 255);
                const int q0_ = (e_ >> 8) & 63;
                const int myq = (e_ >> (8 + 6 * qi4)) & 63; const bool valid = (qi4 == 0) || (myq != q0_); const int tq = 64 * qt + myq;
                const bool nearJ = (Jb >= cur - 2);
                const float cinit = nearJ ? 0.f : (valid ? b31 - ref : -INFINITY);
                if (kpend) {
#pragma unroll
                    for (int x = 0; x < 8; ++x) kfC[x] = kfN[x];
                    kpend = false; }
                if (reload) { LOADK(Jn, kfN); kpend = true; }
                f32x4 s[4]; const f32x4 cv = (f32x4){cinit, cinit, cinit, cinit};
#pragma unroll
                for (int kt = 0; kt < 4; ++kt) { s[kt] = cv;
                    s[kt] = __builtin_amdgcn_mfma_f32_16x16x32_fp8_fp8(kfC[2 * kt], qg0, s[kt], 0, 0, 0); s[kt] = __builtin_amdgcn_mfma_f32_16x16x32_fp8_fp8(kfC[2 * kt + 1], qg1, s[kt], 0, 0, 0); }
                const float refc = ref;
                if (n + 1 < ntask) QFETCH(e_nxt);
                if (nearJ) { const float sub = valid ? refc : INFINITY;
                    float bb[16];
#pragma unroll
                    for (int kt = 0; kt < 4; ++kt)
#pragma unroll
                        for (int r = 0; r < 4; ++r) { const int dd = tq - 64 * Jb - (16 * kt + 4 * gq + r); bb[kt * 4 + r] = luth[4 * min(max(dd, 0), 127)]; }
#pragma unroll
                    for (int x = 0; x < 16; ++x) asm volatile("" : "+v"(bb[x]));
#pragma unroll
                    for (int kt = 0; kt < 4; ++kt)
#pragma unroll
                        for (int r = 0; r < 4; ++r) { const int dd = tq - 64 * Jb - (16 * kt + 4 * gq + r); const float tt = s[kt][r] + bb[kt * 4 + r] - sub;
                            s[kt][r] = (dd >= 0) ? tt : -INFINITY; } }
#pragma unroll
                for (int kt = 0; kt < 4; ++kt)
#pragma unroll
                    for (int r = 0; r < 4; ++r) s[kt][r] = __builtin_amdgcn_exp2f(s[kt][r]);
                bf16x8 pb[2];
#pragma unroll
                for (int ks = 0; ks < 2; ++ks) pb[ks] = __builtin_bit_cast(bf16x8, (u32x4){cvtpk(s[2 * ks][0], s[2 * ks][1]), cvtpk(s[2 * ks][2], s[2 * ks][3]), cvtpk(s[2 * ks + 1][0], s[2 * ks + 1][1]), cvtpk(s[2 * ks + 1][2], s[2 * ks + 1][3])});
                float ls;
                { const bf16x8 ones = __builtin_bit_cast(bf16x8, (u32x4){0x3F803F80u, 0x3F803F80u, 0x3F803F80u, 0x3F803F80u});
                  f32x4 sm_ = (f32x4){0.f, 0.f, 0.f, 0.f};
                  sm_ = __builtin_amdgcn_mfma_f32_16x16x32_bf16(ones, pb[0], sm_, 0, 0, 0); sm_ = __builtin_amdgcn_mfma_f32_16x16x32_bf16(ones, pb[1], sm_, 0, 0, 0); ls = sm_[0]; }
                LAS float* ex = EX + buf * 8704 + ((wid * 4 + qi4) * 4 + h) * 68 + 4 * gq;
                f32x4 ot[4];
#pragma unroll
                for (int mt = 0; mt < 4; ++mt) { ot[mt] = (f32x4){0.f, 0.f, 0.f, 0.f};
                    ot[mt] = __builtin_amdgcn_mfma_f32_16x16x32_bf16(vfC[2 * mt], pb[0], ot[mt], 0, 0, 0); ot[mt] = __builtin_amdgcn_mfma_f32_16x16x32_bf16(vfC[2 * mt + 1], pb[1], ot[mt], 0, 0, 0); }
                if (reload) LOADV(Jn, vfC);
#pragma unroll
                for (int mt = 0; mt < 4; ++mt) *(LAS f32x4*)(ex + 16 * mt) = ot[mt];
                if (gq == 0) { LEX[buf * 128 + wid * 16 + c16] = ls; if (h == 0 && valid) __hip_atomic_fetch_or(QM + buf * 64 + myq, 1u << (wid * 4 + qi4), __ATOMIC_RELAXED, __HIP_MEMORY_SCOPE_WORKGROUP); }
                e_cur = e_nxt;
            }
            OWNER_PASS(qm0, qm1, buf ^ 1);
            if (n > 0 && (lane & 15) == 0) { QM[(buf ^ 1) * 64 + 8 * wid + gq] = 0u; QM[(buf ^ 1) * 64 + 8 * wid + 4 + gq] = 0u; }
            LDS_WAIT(); __builtin_amdgcn_s_barrier();
        }
        if (nround > 0) { const int lb = (nround - 1) & 1; const unsigned l0 = QM[lb * 64 + 8 * wid + gq], l1 = QM[lb * 64 + 8 * wid + 4 + gq]; OWNER_PASS(l0, l1, lb); }
#undef OWNER_PASS
        LDS_WAIT(); __builtin_amdgcn_s_barrier();
        {
            const int li = lane & 15, hsel = li >> 2, dq = (li & 3) * 16;
#pragma unroll
            for (int pass = 0; pass < 2; ++pass) { const int q = 8 * wid + 4 * pass + gq; LAS f32x4* ap = (LAS f32x4*)(OACC + (4 * q + hsel) * 64 + dq);
#pragma unroll
                for (int k = 0; k < 4; ++k) ap[k] = (f32x4){oa[pass][4 * k], oa[pass][4 * k + 1], oa[pass][4 * k + 2], oa[pass][4 * k + 3]};
                if ((li & 3) == 0) LACC[4 * q + hsel] += la2[pass]; }
        }
#undef LOADK
#undef LOADV
#undef QFETCH
    }
    LDS_WAIT(); __builtin_amdgcn_s_barrier();

    REG_T1(12); REG_T0(13);
    {
        if (hi == 0) { const float lt = LACC[32 * wid + r32]; wsf[r32] = lt > 0.f ? gate_s / lt : 0.f; }
        LDS_WAIT();
#pragma unroll
        for (int i = 0; i < 4; ++i) { const int rowl = i * 8 + (lane >> 3), chn = lane & 7, row = 32 * wid + rowl;
            const float f = wsf[rowl];
            const f32x4 a0 = *(const LAS f32x4*)(OACC + row * 64 + chn * 8), a1 = *(const LAS f32x4*)(OACC + row * 64 + chn * 8 + 4);
            const size_t tt = (size_t)(64 * qt + 8 * wid + (rowl >> 2)); const int col = (4 * g + (rowl & 3)) * 64 + chn * 8;
            const u32x4 ov = *(const u32x4*)(F.XN() + tt * 1024 + col);
            const u32x4 gn = __builtin_nontemporal_load((const u32x4*)(F.GN() + tt * 512 + col));
            u32x4 w; w.x = pk2((bflo(ov.x) + a0[0] * f) * bflo(gn.x), (bfhi(ov.x) + a0[1] * f) * bfhi(gn.x)); w.y = pk2((bflo(ov.y) + a0[2] * f) * bflo(gn.y), (bfhi(ov.y) + a0[3] * f) * bfhi(gn.y));
            w.z = pk2((bflo(ov.z) + a1[0] * f) * bflo(gn.z), (bfhi(ov.z) + a1[1] * f) * bfhi(gn.z)); w.w = pk2((bflo(ov.w) + a1[2] * f) * bflo(gn.w), (bfhi(ov.w) + a1[3] * f) * bfhi(gn.w));
            *(u32x4*)(F.XN() + tt * 1024 + col) = w; }
        VM_WAIT(); LDS_WAIT(); __syncthreads();
    }
    REG_T1(13);
#undef DMA_K
#undef DMA_V
#undef ROT
}
}

__global__ void __launch_bounds__(NWAVES * 64, 2) nsa_lru_fwd(Args args) {
    extern __shared__ __attribute__((aligned(16))) unsigned char lds[];
    Frame F;
    F.lds = (LAS unsigned char*)lds;
    F.MISC = (volatile LAS unsigned*)(F.lds + MISC_OFF);
    F.wave = __builtin_amdgcn_readfirstlane((int)(threadIdx.x >> 6));
    F.G = gridDim.x; { const int bx = blockIdx.x; F.vcu = (F.G % 8 == 0) ? (bx % 8) * (F.G / 8) + bx / 8 : bx; }
    F.ws = args.ws;
    gu32* ctl = (gu32*)(args.ws + WS_CTL);
    for (int u = F.wave * 64 + lane_id(); u < (LDS_BYTES - LDSCTL_OFF) / 4; u += NWAVES * 64) ((LAS unsigned*)(F.lds + LDSCTL_OFF))[u] = 0u;
    __syncthreads();
    const int bli = (N_LAUNCHES == PER_PHASE) ? 0 : args.li;
    XcdBarrier bar; bar.bar = (unsigned*)(ctl + CW_BAR) + bli * XCD_BAR_WORDS; bar.x = 0; bar.st = nullptr;
    if (N_LAUNCHES != PER_PHASE) bar = xcd_barrier_post((unsigned*)(ctl + CW_BAR) + bli * XCD_BAR_WORDS, F.MISC + 8);
    if (threadIdx.x == 0) __hip_atomic_store((unsigned*)(ctl + CW_XCC) + F.vcu, xb_xcc_id() + 1u, RLX_AGENT);
#define GRID_BAR() do { if (N_LAUNCHES != PER_PHASE) xcd_barrier(bar); } while (0)
    const int lo = args.ph_lo, hi = args.ph_hi;
    bool df = false;
#define IN(k) (lo <= (k) && (k) < hi)
#define BOTH(k) (IN(k) && IN((k) + 1))

    unsigned long long pt0 = 0ull;
#define PH_T0(k) do { if (PROBE_IDLE == (k)) pt0 = wall_clock64(); } while (0)
#define PH_T1(k) do { if (PROBE_IDLE == (k)) { __syncthreads(); if (threadIdx.x == 0) __hip_atomic_store((unsigned*)(ctl + 12288) + F.vcu, (unsigned)(wall_clock64() - pt0), __ATOMIC_RELAXED, __HIP_MEMORY_SCOPE_AGENT); } } while (0)
    if (IN(0)) { PH_T0(0); p0_prologue(F, args); PH_T1(0); if (BOTH(0)) GRID_BAR(); }

    if (IN(1)) {
        PH_T0(1);
        if (N_LAUNCHES != PER_PHASE && PROBE_DUP < 0) {
            bool ok = (F.G == 256);
            if (ok) {
#pragma unroll
                for (int q = 0; q < 4; ++q) { const int v = 4 * lane_id() + q; const unsigned a = xb_ld((unsigned*)(ctl + CW_XCC) + v), b = xb_ld((unsigned*)(ctl + CW_XCC) + (v & ~31)); ok = ok && (a == b) && (a != 0u); }
            }
            df = (__builtin_amdgcn_ballot_w64(ok) == ~0ull);
        }
        pg8::Gemm g{F.XN(), F.WinT(), F.XN(), F.WinT(), 1024, 1024, 1024}; pg8::StaticOrder S; S.init(SEQ, NPROJ, F.G, (int)blockIdx.x);
        pg8::EpiProj E{F.Q(), F.KV(), F.U(), F.BR(), F.GN(), F.GL(), F.MG()};
        pg8::gemm_phase<pg8::EpiProj, pg8::StaticOrder, true>(F.lds, g, S, E, F.wave);
        {
            asm volatile("s_waitcnt vmcnt(0)" ::: "memory");
            __syncthreads();
            if (threadIdx.x == 0) { unsigned* flagP = (unsigned*)(ctl + CW_FLAGP); pg8::Unit u; bool rel = false;
                for (int i = 0; S.next(i, u); ++i) if (u.pn == 2 && (u.pm & 7) == 0 && u.pm > 0) rel = true;
                if (rel) { __builtin_amdgcn_fence(__ATOMIC_RELEASE, "agent"); asm volatile("s_waitcnt vmcnt(0)" ::: "memory"); }
                for (int i = 0; S.next(i, u); ++i) { (void)xb_add(flagP + u.pm, 1u); if (u.pn == 2 && (u.pm & 7) == 0 && u.pm > 0) (void)xb_add(flagP + 64 + u.pm, 1u); } }
        }
        PH_T1(1);
        if (BOTH(1) && !df) GRID_BAR();
    }

    if (IN(2)) {
        PH_T0(2);
        for (int i = F.vcu; i < 256; i += F.G) {
            if (df) flag_wait((unsigned*)(ctl + CW_FLAGP) + (i >> 2), 20u);
            REG_T0(1); lru_tile<false>(F, args, i); REG_T1(1);
            REG_T0(2); if (!args.pad) qk_norm_tile(F, args, i); REG_T1(2);
            REG_T0(3); vt_tile(F, i); REG_T1(3);
            __syncthreads();
            if (df && ((i >> 2) & 7) == 7 && (i >> 2) < 63) {
                flag_wait((unsigned*)(ctl + CW_FLAGP) + 64 + (i >> 2) + 1, 1u);
                if (threadIdx.x == 0) { __builtin_amdgcn_fence(__ATOMIC_ACQUIRE, "agent"); asm volatile("s_waitcnt vmcnt(0)" ::: "memory"); }
                __syncthreads(); }
            REG_T0(4); compress_item(F, args, i & 1, (i >> 1) & 1, i >> 2); REG_T1(4);
        }
        PH_T1(2);
        if (BOTH(2)) GRID_BAR();
    }

    if (IN(3)) {
        PH_T0(3);
        unsigned* flagA = (unsigned*)(ctl + CW_FLAGA);
#pragma unroll 1
        for (int it = F.vcu; it < 256; it += F.G) {
            const int k = it >> 5, sel = (it >> 4) & 1, qlo = 16 * k + (it & 15), qhi = 255 - qlo;
            { const int tt = sel ? qhi : qlo; REG_T0(5); lru_apply(F, tt); REG_T1(5); flag_signal((unsigned*)(ctl + CW_FLAGL) + (tt >> 2)); }
#pragma unroll 1
            for (int j = 0; j < 2; ++j) { const int qt = j ? qlo : qhi; att::attn_item(F, qt, (j ^ sel) ? 0 : 1); flag_signal(flagA + (qt >> 2)); }
        }
        PH_T1(3);
        if (BOTH(3) && !df) GRID_BAR();
    }

    if (IN(4)) {
        PH_T0(4);
        pg8::Gemm g{F.XN(), F.WaT(), F.XN() + 512, F.WbT(), 1024, 512, 512};
        unsigned* flagA = (unsigned*)(ctl + CW_FLAGA); unsigned* flagB = (unsigned*)(ctl + CW_FLAGB); unsigned* flagL = (unsigned*)(ctl + CW_FLAGL);
        if (df) {
            pg8::XPartOrder S1; S1.init(F.G, (int)blockIdx.x); S1.part = 1; pg8::EpiMerge E1{F.MB(), F.MG(), 1};
            { pg8::Unit u; for (int i = 0; S1.tile((long)i * F.G + (int)blockIdx.x, u); ++i) flag_wait(flagL + u.pm, 4u); }
            pg8::gemm_phase<pg8::EpiMerge, pg8::XPartOrder, true>(F.lds, g, S1, E1, F.wave);
            pg8::XPartOrder S0; S0.init(F.G, (int)blockIdx.x); S0.part = 0;
            { pg8::Unit u; for (int i = 0; S0.tile((long)i * F.G + (int)blockIdx.x, u); ++i) flag_wait(flagA + u.pm, 8u); }
            pg8::gemm_phase<pg8::EpiMerge, pg8::XPartOrder, true>(F.lds, g, S0, E1, F.wave);
            { pg8::Unit u; for (int i = 0; S0.tile((long)i * F.G + (int)blockIdx.x, u); ++i) flag_signal(flagB + u.pm); }
        } else {
            pg8::XDualOrder S; S.init(F.G, (int)blockIdx.x); pg8::EpiMerge E{F.MB(), F.MG(), 0};
            pg8::gemm_phase<pg8::EpiMerge, pg8::XDualOrder, true>(F.lds, g, S, E, F.wave);
        }
        PH_T1(4);
        if (BOTH(4) && !df) GRID_BAR();
    }

    if (IN(5)) {
        PH_T0(5);
        pg8::Gemm g{F.MB(), F.WoutT(), F.MB(), F.WoutT(), 1024, 1024, 1024}; pg8::XOrder S; S.init(F.G, (int)blockIdx.x);
        pg8::EpiOut E{args.in[0], args.out};
        auto gate = [&]() { if (df) { unsigned* flagB = (unsigned*)(ctl + CW_FLAGB); pg8::Unit u; for (int i = 0; S.tile((long)i * F.G + (int)blockIdx.x, u); ++i) flag_wait(flagB + u.pm, 4u); } };
        pg8::gemm_phase<pg8::EpiOut, pg8::XOrder, true>(F.lds, g, S, E, F.wave, gate);
        PH_T1(5);
    }
    if (PROBE_STAGE > 0) {
        if (threadIdx.x == 0) __hip_atomic_store((unsigned*)(ctl + 12288) + F.vcu, F.MISC[17], RLX_AGENT);
        GRID_BAR();
        if (blockIdx.x == 0 && threadIdx.x == 0) {
            unsigned long long sum = 0ull;
            for (int i = 0; i < F.G; ++i) sum += __hip_atomic_load((unsigned*)(ctl + 12288) + i, RLX_AGENT);
            const unsigned long long spin = 16ull * (sum / (unsigned)F.G);
            const unsigned long long s0 = wall_clock64();
            while (wall_clock64() - s0 < spin) __builtin_amdgcn_s_sleep(8);
        }
    }
    if (PROBE_IDLE >= 0) {
        GRID_BAR();
        if (blockIdx.x == 0 && threadIdx.x == 0) {
            unsigned mx = 0u; unsigned long long sum = 0ull;
            for (int i = 0; i < F.G; ++i) { const unsigned v = __hip_atomic_load((unsigned*)(ctl + 12288) + i, __ATOMIC_RELAXED, __HIP_MEMORY_SCOPE_AGENT); mx = max(mx, v); sum += v; }
            const unsigned long long spin = 64ull * ((unsigned long long)mx - sum / (unsigned)F.G);
            const unsigned long long s0 = wall_clock64();
            while (wall_clock64() - s0 < spin) __builtin_amdgcn_s_sleep(8);
        }
    }
#undef IN
#undef BOTH
}

extern "C" void kernel_launch(void* const* d_in, const int* in_sizes, int n_in, void* d_out, int out_size, void* d_ws, size_t ws_size, hipStream_t stream) {
    static int grid = 0;
    if (grid == 0) {
        if (n_in != 20 || in_sizes[0] != SEQ * DM || out_size != SEQ * DM || ws_size < WS_END) { fprintf(stderr, "kernel_launch: unexpected shapes (n_in %d, in0 %d, out %d, ws %zu)\n", n_in, n_in > 0 ? in_sizes[0] : -1, out_size, ws_size); grid = -1; return; }
        int dev = 0, cus = 0, per_cu = 0;
        if (hipGetDevice(&dev) != hipSuccess || hipDeviceGetAttribute(&cus, hipDeviceAttributeMultiprocessorCount, dev) != hipSuccess) { grid = -1; return; }
        if (hipFuncSetAttribute((const void*)nsa_lru_fwd, hipFuncAttributeMaxDynamicSharedMemorySize, LDS_BYTES) != hipSuccess) { fprintf(stderr, "kernel_launch: hipFuncSetAttribute failed\n"); grid = -1; return; }
        if (hipOccupancyMaxActiveBlocksPerMultiprocessor(&per_cu, (const void*)nsa_lru_fwd, NWAVES * 64, LDS_BYTES) != hipSuccess || per_cu < 1)
            fprintf(stderr, "kernel_launch: occupancy query reports %d workgroups per CU\n", per_cu);
        (void)hipGetLastError();
        grid = cus;
    }
    if (grid < 0) return;
    if (hipMemsetAsync((char*)d_ws + WS_CTL, 0, CTL_ZERO_BYTES, stream) != hipSuccess) { fprintf(stderr, "kernel_launch: hipMemsetAsync failed\n"); return; }
    Args a{};
    for (int i = 0; i < 20; ++i) a.in[i] = (const float*)d_in[i];
    a.out = (float*)d_out; a.ws = (unsigned char*)d_ws;
    const int nl = (PROBE_DUP >= 0) ? 2 : N_LAUNCHES;
    for (int li = 0; li < nl; ++li) {
        if (PROBE_DUP >= 0) { a.ph_lo = li ? PROBE_DUP : 0; a.ph_hi = li ? PER_PHASE : PROBE_DUP + 1; a.li = li; a.pad = (li && PROBE_DUP == 2) ? 1 : 0; }
        else { a.ph_lo = (N_LAUNCHES == PER_PHASE) ? li : 0; a.ph_hi = (N_LAUNCHES == PER_PHASE) ? li + 1 : PER_PHASE; a.li = li; }
        hipLaunchKernelGGL(nsa_lru_fwd, dim3(grid), dim3(NWAVES * 64), LDS_BYTES, stream, a);
        const hipError_t le = hipPeekAtLastError();
        if (le != hipSuccess) { fprintf(stderr, "kernel_launch: launch %d failed: %s\n", li, hipGetErrorName(le)); break; }
    }
}
```
